# Optimizing an MI355X kernel written in HIP

```python
import math
import jax, jax.numpy as jnp
from jax import lax
import numpy as np

D_MODEL = 1024
BATCH = 16
SEQ = 2048
DEPTH = 4
DEC_BATCH = 8
DEC_SEQ = 4096
PAST_LEN = 128

GRID_W = 64
HEAD_DIM = 64
RMS_EPS = 1e-6
NEG_INF = -1e30

NA_HEADS = 8
NA_WIN_ROWS = 8
NA_WIN_COLS = 16
NA_COL_BLOCK = 16
NA_KEY_COLS = NA_COL_BLOCK + NA_WIN_COLS

DIFF_HEADS = 4
DIFF_Q_BLOCK = 128

DIL_PAIRS = ((128, 1), (512, 4), (2048, 16))
DIL_GROUPS = 3
DIL_HEADS = 4
DIL_Q_BLOCK = 64

A_W = NA_HEADS * HEAD_DIM
B_QK = DIFF_HEADS * 2 * HEAD_DIM
B_W = DIFF_HEADS * 2 * HEAD_DIM
C_QKV = DIL_GROUPS * DIL_HEADS * HEAD_DIM
C_W = DIL_HEADS * HEAD_DIM
N_BRANCH = 3
IN_SPLITS = (A_W, A_W, A_W, A_W, B_QK, B_QK, B_W, B_W, C_QKV, C_QKV, C_QKV, C_W, N_BRANCH * D_MODEL)
IN_WIDTH = 4 * A_W + 2 * B_QK + 2 * B_W + 3 * C_QKV + C_W + N_BRANCH * D_MODEL

kernel_name = 'hybrid_natten_diff_dilated_encoder'


def rms_norm(x, g):
    xf = x.astype(jnp.float32)
    y = xf * lax.rsqrt(jnp.mean(xf * xf, axis=-1, keepdims=True) + RMS_EPS)
    return (y * g.astype(jnp.float32)).astype(x.dtype)


def alibi_slopes(n):
    return jnp.asarray(2.0 ** (-8.0 * np.arange(1, n + 1) / n), dtype=jnp.float32)


def neighborhood_attention(q, k, v, rpb):
    b, l, h, dh = q.shape
    rows = l // GRID_W
    kh = min(NA_WIN_ROWS, rows)
    n_cb = GRID_W // NA_COL_BLOCK
    qcol = np.arange(GRID_W).reshape(n_cb, NA_COL_BLOCK)
    qstart = np.clip(qcol - NA_WIN_COLS // 2, 0, GRID_W - NA_WIN_COLS)
    kstart = np.clip(np.arange(n_cb) * NA_COL_BLOCK - NA_WIN_COLS // 2, 0, GRID_W - NA_KEY_COLS)
    kcol = kstart[:, None] + np.arange(NA_KEY_COLS)
    col_ok = (kcol[:, None, :] >= qstart[:, :, None]) & (kcol[:, None, :] < qstart[:, :, None] + NA_WIN_COLS)
    col_idx = np.clip(kcol[:, None, :] - qcol[:, :, None] + NA_WIN_COLS - 1, 0, 2 * NA_WIN_COLS - 2)
    mask = jnp.asarray(np.broadcast_to(col_ok[:, None, :, None, :], (n_cb, 1, NA_COL_BLOCK, kh, NA_KEY_COLS)).reshape(n_cb, 1, NA_COL_BLOCK, kh * NA_KEY_COLS))
    row_start = np.clip(np.arange(rows) - kh // 2, 0, rows - kh).astype(np.int32)
    qg = (q * dh ** -0.5).reshape(b, rows, n_cb, NA_COL_BLOCK, h, dh)
    kg = k.reshape(b, rows, GRID_W, h, dh)
    vg = v.reshape(b, rows, GRID_W, h, dh)
    rpb32 = rpb.astype(jnp.float32)

    def one_row(args):
        r, rs = args

        def gather_keys(x):
            x = lax.dynamic_slice_in_dim(x, rs, kh, axis=1)[:, :, kcol]
            return jnp.moveaxis(x, 1, 2).reshape(b, n_cb, kh * NA_KEY_COLS, h, dh)

        kb = gather_keys(kg)
        vb = gather_keys(vg)
        qr = lax.dynamic_index_in_dim(qg, r, axis=1, keepdims=False)
        s = jnp.einsum('bcqhe,bckhe->bchqk', qr, kb).astype(jnp.float32)
        row_off = rs + jnp.arange(kh, dtype=jnp.int32) - r
        bias = rpb32[:, row_off + NA_WIN_ROWS - 1][:, :, col_idx]
        bias = jnp.transpose(bias, (2, 0, 3, 1, 4)).reshape(n_cb, h, NA_COL_BLOCK, kh * NA_KEY_COLS)
        p = jax.nn.softmax(jnp.where(mask, s + bias, NEG_INF), axis=-1).astype(v.dtype)
        return jnp.einsum('bchqk,bckhe->bcqhe', p, vb)

    out = lax.map(one_row, (jnp.arange(rows, dtype=jnp.int32), jnp.asarray(row_start)))
    return jnp.moveaxis(out, 0, 1).reshape(b, l, h * dh)


def diff_attention(q, k, v, lam, slopes, g_diff, lam_init):
    b, l, h, _, dh = q.shape
    nq = l // DIFF_Q_BLOCK
    qb = jnp.moveaxis((q * dh ** -0.5).reshape(b, nq, DIFF_Q_BLOCK, h, 2, dh), 1, 0)
    kpos = jnp.arange(l, dtype=jnp.int32)

    def one_block(args):
        i, qi = args
        s = jnp.einsum('bqhme,bkhme->bhmqk', qi, k).astype(jnp.float32)
        qpos = i * DIFF_Q_BLOCK + jnp.arange(DIFF_Q_BLOCK, dtype=jnp.int32)
        dist = jnp.abs(qpos[:, None] - kpos[None, :]).astype(jnp.float32)
        a = jax.nn.softmax(s - slopes[None, :, None, None, None] * dist, axis=-1)
        w = (a[:, :, 0] - lam * a[:, :, 1]).astype(v.dtype)
        return jnp.einsum('bhqk,bkhe->bqhe', w, v)

    o = lax.map(one_block, (jnp.arange(nq, dtype=jnp.int32), qb))
    o = jnp.moveaxis(o, 0, 1).reshape(b, l, h, 2 * dh)
    o = rms_norm(o, g_diff) * (1.0 - lam_init)
    return o.reshape(b, l, h * 2 * dh)


def dilated_group_attention(q, k, v, window, dilation, slopes):
    b, l, h, dh = q.shape
    n = window // (2 * dilation)
    m = l // dilation
    nb = -(-m // DIL_Q_BLOCK)
    mp = nb * DIL_Q_BLOCK
    span = DIL_Q_BLOCK + 2 * n

    def to_classes(x):
        return jnp.moveaxis(x.reshape(b, m, dilation, h, dh), 2, 1)

    qc = jnp.pad(to_classes(q * dh ** -0.5), ((0, 0), (0, 0), (0, mp - m), (0, 0), (0, 0)))
    qc = qc.reshape(b, dilation, nb, DIL_Q_BLOCK, h, dh)
    pad_k = ((0, 0), (0, 0), (n, mp - m + n), (0, 0), (0, 0))
    idx = np.arange(nb)[:, None] * DIL_Q_BLOCK + np.arange(span)[None, :]
    kb = jnp.pad(to_classes(k), pad_k)[:, :, idx]
    vb = jnp.pad(to_classes(v), pad_k)[:, :, idx]
    s = jnp.einsum('bdnqhe,bdnkhe->bdnhqk', qc, kb).astype(jnp.float32)
    rel = (np.arange(span)[None, :] - n) - np.arange(DIL_Q_BLOCK)[:, None]
    mk = idx - n
    ok = (np.abs(rel)[None] <= n) & (mk[:, None, :] >= 0) & (mk[:, None, :] < m)
    bias = -slopes[:, None, None] * jnp.asarray(dilation * np.abs(rel), dtype=jnp.float32)
    s = jnp.where(jnp.asarray(ok)[None, None, :, None], s + bias[None, None, None], NEG_INF)
    lse = jax.nn.logsumexp(s, axis=-1)
    p = jnp.exp(s - lse[..., None]).astype(v.dtype)
    o = jnp.einsum('bdnhqk,bdnkhe->bdnqhe', p, vb).reshape(b, dilation, mp, h, dh)[:, :, :m]
    o = jnp.moveaxis(o, 1, 2).reshape(b, l, h, dh)
    lse = jnp.moveaxis(lse, -1, -2).reshape(b, dilation, mp, h)[:, :, :m]
    lse = jnp.moveaxis(lse, 1, 2).reshape(b, l, h)
    return o, lse


def dilated_attention(q, k, v, slopes):
    b, l, _, dh = q.shape
    outs, lses = [], []
    for g, (window, dilation) in enumerate(DIL_PAIRS):
        sl = slice(g * DIL_HEADS, (g + 1) * DIL_HEADS)
        o, lse = dilated_group_attention(q[:, :, sl], k[:, :, sl], v[:, :, sl], window, dilation, slopes[sl])
        outs.append(o)
        lses.append(lse)
    wts = jax.nn.softmax(jnp.stack(lses, axis=0), axis=0)
    o = jnp.sum(wts[..., None] * jnp.stack(outs, axis=0).astype(jnp.float32), axis=0)
    return o.astype(q.dtype).reshape(b, l, DIL_HEADS * dh)


def encoder_layer(x, lam_init, g_norm, w_in, b_gate, rpb, lam_qk, g_diff, w_br_a, w_br_b, w_br_c, w_out):
    b, t, _ = x.shape
    h = rms_norm(x, g_norm)
    u = h @ w_in
    offs = [int(o) for o in np.cumsum(IN_SPLITS)[:-1]]
    qa, ka, va, za, qb, kb, vb, zb, qc, kc, vc, zc, gl = jnp.split(u, offs, axis=-1)
    ya = neighborhood_attention(qa.reshape(b, t, NA_HEADS, HEAD_DIM), ka.reshape(b, t, NA_HEADS, HEAD_DIM),
                                va.reshape(b, t, NA_HEADS, HEAD_DIM), rpb)
    lq = lam_qk.astype(jnp.float32)
    lam = jnp.exp(jnp.sum(lq[0] * lq[1])) - jnp.exp(jnp.sum(lq[2] * lq[3])) + lam_init
    yb = diff_attention(qb.reshape(b, t, DIFF_HEADS, 2, HEAD_DIM), kb.reshape(b, t, DIFF_HEADS, 2, HEAD_DIM),
                        vb.reshape(b, t, DIFF_HEADS, 2 * HEAD_DIM), lam, alibi_slopes(DIFF_HEADS), g_diff, lam_init)
    nh_c = DIL_GROUPS * DIL_HEADS
    yc = dilated_attention(qc.reshape(b, t, nh_c, HEAD_DIM), kc.reshape(b, t, nh_c, HEAD_DIM),
                           vc.reshape(b, t, nh_c, HEAD_DIM), alibi_slopes(nh_c))
    pa = (ya * jax.nn.silu(za)) @ w_br_a
    pb = (yb * jax.nn.silu(zb)) @ w_br_b
    pc = (yc * jax.nn.silu(zc)) @ w_br_c
    gates = jax.nn.sigmoid((gl.reshape(b, t, N_BRANCH, D_MODEL) + b_gate).astype(jnp.float32)).astype(x.dtype)
    merged = gates[:, :, 0] * pa + gates[:, :, 1] * pb + gates[:, :, 2] * pc
    return x + merged @ w_out


def trunk(x, g_norm, w_in, b_gate, rpb, lam_qk, g_diff, w_br_a, w_br_b, w_br_c, w_out, g_final):
    for l in range(DEPTH):
        lam_init = 0.8 - 0.6 * math.exp(-0.3 * l)
        x = encoder_layer(x, lam_init, g_norm[l], w_in[l], b_gate[l], rpb[l], lam_qk[l], g_diff[l],
                          w_br_a[l], w_br_b[l], w_br_c[l], w_out[l])
    return rms_norm(x, g_final)


def setup_inputs(seed: int = 0) -> dict:
    key = jax.random.key(seed)
    ks = jax.random.split(key, 13)
    f32 = jnp.float32
    nrm = lambda k_, shape: jax.random.normal(k_, shape, dtype=f32)
    return {
        'x_prompt': nrm(ks[0], (BATCH, SEQ, D_MODEL)),
        'x_sample': nrm(ks[1], (DEC_BATCH, DEC_SEQ, D_MODEL)),
        'g_norm': 1.0 + 0.05 * nrm(ks[2], (DEPTH, D_MODEL)),
        'w_in': nrm(ks[3], (DEPTH, D_MODEL, IN_WIDTH)) * D_MODEL ** -0.5,
        'b_gate': 0.1 * nrm(ks[4], (DEPTH, N_BRANCH, D_MODEL)),
        'rpb': 0.1 * nrm(ks[5], (DEPTH, NA_HEADS, 2 * NA_WIN_ROWS - 1, 2 * NA_WIN_COLS - 1)),
        'lam_qk': 0.1 * nrm(ks[6], (DEPTH, 4, HEAD_DIM)),
        'g_diff': 1.0 + 0.05 * nrm(ks[7], (DEPTH, 2 * HEAD_DIM)),
        'w_br_a': nrm(ks[8], (DEPTH, A_W, D_MODEL)) * A_W ** -0.5,
        'w_br_b': nrm(ks[9], (DEPTH, B_W, D_MODEL)) * B_W ** -0.5,
        'w_br_c': nrm(ks[10], (DEPTH, C_W, D_MODEL)) * C_W ** -0.5,
        'w_out': nrm(ks[11], (DEPTH, D_MODEL, D_MODEL)) * D_MODEL ** -0.5,
        'g_final': 1.0 + 0.05 * nrm(ks[12], (D_MODEL,)),
    }


def reference(x_prompt, x_sample, g_norm, w_in, b_gate, rpb, lam_qk, g_diff, w_br_a, w_br_b, w_br_c, w_out, g_final):
    y_prompt = trunk(x_prompt, g_norm, w_in, b_gate, rpb, lam_qk, g_diff, w_br_a, w_br_b, w_br_c, w_out, g_final)
    y_sample = trunk(x_sample, g_norm, w_in, b_gate, rpb, lam_qk, g_diff, w_br_a, w_br_b, w_br_c, w_out, g_final)
    return (y_prompt, y_sample)
```

```cpp
#include <hip/hip_runtime.h>
#include <hip/hip_cooperative_groups.h>
#include <cstdio>
namespace cg = cooperative_groups;

#define LAS __attribute__((address_space(3)))
typedef unsigned short bf16_t;
typedef short bf16x8 __attribute__((ext_vector_type(8)));
typedef short bf16x4 __attribute__((ext_vector_type(4)));
typedef float f32x4 __attribute__((ext_vector_type(4)));
typedef float f32x16 __attribute__((ext_vector_type(16)));
typedef unsigned u32x4 __attribute__((ext_vector_type(4)));
typedef unsigned u32x2 __attribute__((ext_vector_type(2)));

constexpr int DM = 1024, DEPTH = 4, INW = 9728, UW = 7936, VW = 1792, YW = 1280;
constexpr int TC = 16384, NCHUNK = 4, NTOK = 65536;
constexpr float LOG2E = 1.4426950408889634f;
constexpr float QSCALE = 0.125f * LOG2E;
constexpr int U_QA = 0, U_KA = 512, U_ZA = 1024, U_QB = 1536, U_KB = 2048, U_ZB = 2560, U_QC = 3072, U_KC = 3840, U_ZC = 4608, U_GL = 4864;
constexpr int V_A = 0, V_B = 512, V_C = 1024;

struct Params {
  const float *xp, *xs, *g_norm, *w_in, *b_gate, *rpb, *lam_qk, *g_diff, *w_br_a, *w_br_b, *w_br_c, *w_out, *g_final;
  float* out;
  bf16_t *wt_in, *wt_br, *wt_out, *xb, *u, *vt, *yg, *oc, *merged;
  float *lse, *ssq, *lam;
};

__device__ __forceinline__ unsigned cvt_pk_bf16(float lo, float hi) { unsigned r; asm volatile("v_cvt_pk_bf16_f32 %0, %1, %2" : "=v"(r) : "v"(lo), "v"(hi)); return r; }
__device__ __forceinline__ float bf_lo(unsigned v) { return __uint_as_float(v << 16); }
__device__ __forceinline__ float bf_hi(unsigned v) { return __uint_as_float(v & 0xffff0000u); }
__device__ __forceinline__ float fexp2(float x) { return __builtin_amdgcn_exp2f(x); }
__device__ __forceinline__ float frcp(float x) { return __builtin_amdgcn_rcpf(x); }

__device__ __forceinline__ int opaque_tid() { int t = threadIdx.x; asm volatile("" : "+v"(t)); return t; }

namespace pg8 {
constexpr int BM = 256, BK = 64, HALF = 128, HTB = HALF * BK * 2, STAGE_BYTES = 8 * HTB, NXCD = 8, WGM = 8;
__device__ __forceinline__ int lds_byte(int r, int c) { const int st = (r >> 4) * 2 + (c >> 5), rr = r & 15, cc = c & 31, ob = rr * 64 + cc * 2; return st * 1024 + (ob ^ (((ob >> 9) & 1) << 5)); }
__device__ __forceinline__ void stage_rc(int b, int& R, int& C) { const int st = b / 1024, sb = b % 1024, swz = sb ^ (((sb >> 9) & 1) << 5); R = (st >> 1) * 16 + swz / 64; C = (st & 1) * 32 + (swz % 64) / 2; }
__device__ __forceinline__ int perm32(int rho) { const int n = rho >> 4, i = rho & 15; return 8 * (i >> 2) + 4 * n + (i & 3); }
struct Unit { int pm, pn; };
struct Gemm { const bf16_t* A; const bf16_t* Bt; int M, N, K; };
struct StaticOrder {
  int nM, nN, nwg, G, c;
  __device__ void init(int M, int N, int G_, int c_) { nM = M / BM; nN = N / BM; nwg = nM * nN; G = G_; c = c_; }
  __device__ bool next(int i, Unit& u) const {
    const long L = (long)i * G + c; if (L >= nwg) return false;
    int wgid = (int)L; { const int q = nwg / NXCD, r = nwg % NXCD, xcd = wgid % NXCD, off = wgid / NXCD; wgid = (xcd < r ? xcd * (q + 1) : r * (q + 1) + (xcd - r) * q) + off; }
    const int nig = WGM * nN, gid = wgid / nig, fm = gid * WGM, gsz = (nM - fm) < WGM ? (nM - fm) : WGM;
    u.pm = fm + ((wgid % nig) % gsz); u.pn = (wgid % nig) / gsz; return true;
  }
};

template <class Epi>
__device__ __forceinline__ void gemm_phase(LAS unsigned char* lds, const Gemm g, const StaticOrder& S, const Epi& E) {
  int tid_ = threadIdx.x; asm volatile("" : "+v"(tid_));
  const int tid = tid_, wid = __builtin_amdgcn_readfirstlane(tid >> 6), lane = tid & 63, wr = wid >> 2, wc = wid & 3, fr = lane & 15, fq = lane >> 4;
  const int K = g.K, nt = K / BK;
  unsigned voffA[2], voffB[2];
#pragma unroll
  for (int i = 0; i < 2; ++i) { int R, C; stage_rc(tid * 16 + i * 8192, R, C); const int Rb = (R & ~31) + perm32(R & 31);
    voffA[i] = (unsigned)(R * K + C) * 2u; voffB[i] = (unsigned)(Rb * K + C) * 2u; }
  const size_t kstep = (size_t)(BK * 2);
  const size_t hstep = (size_t)HALF * K * 2;
  const size_t tstep = 2 * hstep;
  const unsigned ldsw = (unsigned)wid * 1024u;
  const int aoff = lds_byte(wr * 64 + fr, fq * 8), boff = lds_byte(wc * 32 + fr, fq * 8);
#define PG8_SA(b, h) (((b) * 2 + (h)) * HTB)
#define PG8_SB(b, h) ((4 + (b) * 2 + (h)) * HTB)
#define PG8_STAGE(bufoff, gbase, voff) do { _Pragma("unroll") for (int _i = 0; _i < 2; ++_i) \
    __builtin_amdgcn_global_load_lds((const unsigned*)((const char*)(gbase) + (voff)[_i]), (LAS unsigned*)(lds + (bufoff) + ldsw + _i * 8192), 16, 0, 0); } while (0)
#define PG8_LDA(dst, b, h) do { _Pragma("unroll") for (int m = 0; m < 4; ++m) _Pragma("unroll") for (int k = 0; k < 2; ++k) dst[m][k] = *(const LAS bf16x8*)(lds + PG8_SA(b, h) + aoff + m * 2048 + k * 1024); } while (0)
#define PG8_LDB(dst, b, h) do { _Pragma("unroll") for (int n = 0; n < 2; ++n) _Pragma("unroll") for (int k = 0; k < 2; ++k) dst[n][k] = *(const LAS bf16x8*)(lds + PG8_SB(b, h) + boff + n * 2048 + k * 1024); } while (0)
#define PG8_MMA(ai, bj, At, Bt) do { __builtin_amdgcn_s_setprio(1); _Pragma("unroll") for (int m = 0; m < 4; ++m) _Pragma("unroll") for (int n = 0; n < 2; ++n) _Pragma("unroll") for (int k = 0; k < 2; ++k) \
    acc[ai][bj][m][n] = __builtin_amdgcn_mfma_f32_16x16x32_bf16(Bt[n][k], At[m][k], acc[ai][bj][m][n], 0, 0, 0); __builtin_amdgcn_s_setprio(0); } while (0)
#define PG8_WAIT_V(n) asm volatile("s_waitcnt vmcnt(" #n ")" ::: "memory")
#define PG8_WAIT_L(n) asm volatile("s_waitcnt lgkmcnt(" #n ")" ::: "memory")
#define PG8_BAR __builtin_amdgcn_s_barrier()
#define PG8_SCHED __builtin_amdgcn_sched_barrier(0)
  Unit cur, nxt; int ui = 0;
  if (!S.next(0, cur)) return;
  f32x4 acc[2][2][4][2];
#pragma unroll
  for (int a = 0; a < 2; ++a)
#pragma unroll
    for (int b = 0; b < 2; ++b)
#pragma unroll
      for (int m = 0; m < 4; ++m)
#pragma unroll
        for (int n = 0; n < 2; ++n) acc[a][b][m][n] = (f32x4){0.f, 0.f, 0.f, 0.f};
  bf16x8 At[4][2], B0[2][2], B1[2][2];
  const char* cA = (const char*)g.A + (size_t)cur.pm * tstep; const char* cB = (const char*)g.Bt + (size_t)cur.pn * tstep;
  PG8_STAGE(PG8_SB(0, 0), cB, voffB); PG8_STAGE(PG8_SA(0, 0), cA, voffA); PG8_STAGE(PG8_SB(0, 1), cB + hstep, voffB); PG8_STAGE(PG8_SA(0, 1), cA + hstep, voffA);
  if (wr == 1) PG8_BAR;
  PG8_WAIT_V(4); PG8_BAR;
  PG8_STAGE(PG8_SB(1, 0), cB + kstep, voffB); PG8_STAGE(PG8_SA(1, 0), cA + kstep, voffA); PG8_STAGE(PG8_SB(1, 1), cB + hstep + kstep, voffB);
  PG8_WAIT_V(6); PG8_BAR;
  for (;;) {
    const bool has_next = S.next(ui + 1, nxt);
    const char* nA = has_next ? (const char*)g.A + (size_t)nxt.pm * tstep : cA; const char* nB = has_next ? (const char*)g.Bt + (size_t)nxt.pn * tstep : cB;
    for (int t = 0; t < nt; t += 2) {
      if constexpr (Epi::HOOK) { if (t == 8 || t == 16) E.hook(acc, cur, t, wr, wc, fr, fq); }
      const bool last = (t == nt - 2);
      const char* a1 = cA + (size_t)(t + 1) * kstep;
      const char* a2 = last ? nA : cA + (size_t)(t + 2) * kstep; const char* b2 = last ? nB : cB + (size_t)(t + 2) * kstep;
      const char* a3 = a2 + kstep; const char* b3 = b2 + kstep;
      PG8_LDB(B0, 0, 0); PG8_SCHED; PG8_LDA(At, 0, 0); PG8_STAGE(PG8_SA(1, 1), a1 + hstep, voffA);
      PG8_WAIT_L(8); PG8_BAR; PG8_WAIT_L(0); PG8_MMA(0, 0, At, B0); PG8_BAR; PG8_SCHED;
      PG8_LDB(B1, 0, 1); PG8_STAGE(PG8_SB(0, 0), b2, voffB);
      PG8_BAR; PG8_WAIT_L(0); PG8_MMA(0, 1, At, B1); PG8_BAR;
      PG8_LDA(At, 0, 1); PG8_STAGE(PG8_SA(0, 0), a2, voffA);
      PG8_BAR; PG8_WAIT_L(0); PG8_MMA(1, 0, At, B0); PG8_BAR; PG8_SCHED;
      PG8_STAGE(PG8_SB(0, 1), b2 + hstep, voffB);
      PG8_WAIT_V(6); PG8_BAR; PG8_MMA(1, 1, At, B1); PG8_BAR;
      PG8_LDB(B0, 1, 0); PG8_SCHED; PG8_LDA(At, 1, 0); PG8_STAGE(PG8_SA(0, 1), a2 + hstep, voffA);
      PG8_WAIT_L(8); PG8_BAR; PG8_WAIT_L(0); PG8_MMA(0, 0, At, B0); PG8_BAR; PG8_SCHED;
      PG8_LDB(B1, 1, 1); PG8_STAGE(PG8_SB(1, 0), b3, voffB);
      PG8_BAR; PG8_WAIT_L(0); PG8_MMA(0, 1, At, B1); PG8_BAR;
      PG8_LDA(At, 1, 1); PG8_STAGE(PG8_SA(1, 0), a3, voffA);
      PG8_BAR; PG8_WAIT_L(0); PG8_MMA(1, 0, At, B0); PG8_BAR; PG8_SCHED;
      PG8_STAGE(PG8_SB(1, 1), b3 + hstep, voffB);
      PG8_WAIT_V(6); PG8_BAR; PG8_MMA(1, 1, At, B1); PG8_BAR;
    }
    E(acc, cur, wr, wc, fr, fq);
    if (!has_next) break;
#pragma unroll
    for (int a = 0; a < 2; ++a)
#pragma unroll
      for (int b = 0; b < 2; ++b)
#pragma unroll
        for (int m = 0; m < 4; ++m)
#pragma unroll
          for (int n = 0; n < 2; ++n) acc[a][b][m][n] = (f32x4){0.f, 0.f, 0.f, 0.f};
    cur = nxt; cA = nA; cB = nB; ++ui;
  }
  PG8_WAIT_V(0);
  if (wr == 0) PG8_BAR;
  PG8_BAR;
#undef PG8_SA
#undef PG8_SB
#undef PG8_STAGE
#undef PG8_LDA
#undef PG8_LDB
#undef PG8_MMA
#undef PG8_WAIT_V
#undef PG8_WAIT_L
#undef PG8_BAR
#undef PG8_SCHED
}
}
using pg8::Unit;

struct EpiU {
  static constexpr bool HOOK = false;
  bf16_t* U; bf16_t* VT; const float* ssq; const float* bg; int L, lshift;
  __device__ __forceinline__ void hook(f32x4 (&)[2][2][4][2], const Unit&, int, int, int, int, int) const {}
  __device__ __forceinline__ void operator()(const f32x4 (&acc)[2][2][4][2], const Unit& u, int wr, int wc, int fr, int fq) const {
    asm volatile("" : "+v"(fr), "+v"(fq));
    const int row0 = u.pm * 256 + wr * 64 + fr, col0 = u.pn * 256 + wc * 32 + 8 * fq;
    const bool isv = u.pn >= 31, isg = (u.pn >= 19) && !isv;
    const int g = u.pn - 35; const int ds = g <= 0 ? 0 : (g == 1 ? 2 : 4);
#pragma unroll
    for (int ai = 0; ai < 2; ++ai)
#pragma unroll
      for (int m = 0; m < 4; ++m) {
        const int row = row0 + ai * 128 + m * 16;
        const f32x4* sp = (const f32x4*)(ssq + (size_t)row * 16);
        const f32x4 a4 = sp[0] + sp[1] + sp[2] + sp[3];
        const float rinv = rsqrtf((a4[0] + a4[1] + a4[2] + a4[3]) * (1.0f / 1024.0f) + 1e-6f);
        if (isg) {
#pragma unroll
          for (int bj = 0; bj < 2; ++bj) {
            const float* bp = bg + (col0 - U_GL) + bj * 128;
            const f32x4 b0 = *(const f32x4*)bp, b1 = *(const f32x4*)(bp + 4);
            f32x4 v0 = acc[ai][bj][m][0] * rinv + b0, v1 = acc[ai][bj][m][1] * rinv + b1;
#pragma unroll
            for (int j = 0; j < 4; ++j) { v0[j] = 1.0f + fminf(fexp2(-v0[j] * LOG2E), 1e30f); v1[j] = 1.0f + fminf(fexp2(-v1[j] * LOG2E), 1e30f); }
            u32x4 pk = {cvt_pk_bf16(v0[0], v0[1]), cvt_pk_bf16(v0[2], v0[3]), cvt_pk_bf16(v1[0], v1[1]), cvt_pk_bf16(v1[2], v1[3])};
            *(u32x4*)(U + (size_t)row * UW + col0 + bj * 128) = pk;
          }
        } else if (!isv) {
#pragma unroll
          for (int bj = 0; bj < 2; ++bj) {
            const f32x4 v0 = acc[ai][bj][m][0] * rinv, v1 = acc[ai][bj][m][1] * rinv;
            u32x4 pk = {cvt_pk_bf16(v0[0], v0[1]), cvt_pk_bf16(v0[2], v0[3]), cvt_pk_bf16(v1[0], v1[1]), cvt_pk_bf16(v1[2], v1[3])};
            *(u32x4*)(U + (size_t)row * UW + col0 + bj * 128) = pk;
          }
        } else {
          const int seq = row >> lshift, pos = row & (L - 1);
          const int pp = ((pos & ((1 << ds) - 1)) << (lshift - ds)) + (pos >> ds);
          bf16_t* vb = VT + ((size_t)seq * VW + (col0 - UW)) * L + pp;
#pragma unroll
          for (int bj = 0; bj < 2; ++bj)
#pragma unroll
            for (int n = 0; n < 2; ++n) {
              const f32x4 v = acc[ai][bj][m][n] * rinv;
              const unsigned p0 = cvt_pk_bf16(v[0], v[1]), p1 = cvt_pk_bf16(v[2], v[3]);
              bf16_t* vp = vb + (size_t)(bj * 128 + 4 * n) * L;
              vp[0] = (bf16_t)(p0 & 0xffffu); vp[(size_t)L] = (bf16_t)(p0 >> 16); vp[(size_t)2 * L] = (bf16_t)(p1 & 0xffffu); vp[(size_t)3 * L] = (bf16_t)(p1 >> 16);
            }
        }
      }
  }
};

struct EpiMerge {
  static constexpr bool HOOK = true;
  const bf16_t* U; bf16_t* MG;
  __device__ __forceinline__ f32x4 gvec(int i, size_t row, int col) const {
    const u32x2 raw = *(const u32x2*)(U + row * UW + U_GL + i * 1024 + col);
    f32x4 e; e[0] = bf_lo(raw[0]); e[1] = bf_hi(raw[0]); e[2] = bf_lo(raw[1]); e[3] = bf_hi(raw[1]); return e;
  }
  __device__ __forceinline__ void hook(f32x4 (&acc)[2][2][4][2], const Unit& u, int t, int wr, int wc, int fr, int fq) const {
    const int i = (t == 8) ? 0 : 1;
    asm volatile("" : "+v"(fr), "+v"(fq));
    const int row0 = u.pm * 256 + wr * 64 + fr, col0 = u.pn * 256 + wc * 32 + 8 * fq;
#pragma unroll
    for (int ai = 0; ai < 2; ++ai)
#pragma unroll
      for (int m = 0; m < 4; ++m) {
#pragma unroll
        for (int bj = 0; bj < 2; ++bj)
#pragma unroll
          for (int n = 0; n < 2; ++n) {
            const size_t row = (size_t)(row0 + ai * 128 + m * 16); const int col = col0 + bj * 128 + 4 * n;
            const f32x4 g0 = gvec(i, row, col), g1 = gvec(i + 1, row, col);
            f32x4 r;
#pragma unroll
            for (int j = 0; j < 4; ++j) r[j] = g1[j] * frcp(g0[j]);
            acc[ai][bj][m][n] *= r;
          }
        if (m & 1) __builtin_amdgcn_sched_barrier(0);
      }
  }
  __device__ __forceinline__ void operator()(const f32x4 (&acc)[2][2][4][2], const Unit& u, int wr, int wc, int fr, int fq) const {
    asm volatile("" : "+v"(fr), "+v"(fq));
    const int row0 = u.pm * 256 + wr * 64 + fr, col0 = u.pn * 256 + wc * 32 + 8 * fq;
#pragma unroll
    for (int ai = 0; ai < 2; ++ai)
#pragma unroll
      for (int m = 0; m < 4; ++m)
#pragma unroll
        for (int bj = 0; bj < 2; ++bj) {
          const size_t row = (size_t)(row0 + ai * 128 + m * 16); const int col = col0 + bj * 128;
          const f32x4 e0 = gvec(2, row, col), e1 = gvec(2, row, col + 4);
          f32x4 v0 = acc[ai][bj][m][0], v1 = acc[ai][bj][m][1];
#pragma unroll
          for (int j = 0; j < 4; ++j) { v0[j] *= frcp(e0[j]); v1[j] *= frcp(e1[j]); }
          u32x4 pk = {cvt_pk_bf16(v0[0], v0[1]), cvt_pk_bf16(v0[2], v0[3]), cvt_pk_bf16(v1[0], v1[1]), cvt_pk_bf16(v1[2], v1[3])};
          *(u32x4*)(MG + row * DM + col) = pk;
        }
  }
};

struct EpiRes {
  static constexpr bool HOOK = false;
  const float* R; float* X; bf16_t* XB; float* ssq;
  __device__ __forceinline__ void hook(f32x4 (&)[2][2][4][2], const Unit&, int, int, int, int, int) const {}
  __device__ __forceinline__ void operator()(const f32x4 (&acc)[2][2][4][2], const Unit& u, int wr, int wc, int fr, int fq) const {
    asm volatile("" : "+v"(fr), "+v"(fq));
    const int row0 = u.pm * 256 + wr * 64 + fr, col0 = u.pn * 256 + wc * 32 + 8 * fq;
#pragma unroll
    for (int ai = 0; ai < 2; ++ai)
#pragma unroll
      for (int m = 0; m < 4; ++m) {
        const size_t row = (size_t)(row0 + ai * 128 + m * 16);
        float s = 0.f;
#pragma unroll
        for (int bj = 0; bj < 2; ++bj) {
          const int col = col0 + bj * 128;
          const f32x4 r0 = *(const f32x4*)(R + row * DM + col), r1 = *(const f32x4*)(R + row * DM + col + 4);
          const f32x4 v0 = r0 + acc[ai][bj][m][0], v1 = r1 + acc[ai][bj][m][1];
          *(f32x4*)(X + row * DM + col) = v0; *(f32x4*)(X + row * DM + col + 4) = v1;
          s += v0[0] * v0[0] + v0[1] * v0[1] + v0[2] * v0[2] + v0[3] * v0[3] + v1[0] * v1[0] + v1[1] * v1[1] + v1[2] * v1[2] + v1[3] * v1[3];
          u32x4 pk = {cvt_pk_bf16(v0[0], v0[1]), cvt_pk_bf16(v0[2], v0[3]), cvt_pk_bf16(v1[0], v1[1]), cvt_pk_bf16(v1[2], v1[3])};
          *(u32x4*)(XB + row * DM + col) = pk;
        }
        s += __shfl_xor(s, 16); s += __shfl_xor(s, 32);
        if (fq == 0) ssq[row * 16 + u.pn * 4 + wc] = s;
      }
  }
};

__device__ __forceinline__ void prep_tile(const float* src, int ldn, int k0, int n0, const float* rscale, float cscale, bf16_t* dst, int ldd, int drow0, int dk0, LAS float* tile) {
  const int tid = opaque_tid(), kk = tid >> 6, nn = tid & 63;
#pragma unroll
  for (int i = 0; i < 8; ++i) {
    const int k = kk * 8 + i;
    float v = src[(size_t)(k0 + k) * ldn + n0 + nn] * cscale;
    if (rscale) v *= rscale[k0 + k];
    tile[k * 65 + nn] = v;
  }
  __syncthreads();
  const int n = tid >> 3, kc = tid & 7;
  float f[8];
#pragma unroll
  for (int j = 0; j < 8; ++j) f[j] = tile[(kc * 8 + j) * 65 + n];
  u32x4 pk = {cvt_pk_bf16(f[0], f[1]), cvt_pk_bf16(f[2], f[3]), cvt_pk_bf16(f[4], f[5]), cvt_pk_bf16(f[6], f[7])};
  *(u32x4*)(dst + (size_t)(drow0 + n) * ldd + dk0 + kc * 8) = pk;
  __syncthreads();
}

__device__ __forceinline__ void win_map(int n0, int& dn0, float& sc) {
  sc = 1.0f;
  if (n0 < 512) { dn0 = U_QA + n0; sc = QSCALE; }
  else if (n0 < 1024) dn0 = U_KA + (n0 - 512);
  else if (n0 < 1536) dn0 = UW + V_A + (n0 - 1024);
  else if (n0 < 2048) dn0 = U_ZA + (n0 - 1536);
  else if (n0 < 2560) { dn0 = U_QB + (n0 - 2048); sc = QSCALE; }
  else if (n0 < 3072) dn0 = U_KB + (n0 - 2560);
  else if (n0 < 3584) dn0 = UW + V_B + (n0 - 3072);
  else if (n0 < 4096) dn0 = U_ZB + (n0 - 3584);
  else if (n0 < 4864) { dn0 = U_QC + (n0 - 4096); sc = QSCALE; }
  else if (n0 < 5632) dn0 = U_KC + (n0 - 4864);
  else if (n0 < 6400) dn0 = UW + V_C + (n0 - 5632);
  else if (n0 < 6656) dn0 = U_ZC + (n0 - 6400);
  else dn0 = U_GL + (n0 - 6656);
}

__device__ void phase_prep(const Params& p, LAS float* tile) {
  constexpr int PER = 3008;
  for (int it = blockIdx.x; it < DEPTH * PER; it += gridDim.x) {
    const int l = it / PER; int r = it % PER;
    if (r < 2432) {
      const int kt = r / 152, ntile = r % 152; int dn0; float sc; win_map(ntile * 64, dn0, sc);
      prep_tile(p.w_in + (size_t)l * DM * INW, INW, kt * 64, ntile * 64, p.g_norm + l * DM, sc, p.wt_in + (size_t)l * INW * DM, DM, dn0, kt * 64, tile);
    } else if ((r -= 2432) < 128) {
      const int kt = r / 16, ntile = r % 16;
      prep_tile(p.w_br_a + (size_t)l * 512 * DM, DM, kt * 64, ntile * 64, nullptr, 1.0f, p.wt_br + (size_t)l * DM * YW, YW, ntile * 64, kt * 64, tile);
    } else if ((r -= 128) < 128) {
      const int kt = r / 16, ntile = r % 16;
      prep_tile(p.w_br_b + (size_t)l * 512 * DM, DM, kt * 64, ntile * 64, nullptr, 1.0f, p.wt_br + (size_t)l * DM * YW, YW, ntile * 64, 512 + kt * 64, tile);
    } else if ((r -= 128) < 64) {
      const int kt = r / 16, ntile = r % 16;
      prep_tile(p.w_br_c + (size_t)l * 256 * DM, DM, kt * 64, ntile * 64, nullptr, 1.0f, p.wt_br + (size_t)l * DM * YW, YW, ntile * 64, 1024 + kt * 64, tile);
    } else {
      r -= 64; const int kt = r / 16, ntile = r % 16;
      prep_tile(p.w_out + (size_t)l * DM * DM, DM, kt * 64, ntile * 64, nullptr, 1.0f, p.wt_out + (size_t)l * DM * DM, DM, ntile * 64, kt * 64, tile);
    }
  }
  if (blockIdx.x == 0 && threadIdx.x < 64) {
    const int lane = threadIdx.x;
    for (int l = 0; l < DEPTH; ++l) {
      const float* lq = p.lam_qk + l * 256;
      float a = lq[lane] * lq[64 + lane], b = lq[128 + lane] * lq[192 + lane];
      for (int o = 32; o >= 1; o >>= 1) { a += __shfl_xor(a, o); b += __shfl_xor(b, o); }
      if (lane == 0) p.lam[l] = expf(a) - expf(b) + (0.8f - 0.6f * expf(-0.3f * (float)l));
    }
  }
}

__device__ void phase_x(const Params& p, int chunk) {
  const float* xin = (chunk < 2) ? p.xp + (size_t)chunk * TC * DM : p.xs + (size_t)(chunk - 2) * TC * DM;
  float* ssq = p.ssq + (size_t)chunk * TC * 16;
  const int tid = opaque_tid(), lane = tid & 63, w = blockIdx.x * 8 + (tid >> 6), nw = gridDim.x * 8;
  for (int row = w; row < TC; row += nw) {
    const float* xr = xin + (size_t)row * DM + lane * 16;
    f32x4 v[4]; float s = 0.f;
#pragma unroll
    for (int i = 0; i < 4; ++i) { v[i] = *(const f32x4*)(xr + i * 4); s += v[i][0] * v[i][0] + v[i][1] * v[i][1] + v[i][2] * v[i][2] + v[i][3] * v[i][3]; }
    for (int o = 32; o >= 1; o >>= 1) s += __shfl_xor(s, o);
    u32x4 p0 = {cvt_pk_bf16(v[0][0], v[0][1]), cvt_pk_bf16(v[0][2], v[0][3]), cvt_pk_bf16(v[1][0], v[1][1]), cvt_pk_bf16(v[1][2], v[1][3])};
    u32x4 p1 = {cvt_pk_bf16(v[2][0], v[2][1]), cvt_pk_bf16(v[2][2], v[2][3]), cvt_pk_bf16(v[3][0], v[3][1]), cvt_pk_bf16(v[3][2], v[3][3])};
    bf16_t* xo = p.xb + (size_t)row * DM + lane * 16;
    *(u32x4*)xo = p0; *(u32x4*)(xo + 8) = p1;
    if (lane < 16) ssq[(size_t)row * 16 + lane] = (lane == 0) ? s : 0.f;
  }
}

__device__ void phase_final(const Params& p, int chunk) {
  float* x = p.out + (size_t)chunk * TC * DM;
  const float* ssq = p.ssq + (size_t)chunk * TC * 16;
  const int tid = opaque_tid(), lane = tid & 63, w = blockIdx.x * 8 + (tid >> 6), nw = gridDim.x * 8;
  for (int row = w; row < TC; row += nw) {
    const f32x4* sp = (const f32x4*)(ssq + (size_t)row * 16);
    const f32x4 a4 = sp[0] + sp[1] + sp[2] + sp[3];
    const float rinv = rsqrtf((a4[0] + a4[1] + a4[2] + a4[3]) * (1.0f / 1024.0f) + 1e-6f);
    float* xr = x + (size_t)row * DM + lane * 16;
#pragma unroll
    for (int i = 0; i < 4; ++i) { f32x4 v = *(const f32x4*)(xr + i * 4); const f32x4 g = *(const f32x4*)(p.g_final + lane * 16 + i * 4); v = v * rinv * g; *(f32x4*)(xr + i * 4) = v; }
  }
}

__device__ __forceinline__ f32x16 mfma32(bf16x8 a, bf16x8 b, f32x16 c) { return __builtin_amdgcn_mfma_f32_32x32x16_bf16(a, b, c, 0, 0, 0); }
__device__ __forceinline__ bf16x8 ld16(const bf16_t* p) { return *(const bf16x8*)p; }
__device__ __forceinline__ bf16x8 ld8x2(const bf16_t* p0, const bf16_t* p1) { const bf16x4 a = *(const bf16x4*)p0, b = *(const bf16x4*)p1; return __builtin_shufflevector(a, b, 0, 1, 2, 3, 4, 5, 6, 7); }

__device__ __forceinline__ void softmax_tile(f32x16& t, float& m, float& l, float& alpha, bf16x8& p0, bf16x8& p1) {
  float tm = t[0];
#pragma unroll
  for (int i = 1; i < 16; ++i) tm = fmaxf(tm, t[i]);
  tm = fmaxf(tm, __shfl_xor(tm, 32));
  const float mn = fmaxf(m, tm);
  alpha = fexp2(m - mn); m = mn;
  float ls = 0.f;
#pragma unroll
  for (int i = 0; i < 16; ++i) { t[i] = fexp2(t[i] - mn); ls += t[i]; }
  l = l * alpha + ls;
  const u32x4 a = {cvt_pk_bf16(t[0], t[1]), cvt_pk_bf16(t[2], t[3]), cvt_pk_bf16(t[4], t[5]), cvt_pk_bf16(t[6], t[7])};
  const u32x4 b = {cvt_pk_bf16(t[8], t[9]), cvt_pk_bf16(t[10], t[11]), cvt_pk_bf16(t[12], t[13]), cvt_pk_bf16(t[14], t[15])};
  p0 = __builtin_bit_cast(bf16x8, a); p1 = __builtin_bit_cast(bf16x8, b);
}
__device__ __forceinline__ f32x16 zero16() { f32x16 z;
#pragma unroll
  for (int i = 0; i < 16; ++i) z[i] = 0.f; return z; }
__device__ __forceinline__ float silu(float z) { return z * frcp(1.0f + fexp2(-z * LOG2E)); }

__device__ void attn_b_unit(const Params& p, int layer, int L, int seq, int h, int qt, int lane, LAS bf16x8* qs) {
  const int q = lane & 31, half = lane >> 5;
  const size_t tokbase = (size_t)seq * L;
  const int tq = qt * 32 + q;
  const bf16_t* urow = p.u + (tokbase + tq) * UW;
#pragma unroll
  for (int mp = 0; mp < 2; ++mp)
#pragma unroll
    for (int ks = 0; ks < 4; ++ks) qs[(mp * 4 + ks) * 64] = ld16(urow + U_QB + h * 128 + mp * 64 + ks * 16 + half * 8);
  f32x16 o[2][4];
#pragma unroll
  for (int mp = 0; mp < 2; ++mp)
#pragma unroll
    for (int dt = 0; dt < 4; ++dt) o[mp][dt] = zero16();
  float mrun[2] = {-1e30f, -1e30f}, lrun[2] = {0.f, 0.f};
  const float slope2 = exp2f(-2.0f * (float)(h + 1)) * LOG2E;
  const bf16_t* vbase = p.vt + ((size_t)seq * VW + V_B + h * 128 + q) * L;
  const bf16_t* kbase = p.u + (tokbase + q) * UW + U_KB + h * 128 + half * 8;
  for (int k0 = 0; k0 < L; k0 += 32) {
    const bf16_t* kp = kbase + (size_t)k0 * UW;
    const float d0 = (float)(k0 + half * 4 - tq);
#pragma unroll
    for (int mp = 0; mp < 2; ++mp) {
      f32x16 s = zero16();
#pragma unroll
      for (int ks = 0; ks < 4; ++ks) s = mfma32(ld16(kp + mp * 64 + ks * 16), qs[(mp * 4 + ks) * 64], s);
#pragma unroll
      for (int i = 0; i < 16; ++i) s[i] = s[i] - slope2 * fabsf(d0 + (float)((i >> 2) * 8 + (i & 3)));
      float alpha; bf16x8 pk[2];
      softmax_tile(s, mrun[mp], lrun[mp], alpha, pk[0], pk[1]);
#pragma unroll
      for (int dt = 0; dt < 4; ++dt) {
        o[mp][dt] *= alpha;
#pragma unroll
        for (int s2 = 0; s2 < 2; ++s2) {
          const bf16_t* vp = vbase + (size_t)(dt * 32) * L + k0 + s2 * 16 + half * 4;
          o[mp][dt] = mfma32(ld8x2(vp, vp + 8), pk[s2], o[mp][dt]);
        }
      }
    }
  }
  const float l0 = lrun[0] + __shfl_xor(lrun[0], 32), l1 = lrun[1] + __shfl_xor(lrun[1], 32);
  const float lam = p.lam[layer];
  const float c0 = frcp(l0), c1 = lam * frcp(l1);
  float ss = 0.f;
#pragma unroll
  for (int dt = 0; dt < 4; ++dt)
#pragma unroll
    for (int i = 0; i < 16; ++i) { const float v = o[0][dt][i] * c0 - o[1][dt][i] * c1; o[0][dt][i] = v; ss += v * v; }
  ss += __shfl_xor(ss, 32);
  const float rn = rsqrtf(ss * (1.0f / 128.0f) + 1e-6f) * (1.0f - (0.8f - 0.6f * expf(-0.3f * (float)layer)));
  const float* gd = p.g_diff + layer * 128;
  bf16_t* yrow = p.yg + (tokbase + tq) * YW + 512 + h * 128;
  const bf16_t* zrow = urow + U_ZB + h * 128;
#pragma unroll
  for (int dt = 0; dt < 4; ++dt)
#pragma unroll
    for (int g4 = 0; g4 < 4; ++g4) {
      const int dim = dt * 32 + g4 * 8 + half * 4;
      const u32x2 zr = *(const u32x2*)(zrow + dim);
      const f32x4 gv = *(const f32x4*)(gd + dim);
      const float y0 = o[0][dt][g4 * 4 + 0] * rn * gv[0] * silu(bf_lo(zr[0]));
      const float y1 = o[0][dt][g4 * 4 + 1] * rn * gv[1] * silu(bf_hi(zr[0]));
      const float y2 = o[0][dt][g4 * 4 + 2] * rn * gv[2] * silu(bf_lo(zr[1]));
      const float y3 = o[0][dt][g4 * 4 + 3] * rn * gv[3] * silu(bf_hi(zr[1]));
      u32x2 pk = {cvt_pk_bf16(y0, y1), cvt_pk_bf16(y2, y3)};
      *(u32x2*)(yrow + dim) = pk;
    }
}

__device__ void attn_a_unit(const Params& p, int layer, int L, int seq, int h, int r, int cb2, int lane) {
  const int q = lane & 31, half = lane >> 5;
  const size_t tokbase = (size_t)seq * L;
  const int rows = L >> 6;
  int rs = r - 4; rs = rs < 0 ? 0 : (rs > rows - 8 ? rows - 8 : rs);
  const int qcol = cb2 * 32 + q, tq = r * 64 + qcol;
  int qstart = qcol - 8; qstart = qstart < 0 ? 0 : (qstart > 48 ? 48 : qstart);
  const bf16_t* urow = p.u + (tokbase + tq) * UW;
  bf16x8 qf[4];
#pragma unroll
  for (int ks = 0; ks < 4; ++ks) qf[ks] = ld16(urow + U_QA + h * 64 + ks * 16 + half * 8);
  f32x16 o[2] = {zero16(), zero16()};
  float mrun = -1e30f, lrun = 0.f;
  const float* rpb = p.rpb + ((size_t)layer * 8 + h) * 15 * 31;
  const bf16_t* vbase = p.vt + ((size_t)seq * VW + V_A + h * 64 + q) * L;
  for (int i = 0; i < 8; ++i) {
    const int krow = rs + i;
    const float* rpr = rpb + (krow - r + 7) * 31;
#pragma unroll
    for (int seg = 0; seg < 2; ++seg) {
      const bf16_t* kp = p.u + (tokbase + krow * 64 + seg * 32 + q) * UW + U_KA + h * 64 + half * 8;
      f32x16 s = zero16();
#pragma unroll
      for (int ks = 0; ks < 4; ++ks) s = mfma32(ld16(kp + ks * 16), qf[ks], s);
#pragma unroll
      for (int ii = 0; ii < 16; ++ii) {
        const int kcol = seg * 32 + (ii >> 2) * 8 + half * 4 + (ii & 3);
        const bool ok = (kcol >= qstart) && (kcol < qstart + 16);
        int ci = kcol - qcol + 15; ci = ci < 0 ? 0 : (ci > 30 ? 30 : ci);
        s[ii] = ok ? s[ii] + rpr[ci] * LOG2E : -INFINITY;
      }
      float alpha; bf16x8 pk[2];
      softmax_tile(s, mrun, lrun, alpha, pk[0], pk[1]);
#pragma unroll
      for (int dt = 0; dt < 2; ++dt) {
        o[dt] *= alpha;
#pragma unroll
        for (int s2 = 0; s2 < 2; ++s2) {
          const bf16_t* vp = vbase + (size_t)(dt * 32) * L + krow * 64 + seg * 32 + s2 * 16 + half * 4;
          o[dt] = mfma32(ld8x2(vp, vp + 8), pk[s2], o[dt]);
        }
      }
    }
  }
  const float lt = lrun + __shfl_xor(lrun, 32);
  const float c = frcp(lt);
  bf16_t* yrow = p.yg + (tokbase + tq) * YW + h * 64;
  const bf16_t* zrow = urow + U_ZA + h * 64;
#pragma unroll
  for (int dt = 0; dt < 2; ++dt)
#pragma unroll
    for (int g4 = 0; g4 < 4; ++g4) {
      const int dim = dt * 32 + g4 * 8 + half * 4;
      const u32x2 zr = *(const u32x2*)(zrow + dim);
      const float y0 = o[dt][g4 * 4 + 0] * c * silu(bf_lo(zr[0]));
      const float y1 = o[dt][g4 * 4 + 1] * c * silu(bf_hi(zr[0]));
      const float y2 = o[dt][g4 * 4 + 2] * c * silu(bf_lo(zr[1]));
      const float y3 = o[dt][g4 * 4 + 3] * c * silu(bf_hi(zr[1]));
      u32x2 pk = {cvt_pk_bf16(y0, y1), cvt_pk_bf16(y2, y3)};
      *(u32x2*)(yrow + dim) = pk;
    }
}

__device__ void attn_c_unit(const Params& p, int L, int lshift, int seq, int g, int h, int rr, int mblk, int lane) {
  const int q = lane & 31, half = lane >> 5;
  const size_t tokbase = (size_t)seq * L;
  const int ds = (g == 0) ? 0 : (g == 1 ? 2 : 4), d = 1 << ds, M = L >> ds;
  const int hh = g * 4 + h;
  const int m0 = mblk * 32, mq = m0 + q, tq = mq * d + rr;
  const bf16_t* urow = p.u + (tokbase + tq) * UW;
  bf16x8 qf[4];
#pragma unroll
  for (int ks = 0; ks < 4; ++ks) qf[ks] = ld16(urow + U_QC + hh * 64 + ks * 16 + half * 8);
  f32x16 o[2] = {zero16(), zero16()};
  float mrun = -1e30f, lrun = 0.f;
  const float coef = exp2f(-(2.0f / 3.0f) * (float)(hh + 1)) * (float)d * LOG2E;
  const bf16_t* vbase = p.vt + ((size_t)seq * VW + V_C + hh * 64 + q) * L + (size_t)rr * M;
  for (int j = 0; j < 5; ++j) {
    const int mk0 = m0 - 64 + 32 * j;
    if (mk0 + 32 <= 0 || mk0 >= M) continue;
    int mkl = mk0 + q; mkl = mkl < 0 ? 0 : (mkl > M - 1 ? M - 1 : mkl);
    const bf16_t* kp = p.u + (tokbase + (size_t)mkl * d + rr) * UW + U_KC + hh * 64 + half * 8;
    f32x16 s = zero16();
#pragma unroll
    for (int ks = 0; ks < 4; ++ks) s = mfma32(ld16(kp + ks * 16), qf[ks], s);
#pragma unroll
    for (int ii = 0; ii < 16; ++ii) {
      const int mk = mk0 + (ii >> 2) * 8 + half * 4 + (ii & 3);
      const int rel = mk - mq; const int ar = rel < 0 ? -rel : rel;
      const bool ok = (mk >= 0) && (mk < M) && (ar <= 64);
      s[ii] = ok ? s[ii] - coef * (float)ar : -INFINITY;
    }
    float alpha; bf16x8 pk[2];
    softmax_tile(s, mrun, lrun, alpha, pk[0], pk[1]);
#pragma unroll
    for (int dt = 0; dt < 2; ++dt) {
      o[dt] *= alpha;
#pragma unroll
      for (int s2 = 0; s2 < 2; ++s2) {
        int pa = mk0 + s2 * 16 + half * 4, pb = pa + 8;
        pa = pa < 0 ? 0 : (pa > M - 4 ? M - 4 : pa); pb = pb < 0 ? 0 : (pb > M - 4 ? M - 4 : pb);
        const bf16_t* vp = vbase + (size_t)(dt * 32) * L;
        o[dt] = mfma32(ld8x2(vp + pa, vp + pb), pk[s2], o[dt]);
      }
    }
  }
  const float lt = lrun + __shfl_xor(lrun, 32);
  const float c = frcp(lt);
  bf16_t* orow = p.oc + (tokbase + tq) * 768 + hh * 64;
#pragma unroll
  for (int dt = 0; dt < 2; ++dt)
#pragma unroll
    for (int g4 = 0; g4 < 4; ++g4) {
      const int dim = dt * 32 + g4 * 8 + half * 4;
      u32x2 pk = {cvt_pk_bf16(o[dt][g4 * 4 + 0] * c, o[dt][g4 * 4 + 1] * c), cvt_pk_bf16(o[dt][g4 * 4 + 2] * c, o[dt][g4 * 4 + 3] * c)};
      *(u32x2*)(orow + dim) = pk;
    }
  if (half == 0) p.lse[(tokbase + tq) * 12 + hh] = mrun + log2f(lt);
}

__device__ void phase_attn(const Params& p, int layer, int L, int lshift, LAS unsigned char* lds) {
  const int tiles = L >> 5;
  const int nseq = TC >> lshift;
  const int nw = gridDim.x * 8;
  int w, lane;
  { const int tid = opaque_tid(); lane = tid & 63; const int wid = __builtin_amdgcn_readfirstlane(tid >> 6); w = blockIdx.x * 8 + wid;
    LAS bf16x8* qs = (LAS bf16x8*)lds + wid * 512 + lane;
    for (int ub = w; ub < nseq * 4 * tiles; ub += nw) {
      const int qt = ub % tiles, sh = ub / tiles;
      attn_b_unit(p, layer, L, sh >> 2, sh & 3, qt, lane, qs);
    }
  }
  { const int tid = opaque_tid(); lane = tid & 63; w = blockIdx.x * 8 + __builtin_amdgcn_readfirstlane(tid >> 6); }
  for (int ua = w; ua < nseq * 8 * tiles; ua += nw) {
    const int idx = ua % tiles, sh = ua / tiles;
    attn_a_unit(p, layer, L, sh >> 3, sh & 7, idx >> 1, idx & 1, lane);
  }
  for (int uc = w; uc < nseq * 12 * tiles; uc += nw) {
    const int idx = uc % tiles, sgh = uc / tiles;
    const int seq = sgh / 12, gh = sgh % 12, g = gh >> 2, h = gh & 3;
    const int ds = (g == 0) ? 0 : (g == 1 ? 2 : 4);
    const int mb = (L >> ds) >> 5;
    attn_c_unit(p, L, lshift, seq, g, h, idx / mb, idx % mb, lane);
  }
}

__device__ void phase_combine(const Params& p) {
  const int gt = blockIdx.x * 512 + opaque_tid(), ngt = gridDim.x * 512;
  for (int it = gt; it < TC * 32; it += ngt) {
    const int tok = it >> 5, sub = it & 31, h = sub >> 3, d8 = (sub & 7) * 8;
    const float* ls = p.lse + (size_t)tok * 12;
    const float l0 = ls[h], l1 = ls[4 + h], l2 = ls[8 + h];
    const float mx = fmaxf(l0, fmaxf(l1, l2));
    const float w0 = fexp2(l0 - mx), w1 = fexp2(l1 - mx), w2 = fexp2(l2 - mx);
    const float inv = frcp(w0 + w1 + w2);
    const bf16_t* ob = p.oc + (size_t)tok * 768 + h * 64 + d8;
    const u32x4 a = *(const u32x4*)ob, b = *(const u32x4*)(ob + 256), c = *(const u32x4*)(ob + 512);
    const u32x4 z = *(const u32x4*)(p.u + (size_t)tok * UW + U_ZC + h * 64 + d8);
    u32x4 r;
#pragma unroll
    for (int k = 0; k < 4; ++k) {
      const float vlo = (w0 * bf_lo(a[k]) + w1 * bf_lo(b[k]) + w2 * bf_lo(c[k])) * inv * silu(bf_lo(z[k]));
      const float vhi = (w0 * bf_hi(a[k]) + w1 * bf_hi(b[k]) + w2 * bf_hi(c[k])) * inv * silu(bf_hi(z[k]));
      r[k] = cvt_pk_bf16(vlo, vhi);
    }
    *(u32x4*)(p.yg + (size_t)tok * YW + 1024 + h * 64 + d8) = r;
  }
}

__global__ void __launch_bounds__(512) fwd_megakernel(Params p) {
  __shared__ __attribute__((aligned(16))) unsigned char smem[pg8::STAGE_BYTES];
  cg::grid_group grid = cg::this_grid();
  LAS unsigned char* lds = (LAS unsigned char*)smem;
  phase_prep(p, (LAS float*)smem);
  phase_x(p, 0);
  grid.sync();
  for (int chunk = 0; chunk < NCHUNK; ++chunk) {
    const int L = chunk < 2 ? 2048 : 4096, lshift = chunk < 2 ? 11 : 12;
    const float* xin = (chunk < 2) ? p.xp + (size_t)chunk * TC * DM : p.xs + (size_t)(chunk - 2) * TC * DM;
    float* xres = p.out + (size_t)chunk * TC * DM;
    float* ssq = p.ssq + (size_t)chunk * TC * 16;
    for (int layer = 0; layer < DEPTH; ++layer) {
      {
        pg8::Gemm g{p.xb, p.wt_in + (size_t)layer * INW * DM, TC, INW, DM};
        pg8::StaticOrder S; S.init(TC, INW, gridDim.x, blockIdx.x);
        EpiU E{p.u, p.vt, ssq, p.b_gate + (size_t)layer * 3 * DM, L, lshift};
        pg8::gemm_phase(lds, g, S, E);
      }
      grid.sync();
      phase_attn(p, layer, L, lshift, lds);
      grid.sync();
      phase_combine(p);
      grid.sync();
      {
        pg8::Gemm g{p.yg, p.wt_br + (size_t)layer * DM * YW, TC, DM, YW};
        pg8::StaticOrder S; S.init(TC, DM, gridDim.x, blockIdx.x);
        EpiMerge E{p.u, p.merged};
        pg8::gemm_phase(lds, g, S, E);
      }
      grid.sync();
      {
        pg8::Gemm g{p.merged, p.wt_out + (size_t)layer * DM * DM, TC, DM, DM};
        pg8::StaticOrder S; S.init(TC, DM, gridDim.x, blockIdx.x);
        EpiRes E{layer == 0 ? xin : (const float*)xres, xres, p.xb, ssq};
        pg8::gemm_phase(lds, g, S, E);
      }
      grid.sync();
    }
    phase_final(p, chunk);
    if (chunk + 1 < NCHUNK) { phase_x(p, chunk + 1); grid.sync(); }
  }
}

extern "C" void kernel_launch(void* const* d_in, const int* in_sizes, int n_in, void* d_out, int out_size, void* d_ws, size_t ws_size, hipStream_t stream) {
  (void)in_sizes; (void)n_in; (void)out_size;
  static int grid_blocks = 0;
  if (!grid_blocks) {
    int dev = 0, cus = 0, per_cu = 0;
    hipGetDevice(&dev);
    hipDeviceGetAttribute(&cus, hipDeviceAttributeMultiprocessorCount, dev);
    hipOccupancyMaxActiveBlocksPerMultiprocessor(&per_cu, fwd_megakernel, 512, 0);
    if (per_cu < 1) per_cu = 1;
    grid_blocks = cus * per_cu;
    if (grid_blocks > 256) grid_blocks = 256;
  }
  Params p{};
  p.xp = (const float*)d_in[0]; p.xs = (const float*)d_in[1]; p.g_norm = (const float*)d_in[2]; p.w_in = (const float*)d_in[3];
  p.b_gate = (const float*)d_in[4]; p.rpb = (const float*)d_in[5]; p.lam_qk = (const float*)d_in[6]; p.g_diff = (const float*)d_in[7];
  p.w_br_a = (const float*)d_in[8]; p.w_br_b = (const float*)d_in[9]; p.w_br_c = (const float*)d_in[10]; p.w_out = (const float*)d_in[11];
  p.g_final = (const float*)d_in[12];
  p.out = (float*)d_out;
  char* w = (char*)d_ws; size_t off = 0;
  auto take = [&](size_t bytes) { char* r = w + off; off += (bytes + 255) & ~(size_t)255; return r; };
  p.wt_in = (bf16_t*)take((size_t)DEPTH * INW * DM * 2);
  p.wt_br = (bf16_t*)take((size_t)DEPTH * DM * YW * 2);
  p.wt_out = (bf16_t*)take((size_t)DEPTH * DM * DM * 2);
  p.xb = (bf16_t*)take((size_t)TC * DM * 2);
  p.u = (bf16_t*)take((size_t)TC * UW * 2);
  p.vt = (bf16_t*)take((size_t)TC * VW * 2);
  p.yg = (bf16_t*)take((size_t)TC * YW * 2);
  p.oc = (bf16_t*)take((size_t)TC * 768 * 2);
  p.merged = (bf16_t*)take((size_t)TC * DM * 2);
  p.lse = (float*)take((size_t)TC * 12 * 4);
  p.ssq = (float*)take((size_t)NTOK * 16 * 4);
  p.lam = (float*)take(256);
  if (off > ws_size) fprintf(stderr, "workspace too small: need %zu have %zu\n", off, ws_size);
  void* args[] = {&p};
  hipError_t e = hipLaunchCooperativeKernel((void*)fwd_megakernel, dim3(grid_blocks), dim3(512), args, 0, stream);
  if (e != hipSuccess) fprintf(stderr, "cooperative launch failed: %s (grid %d)\n", hipGetErrorString(e), grid_blocks);
}
```

```cpp
#include <hip/hip_runtime.h>
#include <hip/hip_cooperative_groups.h>
#include <cstdio>
namespace cg = cooperative_groups;
#ifndef PROBE_B
#define PROBE_B 1
#endif
#ifndef PROBE_AC
#define PROBE_AC 1
#endif
#ifndef PROBE_P1
#define PROBE_P1 1
#endif
#ifndef PROBE_SYNC
#define PROBE_SYNC 1
#endif

#define LAS __attribute__((address_space(3)))
typedef unsigned short bf16_t;
typedef short bf16x8 __attribute__((ext_vector_type(8)));
typedef short bf16x4 __attribute__((ext_vector_type(4)));
typedef float f32x4 __attribute__((ext_vector_type(4)));
typedef float f32x16 __attribute__((ext_vector_type(16)));
typedef unsigned u32x4 __attribute__((ext_vector_type(4)));
typedef unsigned u32x2 __attribute__((ext_vector_type(2)));

constexpr int DM = 1024, DEPTH = 4, INW = 9728, UW = 7936, VW = 1792, YW = 1280;
constexpr int TC = 16384, NCHUNK = 4, NTOK = 65536;
constexpr float LOG2E = 1.4426950408889634f;
constexpr float QSCALE = 0.125f * LOG2E;
constexpr int U_QA = 0, U_KA = 512, U_ZA = 1024, U_QB = 1536, U_KB = 2048, U_ZB = 2560, U_QC = 3072, U_KC = 3840, U_ZC = 4608, U_GL = 4864;
constexpr int V_A = 0, V_B = 512, V_C = 1024;

struct Params {
  const float *xp, *xs, *g_norm, *w_in, *b_gate, *rpb, *lam_qk, *g_diff, *w_br_a, *w_br_b, *w_br_c, *w_out, *g_final;
  float* out;
  bf16_t *wt_in, *wt_br, *wt_out, *xb, *u, *vt, *yg, *oc, *merged;
  float *lse, *ssq, *lam;
};

__device__ __forceinline__ unsigned cvt_pk_bf16(float lo, float hi) { unsigned r; asm volatile("v_cvt_pk_bf16_f32 %0, %1, %2" : "=v"(r) : "v"(lo), "v"(hi)); return r; }
__device__ __forceinline__ float bf_lo(unsigned v) { return __uint_as_float(v << 16); }
__device__ __forceinline__ float bf_hi(unsigned v) { return __uint_as_float(v & 0xffff0000u); }
__device__ __forceinline__ float fexp2(float x) { return __builtin_amdgcn_exp2f(x); }
__device__ __forceinline__ float frcp(float x) { return __builtin_amdgcn_rcpf(x); }

__device__ __forceinline__ int opaque_tid() { int t = threadIdx.x; asm volatile("" : "+v"(t)); return t; }

namespace pg8 {
constexpr int BM = 256, BK = 64, HALF = 128, HTB = HALF * BK * 2, STAGE_BYTES = 8 * HTB, NXCD = 8, WGM = 8;
__device__ __forceinline__ int lds_byte(int r, int c) { const int st = (r >> 4) * 2 + (c >> 5), rr = r & 15, cc = c & 31, ob = rr * 64 + cc * 2; return st * 1024 + (ob ^ (((ob >> 9) & 1) << 5)); }
__device__ __forceinline__ void stage_rc(int b, int& R, int& C) { const int st = b / 1024, sb = b % 1024, swz = sb ^ (((sb >> 9) & 1) << 5); R = (st >> 1) * 16 + swz / 64; C = (st & 1) * 32 + (swz % 64) / 2; }
__device__ __forceinline__ int perm32(int rho) { const int n = rho >> 4, i = rho & 15; return 8 * (i >> 2) + 4 * n + (i & 3); }
struct Unit { int pm, pn; };
struct Gemm { const bf16_t* A; const bf16_t* Bt; int M, N, K; };
struct StaticOrder {
  int nM, nN, nwg, G, c;
  __device__ void init(int M, int N, int G_, int c_) { nM = M / BM; nN = N / BM; nwg = nM * nN; G = G_; c = c_; }
  __device__ bool next(int i, Unit& u) const {
    const long L = (long)i * G + c; if (L >= nwg) return false;
    int wgid = (int)L; { const int q = nwg / NXCD, r = nwg % NXCD, xcd = wgid % NXCD, off = wgid / NXCD; wgid = (xcd < r ? xcd * (q + 1) : r * (q + 1) + (xcd - r) * q) + off; }
    const int nig = WGM * nN, gid = wgid / nig, fm = gid * WGM, gsz = (nM - fm) < WGM ? (nM - fm) : WGM;
    u.pm = fm + ((wgid % nig) % gsz); u.pn = (wgid % nig) / gsz; return true;
  }
};

template <class Epi>
__device__ __forceinline__ void gemm_phase(LAS unsigned char* lds, const Gemm g, const StaticOrder& S, const Epi& E) {
  int tid_ = threadIdx.x; asm volatile("" : "+v"(tid_));
  const int tid = tid_, wid = __builtin_amdgcn_readfirstlane(tid >> 6), lane = tid & 63, wr = wid >> 2, wc = wid & 3, fr = lane & 15, fq = lane >> 4;
  const int K = g.K, nt = K / BK;
  unsigned voffA[2], voffB[2];
#pragma unroll
  for (int i = 0; i < 2; ++i) { int R, C; stage_rc(tid * 16 + i * 8192, R, C); const int Rb = (R & ~31) + perm32(R & 31);
    voffA[i] = (unsigned)(R * K + C) * 2u; voffB[i] = (unsigned)(Rb * K + C) * 2u; }
  const size_t kstep = (size_t)(BK * 2);
  const size_t hstep = (size_t)HALF * K * 2;
  const size_t tstep = 2 * hstep;
  const unsigned ldsw = (unsigned)wid * 1024u;
  const int aoff = lds_byte(wr * 64 + fr, fq * 8), boff = lds_byte(wc * 32 + fr, fq * 8);
#define PG8_SA(b, h) (((b) * 2 + (h)) * HTB)
#define PG8_SB(b, h) ((4 + (b) * 2 + (h)) * HTB)
#define PG8_STAGE(bufoff, gbase, voff) do { _Pragma("unroll") for (int _i = 0; _i < 2; ++_i) \
    __builtin_amdgcn_global_load_lds((const unsigned*)((const char*)(gbase) + (voff)[_i]), (LAS unsigned*)(lds + (bufoff) + ldsw + _i * 8192), 16, 0, 0); } while (0)
#define PG8_LDA(dst, b, h) do { _Pragma("unroll") for (int m = 0; m < 4; ++m) _Pragma("unroll") for (int k = 0; k < 2; ++k) dst[m][k] = *(const LAS bf16x8*)(lds + PG8_SA(b, h) + aoff + m * 2048 + k * 1024); } while (0)
#define PG8_LDB(dst, b, h) do { _Pragma("unroll") for (int n = 0; n < 2; ++n) _Pragma("unroll") for (int k = 0; k < 2; ++k) dst[n][k] = *(const LAS bf16x8*)(lds + PG8_SB(b, h) + boff + n * 2048 + k * 1024); } while (0)
#define PG8_MMA(ai, bj, At, Bt) do { __builtin_amdgcn_s_setprio(1); _Pragma("unroll") for (int m = 0; m < 4; ++m) _Pragma("unroll") for (int n = 0; n < 2; ++n) _Pragma("unroll") for (int k = 0; k < 2; ++k) \
    acc[ai][bj][m][n] = __builtin_amdgcn_mfma_f32_16x16x32_bf16(Bt[n][k], At[m][k], acc[ai][bj][m][n], 0, 0, 0); __builtin_amdgcn_s_setprio(0); } while (0)
#define PG8_WAIT_V(n) asm volatile("s_waitcnt vmcnt(" #n ")" ::: "memory")
#define PG8_WAIT_L(n) asm volatile("s_waitcnt lgkmcnt(" #n ")" ::: "memory")
#define PG8_BAR __builtin_amdgcn_s_barrier()
#define PG8_SCHED __builtin_amdgcn_sched_barrier(0)
  Unit cur, nxt; int ui = 0;
  if (!S.next(0, cur)) return;
  f32x4 acc[2][2][4][2];
#pragma unroll
  for (int a = 0; a < 2; ++a)
#pragma unroll
    for (int b = 0; b < 2; ++b)
#pragma unroll
      for (int m = 0; m < 4; ++m)
#pragma unroll
        for (int n = 0; n < 2; ++n) acc[a][b][m][n] = (f32x4){0.f, 0.f, 0.f, 0.f};
  bf16x8 At[4][2], B0[2][2], B1[2][2];
  const char* cA = (const char*)g.A + (size_t)cur.pm * tstep; const char* cB = (const char*)g.Bt + (size_t)cur.pn * tstep;
  PG8_STAGE(PG8_SB(0, 0), cB, voffB); PG8_STAGE(PG8_SA(0, 0), cA, voffA); PG8_STAGE(PG8_SB(0, 1), cB + hstep, voffB); PG8_STAGE(PG8_SA(0, 1), cA + hstep, voffA);
  if (wr == 1) PG8_BAR;
  PG8_WAIT_V(4); PG8_BAR;
  PG8_STAGE(PG8_SB(1, 0), cB + kstep, voffB); PG8_STAGE(PG8_SA(1, 0), cA + kstep, voffA); PG8_STAGE(PG8_SB(1, 1), cB + hstep + kstep, voffB);
  PG8_WAIT_V(6); PG8_BAR;
  for (;;) {
    const bool has_next = S.next(ui + 1, nxt);
    const char* nA = has_next ? (const char*)g.A + (size_t)nxt.pm * tstep : cA; const char* nB = has_next ? (const char*)g.Bt + (size_t)nxt.pn * tstep : cB;
    for (int t = 0; t < nt; t += 2) {
      if constexpr (Epi::HOOK) { if (t == 8 || t == 16) E.hook(acc, cur, t, wr, wc, fr, fq); }
      const bool last = (t == nt - 2);
      const char* a1 = cA + (size_t)(t + 1) * kstep;
      const char* a2 = last ? nA : cA + (size_t)(t + 2) * kstep; const char* b2 = last ? nB : cB + (size_t)(t + 2) * kstep;
      const char* a3 = a2 + kstep; const char* b3 = b2 + kstep;
      PG8_LDB(B0, 0, 0); PG8_SCHED; PG8_LDA(At, 0, 0); PG8_STAGE(PG8_SA(1, 1), a1 + hstep, voffA);
      PG8_WAIT_L(8); PG8_BAR; PG8_WAIT_L(0); PG8_MMA(0, 0, At, B0); PG8_BAR; PG8_SCHED;
      PG8_LDB(B1, 0, 1); PG8_STAGE(PG8_SB(0, 0), b2, voffB);
      PG8_BAR; PG8_WAIT_L(0); PG8_MMA(0, 1, At, B1); PG8_BAR;
      PG8_LDA(At, 0, 1); PG8_STAGE(PG8_SA(0, 0), a2, voffA);
      PG8_BAR; PG8_WAIT_L(0); PG8_MMA(1, 0, At, B0); PG8_BAR; PG8_SCHED;
      PG8_STAGE(PG8_SB(0, 1), b2 + hstep, voffB);
      PG8_WAIT_V(6); PG8_BAR; PG8_MMA(1, 1, At, B1); PG8_BAR;
      PG8_LDB(B0, 1, 0); PG8_SCHED; PG8_LDA(At, 1, 0); PG8_STAGE(PG8_SA(0, 1), a2 + hstep, voffA);
      PG8_WAIT_L(8); PG8_BAR; PG8_WAIT_L(0); PG8_MMA(0, 0, At, B0); PG8_BAR; PG8_SCHED;
      PG8_LDB(B1, 1, 1); PG8_STAGE(PG8_SB(1, 0), b3, voffB);
      PG8_BAR; PG8_WAIT_L(0); PG8_MMA(0, 1, At, B1); PG8_BAR;
      PG8_LDA(At, 1, 1); PG8_STAGE(PG8_SA(1, 0), a3, voffA);
      PG8_BAR; PG8_WAIT_L(0); PG8_MMA(1, 0, At, B0); PG8_BAR; PG8_SCHED;
      PG8_STAGE(PG8_SB(1, 1), b3 + hstep, voffB);
      PG8_WAIT_V(6); PG8_BAR; PG8_MMA(1, 1, At, B1); PG8_BAR;
    }
    E(acc, cur, wr, wc, fr, fq);
    if (!has_next) break;
#pragma unroll
    for (int a = 0; a < 2; ++a)
#pragma unroll
      for (int b = 0; b < 2; ++b)
#pragma unroll
        for (int m = 0; m < 4; ++m)
#pragma unroll
          for (int n = 0; n < 2; ++n) acc[a][b][m][n] = (f32x4){0.f, 0.f, 0.f, 0.f};
    cur = nxt; cA = nA; cB = nB; ++ui;
  }
  PG8_WAIT_V(0);
  if (wr == 0) PG8_BAR;
  PG8_BAR;
#undef PG8_SA
#undef PG8_SB
#undef PG8_STAGE
#undef PG8_LDA
#undef PG8_LDB
#undef PG8_MMA
#undef PG8_WAIT_V
#undef PG8_WAIT_L
#undef PG8_BAR
#undef PG8_SCHED
}
}
using pg8::Unit;

struct EpiU {
  static constexpr bool HOOK = false;
  bf16_t* U; bf16_t* VT; const float* ssq; const float* bg; int L, lshift;
  __device__ __forceinline__ void hook(f32x4 (&)[2][2][4][2], const Unit&, int, int, int, int, int) const {}
  __device__ __forceinline__ void operator()(const f32x4 (&acc)[2][2][4][2], const Unit& u, int wr, int wc, int fr, int fq) const {
    asm volatile("" : "+v"(fr), "+v"(fq));
    const int row0 = u.pm * 256 + wr * 64 + fr, col0 = u.pn * 256 + wc * 32 + 8 * fq;
    const bool isv = u.pn >= 31, isg = (u.pn >= 19) && !isv;
    const int g = u.pn - 35; const int ds = g <= 0 ? 0 : (g == 1 ? 2 : 4);
#pragma unroll
    for (int ai = 0; ai < 2; ++ai)
#pragma unroll
      for (int m = 0; m < 4; ++m) {
        const int row = row0 + ai * 128 + m * 16;
        const f32x4* sp = (const f32x4*)(ssq + (size_t)row * 16);
        const f32x4 a4 = sp[0] + sp[1] + sp[2] + sp[3];
        const float rinv = rsqrtf((a4[0] + a4[1] + a4[2] + a4[3]) * (1.0f / 1024.0f) + 1e-6f);
        if (isg) {
#pragma unroll
          for (int bj = 0; bj < 2; ++bj) {
            const float* bp = bg + (col0 - U_GL) + bj * 128;
            const f32x4 b0 = *(const f32x4*)bp, b1 = *(const f32x4*)(bp + 4);
            f32x4 v0 = acc[ai][bj][m][0] * rinv + b0, v1 = acc[ai][bj][m][1] * rinv + b1;
#pragma unroll
            for (int j = 0; j < 4; ++j) { v0[j] = 1.0f + fminf(fexp2(-v0[j] * LOG2E), 1e30f); v1[j] = 1.0f + fminf(fexp2(-v1[j] * LOG2E), 1e30f); }
            u32x4 pk = {cvt_pk_bf16(v0[0], v0[1]), cvt_pk_bf16(v0[2], v0[3]), cvt_pk_bf16(v1[0], v1[1]), cvt_pk_bf16(v1[2], v1[3])};
            *(u32x4*)(U + (size_t)row * UW + col0 + bj * 128) = pk;
          }
        } else if (!isv) {
#pragma unroll
          for (int bj = 0; bj < 2; ++bj) {
            const f32x4 v0 = acc[ai][bj][m][0] * rinv, v1 = acc[ai][bj][m][1] * rinv;
            u32x4 pk = {cvt_pk_bf16(v0[0], v0[1]), cvt_pk_bf16(v0[2], v0[3]), cvt_pk_bf16(v1[0], v1[1]), cvt_pk_bf16(v1[2], v1[3])};
            *(u32x4*)(U + (size_t)row * UW + col0 + bj * 128) = pk;
          }
        } else {
          const int seq = row >> lshift, pos = row & (L - 1);
          const int pp = ((pos & ((1 << ds) - 1)) << (lshift - ds)) + (pos >> ds);
          bf16_t* vb = VT + ((size_t)seq * VW + (col0 - UW)) * L + pp;
#pragma unroll
          for (int bj = 0; bj < 2; ++bj)
#pragma unroll
            for (int n = 0; n < 2; ++n) {
              const f32x4 v = acc[ai][bj][m][n] * rinv;
              const unsigned p0 = cvt_pk_bf16(v[0], v[1]), p1 = cvt_pk_bf16(v[2], v[3]);
              bf16_t* vp = vb + (size_t)(bj * 128 + 4 * n) * L;
              vp[0] = (bf16_t)(p0 & 0xffffu); vp[(size_t)L] = (bf16_t)(p0 >> 16); vp[(size_t)2 * L] = (bf16_t)(p1 & 0xffffu); vp[(size_t)3 * L] = (bf16_t)(p1 >> 16);
            }
        }
      }
  }
};

struct EpiMerge {
  static constexpr bool HOOK = true;
  const bf16_t* U; bf16_t* MG;
  __device__ __forceinline__ f32x4 gvec(int i, size_t row, int col) const {
    const u32x2 raw = *(const u32x2*)(U + row * UW + U_GL + i * 1024 + col);
    f32x4 e; e[0] = bf_lo(raw[0]); e[1] = bf_hi(raw[0]); e[2] = bf_lo(raw[1]); e[3] = bf_hi(raw[1]); return e;
  }
  __device__ __forceinline__ void hook(f32x4 (&acc)[2][2][4][2], const Unit& u, int t, int wr, int wc, int fr, int fq) const {
    const int i = (t == 8) ? 0 : 1;
    asm volatile("" : "+v"(fr), "+v"(fq));
    const int row0 = u.pm * 256 + wr * 64 + fr, col0 = u.pn * 256 + wc * 32 + 8 * fq;
#pragma unroll
    for (int ai = 0; ai < 2; ++ai)
#pragma unroll
      for (int m = 0; m < 4; ++m) {
#pragma unroll
        for (int bj = 0; bj < 2; ++bj)
#pragma unroll
          for (int n = 0; n < 2; ++n) {
            const size_t row = (size_t)(row0 + ai * 128 + m * 16); const int col = col0 + bj * 128 + 4 * n;
            const f32x4 g0 = gvec(i, row, col), g1 = gvec(i + 1, row, col);
            f32x4 r;
#pragma unroll
            for (int j = 0; j < 4; ++j) r[j] = g1[j] * frcp(g0[j]);
            acc[ai][bj][m][n] *= r;
          }
        if (m & 1) __builtin_amdgcn_sched_barrier(0);
      }
  }
  __device__ __forceinline__ void operator()(const f32x4 (&acc)[2][2][4][2], const Unit& u, int wr, int wc, int fr, int fq) const {
    asm volatile("" : "+v"(fr), "+v"(fq));
    const int row0 = u.pm * 256 + wr * 64 + fr, col0 = u.pn * 256 + wc * 32 + 8 * fq;
#pragma unroll
    for (int ai = 0; ai < 2; ++ai)
#pragma unroll
      for (int m = 0; m < 4; ++m)
#pragma unroll
        for (int bj = 0; bj < 2; ++bj) {
          const size_t row = (size_t)(row0 + ai * 128 + m * 16); const int col = col0 + bj * 128;
          const f32x4 e0 = gvec(2, row, col), e1 = gvec(2, row, col + 4);
          f32x4 v0 = acc[ai][bj][m][0], v1 = acc[ai][bj][m][1];
#pragma unroll
          for (int j = 0; j < 4; ++j) { v0[j] *= frcp(e0[j]); v1[j] *= frcp(e1[j]); }
          u32x4 pk = {cvt_pk_bf16(v0[0], v0[1]), cvt_pk_bf16(v0[2], v0[3]), cvt_pk_bf16(v1[0], v1[1]), cvt_pk_bf16(v1[2], v1[3])};
          *(u32x4*)(MG + row * DM + col) = pk;
        }
  }
};

struct EpiRes {
  static constexpr bool HOOK = false;
  const float* R; float* X; bf16_t* XB; float* ssq;
  __device__ __forceinline__ void hook(f32x4 (&)[2][2][4][2], const Unit&, int, int, int, int, int) const {}
  __device__ __forceinline__ void operator()(const f32x4 (&acc)[2][2][4][2], const Unit& u, int wr, int wc, int fr, int fq) const {
    asm volatile("" : "+v"(fr), "+v"(fq));
    const int row0 = u.pm * 256 + wr * 64 + fr, col0 = u.pn * 256 + wc * 32 + 8 * fq;
#pragma unroll
    for (int ai = 0; ai < 2; ++ai)
#pragma unroll
      for (int m = 0; m < 4; ++m) {
        const size_t row = (size_t)(row0 + ai * 128 + m * 16);
        float s = 0.f;
#pragma unroll
        for (int bj = 0; bj < 2; ++bj) {
          const int col = col0 + bj * 128;
          const f32x4 r0 = *(const f32x4*)(R + row * DM + col), r1 = *(const f32x4*)(R + row * DM + col + 4);
          const f32x4 v0 = r0 + acc[ai][bj][m][0], v1 = r1 + acc[ai][bj][m][1];
          *(f32x4*)(X + row * DM + col) = v0; *(f32x4*)(X + row * DM + col + 4) = v1;
          s += v0[0] * v0[0] + v0[1] * v0[1] + v0[2] * v0[2] + v0[3] * v0[3] + v1[0] * v1[0] + v1[1] * v1[1] + v1[2] * v1[2] + v1[3] * v1[3];
          u32x4 pk = {cvt_pk_bf16(v0[0], v0[1]), cvt_pk_bf16(v0[2], v0[3]), cvt_pk_bf16(v1[0], v1[1]), cvt_pk_bf16(v1[2], v1[3])};
          *(u32x4*)(XB + row * DM + col) = pk;
        }
        s += __shfl_xor(s, 16); s += __shfl_xor(s, 32);
        if (fq == 0) ssq[row * 16 + u.pn * 4 + wc] = s;
      }
  }
};

__device__ __forceinline__ void prep_tile(const float* src, int ldn, int k0, int n0, const float* rscale, float cscale, bf16_t* dst, int ldd, int drow0, int dk0, LAS float* tile) {
  const int tid = opaque_tid(), kk = tid >> 6, nn = tid & 63;
#pragma unroll
  for (int i = 0; i < 8; ++i) {
    const int k = kk * 8 + i;
    float v = src[(size_t)(k0 + k) * ldn + n0 + nn] * cscale;
    if (rscale) v *= rscale[k0 + k];
    tile[k * 65 + nn] = v;
  }
  __syncthreads();
  const int n = tid >> 3, kc = tid & 7;
  float f[8];
#pragma unroll
  for (int j = 0; j < 8; ++j) f[j] = tile[(kc * 8 + j) * 65 + n];
  u32x4 pk = {cvt_pk_bf16(f[0], f[1]), cvt_pk_bf16(f[2], f[3]), cvt_pk_bf16(f[4], f[5]), cvt_pk_bf16(f[6], f[7])};
  *(u32x4*)(dst + (size_t)(drow0 + n) * ldd + dk0 + kc * 8) = pk;
  __syncthreads();
}

__device__ __forceinline__ void win_map(int n0, int& dn0, float& sc) {
  sc = 1.0f;
  if (n0 < 512) { dn0 = U_QA + n0; sc = QSCALE; }
  else if (n0 < 1024) dn0 = U_KA + (n0 - 512);
  else if (n0 < 1536) dn0 = UW + V_A + (n0 - 1024);
  else if (n0 < 2048) dn0 = U_ZA + (n0 - 1536);
  else if (n0 < 2560) { dn0 = U_QB + (n0 - 2048); sc = QSCALE; }
  else if (n0 < 3072) dn0 = U_KB + (n0 - 2560);
  else if (n0 < 3584) dn0 = UW + V_B + (n0 - 3072);
  else if (n0 < 4096) dn0 = U_ZB + (n0 - 3584);
  else if (n0 < 4864) { dn0 = U_QC + (n0 - 4096); sc = QSCALE; }
  else if (n0 < 5632) dn0 = U_KC + (n0 - 4864);
  else if (n0 < 6400) dn0 = UW + V_C + (n0 - 5632);
  else if (n0 < 6656) dn0 = U_ZC + (n0 - 6400);
  else dn0 = U_GL + (n0 - 6656);
}

__device__ void phase_prep(const Params& p, LAS float* tile) {
  constexpr int PER = 3008;
  for (int it = blockIdx.x; it < DEPTH * PER; it += gridDim.x) {
    const int l = it / PER; int r = it % PER;
    if (r < 2432) {
      const int kt = r / 152, ntile = r % 152; int dn0; float sc; win_map(ntile * 64, dn0, sc);
      prep_tile(p.w_in + (size_t)l * DM * INW, INW, kt * 64, ntile * 64, p.g_norm + l * DM, sc, p.wt_in + (size_t)l * INW * DM, DM, dn0, kt * 64, tile);
    } else if ((r -= 2432) < 128) {
      const int kt = r / 16, ntile = r % 16;
      prep_tile(p.w_br_a + (size_t)l * 512 * DM, DM, kt * 64, ntile * 64, nullptr, 1.0f, p.wt_br + (size_t)l * DM * YW, YW, ntile * 64, kt * 64, tile);
    } else if ((r -= 128) < 128) {
      const int kt = r / 16, ntile = r % 16;
      prep_tile(p.w_br_b + (size_t)l * 512 * DM, DM, kt * 64, ntile * 64, nullptr, 1.0f, p.wt_br + (size_t)l * DM * YW, YW, ntile * 64, 512 + kt * 64, tile);
    } else if ((r -= 128) < 64) {
      const int kt = r / 16, ntile = r % 16;
      prep_tile(p.w_br_c + (size_t)l * 256 * DM, DM, kt * 64, ntile * 64, nullptr, 1.0f, p.wt_br + (size_t)l * DM * YW, YW, ntile * 64, 1024 + kt * 64, tile);
    } else {
      r -= 64; const int kt = r / 16, ntile = r % 16;
      prep_tile(p.w_out + (size_t)l * DM * DM, DM, kt * 64, ntile * 64, nullptr, 1.0f, p.wt_out + (size_t)l * DM * DM, DM, ntile * 64, kt * 64, tile);
    }
  }
  if (blockIdx.x == 0 && threadIdx.x < 64) {
    const int lane = threadIdx.x;
    for (int l = 0; l < DEPTH; ++l) {
      const float* lq = p.lam_qk + l * 256;
      float a = lq[lane] * lq[64 + lane], b = lq[128 + lane] * lq[192 + lane];
      for (int o = 32; o >= 1; o >>= 1) { a += __shfl_xor(a, o); b += __shfl_xor(b, o); }
      if (lane == 0) p.lam[l] = expf(a) - expf(b) + (0.8f - 0.6f * expf(-0.3f * (float)l));
    }
  }
}

__device__ void phase_x(const Params& p, int chunk) {
  const float* xin = (chunk < 2) ? p.xp + (size_t)chunk * TC * DM : p.xs + (size_t)(chunk - 2) * TC * DM;
  float* ssq = p.ssq + (size_t)chunk * TC * 16;
  const int tid = opaque_tid(), lane = tid & 63, w = blockIdx.x * 8 + (tid >> 6), nw = gridDim.x * 8;
  for (int row = w; row < TC; row += nw) {
    const float* xr = xin + (size_t)row * DM + lane * 16;
    f32x4 v[4]; float s = 0.f;
#pragma unroll
    for (int i = 0; i < 4; ++i) { v[i] = *(const f32x4*)(xr + i * 4); s += v[i][0] * v[i][0] + v[i][1] * v[i][1] + v[i][2] * v[i][2] + v[i][3] * v[i][3]; }
    for (int o = 32; o >= 1; o >>= 1) s += __shfl_xor(s, o);
    u32x4 p0 = {cvt_pk_bf16(v[0][0], v[0][1]), cvt_pk_bf16(v[0][2], v[0][3]), cvt_pk_bf16(v[1][0], v[1][1]), cvt_pk_bf16(v[1][2], v[1][3])};
    u32x4 p1 = {cvt_pk_bf16(v[2][0], v[2][1]), cvt_pk_bf16(v[2][2], v[2][3]), cvt_pk_bf16(v[3][0], v[3][1]), cvt_pk_bf16(v[3][2], v[3][3])};
    bf16_t* xo = p.xb + (size_t)row * DM + lane * 16;
    *(u32x4*)xo = p0; *(u32x4*)(xo + 8) = p1;
    if (lane < 16) ssq[(size_t)row * 16 + lane] = (lane == 0) ? s : 0.f;
  }
}

__device__ void phase_final(const Params& p, int chunk) {
  float* x = p.out + (size_t)chunk * TC * DM;
  const float* ssq = p.ssq + (size_t)chunk * TC * 16;
  const int tid = opaque_tid(), lane = tid & 63, w = blockIdx.x * 8 + (tid >> 6), nw = gridDim.x * 8;
  for (int row = w; row < TC; row += nw) {
    const f32x4* sp = (const f32x4*)(ssq + (size_t)row * 16);
    const f32x4 a4 = sp[0] + sp[1] + sp[2] + sp[3];
    const float rinv = rsqrtf((a4[0] + a4[1] + a4[2] + a4[3]) * (1.0f / 1024.0f) + 1e-6f);
    float* xr = x + (size_t)row * DM + lane * 16;
#pragma unroll
    for (int i = 0; i < 4; ++i) { f32x4 v = *(const f32x4*)(xr + i * 4); const f32x4 g = *(const f32x4*)(p.g_final + lane * 16 + i * 4); v = v * rinv * g; *(f32x4*)(xr + i * 4) = v; }
  }
}

__device__ __forceinline__ f32x16 mfma32(bf16x8 a, bf16x8 b, f32x16 c) { return __builtin_amdgcn_mfma_f32_32x32x16_bf16(a, b, c, 0, 0, 0); }
__device__ __forceinline__ bf16x8 ld16(const bf16_t* p) { return *(const bf16x8*)p; }
__device__ __forceinline__ bf16x8 ld8x2(const bf16_t* p0, const bf16_t* p1) { const bf16x4 a = *(const bf16x4*)p0, b = *(const bf16x4*)p1; return __builtin_shufflevector(a, b, 0, 1, 2, 3, 4, 5, 6, 7); }

__device__ __forceinline__ void softmax_tile(f32x16& t, float& m, float& l, float& alpha, bf16x8& p0, bf16x8& p1) {
  float tm = t[0];
#pragma unroll
  for (int i = 1; i < 16; ++i) tm = fmaxf(tm, t[i]);
  tm = fmaxf(tm, __shfl_xor(tm, 32));
  const float mn = fmaxf(m, tm);
  alpha = fexp2(m - mn); m = mn;
  float ls = 0.f;
#pragma unroll
  for (int i = 0; i < 16; ++i) { t[i] = fexp2(t[i] - mn); ls += t[i]; }
  l = l * alpha + ls;
  const u32x4 a = {cvt_pk_bf16(t[0], t[1]), cvt_pk_bf16(t[2], t[3]), cvt_pk_bf16(t[4], t[5]), cvt_pk_bf16(t[6], t[7])};
  const u32x4 b = {cvt_pk_bf16(t[8], t[9]), cvt_pk_bf16(t[10], t[11]), cvt_pk_bf16(t[12], t[13]), cvt_pk_bf16(t[14], t[15])};
  p0 = __builtin_bit_cast(bf16x8, a); p1 = __builtin_bit_cast(bf16x8, b);
}
__device__ __forceinline__ f32x16 zero16() { f32x16 z;
#pragma unroll
  for (int i = 0; i < 16; ++i) z[i] = 0.f; return z; }
__device__ __forceinline__ float silu(float z) { return z * frcp(1.0f + fexp2(-z * LOG2E)); }

constexpr int TB_ROW = 144;
constexpr int KB_BYTES = 64 * TB_ROW;
constexpr int VB_BYTES = 128 * TB_ROW;
constexpr int LDS_K = 0, LDS_V = LDS_K + 2 * KB_BYTES, LDS_ATT_END = LDS_V + 2 * VB_BYTES, LDS_ATT_TOTAL = LDS_ATT_END + 65536;
__device__ __forceinline__ void attn_b_pass(const Params& p, int L, int seq, int h, int mp, int tq, int tid, float slope2, LAS unsigned char* lds, f32x16 (&o)[4], float& linv) {
  const int lane = tid & 63, q = lane & 31, half = lane >> 5;
  const size_t tokbase = (size_t)seq * L;
  bf16x8 qf[4];
  { const bf16_t* qp = p.u + (tokbase + tq) * UW + U_QB + h * 128 + mp * 64 + half * 8;
#pragma unroll
    for (int ks = 0; ks < 4; ++ks) qf[ks] = ld16(qp + ks * 16); }
  const int spart = tid & 7, srow = tid >> 3;
  const bf16_t* kg = p.u + (tokbase + srow) * UW + U_KB + h * 128 + mp * 64 + spart * 8;
  const bf16_t* vg = p.vt + ((size_t)seq * VW + V_B + h * 128 + srow) * L + spart * 8;
  const int kst = srow * TB_ROW + spart * 16;
  const int vst = srow * TB_ROW + ((spart >> 1) * 16 + (spart & 1) * 4) * 2;
  const int rd = q * TB_ROW + half * 16;
#pragma unroll
  for (int dt = 0; dt < 4; ++dt) o[dt] = zero16();
  float mrun = -1e30f, lrun = 0.f;
  bf16x8 kr, vr0, vr1;
  kr = ld16(kg); vr0 = ld16(vg); vr1 = ld16(vg + (size_t)64 * L);
  {
    LAS unsigned char* kb = lds + LDS_K; LAS unsigned char* vb = lds + LDS_V;
    *(LAS bf16x8*)(kb + kst) = kr;
    *(LAS bf16x4*)(vb + vst) = __builtin_shufflevector(vr0, vr0, 0, 1, 2, 3); *(LAS bf16x4*)(vb + vst + 16) = __builtin_shufflevector(vr0, vr0, 4, 5, 6, 7);
    *(LAS bf16x4*)(vb + vst + 64 * TB_ROW) = __builtin_shufflevector(vr1, vr1, 0, 1, 2, 3); *(LAS bf16x4*)(vb + vst + 64 * TB_ROW + 16) = __builtin_shufflevector(vr1, vr1, 4, 5, 6, 7);
  }
  __syncthreads();
  const int ntile = L >> 6;
#pragma unroll 1
  for (int t = 0; t < ntile; ++t) {
    const int k0 = t * 64;
    const bool more = (t + 1 < ntile);
    if (more) { kr = ld16(kg + (size_t)(k0 + 64) * UW); const bf16_t* vgn = vg + (k0 + 64); vr0 = ld16(vgn); vr1 = ld16(vgn + (size_t)64 * L); }
    const LAS unsigned char* kb = lds + LDS_K + (t & 1) * KB_BYTES;
    const LAS unsigned char* vb = lds + LDS_V + (t & 1) * VB_BYTES;
#pragma unroll
    for (int sub = 0; sub < 2; ++sub) {
      f32x16 sc = zero16();
#pragma unroll
      for (int ks = 0; ks < 4; ++ks) sc = mfma32(*(const LAS bf16x8*)(kb + rd + sub * 32 * TB_ROW + ks * 32), qf[ks], sc);
      const float d0 = (float)(k0 + sub * 32 + half * 4 - tq);
#pragma unroll
      for (int i = 0; i < 16; ++i) sc[i] -= slope2 * fabsf(d0 + (float)((i >> 2) * 8 + (i & 3)));
      float al; bf16x8 pk[2];
      softmax_tile(sc, mrun, lrun, al, pk[0], pk[1]);
      if (__builtin_amdgcn_ballot_w64(al != 1.0f) != 0) {
#pragma unroll
        for (int dt = 0; dt < 4; ++dt) o[dt] *= al;
      }
#pragma unroll
      for (int dt = 0; dt < 4; ++dt)
#pragma unroll
        for (int s2 = 0; s2 < 2; ++s2) o[dt] = mfma32(*(const LAS bf16x8*)(vb + rd + dt * 32 * TB_ROW + (sub * 2 + s2) * 32), pk[s2], o[dt]);
    }
    if (more) {
      LAS unsigned char* kbn = lds + LDS_K + ((t + 1) & 1) * KB_BYTES; LAS unsigned char* vbn = lds + LDS_V + ((t + 1) & 1) * VB_BYTES;
      *(LAS bf16x8*)(kbn + kst) = kr;
      *(LAS bf16x4*)(vbn + vst) = __builtin_shufflevector(vr0, vr0, 0, 1, 2, 3); *(LAS bf16x4*)(vbn + vst + 16) = __builtin_shufflevector(vr0, vr0, 4, 5, 6, 7);
      *(LAS bf16x4*)(vbn + vst + 64 * TB_ROW) = __builtin_shufflevector(vr1, vr1, 0, 1, 2, 3); *(LAS bf16x4*)(vbn + vst + 64 * TB_ROW + 16) = __builtin_shufflevector(vr1, vr1, 4, 5, 6, 7);
    }
    __syncthreads();
  }
  linv = frcp(lrun + __shfl_xor(lrun, 32));
}
__device__ void attn_b_block(const Params& p, int layer, int L, int seq, int h, int qblk, LAS unsigned char* lds) {
  const int tid = opaque_tid(), lane = tid & 63, wid = __builtin_amdgcn_readfirstlane(tid >> 6);
  const int q = lane & 31, half = lane >> 5;
  const size_t tokbase = (size_t)seq * L;
  const int tq = qblk * 256 + wid * 32 + q;
  const float slope2 = exp2f(-2.0f * (float)(h + 1)) * LOG2E;
  f32x16 o0[4]; float li0, li1;
  LAS u32x4* park = (LAS u32x4*)(lds + LDS_ATT_END) + wid * 512 + lane;
  attn_b_pass(p, L, seq, h, 0, tq, tid, slope2, lds, o0, li0);
#pragma unroll
  for (int dt = 0; dt < 4; ++dt)
#pragma unroll
    for (int g2 = 0; g2 < 2; ++g2) {
      u32x4 pk;
#pragma unroll
      for (int k = 0; k < 4; ++k) pk[k] = cvt_pk_bf16(o0[dt][g2 * 8 + 2 * k] * li0, o0[dt][g2 * 8 + 2 * k + 1] * li0);
      park[(dt * 2 + g2) * 64] = pk;
    }
  attn_b_pass(p, L, seq, h, 1, tq, tid, slope2, lds, o0, li1);
  const float c1 = p.lam[layer] * li1;
  float ss = 0.f;
#pragma unroll
  for (int dt = 0; dt < 4; ++dt)
#pragma unroll
    for (int g2 = 0; g2 < 2; ++g2) {
      const u32x4 pk = park[(dt * 2 + g2) * 64];
#pragma unroll
      for (int k = 0; k < 4; ++k) {
        const float va = bf_lo(pk[k]) - o0[dt][g2 * 8 + 2 * k] * c1, vb = bf_hi(pk[k]) - o0[dt][g2 * 8 + 2 * k + 1] * c1;
        o0[dt][g2 * 8 + 2 * k] = va; o0[dt][g2 * 8 + 2 * k + 1] = vb; ss += va * va + vb * vb;
      }
    }
  ss += __shfl_xor(ss, 32);
  const float rn = rsqrtf(ss * (1.0f / 128.0f) + 1e-6f) * (1.0f - (0.8f - 0.6f * expf(-0.3f * (float)layer)));
  const float* gd = p.g_diff + layer * 128;
  bf16_t* yrow = p.yg + (tokbase + tq) * YW + 512 + h * 128;
  const bf16_t* zrow = p.u + (tokbase + tq) * UW + U_ZB + h * 128;
#pragma unroll
  for (int dt = 0; dt < 4; ++dt)
#pragma unroll
    for (int g4 = 0; g4 < 4; ++g4) {
      const int dim = dt * 32 + g4 * 8 + half * 4;
      const u32x2 zr = *(const u32x2*)(zrow + dim);
      const f32x4 gv = *(const f32x4*)(gd + dim);
      const float y0 = o0[dt][g4 * 4 + 0] * rn * gv[0] * silu(bf_lo(zr[0]));
      const float y1 = o0[dt][g4 * 4 + 1] * rn * gv[1] * silu(bf_hi(zr[0]));
      const float y2 = o0[dt][g4 * 4 + 2] * rn * gv[2] * silu(bf_lo(zr[1]));
      const float y3 = o0[dt][g4 * 4 + 3] * rn * gv[3] * silu(bf_hi(zr[1]));
      u32x2 pk = {cvt_pk_bf16(y0, y1), cvt_pk_bf16(y2, y3)};
      *(u32x2*)(yrow + dim) = pk;
    }
}

__device__ void attn_a_unit(const Params& p, int layer, int L, int seq, int h, int r, int cb2, int lane) {
  const int q = lane & 31, half = lane >> 5;
  const size_t tokbase = (size_t)seq * L;
  const int rows = L >> 6;
  int rs = r - 4; rs = rs < 0 ? 0 : (rs > rows - 8 ? rows - 8 : rs);
  const int qcol = cb2 * 32 + q, tq = r * 64 + qcol;
  int qstart = qcol - 8; qstart = qstart < 0 ? 0 : (qstart > 48 ? 48 : qstart);
  const bf16_t* urow = p.u + (tokbase + tq) * UW;
  bf16x8 qf[4];
#pragma unroll
  for (int ks = 0; ks < 4; ++ks) qf[ks] = ld16(urow + U_QA + h * 64 + ks * 16 + half * 8);
  f32x16 o[2] = {zero16(), zero16()};
  float mrun = -1e30f, lrun = 0.f;
  const float* rpb = p.rpb + ((size_t)layer * 8 + h) * 15 * 31;
  const bf16_t* vbase = p.vt + ((size_t)seq * VW + V_A + h * 64 + q) * L;
  for (int i = 0; i < 8; ++i) {
    const int krow = rs + i;
    const float* rpr = rpb + (krow - r + 7) * 31;
#pragma unroll
    for (int seg = 0; seg < 2; ++seg) {
      const bf16_t* kp = p.u + (tokbase + krow * 64 + seg * 32 + q) * UW + U_KA + h * 64 + half * 8;
      f32x16 s = zero16();
#pragma unroll
      for (int ks = 0; ks < 4; ++ks) s = mfma32(ld16(kp + ks * 16), qf[ks], s);
#pragma unroll
      for (int ii = 0; ii < 16; ++ii) {
        const int kcol = seg * 32 + (ii >> 2) * 8 + half * 4 + (ii & 3);
        const bool ok = (kcol >= qstart) && (kcol < qstart + 16);
        int ci = kcol - qcol + 15; ci = ci < 0 ? 0 : (ci > 30 ? 30 : ci);
        s[ii] = ok ? s[ii] + rpr[ci] * LOG2E : -INFINITY;
      }
      float alpha; bf16x8 pk[2];
      softmax_tile(s, mrun, lrun, alpha, pk[0], pk[1]);
#pragma unroll
      for (int dt = 0; dt < 2; ++dt) {
        o[dt] *= alpha;
#pragma unroll
        for (int s2 = 0; s2 < 2; ++s2) {
          const bf16_t* vp = vbase + (size_t)(dt * 32) * L + krow * 64 + seg * 32 + s2 * 16 + half * 4;
          o[dt] = mfma32(ld8x2(vp, vp + 8), pk[s2], o[dt]);
        }
      }
    }
  }
  const float lt = lrun + __shfl_xor(lrun, 32);
  const float c = frcp(lt);
  bf16_t* yrow = p.yg + (tokbase + tq) * YW + h * 64;
  const bf16_t* zrow = urow + U_ZA + h * 64;
#pragma unroll
  for (int dt = 0; dt < 2; ++dt)
#pragma unroll
    for (int g4 = 0; g4 < 4; ++g4) {
      const int dim = dt * 32 + g4 * 8 + half * 4;
      const u32x2 zr = *(const u32x2*)(zrow + dim);
      const float y0 = o[dt][g4 * 4 + 0] * c * silu(bf_lo(zr[0]));
      const float y1 = o[dt][g4 * 4 + 1] * c * silu(bf_hi(zr[0]));
      const float y2 = o[dt][g4 * 4 + 2] * c * silu(bf_lo(zr[1]));
      const float y3 = o[dt][g4 * 4 + 3] * c * silu(bf_hi(zr[1]));
      u32x2 pk = {cvt_pk_bf16(y0, y1), cvt_pk_bf16(y2, y3)};
      *(u32x2*)(yrow + dim) = pk;
    }
}

__device__ void attn_c_unit(const Params& p, int L, int lshift, int seq, int g, int h, int rr, int mblk, int lane) {
  const int q = lane & 31, half = lane >> 5;
  const size_t tokbase = (size_t)seq * L;
  const int ds = (g == 0) ? 0 : (g == 1 ? 2 : 4), d = 1 << ds, M = L >> ds;
  const int hh = g * 4 + h;
  const int m0 = mblk * 32, mq = m0 + q, tq = mq * d + rr;
  const bf16_t* urow = p.u + (tokbase + tq) * UW;
  bf16x8 qf[4];
#pragma unroll
  for (int ks = 0; ks < 4; ++ks) qf[ks] = ld16(urow + U_QC + hh * 64 + ks * 16 + half * 8);
  f32x16 o[2] = {zero16(), zero16()};
  float mrun = -1e30f, lrun = 0.f;
  const float coef = exp2f(-(2.0f / 3.0f) * (float)(hh + 1)) * (float)d * LOG2E;
  const bf16_t* vbase = p.vt + ((size_t)seq * VW + V_C + hh * 64 + q) * L + (size_t)rr * M;
  for (int j = 0; j < 5; ++j) {
    const int mk0 = m0 - 64 + 32 * j;
    if (mk0 + 32 <= 0 || mk0 >= M) continue;
    int mkl = mk0 + q; mkl = mkl < 0 ? 0 : (mkl > M - 1 ? M - 1 : mkl);
    const bf16_t* kp = p.u + (tokbase + (size_t)mkl * d + rr) * UW + U_KC + hh * 64 + half * 8;
    f32x16 s = zero16();
#pragma unroll
    for (int ks = 0; ks < 4; ++ks) s = mfma32(ld16(kp + ks * 16), qf[ks], s);
#pragma unroll
    for (int ii = 0; ii < 16; ++ii) {
      const int mk = mk0 + (ii >> 2) * 8 + half * 4 + (ii & 3);
      const int rel = mk - mq; const int ar = rel < 0 ? -rel : rel;
      const bool ok = (mk >= 0) && (mk < M) && (ar <= 64);
      s[ii] = ok ? s[ii] - coef * (float)ar : -INFINITY;
    }
    float alpha; bf16x8 pk[2];
    softmax_tile(s, mrun, lrun, alpha, pk[0], pk[1]);
#pragma unroll
    for (int dt = 0; dt < 2; ++dt) {
      o[dt] *= alpha;
#pragma unroll
      for (int s2 = 0; s2 < 2; ++s2) {
        int pa = mk0 + s2 * 16 + half * 4, pb = pa + 8;
        pa = pa < 0 ? 0 : (pa > M - 4 ? M - 4 : pa); pb = pb < 0 ? 0 : (pb > M - 4 ? M - 4 : pb);
        const bf16_t* vp = vbase + (size_t)(dt * 32) * L;
        o[dt] = mfma32(ld8x2(vp + pa, vp + pb), pk[s2], o[dt]);
      }
    }
  }
  const float lt = lrun + __shfl_xor(lrun, 32);
  const float c = frcp(lt);
  bf16_t* orow = p.oc + (tokbase + tq) * 768 + hh * 64;
#pragma unroll
  for (int dt = 0; dt < 2; ++dt)
#pragma unroll
    for (int g4 = 0; g4 < 4; ++g4) {
      const int dim = dt * 32 + g4 * 8 + half * 4;
      u32x2 pk = {cvt_pk_bf16(o[dt][g4 * 4 + 0] * c, o[dt][g4 * 4 + 1] * c), cvt_pk_bf16(o[dt][g4 * 4 + 2] * c, o[dt][g4 * 4 + 3] * c)};
      *(u32x2*)(orow + dim) = pk;
    }
  if (half == 0) p.lse[(tokbase + tq) * 12 + hh] = mrun + log2f(lt);
}

__device__ void phase_attn(const Params& p, int layer, int L, int lshift, LAS unsigned char* lds) {
  const int tiles = L >> 5;
  const int nseq = TC >> lshift;
  const int nw = gridDim.x * 8;
  int w, lane;
  { const int qblks = L >> 8, npairs = nseq * 4, nunits = npairs * qblks;
    for (int rep = 0; rep < PROBE_B; ++rep)
    for (int b = blockIdx.x; b < nunits; b += gridDim.x) {
      int pair, qblk;
      if ((gridDim.x & 7) == 0 && (npairs & 7) == 0 && nunits == (int)gridDim.x) { const int xcd = b & 7, j = b >> 3; pair = xcd * (npairs >> 3) + j / qblks; qblk = j % qblks; }
      else { pair = b / qblks; qblk = b % qblks; }
      attn_b_block(p, layer, L, pair >> 2, pair & 3, qblk, lds);
    }
  }
  { const int tid = opaque_tid(); lane = tid & 63; w = blockIdx.x * 8 + __builtin_amdgcn_readfirstlane(tid >> 6); }
  for (int rep = 0; rep < PROBE_AC; ++rep) {
  for (int ua = w; ua < nseq * 8 * tiles; ua += nw) {
    const int idx = ua % tiles, sh = ua / tiles;
    attn_a_unit(p, layer, L, sh >> 3, sh & 7, idx >> 1, idx & 1, lane);
  }
  for (int uc = w; uc < nseq * 12 * tiles; uc += nw) {
    const int idx = uc % tiles, sgh = uc / tiles;
    const int seq = sgh / 12, gh = sgh % 12, g = gh >> 2, h = gh & 3;
    const int ds = (g == 0) ? 0 : (g == 1 ? 2 : 4);
    const int mb = (L >> ds) >> 5;
    attn_c_unit(p, L, lshift, seq, g, h, idx / mb, idx % mb, lane);
  }
  }
}

__device__ void phase_combine(const Params& p) {
  const int gt = blockIdx.x * 512 + opaque_tid(), ngt = gridDim.x * 512;
  for (int it = gt; it < TC * 32; it += ngt) {
    const int tok = it >> 5, sub = it & 31, h = sub >> 3, d8 = (sub & 7) * 8;
    const float* ls = p.lse + (size_t)tok * 12;
    const float l0 = ls[h], l1 = ls[4 + h], l2 = ls[8 + h];
    const float mx = fmaxf(l0, fmaxf(l1, l2));
    const float w0 = fexp2(l0 - mx), w1 = fexp2(l1 - mx), w2 = fexp2(l2 - mx);
    const float inv = frcp(w0 + w1 + w2);
    const bf16_t* ob = p.oc + (size_t)tok * 768 + h * 64 + d8;
    const u32x4 a = *(const u32x4*)ob, b = *(const u32x4*)(ob + 256), c = *(const u32x4*)(ob + 512);
    const u32x4 z = *(const u32x4*)(p.u + (size_t)tok * UW + U_ZC + h * 64 + d8);
    u32x4 r;
#pragma unroll
    for (int k = 0; k < 4; ++k) {
      const float vlo = (w0 * bf_lo(a[k]) + w1 * bf_lo(b[k]) + w2 * bf_lo(c[k])) * inv * silu(bf_lo(z[k]));
      const float vhi = (w0 * bf_hi(a[k]) + w1 * bf_hi(b[k]) + w2 * bf_hi(c[k])) * inv * silu(bf_hi(z[k]));
      r[k] = cvt_pk_bf16(vlo, vhi);
    }
    *(u32x4*)(p.yg + (size_t)tok * YW + 1024 + h * 64 + d8) = r;
  }
}

__global__ void __launch_bounds__(512) fwd_megakernel(Params p) {
  __shared__ __attribute__((aligned(16))) unsigned char smem[LDS_ATT_TOTAL > pg8::STAGE_BYTES ? LDS_ATT_TOTAL : pg8::STAGE_BYTES];
  cg::grid_group grid = cg::this_grid();
#define GSYNC() do { for (int rep_ = 0; rep_ < PROBE_SYNC; ++rep_) grid.sync(); } while (0)
  LAS unsigned char* lds = (LAS unsigned char*)smem;
  phase_prep(p, (LAS float*)smem);
  phase_x(p, 0);
  GSYNC();
  for (int chunk = 0; chunk < NCHUNK; ++chunk) {
    const int L = chunk < 2 ? 2048 : 4096, lshift = chunk < 2 ? 11 : 12;
    const float* xin = (chunk < 2) ? p.xp + (size_t)chunk * TC * DM : p.xs + (size_t)(chunk - 2) * TC * DM;
    float* xres = p.out + (size_t)chunk * TC * DM;
    float* ssq = p.ssq + (size_t)chunk * TC * 16;
    for (int layer = 0; layer < DEPTH; ++layer) {
      {
        pg8::Gemm g{p.xb, p.wt_in + (size_t)layer * INW * DM, TC, INW, DM};
        pg8::StaticOrder S; S.init(TC, INW, gridDim.x, blockIdx.x);
        EpiU E{p.u, p.vt, ssq, p.b_gate + (size_t)layer * 3 * DM, L, lshift};
        for (int rep = 0; rep < PROBE_P1; ++rep) pg8::gemm_phase(lds, g, S, E);
      }
      GSYNC();
      phase_attn(p, layer, L, lshift, lds);
      GSYNC();
      phase_combine(p);
      GSYNC();
      {
        pg8::Gemm g{p.yg, p.wt_br + (size_t)layer * DM * YW, TC, DM, YW};
        pg8::StaticOrder S; S.init(TC, DM, gridDim.x, blockIdx.x);
        EpiMerge E{p.u, p.merged};
        pg8::gemm_phase(lds, g, S, E);
      }
      GSYNC();
      {
        pg8::Gemm g{p.merged, p.wt_out + (size_t)layer * DM * DM, TC, DM, DM};
        pg8::StaticOrder S; S.init(TC, DM, gridDim.x, blockIdx.x);
        EpiRes E{layer == 0 ? xin : (const float*)xres, xres, p.xb, ssq};
        pg8::gemm_phase(lds, g, S, E);
      }
      GSYNC();
    }
    phase_final(p, chunk);
    if (chunk + 1 < NCHUNK) { phase_x(p, chunk + 1); GSYNC(); }
  }
}

extern "C" void kernel_launch(void* const* d_in, const int* in_sizes, int n_in, void* d_out, int out_size, void* d_ws, size_t ws_size, hipStream_t stream) {
  (void)in_sizes; (void)n_in; (void)out_size;
  static int grid_blocks = 0;
  if (!grid_blocks) {
    int dev = 0, cus = 0, per_cu = 0;
    hipGetDevice(&dev);
    hipDeviceGetAttribute(&cus, hipDeviceAttributeMultiprocessorCount, dev);
    hipOccupancyMaxActiveBlocksPerMultiprocessor(&per_cu, fwd_megakernel, 512, 0);
    if (per_cu < 1) per_cu = 1;
    grid_blocks = cus * per_cu;
    if (grid_blocks > 256) grid_blocks = 256;
  }
  Params p{};
  p.xp = (const float*)d_in[0]; p.xs = (const float*)d_in[1]; p.g_norm = (const float*)d_in[2]; p.w_in = (const float*)d_in[3];
  p.b_gate = (const float*)d_in[4]; p.rpb = (const float*)d_in[5]; p.lam_qk = (const float*)d_in[6]; p.g_diff = (const float*)d_in[7];
  p.w_br_a = (const float*)d_in[8]; p.w_br_b = (const float*)d_in[9]; p.w_br_c = (const float*)d_in[10]; p.w_out = (const float*)d_in[11];
  p.g_final = (const float*)d_in[12];
  p.out = (float*)d_out;
  char* w = (char*)d_ws; size_t off = 0;
  auto take = [&](size_t bytes) { char* r = w + off; off += (bytes + 255) & ~(size_t)255; return r; };
  p.wt_in = (bf16_t*)take((size_t)DEPTH * INW * DM * 2);
  p.wt_br = (bf16_t*)take((size_t)DEPTH * DM * YW * 2);
  p.wt_out = (bf16_t*)take((size_t)DEPTH * DM * DM * 2);
  p.xb = (bf16_t*)take((size_t)TC * DM * 2);
  p.u = (bf16_t*)take((size_t)TC * UW * 2);
  p.vt = (bf16_t*)take((size_t)TC * VW * 2);
  p.yg = (bf16_t*)take((size_t)TC * YW * 2);
  p.oc = (bf16_t*)take((size_t)TC * 768 * 2);
  p.merged = (bf16_t*)take((size_t)TC * DM * 2);
  p.lse = (float*)take((size_t)TC * 12 * 4);
  p.ssq = (float*)take((size_t)NTOK * 16 * 4);
  p.lam = (float*)take(256);
  if (off > ws_size) fprintf(stderr, "workspace too small: need %zu have %zu\n", off, ws_size);
  void* args[] = {&p};
  hipError_t e = hipLaunchCooperativeKernel((void*)fwd_megakernel, dim3(grid_blocks), dim3(512), args, 0, stream);
  if (e != hipSuccess) fprintf(stderr, "cooperative launch failed: %s (grid %d)\n", hipGetErrorString(e), grid_blocks);
}
```

```cpp
#include <hip/hip_runtime.h>
#include <hip/hip_cooperative_groups.h>
#include <cstdio>
namespace cg = cooperative_groups;
#ifndef PROBE_B
#define PROBE_B 1
#endif
#ifndef PROBE_AC
#define PROBE_AC 1
#endif
#ifndef PROBE_P1
#define PROBE_P1 1
#endif
#ifndef PROBE_3A
#define PROBE_3A 1
#endif
#ifndef PROBE_SMALL
#define PROBE_SMALL 1
#endif
#ifndef PROBE_3B
#define PROBE_3B 1
#endif
#ifndef PROBE_SYNC
#define PROBE_SYNC 1
#endif

#define LAS __attribute__((address_space(3)))
typedef unsigned short bf16_t;
typedef short bf16x8 __attribute__((ext_vector_type(8)));
typedef short bf16x4 __attribute__((ext_vector_type(4)));
typedef float f32x4 __attribute__((ext_vector_type(4)));
typedef float f32x16 __attribute__((ext_vector_type(16)));
typedef unsigned u32x4 __attribute__((ext_vector_type(4)));
typedef unsigned u32x2 __attribute__((ext_vector_type(2)));

constexpr int DM = 1024, DEPTH = 4, INW = 9728, UW = 7936, VW = 1792, YW = 1280;
constexpr int TC = 16384, NCHUNK = 4, NTOK = 65536;
constexpr float LOG2E = 1.4426950408889634f;
constexpr float QSCALE = 0.125f * LOG2E;
constexpr int U_QA = 0, U_KA = 512, U_ZA = 1024, U_QB = 1536, U_KB = 2048, U_ZB = 2560, U_QC = 3072, U_KC = 3840, U_ZC = 4608, U_GL = 4864;
constexpr int V_A = 0, V_B = 512, V_C = 1024;

struct Params {
  const float *xp, *xs, *g_norm, *w_in, *b_gate, *rpb, *lam_qk, *g_diff, *w_br_a, *w_br_b, *w_br_c, *w_out, *g_final;
  float* out;
  bf16_t *wt_in, *wt_br, *wt_out, *xb, *u, *vt, *yg, *oc, *merged;
  float *lse, *ssq, *lam;
  unsigned* bar;
};

__device__ __forceinline__ unsigned cvt_pk_bf16(float lo, float hi) { unsigned r; asm volatile("v_cvt_pk_bf16_f32 %0, %1, %2" : "=v"(r) : "v"(lo), "v"(hi)); return r; }
__device__ __forceinline__ float bf_lo(unsigned v) { return __uint_as_float(v << 16); }
__device__ __forceinline__ float bf_hi(unsigned v) { return __uint_as_float(v & 0xffff0000u); }
__device__ __forceinline__ float fexp2(float x) { return __builtin_amdgcn_exp2f(x); }
__device__ __forceinline__ float frcp(float x) { return __builtin_amdgcn_rcpf(x); }

__device__ __forceinline__ int opaque_tid() { int t = threadIdx.x; asm volatile("" : "+v"(t)); return t; }

namespace pg8 {
constexpr int BM = 256, BK = 64, HALF = 128, HTB = HALF * BK * 2, STAGE_BYTES = 8 * HTB, NXCD = 8, WGM = 8;
__device__ __forceinline__ int lds_byte(int r, int c) { const int st = (r >> 4) * 2 + (c >> 5), rr = r & 15, cc = c & 31, ob = rr * 64 + cc * 2; return st * 1024 + (ob ^ (((ob >> 9) & 1) << 5)); }
__device__ __forceinline__ void stage_rc(int b, int& R, int& C) { const int st = b / 1024, sb = b % 1024, swz = sb ^ (((sb >> 9) & 1) << 5); R = (st >> 1) * 16 + swz / 64; C = (st & 1) * 32 + (swz % 64) / 2; }
__device__ __forceinline__ int perm32(int rho) { const int n = rho >> 4, i = rho & 15; return 8 * (i >> 2) + 4 * n + (i & 3); }
struct Unit { int pm, pn; };
struct Gemm { const bf16_t* A; const bf16_t* Bt; int M, N, K; int bperm, lshift; };
struct StaticOrder {
  int nM, nN, nwg, G, c;
  __device__ void init(int M, int N, int G_, int c_) { nM = M / BM; nN = N / BM; nwg = nM * nN; G = G_; c = c_; }
  __device__ bool next(int i, Unit& u) const {
    const long L = (long)i * G + c; if (L >= nwg) return false;
    int wgid = (int)L; { const int q = nwg / NXCD, r = nwg % NXCD, xcd = wgid % NXCD, off = wgid / NXCD; wgid = (xcd < r ? xcd * (q + 1) : r * (q + 1) + (xcd - r) * q) + off; }
    const int nig = WGM * nN, gid = wgid / nig, fm = gid * WGM, gsz = (nM - fm) < WGM ? (nM - fm) : WGM;
    u.pm = fm + ((wgid % nig) % gsz); u.pn = (wgid % nig) / gsz; return true;
  }
};

template <class Epi>
__device__ __forceinline__ void gemm_phase(LAS unsigned char* lds, const Gemm g, const StaticOrder& S, const Epi& E) {
  int tid_ = threadIdx.x; asm volatile("" : "+v"(tid_));
  const int tid = tid_, wid = __builtin_amdgcn_readfirstlane(tid >> 6), lane = tid & 63, wr = wid >> 2, wc = wid & 3, fr = lane & 15, fq = lane >> 4;
  const int K = g.K, nt = K / BK;
  const size_t kstep = (size_t)(BK * 2);
  const size_t hstep = (size_t)HALF * K * 2;
  const size_t tstep = 2 * hstep;
  unsigned voffA[2], voffBr[2], voffBc[2], voffB[2], voffBn[2];
#pragma unroll
  for (int i = 0; i < 2; ++i) { int R, C; stage_rc(tid * 16 + i * 8192, R, C); const int Rb = (R & ~31) + perm32(R & 31);
    voffA[i] = (unsigned)(R * K + C) * 2u; voffBr[i] = (unsigned)(Rb * K) * 2u; voffBc[i] = (unsigned)C * 2u; voffB[i] = voffBr[i] + voffBc[i]; voffBn[i] = voffB[i]; }
  auto bbase = [&](const Unit& u, int hh, int& sh) -> const char* {
    if (!g.bperm) { sh = 0; return (const char*)g.Bt + (size_t)u.pn * tstep + (size_t)hh * hstep; }
    const int ds = u.pm <= 4 ? 0 : (u.pm == 5 ? 2 : 4); sh = ds;
    const int L = 1 << g.lshift; const int p0 = u.pn * 256 + hh * 128, seq = p0 >> g.lshift, p = p0 & (L - 1);
    const int Mc = L >> ds, r = p / Mc, m0 = p & (Mc - 1);
    return (const char*)g.Bt + ((size_t)seq * L + ((size_t)m0 << ds) + r) * (size_t)K * 2;
  };
  const unsigned ldsw = (unsigned)wid * 1024u;
  const int aoff = lds_byte(wr * 64 + fr, fq * 8), boff = lds_byte(wc * 32 + fr, fq * 8);
#define PG8_SA(b, h) (((b) * 2 + (h)) * HTB)
#define PG8_SB(b, h) ((4 + (b) * 2 + (h)) * HTB)
#define PG8_STAGE(bufoff, gbase, voff) do { _Pragma("unroll") for (int _i = 0; _i < 2; ++_i) \
    __builtin_amdgcn_global_load_lds((const unsigned*)((const char*)(gbase) + (voff)[_i]), (LAS unsigned*)(lds + (bufoff) + ldsw + _i * 8192), 16, 0, 0); } while (0)
#define PG8_LDA(dst, b, h) do { _Pragma("unroll") for (int m = 0; m < 4; ++m) _Pragma("unroll") for (int k = 0; k < 2; ++k) dst[m][k] = *(const LAS bf16x8*)(lds + PG8_SA(b, h) + aoff + m * 2048 + k * 1024); } while (0)
#define PG8_LDB(dst, b, h) do { _Pragma("unroll") for (int n = 0; n < 2; ++n) _Pragma("unroll") for (int k = 0; k < 2; ++k) dst[n][k] = *(const LAS bf16x8*)(lds + PG8_SB(b, h) + boff + n * 2048 + k * 1024); } while (0)
#define PG8_MMA(ai, bj, At, Bt) do { __builtin_amdgcn_s_setprio(1); _Pragma("unroll") for (int m = 0; m < 4; ++m) _Pragma("unroll") for (int n = 0; n < 2; ++n) _Pragma("unroll") for (int k = 0; k < 2; ++k) \
    acc[ai][bj][m][n] = __builtin_amdgcn_mfma_f32_16x16x32_bf16(Bt[n][k], At[m][k], acc[ai][bj][m][n], 0, 0, 0); __builtin_amdgcn_s_setprio(0); } while (0)
#define PG8_WAIT_V(n) asm volatile("s_waitcnt vmcnt(" #n ")" ::: "memory")
#define PG8_WAIT_L(n) asm volatile("s_waitcnt lgkmcnt(" #n ")" ::: "memory")
#define PG8_BAR __builtin_amdgcn_s_barrier()
#define PG8_SCHED __builtin_amdgcn_sched_barrier(0)
  Unit cur, nxt; int ui = 0;
  if (!S.next(0, cur)) return;
  f32x4 acc[2][2][4][2];
#pragma unroll
  for (int a = 0; a < 2; ++a)
#pragma unroll
    for (int b = 0; b < 2; ++b)
#pragma unroll
      for (int m = 0; m < 4; ++m)
#pragma unroll
        for (int n = 0; n < 2; ++n) acc[a][b][m][n] = (f32x4){0.f, 0.f, 0.f, 0.f};
  bf16x8 At[4][2], B0[2][2], B1[2][2];
  const char* cA = (const char*)g.A + (size_t)cur.pm * tstep;
  int csh; const char* cB0 = bbase(cur, 0, csh); const char* cB1 = bbase(cur, 1, csh);
#pragma unroll
  for (int i = 0; i < 2; ++i) voffB[i] = (voffBr[i] << csh) + voffBc[i];
  PG8_STAGE(PG8_SB(0, 0), cB0, voffB); PG8_STAGE(PG8_SA(0, 0), cA, voffA); PG8_STAGE(PG8_SB(0, 1), cB1, voffB); PG8_STAGE(PG8_SA(0, 1), cA + hstep, voffA);
  if (wr == 1) PG8_BAR;
  PG8_WAIT_V(4); PG8_BAR;
  PG8_STAGE(PG8_SB(1, 0), cB0 + kstep, voffB); PG8_STAGE(PG8_SA(1, 0), cA + kstep, voffA); PG8_STAGE(PG8_SB(1, 1), cB1 + kstep, voffB);
  PG8_WAIT_V(6); PG8_BAR;
  for (;;) {
    const bool has_next = S.next(ui + 1, nxt);
    const char* nA = cA; const char* nB0 = cB0; const char* nB1 = cB1;
#pragma unroll
    for (int i = 0; i < 2; ++i) voffBn[i] = voffB[i];
    if (has_next) { int nsh; nA = (const char*)g.A + (size_t)nxt.pm * tstep; nB0 = bbase(nxt, 0, nsh); nB1 = bbase(nxt, 1, nsh);
#pragma unroll
      for (int i = 0; i < 2; ++i) voffBn[i] = (voffBr[i] << nsh) + voffBc[i]; }
    for (int t = 0; t < nt; t += 2) {
      if constexpr (Epi::HOOK) { if (t == 8 || t == 16) E.hook(acc, cur, t, wr, wc, fr, fq); }
      const bool last = (t == nt - 2);
      const char* a1 = cA + (size_t)(t + 1) * kstep;
      const char* a2 = last ? nA : cA + (size_t)(t + 2) * kstep;
      const char* b20 = last ? nB0 : cB0 + (size_t)(t + 2) * kstep; const char* b21 = last ? nB1 : cB1 + (size_t)(t + 2) * kstep;
      const char* a3 = a2 + kstep; const char* b30 = b20 + kstep; const char* b31 = b21 + kstep;
      unsigned vB[2];
#pragma unroll
      for (int i = 0; i < 2; ++i) vB[i] = last ? voffBn[i] : voffB[i];
      PG8_LDB(B0, 0, 0); PG8_SCHED; PG8_LDA(At, 0, 0); PG8_STAGE(PG8_SA(1, 1), a1 + hstep, voffA);
      PG8_WAIT_L(8); PG8_BAR; PG8_WAIT_L(0); PG8_MMA(0, 0, At, B0); PG8_BAR; PG8_SCHED;
      PG8_LDB(B1, 0, 1); PG8_STAGE(PG8_SB(0, 0), b20, vB);
      PG8_BAR; PG8_WAIT_L(0); PG8_MMA(0, 1, At, B1); PG8_BAR;
      PG8_LDA(At, 0, 1); PG8_STAGE(PG8_SA(0, 0), a2, voffA);
      PG8_BAR; PG8_WAIT_L(0); PG8_MMA(1, 0, At, B0); PG8_BAR; PG8_SCHED;
      PG8_STAGE(PG8_SB(0, 1), b21, vB);
      PG8_WAIT_V(6); PG8_BAR; PG8_MMA(1, 1, At, B1); PG8_BAR;
      PG8_LDB(B0, 1, 0); PG8_SCHED; PG8_LDA(At, 1, 0); PG8_STAGE(PG8_SA(0, 1), a2 + hstep, voffA);
      PG8_WAIT_L(8); PG8_BAR; PG8_WAIT_L(0); PG8_MMA(0, 0, At, B0); PG8_BAR; PG8_SCHED;
      PG8_LDB(B1, 1, 1); PG8_STAGE(PG8_SB(1, 0), b30, vB);
      PG8_BAR; PG8_WAIT_L(0); PG8_MMA(0, 1, At, B1); PG8_BAR;
      PG8_LDA(At, 1, 1); PG8_STAGE(PG8_SA(1, 0), a3, voffA);
      PG8_BAR; PG8_WAIT_L(0); PG8_MMA(1, 0, At, B0); PG8_BAR; PG8_SCHED;
      PG8_STAGE(PG8_SB(1, 1), b31, vB);
      PG8_WAIT_V(6); PG8_BAR; PG8_MMA(1, 1, At, B1); PG8_BAR;
    }
    E(acc, cur, wr, wc, fr, fq);
    if (!has_next) break;
#pragma unroll
    for (int a = 0; a < 2; ++a)
#pragma unroll
      for (int b = 0; b < 2; ++b)
#pragma unroll
        for (int m = 0; m < 4; ++m)
#pragma unroll
          for (int n = 0; n < 2; ++n) acc[a][b][m][n] = (f32x4){0.f, 0.f, 0.f, 0.f};
    cur = nxt; cA = nA; cB0 = nB0; cB1 = nB1; ++ui;
#pragma unroll
    for (int i = 0; i < 2; ++i) voffB[i] = voffBn[i];
  }
  PG8_WAIT_V(0);
  if (wr == 0) PG8_BAR;
  PG8_BAR;
#undef PG8_SA
#undef PG8_SB
#undef PG8_STAGE
#undef PG8_LDA
#undef PG8_LDB
#undef PG8_MMA
#undef PG8_WAIT_V
#undef PG8_WAIT_L
#undef PG8_BAR
#undef PG8_SCHED
}
}
using pg8::Unit;

struct EpiU {
  static constexpr bool HOOK = false;
  bf16_t* U; const float* ssq; const float* bg;
  __device__ __forceinline__ void hook(f32x4 (&)[2][2][4][2], const Unit&, int, int, int, int, int) const {}
  __device__ __forceinline__ void operator()(const f32x4 (&acc)[2][2][4][2], const Unit& u, int wr, int wc, int fr, int fq) const {
    asm volatile("" : "+v"(fr), "+v"(fq));
    const int row0 = u.pm * 256 + wr * 64 + fr, col0 = u.pn * 256 + wc * 32 + 8 * fq;
    const bool isg = (u.pn >= 19);
#pragma unroll
    for (int ai = 0; ai < 2; ++ai)
#pragma unroll
      for (int m = 0; m < 4; ++m) {
        const int row = row0 + ai * 128 + m * 16;
        const f32x4* sp = (const f32x4*)(ssq + (size_t)row * 16);
        const f32x4 a4 = sp[0] + sp[1] + sp[2] + sp[3];
        const float rinv = rsqrtf((a4[0] + a4[1] + a4[2] + a4[3]) * (1.0f / 1024.0f) + 1e-6f);
        if (isg) {
#pragma unroll
          for (int bj = 0; bj < 2; ++bj) {
            const float* bp = bg + (col0 - U_GL) + bj * 128;
            const f32x4 b0 = *(const f32x4*)bp, b1 = *(const f32x4*)(bp + 4);
            f32x4 v0 = acc[ai][bj][m][0] * rinv + b0, v1 = acc[ai][bj][m][1] * rinv + b1;
#pragma unroll
            for (int j = 0; j < 4; ++j) { v0[j] = 1.0f + fminf(fexp2(-v0[j] * LOG2E), 1e30f); v1[j] = 1.0f + fminf(fexp2(-v1[j] * LOG2E), 1e30f); }
            u32x4 pk = {cvt_pk_bf16(v0[0], v0[1]), cvt_pk_bf16(v0[2], v0[3]), cvt_pk_bf16(v1[0], v1[1]), cvt_pk_bf16(v1[2], v1[3])};
            *(u32x4*)(U + (size_t)row * UW + col0 + bj * 128) = pk;
          }
        } else {
#pragma unroll
          for (int bj = 0; bj < 2; ++bj) {
            const f32x4 v0 = acc[ai][bj][m][0] * rinv, v1 = acc[ai][bj][m][1] * rinv;
            u32x4 pk = {cvt_pk_bf16(v0[0], v0[1]), cvt_pk_bf16(v0[2], v0[3]), cvt_pk_bf16(v1[0], v1[1]), cvt_pk_bf16(v1[2], v1[3])};
            *(u32x4*)(U + (size_t)row * UW + col0 + bj * 128) = pk;
          }
        }
      }
  }
};

struct EpiVT {
  static constexpr bool HOOK = false;
  bf16_t* VT; const float* ssq; int L, lshift;
  __device__ __forceinline__ void hook(f32x4 (&)[2][2][4][2], const Unit&, int, int, int, int, int) const {}
  __device__ __forceinline__ void operator()(const f32x4 (&acc)[2][2][4][2], const Unit& u, int wr, int wc, int fr, int fq) const {
    asm volatile("" : "+v"(fr), "+v"(fq));
    const int vrow0 = u.pm * 256 + wr * 64 + fr, pcol0 = u.pn * 256 + wc * 32 + 8 * fq;
    const int ds = u.pm <= 4 ? 0 : (u.pm == 5 ? 2 : 4);
    const int Mc = L >> ds;
#pragma unroll
    for (int bj = 0; bj < 2; ++bj) {
      const int p0 = pcol0 + bj * 128, seq = p0 >> lshift, pos = p0 & (L - 1);
      const int r = pos / Mc, m0 = pos & (Mc - 1);
      float rinv[8];
#pragma unroll
      for (int j = 0; j < 8; ++j) {
        const int tok = (seq << lshift) + ((m0 + j) << ds) + r;
        const f32x4* sp = (const f32x4*)(ssq + (size_t)tok * 16);
        const f32x4 a4 = sp[0] + sp[1] + sp[2] + sp[3];
        rinv[j] = rsqrtf((a4[0] + a4[1] + a4[2] + a4[3]) * (1.0f / 1024.0f) + 1e-6f);
      }
      bf16_t* vb = VT + ((size_t)seq * VW + vrow0) * L + pos;
#pragma unroll
      for (int ai = 0; ai < 2; ++ai)
#pragma unroll
        for (int m = 0; m < 4; ++m) {
          const f32x4 v0 = acc[ai][bj][m][0], v1 = acc[ai][bj][m][1];
          u32x4 pk = {cvt_pk_bf16(v0[0] * rinv[0], v0[1] * rinv[1]), cvt_pk_bf16(v0[2] * rinv[2], v0[3] * rinv[3]),
                      cvt_pk_bf16(v1[0] * rinv[4], v1[1] * rinv[5]), cvt_pk_bf16(v1[2] * rinv[6], v1[3] * rinv[7])};
          *(u32x4*)(vb + (size_t)(ai * 128 + m * 16) * L) = pk;
        }
    }
  }
};

struct EpiMerge {
  static constexpr bool HOOK = true;
  const bf16_t* U; bf16_t* MG;
  __device__ __forceinline__ f32x4 gvec(int i, size_t row, int col) const {
    const u32x2 raw = *(const u32x2*)(U + row * UW + U_GL + i * 1024 + col);
    f32x4 e; e[0] = bf_lo(raw[0]); e[1] = bf_hi(raw[0]); e[2] = bf_lo(raw[1]); e[3] = bf_hi(raw[1]); return e;
  }
  __device__ __forceinline__ void hook(f32x4 (&acc)[2][2][4][2], const Unit& u, int t, int wr, int wc, int fr, int fq) const {
    const int i = (t == 8) ? 0 : 1;
    asm volatile("" : "+v"(fr), "+v"(fq));
    const int row0 = u.pm * 256 + wr * 64 + fr, col0 = u.pn * 256 + wc * 32 + 8 * fq;
#pragma unroll
    for (int ai = 0; ai < 2; ++ai)
#pragma unroll
      for (int m = 0; m < 4; ++m) {
#pragma unroll
        for (int bj = 0; bj < 2; ++bj)
#pragma unroll
          for (int n = 0; n < 2; ++n) {
            const size_t row = (size_t)(row0 + ai * 128 + m * 16); const int col = col0 + bj * 128 + 4 * n;
            const f32x4 g0 = gvec(i, row, col), g1 = gvec(i + 1, row, col);
            f32x4 r;
#pragma unroll
            for (int j = 0; j < 4; ++j) r[j] = g1[j] * frcp(g0[j]);
            acc[ai][bj][m][n] *= r;
          }
        if (m == 3) __builtin_amdgcn_sched_barrier(0);
      }
  }
  __device__ __forceinline__ void operator()(const f32x4 (&acc)[2][2][4][2], const Unit& u, int wr, int wc, int fr, int fq) const {
    asm volatile("" : "+v"(fr), "+v"(fq));
    const int row0 = u.pm * 256 + wr * 64 + fr, col0 = u.pn * 256 + wc * 32 + 8 * fq;
#pragma unroll
    for (int ai = 0; ai < 2; ++ai)
#pragma unroll
      for (int m = 0; m < 4; ++m)
#pragma unroll
        for (int bj = 0; bj < 2; ++bj) {
          const size_t row = (size_t)(row0 + ai * 128 + m * 16); const int col = col0 + bj * 128;
          const f32x4 e0 = gvec(2, row, col), e1 = gvec(2, row, col + 4);
          f32x4 v0 = acc[ai][bj][m][0], v1 = acc[ai][bj][m][1];
#pragma unroll
          for (int j = 0; j < 4; ++j) { v0[j] *= frcp(e0[j]); v1[j] *= frcp(e1[j]); }
          u32x4 pk = {cvt_pk_bf16(v0[0], v0[1]), cvt_pk_bf16(v0[2], v0[3]), cvt_pk_bf16(v1[0], v1[1]), cvt_pk_bf16(v1[2], v1[3])};
          *(u32x4*)(MG + row * DM + col) = pk;
        }
  }
};

struct EpiRes {
  static constexpr bool HOOK = false;
  const float* R; float* X; bf16_t* XB; float* ssq;
  __device__ __forceinline__ void hook(f32x4 (&)[2][2][4][2], const Unit&, int, int, int, int, int) const {}
  __device__ __forceinline__ void operator()(const f32x4 (&acc)[2][2][4][2], const Unit& u, int wr, int wc, int fr, int fq) const {
    asm volatile("" : "+v"(fr), "+v"(fq));
    const int row0 = u.pm * 256 + wr * 64 + fr, col0 = u.pn * 256 + wc * 32 + 8 * fq;
#pragma unroll
    for (int ai = 0; ai < 2; ++ai)
#pragma unroll
      for (int m = 0; m < 4; ++m) {
        const size_t row = (size_t)(row0 + ai * 128 + m * 16);
        float s = 0.f;
#pragma unroll
        for (int bj = 0; bj < 2; ++bj) {
          const int col = col0 + bj * 128;
          const f32x4 r0 = *(const f32x4*)(R + row * DM + col), r1 = *(const f32x4*)(R + row * DM + col + 4);
          const f32x4 v0 = r0 + acc[ai][bj][m][0], v1 = r1 + acc[ai][bj][m][1];
          *(f32x4*)(X + row * DM + col) = v0; *(f32x4*)(X + row * DM + col + 4) = v1;
          s += v0[0] * v0[0] + v0[1] * v0[1] + v0[2] * v0[2] + v0[3] * v0[3] + v1[0] * v1[0] + v1[1] * v1[1] + v1[2] * v1[2] + v1[3] * v1[3];
          u32x4 pk = {cvt_pk_bf16(v0[0], v0[1]), cvt_pk_bf16(v0[2], v0[3]), cvt_pk_bf16(v1[0], v1[1]), cvt_pk_bf16(v1[2], v1[3])};
          *(u32x4*)(XB + row * DM + col) = pk;
        }
        s += __shfl_xor(s, 16); s += __shfl_xor(s, 32);
        if (fq == 0) ssq[row * 16 + u.pn * 4 + wc] = s;
      }
  }
};

__device__ __forceinline__ void prep_tile(const float* src, int ldn, int k0, int n0, const float* rscale, float cscale, bf16_t* dst, int ldd, int drow0, int dk0, LAS float* tile) {
  const int tid = opaque_tid(), kk = tid >> 6, nn = tid & 63;
#pragma unroll
  for (int i = 0; i < 8; ++i) {
    const int k = kk * 8 + i;
    float v = src[(size_t)(k0 + k) * ldn + n0 + nn] * cscale;
    if (rscale) v *= rscale[k0 + k];
    tile[k * 65 + nn] = v;
  }
  __syncthreads();
  const int n = tid >> 3, kc = tid & 7;
  float f[8];
#pragma unroll
  for (int j = 0; j < 8; ++j) f[j] = tile[(kc * 8 + j) * 65 + n];
  u32x4 pk = {cvt_pk_bf16(f[0], f[1]), cvt_pk_bf16(f[2], f[3]), cvt_pk_bf16(f[4], f[5]), cvt_pk_bf16(f[6], f[7])};
  *(u32x4*)(dst + (size_t)(drow0 + n) * ldd + dk0 + kc * 8) = pk;
  __syncthreads();
}

__device__ __forceinline__ void win_map(int n0, int& dn0, float& sc) {
  sc = 1.0f;
  if (n0 < 512) { dn0 = U_QA + n0; sc = QSCALE; }
  else if (n0 < 1024) dn0 = U_KA + (n0 - 512);
  else if (n0 < 1536) dn0 = UW + V_A + (n0 - 1024);
  else if (n0 < 2048) dn0 = U_ZA + (n0 - 1536);
  else if (n0 < 2560) { dn0 = U_QB + (n0 - 2048); sc = QSCALE; }
  else if (n0 < 3072) dn0 = U_KB + (n0 - 2560);
  else if (n0 < 3584) dn0 = UW + V_B + (n0 - 3072);
  else if (n0 < 4096) dn0 = U_ZB + (n0 - 3584);
  else if (n0 < 4864) { dn0 = U_QC + (n0 - 4096); sc = QSCALE; }
  else if (n0 < 5632) dn0 = U_KC + (n0 - 4864);
  else if (n0 < 6400) dn0 = UW + V_C + (n0 - 5632);
  else if (n0 < 6656) dn0 = U_ZC + (n0 - 6400);
  else dn0 = U_GL + (n0 - 6656);
}

__device__ void phase_prep(const Params& p, LAS float* tile) {
  constexpr int PER = 3008;
  for (int it = blockIdx.x; it < DEPTH * PER; it += gridDim.x) {
    const int l = it / PER; int r = it % PER;
    if (r < 2432) {
      const int kt = r / 152, ntile = r % 152; int dn0; float sc; win_map(ntile * 64, dn0, sc);
      prep_tile(p.w_in + (size_t)l * DM * INW, INW, kt * 64, ntile * 64, p.g_norm + l * DM, sc, p.wt_in + (size_t)l * INW * DM, DM, dn0, kt * 64, tile);
    } else if ((r -= 2432) < 128) {
      const int kt = r / 16, ntile = r % 16;
      prep_tile(p.w_br_a + (size_t)l * 512 * DM, DM, kt * 64, ntile * 64, nullptr, 1.0f, p.wt_br + (size_t)l * DM * YW, YW, ntile * 64, kt * 64, tile);
    } else if ((r -= 128) < 128) {
      const int kt = r / 16, ntile = r % 16;
      prep_tile(p.w_br_b + (size_t)l * 512 * DM, DM, kt * 64, ntile * 64, nullptr, 1.0f, p.wt_br + (size_t)l * DM * YW, YW, ntile * 64, 512 + kt * 64, tile);
    } else if ((r -= 128) < 64) {
      const int kt = r / 16, ntile = r % 16;
      prep_tile(p.w_br_c + (size_t)l * 256 * DM, DM, kt * 64, ntile * 64, nullptr, 1.0f, p.wt_br + (size_t)l * DM * YW, YW, ntile * 64, 1024 + kt * 64, tile);
    } else {
      r -= 64; const int kt = r / 16, ntile = r % 16;
      prep_tile(p.w_out + (size_t)l * DM * DM, DM, kt * 64, ntile * 64, nullptr, 1.0f, p.wt_out + (size_t)l * DM * DM, DM, ntile * 64, kt * 64, tile);
    }
  }
  if (blockIdx.x == 0 && threadIdx.x < 64) {
    const int lane = threadIdx.x;
    for (int l = 0; l < DEPTH; ++l) {
      const float* lq = p.lam_qk + l * 256;
      float a = lq[lane] * lq[64 + lane], b = lq[128 + lane] * lq[192 + lane];
      for (int o = 32; o >= 1; o >>= 1) { a += __shfl_xor(a, o); b += __shfl_xor(b, o); }
      if (lane == 0) p.lam[l] = expf(a) - expf(b) + (0.8f - 0.6f * expf(-0.3f * (float)l));
    }
  }
}

__device__ void phase_x(const Params& p, int chunk) {
  const float* xin = (chunk < 2) ? p.xp + (size_t)chunk * TC * DM : p.xs + (size_t)(chunk - 2) * TC * DM;
  float* ssq = p.ssq + (size_t)chunk * TC * 16;
  const int tid = opaque_tid(), lane = tid & 63, w = blockIdx.x * 8 + (tid >> 6), nw = gridDim.x * 8;
  for (int row = w; row < TC; row += nw) {
    const float* xr = xin + (size_t)row * DM + lane * 16;
    f32x4 v[4]; float s = 0.f;
#pragma unroll
    for (int i = 0; i < 4; ++i) { v[i] = *(const f32x4*)(xr + i * 4); s += v[i][0] * v[i][0] + v[i][1] * v[i][1] + v[i][2] * v[i][2] + v[i][3] * v[i][3]; }
    for (int o = 32; o >= 1; o >>= 1) s += __shfl_xor(s, o);
    u32x4 p0 = {cvt_pk_bf16(v[0][0], v[0][1]), cvt_pk_bf16(v[0][2], v[0][3]), cvt_pk_bf16(v[1][0], v[1][1]), cvt_pk_bf16(v[1][2], v[1][3])};
    u32x4 p1 = {cvt_pk_bf16(v[2][0], v[2][1]), cvt_pk_bf16(v[2][2], v[2][3]), cvt_pk_bf16(v[3][0], v[3][1]), cvt_pk_bf16(v[3][2], v[3][3])};
    bf16_t* xo = p.xb + (size_t)row * DM + lane * 16;
    *(u32x4*)xo = p0; *(u32x4*)(xo + 8) = p1;
    if (lane < 16) ssq[(size_t)row * 16 + lane] = (lane == 0) ? s : 0.f;
  }
}

__device__ void phase_final(const Params& p, int chunk) {
  float* x = p.out + (size_t)chunk * TC * DM;
  const float* ssq = p.ssq + (size_t)chunk * TC * 16;
  const int tid = opaque_tid(), lane = tid & 63, w = blockIdx.x * 8 + (tid >> 6), nw = gridDim.x * 8;
  for (int row = w; row < TC; row += nw) {
    const f32x4* sp = (const f32x4*)(ssq + (size_t)row * 16);
    const f32x4 a4 = sp[0] + sp[1] + sp[2] + sp[3];
    const float rinv = rsqrtf((a4[0] + a4[1] + a4[2] + a4[3]) * (1.0f / 1024.0f) + 1e-6f);
    float* xr = x + (size_t)row * DM + lane * 16;
#pragma unroll
    for (int i = 0; i < 4; ++i) { f32x4 v = *(const f32x4*)(xr + i * 4); const f32x4 g = *(const f32x4*)(p.g_final + lane * 16 + i * 4); v = v * rinv * g; *(f32x4*)(xr + i * 4) = v; }
  }
}

__device__ __forceinline__ f32x16 mfma32(bf16x8 a, bf16x8 b, f32x16 c) { return __builtin_amdgcn_mfma_f32_32x32x16_bf16(a, b, c, 0, 0, 0); }
__device__ __forceinline__ bf16x8 ld16(const bf16_t* p) { return *(const bf16x8*)p; }
__device__ __forceinline__ bf16x8 ld8x2(const bf16_t* p0, const bf16_t* p1) { const bf16x4 a = *(const bf16x4*)p0, b = *(const bf16x4*)p1; return __builtin_shufflevector(a, b, 0, 1, 2, 3, 4, 5, 6, 7); }

__device__ __forceinline__ void softmax_tile(f32x16& t, float& m, float& l, float& alpha, bf16x8& p0, bf16x8& p1) {
  float tm = t[0];
#pragma unroll
  for (int i = 1; i < 16; ++i) tm = fmaxf(tm, t[i]);
  tm = fmaxf(tm, __shfl_xor(tm, 32));
  const float mn = fmaxf(m, tm);
  alpha = fexp2(m - mn); m = mn;
  float ls = 0.f;
#pragma unroll
  for (int i = 0; i < 16; ++i) { t[i] = fexp2(t[i] - mn); ls += t[i]; }
  l = l * alpha + ls;
  const u32x4 a = {cvt_pk_bf16(t[0], t[1]), cvt_pk_bf16(t[2], t[3]), cvt_pk_bf16(t[4], t[5]), cvt_pk_bf16(t[6], t[7])};
  const u32x4 b = {cvt_pk_bf16(t[8], t[9]), cvt_pk_bf16(t[10], t[11]), cvt_pk_bf16(t[12], t[13]), cvt_pk_bf16(t[14], t[15])};
  p0 = __builtin_bit_cast(bf16x8, a); p1 = __builtin_bit_cast(bf16x8, b);
}
__device__ __forceinline__ f32x16 zero16() { f32x16 z;
#pragma unroll
  for (int i = 0; i < 16; ++i) z[i] = 0.f; return z; }
__device__ __forceinline__ float silu(float z) { return z * frcp(1.0f + fexp2(-z * LOG2E)); }

constexpr int TB_ROW = 144;
constexpr int KB_BYTES = 64 * TB_ROW;
constexpr int VB_BYTES = 128 * TB_ROW;
constexpr int LDS_K = 0, LDS_V = LDS_K + 2 * KB_BYTES, LDS_ATT_END = LDS_V + 2 * VB_BYTES, LDS_ATT_TOTAL = LDS_ATT_END + 65536;
__device__ __forceinline__ void attn_b_pass(const Params& p, int L, int seq, int h, int mp, int tq, int tid, float slope2, LAS unsigned char* lds, f32x16 (&o)[4], float& linv) {
  const int lane = tid & 63, q = lane & 31, half = lane >> 5;
  const size_t tokbase = (size_t)seq * L;
  bf16x8 qf[4];
  { const bf16_t* qp = p.u + (tokbase + tq) * UW + U_QB + h * 128 + mp * 64 + half * 8;
#pragma unroll
    for (int ks = 0; ks < 4; ++ks) qf[ks] = ld16(qp + ks * 16); }
  const int spart = tid & 7, srow = tid >> 3;
  const bf16_t* kg = p.u + (tokbase + srow) * UW + U_KB + h * 128 + mp * 64 + spart * 8;
  const bf16_t* vg = p.vt + ((size_t)seq * VW + V_B + h * 128 + srow) * L + spart * 8;
  const int kst = srow * TB_ROW + spart * 16;
  const int vst = srow * TB_ROW + ((spart >> 1) * 16 + (spart & 1) * 4) * 2;
  const int rd = q * TB_ROW + half * 16;
#pragma unroll
  for (int dt = 0; dt < 4; ++dt) o[dt] = zero16();
  float mrun = -1e30f, lrun = 0.f;
  bf16x8 kr, vr0, vr1;
  kr = ld16(kg); vr0 = ld16(vg); vr1 = ld16(vg + (size_t)64 * L);
  {
    LAS unsigned char* kb = lds + LDS_K; LAS unsigned char* vb = lds + LDS_V;
    *(LAS bf16x8*)(kb + kst) = kr;
    *(LAS bf16x4*)(vb + vst) = __builtin_shufflevector(vr0, vr0, 0, 1, 2, 3); *(LAS bf16x4*)(vb + vst + 16) = __builtin_shufflevector(vr0, vr0, 4, 5, 6, 7);
    *(LAS bf16x4*)(vb + vst + 64 * TB_ROW) = __builtin_shufflevector(vr1, vr1, 0, 1, 2, 3); *(LAS bf16x4*)(vb + vst + 64 * TB_ROW + 16) = __builtin_shufflevector(vr1, vr1, 4, 5, 6, 7);
  }
  __syncthreads();
  const int ntile = L >> 6;
#pragma unroll 1
  for (int t = 0; t < ntile; ++t) {
    const int k0 = t * 64;
    const bool more = (t + 1 < ntile);
    if (more) { kr = ld16(kg + (size_t)(k0 + 64) * UW); const bf16_t* vgn = vg + (k0 + 64); vr0 = ld16(vgn); vr1 = ld16(vgn + (size_t)64 * L); }
    const LAS unsigned char* kb = lds + LDS_K + (t & 1) * KB_BYTES;
    const LAS unsigned char* vb = lds + LDS_V + (t & 1) * VB_BYTES;
#pragma unroll
    for (int sub = 0; sub < 2; ++sub) {
      f32x16 sc = zero16();
#pragma unroll
      for (int ks = 0; ks < 4; ++ks) sc = mfma32(*(const LAS bf16x8*)(kb + rd + sub * 32 * TB_ROW + ks * 32), qf[ks], sc);
      const float d0 = (float)(k0 + sub * 32 + half * 4 - tq);
#pragma unroll
      for (int i = 0; i < 16; ++i) sc[i] -= slope2 * fabsf(d0 + (float)((i >> 2) * 8 + (i & 3)));
      float al; bf16x8 pk[2];
      softmax_tile(sc, mrun, lrun, al, pk[0], pk[1]);
      if (__builtin_amdgcn_ballot_w64(al != 1.0f) != 0) {
#pragma unroll
        for (int dt = 0; dt < 4; ++dt) o[dt] *= al;
      }
#pragma unroll
      for (int dt = 0; dt < 4; ++dt)
#pragma unroll
        for (int s2 = 0; s2 < 2; ++s2) o[dt] = mfma32(*(const LAS bf16x8*)(vb + rd + dt * 32 * TB_ROW + (sub * 2 + s2) * 32), pk[s2], o[dt]);
    }
    if (more) {
      LAS unsigned char* kbn = lds + LDS_K + ((t + 1) & 1) * KB_BYTES; LAS unsigned char* vbn = lds + LDS_V + ((t + 1) & 1) * VB_BYTES;
      *(LAS bf16x8*)(kbn + kst) = kr;
      *(LAS bf16x4*)(vbn + vst) = __builtin_shufflevector(vr0, vr0, 0, 1, 2, 3); *(LAS bf16x4*)(vbn + vst + 16) = __builtin_shufflevector(vr0, vr0, 4, 5, 6, 7);
      *(LAS bf16x4*)(vbn + vst + 64 * TB_ROW) = __builtin_shufflevector(vr1, vr1, 0, 1, 2, 3); *(LAS bf16x4*)(vbn + vst + 64 * TB_ROW + 16) = __builtin_shufflevector(vr1, vr1, 4, 5, 6, 7);
    }
    __syncthreads();
  }
  linv = frcp(lrun + __shfl_xor(lrun, 32));
}
__device__ void attn_b_block(const Params& p, int layer, int L, int seq, int h, int qblk, LAS unsigned char* lds) {
  const int tid = opaque_tid(), lane = tid & 63, wid = __builtin_amdgcn_readfirstlane(tid >> 6);
  const int q = lane & 31, half = lane >> 5;
  const size_t tokbase = (size_t)seq * L;
  const int tq = qblk * 256 + wid * 32 + q;
  const float slope2 = exp2f(-2.0f * (float)(h + 1)) * LOG2E;
  f32x16 o0[4]; float li0, li1;
  LAS u32x4* park = (LAS u32x4*)(lds + LDS_ATT_END) + wid * 512 + lane;
  attn_b_pass(p, L, seq, h, 0, tq, tid, slope2, lds, o0, li0);
#pragma unroll
  for (int dt = 0; dt < 4; ++dt)
#pragma unroll
    for (int g2 = 0; g2 < 2; ++g2) {
      u32x4 pk;
#pragma unroll
      for (int k = 0; k < 4; ++k) pk[k] = cvt_pk_bf16(o0[dt][g2 * 8 + 2 * k] * li0, o0[dt][g2 * 8 + 2 * k + 1] * li0);
      park[(dt * 2 + g2) * 64] = pk;
    }
  attn_b_pass(p, L, seq, h, 1, tq, tid, slope2, lds, o0, li1);
  const float c1 = p.lam[layer] * li1;
  float ss = 0.f;
#pragma unroll
  for (int dt = 0; dt < 4; ++dt)
#pragma unroll
    for (int g2 = 0; g2 < 2; ++g2) {
      const u32x4 pk = park[(dt * 2 + g2) * 64];
#pragma unroll
      for (int k = 0; k < 4; ++k) {
        const float va = bf_lo(pk[k]) - o0[dt][g2 * 8 + 2 * k] * c1, vb = bf_hi(pk[k]) - o0[dt][g2 * 8 + 2 * k + 1] * c1;
        o0[dt][g2 * 8 + 2 * k] = va; o0[dt][g2 * 8 + 2 * k + 1] = vb; ss += va * va + vb * vb;
      }
    }
  ss += __shfl_xor(ss, 32);
  const float rn = rsqrtf(ss * (1.0f / 128.0f) + 1e-6f) * (1.0f - (0.8f - 0.6f * expf(-0.3f * (float)layer)));
  const float* gd = p.g_diff + layer * 128;
  bf16_t* yrow = p.yg + (tokbase + tq) * YW + 512 + h * 128;
  const bf16_t* zrow = p.u + (tokbase + tq) * UW + U_ZB + h * 128;
#pragma unroll
  for (int dt = 0; dt < 4; ++dt)
#pragma unroll
    for (int g4 = 0; g4 < 4; ++g4) {
      const int dim = dt * 32 + g4 * 8 + half * 4;
      const u32x2 zr = *(const u32x2*)(zrow + dim);
      const f32x4 gv = *(const f32x4*)(gd + dim);
      const float y0 = o0[dt][g4 * 4 + 0] * rn * gv[0] * silu(bf_lo(zr[0]));
      const float y1 = o0[dt][g4 * 4 + 1] * rn * gv[1] * silu(bf_hi(zr[0]));
      const float y2 = o0[dt][g4 * 4 + 2] * rn * gv[2] * silu(bf_lo(zr[1]));
      const float y3 = o0[dt][g4 * 4 + 3] * rn * gv[3] * silu(bf_hi(zr[1]));
      u32x2 pk = {cvt_pk_bf16(y0, y1), cvt_pk_bf16(y2, y3)};
      *(u32x2*)(yrow + dim) = pk;
    }
}

__device__ void attn_a_unit(const Params& p, int layer, int L, int seq, int h, int r, int cb2, int lane) {
  const int q = lane & 31, half = lane >> 5;
  const size_t tokbase = (size_t)seq * L;
  const int rows = L >> 6;
  int rs = r - 4; rs = rs < 0 ? 0 : (rs > rows - 8 ? rows - 8 : rs);
  const int qcol = cb2 * 32 + q, tq = r * 64 + qcol;
  int qstart = qcol - 8; qstart = qstart < 0 ? 0 : (qstart > 48 ? 48 : qstart);
  const bf16_t* urow = p.u + (tokbase + tq) * UW;
  bf16x8 qf[4];
#pragma unroll
  for (int ks = 0; ks < 4; ++ks) qf[ks] = ld16(urow + U_QA + h * 64 + ks * 16 + half * 8);
  f32x16 o[2] = {zero16(), zero16()};
  float mrun = -1e30f, lrun = 0.f;
  const float* rpb = p.rpb + ((size_t)layer * 8 + h) * 15 * 31;
  const bf16_t* vbase = p.vt + ((size_t)seq * VW + V_A + h * 64 + q) * L;
  for (int i = 0; i < 8; ++i) {
    const int krow = rs + i;
    const float* rpr = rpb + (krow - r + 7) * 31;
#pragma unroll
    for (int seg = 0; seg < 2; ++seg) {
      const bf16_t* kp = p.u + (tokbase + krow * 64 + seg * 32 + q) * UW + U_KA + h * 64 + half * 8;
      f32x16 s = zero16();
#pragma unroll
      for (int ks = 0; ks < 4; ++ks) s = mfma32(ld16(kp + ks * 16), qf[ks], s);
#pragma unroll
      for (int ii = 0; ii < 16; ++ii) {
        const int kcol = seg * 32 + (ii >> 2) * 8 + half * 4 + (ii & 3);
        const bool ok = (kcol >= qstart) && (kcol < qstart + 16);
        int ci = kcol - qcol + 15; ci = ci < 0 ? 0 : (ci > 30 ? 30 : ci);
        s[ii] = ok ? s[ii] + rpr[ci] * LOG2E : -INFINITY;
      }
      float alpha; bf16x8 pk[2];
      softmax_tile(s, mrun, lrun, alpha, pk[0], pk[1]);
#pragma unroll
      for (int dt = 0; dt < 2; ++dt) {
        o[dt] *= alpha;
#pragma unroll
        for (int s2 = 0; s2 < 2; ++s2) {
          const bf16_t* vp = vbase + (size_t)(dt * 32) * L + krow * 64 + seg * 32 + s2 * 16 + half * 4;
          o[dt] = mfma32(ld8x2(vp, vp + 8), pk[s2], o[dt]);
        }
      }
    }
  }
  const float lt = lrun + __shfl_xor(lrun, 32);
  const float c = frcp(lt);
  bf16_t* yrow = p.yg + (tokbase + tq) * YW + h * 64;
  const bf16_t* zrow = urow + U_ZA + h * 64;
#pragma unroll
  for (int dt = 0; dt < 2; ++dt)
#pragma unroll
    for (int g4 = 0; g4 < 4; ++g4) {
      const int dim = dt * 32 + g4 * 8 + half * 4;
      const u32x2 zr = *(const u32x2*)(zrow + dim);
      const float y0 = o[dt][g4 * 4 + 0] * c * silu(bf_lo(zr[0]));
      const float y1 = o[dt][g4 * 4 + 1] * c * silu(bf_hi(zr[0]));
      const float y2 = o[dt][g4 * 4 + 2] * c * silu(bf_lo(zr[1]));
      const float y3 = o[dt][g4 * 4 + 3] * c * silu(bf_hi(zr[1]));
      u32x2 pk = {cvt_pk_bf16(y0, y1), cvt_pk_bf16(y2, y3)};
      *(u32x2*)(yrow + dim) = pk;
    }
}

__device__ void attn_c_unit(const Params& p, int L, int lshift, int seq, int g, int h, int rr, int mblk, int lane) {
  const int q = lane & 31, half = lane >> 5;
  const size_t tokbase = (size_t)seq * L;
  const int ds = (g == 0) ? 0 : (g == 1 ? 2 : 4), d = 1 << ds, M = L >> ds;
  const int hh = g * 4 + h;
  const int m0 = mblk * 32, mq = m0 + q, tq = mq * d + rr;
  const bf16_t* urow = p.u + (tokbase + tq) * UW;
  bf16x8 qf[4];
#pragma unroll
  for (int ks = 0; ks < 4; ++ks) qf[ks] = ld16(urow + U_QC + hh * 64 + ks * 16 + half * 8);
  f32x16 o[2] = {zero16(), zero16()};
  float mrun = -1e30f, lrun = 0.f;
  const float coef = exp2f(-(2.0f / 3.0f) * (float)(hh + 1)) * (float)d * LOG2E;
  const bf16_t* vbase = p.vt + ((size_t)seq * VW + V_C + hh * 64 + q) * L + (size_t)rr * M;
  for (int j = 0; j < 5; ++j) {
    const int mk0 = m0 - 64 + 32 * j;
    if (mk0 + 32 <= 0 || mk0 >= M) continue;
    int mkl = mk0 + q; mkl = mkl < 0 ? 0 : (mkl > M - 1 ? M - 1 : mkl);
    const bf16_t* kp = p.u + (tokbase + (size_t)mkl * d + rr) * UW + U_KC + hh * 64 + half * 8;
    f32x16 s = zero16();
#pragma unroll
    for (int ks = 0; ks < 4; ++ks) s = mfma32(ld16(kp + ks * 16), qf[ks], s);
#pragma unroll
    for (int ii = 0; ii < 16; ++ii) {
      const int mk = mk0 + (ii >> 2) * 8 + half * 4 + (ii & 3);
      const int rel = mk - mq; const int ar = rel < 0 ? -rel : rel;
      const bool ok = (mk >= 0) && (mk < M) && (ar <= 64);
      s[ii] = ok ? s[ii] - coef * (float)ar : -INFINITY;
    }
    float alpha; bf16x8 pk[2];
    softmax_tile(s, mrun, lrun, alpha, pk[0], pk[1]);
#pragma unroll
    for (int dt = 0; dt < 2; ++dt) {
      o[dt] *= alpha;
#pragma unroll
      for (int s2 = 0; s2 < 2; ++s2) {
        int pa = mk0 + s2 * 16 + half * 4, pb = pa + 8;
        pa = pa < 0 ? 0 : (pa > M - 4 ? M - 4 : pa); pb = pb < 0 ? 0 : (pb > M - 4 ? M - 4 : pb);
        const bf16_t* vp = vbase + (size_t)(dt * 32) * L;
        o[dt] = mfma32(ld8x2(vp + pa, vp + pb), pk[s2], o[dt]);
      }
    }
  }
  const float lt = lrun + __shfl_xor(lrun, 32);
  const float c = frcp(lt);
  bf16_t* orow = p.oc + (tokbase + tq) * 768 + hh * 64;
#pragma unroll
  for (int dt = 0; dt < 2; ++dt)
#pragma unroll
    for (int g4 = 0; g4 < 4; ++g4) {
      const int dim = dt * 32 + g4 * 8 + half * 4;
      u32x2 pk = {cvt_pk_bf16(o[dt][g4 * 4 + 0] * c, o[dt][g4 * 4 + 1] * c), cvt_pk_bf16(o[dt][g4 * 4 + 2] * c, o[dt][g4 * 4 + 3] * c)};
      *(u32x2*)(orow + dim) = pk;
    }
  if (half == 0) p.lse[(tokbase + tq) * 12 + hh] = mrun + log2f(lt);
}

__device__ void phase_attn(const Params& p, int layer, int L, int lshift, LAS unsigned char* lds) {
  const int tiles = L >> 5;
  const int nseq = TC >> lshift;
  const int nw = gridDim.x * 8;
  int w, lane;
  { const int qblks = L >> 8, npairs = nseq * 4, nunits = npairs * qblks;
    for (int rep = 0; rep < PROBE_B; ++rep)
    for (int b = blockIdx.x; b < nunits; b += gridDim.x) {
      int pair, qblk;
      if ((gridDim.x & 7) == 0 && (npairs & 7) == 0 && nunits == (int)gridDim.x) { const int xcd = b & 7, j = b >> 3; pair = xcd * (npairs >> 3) + j / qblks; qblk = j % qblks; }
      else { pair = b / qblks; qblk = b % qblks; }
      attn_b_block(p, layer, L, pair >> 2, pair & 3, qblk, lds);
    }
  }
  { const int tid = opaque_tid(); lane = tid & 63; w = blockIdx.x * 8 + __builtin_amdgcn_readfirstlane(tid >> 6); }
  for (int rep = 0; rep < PROBE_AC; ++rep) {
  for (int ua = w; ua < nseq * 8 * tiles; ua += nw) {
    const int idx = ua % tiles, sh = ua / tiles;
    attn_a_unit(p, layer, L, sh >> 3, sh & 7, idx >> 1, idx & 1, lane);
  }
  for (int uc = w; uc < nseq * 12 * tiles; uc += nw) {
    const int idx = uc % tiles, sgh = uc / tiles;
    const int seq = sgh / 12, gh = sgh % 12, g = gh >> 2, h = gh & 3;
    const int ds = (g == 0) ? 0 : (g == 1 ? 2 : 4);
    const int mb = (L >> ds) >> 5;
    attn_c_unit(p, L, lshift, seq, g, h, idx / mb, idx % mb, lane);
  }
  }
}

__device__ void phase_combine(const Params& p) {
  const int gt = blockIdx.x * 512 + opaque_tid(), ngt = gridDim.x * 512;
  for (int it = gt; it < TC * 32; it += ngt) {
    const int tok = it >> 5, sub = it & 31, h = sub >> 3, d8 = (sub & 7) * 8;
    const float* ls = p.lse + (size_t)tok * 12;
    const float l0 = ls[h], l1 = ls[4 + h], l2 = ls[8 + h];
    const float mx = fmaxf(l0, fmaxf(l1, l2));
    const float w0 = fexp2(l0 - mx), w1 = fexp2(l1 - mx), w2 = fexp2(l2 - mx);
    const float inv = frcp(w0 + w1 + w2);
    const bf16_t* ob = p.oc + (size_t)tok * 768 + h * 64 + d8;
    const u32x4 a = *(const u32x4*)ob, b = *(const u32x4*)(ob + 256), c = *(const u32x4*)(ob + 512);
    const u32x4 z = *(const u32x4*)(p.u + (size_t)tok * UW + U_ZC + h * 64 + d8);
    u32x4 r;
#pragma unroll
    for (int k = 0; k < 4; ++k) {
      const float vlo = (w0 * bf_lo(a[k]) + w1 * bf_lo(b[k]) + w2 * bf_lo(c[k])) * inv * silu(bf_lo(z[k]));
      const float vhi = (w0 * bf_hi(a[k]) + w1 * bf_hi(b[k]) + w2 * bf_hi(c[k])) * inv * silu(bf_hi(z[k]));
      r[k] = cvt_pk_bf16(vlo, vhi);
    }
    *(u32x4*)(p.yg + (size_t)tok * YW + 1024 + h * 64 + d8) = r;
  }
}


#define XB_TMO      128
#define XB_XCNT(j)  (256  + 64 * (j))
#define XB_XSUB(j)  (1280 + 64 * (j))
#define XB_XGEN(j)  (2304 + 64 * (j))
#define XB_TOP      3328
#define XB_TOPGEN   3392
#define XCD_BAR_WORDS 3456
#define XB_SPIN_CAP (1u << 18)
__device__ __forceinline__ unsigned xb_ld(unsigned* p)              { return __hip_atomic_load(p, __ATOMIC_RELAXED, __HIP_MEMORY_SCOPE_AGENT); }
__device__ __forceinline__ unsigned xb_add(unsigned* p, unsigned v) { return __hip_atomic_fetch_add(p, v, __ATOMIC_RELAXED, __HIP_MEMORY_SCOPE_AGENT); }
__device__ __forceinline__ unsigned xb_xcc_id() { return (unsigned)__builtin_amdgcn_s_getreg((3 << 11) | 20) & 0xFu; }
#define XB_SPIN(cond, bar) do { unsigned _sp = 0; while (cond) { __builtin_amdgcn_s_sleep(1); \
    if ((++_sp & 255u) == 0u) { if (xb_ld(&(bar)[XB_TMO])) break; if (_sp > XB_SPIN_CAP) { atomicAdd(&(bar)[XB_TMO], 1u); break; } } } } while (0)
struct XcdBarrier { unsigned* bar; unsigned x; volatile LAS unsigned* st; };
__device__ __forceinline__ XcdBarrier xcd_barrier_post(unsigned* bar, volatile LAS unsigned* st) {
  XcdBarrier b; b.bar = bar; b.x = xb_xcc_id(); b.st = st;
  if (threadIdx.x == 0) (void)xb_add(&bar[XB_XCNT(b.x)], 1u);
  return b;
}
__device__ __forceinline__ void xcd_barrier_complete(unsigned* bar, unsigned x, unsigned& nloc, unsigned& nx) {
  const unsigned G = gridDim.x * gridDim.y * gridDim.z;
  unsigned sum, cnt, mine, sp = 0u;
  for (;;) {
    sum = 0u; cnt = 0u; mine = 0u;
#pragma unroll
    for (unsigned j = 0; j < 16; ++j) { const unsigned c = xb_ld(&bar[XB_XCNT(j)]); sum += c; cnt += (c > 0u) ? 1u : 0u; mine = (j == x) ? c : mine; }
    if (sum == G) break;
    __builtin_amdgcn_s_sleep(1);
    if ((++sp & 255u) == 0u) { if (xb_ld(&bar[XB_TMO])) break; if (sp > XB_SPIN_CAP) { atomicAdd(&bar[XB_TMO], 1u); break; } }
  }
  nloc = mine > 0u ? mine : 1u; nx = cnt > 0u ? cnt : 1u;
}
__device__ __forceinline__ void xcd_barrier(const XcdBarrier& b) {
  asm volatile("s_waitcnt vmcnt(0)" ::: "memory");
  __syncthreads();
  if (threadIdx.x == 0) {
    unsigned* bar = b.bar;
    __builtin_amdgcn_s_waitcnt(0);
    unsigned nloc = b.st[0], nx = b.st[1];
    if (nloc == 0u) { xcd_barrier_complete(bar, b.x, nloc, nx); b.st[0] = nloc; b.st[1] = nx; }
    const unsigned old = xb_add(&bar[XB_XSUB(b.x)], 1u);
    const unsigned gen = old / nloc;
    if (old + 1u == (gen + 1u) * nloc) {
      __builtin_amdgcn_fence(__ATOMIC_RELEASE, "agent");
      asm volatile("s_waitcnt vmcnt(0)" ::: "memory");
      const unsigned og = xb_add(&bar[XB_TOP], 1u);
      const unsigned tg = og / nx;
      if (og + 1u == (tg + 1u) * nx) xb_add(&bar[XB_TOPGEN], 1u);
      else XB_SPIN(xb_ld(&bar[XB_TOPGEN]) == tg, bar);
      __builtin_amdgcn_fence(__ATOMIC_ACQUIRE, "agent");
      xb_add(&bar[XB_XGEN(b.x)], 1u);
      asm volatile("s_waitcnt vmcnt(0)" ::: "memory");
    } else {
      XB_SPIN(xb_ld(&bar[XB_XGEN(b.x)]) == gen, bar);
      __builtin_amdgcn_fence(__ATOMIC_ACQUIRE, "agent");
      asm volatile("s_waitcnt vmcnt(0)" ::: "memory");
    }
  }
  __syncthreads();
}

__global__ void __launch_bounds__(512) fwd_megakernel(Params p) {
  __shared__ __attribute__((aligned(16))) unsigned char smem[LDS_ATT_TOTAL > pg8::STAGE_BYTES ? LDS_ATT_TOTAL : pg8::STAGE_BYTES];
  __shared__ __attribute__((aligned(16))) unsigned xb_words[4];
  cg::grid_group grid = cg::this_grid();
  if (threadIdx.x == 0) { xb_words[0] = 0u; xb_words[1] = 0u; xb_words[2] = 0u; xb_words[3] = 0u; }
  __syncthreads();
  const XcdBarrier xb = xcd_barrier_post(p.bar, (volatile LAS unsigned*)xb_words);
#define GSYNC() do { for (int rep_ = 0; rep_ < PROBE_SYNC; ++rep_) xcd_barrier(xb); } while (0)
  LAS unsigned char* lds = (LAS unsigned char*)smem;
  for (int rep = 0; rep < PROBE_SMALL; ++rep) phase_prep(p, (LAS float*)smem);
  for (int rep = 0; rep < PROBE_SMALL; ++rep) phase_x(p, 0);
  grid.sync();
  for (int chunk = 0; chunk < NCHUNK; ++chunk) {
    const int L = chunk < 2 ? 2048 : 4096, lshift = chunk < 2 ? 11 : 12;
    const float* xin = (chunk < 2) ? p.xp + (size_t)chunk * TC * DM : p.xs + (size_t)(chunk - 2) * TC * DM;
    float* xres = p.out + (size_t)chunk * TC * DM;
    float* ssq = p.ssq + (size_t)chunk * TC * 16;
    for (int layer = 0; layer < DEPTH; ++layer) {
      {
        for (int rep = 0; rep < PROBE_P1; ++rep) {
        { pg8::Gemm g{p.xb, p.wt_in + (size_t)layer * INW * DM, TC, UW, DM, 0, lshift};
          pg8::StaticOrder S; S.init(TC, UW, gridDim.x, blockIdx.x);
          EpiU E{p.u, ssq, p.b_gate + (size_t)layer * 3 * DM};
          pg8::gemm_phase(lds, g, S, E); }
        {
          pg8::Gemm g{p.wt_in + ((size_t)layer * INW + UW) * DM, p.xb, VW, TC, DM, 1, lshift};
          pg8::StaticOrder S; S.init(VW, TC, gridDim.x, (blockIdx.x + (gridDim.x >> 2)) % gridDim.x);
          EpiVT E{p.vt, ssq, L, lshift};
          pg8::gemm_phase(lds, g, S, E); }
        }
      }
      GSYNC();
      phase_attn(p, layer, L, lshift, lds);
      GSYNC();
      for (int rep = 0; rep < PROBE_SMALL; ++rep) phase_combine(p);
      GSYNC();
      {
        pg8::Gemm g{p.yg, p.wt_br + (size_t)layer * DM * YW, TC, DM, YW, 0, 0};
        pg8::StaticOrder S; S.init(TC, DM, gridDim.x, blockIdx.x);
        EpiMerge E{p.u, p.merged};
        for (int rep = 0; rep < PROBE_3A; ++rep) pg8::gemm_phase(lds, g, S, E);
      }
      GSYNC();
      {
        pg8::Gemm g{p.merged, p.wt_out + (size_t)layer * DM * DM, TC, DM, DM, 0, 0};
        pg8::StaticOrder S; S.init(TC, DM, gridDim.x, blockIdx.x);
        EpiRes E{layer == 0 ? xin : (const float*)xres, xres, p.xb, ssq};
        pg8::gemm_phase(lds, g, S, E);
        if (PROBE_3B > 1 && layer == 0) { for (int rep = 0; rep < 4 * (PROBE_3B - 1); ++rep) pg8::gemm_phase(lds, g, S, E); }
      }
      GSYNC();
    }
    phase_final(p, chunk);
    if (chunk + 1 < NCHUNK) { for (int rep = 0; rep < PROBE_SMALL; ++rep) phase_x(p, chunk + 1); GSYNC(); }
  }
}

extern "C" void kernel_launch(void* const* d_in, const int* in_sizes, int n_in, void* d_out, int out_size, void* d_ws, size_t ws_size, hipStream_t stream) {
  (void)in_sizes; (void)n_in; (void)out_size;
  static int grid_blocks = 0;
  if (!grid_blocks) {
    int dev = 0, cus = 0, per_cu = 0;
    hipGetDevice(&dev);
    hipDeviceGetAttribute(&cus, hipDeviceAttributeMultiprocessorCount, dev);
    hipOccupancyMaxActiveBlocksPerMultiprocessor(&per_cu, fwd_megakernel, 512, 0);
    if (per_cu < 1) per_cu = 1;
    grid_blocks = cus * per_cu;
    if (grid_blocks > 256) grid_blocks = 256;
  }
  Params p{};
  p.xp = (const float*)d_in[0]; p.xs = (const float*)d_in[1]; p.g_norm = (const float*)d_in[2]; p.w_in = (const float*)d_in[3];
  p.b_gate = (const float*)d_in[4]; p.rpb = (const float*)d_in[5]; p.lam_qk = (const float*)d_in[6]; p.g_diff = (const float*)d_in[7];
  p.w_br_a = (const float*)d_in[8]; p.w_br_b = (const float*)d_in[9]; p.w_br_c = (const float*)d_in[10]; p.w_out = (const float*)d_in[11];
  p.g_final = (const float*)d_in[12];
  p.out = (float*)d_out;
  char* w = (char*)d_ws; size_t off = 0;
  auto take = [&](size_t bytes) { char* r = w + off; off += (bytes + 255) & ~(size_t)255; return r; };
  p.wt_in = (bf16_t*)take((size_t)DEPTH * INW * DM * 2);
  p.wt_br = (bf16_t*)take((size_t)DEPTH * DM * YW * 2);
  p.wt_out = (bf16_t*)take((size_t)DEPTH * DM * DM * 2);
  p.xb = (bf16_t*)take((size_t)TC * DM * 2);
  p.u = (bf16_t*)take((size_t)TC * UW * 2);
  p.vt = (bf16_t*)take((size_t)TC * VW * 2);
  p.yg = (bf16_t*)take((size_t)TC * YW * 2);
  p.oc = (bf16_t*)take((size_t)TC * 768 * 2);
  p.merged = (bf16_t*)take((size_t)TC * DM * 2);
  p.lse = (float*)take((size_t)TC * 12 * 4);
  p.ssq = (float*)take((size_t)NTOK * 16 * 4);
  p.lam = (float*)take(256);
  p.bar = (unsigned*)take((size_t)XCD_BAR_WORDS * 4);
  if (off > ws_size) fprintf(stderr, "workspace too small: need %zu have %zu\n", off, ws_size);
  hipMemsetAsync(p.bar, 0, (size_t)XCD_BAR_WORDS * 4, stream);
  void* args[] = {&p};
  hipError_t e = hipLaunchCooperativeKernel((void*)fwd_megakernel, dim3(grid_blocks), dim3(512), args, 0, stream);
  if (e != hipSuccess) fprintf(stderr, "cooperative launch failed: %s (grid %d)\n", hipGetErrorString(e), grid_blocks);
}
```

```cpp
#include <hip/hip_runtime.h>
#include <hip/hip_cooperative_groups.h>
#include <cstdio>
namespace cg = cooperative_groups;
#ifndef PROBE_B
#define PROBE_B 1
#endif
#ifndef PROBE_AC
#define PROBE_AC 1
#endif
#ifndef PROBE_P1
#define PROBE_P1 1
#endif
#ifndef PROBE_3A
#define PROBE_3A 1
#endif
#ifndef PROBE_SMALL
#define PROBE_SMALL 1
#endif
#ifndef PROBE_3B
#define PROBE_3B 1
#endif
#ifndef PROBE_SYNC
#define PROBE_SYNC 1
#endif

#define LAS __attribute__((address_space(3)))
typedef unsigned short bf16_t;
typedef short bf16x8 __attribute__((ext_vector_type(8)));
typedef short bf16x4 __attribute__((ext_vector_type(4)));
typedef float f32x4 __attribute__((ext_vector_type(4)));
typedef float f32x16 __attribute__((ext_vector_type(16)));
typedef unsigned u32x4 __attribute__((ext_vector_type(4)));
typedef unsigned u32x2 __attribute__((ext_vector_type(2)));

constexpr int DM = 1024, DEPTH = 4, INW = 9728, UW = 7936, VW = 1792, YW = 1280;
constexpr int TC = 16384, NCHUNK = 4, NTOK = 65536;
constexpr float LOG2E = 1.4426950408889634f;
constexpr float QSCALE = 0.125f * LOG2E;
constexpr int U_QA = 0, U_KA = 512, U_ZA = 1024, U_QB = 1536, U_KB = 2048, U_ZB = 2560, U_QC = 3072, U_KC = 3840, U_ZC = 4608, U_GL = 4864;
constexpr int V_A = 0, V_B = 512, V_C = 1024;

struct Params {
  const float *xp, *xs, *g_norm, *w_in, *b_gate, *rpb, *lam_qk, *g_diff, *w_br_a, *w_br_b, *w_br_c, *w_out, *g_final;
  float* out;
  bf16_t *wt_in, *wt_br, *wt_out, *xb, *u, *vt, *yg, *oc, *merged;
  float *lse, *ssq, *lam;
  unsigned* bar;
};

__device__ __forceinline__ unsigned cvt_pk_bf16(float lo, float hi) { unsigned r; asm volatile("v_cvt_pk_bf16_f32 %0, %1, %2" : "=v"(r) : "v"(lo), "v"(hi)); return r; }
__device__ __forceinline__ float bf_lo(unsigned v) { return __uint_as_float(v << 16); }
__device__ __forceinline__ float bf_hi(unsigned v) { return __uint_as_float(v & 0xffff0000u); }
__device__ __forceinline__ float fexp2(float x) { return __builtin_amdgcn_exp2f(x); }
__device__ __forceinline__ float frcp(float x) { return __builtin_amdgcn_rcpf(x); }

__shared__ int g_wid_table[64];
__device__ __forceinline__ unsigned hw_wave_slot() { return (unsigned)__builtin_amdgcn_s_getreg(((6 - 1) << 11) | (0 << 6) | 4) & 63u; }
__device__ __forceinline__ int opaque_tid() {
  const int wid = __builtin_amdgcn_readfirstlane(g_wid_table[hw_wave_slot()]);
  unsigned z = 0u; asm volatile("" : "+v"(z));
  int t = wid * 64 + (int)__builtin_amdgcn_mbcnt_hi(~0u, __builtin_amdgcn_mbcnt_lo(~0u, z));
  asm volatile("" : "+v"(t)); return t;
}

namespace pg8 {
constexpr int BM = 256, BK = 64, HALF = 128, HTB = HALF * BK * 2, STAGE_BYTES = 8 * HTB, NXCD = 8, WGM = 8;
__device__ __forceinline__ int lds_byte(int r, int c) { const int st = (r >> 4) * 2 + (c >> 5), rr = r & 15, cc = c & 31, ob = rr * 64 + cc * 2; return st * 1024 + (ob ^ (((ob >> 9) & 1) << 5)); }
__device__ __forceinline__ void stage_rc(int b, int& R, int& C) { const int st = b / 1024, sb = b % 1024, swz = sb ^ (((sb >> 9) & 1) << 5); R = (st >> 1) * 16 + swz / 64; C = (st & 1) * 32 + (swz % 64) / 2; }
__device__ __forceinline__ int perm32(int rho) { const int n = rho >> 4, i = rho & 15; return 8 * (i >> 2) + 4 * n + (i & 3); }
struct Unit { int pm, pn; };
struct Gemm { const bf16_t* A; const bf16_t* Bt; int M, N, K; int bperm, lshift; };
struct StaticOrder {
  int nM, nN, nwg, G, c;
  __device__ void init(int M, int N, int G_, int c_) { nM = M / BM; nN = N / BM; nwg = nM * nN; G = G_; c = c_; }
  __device__ bool next(int i, Unit& u) const {
    const long L = (long)i * G + c; if (L >= nwg) return false;
    int wgid = (int)L; { const int q = nwg / NXCD, r = nwg % NXCD, xcd = wgid % NXCD, off = wgid / NXCD; wgid = (xcd < r ? xcd * (q + 1) : r * (q + 1) + (xcd - r) * q) + off; }
    const int nig = WGM * nN, gid = wgid / nig, fm = gid * WGM, gsz = (nM - fm) < WGM ? (nM - fm) : WGM;
    u.pm = fm + ((wgid % nig) % gsz); u.pn = (wgid % nig) / gsz; return true;
  }
};

template <class Epi>
__device__ __forceinline__ void gemm_phase(LAS unsigned char* lds, const Gemm g, const StaticOrder& S, const Epi& E) {
  const int tid_ = opaque_tid();
  const int tid = tid_, wid = __builtin_amdgcn_readfirstlane(tid >> 6), lane = tid & 63, wr = wid >> 2, wc = wid & 3, fr = lane & 15, fq = lane >> 4;
  const int K = g.K, nt = K / BK;
  const size_t kstep = (size_t)(BK * 2);
  const size_t hstep = (size_t)HALF * K * 2;
  const size_t tstep = 2 * hstep;
  unsigned voffA[2], voffBr[2], voffBc[2], voffB[2], voffBn[2];
#pragma unroll
  for (int i = 0; i < 2; ++i) { int R, C; stage_rc(tid * 16 + i * 8192, R, C); const int Rb = (R & ~31) + perm32(R & 31);
    voffA[i] = (unsigned)(R * K + C) * 2u; voffBr[i] = (unsigned)(Rb * K) * 2u; voffBc[i] = (unsigned)C * 2u; voffB[i] = voffBr[i] + voffBc[i]; voffBn[i] = voffB[i]; }
  auto bbase = [&](const Unit& u, int hh, int& sh) -> const char* {
    if (!g.bperm) { sh = 0; return (const char*)g.Bt + (size_t)u.pn * tstep + (size_t)hh * hstep; }
    const int ds = u.pm <= 4 ? 0 : (u.pm == 5 ? 2 : 4); sh = ds;
    const int L = 1 << g.lshift; const int p0 = u.pn * 256 + hh * 128, seq = p0 >> g.lshift, p = p0 & (L - 1);
    const int Mc = L >> ds, r = p / Mc, m0 = p & (Mc - 1);
    return (const char*)g.Bt + ((size_t)seq * L + ((size_t)m0 << ds) + r) * (size_t)K * 2;
  };
  const unsigned ldsw = (unsigned)wid * 1024u;
  const int aoff = lds_byte(wr * 64 + fr, fq * 8), boff = lds_byte(wc * 32 + fr, fq * 8);
#define PG8_SA(b, h) (((b) * 2 + (h)) * HTB)
#define PG8_SB(b, h) ((4 + (b) * 2 + (h)) * HTB)
#define PG8_STAGE(bufoff, gbase, voff) do { _Pragma("unroll") for (int _i = 0; _i < 2; ++_i) \
    __builtin_amdgcn_global_load_lds((const unsigned*)((const char*)(gbase) + (voff)[_i]), (LAS unsigned*)(lds + (bufoff) + ldsw + _i * 8192), 16, 0, 0); } while (0)
#define PG8_LDA(dst, b, h) do { _Pragma("unroll") for (int m = 0; m < 4; ++m) _Pragma("unroll") for (int k = 0; k < 2; ++k) dst[m][k] = *(const LAS bf16x8*)(lds + PG8_SA(b, h) + aoff + m * 2048 + k * 1024); } while (0)
#define PG8_LDB(dst, b, h) do { _Pragma("unroll") for (int n = 0; n < 2; ++n) _Pragma("unroll") for (int k = 0; k < 2; ++k) dst[n][k] = *(const LAS bf16x8*)(lds + PG8_SB(b, h) + boff + n * 2048 + k * 1024); } while (0)
#define PG8_MMA(ai, bj, At, Bt) do { __builtin_amdgcn_s_setprio(1); _Pragma("unroll") for (int m = 0; m < 4; ++m) _Pragma("unroll") for (int n = 0; n < 2; ++n) _Pragma("unroll") for (int k = 0; k < 2; ++k) \
    acc[ai][bj][m][n] = __builtin_amdgcn_mfma_f32_16x16x32_bf16(Bt[n][k], At[m][k], acc[ai][bj][m][n], 0, 0, 0); __builtin_amdgcn_s_setprio(0); } while (0)
#define PG8_WAIT_V(n) asm volatile("s_waitcnt vmcnt(" #n ")" ::: "memory")
#define PG8_WAIT_L(n) asm volatile("s_waitcnt lgkmcnt(" #n ")" ::: "memory")
#define PG8_BAR __builtin_amdgcn_s_barrier()
#define PG8_SCHED __builtin_amdgcn_sched_barrier(0)
  Unit cur, nxt; int ui = 0;
  if (!S.next(0, cur)) return;
  f32x4 acc[2][2][4][2];
#pragma unroll
  for (int a = 0; a < 2; ++a)
#pragma unroll
    for (int b = 0; b < 2; ++b)
#pragma unroll
      for (int m = 0; m < 4; ++m)
#pragma unroll
        for (int n = 0; n < 2; ++n) acc[a][b][m][n] = (f32x4){0.f, 0.f, 0.f, 0.f};
  bf16x8 At[4][2], B0[2][2], B1[2][2];
  const char* cA = (const char*)g.A + (size_t)cur.pm * tstep;
  int csh; const char* cB0 = bbase(cur, 0, csh); const char* cB1 = bbase(cur, 1, csh);
#pragma unroll
  for (int i = 0; i < 2; ++i) voffB[i] = (voffBr[i] << csh) + voffBc[i];
  PG8_STAGE(PG8_SB(0, 0), cB0, voffB); PG8_STAGE(PG8_SA(0, 0), cA, voffA); PG8_STAGE(PG8_SB(0, 1), cB1, voffB); PG8_STAGE(PG8_SA(0, 1), cA + hstep, voffA);
  if (wr == 1) PG8_BAR;
  PG8_WAIT_V(4); PG8_BAR;
  PG8_STAGE(PG8_SB(1, 0), cB0 + kstep, voffB); PG8_STAGE(PG8_SA(1, 0), cA + kstep, voffA); PG8_STAGE(PG8_SB(1, 1), cB1 + kstep, voffB);
  PG8_WAIT_V(6); PG8_BAR;
  for (;;) {
    const bool has_next = S.next(ui + 1, nxt);
    const char* nA = cA; const char* nB0 = cB0; const char* nB1 = cB1;
#pragma unroll
    for (int i = 0; i < 2; ++i) voffBn[i] = voffB[i];
    if (has_next) { int nsh; nA = (const char*)g.A + (size_t)nxt.pm * tstep; nB0 = bbase(nxt, 0, nsh); nB1 = bbase(nxt, 1, nsh);
#pragma unroll
      for (int i = 0; i < 2; ++i) voffBn[i] = (voffBr[i] << nsh) + voffBc[i]; }
    for (int t = 0; t < nt; t += 2) {
      if constexpr (Epi::HOOK) { if (t == 8 || t == 16) E.hook(acc, cur, t, wr, wc, fr, fq); }
      const bool last = (t == nt - 2);
      const char* a1 = cA + (size_t)(t + 1) * kstep;
      const char* a2 = last ? nA : cA + (size_t)(t + 2) * kstep;
      const char* b20 = last ? nB0 : cB0 + (size_t)(t + 2) * kstep; const char* b21 = last ? nB1 : cB1 + (size_t)(t + 2) * kstep;
      const char* a3 = a2 + kstep; const char* b30 = b20 + kstep; const char* b31 = b21 + kstep;
      unsigned vB[2];
#pragma unroll
      for (int i = 0; i < 2; ++i) vB[i] = last ? voffBn[i] : voffB[i];
      PG8_LDB(B0, 0, 0); PG8_SCHED; PG8_LDA(At, 0, 0); PG8_STAGE(PG8_SA(1, 1), a1 + hstep, voffA);
      PG8_WAIT_L(8); PG8_BAR; PG8_WAIT_L(0); PG8_MMA(0, 0, At, B0); PG8_BAR; PG8_SCHED;
      PG8_LDB(B1, 0, 1); PG8_STAGE(PG8_SB(0, 0), b20, vB);
      PG8_BAR; PG8_WAIT_L(0); PG8_MMA(0, 1, At, B1); PG8_BAR;
      PG8_LDA(At, 0, 1); PG8_STAGE(PG8_SA(0, 0), a2, voffA);
      PG8_BAR; PG8_WAIT_L(0); PG8_MMA(1, 0, At, B0); PG8_BAR; PG8_SCHED;
      PG8_STAGE(PG8_SB(0, 1), b21, vB);
      PG8_WAIT_V(6); PG8_BAR; PG8_MMA(1, 1, At, B1); PG8_BAR;
      PG8_LDB(B0, 1, 0); PG8_SCHED; PG8_LDA(At, 1, 0); PG8_STAGE(PG8_SA(0, 1), a2 + hstep, voffA);
      PG8_WAIT_L(8); PG8_BAR; PG8_WAIT_L(0); PG8_MMA(0, 0, At, B0); PG8_BAR; PG8_SCHED;
      PG8_LDB(B1, 1, 1); PG8_STAGE(PG8_SB(1, 0), b30, vB);
      PG8_BAR; PG8_WAIT_L(0); PG8_MMA(0, 1, At, B1); PG8_BAR;
      PG8_LDA(At, 1, 1); PG8_STAGE(PG8_SA(1, 0), a3, voffA);
      PG8_BAR; PG8_WAIT_L(0); PG8_MMA(1, 0, At, B0); PG8_BAR; PG8_SCHED;
      PG8_STAGE(PG8_SB(1, 1), b31, vB);
      PG8_WAIT_V(6); PG8_BAR; PG8_MMA(1, 1, At, B1); PG8_BAR;
    }
    E(acc, cur, wr, wc, fr, fq);
    if (!has_next) break;
#pragma unroll
    for (int a = 0; a < 2; ++a)
#pragma unroll
      for (int b = 0; b < 2; ++b)
#pragma unroll
        for (int m = 0; m < 4; ++m)
#pragma unroll
          for (int n = 0; n < 2; ++n) acc[a][b][m][n] = (f32x4){0.f, 0.f, 0.f, 0.f};
    cur = nxt; cA = nA; cB0 = nB0; cB1 = nB1; ++ui;
#pragma unroll
    for (int i = 0; i < 2; ++i) voffB[i] = voffBn[i];
  }
  PG8_WAIT_V(0);
  if (wr == 0) PG8_BAR;
  PG8_BAR;
#undef PG8_SA
#undef PG8_SB
#undef PG8_STAGE
#undef PG8_LDA
#undef PG8_LDB
#undef PG8_MMA
#undef PG8_WAIT_V
#undef PG8_WAIT_L
#undef PG8_BAR
#undef PG8_SCHED
}
}
using pg8::Unit;

struct EpiU {
  static constexpr bool HOOK = false;
  bf16_t* U; const float* ssq; const float* bg;
  __device__ __forceinline__ void hook(f32x4 (&)[2][2][4][2], const Unit&, int, int, int, int, int) const {}
  __device__ __forceinline__ void operator()(const f32x4 (&acc)[2][2][4][2], const Unit& u, int wr, int wc, int fr, int fq) const {
    asm volatile("" : "+v"(fr), "+v"(fq));
    const int row0 = u.pm * 256 + wr * 64 + fr, col0 = u.pn * 256 + wc * 32 + 8 * fq;
    const bool isg = (u.pn >= 19);
#pragma unroll
    for (int ai = 0; ai < 2; ++ai)
#pragma unroll
      for (int m = 0; m < 4; ++m) {
        const int row = row0 + ai * 128 + m * 16;
        const f32x4* sp = (const f32x4*)(ssq + (size_t)row * 16);
        const f32x4 a4 = sp[0] + sp[1] + sp[2] + sp[3];
        const float rinv = rsqrtf((a4[0] + a4[1] + a4[2] + a4[3]) * (1.0f / 1024.0f) + 1e-6f);
        if (isg) {
#pragma unroll
          for (int bj = 0; bj < 2; ++bj) {
            const float* bp = bg + (col0 - U_GL) + bj * 128;
            const f32x4 b0 = *(const f32x4*)bp, b1 = *(const f32x4*)(bp + 4);
            f32x4 v0 = acc[ai][bj][m][0] * rinv + b0, v1 = acc[ai][bj][m][1] * rinv + b1;
#pragma unroll
            for (int j = 0; j < 4; ++j) { v0[j] = 1.0f + fminf(fexp2(-v0[j] * LOG2E), 1e30f); v1[j] = 1.0f + fminf(fexp2(-v1[j] * LOG2E), 1e30f); }
            u32x4 pk = {cvt_pk_bf16(v0[0], v0[1]), cvt_pk_bf16(v0[2], v0[3]), cvt_pk_bf16(v1[0], v1[1]), cvt_pk_bf16(v1[2], v1[3])};
            *(u32x4*)(U + (size_t)row * UW + col0 + bj * 128) = pk;
          }
        } else {
#pragma unroll
          for (int bj = 0; bj < 2; ++bj) {
            const f32x4 v0 = acc[ai][bj][m][0] * rinv, v1 = acc[ai][bj][m][1] * rinv;
            u32x4 pk = {cvt_pk_bf16(v0[0], v0[1]), cvt_pk_bf16(v0[2], v0[3]), cvt_pk_bf16(v1[0], v1[1]), cvt_pk_bf16(v1[2], v1[3])};
            *(u32x4*)(U + (size_t)row * UW + col0 + bj * 128) = pk;
          }
        }
      }
  }
};

struct EpiVT {
  static constexpr bool HOOK = false;
  bf16_t* VT; const float* ssq; int L, lshift;
  __device__ __forceinline__ void hook(f32x4 (&)[2][2][4][2], const Unit&, int, int, int, int, int) const {}
  __device__ __forceinline__ void operator()(const f32x4 (&acc)[2][2][4][2], const Unit& u, int wr, int wc, int fr, int fq) const {
    asm volatile("" : "+v"(fr), "+v"(fq));
    const int vrow0 = u.pm * 256 + wr * 64 + fr, pcol0 = u.pn * 256 + wc * 32 + 8 * fq;
    const int ds = u.pm <= 4 ? 0 : (u.pm == 5 ? 2 : 4);
    const int Mc = L >> ds;
#pragma unroll
    for (int bj = 0; bj < 2; ++bj) {
      const int p0 = pcol0 + bj * 128, seq = p0 >> lshift, pos = p0 & (L - 1);
      const int r = pos / Mc, m0 = pos & (Mc - 1);
      float rinv[8];
#pragma unroll
      for (int j = 0; j < 8; ++j) {
        const int tok = (seq << lshift) + ((m0 + j) << ds) + r;
        const f32x4* sp = (const f32x4*)(ssq + (size_t)tok * 16);
        const f32x4 a4 = sp[0] + sp[1] + sp[2] + sp[3];
        rinv[j] = rsqrtf((a4[0] + a4[1] + a4[2] + a4[3]) * (1.0f / 1024.0f) + 1e-6f);
      }
      bf16_t* vb = VT + ((size_t)seq * VW + vrow0) * L + pos;
#pragma unroll
      for (int ai = 0; ai < 2; ++ai)
#pragma unroll
        for (int m = 0; m < 4; ++m) {
          const f32x4 v0 = acc[ai][bj][m][0], v1 = acc[ai][bj][m][1];
          u32x4 pk = {cvt_pk_bf16(v0[0] * rinv[0], v0[1] * rinv[1]), cvt_pk_bf16(v0[2] * rinv[2], v0[3] * rinv[3]),
                      cvt_pk_bf16(v1[0] * rinv[4], v1[1] * rinv[5]), cvt_pk_bf16(v1[2] * rinv[6], v1[3] * rinv[7])};
          *(u32x4*)(vb + (size_t)(ai * 128 + m * 16) * L) = pk;
        }
    }
  }
};

struct EpiMerge {
  static constexpr bool HOOK = true;
  const bf16_t* U; bf16_t* MG;
  __device__ __forceinline__ f32x4 gvec(int i, size_t row, int col) const {
    const u32x2 raw = *(const u32x2*)(U + row * UW + U_GL + i * 1024 + col);
    f32x4 e; e[0] = bf_lo(raw[0]); e[1] = bf_hi(raw[0]); e[2] = bf_lo(raw[1]); e[3] = bf_hi(raw[1]); return e;
  }
  __device__ __forceinline__ void hook(f32x4 (&acc)[2][2][4][2], const Unit& u, int t, int wr, int wc, int fr, int fq) const {
    const int i = (t == 8) ? 0 : 1;
    asm volatile("" : "+v"(fr), "+v"(fq));
    const int row0 = u.pm * 256 + wr * 64 + fr, col0 = u.pn * 256 + wc * 32 + 8 * fq;
#pragma unroll
    for (int ai = 0; ai < 2; ++ai) {
#pragma unroll
      for (int m = 0; m < 4; ++m)
#pragma unroll
        for (int bj = 0; bj < 2; ++bj) {
          const bf16_t* gp = U + (size_t)(row0 + ai * 128 + m * 16) * UW + U_GL + i * 1024 + col0 + bj * 128;
          const u32x4 a = *(const u32x4*)gp, b = *(const u32x4*)(gp + 1024);
#pragma unroll
          for (int n = 0; n < 2; ++n) {
            f32x4 r;
            r[0] = bf_lo(b[2 * n]) * frcp(bf_lo(a[2 * n])); r[1] = bf_hi(b[2 * n]) * frcp(bf_hi(a[2 * n]));
            r[2] = bf_lo(b[2 * n + 1]) * frcp(bf_lo(a[2 * n + 1])); r[3] = bf_hi(b[2 * n + 1]) * frcp(bf_hi(a[2 * n + 1]));
            acc[ai][bj][m][n] *= r;
          }
        }
      __builtin_amdgcn_sched_barrier(0);
    }
  }
  __device__ __forceinline__ void operator()(const f32x4 (&acc)[2][2][4][2], const Unit& u, int wr, int wc, int fr, int fq) const {
    asm volatile("" : "+v"(fr), "+v"(fq));
    const int row0 = u.pm * 256 + wr * 64 + fr, col0 = u.pn * 256 + wc * 32 + 8 * fq;
#pragma unroll
    for (int ai = 0; ai < 2; ++ai)
#pragma unroll
      for (int m = 0; m < 4; ++m)
#pragma unroll
        for (int bj = 0; bj < 2; ++bj) {
          const size_t row = (size_t)(row0 + ai * 128 + m * 16); const int col = col0 + bj * 128;
          const f32x4 e0 = gvec(2, row, col), e1 = gvec(2, row, col + 4);
          f32x4 v0 = acc[ai][bj][m][0], v1 = acc[ai][bj][m][1];
#pragma unroll
          for (int j = 0; j < 4; ++j) { v0[j] *= frcp(e0[j]); v1[j] *= frcp(e1[j]); }
          u32x4 pk = {cvt_pk_bf16(v0[0], v0[1]), cvt_pk_bf16(v0[2], v0[3]), cvt_pk_bf16(v1[0], v1[1]), cvt_pk_bf16(v1[2], v1[3])};
          *(u32x4*)(MG + row * DM + col) = pk;
        }
  }
};

struct EpiRes {
  static constexpr bool HOOK = false;
  const float* R; float* X; bf16_t* XB; float* ssq;
  __device__ __forceinline__ void hook(f32x4 (&)[2][2][4][2], const Unit&, int, int, int, int, int) const {}
  __device__ __forceinline__ void operator()(const f32x4 (&acc)[2][2][4][2], const Unit& u, int wr, int wc, int fr, int fq) const {
    asm volatile("" : "+v"(fr), "+v"(fq));
    const int row0 = u.pm * 256 + wr * 64 + fr, col0 = u.pn * 256 + wc * 32 + 8 * fq;
#pragma unroll
    for (int ai = 0; ai < 2; ++ai)
#pragma unroll
      for (int m = 0; m < 4; ++m) {
        const size_t row = (size_t)(row0 + ai * 128 + m * 16);
        float s = 0.f;
#pragma unroll
        for (int bj = 0; bj < 2; ++bj) {
          const int col = col0 + bj * 128;
          const f32x4 r0 = *(const f32x4*)(R + row * DM + col), r1 = *(const f32x4*)(R + row * DM + col + 4);
          const f32x4 v0 = r0 + acc[ai][bj][m][0], v1 = r1 + acc[ai][bj][m][1];
          *(f32x4*)(X + row * DM + col) = v0; *(f32x4*)(X + row * DM + col + 4) = v1;
          s += v0[0] * v0[0] + v0[1] * v0[1] + v0[2] * v0[2] + v0[3] * v0[3] + v1[0] * v1[0] + v1[1] * v1[1] + v1[2] * v1[2] + v1[3] * v1[3];
          u32x4 pk = {cvt_pk_bf16(v0[0], v0[1]), cvt_pk_bf16(v0[2], v0[3]), cvt_pk_bf16(v1[0], v1[1]), cvt_pk_bf16(v1[2], v1[3])};
          *(u32x4*)(XB + row * DM + col) = pk;
        }
        s += __shfl_xor(s, 16); s += __shfl_xor(s, 32);
        if (fq == 0) ssq[row * 16 + u.pn * 4 + wc] = s;
      }
  }
};

__device__ __forceinline__ void prep_tile(const float* src, int ldn, int k0, int n0, const float* rscale, float cscale, bf16_t* dst, int ldd, int drow0, int dk0, LAS float* tile) {
  const int tid = opaque_tid(), kk = tid >> 6, nn = tid & 63;
#pragma unroll
  for (int i = 0; i < 8; ++i) {
    const int k = kk * 8 + i;
    float v = src[(size_t)(k0 + k) * ldn + n0 + nn] * cscale;
    if (rscale) v *= rscale[k0 + k];
    tile[k * 65 + nn] = v;
  }
  __syncthreads();
  const int n = tid >> 3, kc = tid & 7;
  float f[8];
#pragma unroll
  for (int j = 0; j < 8; ++j) f[j] = tile[(kc * 8 + j) * 65 + n];
  u32x4 pk = {cvt_pk_bf16(f[0], f[1]), cvt_pk_bf16(f[2], f[3]), cvt_pk_bf16(f[4], f[5]), cvt_pk_bf16(f[6], f[7])};
  *(u32x4*)(dst + (size_t)(drow0 + n) * ldd + dk0 + kc * 8) = pk;
  __syncthreads();
}

__device__ __forceinline__ void win_map(int n0, int& dn0, float& sc) {
  sc = 1.0f;
  if (n0 < 512) { dn0 = U_QA + n0; sc = QSCALE; }
  else if (n0 < 1024) dn0 = U_KA + (n0 - 512);
  else if (n0 < 1536) dn0 = UW + V_A + (n0 - 1024);
  else if (n0 < 2048) dn0 = U_ZA + (n0 - 1536);
  else if (n0 < 2560) { dn0 = U_QB + (n0 - 2048); sc = QSCALE; }
  else if (n0 < 3072) dn0 = U_KB + (n0 - 2560);
  else if (n0 < 3584) dn0 = UW + V_B + (n0 - 3072);
  else if (n0 < 4096) dn0 = U_ZB + (n0 - 3584);
  else if (n0 < 4864) { dn0 = U_QC + (n0 - 4096); sc = QSCALE; }
  else if (n0 < 5632) dn0 = U_KC + (n0 - 4864);
  else if (n0 < 6400) dn0 = UW + V_C + (n0 - 5632);
  else if (n0 < 6656) dn0 = U_ZC + (n0 - 6400);
  else dn0 = U_GL + (n0 - 6656);
}

__device__ void phase_prep(const Params& p, LAS float* tile) {
  constexpr int PER = 3008;
  for (int it = blockIdx.x; it < DEPTH * PER; it += gridDim.x) {
    const int l = it / PER; int r = it % PER;
    if (r < 2432) {
      const int kt = r / 152, ntile = r % 152; int dn0; float sc; win_map(ntile * 64, dn0, sc);
      prep_tile(p.w_in + (size_t)l * DM * INW, INW, kt * 64, ntile * 64, p.g_norm + l * DM, sc, p.wt_in + (size_t)l * INW * DM, DM, dn0, kt * 64, tile);
    } else if ((r -= 2432) < 128) {
      const int kt = r / 16, ntile = r % 16;
      prep_tile(p.w_br_a + (size_t)l * 512 * DM, DM, kt * 64, ntile * 64, nullptr, 1.0f, p.wt_br + (size_t)l * DM * YW, YW, ntile * 64, kt * 64, tile);
    } else if ((r -= 128) < 128) {
      const int kt = r / 16, ntile = r % 16;
      prep_tile(p.w_br_b + (size_t)l * 512 * DM, DM, kt * 64, ntile * 64, nullptr, 1.0f, p.wt_br + (size_t)l * DM * YW, YW, ntile * 64, 512 + kt * 64, tile);
    } else if ((r -= 128) < 64) {
      const int kt = r / 16, ntile = r % 16;
      prep_tile(p.w_br_c + (size_t)l * 256 * DM, DM, kt * 64, ntile * 64, nullptr, 1.0f, p.wt_br + (size_t)l * DM * YW, YW, ntile * 64, 1024 + kt * 64, tile);
    } else {
      r -= 64; const int kt = r / 16, ntile = r % 16;
      prep_tile(p.w_out + (size_t)l * DM * DM, DM, kt * 64, ntile * 64, nullptr, 1.0f, p.wt_out + (size_t)l * DM * DM, DM, ntile * 64, kt * 64, tile);
    }
  }
  const int ptid = opaque_tid();
  if (blockIdx.x == 0 && ptid < 64) {
    const int lane = ptid;
    for (int l = 0; l < DEPTH; ++l) {
      const float* lq = p.lam_qk + l * 256;
      float a = lq[lane] * lq[64 + lane], b = lq[128 + lane] * lq[192 + lane];
      for (int o = 32; o >= 1; o >>= 1) { a += __shfl_xor(a, o); b += __shfl_xor(b, o); }
      if (lane == 0) { const float li = 0.8f - 0.6f * expf(-0.3f * (float)l); p.lam[l] = expf(a) - expf(b) + li; p.lam[4 + l] = 1.0f - li; }
    }
  }
}

__device__ void phase_x(const Params& p, int chunk) {
  const float* xin = (chunk < 2) ? p.xp + (size_t)chunk * TC * DM : p.xs + (size_t)(chunk - 2) * TC * DM;
  float* ssq = p.ssq + (size_t)chunk * TC * 16;
  const int tid = opaque_tid(), lane = tid & 63, w = blockIdx.x * 8 + (tid >> 6), nw = gridDim.x * 8;
  for (int row = w; row < TC; row += nw) {
    const float* xr = xin + (size_t)row * DM + lane * 16;
    f32x4 v[4]; float s = 0.f;
#pragma unroll
    for (int i = 0; i < 4; ++i) { v[i] = *(const f32x4*)(xr + i * 4); s += v[i][0] * v[i][0] + v[i][1] * v[i][1] + v[i][2] * v[i][2] + v[i][3] * v[i][3]; }
    for (int o = 32; o >= 1; o >>= 1) s += __shfl_xor(s, o);
    u32x4 p0 = {cvt_pk_bf16(v[0][0], v[0][1]), cvt_pk_bf16(v[0][2], v[0][3]), cvt_pk_bf16(v[1][0], v[1][1]), cvt_pk_bf16(v[1][2], v[1][3])};
    u32x4 p1 = {cvt_pk_bf16(v[2][0], v[2][1]), cvt_pk_bf16(v[2][2], v[2][3]), cvt_pk_bf16(v[3][0], v[3][1]), cvt_pk_bf16(v[3][2], v[3][3])};
    bf16_t* xo = p.xb + (size_t)row * DM + lane * 16;
    *(u32x4*)xo = p0; *(u32x4*)(xo + 8) = p1;
    if (lane < 16) ssq[(size_t)row * 16 + lane] = (lane == 0) ? s : 0.f;
  }
}

__device__ void phase_final(const Params& p, int chunk) {
  float* x = p.out + (size_t)chunk * TC * DM;
  const float* ssq = p.ssq + (size_t)chunk * TC * 16;
  const int tid = opaque_tid(), lane = tid & 63, w = blockIdx.x * 8 + (tid >> 6), nw = gridDim.x * 8;
  for (int row = w; row < TC; row += nw) {
    const f32x4* sp = (const f32x4*)(ssq + (size_t)row * 16);
    const f32x4 a4 = sp[0] + sp[1] + sp[2] + sp[3];
    const float rinv = rsqrtf((a4[0] + a4[1] + a4[2] + a4[3]) * (1.0f / 1024.0f) + 1e-6f);
    float* xr = x + (size_t)row * DM + lane * 16;
#pragma unroll
    for (int i = 0; i < 4; ++i) { f32x4 v = *(const f32x4*)(xr + i * 4); const f32x4 g = *(const f32x4*)(p.g_final + lane * 16 + i * 4); v = v * rinv * g; *(f32x4*)(xr + i * 4) = v; }
  }
}

__device__ __forceinline__ f32x16 mfma32(bf16x8 a, bf16x8 b, f32x16 c) { return __builtin_amdgcn_mfma_f32_32x32x16_bf16(a, b, c, 0, 0, 0); }
__device__ __forceinline__ bf16x8 ld16(const bf16_t* p) { return *(const bf16x8*)p; }
__device__ __forceinline__ bf16x8 ld8x2(const bf16_t* p0, const bf16_t* p1) { const bf16x4 a = *(const bf16x4*)p0, b = *(const bf16x4*)p1; return __builtin_shufflevector(a, b, 0, 1, 2, 3, 4, 5, 6, 7); }

__device__ __forceinline__ void softmax_tile(f32x16& t, float& m, float& l, float& alpha, bf16x8& p0, bf16x8& p1) {
  float tm = t[0];
#pragma unroll
  for (int i = 1; i < 16; ++i) tm = fmaxf(tm, t[i]);
  tm = fmaxf(tm, __shfl_xor(tm, 32));
  const float mn = fmaxf(m, tm);
  alpha = fexp2(m - mn); m = mn;
  float ls = 0.f;
#pragma unroll
  for (int i = 0; i < 16; ++i) { t[i] = fexp2(t[i] - mn); ls += t[i]; }
  l = l * alpha + ls;
  const u32x4 a = {cvt_pk_bf16(t[0], t[1]), cvt_pk_bf16(t[2], t[3]), cvt_pk_bf16(t[4], t[5]), cvt_pk_bf16(t[6], t[7])};
  const u32x4 b = {cvt_pk_bf16(t[8], t[9]), cvt_pk_bf16(t[10], t[11]), cvt_pk_bf16(t[12], t[13]), cvt_pk_bf16(t[14], t[15])};
  p0 = __builtin_bit_cast(bf16x8, a); p1 = __builtin_bit_cast(bf16x8, b);
}
__device__ __forceinline__ f32x16 zero16() { f32x16 z;
#pragma unroll
  for (int i = 0; i < 16; ++i) z[i] = 0.f; return z; }
__device__ __forceinline__ float silu(float z) { return z * frcp(1.0f + fexp2(-z * LOG2E)); }

constexpr int TB_ROW = 144;
constexpr int KB_BYTES = 64 * TB_ROW;
constexpr int VB_BYTES = 128 * TB_ROW;
constexpr int LDS_K = 0, LDS_V = LDS_K + 2 * KB_BYTES, LDS_ATT_END = LDS_V + 2 * VB_BYTES, LDS_ATT_TOTAL = LDS_ATT_END + 65536;
template <int SIDE>
__device__ __forceinline__ void b_far_subtile(const LAS unsigned char* kb, const LAS unsigned char* vb, int rd, int sub, const bf16x8 (&qf)[4], const f32x16& bp, float slope2, float d0,
                                              float& mrun, float& lrun, f32x16 (&o)[4]) {
  const float base = (SIDE > 0 ? -slope2 : slope2) * d0 - mrun;
  f32x16 sc;
#pragma unroll
  for (int i = 0; i < 16; ++i) sc[i] = SIDE > 0 ? base - bp[i] : base + bp[i];
#pragma unroll
  for (int ks = 0; ks < 4; ++ks) sc = mfma32(*(const LAS bf16x8*)(kb + rd + sub * 32 * TB_ROW + ks * 32), qf[ks], sc);
  float tm = sc[0];
#pragma unroll
  for (int i = 1; i < 16; ++i) tm = fmaxf(tm, sc[i]);
  tm = fmaxf(tm, __shfl_xor(tm, 32));
  if (__builtin_amdgcn_ballot_w64(tm > 0.0f) != 0) {
    const float delta = fmaxf(tm, 0.0f);
    const float al = fexp2(-delta);
    mrun += delta; lrun *= al;
#pragma unroll
    for (int i = 0; i < 16; ++i) sc[i] -= delta;
#pragma unroll
    for (int dt = 0; dt < 4; ++dt) o[dt] *= al;
  }
#pragma unroll
  for (int i = 0; i < 16; ++i) sc[i] = fexp2(sc[i]);
  { const f32x4 a4 = (f32x4){sc[0], sc[1], sc[2], sc[3]} + (f32x4){sc[4], sc[5], sc[6], sc[7]} + (f32x4){sc[8], sc[9], sc[10], sc[11]} + (f32x4){sc[12], sc[13], sc[14], sc[15]};
    lrun += (a4[0] + a4[1]) + (a4[2] + a4[3]); }
  const u32x4 pa = {cvt_pk_bf16(sc[0], sc[1]), cvt_pk_bf16(sc[2], sc[3]), cvt_pk_bf16(sc[4], sc[5]), cvt_pk_bf16(sc[6], sc[7])};
  const u32x4 pb = {cvt_pk_bf16(sc[8], sc[9]), cvt_pk_bf16(sc[10], sc[11]), cvt_pk_bf16(sc[12], sc[13]), cvt_pk_bf16(sc[14], sc[15])};
  const bf16x8 pk0 = __builtin_bit_cast(bf16x8, pa), pk1 = __builtin_bit_cast(bf16x8, pb);
#pragma unroll
  for (int dt = 0; dt < 4; ++dt) {
    o[dt] = mfma32(*(const LAS bf16x8*)(vb + rd + dt * 32 * TB_ROW + (sub * 2) * 32), pk0, o[dt]);
    o[dt] = mfma32(*(const LAS bf16x8*)(vb + rd + dt * 32 * TB_ROW + (sub * 2 + 1) * 32), pk1, o[dt]);
  }
}

__device__ __forceinline__ void attn_b_pass(const Params& p, int L, int seq, int h, int mp, int qblk, int tq, int tid, float slope2, LAS unsigned char* lds, f32x16 (&o)[4], float& linv) {
  const int lane = tid & 63, q = lane & 31, half = lane >> 5;
  const size_t tokbase = (size_t)seq * L;
  bf16x8 qf[4];
  { const bf16_t* qp = p.u + (tokbase + tq) * UW + U_QB + h * 128 + mp * 64 + half * 8;
#pragma unroll
    for (int ks = 0; ks < 4; ++ks) qf[ks] = ld16(qp + ks * 16); }
  const int spart = tid & 7, srow = tid >> 3;
  const bf16_t* kg = p.u + (tokbase + srow) * UW + U_KB + h * 128 + mp * 64 + spart * 8;
  const bf16_t* vg = p.vt + ((size_t)seq * VW + V_B + h * 128 + srow) * L + spart * 8;
  const int kst = srow * TB_ROW + spart * 16;
  const int vst = srow * TB_ROW + ((spart >> 1) * 16 + (spart & 1) * 4) * 2;
  const int rd = q * TB_ROW + half * 16;
#pragma unroll
  for (int dt = 0; dt < 4; ++dt) o[dt] = zero16();
  float mrun = -1e30f, lrun = 0.f;
  f32x16 bp;
#pragma unroll
  for (int i = 0; i < 16; ++i) bp[i] = slope2 * (float)((i >> 2) * 8 + (i & 3));
  const int ntile = L >> 6, t0 = qblk * 4, nR = ntile - t0;
  auto tile_of = [&](int idx) { return idx < nR ? t0 + idx : (t0 - 1) - (idx - nR); };
  bf16x8 krA, vrA0, vrA1, krB, vrB0, vrB1;
  auto gload = [&](int idx, bf16x8& kr, bf16x8& v0, bf16x8& v1) { const int kn = tile_of(idx) * 64; kr = ld16(kg + (size_t)kn * UW); v0 = ld16(vg + kn); v1 = ld16(vg + (size_t)64 * L + kn); };
  auto lwrite = [&](int buf, const bf16x8& kr, const bf16x8& v0, const bf16x8& v1) {
    LAS unsigned char* kb = lds + LDS_K + buf * KB_BYTES; LAS unsigned char* vb = lds + LDS_V + buf * VB_BYTES;
    *(LAS bf16x8*)(kb + kst) = kr;
    *(LAS bf16x4*)(vb + vst) = __builtin_shufflevector(v0, v0, 0, 1, 2, 3); *(LAS bf16x4*)(vb + vst + 16) = __builtin_shufflevector(v0, v0, 4, 5, 6, 7);
    *(LAS bf16x4*)(vb + vst + 64 * TB_ROW) = __builtin_shufflevector(v1, v1, 0, 1, 2, 3); *(LAS bf16x4*)(vb + vst + 64 * TB_ROW + 16) = __builtin_shufflevector(v1, v1, 4, 5, 6, 7);
  };
  auto compute = [&](int idx, int buf) {
    const int k0 = tile_of(idx) * 64;
    const LAS unsigned char* kb = lds + LDS_K + buf * KB_BYTES;
    const LAS unsigned char* vb = lds + LDS_V + buf * VB_BYTES;
    if (idx < 4) {
#pragma unroll
      for (int sub = 0; sub < 2; ++sub) {
        f32x16 sc = zero16();
#pragma unroll
        for (int ks = 0; ks < 4; ++ks) sc = mfma32(*(const LAS bf16x8*)(kb + rd + sub * 32 * TB_ROW + ks * 32), qf[ks], sc);
        const float d0 = (float)(k0 + sub * 32 + half * 4 - tq);
#pragma unroll
        for (int i = 0; i < 16; ++i) sc[i] -= slope2 * fabsf(d0 + (float)((i >> 2) * 8 + (i & 3)));
        float al; bf16x8 pk[2];
        softmax_tile(sc, mrun, lrun, al, pk[0], pk[1]);
        if (__builtin_amdgcn_ballot_w64(al != 1.0f) != 0) {
#pragma unroll
          for (int dt = 0; dt < 4; ++dt) o[dt] *= al;
        }
#pragma unroll
        for (int dt = 0; dt < 4; ++dt)
#pragma unroll
          for (int s2 = 0; s2 < 2; ++s2) o[dt] = mfma32(*(const LAS bf16x8*)(vb + rd + dt * 32 * TB_ROW + (sub * 2 + s2) * 32), pk[s2], o[dt]);
      }
    } else if (idx < nR) {
#pragma unroll
      for (int sub = 0; sub < 2; ++sub) b_far_subtile<1>(kb, vb, rd, sub, qf, bp, slope2, (float)(k0 + sub * 32 + half * 4 - tq), mrun, lrun, o);
    } else {
#pragma unroll
      for (int sub = 0; sub < 2; ++sub) b_far_subtile<-1>(kb, vb, rd, sub, qf, bp, slope2, (float)(k0 + sub * 32 + half * 4 - tq), mrun, lrun, o);
    }
  };
  gload(0, krA, vrA0, vrA1);
  gload(1, krB, vrB0, vrB1);
  lwrite(0, krA, vrA0, vrA1);
  asm volatile("" : "+v"(qf[0]), "+v"(qf[1]), "+v"(qf[2]), "+v"(qf[3]));
  asm volatile("" : "+v"(krB), "+v"(vrB0), "+v"(vrB1));
  __syncthreads();
#pragma unroll 1
  for (int idx = 0; idx < ntile; idx += 2) {
    if (idx + 2 < ntile) gload(idx + 2, krA, vrA0, vrA1);
    compute(idx, 0);
    lwrite(1, krB, vrB0, vrB1);
    __syncthreads();
    if (idx + 3 < ntile) gload(idx + 3, krB, vrB0, vrB1);
    compute(idx + 1, 1);
    if (idx + 2 < ntile) lwrite(0, krA, vrA0, vrA1);
    __syncthreads();
  }
  linv = frcp(lrun + __shfl_xor(lrun, 32));
}
__device__ void attn_b_block(const Params& p, int layer, int L, int seq, int h, int qblk, LAS unsigned char* lds) {
  const int tid = opaque_tid(), lane = tid & 63, wid = __builtin_amdgcn_readfirstlane(tid >> 6);
  const int q = lane & 31, half = lane >> 5;
  const size_t tokbase = (size_t)seq * L;
  const int tq = qblk * 256 + wid * 32 + q;
  const float slope2 = exp2f(-2.0f * (float)(h + 1)) * LOG2E;
  f32x16 o0[4]; float li0, li1;
  LAS u32x4* park = (LAS u32x4*)(lds + LDS_ATT_END) + wid * 512 + lane;
  attn_b_pass(p, L, seq, h, 0, qblk, tq, tid, slope2, lds, o0, li0);
#pragma unroll
  for (int dt = 0; dt < 4; ++dt)
#pragma unroll
    for (int g2 = 0; g2 < 2; ++g2) {
      u32x4 pk;
#pragma unroll
      for (int k = 0; k < 4; ++k) pk[k] = cvt_pk_bf16(o0[dt][g2 * 8 + 2 * k] * li0, o0[dt][g2 * 8 + 2 * k + 1] * li0);
      park[(dt * 2 + g2) * 64] = pk;
    }
  attn_b_pass(p, L, seq, h, 1, qblk, tq, tid, slope2, lds, o0, li1);
  const float c1 = p.lam[layer] * li1;
  const int tid2 = opaque_tid(), half2 = (tid2 >> 5) & 1;
  const size_t tok2 = (size_t)seq * L + qblk * 256 + (tid2 >> 6) * 32 + (tid2 & 31);
  float ss = 0.f;
#pragma unroll
  for (int dt = 0; dt < 4; ++dt)
#pragma unroll
    for (int g2 = 0; g2 < 2; ++g2) {
      const u32x4 pk = park[(dt * 2 + g2) * 64];
#pragma unroll
      for (int k = 0; k < 4; ++k) {
        const float va = bf_lo(pk[k]) - o0[dt][g2 * 8 + 2 * k] * c1, vb = bf_hi(pk[k]) - o0[dt][g2 * 8 + 2 * k + 1] * c1;
        o0[dt][g2 * 8 + 2 * k] = va; o0[dt][g2 * 8 + 2 * k + 1] = vb; ss += va * va + vb * vb;
      }
    }
  ss += __shfl_xor(ss, 32);
  const float rn = rsqrtf(ss * (1.0f / 128.0f) + 1e-6f) * p.lam[4 + layer];
  const float* gd = p.g_diff + layer * 128;
  bf16_t* yrow = p.yg + tok2 * YW + 512 + h * 128;
  const bf16_t* zrow = p.u + tok2 * UW + U_ZB + h * 128;
#pragma unroll
  for (int dt = 0; dt < 4; ++dt)
#pragma unroll
    for (int g4 = 0; g4 < 4; ++g4) {
      const int dim = dt * 32 + g4 * 8 + half2 * 4;
      const u32x2 zr = *(const u32x2*)(zrow + dim);
      const f32x4 gv = *(const f32x4*)(gd + dim);
      const float y0 = o0[dt][g4 * 4 + 0] * rn * gv[0] * silu(bf_lo(zr[0]));
      const float y1 = o0[dt][g4 * 4 + 1] * rn * gv[1] * silu(bf_hi(zr[0]));
      const float y2 = o0[dt][g4 * 4 + 2] * rn * gv[2] * silu(bf_lo(zr[1]));
      const float y3 = o0[dt][g4 * 4 + 3] * rn * gv[3] * silu(bf_hi(zr[1]));
      u32x2 pk = {cvt_pk_bf16(y0, y1), cvt_pk_bf16(y2, y3)};
      *(u32x2*)(yrow + dim) = pk;
    }
}

constexpr int LDS_AK = 0, LDS_AV = LDS_AK + 2 * KB_BYTES, LDS_ATAB = LDS_AV + 2 * KB_BYTES, ATAB_ROW = 128;
__device__ void attn_a_block(const Params& p, int layer, int L, int seq, int h, int r0, LAS unsigned char* lds) {
  const int tid = opaque_tid(), lane = tid & 63, wid = __builtin_amdgcn_readfirstlane(tid >> 6);
  const int q = lane & 31, half = lane >> 5;
  const size_t tokbase = (size_t)seq * L;
  const int rows = L >> 6;
  const int r = r0 + (wid >> 1), cb2 = wid & 1;
  int rs = r - 4; rs = rs < 0 ? 0 : (rs > rows - 8 ? rows - 8 : rs);
  int kr_lo = r0 - 4; kr_lo = kr_lo < 0 ? 0 : (kr_lo > rows - 8 ? rows - 8 : kr_lo);
  int kr_hi = r0 - 1; kr_hi = (kr_hi < 0 ? 0 : (kr_hi > rows - 8 ? rows - 8 : kr_hi)) + 7;
  const int qcol = cb2 * 32 + q, tq = r * 64 + qcol;
  int qstart = qcol - 8; qstart = qstart < 0 ? 0 : (qstart > 48 ? 48 : qstart);
  bf16x8 qf[4];
  { const bf16_t* qp = p.u + (tokbase + tq) * UW + U_QA + h * 64 + half * 8;
#pragma unroll
    for (int ks = 0; ks < 4; ++ks) qf[ks] = ld16(qp + ks * 16); }
  {
    LAS float* tab = (LAS float*)(lds + LDS_ATAB);
    const float* rpb = p.rpb + ((size_t)layer * 8 + h) * 15 * 31;
    for (int idx = tid; idx < 15 * ATAB_ROW; idx += 512) { const int row = idx >> 7, cc = (idx & 127) - 48; tab[idx] = (cc >= 0 && cc <= 30) ? rpb[row * 31 + cc] * LOG2E : 0.f; }
  }
  const int spart = tid & 7, srow = tid >> 3;
  const bf16_t* kg = p.u + (tokbase + srow) * UW + U_KA + h * 64 + spart * 8;
  const bf16_t* vg = p.vt + ((size_t)seq * VW + V_A + h * 64 + srow) * L + spart * 8;
  const int kst = srow * TB_ROW + spart * 16;
  const int vst = srow * TB_ROW + ((spart >> 1) * 16 + (spart & 1) * 4) * 2;
  const int rd = q * TB_ROW + half * 16;
  f32x16 o[2] = {zero16(), zero16()};
  float mrun = -1e30f, lrun = 0.f;
  bf16x8 kr_, vr_;
  kr_ = ld16(kg + (size_t)(kr_lo * 64) * UW); vr_ = ld16(vg + kr_lo * 64);
  *(LAS bf16x8*)(lds + LDS_AK + kst) = kr_;
  *(LAS bf16x4*)(lds + LDS_AV + vst) = __builtin_shufflevector(vr_, vr_, 0, 1, 2, 3); *(LAS bf16x4*)(lds + LDS_AV + vst + 16) = __builtin_shufflevector(vr_, vr_, 4, 5, 6, 7);
  asm volatile("" : "+v"(qf[0]), "+v"(qf[1]), "+v"(qf[2]), "+v"(qf[3]));
  __syncthreads();
#pragma unroll 1
  for (int kr = kr_lo; kr <= kr_hi; ++kr) {
    const int it = kr - kr_lo;
    const bool more = (kr < kr_hi);
    if (more) { kr_ = ld16(kg + (size_t)((kr + 1) * 64) * UW); vr_ = ld16(vg + (kr + 1) * 64); }
    const LAS unsigned char* kb = lds + LDS_AK + (it & 1) * KB_BYTES;
    const LAS unsigned char* vb = lds + LDS_AV + (it & 1) * KB_BYTES;
    if (kr >= rs && kr < rs + 8) {
      const LAS float* trow = (const LAS float*)(lds + LDS_ATAB) + (kr - r + 7) * ATAB_ROW + (half * 4 - qcol + 15 + 48);
#pragma unroll
      for (int seg = 0; seg < 2; ++seg) {
        f32x16 sc = zero16();
#pragma unroll
        for (int ks = 0; ks < 4; ++ks) sc = mfma32(*(const LAS bf16x8*)(kb + rd + seg * 32 * TB_ROW + ks * 32), qf[ks], sc);
#pragma unroll
        for (int ii = 0; ii < 16; ++ii) {
          const int kcol = seg * 32 + (ii >> 2) * 8 + half * 4 + (ii & 3);
          const bool ok = (kcol >= qstart) && (kcol < qstart + 16);
          sc[ii] = ok ? sc[ii] + trow[seg * 32 + (ii >> 2) * 8 + (ii & 3)] : -INFINITY;
        }
        float al; bf16x8 pk[2];
        softmax_tile(sc, mrun, lrun, al, pk[0], pk[1]);
        if (__builtin_amdgcn_ballot_w64(al != 1.0f) != 0) { o[0] *= al; o[1] *= al; }
#pragma unroll
        for (int dt = 0; dt < 2; ++dt)
#pragma unroll
          for (int s2 = 0; s2 < 2; ++s2) o[dt] = mfma32(*(const LAS bf16x8*)(vb + rd + dt * 32 * TB_ROW + (seg * 2 + s2) * 32), pk[s2], o[dt]);
      }
    }
    if (more) {
      LAS unsigned char* kbn = lds + LDS_AK + ((it + 1) & 1) * KB_BYTES; LAS unsigned char* vbn = lds + LDS_AV + ((it + 1) & 1) * KB_BYTES;
      *(LAS bf16x8*)(kbn + kst) = kr_;
      *(LAS bf16x4*)(vbn + vst) = __builtin_shufflevector(vr_, vr_, 0, 1, 2, 3); *(LAS bf16x4*)(vbn + vst + 16) = __builtin_shufflevector(vr_, vr_, 4, 5, 6, 7);
    }
    __syncthreads();
  }
  const float c = frcp(lrun + __shfl_xor(lrun, 32));
  bf16_t* yrow = p.yg + (tokbase + tq) * YW + h * 64;
  const bf16_t* zrow = p.u + (tokbase + tq) * UW + U_ZA + h * 64;
#pragma unroll
  for (int dt = 0; dt < 2; ++dt)
#pragma unroll
    for (int g4 = 0; g4 < 4; ++g4) {
      const int dim = dt * 32 + g4 * 8 + half * 4;
      const u32x2 zr = *(const u32x2*)(zrow + dim);
      const float y0 = o[dt][g4 * 4 + 0] * c * silu(bf_lo(zr[0]));
      const float y1 = o[dt][g4 * 4 + 1] * c * silu(bf_hi(zr[0]));
      const float y2 = o[dt][g4 * 4 + 2] * c * silu(bf_lo(zr[1]));
      const float y3 = o[dt][g4 * 4 + 3] * c * silu(bf_hi(zr[1]));
      u32x2 pk = {cvt_pk_bf16(y0, y1), cvt_pk_bf16(y2, y3)};
      *(u32x2*)(yrow + dim) = pk;
    }
}

__device__ void attn_c_unit(const Params& p, int L, int lshift, int seq, int g, int h, int rr, int mblk, int lane) {
  const int q = lane & 31, half = lane >> 5;
  const size_t tokbase = (size_t)seq * L;
  const int ds = (g == 0) ? 0 : (g == 1 ? 2 : 4), d = 1 << ds, M = L >> ds;
  const int hh = g * 4 + h;
  const int m0 = mblk * 32, mq = m0 + q, tq = mq * d + rr;
  const bf16_t* urow = p.u + (tokbase + tq) * UW;
  bf16x8 qf[4];
#pragma unroll
  for (int ks = 0; ks < 4; ++ks) qf[ks] = ld16(urow + U_QC + hh * 64 + ks * 16 + half * 8);
  f32x16 o[2] = {zero16(), zero16()};
  float mrun = -1e30f, lrun = 0.f;
  const float coef = exp2f(-(2.0f / 3.0f) * (float)(hh + 1)) * (float)d * LOG2E;
  const bf16_t* vbase = p.vt + ((size_t)seq * VW + V_C + hh * 64 + q) * L + (size_t)rr * M;
  bf16x8 kf[5][4];
#pragma unroll
  for (int j = 0; j < 5; ++j) {
    int mkl = m0 - 64 + 32 * j + q; mkl = mkl < 0 ? 0 : (mkl > M - 1 ? M - 1 : mkl);
    const bf16_t* kp = p.u + (tokbase + (size_t)mkl * d + rr) * UW + U_KC + hh * 64 + half * 8;
#pragma unroll
    for (int ks = 0; ks < 4; ++ks) kf[j][ks] = ld16(kp + ks * 16);
  }
  bf16x8 vf[2][2][2];
  auto load_v = [&](int j, bf16x8 (&dst)[2][2]) {
#pragma unroll
    for (int dt = 0; dt < 2; ++dt)
#pragma unroll
      for (int s2 = 0; s2 < 2; ++s2) {
        int pa = m0 - 64 + 32 * j + s2 * 16 + half * 4, pb = pa + 8;
        pa = pa < 0 ? 0 : (pa > M - 4 ? M - 4 : pa); pb = pb < 0 ? 0 : (pb > M - 4 ? M - 4 : pb);
        const bf16_t* vp = vbase + (size_t)(dt * 32) * L;
        dst[dt][s2] = ld8x2(vp + pa, vp + pb);
      }
  };
  load_v(0, vf[0]);
#pragma unroll
  for (int j = 0; j < 5; ++j) {
    if (j + 1 < 5) load_v(j + 1, vf[(j + 1) & 1]);
    const int mk0 = m0 - 64 + 32 * j;
    if (mk0 + 32 <= 0 || mk0 >= M) continue;
    f32x16 s = zero16();
#pragma unroll
    for (int ks = 0; ks < 4; ++ks) s = mfma32(kf[j][ks], qf[ks], s);
#pragma unroll
    for (int ii = 0; ii < 16; ++ii) {
      const int mk = mk0 + (ii >> 2) * 8 + half * 4 + (ii & 3);
      const int rel = mk - mq; const int ar = rel < 0 ? -rel : rel;
      const bool ok = (mk >= 0) && (mk < M) && (ar <= 64);
      s[ii] = ok ? s[ii] - coef * (float)ar : -INFINITY;
    }
    float alpha; bf16x8 pk[2];
    softmax_tile(s, mrun, lrun, alpha, pk[0], pk[1]);
#pragma unroll
    for (int dt = 0; dt < 2; ++dt) {
      o[dt] *= alpha;
#pragma unroll
      for (int s2 = 0; s2 < 2; ++s2) o[dt] = mfma32(vf[j & 1][dt][s2], pk[s2], o[dt]);
    }
  }
  const float lt = lrun + __shfl_xor(lrun, 32);
  const float c = frcp(lt);
  bf16_t* orow = p.oc + (tokbase + tq) * 768 + hh * 64;
#pragma unroll
  for (int dt = 0; dt < 2; ++dt)
#pragma unroll
    for (int g4 = 0; g4 < 4; ++g4) {
      const int dim = dt * 32 + g4 * 8 + half * 4;
      u32x2 pk = {cvt_pk_bf16(o[dt][g4 * 4 + 0] * c, o[dt][g4 * 4 + 1] * c), cvt_pk_bf16(o[dt][g4 * 4 + 2] * c, o[dt][g4 * 4 + 3] * c)};
      *(u32x2*)(orow + dim) = pk;
    }
  if (half == 0) p.lse[(tokbase + tq) * 12 + hh] = mrun + log2f(lt);
}

__device__ void phase_attn(const Params& p, int layer, int L, int lshift, LAS unsigned char* lds) {
  const int tiles = L >> 5;
  const int nseq = TC >> lshift;
  const int nw = gridDim.x * 8;
  int w, lane;
  { const int qblks = L >> 8, npairs = nseq * 4, nunits = npairs * qblks;
    for (int rep = 0; rep < PROBE_B; ++rep)
    for (int b = blockIdx.x; b < nunits; b += gridDim.x) {
      int pair, qblk;
      if ((gridDim.x & 7) == 0 && (npairs & 7) == 0 && nunits == (int)gridDim.x) { const int xcd = b & 7, j = b >> 3; pair = xcd * (npairs >> 3) + j / qblks; qblk = j % qblks; }
      else { pair = b / qblks; qblk = b % qblks; }
      attn_b_block(p, layer, L, pair >> 2, pair & 3, qblk, lds);
    }
  }
  { const int tid = opaque_tid(); lane = tid & 63; w = blockIdx.x * 8 + __builtin_amdgcn_readfirstlane(tid >> 6); }
  for (int rep = 0; rep < PROBE_AC; ++rep) {
  { const int rgs = L >> 8, nunits = nseq * 8 * rgs;
    for (int b = blockIdx.x; b < nunits; b += gridDim.x) { const int sh = b / rgs, rg = b % rgs; attn_a_block(p, layer, L, sh >> 3, sh & 7, rg * 4, lds); }
  }
  { const int tid = opaque_tid(); lane = tid & 63; w = blockIdx.x * 8 + __builtin_amdgcn_readfirstlane(tid >> 6); }
  for (int uc = w; uc < nseq * 12 * tiles; uc += nw) {
    const int idx = uc % tiles, sgh = uc / tiles;
    const int seq = sgh / 12, gh = sgh % 12, g = gh >> 2, h = gh & 3;
    const int ds = (g == 0) ? 0 : (g == 1 ? 2 : 4);
    const int mb = (L >> ds) >> 5;
    attn_c_unit(p, L, lshift, seq, g, h, idx / mb, idx % mb, lane);
  }
  }
}

__device__ void phase_combine(const Params& p) {
  const int gt = blockIdx.x * 512 + opaque_tid(), ngt = gridDim.x * 512;
  for (int it = gt; it < TC * 32; it += ngt) {
    const int tok = it >> 5, sub = it & 31, h = sub >> 3, d8 = (sub & 7) * 8;
    const float* ls = p.lse + (size_t)tok * 12;
    const float l0 = ls[h], l1 = ls[4 + h], l2 = ls[8 + h];
    const float mx = fmaxf(l0, fmaxf(l1, l2));
    const float w0 = fexp2(l0 - mx), w1 = fexp2(l1 - mx), w2 = fexp2(l2 - mx);
    const float inv = frcp(w0 + w1 + w2);
    const bf16_t* ob = p.oc + (size_t)tok * 768 + h * 64 + d8;
    const u32x4 a = *(const u32x4*)ob, b = *(const u32x4*)(ob + 256), c = *(const u32x4*)(ob + 512);
    const u32x4 z = *(const u32x4*)(p.u + (size_t)tok * UW + U_ZC + h * 64 + d8);
    u32x4 r;
#pragma unroll
    for (int k = 0; k < 4; ++k) {
      const float vlo = (w0 * bf_lo(a[k]) + w1 * bf_lo(b[k]) + w2 * bf_lo(c[k])) * inv * silu(bf_lo(z[k]));
      const float vhi = (w0 * bf_hi(a[k]) + w1 * bf_hi(b[k]) + w2 * bf_hi(c[k])) * inv * silu(bf_hi(z[k]));
      r[k] = cvt_pk_bf16(vlo, vhi);
    }
    *(u32x4*)(p.yg + (size_t)tok * YW + 1024 + h * 64 + d8) = r;
  }
}


#define XB_TMO      128
#define XB_XCNT(j)  (256  + 64 * (j))
#define XB_XSUB(j)  (1280 + 64 * (j))
#define XB_XGEN(j)  (2304 + 64 * (j))
#define XB_TOP      3328
#define XB_TOPGEN   3392
#define XCD_BAR_WORDS 3456
#define XB_SPIN_CAP (1u << 18)
__device__ __forceinline__ unsigned xb_ld(unsigned* p)              { return __hip_atomic_load(p, __ATOMIC_RELAXED, __HIP_MEMORY_SCOPE_AGENT); }
__device__ __forceinline__ unsigned xb_add(unsigned* p, unsigned v) { return __hip_atomic_fetch_add(p, v, __ATOMIC_RELAXED, __HIP_MEMORY_SCOPE_AGENT); }
__device__ __forceinline__ unsigned xb_xcc_id() { return (unsigned)__builtin_amdgcn_s_getreg((3 << 11) | 20) & 0xFu; }
#define XB_SPIN(cond, bar) do { unsigned _sp = 0; while (cond) { __builtin_amdgcn_s_sleep(1); \
    if ((++_sp & 255u) == 0u) { if (xb_ld(&(bar)[XB_TMO])) break; if (_sp > XB_SPIN_CAP) { atomicAdd(&(bar)[XB_TMO], 1u); break; } } } } while (0)
struct XcdBarrier { unsigned* bar; unsigned x; volatile LAS unsigned* st; };
__device__ __forceinline__ XcdBarrier xcd_barrier_post(unsigned* bar, volatile LAS unsigned* st) {
  XcdBarrier b; b.bar = bar; b.x = xb_xcc_id(); b.st = st;
  if (opaque_tid() == 0) (void)xb_add(&bar[XB_XCNT(b.x)], 1u);
  return b;
}
__device__ __forceinline__ void xcd_barrier_complete(unsigned* bar, unsigned x, unsigned& nloc, unsigned& nx) {
  const unsigned G = gridDim.x * gridDim.y * gridDim.z;
  unsigned sum, cnt, mine, sp = 0u;
  for (;;) {
    sum = 0u; cnt = 0u; mine = 0u;
#pragma unroll
    for (unsigned j = 0; j < 16; ++j) { const unsigned c = xb_ld(&bar[XB_XCNT(j)]); sum += c; cnt += (c > 0u) ? 1u : 0u; mine = (j == x) ? c : mine; }
    if (sum == G) break;
    __builtin_amdgcn_s_sleep(1);
    if ((++sp & 255u) == 0u) { if (xb_ld(&bar[XB_TMO])) break; if (sp > XB_SPIN_CAP) { atomicAdd(&bar[XB_TMO], 1u); break; } }
  }
  nloc = mine > 0u ? mine : 1u; nx = cnt > 0u ? cnt : 1u;
}
__device__ __forceinline__ void xcd_barrier(const XcdBarrier& b) {
  asm volatile("s_waitcnt vmcnt(0)" ::: "memory");
  __syncthreads();
  if (opaque_tid() == 0) {
    unsigned* bar = b.bar;
    __builtin_amdgcn_s_waitcnt(0);
    unsigned nloc = b.st[0], nx = b.st[1];
    if (nloc == 0u) { xcd_barrier_complete(bar, b.x, nloc, nx); b.st[0] = nloc; b.st[1] = nx; }
    const unsigned old = xb_add(&bar[XB_XSUB(b.x)], 1u);
    const unsigned gen = old / nloc;
    if (old + 1u == (gen + 1u) * nloc) {
      __builtin_amdgcn_fence(__ATOMIC_RELEASE, "agent");
      asm volatile("s_waitcnt vmcnt(0)" ::: "memory");
      const unsigned og = xb_add(&bar[XB_TOP], 1u);
      const unsigned tg = og / nx;
      if (og + 1u == (tg + 1u) * nx) xb_add(&bar[XB_TOPGEN], 1u);
      else XB_SPIN(xb_ld(&bar[XB_TOPGEN]) == tg, bar);
      __builtin_amdgcn_fence(__ATOMIC_ACQUIRE, "agent");
      xb_add(&bar[XB_XGEN(b.x)], 1u);
      asm volatile("s_waitcnt vmcnt(0)" ::: "memory");
    } else {
      XB_SPIN(xb_ld(&bar[XB_XGEN(b.x)]) == gen, bar);
      __builtin_amdgcn_fence(__ATOMIC_ACQUIRE, "agent");
      asm volatile("s_waitcnt vmcnt(0)" ::: "memory");
    }
  }
  __syncthreads();
}

__global__ void __launch_bounds__(512) fwd_megakernel(Params p) {
  __shared__ __attribute__((aligned(16))) unsigned char smem[LDS_ATT_TOTAL > pg8::STAGE_BYTES ? LDS_ATT_TOTAL : pg8::STAGE_BYTES];
  __shared__ __attribute__((aligned(16))) unsigned xb_words[4];
  cg::grid_group grid = cg::this_grid();
  if (threadIdx.x == 0) { xb_words[0] = 0u; xb_words[1] = 0u; xb_words[2] = 0u; xb_words[3] = 0u; }
  if ((threadIdx.x & 63) == 0) g_wid_table[hw_wave_slot()] = (int)(threadIdx.x >> 6);
  __syncthreads();
  const XcdBarrier xb = xcd_barrier_post(p.bar, (volatile LAS unsigned*)xb_words);
#define GSYNC() do { for (int rep_ = 0; rep_ < PROBE_SYNC; ++rep_) xcd_barrier(xb); } while (0)
  LAS unsigned char* lds = (LAS unsigned char*)smem;
  for (int rep = 0; rep < PROBE_SMALL; ++rep) phase_prep(p, (LAS float*)smem);
  for (int rep = 0; rep < PROBE_SMALL; ++rep) phase_x(p, 0);
  grid.sync();
  for (int chunk = 0; chunk < NCHUNK; ++chunk) {
    const int L = chunk < 2 ? 2048 : 4096, lshift = chunk < 2 ? 11 : 12;
    const float* xin = (chunk < 2) ? p.xp + (size_t)chunk * TC * DM : p.xs + (size_t)(chunk - 2) * TC * DM;
    float* xres = p.out + (size_t)chunk * TC * DM;
    float* ssq = p.ssq + (size_t)chunk * TC * 16;
    for (int layer = 0; layer < DEPTH; ++layer) {
      {
        for (int rep = 0; rep < PROBE_P1; ++rep) {
        { pg8::Gemm g{p.xb, p.wt_in + (size_t)layer * INW * DM, TC, UW, DM, 0, lshift};
          pg8::StaticOrder S; S.init(TC, UW, gridDim.x, blockIdx.x);
          EpiU E{p.u, ssq, p.b_gate + (size_t)layer * 3 * DM};
          pg8::gemm_phase(lds, g, S, E); }
        {
          pg8::Gemm g{p.wt_in + ((size_t)layer * INW + UW) * DM, p.xb, VW, TC, DM, 1, lshift};
          pg8::StaticOrder S; S.init(VW, TC, gridDim.x, (blockIdx.x + (gridDim.x >> 2)) % gridDim.x);
          EpiVT E{p.vt, ssq, L, lshift};
          pg8::gemm_phase(lds, g, S, E); }
        }
      }
      GSYNC();
      phase_attn(p, layer, L, lshift, lds);
      GSYNC();
      for (int rep = 0; rep < PROBE_SMALL; ++rep) phase_combine(p);
      GSYNC();
      {
        pg8::Gemm g{p.yg, p.wt_br + (size_t)layer * DM * YW, TC, DM, YW, 0, 0};
        pg8::StaticOrder S; S.init(TC, DM, gridDim.x, blockIdx.x);
        EpiMerge E{p.u, p.merged};
        for (int rep = 0; rep < PROBE_3A; ++rep) pg8::gemm_phase(lds, g, S, E);
      }
      GSYNC();
      {
        pg8::Gemm g{p.merged, p.wt_out + (size_t)layer * DM * DM, TC, DM, DM, 0, 0};
        pg8::StaticOrder S; S.init(TC, DM, gridDim.x, blockIdx.x);
        EpiRes E{layer == 0 ? xin : (const float*)xres, xres, p.xb, ssq};
        pg8::gemm_phase(lds, g, S, E);
        if (PROBE_3B > 1 && layer == 0) { for (int rep = 0; rep < 4 * (PROBE_3B - 1); ++rep) pg8::gemm_phase(lds, g, S, E); }
      }
      GSYNC();
    }
    phase_final(p, chunk);
    if (chunk + 1 < NCHUNK) { for (int rep = 0; rep < PROBE_SMALL; ++rep) phase_x(p, chunk + 1); GSYNC(); }
  }
}

extern "C" void kernel_launch(void* const* d_in, const int* in_sizes, int n_in, void* d_out, int out_size, void* d_ws, size_t ws_size, hipStream_t stream) {
  (void)in_sizes; (void)n_in; (void)out_size;
  static int grid_blocks = 0;
  if (!grid_blocks) {
    int dev = 0, cus = 0, per_cu = 0;
    hipGetDevice(&dev);
    hipDeviceGetAttribute(&cus, hipDeviceAttributeMultiprocessorCount, dev);
    hipOccupancyMaxActiveBlocksPerMultiprocessor(&per_cu, fwd_megakernel, 512, 0);
    if (per_cu < 1) per_cu = 1;
    grid_blocks = cus * per_cu;
    if (grid_blocks > 256) grid_blocks = 256;
  }
  Params p{};
  p.xp = (const float*)d_in[0]; p.xs = (const float*)d_in[1]; p.g_norm = (const float*)d_in[2]; p.w_in = (const float*)d_in[3];
  p.b_gate = (const float*)d_in[4]; p.rpb = (const float*)d_in[5]; p.lam_qk = (const float*)d_in[6]; p.g_diff = (const float*)d_in[7];
  p.w_br_a = (const float*)d_in[8]; p.w_br_b = (const float*)d_in[9]; p.w_br_c = (const float*)d_in[10]; p.w_out = (const float*)d_in[11];
  p.g_final = (const float*)d_in[12];
  p.out = (float*)d_out;
  char* w = (char*)d_ws; size_t off = 0;
  auto take = [&](size_t bytes) { char* r = w + off; off += (bytes + 255) & ~(size_t)255; return r; };
  p.wt_in = (bf16_t*)take((size_t)DEPTH * INW * DM * 2);
  p.wt_br = (bf16_t*)take((size_t)DEPTH * DM * YW * 2);
  p.wt_out = (bf16_t*)take((size_t)DEPTH * DM * DM * 2);
  p.xb = (bf16_t*)take((size_t)TC * DM * 2);
  p.u = (bf16_t*)take((size_t)TC * UW * 2);
  p.vt = (bf16_t*)take((size_t)TC * VW * 2);
  p.yg = (bf16_t*)take((size_t)TC * YW * 2);
  p.oc = (bf16_t*)take((size_t)TC * 768 * 2);
  p.merged = (bf16_t*)take((size_t)TC * DM * 2);
  p.lse = (float*)take((size_t)TC * 12 * 4);
  p.ssq = (float*)take((size_t)NTOK * 16 * 4);
  p.lam = (float*)take(256);
  p.bar = (unsigned*)take((size_t)XCD_BAR_WORDS * 4);
  if (off > ws_size) fprintf(stderr, "workspace too small: need %zu have %zu\n", off, ws_size);
  hipMemsetAsync(p.bar, 0, (size_t)XCD_BAR_WORDS * 4, stream);
  void* args[] = {&p};
  hipError_t e = hipLaunchCooperativeKernel((void*)fwd_megakernel, dim3(grid_blocks), dim3(512), args, 0, stream);
  if (e != hipSuccess) fprintf(stderr, "cooperative launch failed: %s (grid %d)\n", hipGetErrorString(e), grid_blocks);
}
```

```cpp
#include <hip/hip_runtime.h>
#include <hip/hip_cooperative_groups.h>
#include <cstdio>
namespace cg = cooperative_groups;
#ifndef PROBE_B
#define PROBE_B 1
#endif
#ifndef PROBE_AC
#define PROBE_AC 1
#endif
#ifndef PROBE_P1
#define PROBE_P1 1
#endif
#ifndef PROBE_3A
#define PROBE_3A 1
#endif
#ifndef PROBE_SMALL
#define PROBE_SMALL 1
#endif
#ifndef PROBE_3B
#define PROBE_3B 1
#endif
#ifndef PROBE_ATT
#define PROBE_ATT 1
#endif
#ifndef PROBE_SYNC
#define PROBE_SYNC 1
#endif

#define LAS __attribute__((address_space(3)))
typedef unsigned short bf16_t;
typedef short bf16x8 __attribute__((ext_vector_type(8)));
typedef short bf16x4 __attribute__((ext_vector_type(4)));
typedef float f32x4 __attribute__((ext_vector_type(4)));
typedef float f32x16 __attribute__((ext_vector_type(16)));
typedef unsigned u32x4 __attribute__((ext_vector_type(4)));
typedef unsigned u32x2 __attribute__((ext_vector_type(2)));

constexpr int DM = 1024, DEPTH = 4, INW = 9728, UW = 7936, VW = 1792, YW = 1280;
constexpr int TC = 16384, NCHUNK = 4, NTOK = 65536;
constexpr float LOG2E = 1.4426950408889634f;
constexpr float QSCALE = 0.125f * LOG2E;
constexpr int U_QA = 0, U_KA = 512, U_ZA = 1024, U_QB = 1536, U_KB = 2048, U_ZB = 2560, U_QC = 3072, U_KC = 3840, U_ZC = 4608, U_GL = 4864;
constexpr int V_A = 0, V_B = 512, V_C = 1024;

struct Params {
  const float *xp, *xs, *g_norm, *w_in, *b_gate, *rpb, *lam_qk, *g_diff, *w_br_a, *w_br_b, *w_br_c, *w_out, *g_final;
  float* out;
  bf16_t *wt_in, *wt_br, *wt_out, *xb, *u, *vt, *yg, *oc, *merged;
  float *lse, *ssq, *lam, *rinv;
  unsigned* bar;
};

__device__ __forceinline__ unsigned cvt_pk_bf16(float lo, float hi) { unsigned r; asm volatile("v_cvt_pk_bf16_f32 %0, %1, %2" : "=v"(r) : "v"(lo), "v"(hi)); return r; }
__device__ __forceinline__ float bf_lo(unsigned v) { return __uint_as_float(v << 16); }
__device__ __forceinline__ float bf_hi(unsigned v) { return __uint_as_float(v & 0xffff0000u); }
__device__ __forceinline__ float fexp2(float x) { return __builtin_amdgcn_exp2f(x); }
__device__ __forceinline__ float frcp(float x) { return __builtin_amdgcn_rcpf(x); }

__shared__ int g_wid_table[64];
__device__ __forceinline__ unsigned hw_wave_slot() { return (unsigned)__builtin_amdgcn_s_getreg(((6 - 1) << 11) | (0 << 6) | 4) & 63u; }
__device__ __forceinline__ int opaque_tid() {
  const int wid = __builtin_amdgcn_readfirstlane(g_wid_table[hw_wave_slot()]);
  unsigned z = 0u; asm volatile("" : "+v"(z));
  int t = wid * 64 + (int)__builtin_amdgcn_mbcnt_hi(~0u, __builtin_amdgcn_mbcnt_lo(~0u, z));
  asm volatile("" : "+v"(t)); return t;
}

namespace pg8 {
constexpr int BM = 256, BK = 64, HALF = 128, HTB = HALF * BK * 2, STAGE_BYTES = 8 * HTB, NXCD = 8, WGM = 8;
__device__ __forceinline__ int lds_byte(int r, int c) { const int st = (r >> 4) * 2 + (c >> 5), rr = r & 15, cc = c & 31, ob = rr * 64 + cc * 2; return st * 1024 + (ob ^ (((ob >> 9) & 1) << 5)); }
__device__ __forceinline__ void stage_rc(int b, int& R, int& C) { const int st = b / 1024, sb = b % 1024, swz = sb ^ (((sb >> 9) & 1) << 5); R = (st >> 1) * 16 + swz / 64; C = (st & 1) * 32 + (swz % 64) / 2; }
__device__ __forceinline__ int perm32(int rho) { const int n = rho >> 4, i = rho & 15; return 8 * (i >> 2) + 4 * n + (i & 3); }
struct Unit { int pm, pn; };
struct Gemm { const bf16_t* A; const bf16_t* Bt; int M, N, K; int bperm, lshift; };
struct StaticOrder {
  int nM, nN, nwg, G, c;
  __device__ void init(int M, int N, int G_, int c_) { nM = M / BM; nN = N / BM; nwg = nM * nN; G = G_; c = c_; }
  __device__ bool next(int i, Unit& u) const {
    const long L = (long)i * G + c; if (L >= nwg) return false;
    int wgid = (int)L; { const int q = nwg / NXCD, r = nwg % NXCD, xcd = wgid % NXCD, off = wgid / NXCD; wgid = (xcd < r ? xcd * (q + 1) : r * (q + 1) + (xcd - r) * q) + off; }
    const int nig = WGM * nN, gid = wgid / nig, fm = gid * WGM, gsz = (nM - fm) < WGM ? (nM - fm) : WGM;
    u.pm = fm + ((wgid % nig) % gsz); u.pn = (wgid % nig) / gsz; return true;
  }
};

template <class Epi>
__device__ __forceinline__ void gemm_phase(LAS unsigned char* lds, const Gemm g, const StaticOrder& S, const Epi& E) {
  const int tid_ = opaque_tid();
  const int tid = tid_, wid = __builtin_amdgcn_readfirstlane(tid >> 6), lane = tid & 63, wr = wid >> 2, wc = wid & 3, fr = lane & 15, fq = lane >> 4;
  const int K = g.K, nt = K / BK;
  const size_t kstep = (size_t)(BK * 2);
  const size_t hstep = (size_t)HALF * K * 2;
  const size_t tstep = 2 * hstep;
  unsigned voffA[2], voffBr[2], voffBc[2], voffB[2], voffBn[2];
#pragma unroll
  for (int i = 0; i < 2; ++i) { int R, C; stage_rc(tid * 16 + i * 8192, R, C); const int Rb = (R & ~31) + perm32(R & 31);
    voffA[i] = (unsigned)(R * K + C) * 2u; voffBr[i] = (unsigned)(Rb * K) * 2u; voffBc[i] = (unsigned)C * 2u; voffB[i] = voffBr[i] + voffBc[i]; voffBn[i] = voffB[i]; }
  auto bbase = [&](const Unit& u, int hh, int& sh) -> const char* {
    if (!g.bperm) { sh = 0; return (const char*)g.Bt + (size_t)u.pn * tstep + (size_t)hh * hstep; }
    const int ds = u.pm <= 4 ? 0 : (u.pm == 5 ? 2 : 4); sh = ds;
    const int L = 1 << g.lshift; const int p0 = u.pn * 256 + hh * 128, seq = p0 >> g.lshift, p = p0 & (L - 1);
    const int Mc = L >> ds, r = p / Mc, m0 = p & (Mc - 1);
    return (const char*)g.Bt + ((size_t)seq * L + ((size_t)m0 << ds) + r) * (size_t)K * 2;
  };
  const unsigned ldsw = (unsigned)wid * 1024u;
  const int aoff = lds_byte(wr * 64 + fr, fq * 8), boff = lds_byte(wc * 32 + fr, fq * 8);
#define PG8_SA(b, h) (((b) * 2 + (h)) * HTB)
#define PG8_SB(b, h) ((4 + (b) * 2 + (h)) * HTB)
#define PG8_STAGE(bufoff, gbase, voff) do { _Pragma("unroll") for (int _i = 0; _i < 2; ++_i) \
    __builtin_amdgcn_global_load_lds((const unsigned*)((const char*)(gbase) + (voff)[_i]), (LAS unsigned*)(lds + (bufoff) + ldsw + _i * 8192), 16, 0, 0); } while (0)
#define PG8_LDA(dst, b, h) do { _Pragma("unroll") for (int m = 0; m < 4; ++m) _Pragma("unroll") for (int k = 0; k < 2; ++k) dst[m][k] = *(const LAS bf16x8*)(lds + PG8_SA(b, h) + aoff + m * 2048 + k * 1024); } while (0)
#define PG8_LDB(dst, b, h) do { _Pragma("unroll") for (int n = 0; n < 2; ++n) _Pragma("unroll") for (int k = 0; k < 2; ++k) dst[n][k] = *(const LAS bf16x8*)(lds + PG8_SB(b, h) + boff + n * 2048 + k * 1024); } while (0)
#define PG8_MMA(ai, bj, At, Bt) do { __builtin_amdgcn_s_setprio(1); _Pragma("unroll") for (int m = 0; m < 4; ++m) _Pragma("unroll") for (int n = 0; n < 2; ++n) _Pragma("unroll") for (int k = 0; k < 2; ++k) \
    acc[ai][bj][m][n] = __builtin_amdgcn_mfma_f32_16x16x32_bf16(Bt[n][k], At[m][k], acc[ai][bj][m][n], 0, 0, 0); __builtin_amdgcn_s_setprio(0); } while (0)
#define PG8_WAIT_V(n) asm volatile("s_waitcnt vmcnt(" #n ")" ::: "memory")
#define PG8_WAIT_L(n) asm volatile("s_waitcnt lgkmcnt(" #n ")" ::: "memory")
#define PG8_BAR __builtin_amdgcn_s_barrier()
#define PG8_SCHED __builtin_amdgcn_sched_barrier(0)
  Unit cur, nxt; int ui = 0;
  if (!S.next(0, cur)) return;
  f32x4 acc[2][2][4][2];
#pragma unroll
  for (int a = 0; a < 2; ++a)
#pragma unroll
    for (int b = 0; b < 2; ++b)
#pragma unroll
      for (int m = 0; m < 4; ++m)
#pragma unroll
        for (int n = 0; n < 2; ++n) acc[a][b][m][n] = (f32x4){0.f, 0.f, 0.f, 0.f};
  bf16x8 At[4][2], B0[2][2], B1[2][2];
  const char* cA = (const char*)g.A + (size_t)cur.pm * tstep;
  int csh; const char* cB0 = bbase(cur, 0, csh); const char* cB1 = bbase(cur, 1, csh);
#pragma unroll
  for (int i = 0; i < 2; ++i) voffB[i] = (voffBr[i] << csh) + voffBc[i];
  PG8_STAGE(PG8_SB(0, 0), cB0, voffB); PG8_STAGE(PG8_SA(0, 0), cA, voffA); PG8_STAGE(PG8_SB(0, 1), cB1, voffB); PG8_STAGE(PG8_SA(0, 1), cA + hstep, voffA);
  if (wr == 1) PG8_BAR;
  PG8_WAIT_V(4); PG8_BAR;
  PG8_STAGE(PG8_SB(1, 0), cB0 + kstep, voffB); PG8_STAGE(PG8_SA(1, 0), cA + kstep, voffA); PG8_STAGE(PG8_SB(1, 1), cB1 + kstep, voffB);
  PG8_WAIT_V(6); PG8_BAR;
  for (;;) {
    const bool has_next = S.next(ui + 1, nxt);
    const char* nA = cA; const char* nB0 = cB0; const char* nB1 = cB1;
#pragma unroll
    for (int i = 0; i < 2; ++i) voffBn[i] = voffB[i];
    if (has_next) { int nsh; nA = (const char*)g.A + (size_t)nxt.pm * tstep; nB0 = bbase(nxt, 0, nsh); nB1 = bbase(nxt, 1, nsh);
#pragma unroll
      for (int i = 0; i < 2; ++i) voffBn[i] = (voffBr[i] << nsh) + voffBc[i]; }
    for (int t = 0; t < nt; t += 2) {
      if constexpr (Epi::HOOK) { if (t == 8 || t == 16) E.hook(acc, cur, t, wr, wc, fr, fq); }
      const bool last = (t == nt - 2);
      const char* a1 = cA + (size_t)(t + 1) * kstep;
      const char* a2 = last ? nA : cA + (size_t)(t + 2) * kstep;
      const char* b20 = last ? nB0 : cB0 + (size_t)(t + 2) * kstep; const char* b21 = last ? nB1 : cB1 + (size_t)(t + 2) * kstep;
      const char* a3 = a2 + kstep; const char* b30 = b20 + kstep; const char* b31 = b21 + kstep;
      unsigned vB[2];
#pragma unroll
      for (int i = 0; i < 2; ++i) vB[i] = last ? voffBn[i] : voffB[i];
      PG8_LDB(B0, 0, 0); PG8_SCHED; PG8_LDA(At, 0, 0); PG8_STAGE(PG8_SA(1, 1), a1 + hstep, voffA);
      PG8_WAIT_L(8); PG8_BAR; PG8_WAIT_L(0); PG8_MMA(0, 0, At, B0); PG8_BAR; PG8_SCHED;
      PG8_LDB(B1, 0, 1); PG8_STAGE(PG8_SB(0, 0), b20, vB);
      PG8_BAR; PG8_WAIT_L(0); PG8_MMA(0, 1, At, B1); PG8_BAR;
      PG8_LDA(At, 0, 1); PG8_STAGE(PG8_SA(0, 0), a2, voffA);
      PG8_BAR; PG8_WAIT_L(0); PG8_MMA(1, 0, At, B0); PG8_BAR; PG8_SCHED;
      PG8_STAGE(PG8_SB(0, 1), b21, vB);
      PG8_WAIT_V(6); PG8_BAR; PG8_MMA(1, 1, At, B1); PG8_BAR;
      PG8_LDB(B0, 1, 0); PG8_SCHED; PG8_LDA(At, 1, 0); PG8_STAGE(PG8_SA(0, 1), a2 + hstep, voffA);
      PG8_WAIT_L(8); PG8_BAR; PG8_WAIT_L(0); PG8_MMA(0, 0, At, B0); PG8_BAR; PG8_SCHED;
      PG8_LDB(B1, 1, 1); PG8_STAGE(PG8_SB(1, 0), b30, vB);
      PG8_BAR; PG8_WAIT_L(0); PG8_MMA(0, 1, At, B1); PG8_BAR;
      PG8_LDA(At, 1, 1); PG8_STAGE(PG8_SA(1, 0), a3, voffA);
      PG8_BAR; PG8_WAIT_L(0); PG8_MMA(1, 0, At, B0); PG8_BAR; PG8_SCHED;
      PG8_STAGE(PG8_SB(1, 1), b31, vB);
      PG8_WAIT_V(6); PG8_BAR; PG8_MMA(1, 1, At, B1); PG8_BAR;
    }
    E(acc, cur, wr, wc, fr, fq);
    if (!has_next) break;
#pragma unroll
    for (int a = 0; a < 2; ++a)
#pragma unroll
      for (int b = 0; b < 2; ++b)
#pragma unroll
        for (int m = 0; m < 4; ++m)
#pragma unroll
          for (int n = 0; n < 2; ++n) acc[a][b][m][n] = (f32x4){0.f, 0.f, 0.f, 0.f};
    cur = nxt; cA = nA; cB0 = nB0; cB1 = nB1; ++ui;
#pragma unroll
    for (int i = 0; i < 2; ++i) voffB[i] = voffBn[i];
  }
  PG8_WAIT_V(0);
  if (wr == 0) PG8_BAR;
  PG8_BAR;
#undef PG8_SA
#undef PG8_SB
#undef PG8_STAGE
#undef PG8_LDA
#undef PG8_LDB
#undef PG8_MMA
#undef PG8_WAIT_V
#undef PG8_WAIT_L
#undef PG8_BAR
#undef PG8_SCHED
}
}
using pg8::Unit;

struct EpiU {
  static constexpr bool HOOK = false;
  bf16_t* U; const float* rinv; const float* bg;
  __device__ __forceinline__ void hook(f32x4 (&)[2][2][4][2], const Unit&, int, int, int, int, int) const {}
  __device__ __forceinline__ void operator()(const f32x4 (&acc)[2][2][4][2], const Unit& u, int wr, int wc, int fr, int fq) const {
    asm volatile("" : "+v"(fr), "+v"(fq));
    const int row0 = u.pm * 256 + wr * 64 + fr, col0 = u.pn * 256 + wc * 32 + 8 * fq;
    const bool isg = (u.pn >= 19);
    float ri[2][4];
#pragma unroll
    for (int ai = 0; ai < 2; ++ai)
#pragma unroll
      for (int m = 0; m < 4; ++m) ri[ai][m] = rinv[row0 + ai * 128 + m * 16];
    if (isg) {
      f32x4 b[2][2];
#pragma unroll
      for (int bj = 0; bj < 2; ++bj) { const float* bp = bg + (col0 - U_GL) + bj * 128; b[bj][0] = *(const f32x4*)bp; b[bj][1] = *(const f32x4*)(bp + 4); }
#pragma unroll
      for (int ai = 0; ai < 2; ++ai)
#pragma unroll
        for (int m = 0; m < 4; ++m)
#pragma unroll
          for (int bj = 0; bj < 2; ++bj) {
            f32x4 v0 = acc[ai][bj][m][0] * ri[ai][m] + b[bj][0], v1 = acc[ai][bj][m][1] * ri[ai][m] + b[bj][1];
#pragma unroll
            for (int j = 0; j < 4; ++j) { v0[j] = 1.0f + fminf(fexp2(-v0[j] * LOG2E), 1e30f); v1[j] = 1.0f + fminf(fexp2(-v1[j] * LOG2E), 1e30f); }
            u32x4 pk = {cvt_pk_bf16(v0[0], v0[1]), cvt_pk_bf16(v0[2], v0[3]), cvt_pk_bf16(v1[0], v1[1]), cvt_pk_bf16(v1[2], v1[3])};
            *(u32x4*)(U + (size_t)(row0 + ai * 128 + m * 16) * UW + col0 + bj * 128) = pk;
          }
    } else {
#pragma unroll
      for (int ai = 0; ai < 2; ++ai)
#pragma unroll
        for (int m = 0; m < 4; ++m)
#pragma unroll
          for (int bj = 0; bj < 2; ++bj) {
            const f32x4 v0 = acc[ai][bj][m][0] * ri[ai][m], v1 = acc[ai][bj][m][1] * ri[ai][m];
            u32x4 pk = {cvt_pk_bf16(v0[0], v0[1]), cvt_pk_bf16(v0[2], v0[3]), cvt_pk_bf16(v1[0], v1[1]), cvt_pk_bf16(v1[2], v1[3])};
            *(u32x4*)(U + (size_t)(row0 + ai * 128 + m * 16) * UW + col0 + bj * 128) = pk;
          }
    }
  }
};

struct EpiVT {
  static constexpr bool HOOK = false;
  bf16_t* VT; const float* rv; int L, lshift;
  __device__ __forceinline__ void hook(f32x4 (&)[2][2][4][2], const Unit&, int, int, int, int, int) const {}
  __device__ __forceinline__ void operator()(const f32x4 (&acc)[2][2][4][2], const Unit& u, int wr, int wc, int fr, int fq) const {
    asm volatile("" : "+v"(fr), "+v"(fq));
    const int vrow0 = u.pm * 256 + wr * 64 + fr, pcol0 = u.pn * 256 + wc * 32 + 8 * fq;
    const int ds = u.pm <= 4 ? 0 : (u.pm == 5 ? 2 : 4);
    const int Mc = L >> ds;
#pragma unroll
    for (int bj = 0; bj < 2; ++bj) {
      const int p0 = pcol0 + bj * 128, seq = p0 >> lshift, pos = p0 & (L - 1);
      const int r = pos / Mc, m0 = pos & (Mc - 1);
      float rinv[8];
#pragma unroll
      for (int j = 0; j < 8; ++j) rinv[j] = rv[(seq << lshift) + ((m0 + j) << ds) + r];
      bf16_t* vb = VT + ((size_t)seq * VW + vrow0) * L + pos;
#pragma unroll
      for (int ai = 0; ai < 2; ++ai)
#pragma unroll
        for (int m = 0; m < 4; ++m) {
          const f32x4 v0 = acc[ai][bj][m][0], v1 = acc[ai][bj][m][1];
          u32x4 pk = {cvt_pk_bf16(v0[0] * rinv[0], v0[1] * rinv[1]), cvt_pk_bf16(v0[2] * rinv[2], v0[3] * rinv[3]),
                      cvt_pk_bf16(v1[0] * rinv[4], v1[1] * rinv[5]), cvt_pk_bf16(v1[2] * rinv[6], v1[3] * rinv[7])};
          *(u32x4*)(vb + (size_t)(ai * 128 + m * 16) * L) = pk;
        }
    }
  }
};

struct EpiMerge {
  static constexpr bool HOOK = true;
  const bf16_t* U; bf16_t* MG;
  __device__ __forceinline__ f32x4 gvec(int i, size_t row, int col) const {
    const u32x2 raw = *(const u32x2*)(U + row * UW + U_GL + i * 1024 + col);
    f32x4 e; e[0] = bf_lo(raw[0]); e[1] = bf_hi(raw[0]); e[2] = bf_lo(raw[1]); e[3] = bf_hi(raw[1]); return e;
  }
  __device__ __forceinline__ void hook(f32x4 (&acc)[2][2][4][2], const Unit& u, int t, int wr, int wc, int fr, int fq) const {
    const int i = (t == 8) ? 0 : 1;
    asm volatile("" : "+v"(fr), "+v"(fq));
    const int row0 = u.pm * 256 + wr * 64 + fr, col0 = u.pn * 256 + wc * 32 + 8 * fq;
#pragma unroll
    for (int ai = 0; ai < 2; ++ai) {
#pragma unroll
      for (int m = 0; m < 4; ++m)
#pragma unroll
        for (int bj = 0; bj < 2; ++bj) {
          const bf16_t* gp = U + (size_t)(row0 + ai * 128 + m * 16) * UW + U_GL + i * 1024 + col0 + bj * 128;
          const u32x4 a = *(const u32x4*)gp, b = *(const u32x4*)(gp + 1024);
#pragma unroll
          for (int n = 0; n < 2; ++n) {
            f32x4 r;
            r[0] = bf_lo(b[2 * n]) * frcp(bf_lo(a[2 * n])); r[1] = bf_hi(b[2 * n]) * frcp(bf_hi(a[2 * n]));
            r[2] = bf_lo(b[2 * n + 1]) * frcp(bf_lo(a[2 * n + 1])); r[3] = bf_hi(b[2 * n + 1]) * frcp(bf_hi(a[2 * n + 1]));
            acc[ai][bj][m][n] *= r;
          }
        }
      __builtin_amdgcn_sched_barrier(0);
    }
  }
  __device__ __forceinline__ void operator()(const f32x4 (&acc)[2][2][4][2], const Unit& u, int wr, int wc, int fr, int fq) const {
    asm volatile("" : "+v"(fr), "+v"(fq));
    const int row0 = u.pm * 256 + wr * 64 + fr, col0 = u.pn * 256 + wc * 32 + 8 * fq;
    u32x4 g2[2][4][2];
#pragma unroll
    for (int ai = 0; ai < 2; ++ai)
#pragma unroll
      for (int m = 0; m < 4; ++m)
#pragma unroll
        for (int bj = 0; bj < 2; ++bj) g2[ai][m][bj] = *(const u32x4*)(U + (size_t)(row0 + ai * 128 + m * 16) * UW + U_GL + 2 * 1024 + col0 + bj * 128);
    __builtin_amdgcn_sched_barrier(0);
#pragma unroll
    for (int ai = 0; ai < 2; ++ai)
#pragma unroll
      for (int m = 0; m < 4; ++m)
#pragma unroll
        for (int bj = 0; bj < 2; ++bj) {
          const size_t row = (size_t)(row0 + ai * 128 + m * 16); const int col = col0 + bj * 128;
          const u32x4 g = g2[ai][m][bj];
          f32x4 v0 = acc[ai][bj][m][0], v1 = acc[ai][bj][m][1];
          v0[0] *= frcp(bf_lo(g[0])); v0[1] *= frcp(bf_hi(g[0])); v0[2] *= frcp(bf_lo(g[1])); v0[3] *= frcp(bf_hi(g[1]));
          v1[0] *= frcp(bf_lo(g[2])); v1[1] *= frcp(bf_hi(g[2])); v1[2] *= frcp(bf_lo(g[3])); v1[3] *= frcp(bf_hi(g[3]));
          u32x4 pk = {cvt_pk_bf16(v0[0], v0[1]), cvt_pk_bf16(v0[2], v0[3]), cvt_pk_bf16(v1[0], v1[1]), cvt_pk_bf16(v1[2], v1[3])};
          *(u32x4*)(MG + row * DM + col) = pk;
        }
  }
};

struct EpiRes {
  static constexpr bool HOOK = false;
  const float* R; float* X; bf16_t* XB; float* ssq;
  __device__ __forceinline__ void hook(f32x4 (&)[2][2][4][2], const Unit&, int, int, int, int, int) const {}
  __device__ __forceinline__ void operator()(const f32x4 (&acc)[2][2][4][2], const Unit& u, int wr, int wc, int fr, int fq) const {
    asm volatile("" : "+v"(fr), "+v"(fq));
    const int row0 = u.pm * 256 + wr * 64 + fr, col0 = u.pn * 256 + wc * 32 + 8 * fq;
#pragma unroll
    for (int ai = 0; ai < 2; ++ai) {
      f32x4 r[4][2][2];
#pragma unroll
      for (int m = 0; m < 4; ++m)
#pragma unroll
        for (int bj = 0; bj < 2; ++bj) { const float* rp = R + (size_t)(row0 + ai * 128 + m * 16) * DM + col0 + bj * 128; r[m][bj][0] = *(const f32x4*)rp; r[m][bj][1] = *(const f32x4*)(rp + 4); }
      __builtin_amdgcn_sched_barrier(0);
#pragma unroll
      for (int m = 0; m < 4; ++m) {
        const size_t row = (size_t)(row0 + ai * 128 + m * 16);
        float s = 0.f;
#pragma unroll
        for (int bj = 0; bj < 2; ++bj) {
          const int col = col0 + bj * 128;
          const f32x4 v0 = r[m][bj][0] + acc[ai][bj][m][0], v1 = r[m][bj][1] + acc[ai][bj][m][1];
          *(f32x4*)(X + row * DM + col) = v0; *(f32x4*)(X + row * DM + col + 4) = v1;
          s += v0[0] * v0[0] + v0[1] * v0[1] + v0[2] * v0[2] + v0[3] * v0[3] + v1[0] * v1[0] + v1[1] * v1[1] + v1[2] * v1[2] + v1[3] * v1[3];
          u32x4 pk = {cvt_pk_bf16(v0[0], v0[1]), cvt_pk_bf16(v0[2], v0[3]), cvt_pk_bf16(v1[0], v1[1]), cvt_pk_bf16(v1[2], v1[3])};
          *(u32x4*)(XB + row * DM + col) = pk;
        }
        s += __shfl_xor(s, 16); s += __shfl_xor(s, 32);
        if (fq == 0) ssq[row * 16 + u.pn * 4 + wc] = s;
      }
      __builtin_amdgcn_sched_barrier(0);
    }
  }
};

__device__ __forceinline__ void prep_tile(const float* src, int ldn, int k0, int n0, const float* rscale, float cscale, bf16_t* dst, int ldd, int drow0, int dk0, LAS float* tile) {
  const int tid = opaque_tid(), kk = tid >> 6, nn = tid & 63;
#pragma unroll
  for (int i = 0; i < 8; ++i) {
    const int k = kk * 8 + i;
    float v = src[(size_t)(k0 + k) * ldn + n0 + nn] * cscale;
    if (rscale) v *= rscale[k0 + k];
    tile[k * 65 + nn] = v;
  }
  __syncthreads();
  const int n = tid >> 3, kc = tid & 7;
  float f[8];
#pragma unroll
  for (int j = 0; j < 8; ++j) f[j] = tile[(kc * 8 + j) * 65 + n];
  u32x4 pk = {cvt_pk_bf16(f[0], f[1]), cvt_pk_bf16(f[2], f[3]), cvt_pk_bf16(f[4], f[5]), cvt_pk_bf16(f[6], f[7])};
  *(u32x4*)(dst + (size_t)(drow0 + n) * ldd + dk0 + kc * 8) = pk;
  __syncthreads();
}

__device__ __forceinline__ void win_map(int n0, int& dn0, float& sc) {
  sc = 1.0f;
  if (n0 < 512) { dn0 = U_QA + n0; sc = QSCALE; }
  else if (n0 < 1024) dn0 = U_KA + (n0 - 512);
  else if (n0 < 1536) dn0 = UW + V_A + (n0 - 1024);
  else if (n0 < 2048) dn0 = U_ZA + (n0 - 1536);
  else if (n0 < 2560) { dn0 = U_QB + (n0 - 2048); sc = QSCALE; }
  else if (n0 < 3072) dn0 = U_KB + (n0 - 2560);
  else if (n0 < 3584) dn0 = UW + V_B + (n0 - 3072);
  else if (n0 < 4096) dn0 = U_ZB + (n0 - 3584);
  else if (n0 < 4864) { dn0 = U_QC + (n0 - 4096); sc = QSCALE; }
  else if (n0 < 5632) dn0 = U_KC + (n0 - 4864);
  else if (n0 < 6400) dn0 = UW + V_C + (n0 - 5632);
  else if (n0 < 6656) dn0 = U_ZC + (n0 - 6400);
  else dn0 = U_GL + (n0 - 6656);
}

__device__ void phase_prep(const Params& p, LAS float* tile) {
  constexpr int PER = 3008;
  for (int it = blockIdx.x; it < DEPTH * PER; it += gridDim.x) {
    const int l = it / PER; int r = it % PER;
    if (r < 2432) {
      const int kt = r / 152, ntile = r % 152; int dn0; float sc; win_map(ntile * 64, dn0, sc);
      prep_tile(p.w_in + (size_t)l * DM * INW, INW, kt * 64, ntile * 64, p.g_norm + l * DM, sc, p.wt_in + (size_t)l * INW * DM, DM, dn0, kt * 64, tile);
    } else if ((r -= 2432) < 128) {
      const int kt = r / 16, ntile = r % 16;
      prep_tile(p.w_br_a + (size_t)l * 512 * DM, DM, kt * 64, ntile * 64, nullptr, 1.0f, p.wt_br + (size_t)l * DM * YW, YW, ntile * 64, kt * 64, tile);
    } else if ((r -= 128) < 128) {
      const int kt = r / 16, ntile = r % 16;
      prep_tile(p.w_br_b + (size_t)l * 512 * DM, DM, kt * 64, ntile * 64, nullptr, 1.0f, p.wt_br + (size_t)l * DM * YW, YW, ntile * 64, 512 + kt * 64, tile);
    } else if ((r -= 128) < 64) {
      const int kt = r / 16, ntile = r % 16;
      prep_tile(p.w_br_c + (size_t)l * 256 * DM, DM, kt * 64, ntile * 64, nullptr, 1.0f, p.wt_br + (size_t)l * DM * YW, YW, ntile * 64, 1024 + kt * 64, tile);
    } else {
      r -= 64; const int kt = r / 16, ntile = r % 16;
      prep_tile(p.w_out + (size_t)l * DM * DM, DM, kt * 64, ntile * 64, nullptr, 1.0f, p.wt_out + (size_t)l * DM * DM, DM, ntile * 64, kt * 64, tile);
    }
  }
  const int ptid = opaque_tid();
  if (blockIdx.x == 0 && ptid < 64) {
    const int lane = ptid;
    for (int l = 0; l < DEPTH; ++l) {
      const float* lq = p.lam_qk + l * 256;
      float a = lq[lane] * lq[64 + lane], b = lq[128 + lane] * lq[192 + lane];
      for (int o = 32; o >= 1; o >>= 1) { a += __shfl_xor(a, o); b += __shfl_xor(b, o); }
      if (lane == 0) { const float li = 0.8f - 0.6f * expf(-0.3f * (float)l); p.lam[l] = expf(a) - expf(b) + li; p.lam[4 + l] = 1.0f - li; }
    }
  }
}

__device__ void phase_x(const Params& p, int chunk) {
  const float* xin = (chunk < 2) ? p.xp + (size_t)chunk * TC * DM : p.xs + (size_t)(chunk - 2) * TC * DM;
  float* ssq = p.ssq + (size_t)chunk * TC * 16;
  const int tid = opaque_tid(), lane = tid & 63, w = blockIdx.x * 8 + (tid >> 6), nw = gridDim.x * 8;
  for (int row = w; row < TC; row += nw) {
    const float* xr = xin + (size_t)row * DM + lane * 16;
    f32x4 v[4]; float s = 0.f;
#pragma unroll
    for (int i = 0; i < 4; ++i) { v[i] = *(const f32x4*)(xr + i * 4); s += v[i][0] * v[i][0] + v[i][1] * v[i][1] + v[i][2] * v[i][2] + v[i][3] * v[i][3]; }
    for (int o = 32; o >= 1; o >>= 1) s += __shfl_xor(s, o);
    u32x4 p0 = {cvt_pk_bf16(v[0][0], v[0][1]), cvt_pk_bf16(v[0][2], v[0][3]), cvt_pk_bf16(v[1][0], v[1][1]), cvt_pk_bf16(v[1][2], v[1][3])};
    u32x4 p1 = {cvt_pk_bf16(v[2][0], v[2][1]), cvt_pk_bf16(v[2][2], v[2][3]), cvt_pk_bf16(v[3][0], v[3][1]), cvt_pk_bf16(v[3][2], v[3][3])};
    bf16_t* xo = p.xb + (size_t)row * DM + lane * 16;
    *(u32x4*)xo = p0; *(u32x4*)(xo + 8) = p1;
    if (lane < 16) ssq[(size_t)row * 16 + lane] = (lane == 0) ? s : 0.f;
    if (lane == 0) p.rinv[(size_t)chunk * TC + row] = rsqrtf(s * (1.0f / 1024.0f) + 1e-6f);
  }
}

__device__ void phase_rinv(const Params& p, int chunk) {
  const float* ssq = p.ssq + (size_t)chunk * TC * 16; float* rv = p.rinv + (size_t)chunk * TC;
  for (int row = blockIdx.x * 512 + opaque_tid(); row < TC; row += gridDim.x * 512) {
    const f32x4* sp = (const f32x4*)(ssq + (size_t)row * 16);
    const f32x4 a4 = sp[0] + sp[1] + sp[2] + sp[3];
    rv[row] = rsqrtf((a4[0] + a4[1] + a4[2] + a4[3]) * (1.0f / 1024.0f) + 1e-6f);
  }
}

__device__ void phase_final(const Params& p, int chunk) {
  float* x = p.out + (size_t)chunk * TC * DM;
  const float* ssq = p.ssq + (size_t)chunk * TC * 16;
  const int tid = opaque_tid(), lane = tid & 63, w = blockIdx.x * 8 + (tid >> 6), nw = gridDim.x * 8;
  for (int row = w; row < TC; row += nw) {
    const f32x4* sp = (const f32x4*)(ssq + (size_t)row * 16);
    const f32x4 a4 = sp[0] + sp[1] + sp[2] + sp[3];
    const float rinv = rsqrtf((a4[0] + a4[1] + a4[2] + a4[3]) * (1.0f / 1024.0f) + 1e-6f);
    float* xr = x + (size_t)row * DM + lane * 16;
#pragma unroll
    for (int i = 0; i < 4; ++i) { f32x4 v = *(const f32x4*)(xr + i * 4); const f32x4 g = *(const f32x4*)(p.g_final + lane * 16 + i * 4); v = v * rinv * g; *(f32x4*)(xr + i * 4) = v; }
  }
}

__device__ __forceinline__ f32x16 mfma32(bf16x8 a, bf16x8 b, f32x16 c) { return __builtin_amdgcn_mfma_f32_32x32x16_bf16(a, b, c, 0, 0, 0); }
__device__ __forceinline__ bf16x8 ld16(const bf16_t* p) { return *(const bf16x8*)p; }
__device__ __forceinline__ bf16x8 ld8x2(const bf16_t* p0, const bf16_t* p1) { const bf16x4 a = *(const bf16x4*)p0, b = *(const bf16x4*)p1; return __builtin_shufflevector(a, b, 0, 1, 2, 3, 4, 5, 6, 7); }

__device__ __forceinline__ void softmax_tile(f32x16& t, float& m, float& l, float& alpha, bf16x8& p0, bf16x8& p1) {
  float tm = t[0];
#pragma unroll
  for (int i = 1; i < 16; ++i) tm = fmaxf(tm, t[i]);
  tm = fmaxf(tm, __shfl_xor(tm, 32));
  const float mn = fmaxf(m, tm);
  alpha = fexp2(m - mn); m = mn;
  float ls = 0.f;
#pragma unroll
  for (int i = 0; i < 16; ++i) { t[i] = fexp2(t[i] - mn); ls += t[i]; }
  l = l * alpha + ls;
  const u32x4 a = {cvt_pk_bf16(t[0], t[1]), cvt_pk_bf16(t[2], t[3]), cvt_pk_bf16(t[4], t[5]), cvt_pk_bf16(t[6], t[7])};
  const u32x4 b = {cvt_pk_bf16(t[8], t[9]), cvt_pk_bf16(t[10], t[11]), cvt_pk_bf16(t[12], t[13]), cvt_pk_bf16(t[14], t[15])};
  p0 = __builtin_bit_cast(bf16x8, a); p1 = __builtin_bit_cast(bf16x8, b);
}
__device__ __forceinline__ f32x16 zero16() { f32x16 z;
#pragma unroll
  for (int i = 0; i < 16; ++i) z[i] = 0.f; return z; }
__device__ __forceinline__ float silu(float z) { return z * frcp(1.0f + fexp2(-z * LOG2E)); }

constexpr int TB_ROW = 144;
constexpr int KB_BYTES = 64 * TB_ROW;
constexpr int VB_BYTES = 128 * TB_ROW;
constexpr int LDS_K = 0, LDS_V = LDS_K + 2 * KB_BYTES, LDS_ATT_END = LDS_V + 2 * VB_BYTES, LDS_ATT_TOTAL = LDS_ATT_END + 65536;
template <int SIDE>
__device__ __forceinline__ void b_far_subtile(const LAS unsigned char* kb, const LAS unsigned char* vb, int rd, int sub, const bf16x8 (&qf)[4], const f32x16& bp, float slope2, float d0,
                                              float& mrun, float& lrun, f32x16 (&o)[4]) {
  const float base = (SIDE > 0 ? -slope2 : slope2) * d0 - mrun;
  f32x16 sc;
#pragma unroll
  for (int i = 0; i < 16; ++i) sc[i] = SIDE > 0 ? base - bp[i] : base + bp[i];
#pragma unroll
  for (int ks = 0; ks < 4; ++ks) sc = mfma32(*(const LAS bf16x8*)(kb + rd + sub * 32 * TB_ROW + ks * 32), qf[ks], sc);
  float tm = sc[0];
#pragma unroll
  for (int i = 1; i < 16; ++i) tm = fmaxf(tm, sc[i]);
  tm = fmaxf(tm, __shfl_xor(tm, 32));
  if (__builtin_amdgcn_ballot_w64(tm > 0.0f) != 0) {
    const float delta = fmaxf(tm, 0.0f);
    const float al = fexp2(-delta);
    mrun += delta; lrun *= al;
#pragma unroll
    for (int i = 0; i < 16; ++i) sc[i] -= delta;
#pragma unroll
    for (int dt = 0; dt < 4; ++dt) o[dt] *= al;
  }
#pragma unroll
  for (int i = 0; i < 16; ++i) sc[i] = fexp2(sc[i]);
  { const f32x4 a4 = (f32x4){sc[0], sc[1], sc[2], sc[3]} + (f32x4){sc[4], sc[5], sc[6], sc[7]} + (f32x4){sc[8], sc[9], sc[10], sc[11]} + (f32x4){sc[12], sc[13], sc[14], sc[15]};
    lrun += (a4[0] + a4[1]) + (a4[2] + a4[3]); }
  const u32x4 pa = {cvt_pk_bf16(sc[0], sc[1]), cvt_pk_bf16(sc[2], sc[3]), cvt_pk_bf16(sc[4], sc[5]), cvt_pk_bf16(sc[6], sc[7])};
  const u32x4 pb = {cvt_pk_bf16(sc[8], sc[9]), cvt_pk_bf16(sc[10], sc[11]), cvt_pk_bf16(sc[12], sc[13]), cvt_pk_bf16(sc[14], sc[15])};
  const bf16x8 pk0 = __builtin_bit_cast(bf16x8, pa), pk1 = __builtin_bit_cast(bf16x8, pb);
#pragma unroll
  for (int dt = 0; dt < 4; ++dt) {
    o[dt] = mfma32(*(const LAS bf16x8*)(vb + rd + dt * 32 * TB_ROW + (sub * 2) * 32), pk0, o[dt]);
    o[dt] = mfma32(*(const LAS bf16x8*)(vb + rd + dt * 32 * TB_ROW + (sub * 2 + 1) * 32), pk1, o[dt]);
  }
}

__device__ __forceinline__ void attn_b_pass(const Params& p, int L, int seq, int h, int mp, int qblk, int tq, int tid, float slope2, LAS unsigned char* lds, f32x16 (&o)[4], float& linv) {
  const int lane = tid & 63, q = lane & 31, half = lane >> 5;
  const size_t tokbase = (size_t)seq * L;
  bf16x8 qf[4];
  { const bf16_t* qp = p.u + (tokbase + tq) * UW + U_QB + h * 128 + mp * 64 + half * 8;
#pragma unroll
    for (int ks = 0; ks < 4; ++ks) qf[ks] = ld16(qp + ks * 16); }
  const int spart = tid & 7, srow = tid >> 3;
  const bf16_t* kg = p.u + (tokbase + srow) * UW + U_KB + h * 128 + mp * 64 + spart * 8;
  const bf16_t* vg = p.vt + ((size_t)seq * VW + V_B + h * 128 + srow) * L + spart * 8;
  const int kst = srow * TB_ROW + spart * 16;
  const int vst = srow * TB_ROW + ((spart >> 1) * 16 + (spart & 1) * 4) * 2;
  const int rd = q * TB_ROW + half * 16;
#pragma unroll
  for (int dt = 0; dt < 4; ++dt) o[dt] = zero16();
  float mrun = -1e30f, lrun = 0.f;
  f32x16 bp;
#pragma unroll
  for (int i = 0; i < 16; ++i) bp[i] = slope2 * (float)((i >> 2) * 8 + (i & 3));
  const int ntile = L >> 6, t0 = qblk * 4, nR = ntile - t0;
  auto tile_of = [&](int idx) { return idx < nR ? t0 + idx : (t0 - 1) - (idx - nR); };
  bf16x8 krA, vrA0, vrA1, krB, vrB0, vrB1;
  auto gload = [&](int idx, bf16x8& kr, bf16x8& v0, bf16x8& v1) { const int kn = tile_of(idx) * 64; kr = ld16(kg + (size_t)kn * UW); v0 = ld16(vg + kn); v1 = ld16(vg + (size_t)64 * L + kn); };
  auto lwrite = [&](int buf, const bf16x8& kr, const bf16x8& v0, const bf16x8& v1) {
    LAS unsigned char* kb = lds + LDS_K + buf * KB_BYTES; LAS unsigned char* vb = lds + LDS_V + buf * VB_BYTES;
    *(LAS bf16x8*)(kb + kst) = kr;
    *(LAS bf16x4*)(vb + vst) = __builtin_shufflevector(v0, v0, 0, 1, 2, 3); *(LAS bf16x4*)(vb + vst + 16) = __builtin_shufflevector(v0, v0, 4, 5, 6, 7);
    *(LAS bf16x4*)(vb + vst + 64 * TB_ROW) = __builtin_shufflevector(v1, v1, 0, 1, 2, 3); *(LAS bf16x4*)(vb + vst + 64 * TB_ROW + 16) = __builtin_shufflevector(v1, v1, 4, 5, 6, 7);
  };
  auto compute = [&](int idx, int buf) {
    const int k0 = tile_of(idx) * 64;
    const LAS unsigned char* kb = lds + LDS_K + buf * KB_BYTES;
    const LAS unsigned char* vb = lds + LDS_V + buf * VB_BYTES;
    if (idx < 4) {
#pragma unroll
      for (int sub = 0; sub < 2; ++sub) {
        f32x16 sc = zero16();
#pragma unroll
        for (int ks = 0; ks < 4; ++ks) sc = mfma32(*(const LAS bf16x8*)(kb + rd + sub * 32 * TB_ROW + ks * 32), qf[ks], sc);
        const float d0 = (float)(k0 + sub * 32 + half * 4 - tq);
#pragma unroll
        for (int i = 0; i < 16; ++i) sc[i] -= slope2 * fabsf(d0 + (float)((i >> 2) * 8 + (i & 3)));
        float al; bf16x8 pk[2];
        softmax_tile(sc, mrun, lrun, al, pk[0], pk[1]);
        if (__builtin_amdgcn_ballot_w64(al != 1.0f) != 0) {
#pragma unroll
          for (int dt = 0; dt < 4; ++dt) o[dt] *= al;
        }
#pragma unroll
        for (int dt = 0; dt < 4; ++dt)
#pragma unroll
          for (int s2 = 0; s2 < 2; ++s2) o[dt] = mfma32(*(const LAS bf16x8*)(vb + rd + dt * 32 * TB_ROW + (sub * 2 + s2) * 32), pk[s2], o[dt]);
      }
    } else if (idx < nR) {
#pragma unroll
      for (int sub = 0; sub < 2; ++sub) b_far_subtile<1>(kb, vb, rd, sub, qf, bp, slope2, (float)(k0 + sub * 32 + half * 4 - tq), mrun, lrun, o);
    } else {
#pragma unroll
      for (int sub = 0; sub < 2; ++sub) b_far_subtile<-1>(kb, vb, rd, sub, qf, bp, slope2, (float)(k0 + sub * 32 + half * 4 - tq), mrun, lrun, o);
    }
  };
  gload(0, krA, vrA0, vrA1);
  gload(1, krB, vrB0, vrB1);
  lwrite(0, krA, vrA0, vrA1);
  asm volatile("" : "+v"(qf[0]), "+v"(qf[1]), "+v"(qf[2]), "+v"(qf[3]));
  asm volatile("" : "+v"(krB), "+v"(vrB0), "+v"(vrB1));
  __syncthreads();
#pragma unroll 1
  for (int idx = 0; idx < ntile; idx += 2) {
    if (idx + 2 < ntile) gload(idx + 2, krA, vrA0, vrA1);
    compute(idx, 0);
    lwrite(1, krB, vrB0, vrB1);
    __syncthreads();
    if (idx + 3 < ntile) gload(idx + 3, krB, vrB0, vrB1);
    compute(idx + 1, 1);
    if (idx + 2 < ntile) lwrite(0, krA, vrA0, vrA1);
    __syncthreads();
  }
  linv = frcp(lrun + __shfl_xor(lrun, 32));
}
__device__ void attn_b_block(const Params& p, int layer, int L, int seq, int h, int qblk, LAS unsigned char* lds) {
  const int tid = opaque_tid(), lane = tid & 63, wid = __builtin_amdgcn_readfirstlane(tid >> 6);
  const int q = lane & 31, half = lane >> 5;
  const size_t tokbase = (size_t)seq * L;
  const int tq = qblk * 256 + wid * 32 + q;
  const float slope2 = exp2f(-2.0f * (float)(h + 1)) * LOG2E;
  f32x16 o0[4]; float li0, li1;
  LAS u32x4* park = (LAS u32x4*)(lds + LDS_ATT_END) + wid * 512 + lane;
  attn_b_pass(p, L, seq, h, 0, qblk, tq, tid, slope2, lds, o0, li0);
#pragma unroll
  for (int dt = 0; dt < 4; ++dt)
#pragma unroll
    for (int g2 = 0; g2 < 2; ++g2) {
      u32x4 pk;
#pragma unroll
      for (int k = 0; k < 4; ++k) pk[k] = cvt_pk_bf16(o0[dt][g2 * 8 + 2 * k] * li0, o0[dt][g2 * 8 + 2 * k + 1] * li0);
      park[(dt * 2 + g2) * 64] = pk;
    }
  attn_b_pass(p, L, seq, h, 1, qblk, tq, tid, slope2, lds, o0, li1);
  const float c1 = p.lam[layer] * li1;
  const int tid2 = opaque_tid(), half2 = (tid2 >> 5) & 1;
  const size_t tok2 = (size_t)seq * L + qblk * 256 + (tid2 >> 6) * 32 + (tid2 & 31);
  float ss = 0.f;
#pragma unroll
  for (int dt = 0; dt < 4; ++dt)
#pragma unroll
    for (int g2 = 0; g2 < 2; ++g2) {
      const u32x4 pk = park[(dt * 2 + g2) * 64];
#pragma unroll
      for (int k = 0; k < 4; ++k) {
        const float va = bf_lo(pk[k]) - o0[dt][g2 * 8 + 2 * k] * c1, vb = bf_hi(pk[k]) - o0[dt][g2 * 8 + 2 * k + 1] * c1;
        o0[dt][g2 * 8 + 2 * k] = va; o0[dt][g2 * 8 + 2 * k + 1] = vb; ss += va * va + vb * vb;
      }
    }
  ss += __shfl_xor(ss, 32);
  const float rn = rsqrtf(ss * (1.0f / 128.0f) + 1e-6f) * p.lam[4 + layer];
  const float* gd = p.g_diff + layer * 128;
  bf16_t* yrow = p.yg + tok2 * YW + 512 + h * 128;
  const bf16_t* zrow = p.u + tok2 * UW + U_ZB + h * 128;
#pragma unroll
  for (int dt = 0; dt < 4; ++dt)
#pragma unroll
    for (int g4 = 0; g4 < 4; ++g4) {
      const int dim = dt * 32 + g4 * 8 + half2 * 4;
      const u32x2 zr = *(const u32x2*)(zrow + dim);
      const f32x4 gv = *(const f32x4*)(gd + dim);
      const float y0 = o0[dt][g4 * 4 + 0] * rn * gv[0] * silu(bf_lo(zr[0]));
      const float y1 = o0[dt][g4 * 4 + 1] * rn * gv[1] * silu(bf_hi(zr[0]));
      const float y2 = o0[dt][g4 * 4 + 2] * rn * gv[2] * silu(bf_lo(zr[1]));
      const float y3 = o0[dt][g4 * 4 + 3] * rn * gv[3] * silu(bf_hi(zr[1]));
      u32x2 pk = {cvt_pk_bf16(y0, y1), cvt_pk_bf16(y2, y3)};
      *(u32x2*)(yrow + dim) = pk;
    }
}

constexpr int LDS_AK = 0, LDS_AV = LDS_AK + 2 * KB_BYTES, LDS_ATAB = LDS_AV + 2 * KB_BYTES, ATAB_ROW = 128;
__device__ void attn_a_block(const Params& p, int layer, int L, int seq, int h, int r0, LAS unsigned char* lds) {
  const int tid = opaque_tid(), lane = tid & 63, wid = __builtin_amdgcn_readfirstlane(tid >> 6);
  const int q = lane & 31, half = lane >> 5;
  const size_t tokbase = (size_t)seq * L;
  const int rows = L >> 6;
  const int r = r0 + (wid >> 1), cb2 = wid & 1;
  int rs = r - 4; rs = rs < 0 ? 0 : (rs > rows - 8 ? rows - 8 : rs);
  int kr_lo = r0 - 4; kr_lo = kr_lo < 0 ? 0 : (kr_lo > rows - 8 ? rows - 8 : kr_lo);
  int kr_hi = r0 - 1; kr_hi = (kr_hi < 0 ? 0 : (kr_hi > rows - 8 ? rows - 8 : kr_hi)) + 7;
  const int qcol = cb2 * 32 + q, tq = r * 64 + qcol;
  int qstart = qcol - 8; qstart = qstart < 0 ? 0 : (qstart > 48 ? 48 : qstart);
  bf16x8 qf[4];
  { const bf16_t* qp = p.u + (tokbase + tq) * UW + U_QA + h * 64 + half * 8;
#pragma unroll
    for (int ks = 0; ks < 4; ++ks) qf[ks] = ld16(qp + ks * 16); }
  {
    LAS float* tab = (LAS float*)(lds + LDS_ATAB);
    const float* rpb = p.rpb + ((size_t)layer * 8 + h) * 15 * 31;
    for (int idx = tid; idx < 15 * ATAB_ROW; idx += 512) { const int row = idx >> 7, cc = (idx & 127) - 48; tab[idx] = (cc >= 0 && cc <= 30) ? rpb[row * 31 + cc] * LOG2E : 0.f; }
  }
  const int spart = tid & 7, srow = tid >> 3;
  const bf16_t* kg = p.u + (tokbase + srow) * UW + U_KA + h * 64 + spart * 8;
  const bf16_t* vg = p.vt + ((size_t)seq * VW + V_A + h * 64 + srow) * L + spart * 8;
  const int kst = srow * TB_ROW + spart * 16;
  const int vst = srow * TB_ROW + ((spart >> 1) * 16 + (spart & 1) * 4) * 2;
  const int rd = q * TB_ROW + half * 16;
  f32x16 o[2] = {zero16(), zero16()};
  float mrun = -1e30f, lrun = 0.f;
  bf16x8 kr_, vr_;
  kr_ = ld16(kg + (size_t)(kr_lo * 64) * UW); vr_ = ld16(vg + kr_lo * 64);
  *(LAS bf16x8*)(lds + LDS_AK + kst) = kr_;
  *(LAS bf16x4*)(lds + LDS_AV + vst) = __builtin_shufflevector(vr_, vr_, 0, 1, 2, 3); *(LAS bf16x4*)(lds + LDS_AV + vst + 16) = __builtin_shufflevector(vr_, vr_, 4, 5, 6, 7);
  asm volatile("" : "+v"(qf[0]), "+v"(qf[1]), "+v"(qf[2]), "+v"(qf[3]));
  __syncthreads();
#pragma unroll 1
  for (int kr = kr_lo; kr <= kr_hi; ++kr) {
    const int it = kr - kr_lo;
    const bool more = (kr < kr_hi);
    if (more) { kr_ = ld16(kg + (size_t)((kr + 1) * 64) * UW); vr_ = ld16(vg + (kr + 1) * 64); }
    const LAS unsigned char* kb = lds + LDS_AK + (it & 1) * KB_BYTES;
    const LAS unsigned char* vb = lds + LDS_AV + (it & 1) * KB_BYTES;
    if (kr >= rs && kr < rs + 8) {
      const LAS float* trow = (const LAS float*)(lds + LDS_ATAB) + (kr - r + 7) * ATAB_ROW + (half * 4 - qcol + 15 + 48);
#pragma unroll
      for (int seg = 0; seg < 2; ++seg) {
        f32x16 sc = zero16();
#pragma unroll
        for (int ks = 0; ks < 4; ++ks) sc = mfma32(*(const LAS bf16x8*)(kb + rd + seg * 32 * TB_ROW + ks * 32), qf[ks], sc);
#pragma unroll
        for (int ii = 0; ii < 16; ++ii) {
          const int kcol = seg * 32 + (ii >> 2) * 8 + half * 4 + (ii & 3);
          const bool ok = (kcol >= qstart) && (kcol < qstart + 16);
          sc[ii] = ok ? sc[ii] + trow[seg * 32 + (ii >> 2) * 8 + (ii & 3)] : -INFINITY;
        }
        float al; bf16x8 pk[2];
        softmax_tile(sc, mrun, lrun, al, pk[0], pk[1]);
        if (__builtin_amdgcn_ballot_w64(al != 1.0f) != 0) { o[0] *= al; o[1] *= al; }
#pragma unroll
        for (int dt = 0; dt < 2; ++dt)
#pragma unroll
          for (int s2 = 0; s2 < 2; ++s2) o[dt] = mfma32(*(const LAS bf16x8*)(vb + rd + dt * 32 * TB_ROW + (seg * 2 + s2) * 32), pk[s2], o[dt]);
      }
    }
    if (more) {
      LAS unsigned char* kbn = lds + LDS_AK + ((it + 1) & 1) * KB_BYTES; LAS unsigned char* vbn = lds + LDS_AV + ((it + 1) & 1) * KB_BYTES;
      *(LAS bf16x8*)(kbn + kst) = kr_;
      *(LAS bf16x4*)(vbn + vst) = __builtin_shufflevector(vr_, vr_, 0, 1, 2, 3); *(LAS bf16x4*)(vbn + vst + 16) = __builtin_shufflevector(vr_, vr_, 4, 5, 6, 7);
    }
    __syncthreads();
  }
  const float c = frcp(lrun + __shfl_xor(lrun, 32));
  bf16_t* yrow = p.yg + (tokbase + tq) * YW + h * 64;
  const bf16_t* zrow = p.u + (tokbase + tq) * UW + U_ZA + h * 64;
#pragma unroll
  for (int dt = 0; dt < 2; ++dt)
#pragma unroll
    for (int g4 = 0; g4 < 4; ++g4) {
      const int dim = dt * 32 + g4 * 8 + half * 4;
      const u32x2 zr = *(const u32x2*)(zrow + dim);
      const float y0 = o[dt][g4 * 4 + 0] * c * silu(bf_lo(zr[0]));
      const float y1 = o[dt][g4 * 4 + 1] * c * silu(bf_hi(zr[0]));
      const float y2 = o[dt][g4 * 4 + 2] * c * silu(bf_lo(zr[1]));
      const float y3 = o[dt][g4 * 4 + 3] * c * silu(bf_hi(zr[1]));
      u32x2 pk = {cvt_pk_bf16(y0, y1), cvt_pk_bf16(y2, y3)};
      *(u32x2*)(yrow + dim) = pk;
    }
}

__device__ void attn_c_unit(const Params& p, int L, int lshift, int seq, int g, int h, int rr, int mblk, int lane) {
  const int q = lane & 31, half = lane >> 5;
  const size_t tokbase = (size_t)seq * L;
  const int ds = (g == 0) ? 0 : (g == 1 ? 2 : 4), d = 1 << ds, M = L >> ds;
  const int hh = g * 4 + h;
  const int m0 = mblk * 32, mq = m0 + q, tq = mq * d + rr;
  const bf16_t* urow = p.u + (tokbase + tq) * UW;
  bf16x8 qf[4];
#pragma unroll
  for (int ks = 0; ks < 4; ++ks) qf[ks] = ld16(urow + U_QC + hh * 64 + ks * 16 + half * 8);
  f32x16 o[2] = {zero16(), zero16()};
  float mrun = -1e30f, lrun = 0.f;
  const float coef = exp2f(-(2.0f / 3.0f) * (float)(hh + 1)) * (float)d * LOG2E;
  const bf16_t* vbase = p.vt + ((size_t)seq * VW + V_C + hh * 64 + q) * L + (size_t)rr * M;
  bf16x8 kf[5][4];
#pragma unroll
  for (int j = 0; j < 5; ++j) {
    int mkl = m0 - 64 + 32 * j + q; mkl = mkl < 0 ? 0 : (mkl > M - 1 ? M - 1 : mkl);
    const bf16_t* kp = p.u + (tokbase + (size_t)mkl * d + rr) * UW + U_KC + hh * 64 + half * 8;
#pragma unroll
    for (int ks = 0; ks < 4; ++ks) kf[j][ks] = ld16(kp + ks * 16);
  }
  bf16x8 vf[2][2][2];
  auto load_v = [&](int j, bf16x8 (&dst)[2][2]) {
#pragma unroll
    for (int dt = 0; dt < 2; ++dt)
#pragma unroll
      for (int s2 = 0; s2 < 2; ++s2) {
        int pa = m0 - 64 + 32 * j + s2 * 16 + half * 4, pb = pa + 8;
        pa = pa < 0 ? 0 : (pa > M - 4 ? M - 4 : pa); pb = pb < 0 ? 0 : (pb > M - 4 ? M - 4 : pb);
        const bf16_t* vp = vbase + (size_t)(dt * 32) * L;
        dst[dt][s2] = ld8x2(vp + pa, vp + pb);
      }
  };
  load_v(0, vf[0]);
#pragma unroll
  for (int j = 0; j < 5; ++j) {
    if (j + 1 < 5) load_v(j + 1, vf[(j + 1) & 1]);
    const int mk0 = m0 - 64 + 32 * j;
    if (mk0 + 32 <= 0 || mk0 >= M) continue;
    f32x16 s = zero16();
#pragma unroll
    for (int ks = 0; ks < 4; ++ks) s = mfma32(kf[j][ks], qf[ks], s);
#pragma unroll
    for (int ii = 0; ii < 16; ++ii) {
      const int mk = mk0 + (ii >> 2) * 8 + half * 4 + (ii & 3);
      const int rel = mk - mq; const int ar = rel < 0 ? -rel : rel;
      const bool ok = (mk >= 0) && (mk < M) && (ar <= 64);
      s[ii] = ok ? s[ii] - coef * (float)ar : -INFINITY;
    }
    float alpha; bf16x8 pk[2];
    softmax_tile(s, mrun, lrun, alpha, pk[0], pk[1]);
#pragma unroll
    for (int dt = 0; dt < 2; ++dt) {
      o[dt] *= alpha;
#pragma unroll
      for (int s2 = 0; s2 < 2; ++s2) o[dt] = mfma32(vf[j & 1][dt][s2], pk[s2], o[dt]);
    }
  }
  const float lt = lrun + __shfl_xor(lrun, 32);
  const float c = frcp(lt);
  bf16_t* orow = p.oc + (tokbase + tq) * 768 + hh * 64;
#pragma unroll
  for (int dt = 0; dt < 2; ++dt)
#pragma unroll
    for (int g4 = 0; g4 < 4; ++g4) {
      const int dim = dt * 32 + g4 * 8 + half * 4;
      u32x2 pk = {cvt_pk_bf16(o[dt][g4 * 4 + 0] * c, o[dt][g4 * 4 + 1] * c), cvt_pk_bf16(o[dt][g4 * 4 + 2] * c, o[dt][g4 * 4 + 3] * c)};
      *(u32x2*)(orow + dim) = pk;
    }
  if (half == 0) p.lse[(tokbase + tq) * 12 + hh] = mrun + log2f(lt);
}

__device__ void phase_attn(const Params& p, int layer, int L, int lshift, LAS unsigned char* lds) {
  const int tiles = L >> 5;
  const int nseq = TC >> lshift;
  const int nw = gridDim.x * 8;
  int w, lane;
  { const int qblks = L >> 8, npairs = nseq * 4, nunits = npairs * qblks;
    for (int rep = 0; rep < PROBE_B; ++rep)
    for (int b = blockIdx.x; b < nunits; b += gridDim.x) {
      int pair, qblk;
      if ((gridDim.x & 7) == 0 && (npairs & 7) == 0 && nunits == (int)gridDim.x) { const int xcd = b & 7, j = b >> 3; pair = xcd * (npairs >> 3) + j / qblks; qblk = j % qblks; }
      else { pair = b / qblks; qblk = b % qblks; }
      attn_b_block(p, layer, L, pair >> 2, pair & 3, qblk, lds);
    }
  }
  { const int tid = opaque_tid(); lane = tid & 63; w = blockIdx.x * 8 + __builtin_amdgcn_readfirstlane(tid >> 6); }
  for (int rep = 0; rep < PROBE_AC; ++rep) {
  { const int rgs = L >> 8, nunits = nseq * 8 * rgs;
    for (int b = blockIdx.x; b < nunits; b += gridDim.x) { const int sh = b / rgs, rg = b % rgs; attn_a_block(p, layer, L, sh >> 3, sh & 7, rg * 4, lds); }
  }
  { const int tid = opaque_tid(); lane = tid & 63; w = blockIdx.x * 8 + __builtin_amdgcn_readfirstlane(tid >> 6); }
  for (int uc = w; uc < nseq * 12 * tiles; uc += nw) {
    const int idx = uc % tiles, sgh = uc / tiles;
    const int seq = sgh / 12, gh = sgh % 12, g = gh >> 2, h = gh & 3;
    const int ds = (g == 0) ? 0 : (g == 1 ? 2 : 4);
    const int mb = (L >> ds) >> 5;
    attn_c_unit(p, L, lshift, seq, g, h, idx / mb, idx % mb, lane);
  }
  }
}

__device__ void phase_combine(const Params& p) {
  const int gt = blockIdx.x * 512 + opaque_tid(), ngt = gridDim.x * 512;
  for (int it = gt; it < TC * 32; it += ngt) {
    const int tok = it >> 5, sub = it & 31, h = sub >> 3, d8 = (sub & 7) * 8;
    const float* ls = p.lse + (size_t)tok * 12;
    const float l0 = ls[h], l1 = ls[4 + h], l2 = ls[8 + h];
    const float mx = fmaxf(l0, fmaxf(l1, l2));
    const float w0 = fexp2(l0 - mx), w1 = fexp2(l1 - mx), w2 = fexp2(l2 - mx);
    const float inv = frcp(w0 + w1 + w2);
    const bf16_t* ob = p.oc + (size_t)tok * 768 + h * 64 + d8;
    const u32x4 a = *(const u32x4*)ob, b = *(const u32x4*)(ob + 256), c = *(const u32x4*)(ob + 512);
    const u32x4 z = *(const u32x4*)(p.u + (size_t)tok * UW + U_ZC + h * 64 + d8);
    u32x4 r;
#pragma unroll
    for (int k = 0; k < 4; ++k) {
      const float vlo = (w0 * bf_lo(a[k]) + w1 * bf_lo(b[k]) + w2 * bf_lo(c[k])) * inv * silu(bf_lo(z[k]));
      const float vhi = (w0 * bf_hi(a[k]) + w1 * bf_hi(b[k]) + w2 * bf_hi(c[k])) * inv * silu(bf_hi(z[k]));
      r[k] = cvt_pk_bf16(vlo, vhi);
    }
    *(u32x4*)(p.yg + (size_t)tok * YW + 1024 + h * 64 + d8) = r;
  }
}


#define XB_TMO      128
#define XB_XCNT(j)  (256  + 64 * (j))
#define XB_XSUB(j)  (1280 + 64 * (j))
#define XB_XGEN(j)  (2304 + 64 * (j))
#define XB_TOP      3328
#define XB_TOPGEN   3392
#define XCD_BAR_WORDS 3456
#define XB_SPIN_CAP (1u << 18)
__device__ __forceinline__ unsigned xb_ld(unsigned* p)              { return __hip_atomic_load(p, __ATOMIC_RELAXED, __HIP_MEMORY_SCOPE_AGENT); }
__device__ __forceinline__ unsigned xb_add(unsigned* p, unsigned v) { return __hip_atomic_fetch_add(p, v, __ATOMIC_RELAXED, __HIP_MEMORY_SCOPE_AGENT); }
__device__ __forceinline__ unsigned xb_xcc_id() { return (unsigned)__builtin_amdgcn_s_getreg((3 << 11) | 20) & 0xFu; }
#define XB_SPIN(cond, bar) do { unsigned _sp = 0; while (cond) { __builtin_amdgcn_s_sleep(1); \
    if ((++_sp & 255u) == 0u) { if (xb_ld(&(bar)[XB_TMO])) break; if (_sp > XB_SPIN_CAP) { atomicAdd(&(bar)[XB_TMO], 1u); break; } } } } while (0)
struct XcdBarrier { unsigned* bar; unsigned x; volatile LAS unsigned* st; };
__device__ __forceinline__ XcdBarrier xcd_barrier_post(unsigned* bar, volatile LAS unsigned* st) {
  XcdBarrier b; b.bar = bar; b.x = xb_xcc_id(); b.st = st;
  if (opaque_tid() == 0) (void)xb_add(&bar[XB_XCNT(b.x)], 1u);
  return b;
}
__device__ __forceinline__ void xcd_barrier_complete(unsigned* bar, unsigned x, unsigned& nloc, unsigned& nx) {
  const unsigned G = gridDim.x * gridDim.y * gridDim.z;
  unsigned sum, cnt, mine, sp = 0u;
  for (;;) {
    sum = 0u; cnt = 0u; mine = 0u;
#pragma unroll
    for (unsigned j = 0; j < 16; ++j) { const unsigned c = xb_ld(&bar[XB_XCNT(j)]); sum += c; cnt += (c > 0u) ? 1u : 0u; mine = (j == x) ? c : mine; }
    if (sum == G) break;
    __builtin_amdgcn_s_sleep(1);
    if ((++sp & 255u) == 0u) { if (xb_ld(&bar[XB_TMO])) break; if (sp > XB_SPIN_CAP) { atomicAdd(&bar[XB_TMO], 1u); break; } }
  }
  nloc = mine > 0u ? mine : 1u; nx = cnt > 0u ? cnt : 1u;
}
__device__ __forceinline__ void xcd_barrier(const XcdBarrier& b) {
  asm volatile("s_waitcnt vmcnt(0)" ::: "memory");
  __syncthreads();
  if (opaque_tid() == 0) {
    unsigned* bar = b.bar;
    __builtin_amdgcn_s_waitcnt(0);
    unsigned nloc = b.st[0], nx = b.st[1];
    if (nloc == 0u) { xcd_barrier_complete(bar, b.x, nloc, nx); b.st[0] = nloc; b.st[1] = nx; }
    const unsigned old = xb_add(&bar[XB_XSUB(b.x)], 1u);
    const unsigned gen = old / nloc;
    if (old + 1u == (gen + 1u) * nloc) {
      __builtin_amdgcn_fence(__ATOMIC_RELEASE, "agent");
      asm volatile("s_waitcnt vmcnt(0)" ::: "memory");
      const unsigned og = xb_add(&bar[XB_TOP], 1u);
      const unsigned tg = og / nx;
      if (og + 1u == (tg + 1u) * nx) xb_add(&bar[XB_TOPGEN], 1u);
      else XB_SPIN(xb_ld(&bar[XB_TOPGEN]) == tg, bar);
      __builtin_amdgcn_fence(__ATOMIC_ACQUIRE, "agent");
      xb_add(&bar[XB_XGEN(b.x)], 1u);
      asm volatile("s_waitcnt vmcnt(0)" ::: "memory");
    } else {
      XB_SPIN(xb_ld(&bar[XB_XGEN(b.x)]) == gen, bar);
      __builtin_amdgcn_fence(__ATOMIC_ACQUIRE, "agent");
      asm volatile("s_waitcnt vmcnt(0)" ::: "memory");
    }
  }
  __syncthreads();
}

__global__ void __launch_bounds__(512) fwd_megakernel(Params p) {
  __shared__ __attribute__((aligned(16))) unsigned char smem[LDS_ATT_TOTAL > pg8::STAGE_BYTES ? LDS_ATT_TOTAL : pg8::STAGE_BYTES];
  __shared__ __attribute__((aligned(16))) unsigned xb_words[4];
  cg::grid_group grid = cg::this_grid();
  if (threadIdx.x == 0) { xb_words[0] = 0u; xb_words[1] = 0u; xb_words[2] = 0u; xb_words[3] = 0u; }
  if ((threadIdx.x & 63) == 0) g_wid_table[hw_wave_slot()] = (int)(threadIdx.x >> 6);
  __syncthreads();
  const XcdBarrier xb = xcd_barrier_post(p.bar, (volatile LAS unsigned*)xb_words);
#define GSYNC() do { for (int rep_ = 0; rep_ < PROBE_SYNC; ++rep_) xcd_barrier(xb); } while (0)
  LAS unsigned char* lds = (LAS unsigned char*)smem;
  for (int rep = 0; rep < PROBE_SMALL; ++rep) phase_prep(p, (LAS float*)smem);
  for (int rep = 0; rep < PROBE_SMALL; ++rep) phase_x(p, 0);
  grid.sync();
  for (int chunk = 0; chunk < NCHUNK; ++chunk) {
    const int L = chunk < 2 ? 2048 : 4096, lshift = chunk < 2 ? 11 : 12;
    const float* xin = (chunk < 2) ? p.xp + (size_t)chunk * TC * DM : p.xs + (size_t)(chunk - 2) * TC * DM;
    float* xres = p.out + (size_t)chunk * TC * DM;
    float* ssq = p.ssq + (size_t)chunk * TC * 16;
    for (int layer = 0; layer < DEPTH; ++layer) {
      {
        for (int rep = 0; rep < PROBE_P1; ++rep) {
        { pg8::Gemm g{p.xb, p.wt_in + (size_t)layer * INW * DM, TC, UW, DM, 0, lshift};
          pg8::StaticOrder S; S.init(TC, UW, gridDim.x, blockIdx.x);
          EpiU E{p.u, p.rinv + (size_t)chunk * TC, p.b_gate + (size_t)layer * 3 * DM};
          pg8::gemm_phase(lds, g, S, E); }
        {
          pg8::Gemm g{p.wt_in + ((size_t)layer * INW + UW) * DM, p.xb, VW, TC, DM, 1, lshift};
          pg8::StaticOrder S; S.init(VW, TC, gridDim.x, (blockIdx.x + (gridDim.x >> 2)) % gridDim.x);
          EpiVT E{p.vt, p.rinv + (size_t)chunk * TC, L, lshift};
          pg8::gemm_phase(lds, g, S, E); }
        if (rep + 1 < PROBE_P1) GSYNC();
        }
      }
      GSYNC();
      for (int rep = 0; rep < PROBE_ATT; ++rep) { phase_attn(p, layer, L, lshift, lds);
      GSYNC(); }
      for (int rep = 0; rep < PROBE_SMALL; ++rep) phase_combine(p);
      GSYNC();
      {
        pg8::Gemm g{p.yg, p.wt_br + (size_t)layer * DM * YW, TC, DM, YW, 0, 0};
        pg8::StaticOrder S; S.init(TC, DM, gridDim.x, blockIdx.x);
        EpiMerge E{p.u, p.merged};
        for (int rep = 0; rep < PROBE_3A; ++rep) pg8::gemm_phase(lds, g, S, E);
      }
      GSYNC();
      {
        pg8::Gemm g{p.merged, p.wt_out + (size_t)layer * DM * DM, TC, DM, DM, 0, 0};
        pg8::StaticOrder S; S.init(TC, DM, gridDim.x, blockIdx.x);
        EpiRes E{layer == 0 ? xin : (const float*)xres, xres, p.xb, ssq};
        pg8::gemm_phase(lds, g, S, E);
        if (PROBE_3B > 1 && layer == 0) { for (int rep = 0; rep < 4 * (PROBE_3B - 1); ++rep) pg8::gemm_phase(lds, g, S, E); }
      }
      GSYNC();
      if (layer + 1 < DEPTH) { phase_rinv(p, chunk); GSYNC(); }
    }
    phase_final(p, chunk);
    if (chunk + 1 < NCHUNK) { for (int rep = 0; rep < PROBE_SMALL; ++rep) phase_x(p, chunk + 1); GSYNC(); }
  }
}

extern "C" void kernel_launch(void* const* d_in, const int* in_sizes, int n_in, void* d_out, int out_size, void* d_ws, size_t ws_size, hipStream_t stream) {
  (void)in_sizes; (void)n_in; (void)out_size;
  static int grid_blocks = 0;
  if (!grid_blocks) {
    int dev = 0, cus = 0, per_cu = 0;
    hipGetDevice(&dev);
    hipDeviceGetAttribute(&cus, hipDeviceAttributeMultiprocessorCount, dev);
    hipOccupancyMaxActiveBlocksPerMultiprocessor(&per_cu, fwd_megakernel, 512, 0);
    if (per_cu < 1) per_cu = 1;
    grid_blocks = cus * per_cu;
    if (grid_blocks > 256) grid_blocks = 256;
  }
  Params p{};
  p.xp = (const float*)d_in[0]; p.xs = (const float*)d_in[1]; p.g_norm = (const float*)d_in[2]; p.w_in = (const float*)d_in[3];
  p.b_gate = (const float*)d_in[4]; p.rpb = (const float*)d_in[5]; p.lam_qk = (const float*)d_in[6]; p.g_diff = (const float*)d_in[7];
  p.w_br_a = (const float*)d_in[8]; p.w_br_b = (const float*)d_in[9]; p.w_br_c = (const float*)d_in[10]; p.w_out = (const float*)d_in[11];
  p.g_final = (const float*)d_in[12];
  p.out = (float*)d_out;
  char* w = (char*)d_ws; size_t off = 0;
  auto take = [&](size_t bytes) { char* r = w + off; off += (bytes + 255) & ~(size_t)255; return r; };
  p.wt_in = (bf16_t*)take((size_t)DEPTH * INW * DM * 2);
  p.wt_br = (bf16_t*)take((size_t)DEPTH * DM * YW * 2);
  p.wt_out = (bf16_t*)take((size_t)DEPTH * DM * DM * 2);
  p.xb = (bf16_t*)take((size_t)TC * DM * 2);
  p.u = (bf16_t*)take((size_t)TC * UW * 2);
  p.vt = (bf16_t*)take((size_t)TC * VW * 2);
  p.yg = (bf16_t*)take((size_t)TC * YW * 2);
  p.oc = (bf16_t*)take((size_t)TC * 768 * 2);
  p.merged = (bf16_t*)take((size_t)TC * DM * 2);
  p.lse = (float*)take((size_t)TC * 12 * 4);
  p.ssq = (float*)take((size_t)NTOK * 16 * 4);
  p.lam = (float*)take(256);
  p.rinv = (float*)take((size_t)NTOK * 4);
  p.bar = (unsigned*)take((size_t)XCD_BAR_WORDS * 4);
  if (off > ws_size) fprintf(stderr, "workspace too small: need %zu have %zu\n", off, ws_size);
  hipMemsetAsync(p.bar, 0, (size_t)XCD_BAR_WORDS * 4, stream);
  void* args[] = {&p};
  hipError_t e = hipLaunchCooperativeKernel((void*)fwd_megakernel, dim3(grid_blocks), dim3(512), args, 0, stream);
  if (e != hipSuccess) fprintf(stderr, "cooperative launch failed: %s (grid %d)\n", hipGetErrorString(e), grid_blocks);
}
```

```cpp
#include <hip/hip_runtime.h>
#include <hip/hip_cooperative_groups.h>
#include <cstdio>
namespace cg = cooperative_groups;
#ifndef PROBE_B
#define PROBE_B 1
#endif
#ifndef PROBE_AC
#define PROBE_AC 1
#endif
#ifndef PROBE_P1
#define PROBE_P1 1
#endif
#ifndef PROBE_3A
#define PROBE_3A 1
#endif
#ifndef PROBE_SMALL
#define PROBE_SMALL 1
#endif
#ifndef PROBE_3B
#define PROBE_3B 1
#endif
#ifndef PROBE_ATT
#define PROBE_ATT 1
#endif
#ifndef PROBE_SYNC
#define PROBE_SYNC 1
#endif

#define LAS __attribute__((address_space(3)))
typedef unsigned short bf16_t;
typedef short bf16x8 __attribute__((ext_vector_type(8)));
typedef short bf16x4 __attribute__((ext_vector_type(4)));
typedef float f32x4 __attribute__((ext_vector_type(4)));
typedef float f32x16 __attribute__((ext_vector_type(16)));
typedef unsigned u32x4 __attribute__((ext_vector_type(4)));
typedef unsigned u32x2 __attribute__((ext_vector_type(2)));

constexpr int DM = 1024, DEPTH = 4, INW = 9728, UW = 7936, VW = 1792, YW = 1280;
constexpr int TC = 16384, NCHUNK = 4, NTOK = 65536;
constexpr float LOG2E = 1.4426950408889634f;
constexpr float QSCALE = 0.125f * LOG2E;
constexpr int U_QA = 0, U_KA = 512, U_ZA = 1024, U_QB = 1536, U_KB = 2048, U_ZB = 2560, U_QC = 3072, U_KC = 3840, U_ZC = 4608, U_GL = 4864;
constexpr int V_A = 0, V_B = 512, V_C = 1024;

struct Params {
  const float *xp, *xs, *g_norm, *w_in, *b_gate, *rpb, *lam_qk, *g_diff, *w_br_a, *w_br_b, *w_br_c, *w_out, *g_final;
  float* out;
  bf16_t *wt_in, *wt_br, *wt_out, *xb, *u, *vt, *yg, *oc, *merged;
  float *lse, *ssq, *lam, *rinv;
  unsigned* bar;
};

__device__ __forceinline__ unsigned cvt_pk_bf16(float lo, float hi) { unsigned r; asm volatile("v_cvt_pk_bf16_f32 %0, %1, %2" : "=v"(r) : "v"(lo), "v"(hi)); return r; }
__device__ __forceinline__ float bf_lo(unsigned v) { return __uint_as_float(v << 16); }
__device__ __forceinline__ float bf_hi(unsigned v) { return __uint_as_float(v & 0xffff0000u); }
__device__ __forceinline__ float fexp2(float x) { return __builtin_amdgcn_exp2f(x); }
__device__ __forceinline__ float frcp(float x) { return __builtin_amdgcn_rcpf(x); }

__shared__ int g_wid_table[64];
__device__ __forceinline__ unsigned hw_wave_slot() { return (unsigned)__builtin_amdgcn_s_getreg(((6 - 1) << 11) | (0 << 6) | 4) & 63u; }
__device__ __forceinline__ int opaque_tid() {
  const int wid = __builtin_amdgcn_readfirstlane(g_wid_table[hw_wave_slot()]);
  unsigned z = 0u; asm volatile("" : "+v"(z));
  int t = wid * 64 + (int)__builtin_amdgcn_mbcnt_hi(~0u, __builtin_amdgcn_mbcnt_lo(~0u, z));
  asm volatile("" : "+v"(t)); return t;
}

namespace pg8 {
constexpr int BM = 256, BK = 64, HALF = 128, HTB = HALF * BK * 2, STAGE_BYTES = 8 * HTB, NXCD = 8, WGM = 8;
__device__ __forceinline__ int lds_byte(int r, int c) { const int st = (r >> 4) * 2 + (c >> 5), rr = r & 15, cc = c & 31, ob = rr * 64 + cc * 2; return st * 1024 + (ob ^ (((ob >> 9) & 1) << 5)); }
__device__ __forceinline__ void stage_rc(int b, int& R, int& C) { const int st = b / 1024, sb = b % 1024, swz = sb ^ (((sb >> 9) & 1) << 5); R = (st >> 1) * 16 + swz / 64; C = (st & 1) * 32 + (swz % 64) / 2; }
__device__ __forceinline__ int perm32(int rho) { const int n = rho >> 4, i = rho & 15; return 8 * (i >> 2) + 4 * n + (i & 3); }
struct Unit { int pm, pn; };
struct Gemm { const bf16_t* A; const bf16_t* Bt; int M, N, K; int bperm, lshift; };
struct StaticOrder {
  int nM, nN, nwg, G, c;
  __device__ void init(int M, int N, int G_, int c_) { nM = M / BM; nN = N / BM; nwg = nM * nN; G = G_; c = c_; }
  __device__ bool next(int i, Unit& u) const {
    const long L = (long)i * G + c; if (L >= nwg) return false;
    int wgid = (int)L; { const int q = nwg / NXCD, r = nwg % NXCD, xcd = wgid % NXCD, off = wgid / NXCD; wgid = (xcd < r ? xcd * (q + 1) : r * (q + 1) + (xcd - r) * q) + off; }
    const int nig = WGM * nN, gid = wgid / nig, fm = gid * WGM, gsz = (nM - fm) < WGM ? (nM - fm) : WGM;
    u.pm = fm + ((wgid % nig) % gsz); u.pn = (wgid % nig) / gsz; return true;
  }
};

template <class Epi>
__device__ __forceinline__ void gemm_phase(LAS unsigned char* lds, const Gemm g, const StaticOrder& S, const Epi& E) {
  const int tid_ = opaque_tid();
  const int tid = tid_, wid = __builtin_amdgcn_readfirstlane(tid >> 6), lane = tid & 63, wr = wid >> 2, wc = wid & 3, fr = lane & 15, fq = lane >> 4;
  const int K = g.K, nt = K / BK;
  const size_t kstep = (size_t)(BK * 2);
  const size_t hstep = (size_t)HALF * K * 2;
  const size_t tstep = 2 * hstep;
  unsigned voffA[2], voffBr[2], voffBc[2], voffB[2], voffBn[2];
#pragma unroll
  for (int i = 0; i < 2; ++i) { int R, C; stage_rc(tid * 16 + i * 8192, R, C); const int Rb = (R & ~31) + perm32(R & 31);
    voffA[i] = (unsigned)(R * K + C) * 2u; voffBr[i] = (unsigned)(Rb * K) * 2u; voffBc[i] = (unsigned)C * 2u; voffB[i] = voffBr[i] + voffBc[i]; voffBn[i] = voffB[i]; }
  auto bbase = [&](const Unit& u, int hh, int& sh) -> const char* {
    if (!g.bperm) { sh = 0; return (const char*)g.Bt + (size_t)u.pn * tstep + (size_t)hh * hstep; }
    const int ds = u.pm <= 4 ? 0 : (u.pm == 5 ? 2 : 4); sh = ds;
    const int L = 1 << g.lshift; const int p0 = u.pn * 256 + hh * 128, seq = p0 >> g.lshift, p = p0 & (L - 1);
    const int Mc = L >> ds, r = p / Mc, m0 = p & (Mc - 1);
    return (const char*)g.Bt + ((size_t)seq * L + ((size_t)m0 << ds) + r) * (size_t)K * 2;
  };
  const unsigned ldsw = (unsigned)wid * 1024u;
  const int aoff = lds_byte(wr * 64 + fr, fq * 8), boff = lds_byte(wc * 32 + fr, fq * 8);
#define PG8_SA(b, h) (((b) * 2 + (h)) * HTB)
#define PG8_SB(b, h) ((4 + (b) * 2 + (h)) * HTB)
#define PG8_STAGE(bufoff, gbase, voff) do { _Pragma("unroll") for (int _i = 0; _i < 2; ++_i) \
    __builtin_amdgcn_global_load_lds((const unsigned*)((const char*)(gbase) + (voff)[_i]), (LAS unsigned*)(lds + (bufoff) + ldsw + _i * 8192), 16, 0, 0); } while (0)
#define PG8_LDA(dst, b, h) do { _Pragma("unroll") for (int m = 0; m < 4; ++m) _Pragma("unroll") for (int k = 0; k < 2; ++k) dst[m][k] = *(const LAS bf16x8*)(lds + PG8_SA(b, h) + aoff + m * 2048 + k * 1024); } while (0)
#define PG8_LDB(dst, b, h) do { _Pragma("unroll") for (int n = 0; n < 2; ++n) _Pragma("unroll") for (int k = 0; k < 2; ++k) dst[n][k] = *(const LAS bf16x8*)(lds + PG8_SB(b, h) + boff + n * 2048 + k * 1024); } while (0)
#define PG8_MMA(ai, bj, At, Bt) do { __builtin_amdgcn_s_setprio(1); _Pragma("unroll") for (int m = 0; m < 4; ++m) _Pragma("unroll") for (int n = 0; n < 2; ++n) _Pragma("unroll") for (int k = 0; k < 2; ++k) \
    acc[ai][bj][m][n] = __builtin_amdgcn_mfma_f32_16x16x32_bf16(Bt[n][k], At[m][k], acc[ai][bj][m][n], 0, 0, 0); __builtin_amdgcn_s_setprio(0); } while (0)
#define PG8_WAIT_V(n) asm volatile("s_waitcnt vmcnt(" #n ")" ::: "memory")
#define PG8_WAIT_L(n) asm volatile("s_waitcnt lgkmcnt(" #n ")" ::: "memory")
#define PG8_BAR __builtin_amdgcn_s_barrier()
#define PG8_SCHED __builtin_amdgcn_sched_barrier(0)
  Unit cur, nxt; int ui = 0;
  if (!S.next(0, cur)) return;
  f32x4 acc[2][2][4][2];
#pragma unroll
  for (int a = 0; a < 2; ++a)
#pragma unroll
    for (int b = 0; b < 2; ++b)
#pragma unroll
      for (int m = 0; m < 4; ++m)
#pragma unroll
        for (int n = 0; n < 2; ++n) acc[a][b][m][n] = (f32x4){0.f, 0.f, 0.f, 0.f};
  bf16x8 At[4][2], B0[2][2], B1[2][2];
  const char* cA = (const char*)g.A + (size_t)cur.pm * tstep;
  int csh; const char* cB0 = bbase(cur, 0, csh); const char* cB1 = bbase(cur, 1, csh);
#pragma unroll
  for (int i = 0; i < 2; ++i) voffB[i] = (voffBr[i] << csh) + voffBc[i];
  PG8_STAGE(PG8_SB(0, 0), cB0, voffB); PG8_STAGE(PG8_SA(0, 0), cA, voffA); PG8_STAGE(PG8_SB(0, 1), cB1, voffB); PG8_STAGE(PG8_SA(0, 1), cA + hstep, voffA);
  if (wr == 1) PG8_BAR;
  PG8_WAIT_V(4); PG8_BAR;
  PG8_STAGE(PG8_SB(1, 0), cB0 + kstep, voffB); PG8_STAGE(PG8_SA(1, 0), cA + kstep, voffA); PG8_STAGE(PG8_SB(1, 1), cB1 + kstep, voffB);
  PG8_WAIT_V(6); PG8_BAR;
  for (;;) {
    const bool has_next = S.next(ui + 1, nxt);
    const char* nA = cA; const char* nB0 = cB0; const char* nB1 = cB1;
#pragma unroll
    for (int i = 0; i < 2; ++i) voffBn[i] = voffB[i];
    if (has_next) { int nsh; nA = (const char*)g.A + (size_t)nxt.pm * tstep; nB0 = bbase(nxt, 0, nsh); nB1 = bbase(nxt, 1, nsh);
#pragma unroll
      for (int i = 0; i < 2; ++i) voffBn[i] = (voffBr[i] << nsh) + voffBc[i]; }
    for (int t = 0; t < nt; t += 2) {
      if constexpr (Epi::HOOK) { if (t == 8 || t == 16) E.hook(acc, cur, t, wr, wc, fr, fq); }
      const bool last = (t == nt - 2);
      const char* a1 = cA + (size_t)(t + 1) * kstep;
      const char* a2 = last ? nA : cA + (size_t)(t + 2) * kstep;
      const char* b20 = last ? nB0 : cB0 + (size_t)(t + 2) * kstep; const char* b21 = last ? nB1 : cB1 + (size_t)(t + 2) * kstep;
      const char* a3 = a2 + kstep; const char* b30 = b20 + kstep; const char* b31 = b21 + kstep;
      unsigned vB[2];
#pragma unroll
      for (int i = 0; i < 2; ++i) vB[i] = last ? voffBn[i] : voffB[i];
      PG8_LDB(B0, 0, 0); PG8_SCHED; PG8_LDA(At, 0, 0); PG8_STAGE(PG8_SA(1, 1), a1 + hstep, voffA);
      PG8_WAIT_L(8); PG8_BAR; PG8_WAIT_L(0); PG8_MMA(0, 0, At, B0); PG8_BAR; PG8_SCHED;
      PG8_LDB(B1, 0, 1); PG8_STAGE(PG8_SB(0, 0), b20, vB);
      PG8_BAR; PG8_WAIT_L(0); PG8_MMA(0, 1, At, B1); PG8_BAR;
      PG8_LDA(At, 0, 1); PG8_STAGE(PG8_SA(0, 0), a2, voffA);
      PG8_BAR; PG8_WAIT_L(0); PG8_MMA(1, 0, At, B0); PG8_BAR; PG8_SCHED;
      PG8_STAGE(PG8_SB(0, 1), b21, vB);
      PG8_WAIT_V(6); PG8_BAR; PG8_MMA(1, 1, At, B1); PG8_BAR;
      PG8_LDB(B0, 1, 0); PG8_SCHED; PG8_LDA(At, 1, 0); PG8_STAGE(PG8_SA(0, 1), a2 + hstep, voffA);
      PG8_WAIT_L(8); PG8_BAR; PG8_WAIT_L(0); PG8_MMA(0, 0, At, B0); PG8_BAR; PG8_SCHED;
      PG8_LDB(B1, 1, 1); PG8_STAGE(PG8_SB(1, 0), b30, vB);
      PG8_BAR; PG8_WAIT_L(0); PG8_MMA(0, 1, At, B1); PG8_BAR;
      PG8_LDA(At, 1, 1); PG8_STAGE(PG8_SA(1, 0), a3, voffA);
      PG8_BAR; PG8_WAIT_L(0); PG8_MMA(1, 0, At, B0); PG8_BAR; PG8_SCHED;
      PG8_STAGE(PG8_SB(1, 1), b31, vB);
      PG8_WAIT_V(6); PG8_BAR; PG8_MMA(1, 1, At, B1); PG8_BAR;
    }
    E(acc, cur, wr, wc, fr, fq);
    if (!has_next) break;
#pragma unroll
    for (int a = 0; a < 2; ++a)
#pragma unroll
      for (int b = 0; b < 2; ++b)
#pragma unroll
        for (int m = 0; m < 4; ++m)
#pragma unroll
          for (int n = 0; n < 2; ++n) acc[a][b][m][n] = (f32x4){0.f, 0.f, 0.f, 0.f};
    cur = nxt; cA = nA; cB0 = nB0; cB1 = nB1; ++ui;
#pragma unroll
    for (int i = 0; i < 2; ++i) voffB[i] = voffBn[i];
  }
  PG8_WAIT_V(0);
  if (wr == 0) PG8_BAR;
  PG8_BAR;
#undef PG8_SA
#undef PG8_SB
#undef PG8_STAGE
#undef PG8_LDA
#undef PG8_LDB
#undef PG8_MMA
#undef PG8_WAIT_V
#undef PG8_WAIT_L
#undef PG8_BAR
#undef PG8_SCHED
}
}
using pg8::Unit;

struct EpiU {
  static constexpr bool HOOK = false;
  bf16_t* U; const float* rinv; const float* bg;
  __device__ __forceinline__ void hook(f32x4 (&)[2][2][4][2], const Unit&, int, int, int, int, int) const {}
  __device__ __forceinline__ void operator()(const f32x4 (&acc)[2][2][4][2], const Unit& u, int wr, int wc, int fr, int fq) const {
    asm volatile("" : "+v"(fr), "+v"(fq));
    const int row0 = u.pm * 256 + wr * 64 + fr, col0 = u.pn * 256 + wc * 32 + 8 * fq;
    const bool isg = (u.pn >= 19);
    float ri[2][4];
#pragma unroll
    for (int ai = 0; ai < 2; ++ai)
#pragma unroll
      for (int m = 0; m < 4; ++m) ri[ai][m] = rinv[row0 + ai * 128 + m * 16];
    if (isg) {
      f32x4 b[2][2];
#pragma unroll
      for (int bj = 0; bj < 2; ++bj) { const float* bp = bg + (col0 - U_GL) + bj * 128; b[bj][0] = *(const f32x4*)bp; b[bj][1] = *(const f32x4*)(bp + 4); }
#pragma unroll
      for (int ai = 0; ai < 2; ++ai)
#pragma unroll
        for (int m = 0; m < 4; ++m)
#pragma unroll
          for (int bj = 0; bj < 2; ++bj) {
            f32x4 v0 = acc[ai][bj][m][0] * ri[ai][m] + b[bj][0], v1 = acc[ai][bj][m][1] * ri[ai][m] + b[bj][1];
#pragma unroll
            for (int j = 0; j < 4; ++j) { v0[j] = 1.0f + fminf(fexp2(-v0[j] * LOG2E), 1e30f); v1[j] = 1.0f + fminf(fexp2(-v1[j] * LOG2E), 1e30f); }
            u32x4 pk = {cvt_pk_bf16(v0[0], v0[1]), cvt_pk_bf16(v0[2], v0[3]), cvt_pk_bf16(v1[0], v1[1]), cvt_pk_bf16(v1[2], v1[3])};
            *(u32x4*)(U + (size_t)(row0 + ai * 128 + m * 16) * UW + col0 + bj * 128) = pk;
          }
    } else {
#pragma unroll
      for (int ai = 0; ai < 2; ++ai)
#pragma unroll
        for (int m = 0; m < 4; ++m)
#pragma unroll
          for (int bj = 0; bj < 2; ++bj) {
            const f32x4 v0 = acc[ai][bj][m][0] * ri[ai][m], v1 = acc[ai][bj][m][1] * ri[ai][m];
            u32x4 pk = {cvt_pk_bf16(v0[0], v0[1]), cvt_pk_bf16(v0[2], v0[3]), cvt_pk_bf16(v1[0], v1[1]), cvt_pk_bf16(v1[2], v1[3])};
            *(u32x4*)(U + (size_t)(row0 + ai * 128 + m * 16) * UW + col0 + bj * 128) = pk;
          }
    }
  }
};

struct EpiVT {
  static constexpr bool HOOK = false;
  bf16_t* VT; const float* rv; int L, lshift;
  __device__ __forceinline__ void hook(f32x4 (&)[2][2][4][2], const Unit&, int, int, int, int, int) const {}
  __device__ __forceinline__ void operator()(const f32x4 (&acc)[2][2][4][2], const Unit& u, int wr, int wc, int fr, int fq) const {
    asm volatile("" : "+v"(fr), "+v"(fq));
    const int vrow0 = u.pm * 256 + wr * 64 + fr, pcol0 = u.pn * 256 + wc * 32 + 8 * fq;
    const int ds = u.pm <= 4 ? 0 : (u.pm == 5 ? 2 : 4);
    const int Mc = L >> ds;
#pragma unroll
    for (int bj = 0; bj < 2; ++bj) {
      const int p0 = pcol0 + bj * 128, seq = p0 >> lshift, pos = p0 & (L - 1);
      const int r = pos / Mc, m0 = pos & (Mc - 1);
      float rinv[8];
#pragma unroll
      for (int j = 0; j < 8; ++j) rinv[j] = rv[(seq << lshift) + ((m0 + j) << ds) + r];
      bf16_t* vb = VT + ((size_t)seq * VW + vrow0) * L + pos;
#pragma unroll
      for (int ai = 0; ai < 2; ++ai)
#pragma unroll
        for (int m = 0; m < 4; ++m) {
          const f32x4 v0 = acc[ai][bj][m][0], v1 = acc[ai][bj][m][1];
          u32x4 pk = {cvt_pk_bf16(v0[0] * rinv[0], v0[1] * rinv[1]), cvt_pk_bf16(v0[2] * rinv[2], v0[3] * rinv[3]),
                      cvt_pk_bf16(v1[0] * rinv[4], v1[1] * rinv[5]), cvt_pk_bf16(v1[2] * rinv[6], v1[3] * rinv[7])};
          *(u32x4*)(vb + (size_t)(ai * 128 + m * 16) * L) = pk;
        }
    }
  }
};

struct EpiMerge {
  static constexpr bool HOOK = true;
  const bf16_t* U; bf16_t* MG;
  __device__ __forceinline__ f32x4 gvec(int i, size_t row, int col) const {
    const u32x2 raw = *(const u32x2*)(U + row * UW + U_GL + i * 1024 + col);
    f32x4 e; e[0] = bf_lo(raw[0]); e[1] = bf_hi(raw[0]); e[2] = bf_lo(raw[1]); e[3] = bf_hi(raw[1]); return e;
  }
  __device__ __forceinline__ void hook(f32x4 (&acc)[2][2][4][2], const Unit& u, int t, int wr, int wc, int fr, int fq) const {
    const int i = (t == 8) ? 0 : 1;
    asm volatile("" : "+v"(fr), "+v"(fq));
    const int row0 = u.pm * 256 + wr * 64 + fr, col0 = u.pn * 256 + wc * 32 + 8 * fq;
#pragma unroll
    for (int ai = 0; ai < 2; ++ai) {
#pragma unroll
      for (int m = 0; m < 4; ++m)
#pragma unroll
        for (int bj = 0; bj < 2; ++bj) {
          const bf16_t* gp = U + (size_t)(row0 + ai * 128 + m * 16) * UW + U_GL + i * 1024 + col0 + bj * 128;
          const u32x4 a = *(const u32x4*)gp, b = *(const u32x4*)(gp + 1024);
#pragma unroll
          for (int n = 0; n < 2; ++n) {
            f32x4 r;
            r[0] = bf_lo(b[2 * n]) * frcp(bf_lo(a[2 * n])); r[1] = bf_hi(b[2 * n]) * frcp(bf_hi(a[2 * n]));
            r[2] = bf_lo(b[2 * n + 1]) * frcp(bf_lo(a[2 * n + 1])); r[3] = bf_hi(b[2 * n + 1]) * frcp(bf_hi(a[2 * n + 1]));
            acc[ai][bj][m][n] *= r;
          }
        }
      __builtin_amdgcn_sched_barrier(0);
    }
  }
  __device__ __forceinline__ void operator()(const f32x4 (&acc)[2][2][4][2], const Unit& u, int wr, int wc, int fr, int fq) const {
    asm volatile("" : "+v"(fr), "+v"(fq));
    const int row0 = u.pm * 256 + wr * 64 + fr, col0 = u.pn * 256 + wc * 32 + 8 * fq;
    u32x4 g2[2][4][2];
#pragma unroll
    for (int ai = 0; ai < 2; ++ai)
#pragma unroll
      for (int m = 0; m < 4; ++m)
#pragma unroll
        for (int bj = 0; bj < 2; ++bj) g2[ai][m][bj] = *(const u32x4*)(U + (size_t)(row0 + ai * 128 + m * 16) * UW + U_GL + 2 * 1024 + col0 + bj * 128);
    __builtin_amdgcn_sched_barrier(0);
#pragma unroll
    for (int ai = 0; ai < 2; ++ai)
#pragma unroll
      for (int m = 0; m < 4; ++m)
#pragma unroll
        for (int bj = 0; bj < 2; ++bj) {
          const size_t row = (size_t)(row0 + ai * 128 + m * 16); const int col = col0 + bj * 128;
          const u32x4 g = g2[ai][m][bj];
          f32x4 v0 = acc[ai][bj][m][0], v1 = acc[ai][bj][m][1];
          v0[0] *= frcp(bf_lo(g[0])); v0[1] *= frcp(bf_hi(g[0])); v0[2] *= frcp(bf_lo(g[1])); v0[3] *= frcp(bf_hi(g[1]));
          v1[0] *= frcp(bf_lo(g[2])); v1[1] *= frcp(bf_hi(g[2])); v1[2] *= frcp(bf_lo(g[3])); v1[3] *= frcp(bf_hi(g[3]));
          u32x4 pk = {cvt_pk_bf16(v0[0], v0[1]), cvt_pk_bf16(v0[2], v0[3]), cvt_pk_bf16(v1[0], v1[1]), cvt_pk_bf16(v1[2], v1[3])};
          *(u32x4*)(MG + row * DM + col) = pk;
        }
  }
};

struct EpiRes {
  static constexpr bool HOOK = false;
  const float* R; float* X; bf16_t* XB; float* ssq;
  __device__ __forceinline__ void hook(f32x4 (&)[2][2][4][2], const Unit&, int, int, int, int, int) const {}
  __device__ __forceinline__ void operator()(const f32x4 (&acc)[2][2][4][2], const Unit& u, int wr, int wc, int fr, int fq) const {
    asm volatile("" : "+v"(fr), "+v"(fq));
    const int row0 = u.pm * 256 + wr * 64 + fr, col0 = u.pn * 256 + wc * 32 + 8 * fq;
#pragma unroll
    for (int ai = 0; ai < 2; ++ai) {
      f32x4 r[4][2][2];
#pragma unroll
      for (int m = 0; m < 4; ++m)
#pragma unroll
        for (int bj = 0; bj < 2; ++bj) { const float* rp = R + (size_t)(row0 + ai * 128 + m * 16) * DM + col0 + bj * 128; r[m][bj][0] = *(const f32x4*)rp; r[m][bj][1] = *(const f32x4*)(rp + 4); }
      __builtin_amdgcn_sched_barrier(0);
#pragma unroll
      for (int m = 0; m < 4; ++m) {
        const size_t row = (size_t)(row0 + ai * 128 + m * 16);
        float s = 0.f;
#pragma unroll
        for (int bj = 0; bj < 2; ++bj) {
          const int col = col0 + bj * 128;
          const f32x4 v0 = r[m][bj][0] + acc[ai][bj][m][0], v1 = r[m][bj][1] + acc[ai][bj][m][1];
          *(f32x4*)(X + row * DM + col) = v0; *(f32x4*)(X + row * DM + col + 4) = v1;
          s += v0[0] * v0[0] + v0[1] * v0[1] + v0[2] * v0[2] + v0[3] * v0[3] + v1[0] * v1[0] + v1[1] * v1[1] + v1[2] * v1[2] + v1[3] * v1[3];
          u32x4 pk = {cvt_pk_bf16(v0[0], v0[1]), cvt_pk_bf16(v0[2], v0[3]), cvt_pk_bf16(v1[0], v1[1]), cvt_pk_bf16(v1[2], v1[3])};
          *(u32x4*)(XB + row * DM + col) = pk;
        }
        s += __shfl_xor(s, 16); s += __shfl_xor(s, 32);
        if (fq == 0) ssq[row * 16 + u.pn * 4 + wc] = s;
      }
      __builtin_amdgcn_sched_barrier(0);
    }
  }
};

__device__ __forceinline__ void prep_tile(const float* src, int ldn, int k0, int n0, const float* rscale, float cscale, bf16_t* dst, int ldd, int drow0, int dk0, LAS float* tile) {
  const int tid = opaque_tid(), kk = tid >> 6, nn = tid & 63;
#pragma unroll
  for (int i = 0; i < 8; ++i) {
    const int k = kk * 8 + i;
    float v = src[(size_t)(k0 + k) * ldn + n0 + nn] * cscale;
    if (rscale) v *= rscale[k0 + k];
    tile[k * 65 + nn] = v;
  }
  __syncthreads();
  const int n = tid >> 3, kc = tid & 7;
  float f[8];
#pragma unroll
  for (int j = 0; j < 8; ++j) f[j] = tile[(kc * 8 + j) * 65 + n];
  u32x4 pk = {cvt_pk_bf16(f[0], f[1]), cvt_pk_bf16(f[2], f[3]), cvt_pk_bf16(f[4], f[5]), cvt_pk_bf16(f[6], f[7])};
  *(u32x4*)(dst + (size_t)(drow0 + n) * ldd + dk0 + kc * 8) = pk;
  __syncthreads();
}

__device__ __forceinline__ void win_map(int n0, int& dn0, float& sc) {
  sc = 1.0f;
  if (n0 < 512) { dn0 = U_QA + n0; sc = QSCALE; }
  else if (n0 < 1024) dn0 = U_KA + (n0 - 512);
  else if (n0 < 1536) dn0 = UW + V_A + (n0 - 1024);
  else if (n0 < 2048) dn0 = U_ZA + (n0 - 1536);
  else if (n0 < 2560) { dn0 = U_QB + (n0 - 2048); sc = QSCALE; }
  else if (n0 < 3072) dn0 = U_KB + (n0 - 2560);
  else if (n0 < 3584) dn0 = UW + V_B + (n0 - 3072);
  else if (n0 < 4096) dn0 = U_ZB + (n0 - 3584);
  else if (n0 < 4864) { dn0 = U_QC + (n0 - 4096); sc = QSCALE; }
  else if (n0 < 5632) dn0 = U_KC + (n0 - 4864);
  else if (n0 < 6400) dn0 = UW + V_C + (n0 - 5632);
  else if (n0 < 6656) dn0 = U_ZC + (n0 - 6400);
  else dn0 = U_GL + (n0 - 6656);
}

__device__ void phase_prep(const Params& p, LAS float* tile) {
  constexpr int PER = 3008;
  for (int it = blockIdx.x; it < DEPTH * PER; it += gridDim.x) {
    const int l = it / PER; int r = it % PER;
    if (r < 2432) {
      const int kt = r / 152, ntile = r % 152; int dn0; float sc; win_map(ntile * 64, dn0, sc);
      prep_tile(p.w_in + (size_t)l * DM * INW, INW, kt * 64, ntile * 64, p.g_norm + l * DM, sc, p.wt_in + (size_t)l * INW * DM, DM, dn0, kt * 64, tile);
    } else if ((r -= 2432) < 128) {
      const int kt = r / 16, ntile = r % 16;
      prep_tile(p.w_br_a + (size_t)l * 512 * DM, DM, kt * 64, ntile * 64, nullptr, 1.0f, p.wt_br + (size_t)l * DM * YW, YW, ntile * 64, kt * 64, tile);
    } else if ((r -= 128) < 128) {
      const int kt = r / 16, ntile = r % 16;
      prep_tile(p.w_br_b + (size_t)l * 512 * DM, DM, kt * 64, ntile * 64, nullptr, 1.0f, p.wt_br + (size_t)l * DM * YW, YW, ntile * 64, 512 + kt * 64, tile);
    } else if ((r -= 128) < 64) {
      const int kt = r / 16, ntile = r % 16;
      prep_tile(p.w_br_c + (size_t)l * 256 * DM, DM, kt * 64, ntile * 64, nullptr, 1.0f, p.wt_br + (size_t)l * DM * YW, YW, ntile * 64, 1024 + kt * 64, tile);
    } else {
      r -= 64; const int kt = r / 16, ntile = r % 16;
      prep_tile(p.w_out + (size_t)l * DM * DM, DM, kt * 64, ntile * 64, nullptr, 1.0f, p.wt_out + (size_t)l * DM * DM, DM, ntile * 64, kt * 64, tile);
    }
  }
  const int ptid = opaque_tid();
  if (blockIdx.x == 0 && ptid < 64) {
    const int lane = ptid;
    for (int l = 0; l < DEPTH; ++l) {
      const float* lq = p.lam_qk + l * 256;
      float a = lq[lane] * lq[64 + lane], b = lq[128 + lane] * lq[192 + lane];
      for (int o = 32; o >= 1; o >>= 1) { a += __shfl_xor(a, o); b += __shfl_xor(b, o); }
      if (lane == 0) { const float li = 0.8f - 0.6f * expf(-0.3f * (float)l); p.lam[l] = expf(a) - expf(b) + li; p.lam[4 + l] = 1.0f - li; }
    }
  }
}

__device__ void phase_x(const Params& p, int chunk) {
  const float* xin = (chunk < 2) ? p.xp + (size_t)chunk * TC * DM : p.xs + (size_t)(chunk - 2) * TC * DM;
  float* ssq = p.ssq + (size_t)chunk * TC * 16;
  const int tid = opaque_tid(), lane = tid & 63, w = blockIdx.x * 8 + (tid >> 6), nw = gridDim.x * 8;
  for (int row = w; row < TC; row += nw) {
    const float* xr = xin + (size_t)row * DM + lane * 16;
    f32x4 v[4]; float s = 0.f;
#pragma unroll
    for (int i = 0; i < 4; ++i) { v[i] = *(const f32x4*)(xr + i * 4); s += v[i][0] * v[i][0] + v[i][1] * v[i][1] + v[i][2] * v[i][2] + v[i][3] * v[i][3]; }
    for (int o = 32; o >= 1; o >>= 1) s += __shfl_xor(s, o);
    u32x4 p0 = {cvt_pk_bf16(v[0][0], v[0][1]), cvt_pk_bf16(v[0][2], v[0][3]), cvt_pk_bf16(v[1][0], v[1][1]), cvt_pk_bf16(v[1][2], v[1][3])};
    u32x4 p1 = {cvt_pk_bf16(v[2][0], v[2][1]), cvt_pk_bf16(v[2][2], v[2][3]), cvt_pk_bf16(v[3][0], v[3][1]), cvt_pk_bf16(v[3][2], v[3][3])};
    bf16_t* xo = p.xb + (size_t)row * DM + lane * 16;
    *(u32x4*)xo = p0; *(u32x4*)(xo + 8) = p1;
    if (lane < 16) ssq[(size_t)row * 16 + lane] = (lane == 0) ? s : 0.f;
    if (lane == 0) p.rinv[(size_t)chunk * TC + row] = rsqrtf(s * (1.0f / 1024.0f) + 1e-6f);
  }
}

__device__ void phase_rinv(const Params& p, int chunk) {
  const float* ssq = p.ssq + (size_t)chunk * TC * 16; float* rv = p.rinv + (size_t)chunk * TC;
  for (int row = blockIdx.x * 512 + opaque_tid(); row < TC; row += gridDim.x * 512) {
    const f32x4* sp = (const f32x4*)(ssq + (size_t)row * 16);
    const f32x4 a4 = sp[0] + sp[1] + sp[2] + sp[3];
    rv[row] = rsqrtf((a4[0] + a4[1] + a4[2] + a4[3]) * (1.0f / 1024.0f) + 1e-6f);
  }
}

__device__ void phase_final(const Params& p, int chunk) {
  float* x = p.out + (size_t)chunk * TC * DM;
  const float* ssq = p.ssq + (size_t)chunk * TC * 16;
  const int tid = opaque_tid(), lane = tid & 63, w = blockIdx.x * 8 + (tid >> 6), nw = gridDim.x * 8;
  for (int row = w; row < TC; row += nw) {
    const f32x4* sp = (const f32x4*)(ssq + (size_t)row * 16);
    const f32x4 a4 = sp[0] + sp[1] + sp[2] + sp[3];
    const float rinv = rsqrtf((a4[0] + a4[1] + a4[2] + a4[3]) * (1.0f / 1024.0f) + 1e-6f);
    float* xr = x + (size_t)row * DM + lane * 16;
#pragma unroll
    for (int i = 0; i < 4; ++i) { f32x4 v = *(const f32x4*)(xr + i * 4); const f32x4 g = *(const f32x4*)(p.g_final + lane * 16 + i * 4); v = v * rinv * g; *(f32x4*)(xr + i * 4) = v; }
  }
}

__device__ __forceinline__ f32x16 mfma32(bf16x8 a, bf16x8 b, f32x16 c) { return __builtin_amdgcn_mfma_f32_32x32x16_bf16(a, b, c, 0, 0, 0); }
__device__ __forceinline__ bf16x8 ld16(const bf16_t* p) { return *(const bf16x8*)p; }
__device__ __forceinline__ bf16x8 ld8x2(const bf16_t* p0, const bf16_t* p1) { const bf16x4 a = *(const bf16x4*)p0, b = *(const bf16x4*)p1; return __builtin_shufflevector(a, b, 0, 1, 2, 3, 4, 5, 6, 7); }

__device__ __forceinline__ void softmax_tile(f32x16& t, float& m, float& l, float& alpha, bf16x8& p0, bf16x8& p1) {
  float tm = t[0];
#pragma unroll
  for (int i = 1; i < 16; ++i) tm = fmaxf(tm, t[i]);
  tm = fmaxf(tm, __shfl_xor(tm, 32));
  const float mn = fmaxf(m, tm);
  alpha = fexp2(m - mn); m = mn;
  float ls = 0.f;
#pragma unroll
  for (int i = 0; i < 16; ++i) { t[i] = fexp2(t[i] - mn); ls += t[i]; }
  l = l * alpha + ls;
  const u32x4 a = {cvt_pk_bf16(t[0], t[1]), cvt_pk_bf16(t[2], t[3]), cvt_pk_bf16(t[4], t[5]), cvt_pk_bf16(t[6], t[7])};
  const u32x4 b = {cvt_pk_bf16(t[8], t[9]), cvt_pk_bf16(t[10], t[11]), cvt_pk_bf16(t[12], t[13]), cvt_pk_bf16(t[14], t[15])};
  p0 = __builtin_bit_cast(bf16x8, a); p1 = __builtin_bit_cast(bf16x8, b);
}
__device__ __forceinline__ f32x16 zero16() { f32x16 z;
#pragma unroll
  for (int i = 0; i < 16; ++i) z[i] = 0.f; return z; }
__device__ __forceinline__ float silu(float z) { return z * frcp(1.0f + fexp2(-z * LOG2E)); }

constexpr int TB_ROW = 144;
constexpr int KB_BYTES = 64 * TB_ROW;
constexpr int VB_BYTES = 128 * TB_ROW;
constexpr int LDS_K = 0, LDS_V = LDS_K + 2 * KB_BYTES, LDS_ATT_END = LDS_V + 2 * VB_BYTES, LDS_ATT_TOTAL = LDS_ATT_END + 65536;
template <int SIDE>
__device__ __forceinline__ void b_far_subtile(const LAS unsigned char* kb, const LAS unsigned char* vb, int rd, int sub, const bf16x8 (&qf)[4], const f32x16& bp, float slope2, float d0,
                                              float& mrun, float& lrun, f32x16 (&o)[4]) {
  const float base = (SIDE > 0 ? -slope2 : slope2) * d0 - mrun;
  f32x16 sc;
#pragma unroll
  for (int i = 0; i < 16; ++i) sc[i] = SIDE > 0 ? base - bp[i] : base + bp[i];
#pragma unroll
  for (int ks = 0; ks < 4; ++ks) sc = mfma32(*(const LAS bf16x8*)(kb + rd + sub * 32 * TB_ROW + ks * 32), qf[ks], sc);
  float tm = sc[0];
#pragma unroll
  for (int i = 1; i < 16; ++i) tm = fmaxf(tm, sc[i]);
  tm = fmaxf(tm, __shfl_xor(tm, 32));
  if (__builtin_amdgcn_ballot_w64(tm > 0.0f) != 0) {
    const float delta = fmaxf(tm, 0.0f);
    const float al = fexp2(-delta);
    mrun += delta; lrun *= al;
#pragma unroll
    for (int i = 0; i < 16; ++i) sc[i] -= delta;
#pragma unroll
    for (int dt = 0; dt < 4; ++dt) o[dt] *= al;
  }
#pragma unroll
  for (int i = 0; i < 16; ++i) sc[i] = fexp2(sc[i]);
  { const f32x4 a4 = (f32x4){sc[0], sc[1], sc[2], sc[3]} + (f32x4){sc[4], sc[5], sc[6], sc[7]} + (f32x4){sc[8], sc[9], sc[10], sc[11]} + (f32x4){sc[12], sc[13], sc[14], sc[15]};
    lrun += (a4[0] + a4[1]) + (a4[2] + a4[3]); }
  const u32x4 pa = {cvt_pk_bf16(sc[0], sc[1]), cvt_pk_bf16(sc[2], sc[3]), cvt_pk_bf16(sc[4], sc[5]), cvt_pk_bf16(sc[6], sc[7])};
  const u32x4 pb = {cvt_pk_bf16(sc[8], sc[9]), cvt_pk_bf16(sc[10], sc[11]), cvt_pk_bf16(sc[12], sc[13]), cvt_pk_bf16(sc[14], sc[15])};
  const bf16x8 pk0 = __builtin_bit_cast(bf16x8, pa), pk1 = __builtin_bit_cast(bf16x8, pb);
#pragma unroll
  for (int dt = 0; dt < 4; ++dt) {
    o[dt] = mfma32(*(const LAS bf16x8*)(vb + rd + dt * 32 * TB_ROW + (sub * 2) * 32), pk0, o[dt]);
    o[dt] = mfma32(*(const LAS bf16x8*)(vb + rd + dt * 32 * TB_ROW + (sub * 2 + 1) * 32), pk1, o[dt]);
  }
}

__device__ __forceinline__ void attn_b_pass(const Params& p, int L, int seq, int h, int mp, int qblk, int tq, int tid, float slope2, LAS unsigned char* lds, f32x16 (&o)[4], float& linv) {
  const int lane = tid & 63, q = lane & 31, half = lane >> 5;
  const size_t tokbase = (size_t)seq * L;
  bf16x8 qf[4];
  { const bf16_t* qp = p.u + (tokbase + tq) * UW + U_QB + h * 128 + mp * 64 + half * 8;
#pragma unroll
    for (int ks = 0; ks < 4; ++ks) qf[ks] = ld16(qp + ks * 16); }
  const int spart = tid & 7, srow = tid >> 3;
  const bf16_t* kg = p.u + (tokbase + srow) * UW + U_KB + h * 128 + mp * 64 + spart * 8;
  const bf16_t* vg = p.vt + ((size_t)seq * VW + V_B + h * 128 + srow) * L + spart * 8;
  const int kst = srow * TB_ROW + spart * 16;
  const int vst = srow * TB_ROW + ((spart >> 1) * 16 + (spart & 1) * 4) * 2;
  const int rd = q * TB_ROW + half * 16;
#pragma unroll
  for (int dt = 0; dt < 4; ++dt) o[dt] = zero16();
  float mrun = -1e30f, lrun = 0.f;
  f32x16 bp;
#pragma unroll
  for (int i = 0; i < 16; ++i) bp[i] = slope2 * (float)((i >> 2) * 8 + (i & 3));
  const int ntile = L >> 6, t0 = qblk * 4, nR = ntile - t0;
  auto tile_of = [&](int idx) { return idx < nR ? t0 + idx : (t0 - 1) - (idx - nR); };
  bf16x8 krA, vrA0, vrA1, krB, vrB0, vrB1;
  auto gload = [&](int idx, bf16x8& kr, bf16x8& v0, bf16x8& v1) { const int kn = tile_of(idx) * 64; kr = ld16(kg + (size_t)kn * UW); v0 = ld16(vg + kn); v1 = ld16(vg + (size_t)64 * L + kn); };
  auto lwrite = [&](int buf, const bf16x8& kr, const bf16x8& v0, const bf16x8& v1) {
    LAS unsigned char* kb = lds + LDS_K + buf * KB_BYTES; LAS unsigned char* vb = lds + LDS_V + buf * VB_BYTES;
    *(LAS bf16x8*)(kb + kst) = kr;
    *(LAS bf16x4*)(vb + vst) = __builtin_shufflevector(v0, v0, 0, 1, 2, 3); *(LAS bf16x4*)(vb + vst + 16) = __builtin_shufflevector(v0, v0, 4, 5, 6, 7);
    *(LAS bf16x4*)(vb + vst + 64 * TB_ROW) = __builtin_shufflevector(v1, v1, 0, 1, 2, 3); *(LAS bf16x4*)(vb + vst + 64 * TB_ROW + 16) = __builtin_shufflevector(v1, v1, 4, 5, 6, 7);
  };
  auto compute = [&](int idx, int buf) {
    const int k0 = tile_of(idx) * 64;
    const LAS unsigned char* kb = lds + LDS_K + buf * KB_BYTES;
    const LAS unsigned char* vb = lds + LDS_V + buf * VB_BYTES;
    if (idx < 4) {
#pragma unroll
      for (int sub = 0; sub < 2; ++sub) {
        f32x16 sc = zero16();
#pragma unroll
        for (int ks = 0; ks < 4; ++ks) sc = mfma32(*(const LAS bf16x8*)(kb + rd + sub * 32 * TB_ROW + ks * 32), qf[ks], sc);
        const float d0 = (float)(k0 + sub * 32 + half * 4 - tq);
#pragma unroll
        for (int i = 0; i < 16; ++i) sc[i] -= slope2 * fabsf(d0 + (float)((i >> 2) * 8 + (i & 3)));
        float al; bf16x8 pk[2];
        softmax_tile(sc, mrun, lrun, al, pk[0], pk[1]);
        if (__builtin_amdgcn_ballot_w64(al != 1.0f) != 0) {
#pragma unroll
          for (int dt = 0; dt < 4; ++dt) o[dt] *= al;
        }
#pragma unroll
        for (int dt = 0; dt < 4; ++dt)
#pragma unroll
          for (int s2 = 0; s2 < 2; ++s2) o[dt] = mfma32(*(const LAS bf16x8*)(vb + rd + dt * 32 * TB_ROW + (sub * 2 + s2) * 32), pk[s2], o[dt]);
      }
    } else if (idx < nR) {
#pragma unroll
      for (int sub = 0; sub < 2; ++sub) b_far_subtile<1>(kb, vb, rd, sub, qf, bp, slope2, (float)(k0 + sub * 32 + half * 4 - tq), mrun, lrun, o);
    } else {
#pragma unroll
      for (int sub = 0; sub < 2; ++sub) b_far_subtile<-1>(kb, vb, rd, sub, qf, bp, slope2, (float)(k0 + sub * 32 + half * 4 - tq), mrun, lrun, o);
    }
  };
  gload(0, krA, vrA0, vrA1);
  gload(1, krB, vrB0, vrB1);
  lwrite(0, krA, vrA0, vrA1);
  asm volatile("" : "+v"(qf[0]), "+v"(qf[1]), "+v"(qf[2]), "+v"(qf[3]));
  asm volatile("" : "+v"(krB), "+v"(vrB0), "+v"(vrB1));
  __syncthreads();
#pragma unroll 1
  for (int idx = 0; idx < ntile; idx += 2) {
    if (idx + 2 < ntile) gload(idx + 2, krA, vrA0, vrA1);
    compute(idx, 0);
    lwrite(1, krB, vrB0, vrB1);
    __syncthreads();
    if (idx + 3 < ntile) gload(idx + 3, krB, vrB0, vrB1);
    compute(idx + 1, 1);
    if (idx + 2 < ntile) lwrite(0, krA, vrA0, vrA1);
    __syncthreads();
  }
  linv = frcp(lrun + __shfl_xor(lrun, 32));
}
__device__ void attn_b_block(const Params& p, int layer, int L, int seq, int h, int qblk, LAS unsigned char* lds) {
  const int tid = opaque_tid(), lane = tid & 63, wid = __builtin_amdgcn_readfirstlane(tid >> 6);
  const int q = lane & 31, half = lane >> 5;
  const size_t tokbase = (size_t)seq * L;
  const int tq = qblk * 256 + wid * 32 + q;
  const float slope2 = exp2f(-2.0f * (float)(h + 1)) * LOG2E;
  f32x16 o0[4]; float li0, li1;
  LAS u32x4* park = (LAS u32x4*)(lds + LDS_ATT_END) + wid * 512 + lane;
  attn_b_pass(p, L, seq, h, 0, qblk, tq, tid, slope2, lds, o0, li0);
#pragma unroll
  for (int dt = 0; dt < 4; ++dt)
#pragma unroll
    for (int g2 = 0; g2 < 2; ++g2) {
      u32x4 pk;
#pragma unroll
      for (int k = 0; k < 4; ++k) pk[k] = cvt_pk_bf16(o0[dt][g2 * 8 + 2 * k] * li0, o0[dt][g2 * 8 + 2 * k + 1] * li0);
      park[(dt * 2 + g2) * 64] = pk;
    }
  attn_b_pass(p, L, seq, h, 1, qblk, tq, tid, slope2, lds, o0, li1);
  const float c1 = p.lam[layer] * li1;
  const int tid2 = opaque_tid(), half2 = (tid2 >> 5) & 1;
  const size_t tok2 = (size_t)seq * L + qblk * 256 + (tid2 >> 6) * 32 + (tid2 & 31);
  float ss = 0.f;
#pragma unroll
  for (int dt = 0; dt < 4; ++dt)
#pragma unroll
    for (int g2 = 0; g2 < 2; ++g2) {
      const u32x4 pk = park[(dt * 2 + g2) * 64];
#pragma unroll
      for (int k = 0; k < 4; ++k) {
        const float va = bf_lo(pk[k]) - o0[dt][g2 * 8 + 2 * k] * c1, vb = bf_hi(pk[k]) - o0[dt][g2 * 8 + 2 * k + 1] * c1;
        o0[dt][g2 * 8 + 2 * k] = va; o0[dt][g2 * 8 + 2 * k + 1] = vb; ss += va * va + vb * vb;
      }
    }
  ss += __shfl_xor(ss, 32);
  const float rn = rsqrtf(ss * (1.0f / 128.0f) + 1e-6f) * p.lam[4 + layer];
  const float* gd = p.g_diff + layer * 128;
  bf16_t* yrow = p.yg + tok2 * YW + 512 + h * 128;
  const bf16_t* zrow = p.u + tok2 * UW + U_ZB + h * 128;
#pragma unroll
  for (int dt = 0; dt < 4; ++dt)
#pragma unroll
    for (int g4 = 0; g4 < 4; ++g4) {
      const int dim = dt * 32 + g4 * 8 + half2 * 4;
      const u32x2 zr = *(const u32x2*)(zrow + dim);
      const f32x4 gv = *(const f32x4*)(gd + dim);
      const float y0 = o0[dt][g4 * 4 + 0] * rn * gv[0] * silu(bf_lo(zr[0]));
      const float y1 = o0[dt][g4 * 4 + 1] * rn * gv[1] * silu(bf_hi(zr[0]));
      const float y2 = o0[dt][g4 * 4 + 2] * rn * gv[2] * silu(bf_lo(zr[1]));
      const float y3 = o0[dt][g4 * 4 + 3] * rn * gv[3] * silu(bf_hi(zr[1]));
      u32x2 pk = {cvt_pk_bf16(y0, y1), cvt_pk_bf16(y2, y3)};
      *(u32x2*)(yrow + dim) = pk;
    }
}

constexpr int LDS_AK = 0, LDS_AV = LDS_AK + 2 * KB_BYTES, LDS_ATAB = LDS_AV + 2 * KB_BYTES, ATAB_ROW = 128;
__device__ void attn_a_block(const Params& p, int layer, int L, int seq, int h, int r0, LAS unsigned char* lds) {
  const int tid = opaque_tid(), lane = tid & 63, wid = __builtin_amdgcn_readfirstlane(tid >> 6);
  const int q = lane & 31, half = lane >> 5;
  const size_t tokbase = (size_t)seq * L;
  const int rows = L >> 6;
  const int r = r0 + (wid >> 1), cb2 = wid & 1;
  int rs = r - 4; rs = rs < 0 ? 0 : (rs > rows - 8 ? rows - 8 : rs);
  int kr_lo = r0 - 4; kr_lo = kr_lo < 0 ? 0 : (kr_lo > rows - 8 ? rows - 8 : kr_lo);
  int kr_hi = r0 - 1; kr_hi = (kr_hi < 0 ? 0 : (kr_hi > rows - 8 ? rows - 8 : kr_hi)) + 7;
  const int qcol = cb2 * 32 + q, tq = r * 64 + qcol;
  int qstart = qcol - 8; qstart = qstart < 0 ? 0 : (qstart > 48 ? 48 : qstart);
  bf16x8 qf[4];
  { const bf16_t* qp = p.u + (tokbase + tq) * UW + U_QA + h * 64 + half * 8;
#pragma unroll
    for (int ks = 0; ks < 4; ++ks) qf[ks] = ld16(qp + ks * 16); }
  {
    LAS float* tab = (LAS float*)(lds + LDS_ATAB);
    const float* rpb = p.rpb + ((size_t)layer * 8 + h) * 15 * 31;
    for (int idx = tid; idx < 15 * ATAB_ROW; idx += 512) { const int row = idx >> 7, cc = (idx & 127) - 48; tab[idx] = (cc >= 0 && cc <= 30) ? rpb[row * 31 + cc] * LOG2E : 0.f; }
  }
  const int spart = tid & 7, srow = tid >> 3;
  const bf16_t* kg = p.u + (tokbase + srow) * UW + U_KA + h * 64 + spart * 8;
  const bf16_t* vg = p.vt + ((size_t)seq * VW + V_A + h * 64 + srow) * L + spart * 8;
  const int kst = srow * TB_ROW + spart * 16;
  const int vst = srow * TB_ROW + ((spart >> 1) * 16 + (spart & 1) * 4) * 2;
  const int rd = q * TB_ROW + half * 16;
  f32x16 o[2] = {zero16(), zero16()};
  float mrun = -1e30f, lrun = 0.f;
  bf16x8 kr_, vr_;
  kr_ = ld16(kg + (size_t)(kr_lo * 64) * UW); vr_ = ld16(vg + kr_lo * 64);
  *(LAS bf16x8*)(lds + LDS_AK + kst) = kr_;
  *(LAS bf16x4*)(lds + LDS_AV + vst) = __builtin_shufflevector(vr_, vr_, 0, 1, 2, 3); *(LAS bf16x4*)(lds + LDS_AV + vst + 16) = __builtin_shufflevector(vr_, vr_, 4, 5, 6, 7);
  asm volatile("" : "+v"(qf[0]), "+v"(qf[1]), "+v"(qf[2]), "+v"(qf[3]));
  __syncthreads();
#pragma unroll 1
  for (int kr = kr_lo; kr <= kr_hi; ++kr) {
    const int it = kr - kr_lo;
    const bool more = (kr < kr_hi);
    if (more) { kr_ = ld16(kg + (size_t)((kr + 1) * 64) * UW); vr_ = ld16(vg + (kr + 1) * 64); }
    const LAS unsigned char* kb = lds + LDS_AK + (it & 1) * KB_BYTES;
    const LAS unsigned char* vb = lds + LDS_AV + (it & 1) * KB_BYTES;
    if (kr >= rs && kr < rs + 8) {
      const LAS float* trow = (const LAS float*)(lds + LDS_ATAB) + (kr - r + 7) * ATAB_ROW + (half * 4 - qcol + 15 + 48);
#pragma unroll
      for (int seg = 0; seg < 2; ++seg) {
        f32x16 sc = zero16();
#pragma unroll
        for (int ks = 0; ks < 4; ++ks) sc = mfma32(*(const LAS bf16x8*)(kb + rd + seg * 32 * TB_ROW + ks * 32), qf[ks], sc);
#pragma unroll
        for (int ii = 0; ii < 16; ++ii) {
          const int kcol = seg * 32 + (ii >> 2) * 8 + half * 4 + (ii & 3);
          const bool ok = (kcol >= qstart) && (kcol < qstart + 16);
          sc[ii] = ok ? sc[ii] + trow[seg * 32 + (ii >> 2) * 8 + (ii & 3)] : -INFINITY;
        }
        float al; bf16x8 pk[2];
        softmax_tile(sc, mrun, lrun, al, pk[0], pk[1]);
        if (__builtin_amdgcn_ballot_w64(al != 1.0f) != 0) { o[0] *= al; o[1] *= al; }
#pragma unroll
        for (int dt = 0; dt < 2; ++dt)
#pragma unroll
          for (int s2 = 0; s2 < 2; ++s2) o[dt] = mfma32(*(const LAS bf16x8*)(vb + rd + dt * 32 * TB_ROW + (seg * 2 + s2) * 32), pk[s2], o[dt]);
      }
    }
    if (more) {
      LAS unsigned char* kbn = lds + LDS_AK + ((it + 1) & 1) * KB_BYTES; LAS unsigned char* vbn = lds + LDS_AV + ((it + 1) & 1) * KB_BYTES;
      *(LAS bf16x8*)(kbn + kst) = kr_;
      *(LAS bf16x4*)(vbn + vst) = __builtin_shufflevector(vr_, vr_, 0, 1, 2, 3); *(LAS bf16x4*)(vbn + vst + 16) = __builtin_shufflevector(vr_, vr_, 4, 5, 6, 7);
    }
    __syncthreads();
  }
  const float c = frcp(lrun + __shfl_xor(lrun, 32));
  bf16_t* yrow = p.yg + (tokbase + tq) * YW + h * 64;
  const bf16_t* zrow = p.u + (tokbase + tq) * UW + U_ZA + h * 64;
#pragma unroll
  for (int dt = 0; dt < 2; ++dt)
#pragma unroll
    for (int g4 = 0; g4 < 4; ++g4) {
      const int dim = dt * 32 + g4 * 8 + half * 4;
      const u32x2 zr = *(const u32x2*)(zrow + dim);
      const float y0 = o[dt][g4 * 4 + 0] * c * silu(bf_lo(zr[0]));
      const float y1 = o[dt][g4 * 4 + 1] * c * silu(bf_hi(zr[0]));
      const float y2 = o[dt][g4 * 4 + 2] * c * silu(bf_lo(zr[1]));
      const float y3 = o[dt][g4 * 4 + 3] * c * silu(bf_hi(zr[1]));
      u32x2 pk = {cvt_pk_bf16(y0, y1), cvt_pk_bf16(y2, y3)};
      *(u32x2*)(yrow + dim) = pk;
    }
}

__device__ void attn_c_unit(const Params& p, int L, int lshift, int seq, int g, int h, int rr, int mblk, int lane) {
  const int q = lane & 31, half = lane >> 5;
  const size_t tokbase = (size_t)seq * L;
  const int ds = (g == 0) ? 0 : (g == 1 ? 2 : 4), d = 1 << ds, M = L >> ds;
  const int hh = g * 4 + h;
  const int m0 = mblk * 32, mq = m0 + q, tq = mq * d + rr;
  const bf16_t* urow = p.u + (tokbase + tq) * UW;
  bf16x8 qf[4];
#pragma unroll
  for (int ks = 0; ks < 4; ++ks) qf[ks] = ld16(urow + U_QC + hh * 64 + ks * 16 + half * 8);
  f32x16 o[2] = {zero16(), zero16()};
  float mrun = -1e30f, lrun = 0.f;
  const float coef = exp2f(-(2.0f / 3.0f) * (float)(hh + 1)) * (float)d * LOG2E;
  const bf16_t* vbase = p.vt + ((size_t)seq * VW + V_C + hh * 64 + q) * L + (size_t)rr * M;
  bf16x8 kf[5][4];
#pragma unroll
  for (int j = 0; j < 5; ++j) {
    int mkl = m0 - 64 + 32 * j + q; mkl = mkl < 0 ? 0 : (mkl > M - 1 ? M - 1 : mkl);
    const bf16_t* kp = p.u + (tokbase + (size_t)mkl * d + rr) * UW + U_KC + hh * 64 + half * 8;
#pragma unroll
    for (int ks = 0; ks < 4; ++ks) kf[j][ks] = ld16(kp + ks * 16);
  }
  bf16x8 vf[2][2][2];
  auto load_v = [&](int j, bf16x8 (&dst)[2][2]) {
#pragma unroll
    for (int dt = 0; dt < 2; ++dt)
#pragma unroll
      for (int s2 = 0; s2 < 2; ++s2) {
        int pa = m0 - 64 + 32 * j + s2 * 16 + half * 4, pb = pa + 8;
        pa = pa < 0 ? 0 : (pa > M - 4 ? M - 4 : pa); pb = pb < 0 ? 0 : (pb > M - 4 ? M - 4 : pb);
        const bf16_t* vp = vbase + (size_t)(dt * 32) * L;
        dst[dt][s2] = ld8x2(vp + pa, vp + pb);
      }
  };
  load_v(0, vf[0]);
#pragma unroll
  for (int j = 0; j < 5; ++j) {
    if (j + 1 < 5) load_v(j + 1, vf[(j + 1) & 1]);
    const int mk0 = m0 - 64 + 32 * j;
    if (mk0 + 32 <= 0 || mk0 >= M) continue;
    f32x16 s = zero16();
#pragma unroll
    for (int ks = 0; ks < 4; ++ks) s = mfma32(kf[j][ks], qf[ks], s);
#pragma unroll
    for (int ii = 0; ii < 16; ++ii) {
      const int mk = mk0 + (ii >> 2) * 8 + half * 4 + (ii & 3);
      const int rel = mk - mq; const int ar = rel < 0 ? -rel : rel;
      const bool ok = (mk >= 0) && (mk < M) && (ar <= 64);
      s[ii] = ok ? s[ii] - coef * (float)ar : -INFINITY;
    }
    float alpha; bf16x8 pk[2];
    softmax_tile(s, mrun, lrun, alpha, pk[0], pk[1]);
#pragma unroll
    for (int dt = 0; dt < 2; ++dt) {
      o[dt] *= alpha;
#pragma unroll
      for (int s2 = 0; s2 < 2; ++s2) o[dt] = mfma32(vf[j & 1][dt][s2], pk[s2], o[dt]);
    }
  }
  const float lt = lrun + __shfl_xor(lrun, 32);
  const float c = frcp(lt);
  bf16_t* orow = p.oc + (tokbase + tq) * 768 + hh * 64;
#pragma unroll
  for (int dt = 0; dt < 2; ++dt)
#pragma unroll
    for (int g4 = 0; g4 < 4; ++g4) {
      const int dim = dt * 32 + g4 * 8 + half * 4;
      u32x2 pk = {cvt_pk_bf16(o[dt][g4 * 4 + 0] * c, o[dt][g4 * 4 + 1] * c), cvt_pk_bf16(o[dt][g4 * 4 + 2] * c, o[dt][g4 * 4 + 3] * c)};
      *(u32x2*)(orow + dim) = pk;
    }
  if (half == 0) p.lse[(tokbase + tq) * 12 + hh] = mrun + log2f(lt);
}

constexpr int CV_ROW = 784;
constexpr int LDS_CK = 0, LDS_CV = 384 * TB_ROW;
__device__ void attn_c_block(const Params& p, int L, int lshift, int seq, int g, int h, int pblk, LAS unsigned char* lds) {
  const int tid = opaque_tid(), lane = tid & 63, wid = __builtin_amdgcn_readfirstlane(tid >> 6);
  const int q = lane & 31, half = lane >> 5;
  const size_t tokbase = (size_t)seq * L;
  const int ds = (g == 0) ? 0 : (g == 1 ? 2 : 4), d = 1 << ds, M = L >> ds;
  const int hh = g * 4 + h;
  const int p0 = pblk * 256;
  {
    const int part = tid & 7;
#pragma unroll
    for (int c = 0; c < 6; ++c) {
      const int row = (tid >> 3) + c * 64;
      int pp = p0 - 64 + row; pp = pp < 0 ? 0 : (pp > L - 1 ? L - 1 : pp);
      const int tok = ((pp & (M - 1)) << ds) + (pp >> (lshift - ds));
      const bf16x8 v = ld16(p.u + (tokbase + tok) * UW + U_KC + hh * 64 + part * 8);
      *(LAS bf16x8*)(lds + LDS_CK + row * TB_ROW + part * 16) = v;
    }
#pragma unroll
    for (int c = 0; c < 6; ++c) {
      const int idx = tid + c * 512, dim = idx / 48, c8 = idx % 48;
      int pp = p0 - 64 + c8 * 8; pp = pp < 0 ? 0 : (pp > L - 8 ? L - 8 : pp);
      const bf16x8 v = ld16(p.vt + ((size_t)seq * VW + V_C + hh * 64 + dim) * L + pp);
      LAS unsigned char* dst = lds + LDS_CV + dim * CV_ROW + ((c8 >> 1) * 16 + (c8 & 1) * 4) * 2;
      *(LAS bf16x4*)dst = __builtin_shufflevector(v, v, 0, 1, 2, 3); *(LAS bf16x4*)(dst + 16) = __builtin_shufflevector(v, v, 4, 5, 6, 7);
    }
  }
  const int pw = p0 + wid * 32;
  const int rr = pw >> (lshift - ds), m0 = pw & (M - 1), mq = m0 + q, tq = mq * d + rr;
  bf16x8 qf[4];
  { const bf16_t* qp = p.u + (tokbase + tq) * UW + U_QC + hh * 64 + half * 8;
#pragma unroll
    for (int ks = 0; ks < 4; ++ks) qf[ks] = ld16(qp + ks * 16); }
  f32x16 o[2] = {zero16(), zero16()};
  float mrun = -1e30f, lrun = 0.f;
  const float coef = exp2f(-(2.0f / 3.0f) * (float)(hh + 1)) * (float)d * LOG2E;
  __syncthreads();
#pragma unroll
  for (int j = 0; j < 5; ++j) {
    const int mk0 = m0 - 64 + 32 * j;
    if (mk0 + 32 <= 0 || mk0 >= M) continue;
    const LAS unsigned char* kb = lds + LDS_CK + ((wid + j) * 32 + q) * TB_ROW + half * 16;
    f32x16 sc = zero16();
#pragma unroll
    for (int ks = 0; ks < 4; ++ks) sc = mfma32(*(const LAS bf16x8*)(kb + ks * 32), qf[ks], sc);
#pragma unroll
    for (int ii = 0; ii < 16; ++ii) {
      const int mk = mk0 + (ii >> 2) * 8 + half * 4 + (ii & 3);
      const int rel = mk - mq; const int ar = rel < 0 ? -rel : rel;
      const bool ok = (mk >= 0) && (mk < M) && (ar <= 64);
      sc[ii] = ok ? sc[ii] - coef * (float)ar : -INFINITY;
    }
    float alpha; bf16x8 pk[2];
    softmax_tile(sc, mrun, lrun, alpha, pk[0], pk[1]);
#pragma unroll
    for (int dt = 0; dt < 2; ++dt) {
      o[dt] *= alpha;
#pragma unroll
      for (int s2 = 0; s2 < 2; ++s2)
        o[dt] = mfma32(*(const LAS bf16x8*)(lds + LDS_CV + (dt * 32 + q) * CV_ROW + ((wid + j) * 32 + s2 * 16) * 2 + half * 16), pk[s2], o[dt]);
    }
  }
  __syncthreads();
  const float lt = lrun + __shfl_xor(lrun, 32);
  const float c = frcp(lt);
  bf16_t* orow = p.oc + (tokbase + tq) * 768 + hh * 64;
#pragma unroll
  for (int dt = 0; dt < 2; ++dt)
#pragma unroll
    for (int g4 = 0; g4 < 4; ++g4) {
      const int dim = dt * 32 + g4 * 8 + half * 4;
      u32x2 pk = {cvt_pk_bf16(o[dt][g4 * 4 + 0] * c, o[dt][g4 * 4 + 1] * c), cvt_pk_bf16(o[dt][g4 * 4 + 2] * c, o[dt][g4 * 4 + 3] * c)};
      *(u32x2*)(orow + dim) = pk;
    }
  if (half == 0) p.lse[(tokbase + tq) * 12 + hh] = mrun + log2f(lt);
}

__device__ void phase_attn(const Params& p, int layer, int L, int lshift, LAS unsigned char* lds) {
  const int tiles = L >> 5;
  const int nseq = TC >> lshift;
  const int nw = gridDim.x * 8;
  int w, lane;
  { const int qblks = L >> 8, npairs = nseq * 4, nunits = npairs * qblks;
    for (int rep = 0; rep < PROBE_B; ++rep)
    for (int b = blockIdx.x; b < nunits; b += gridDim.x) {
      int pair, qblk;
      if ((gridDim.x & 7) == 0 && (npairs & 7) == 0 && nunits == (int)gridDim.x) { const int xcd = b & 7, j = b >> 3; pair = xcd * (npairs >> 3) + j / qblks; qblk = j % qblks; }
      else { pair = b / qblks; qblk = b % qblks; }
      attn_b_block(p, layer, L, pair >> 2, pair & 3, qblk, lds);
    }
  }
  { const int tid = opaque_tid(); lane = tid & 63; w = blockIdx.x * 8 + __builtin_amdgcn_readfirstlane(tid >> 6); }
  for (int rep = 0; rep < PROBE_AC; ++rep) {
  { const int rgs = L >> 8, nunits = nseq * 8 * rgs;
    for (int b = blockIdx.x; b < nunits; b += gridDim.x) { const int sh = b / rgs, rg = b % rgs; attn_a_block(p, layer, L, sh >> 3, sh & 7, rg * 4, lds); }
  }
  { const int tid = opaque_tid(); lane = tid & 63; w = blockIdx.x * 8 + __builtin_amdgcn_readfirstlane(tid >> 6); }
  { const int pbs = L >> 8, nunits = nseq * 12 * pbs;
    for (int b = blockIdx.x; b < nunits; b += gridDim.x) {
      const int pblk = b % pbs, sgh = b / pbs;
      const int seq = sgh / 12, gh = sgh % 12;
      attn_c_block(p, L, lshift, seq, gh >> 2, gh & 3, pblk, lds);
    }
  }
  }
}

__device__ void phase_combine(const Params& p) {
  const int gt = blockIdx.x * 512 + opaque_tid(), ngt = gridDim.x * 512;
  for (int it = gt; it < TC * 32; it += ngt) {
    const int tok = it >> 5, sub = it & 31, h = sub >> 3, d8 = (sub & 7) * 8;
    const float* ls = p.lse + (size_t)tok * 12;
    const float l0 = ls[h], l1 = ls[4 + h], l2 = ls[8 + h];
    const float mx = fmaxf(l0, fmaxf(l1, l2));
    const float w0 = fexp2(l0 - mx), w1 = fexp2(l1 - mx), w2 = fexp2(l2 - mx);
    const float inv = frcp(w0 + w1 + w2);
    const bf16_t* ob = p.oc + (size_t)tok * 768 + h * 64 + d8;
    const u32x4 a = *(const u32x4*)ob, b = *(const u32x4*)(ob + 256), c = *(const u32x4*)(ob + 512);
    const u32x4 z = *(const u32x4*)(p.u + (size_t)tok * UW + U_ZC + h * 64 + d8);
    u32x4 r;
#pragma unroll
    for (int k = 0; k < 4; ++k) {
      const float vlo = (w0 * bf_lo(a[k]) + w1 * bf_lo(b[k]) + w2 * bf_lo(c[k])) * inv * silu(bf_lo(z[k]));
      const float vhi = (w0 * bf_hi(a[k]) + w1 * bf_hi(b[k]) + w2 * bf_hi(c[k])) * inv * silu(bf_hi(z[k]));
      r[k] = cvt_pk_bf16(vlo, vhi);
    }
    *(u32x4*)(p.yg + (size_t)tok * YW + 1024 + h * 64 + d8) = r;
  }
}


#define XB_TMO      128
#define XB_XCNT(j)  (256  + 64 * (j))
#define XB_XSUB(j)  (1280 + 64 * (j))
#define XB_XGEN(j)  (2304 + 64 * (j))
#define XB_TOP      3328
#define XB_TOPGEN   3392
#define XCD_BAR_WORDS 3456
#define XB_SPIN_CAP (1u << 18)
__device__ __forceinline__ unsigned xb_ld(unsigned* p)              { return __hip_atomic_load(p, __ATOMIC_RELAXED, __HIP_MEMORY_SCOPE_AGENT); }
__device__ __forceinline__ unsigned xb_add(unsigned* p, unsigned v) { return __hip_atomic_fetch_add(p, v, __ATOMIC_RELAXED, __HIP_MEMORY_SCOPE_AGENT); }
__device__ __forceinline__ unsigned xb_xcc_id() { return (unsigned)__builtin_amdgcn_s_getreg((3 << 11) | 20) & 0xFu; }
#define XB_SPIN(cond, bar) do { unsigned _sp = 0; while (cond) { __builtin_amdgcn_s_sleep(1); \
    if ((++_sp & 255u) == 0u) { if (xb_ld(&(bar)[XB_TMO])) break; if (_sp > XB_SPIN_CAP) { atomicAdd(&(bar)[XB_TMO], 1u); break; } } } } while (0)
struct XcdBarrier { unsigned* bar; unsigned x; volatile LAS unsigned* st; };
__device__ __forceinline__ XcdBarrier xcd_barrier_post(unsigned* bar, volatile LAS unsigned* st) {
  XcdBarrier b; b.bar = bar; b.x = xb_xcc_id(); b.st = st;
  if (opaque_tid() == 0) (void)xb_add(&bar[XB_XCNT(b.x)], 1u);
  return b;
}
__device__ __forceinline__ void xcd_barrier_complete(unsigned* bar, unsigned x, unsigned& nloc, unsigned& nx) {
  const unsigned G = gridDim.x * gridDim.y * gridDim.z;
  unsigned sum, cnt, mine, sp = 0u;
  for (;;) {
    sum = 0u; cnt = 0u; mine = 0u;
#pragma unroll
    for (unsigned j = 0; j < 16; ++j) { const unsigned c = xb_ld(&bar[XB_XCNT(j)]); sum += c; cnt += (c > 0u) ? 1u : 0u; mine = (j == x) ? c : mine; }
    if (sum == G) break;
    __builtin_amdgcn_s_sleep(1);
    if ((++sp & 255u) == 0u) { if (xb_ld(&bar[XB_TMO])) break; if (sp > XB_SPIN_CAP) { atomicAdd(&bar[XB_TMO], 1u); break; } }
  }
  nloc = mine > 0u ? mine : 1u; nx = cnt > 0u ? cnt : 1u;
}
__device__ __forceinline__ void xcd_barrier(const XcdBarrier& b) {
  asm volatile("s_waitcnt vmcnt(0)" ::: "memory");
  __syncthreads();
  if (opaque_tid() == 0) {
    unsigned* bar = b.bar;
    __builtin_amdgcn_s_waitcnt(0);
    unsigned nloc = b.st[0], nx = b.st[1];
    if (nloc == 0u) { xcd_barrier_complete(bar, b.x, nloc, nx); b.st[0] = nloc; b.st[1] = nx; }
    const unsigned old = xb_add(&bar[XB_XSUB(b.x)], 1u);
    const unsigned gen = old / nloc;
    if (old + 1u == (gen + 1u) * nloc) {
      __builtin_amdgcn_fence(__ATOMIC_RELEASE, "agent");
      asm volatile("s_waitcnt vmcnt(0)" ::: "memory");
      const unsigned og = xb_add(&bar[XB_TOP], 1u);
      const unsigned tg = og / nx;
      if (og + 1u == (tg + 1u) * nx) xb_add(&bar[XB_TOPGEN], 1u);
      else XB_SPIN(xb_ld(&bar[XB_TOPGEN]) == tg, bar);
      __builtin_amdgcn_fence(__ATOMIC_ACQUIRE, "agent");
      xb_add(&bar[XB_XGEN(b.x)], 1u);
      asm volatile("s_waitcnt vmcnt(0)" ::: "memory");
    } else {
      XB_SPIN(xb_ld(&bar[XB_XGEN(b.x)]) == gen, bar);
      __builtin_amdgcn_fence(__ATOMIC_ACQUIRE, "agent");
      asm volatile("s_waitcnt vmcnt(0)" ::: "memory");
    }
  }
  __syncthreads();
}

__global__ void __launch_bounds__(512) fwd_megakernel(Params p) {
  __shared__ __attribute__((aligned(16))) unsigned char smem[LDS_ATT_TOTAL > pg8::STAGE_BYTES ? LDS_ATT_TOTAL : pg8::STAGE_BYTES];
  __shared__ __attribute__((aligned(16))) unsigned xb_words[4];
  cg::grid_group grid = cg::this_grid();
  if (threadIdx.x == 0) { xb_words[0] = 0u; xb_words[1] = 0u; xb_words[2] = 0u; xb_words[3] = 0u; }
  if ((threadIdx.x & 63) == 0) g_wid_table[hw_wave_slot()] = (int)(threadIdx.x >> 6);
  __syncthreads();
  const XcdBarrier xb = xcd_barrier_post(p.bar, (volatile LAS unsigned*)xb_words);
#define GSYNC() do { for (int rep_ = 0; rep_ < PROBE_SYNC; ++rep_) xcd_barrier(xb); } while (0)
  LAS unsigned char* lds = (LAS unsigned char*)smem;
  for (int rep = 0; rep < PROBE_SMALL; ++rep) phase_prep(p, (LAS float*)smem);
  for (int rep = 0; rep < PROBE_SMALL; ++rep) phase_x(p, 0);
  grid.sync();
  for (int chunk = 0; chunk < NCHUNK; ++chunk) {
    const int L = chunk < 2 ? 2048 : 4096, lshift = chunk < 2 ? 11 : 12;
    const float* xin = (chunk < 2) ? p.xp + (size_t)chunk * TC * DM : p.xs + (size_t)(chunk - 2) * TC * DM;
    float* xres = p.out + (size_t)chunk * TC * DM;
    float* ssq = p.ssq + (size_t)chunk * TC * 16;
    for (int layer = 0; layer < DEPTH; ++layer) {
      {
        for (int rep = 0; rep < PROBE_P1; ++rep) {
        { pg8::Gemm g{p.xb, p.wt_in + (size_t)layer * INW * DM, TC, UW, DM, 0, lshift};
          pg8::StaticOrder S; S.init(TC, UW, gridDim.x, blockIdx.x);
          EpiU E{p.u, p.rinv + (size_t)chunk * TC, p.b_gate + (size_t)layer * 3 * DM};
          pg8::gemm_phase(lds, g, S, E); }
        {
          pg8::Gemm g{p.wt_in + ((size_t)layer * INW + UW) * DM, p.xb, VW, TC, DM, 1, lshift};
          pg8::StaticOrder S; S.init(VW, TC, gridDim.x, (blockIdx.x + (gridDim.x >> 2)) % gridDim.x);
          EpiVT E{p.vt, p.rinv + (size_t)chunk * TC, L, lshift};
          pg8::gemm_phase(lds, g, S, E); }
        if (rep + 1 < PROBE_P1) GSYNC();
        }
      }
      GSYNC();
      for (int rep = 0; rep < PROBE_ATT; ++rep) { phase_attn(p, layer, L, lshift, lds);
      GSYNC(); }
      for (int rep = 0; rep < PROBE_SMALL; ++rep) phase_combine(p);
      GSYNC();
      {
        pg8::Gemm g{p.yg, p.wt_br + (size_t)layer * DM * YW, TC, DM, YW, 0, 0};
        pg8::StaticOrder S; S.init(TC, DM, gridDim.x, blockIdx.x);
        EpiMerge E{p.u, p.merged};
        for (int rep = 0; rep < PROBE_3A; ++rep) pg8::gemm_phase(lds, g, S, E);
      }
      GSYNC();
      {
        pg8::Gemm g{p.merged, p.wt_out + (size_t)layer * DM * DM, TC, DM, DM, 0, 0};
        pg8::StaticOrder S; S.init(TC, DM, gridDim.x, blockIdx.x);
        EpiRes E{layer == 0 ? xin : (const float*)xres, xres, p.xb, ssq};
        pg8::gemm_phase(lds, g, S, E);
        if (PROBE_3B > 1 && layer == 0) { for (int rep = 0; rep < 4 * (PROBE_3B - 1); ++rep) pg8::gemm_phase(lds, g, S, E); }
      }
      GSYNC();
      if (layer + 1 < DEPTH) { phase_rinv(p, chunk); GSYNC(); }
    }
    phase_final(p, chunk);
    if (chunk + 1 < NCHUNK) { for (int rep = 0; rep < PROBE_SMALL; ++rep) phase_x(p, chunk + 1); GSYNC(); }
  }
}

extern "C" void kernel_launch(void* const* d_in, const int* in_sizes, int n_in, void* d_out, int out_size, void* d_ws, size_t ws_size, hipStream_t stream) {
  (void)in_sizes; (void)n_in; (void)out_size;
  static int grid_blocks = 0;
  if (!grid_blocks) {
    int dev = 0, cus = 0, per_cu = 0;
    hipGetDevice(&dev);
    hipDeviceGetAttribute(&cus, hipDeviceAttributeMultiprocessorCount, dev);
    hipOccupancyMaxActiveBlocksPerMultiprocessor(&per_cu, fwd_megakernel, 512, 0);
    if (per_cu < 1) per_cu = 1;
    grid_blocks = cus * per_cu;
    if (grid_blocks > 256) grid_blocks = 256;
  }
  Params p{};
  p.xp = (const float*)d_in[0]; p.xs = (const float*)d_in[1]; p.g_norm = (const float*)d_in[2]; p.w_in = (const float*)d_in[3];
  p.b_gate = (const float*)d_in[4]; p.rpb = (const float*)d_in[5]; p.lam_qk = (const float*)d_in[6]; p.g_diff = (const float*)d_in[7];
  p.w_br_a = (const float*)d_in[8]; p.w_br_b = (const float*)d_in[9]; p.w_br_c = (const float*)d_in[10]; p.w_out = (const float*)d_in[11];
  p.g_final = (const float*)d_in[12];
  p.out = (float*)d_out;
  char* w = (char*)d_ws; size_t off = 0;
  auto take = [&](size_t bytes) { char* r = w + off; off += (bytes + 255) & ~(size_t)255; return r; };
  p.wt_in = (bf16_t*)take((size_t)DEPTH * INW * DM * 2);
  p.wt_br = (bf16_t*)take((size_t)DEPTH * DM * YW * 2);
  p.wt_out = (bf16_t*)take((size_t)DEPTH * DM * DM * 2);
  p.xb = (bf16_t*)take((size_t)TC * DM * 2);
  p.u = (bf16_t*)take((size_t)TC * UW * 2);
  p.vt = (bf16_t*)take((size_t)TC * VW * 2);
  p.yg = (bf16_t*)take((size_t)TC * YW * 2);
  p.oc = (bf16_t*)take((size_t)TC * 768 * 2);
  p.merged = (bf16_t*)take((size_t)TC * DM * 2);
  p.lse = (float*)take((size_t)TC * 12 * 4);
  p.ssq = (float*)take((size_t)NTOK * 16 * 4);
  p.lam = (float*)take(256);
  p.rinv = (float*)take((size_t)NTOK * 4);
  p.bar = (unsigned*)take((size_t)XCD_BAR_WORDS * 4);
  if (off > ws_size) fprintf(stderr, "workspace too small: need %zu have %zu\n", off, ws_size);
  hipMemsetAsync(p.bar, 0, (size_t)XCD_BAR_WORDS * 4, stream);
  void* args[] = {&p};
  hipError_t e = hipLaunchCooperativeKernel((void*)fwd_megakernel, dim3(grid_blocks), dim3(512), args, 0, stream);
  if (e != hipSuccess) fprintf(stderr, "cooperative launch failed: %s (grid %d)\n", hipGetErrorString(e), grid_blocks);
}
```

```cpp
#include <hip/hip_runtime.h>
#include <hip/hip_cooperative_groups.h>
#include <cstdio>
namespace cg = cooperative_groups;

#define LAS __attribute__((address_space(3)))
typedef unsigned short bf16_t;
typedef short bf16x8 __attribute__((ext_vector_type(8)));
typedef short bf16x4 __attribute__((ext_vector_type(4)));
typedef float f32x4 __attribute__((ext_vector_type(4)));
typedef float f32x16 __attribute__((ext_vector_type(16)));
typedef unsigned u32x4 __attribute__((ext_vector_type(4)));
typedef unsigned u32x2 __attribute__((ext_vector_type(2)));

constexpr int DM = 1024, DEPTH = 4, INW = 9728, UW = 7936, VW = 1792, YW = 1280;
constexpr int TC = 16384, NCHUNK = 4, NTOK = 65536;
constexpr float LOG2E = 1.4426950408889634f;
constexpr float QSCALE = 0.125f * LOG2E;
constexpr int U_QA = 0, U_KA = 512, U_ZA = 1024, U_QB = 1536, U_KB = 2048, U_ZB = 2560, U_QC = 3072, U_KC = 3840, U_ZC = 4608, U_GL = 4864;
constexpr int V_A = 0, V_B = 512, V_C = 1024;

struct Params {
  const float *xp, *xs, *g_norm, *w_in, *b_gate, *rpb, *lam_qk, *g_diff, *w_br_a, *w_br_b, *w_br_c, *w_out, *g_final;
  float* out;
  bf16_t *wt_in, *wt_br, *wt_out, *xb, *u, *vt, *yg, *oc, *merged;
  float *lse, *ssq, *lam, *rinv;
  unsigned* bar;
};

__device__ __forceinline__ unsigned cvt_pk_bf16(float lo, float hi) { unsigned r; asm volatile("v_cvt_pk_bf16_f32 %0, %1, %2" : "=v"(r) : "v"(lo), "v"(hi)); return r; }
__device__ __forceinline__ float bf_lo(unsigned v) { return __uint_as_float(v << 16); }
__device__ __forceinline__ float bf_hi(unsigned v) { return __uint_as_float(v & 0xffff0000u); }
__device__ __forceinline__ float fexp2(float x) { return __builtin_amdgcn_exp2f(x); }
__device__ __forceinline__ float frcp(float x) { return __builtin_amdgcn_rcpf(x); }

__shared__ int g_wid_table[64];
__device__ __forceinline__ unsigned hw_wave_slot() { return (unsigned)__builtin_amdgcn_s_getreg(((6 - 1) << 11) | (0 << 6) | 4) & 63u; }
__device__ __forceinline__ int opaque_tid() {
  const int wid = __builtin_amdgcn_readfirstlane(g_wid_table[hw_wave_slot()]);
  unsigned z = 0u; asm volatile("" : "+v"(z));
  int t = wid * 64 + (int)__builtin_amdgcn_mbcnt_hi(~0u, __builtin_amdgcn_mbcnt_lo(~0u, z));
  asm volatile("" : "+v"(t)); return t;
}

namespace pg8 {
constexpr int BM = 256, BK = 64, HALF = 128, HTB = HALF * BK * 2, STAGE_BYTES = 8 * HTB, NXCD = 8, WGM = 8;
__device__ __forceinline__ int lds_byte(int r, int c) { const int st = (r >> 4) * 2 + (c >> 5), rr = r & 15, cc = c & 31, ob = rr * 64 + cc * 2; return st * 1024 + (ob ^ (((ob >> 9) & 1) << 5)); }
__device__ __forceinline__ void stage_rc(int b, int& R, int& C) { const int st = b / 1024, sb = b % 1024, swz = sb ^ (((sb >> 9) & 1) << 5); R = (st >> 1) * 16 + swz / 64; C = (st & 1) * 32 + (swz % 64) / 2; }
__device__ __forceinline__ int perm32(int rho) { const int n = rho >> 4, i = rho & 15; return 8 * (i >> 2) + 4 * n + (i & 3); }
struct Unit { int pm, pn; };
struct Gemm { const bf16_t* A; const bf16_t* Bt; int M, N, K; int bperm, lshift; };
struct StaticOrder {
  int nM, nN, nwg, G, c;
  __device__ void init(int M, int N, int G_, int c_) { nM = M / BM; nN = N / BM; nwg = nM * nN; G = G_; c = c_; }
  __device__ bool next(int i, Unit& u) const {
    const long L = (long)i * G + c; if (L >= nwg) return false;
    int wgid = (int)L; { const int q = nwg / NXCD, r = nwg % NXCD, xcd = wgid % NXCD, off = wgid / NXCD; wgid = (xcd < r ? xcd * (q + 1) : r * (q + 1) + (xcd - r) * q) + off; }
    const int nig = WGM * nN, gid = wgid / nig, fm = gid * WGM, gsz = (nM - fm) < WGM ? (nM - fm) : WGM;
    u.pm = fm + ((wgid % nig) % gsz); u.pn = (wgid % nig) / gsz; return true;
  }
};

template <class Epi>
__device__ __forceinline__ void gemm_phase(LAS unsigned char* lds, const Gemm g, const StaticOrder& S, const Epi& E) {
  const int tid_ = opaque_tid();
  const int tid = tid_, wid = __builtin_amdgcn_readfirstlane(tid >> 6), lane = tid & 63, wr = wid >> 2, wc = wid & 3, fr = lane & 15, fq = lane >> 4;
  const int K = g.K, nt = K / BK;
  const size_t kstep = (size_t)(BK * 2);
  const size_t hstep = (size_t)HALF * K * 2;
  const size_t tstep = 2 * hstep;
  unsigned voffA[2], voffBr[2], voffBc[2], voffB[2], voffBn[2];
#pragma unroll
  for (int i = 0; i < 2; ++i) { int R, C; stage_rc(tid * 16 + i * 8192, R, C); const int Rb = (R & ~31) + perm32(R & 31);
    voffA[i] = (unsigned)(R * K + C) * 2u; voffBr[i] = (unsigned)(Rb * K) * 2u; voffBc[i] = (unsigned)C * 2u; voffB[i] = voffBr[i] + voffBc[i]; voffBn[i] = voffB[i]; }
  auto bbase = [&](const Unit& u, int hh, int& sh) -> const char* {
    if (!g.bperm) { sh = 0; return (const char*)g.Bt + (size_t)u.pn * tstep + (size_t)hh * hstep; }
    const int ds = u.pm <= 4 ? 0 : (u.pm == 5 ? 2 : 4); sh = ds;
    const int L = 1 << g.lshift; const int p0 = u.pn * 256 + hh * 128, seq = p0 >> g.lshift, p = p0 & (L - 1);
    const int Mc = L >> ds, r = p / Mc, m0 = p & (Mc - 1);
    return (const char*)g.Bt + ((size_t)seq * L + ((size_t)m0 << ds) + r) * (size_t)K * 2;
  };
  const unsigned ldsw = (unsigned)wid * 1024u;
  const int aoff = lds_byte(wr * 64 + fr, fq * 8), boff = lds_byte(wc * 32 + fr, fq * 8);
#define PG8_SA(b, h) (((b) * 2 + (h)) * HTB)
#define PG8_SB(b, h) ((4 + (b) * 2 + (h)) * HTB)
#define PG8_STAGE(bufoff, gbase, voff) do { _Pragma("unroll") for (int _i = 0; _i < 2; ++_i) \
    __builtin_amdgcn_global_load_lds((const unsigned*)((const char*)(gbase) + (voff)[_i]), (LAS unsigned*)(lds + (bufoff) + ldsw + _i * 8192), 16, 0, 0); } while (0)
#define PG8_LDA(dst, b, h) do { _Pragma("unroll") for (int m = 0; m < 4; ++m) _Pragma("unroll") for (int k = 0; k < 2; ++k) dst[m][k] = *(const LAS bf16x8*)(lds + PG8_SA(b, h) + aoff + m * 2048 + k * 1024); } while (0)
#define PG8_LDB(dst, b, h) do { _Pragma("unroll") for (int n = 0; n < 2; ++n) _Pragma("unroll") for (int k = 0; k < 2; ++k) dst[n][k] = *(const LAS bf16x8*)(lds + PG8_SB(b, h) + boff + n * 2048 + k * 1024); } while (0)
#define PG8_MMA(ai, bj, At, Bt) do { __builtin_amdgcn_s_setprio(1); _Pragma("unroll") for (int m = 0; m < 4; ++m) _Pragma("unroll") for (int n = 0; n < 2; ++n) _Pragma("unroll") for (int k = 0; k < 2; ++k) \
    acc[ai][bj][m][n] = __builtin_amdgcn_mfma_f32_16x16x32_bf16(Bt[n][k], At[m][k], acc[ai][bj][m][n], 0, 0, 0); __builtin_amdgcn_s_setprio(0); } while (0)
#define PG8_WAIT_V(n) asm volatile("s_waitcnt vmcnt(" #n ")" ::: "memory")
#define PG8_WAIT_L(n) asm volatile("s_waitcnt lgkmcnt(" #n ")" ::: "memory")
#define PG8_BAR __builtin_amdgcn_s_barrier()
#define PG8_SCHED __builtin_amdgcn_sched_barrier(0)
  Unit cur, nxt; int ui = 0;
  if (!S.next(0, cur)) return;
  f32x4 acc[2][2][4][2];
#pragma unroll
  for (int a = 0; a < 2; ++a)
#pragma unroll
    for (int b = 0; b < 2; ++b)
#pragma unroll
      for (int m = 0; m < 4; ++m)
#pragma unroll
        for (int n = 0; n < 2; ++n) acc[a][b][m][n] = (f32x4){0.f, 0.f, 0.f, 0.f};
  bf16x8 At[4][2], B0[2][2], B1[2][2];
  const char* cA = (const char*)g.A + (size_t)cur.pm * tstep;
  int csh; const char* cB0 = bbase(cur, 0, csh); const char* cB1 = bbase(cur, 1, csh);
#pragma unroll
  for (int i = 0; i < 2; ++i) voffB[i] = (voffBr[i] << csh) + voffBc[i];
  PG8_STAGE(PG8_SB(0, 0), cB0, voffB); PG8_STAGE(PG8_SA(0, 0), cA, voffA); PG8_STAGE(PG8_SB(0, 1), cB1, voffB); PG8_STAGE(PG8_SA(0, 1), cA + hstep, voffA);
  if (wr == 1) PG8_BAR;
  PG8_WAIT_V(4); PG8_BAR;
  PG8_STAGE(PG8_SB(1, 0), cB0 + kstep, voffB); PG8_STAGE(PG8_SA(1, 0), cA + kstep, voffA); PG8_STAGE(PG8_SB(1, 1), cB1 + kstep, voffB);
  PG8_WAIT_V(6); PG8_BAR;
  for (;;) {
    const bool has_next = S.next(ui + 1, nxt);
    const char* nA = cA; const char* nB0 = cB0; const char* nB1 = cB1;
#pragma unroll
    for (int i = 0; i < 2; ++i) voffBn[i] = voffB[i];
    if (has_next) { int nsh; nA = (const char*)g.A + (size_t)nxt.pm * tstep; nB0 = bbase(nxt, 0, nsh); nB1 = bbase(nxt, 1, nsh);
#pragma unroll
      for (int i = 0; i < 2; ++i) voffBn[i] = (voffBr[i] << nsh) + voffBc[i]; }
    for (int t = 0; t < nt; t += 2) {
      if constexpr (Epi::HOOK) { if (t == 8 || t == 16) E.hook(acc, cur, t, wr, wc, fr, fq); }
      const bool last = (t == nt - 2);
      const char* a1 = cA + (size_t)(t + 1) * kstep;
      const char* a2 = last ? nA : cA + (size_t)(t + 2) * kstep;
      const char* b20 = last ? nB0 : cB0 + (size_t)(t + 2) * kstep; const char* b21 = last ? nB1 : cB1 + (size_t)(t + 2) * kstep;
      const char* a3 = a2 + kstep; const char* b30 = b20 + kstep; const char* b31 = b21 + kstep;
      unsigned vB[2];
#pragma unroll
      for (int i = 0; i < 2; ++i) vB[i] = last ? voffBn[i] : voffB[i];
      PG8_LDB(B0, 0, 0); PG8_SCHED; PG8_LDA(At, 0, 0); PG8_STAGE(PG8_SA(1, 1), a1 + hstep, voffA);
      PG8_WAIT_L(8); PG8_BAR; PG8_WAIT_L(0); PG8_MMA(0, 0, At, B0); PG8_BAR; PG8_SCHED;
      PG8_LDB(B1, 0, 1); PG8_STAGE(PG8_SB(0, 0), b20, vB);
      PG8_BAR; PG8_WAIT_L(0); PG8_MMA(0, 1, At, B1); PG8_BAR;
      PG8_LDA(At, 0, 1); PG8_STAGE(PG8_SA(0, 0), a2, voffA);
      PG8_BAR; PG8_WAIT_L(0); PG8_MMA(1, 0, At, B0); PG8_BAR; PG8_SCHED;
      PG8_STAGE(PG8_SB(0, 1), b21, vB);
      PG8_WAIT_V(6); PG8_BAR; PG8_MMA(1, 1, At, B1); PG8_BAR;
      PG8_LDB(B0, 1, 0); PG8_SCHED; PG8_LDA(At, 1, 0); PG8_STAGE(PG8_SA(0, 1), a2 + hstep, voffA);
      PG8_WAIT_L(8); PG8_BAR; PG8_WAIT_L(0); PG8_MMA(0, 0, At, B0); PG8_BAR; PG8_SCHED;
      PG8_LDB(B1, 1, 1); PG8_STAGE(PG8_SB(1, 0), b30, vB);
      PG8_BAR; PG8_WAIT_L(0); PG8_MMA(0, 1, At, B1); PG8_BAR;
      PG8_LDA(At, 1, 1); PG8_STAGE(PG8_SA(1, 0), a3, voffA);
      PG8_BAR; PG8_WAIT_L(0); PG8_MMA(1, 0, At, B0); PG8_BAR; PG8_SCHED;
      PG8_STAGE(PG8_SB(1, 1), b31, vB);
      PG8_WAIT_V(6); PG8_BAR; PG8_MMA(1, 1, At, B1); PG8_BAR;
    }
    E(acc, cur, wr, wc, fr, fq);
    if (!has_next) break;
#pragma unroll
    for (int a = 0; a < 2; ++a)
#pragma unroll
      for (int b = 0; b < 2; ++b)
#pragma unroll
        for (int m = 0; m < 4; ++m)
#pragma unroll
          for (int n = 0; n < 2; ++n) acc[a][b][m][n] = (f32x4){0.f, 0.f, 0.f, 0.f};
    cur = nxt; cA = nA; cB0 = nB0; cB1 = nB1; ++ui;
#pragma unroll
    for (int i = 0; i < 2; ++i) voffB[i] = voffBn[i];
  }
  PG8_WAIT_V(0);
  if (wr == 0) PG8_BAR;
  PG8_BAR;
#undef PG8_SA
#undef PG8_SB
#undef PG8_STAGE
#undef PG8_LDA
#undef PG8_LDB
#undef PG8_MMA
#undef PG8_WAIT_V
#undef PG8_WAIT_L
#undef PG8_BAR
#undef PG8_SCHED
}
}
using pg8::Unit;

struct EpiU {
  static constexpr bool HOOK = false;
  bf16_t* U; const float* rinv; const float* bg;
  __device__ __forceinline__ void hook(f32x4 (&)[2][2][4][2], const Unit&, int, int, int, int, int) const {}
  __device__ __forceinline__ void operator()(const f32x4 (&acc)[2][2][4][2], const Unit& u, int wr, int wc, int fr, int fq) const {
    asm volatile("" : "+v"(fr), "+v"(fq));
    const int row0 = u.pm * 256 + wr * 64 + fr, col0 = u.pn * 256 + wc * 32 + 8 * fq;
    const bool isg = (u.pn >= 19);
    float ri[2][4];
#pragma unroll
    for (int ai = 0; ai < 2; ++ai)
#pragma unroll
      for (int m = 0; m < 4; ++m) ri[ai][m] = rinv[row0 + ai * 128 + m * 16];
    if (isg) {
      f32x4 b[2][2];
#pragma unroll
      for (int bj = 0; bj < 2; ++bj) { const float* bp = bg + (col0 - U_GL) + bj * 128; b[bj][0] = *(const f32x4*)bp; b[bj][1] = *(const f32x4*)(bp + 4); }
#pragma unroll
      for (int ai = 0; ai < 2; ++ai)
#pragma unroll
        for (int m = 0; m < 4; ++m)
#pragma unroll
          for (int bj = 0; bj < 2; ++bj) {
            f32x4 v0 = acc[ai][bj][m][0] * ri[ai][m] + b[bj][0], v1 = acc[ai][bj][m][1] * ri[ai][m] + b[bj][1];
#pragma unroll
            for (int j = 0; j < 4; ++j) { v0[j] = 1.0f + fminf(fexp2(-v0[j] * LOG2E), 1e30f); v1[j] = 1.0f + fminf(fexp2(-v1[j] * LOG2E), 1e30f); }
            u32x4 pk = {cvt_pk_bf16(v0[0], v0[1]), cvt_pk_bf16(v0[2], v0[3]), cvt_pk_bf16(v1[0], v1[1]), cvt_pk_bf16(v1[2], v1[3])};
            *(u32x4*)(U + (size_t)(row0 + ai * 128 + m * 16) * UW + col0 + bj * 128) = pk;
          }
    } else {
#pragma unroll
      for (int ai = 0; ai < 2; ++ai)
#pragma unroll
        for (int m = 0; m < 4; ++m)
#pragma unroll
          for (int bj = 0; bj < 2; ++bj) {
            const f32x4 v0 = acc[ai][bj][m][0] * ri[ai][m], v1 = acc[ai][bj][m][1] * ri[ai][m];
            u32x4 pk = {cvt_pk_bf16(v0[0], v0[1]), cvt_pk_bf16(v0[2], v0[3]), cvt_pk_bf16(v1[0], v1[1]), cvt_pk_bf16(v1[2], v1[3])};
            *(u32x4*)(U + (size_t)(row0 + ai * 128 + m * 16) * UW + col0 + bj * 128) = pk;
          }
    }
  }
};

struct EpiVT {
  static constexpr bool HOOK = false;
  bf16_t* VT; const float* rv; int L, lshift;
  __device__ __forceinline__ void hook(f32x4 (&)[2][2][4][2], const Unit&, int, int, int, int, int) const {}
  __device__ __forceinline__ void operator()(const f32x4 (&acc)[2][2][4][2], const Unit& u, int wr, int wc, int fr, int fq) const {
    asm volatile("" : "+v"(fr), "+v"(fq));
    const int vrow0 = u.pm * 256 + wr * 64 + fr, pcol0 = u.pn * 256 + wc * 32 + 8 * fq;
    const int ds = u.pm <= 4 ? 0 : (u.pm == 5 ? 2 : 4);
    const int Mc = L >> ds;
#pragma unroll
    for (int bj = 0; bj < 2; ++bj) {
      const int p0 = pcol0 + bj * 128, seq = p0 >> lshift, pos = p0 & (L - 1);
      const int r = pos / Mc, m0 = pos & (Mc - 1);
      float rinv[8];
#pragma unroll
      for (int j = 0; j < 8; ++j) rinv[j] = rv[(seq << lshift) + ((m0 + j) << ds) + r];
      bf16_t* vb = VT + ((size_t)seq * VW + vrow0) * L + pos;
#pragma unroll
      for (int ai = 0; ai < 2; ++ai)
#pragma unroll
        for (int m = 0; m < 4; ++m) {
          const f32x4 v0 = acc[ai][bj][m][0], v1 = acc[ai][bj][m][1];
          u32x4 pk = {cvt_pk_bf16(v0[0] * rinv[0], v0[1] * rinv[1]), cvt_pk_bf16(v0[2] * rinv[2], v0[3] * rinv[3]),
                      cvt_pk_bf16(v1[0] * rinv[4], v1[1] * rinv[5]), cvt_pk_bf16(v1[2] * rinv[6], v1[3] * rinv[7])};
          *(u32x4*)(vb + (size_t)(ai * 128 + m * 16) * L) = pk;
        }
    }
  }
};

struct EpiMerge {
  static constexpr bool HOOK = true;
  const bf16_t* U; bf16_t* MG;
  __device__ __forceinline__ f32x4 gvec(int i, size_t row, int col) const {
    const u32x2 raw = *(const u32x2*)(U + row * UW + U_GL + i * 1024 + col);
    f32x4 e; e[0] = bf_lo(raw[0]); e[1] = bf_hi(raw[0]); e[2] = bf_lo(raw[1]); e[3] = bf_hi(raw[1]); return e;
  }
  __device__ __forceinline__ void hook(f32x4 (&acc)[2][2][4][2], const Unit& u, int t, int wr, int wc, int fr, int fq) const {
    const int i = (t == 8) ? 0 : 1;
    asm volatile("" : "+v"(fr), "+v"(fq));
    const int row0 = u.pm * 256 + wr * 64 + fr, col0 = u.pn * 256 + wc * 32 + 8 * fq;
#pragma unroll
    for (int ai = 0; ai < 2; ++ai) {
#pragma unroll
      for (int m = 0; m < 4; ++m)
#pragma unroll
        for (int bj = 0; bj < 2; ++bj) {
          const bf16_t* gp = U + (size_t)(row0 + ai * 128 + m * 16) * UW + U_GL + i * 1024 + col0 + bj * 128;
          const u32x4 a = *(const u32x4*)gp, b = *(const u32x4*)(gp + 1024);
#pragma unroll
          for (int n = 0; n < 2; ++n) {
            f32x4 r;
            r[0] = bf_lo(b[2 * n]) * frcp(bf_lo(a[2 * n])); r[1] = bf_hi(b[2 * n]) * frcp(bf_hi(a[2 * n]));
            r[2] = bf_lo(b[2 * n + 1]) * frcp(bf_lo(a[2 * n + 1])); r[3] = bf_hi(b[2 * n + 1]) * frcp(bf_hi(a[2 * n + 1]));
            acc[ai][bj][m][n] *= r;
          }
        }
      __builtin_amdgcn_sched_barrier(0);
    }
  }
  __device__ __forceinline__ void operator()(const f32x4 (&acc)[2][2][4][2], const Unit& u, int wr, int wc, int fr, int fq) const {
    asm volatile("" : "+v"(fr), "+v"(fq));
    const int row0 = u.pm * 256 + wr * 64 + fr, col0 = u.pn * 256 + wc * 32 + 8 * fq;
    u32x4 g2[2][4][2];
#pragma unroll
    for (int ai = 0; ai < 2; ++ai)
#pragma unroll
      for (int m = 0; m < 4; ++m)
#pragma unroll
        for (int bj = 0; bj < 2; ++bj) g2[ai][m][bj] = *(const u32x4*)(U + (size_t)(row0 + ai * 128 + m * 16) * UW + U_GL + 2 * 1024 + col0 + bj * 128);
    __builtin_amdgcn_sched_barrier(0);
#pragma unroll
    for (int ai = 0; ai < 2; ++ai)
#pragma unroll
      for (int m = 0; m < 4; ++m)
#pragma unroll
        for (int bj = 0; bj < 2; ++bj) {
          const size_t row = (size_t)(row0 + ai * 128 + m * 16); const int col = col0 + bj * 128;
          const u32x4 g = g2[ai][m][bj];
          f32x4 v0 = acc[ai][bj][m][0], v1 = acc[ai][bj][m][1];
          v0[0] *= frcp(bf_lo(g[0])); v0[1] *= frcp(bf_hi(g[0])); v0[2] *= frcp(bf_lo(g[1])); v0[3] *= frcp(bf_hi(g[1]));
          v1[0] *= frcp(bf_lo(g[2])); v1[1] *= frcp(bf_hi(g[2])); v1[2] *= frcp(bf_lo(g[3])); v1[3] *= frcp(bf_hi(g[3]));
          u32x4 pk = {cvt_pk_bf16(v0[0], v0[1]), cvt_pk_bf16(v0[2], v0[3]), cvt_pk_bf16(v1[0], v1[1]), cvt_pk_bf16(v1[2], v1[3])};
          *(u32x4*)(MG + row * DM + col) = pk;
        }
  }
};

struct EpiRes {
  static constexpr bool HOOK = false;
  const float* R; float* X; bf16_t* XB; float* ssq;
  __device__ __forceinline__ void hook(f32x4 (&)[2][2][4][2], const Unit&, int, int, int, int, int) const {}
  __device__ __forceinline__ void operator()(const f32x4 (&acc)[2][2][4][2], const Unit& u, int wr, int wc, int fr, int fq) const {
    asm volatile("" : "+v"(fr), "+v"(fq));
    const int row0 = u.pm * 256 + wr * 64 + fr, col0 = u.pn * 256 + wc * 32 + 8 * fq;
#pragma unroll
    for (int ai = 0; ai < 2; ++ai) {
      f32x4 r[4][2][2];
#pragma unroll
      for (int m = 0; m < 4; ++m)
#pragma unroll
        for (int bj = 0; bj < 2; ++bj) { const float* rp = R + (size_t)(row0 + ai * 128 + m * 16) * DM + col0 + bj * 128; r[m][bj][0] = *(const f32x4*)rp; r[m][bj][1] = *(const f32x4*)(rp + 4); }
      __builtin_amdgcn_sched_barrier(0);
#pragma unroll
      for (int m = 0; m < 4; ++m) {
        const size_t row = (size_t)(row0 + ai * 128 + m * 16);
        float s = 0.f;
#pragma unroll
        for (int bj = 0; bj < 2; ++bj) {
          const int col = col0 + bj * 128;
          const f32x4 v0 = r[m][bj][0] + acc[ai][bj][m][0], v1 = r[m][bj][1] + acc[ai][bj][m][1];
          *(f32x4*)(X + row * DM + col) = v0; *(f32x4*)(X + row * DM + col + 4) = v1;
          s += v0[0] * v0[0] + v0[1] * v0[1] + v0[2] * v0[2] + v0[3] * v0[3] + v1[0] * v1[0] + v1[1] * v1[1] + v1[2] * v1[2] + v1[3] * v1[3];
          u32x4 pk = {cvt_pk_bf16(v0[0], v0[1]), cvt_pk_bf16(v0[2], v0[3]), cvt_pk_bf16(v1[0], v1[1]), cvt_pk_bf16(v1[2], v1[3])};
          *(u32x4*)(XB + row * DM + col) = pk;
        }
        s += __shfl_xor(s, 16); s += __shfl_xor(s, 32);
        if (fq == 0) ssq[row * 16 + u.pn * 4 + wc] = s;
      }
      __builtin_amdgcn_sched_barrier(0);
    }
  }
};

__device__ __forceinline__ void prep_tile(const float* src, int ldn, int k0, int n0, const float* rscale, float cscale, bf16_t* dst, int ldd, int drow0, int dk0, LAS float* tile) {
  const int tid = opaque_tid(), kk = tid >> 6, nn = tid & 63;
#pragma unroll
  for (int i = 0; i < 8; ++i) {
    const int k = kk * 8 + i;
    float v = src[(size_t)(k0 + k) * ldn + n0 + nn] * cscale;
    if (rscale) v *= rscale[k0 + k];
    tile[k * 65 + nn] = v;
  }
  __syncthreads();
  const int n = tid >> 3, kc = tid & 7;
  float f[8];
#pragma unroll
  for (int j = 0; j < 8; ++j) f[j] = tile[(kc * 8 + j) * 65 + n];
  u32x4 pk = {cvt_pk_bf16(f[0], f[1]), cvt_pk_bf16(f[2], f[3]), cvt_pk_bf16(f[4], f[5]), cvt_pk_bf16(f[6], f[7])};
  *(u32x4*)(dst + (size_t)(drow0 + n) * ldd + dk0 + kc * 8) = pk;
  __syncthreads();
}

__device__ __forceinline__ void win_map(int n0, int& dn0, float& sc) {
  sc = 1.0f;
  if (n0 < 512) { dn0 = U_QA + n0; sc = QSCALE; }
  else if (n0 < 1024) dn0 = U_KA + (n0 - 512);
  else if (n0 < 1536) dn0 = UW + V_A + (n0 - 1024);
  else if (n0 < 2048) dn0 = U_ZA + (n0 - 1536);
  else if (n0 < 2560) { dn0 = U_QB + (n0 - 2048); sc = QSCALE; }
  else if (n0 < 3072) dn0 = U_KB + (n0 - 2560);
  else if (n0 < 3584) dn0 = UW + V_B + (n0 - 3072);
  else if (n0 < 4096) dn0 = U_ZB + (n0 - 3584);
  else if (n0 < 4864) { dn0 = U_QC + (n0 - 4096); sc = QSCALE; }
  else if (n0 < 5632) dn0 = U_KC + (n0 - 4864);
  else if (n0 < 6400) dn0 = UW + V_C + (n0 - 5632);
  else if (n0 < 6656) dn0 = U_ZC + (n0 - 6400);
  else dn0 = U_GL + (n0 - 6656);
}

__device__ void phase_prep(const Params& p, LAS float* tile) {
  constexpr int PER = 3008;
  for (int it = blockIdx.x; it < DEPTH * PER; it += gridDim.x) {
    const int l = it / PER; int r = it % PER;
    if (r < 2432) {
      const int kt = r / 152, ntile = r % 152; int dn0; float sc; win_map(ntile * 64, dn0, sc);
      prep_tile(p.w_in + (size_t)l * DM * INW, INW, kt * 64, ntile * 64, p.g_norm + l * DM, sc, p.wt_in + (size_t)l * INW * DM, DM, dn0, kt * 64, tile);
    } else if ((r -= 2432) < 128) {
      const int kt = r / 16, ntile = r % 16;
      prep_tile(p.w_br_a + (size_t)l * 512 * DM, DM, kt * 64, ntile * 64, nullptr, 1.0f, p.wt_br + (size_t)l * DM * YW, YW, ntile * 64, kt * 64, tile);
    } else if ((r -= 128) < 128) {
      const int kt = r / 16, ntile = r % 16;
      prep_tile(p.w_br_b + (size_t)l * 512 * DM, DM, kt * 64, ntile * 64, nullptr, 1.0f, p.wt_br + (size_t)l * DM * YW, YW, ntile * 64, 512 + kt * 64, tile);
    } else if ((r -= 128) < 64) {
      const int kt = r / 16, ntile = r % 16;
      prep_tile(p.w_br_c + (size_t)l * 256 * DM, DM, kt * 64, ntile * 64, nullptr, 1.0f, p.wt_br + (size_t)l * DM * YW, YW, ntile * 64, 1024 + kt * 64, tile);
    } else {
      r -= 64; const int kt = r / 16, ntile = r % 16;
      prep_tile(p.w_out + (size_t)l * DM * DM, DM, kt * 64, ntile * 64, nullptr, 1.0f, p.wt_out + (size_t)l * DM * DM, DM, ntile * 64, kt * 64, tile);
    }
  }
  const int ptid = opaque_tid();
  if (blockIdx.x == 0 && ptid < 64) {
    const int lane = ptid;
    for (int l = 0; l < DEPTH; ++l) {
      const float* lq = p.lam_qk + l * 256;
      float a = lq[lane] * lq[64 + lane], b = lq[128 + lane] * lq[192 + lane];
      for (int o = 32; o >= 1; o >>= 1) { a += __shfl_xor(a, o); b += __shfl_xor(b, o); }
      if (lane == 0) { const float li = 0.8f - 0.6f * expf(-0.3f * (float)l); p.lam[l] = expf(a) - expf(b) + li; p.lam[4 + l] = 1.0f - li; }
    }
  }
}

__device__ void phase_x(const Params& p, int chunk) {
  const float* xin = (chunk < 2) ? p.xp + (size_t)chunk * TC * DM : p.xs + (size_t)(chunk - 2) * TC * DM;
  float* ssq = p.ssq + (size_t)chunk * TC * 16;
  const int tid = opaque_tid(), lane = tid & 63, w = blockIdx.x * 8 + (tid >> 6), nw = gridDim.x * 8;
  for (int row = w; row < TC; row += nw) {
    const float* xr = xin + (size_t)row * DM + lane * 16;
    f32x4 v[4]; float s = 0.f;
#pragma unroll
    for (int i = 0; i < 4; ++i) { v[i] = *(const f32x4*)(xr + i * 4); s += v[i][0] * v[i][0] + v[i][1] * v[i][1] + v[i][2] * v[i][2] + v[i][3] * v[i][3]; }
    for (int o = 32; o >= 1; o >>= 1) s += __shfl_xor(s, o);
    u32x4 p0 = {cvt_pk_bf16(v[0][0], v[0][1]), cvt_pk_bf16(v[0][2], v[0][3]), cvt_pk_bf16(v[1][0], v[1][1]), cvt_pk_bf16(v[1][2], v[1][3])};
    u32x4 p1 = {cvt_pk_bf16(v[2][0], v[2][1]), cvt_pk_bf16(v[2][2], v[2][3]), cvt_pk_bf16(v[3][0], v[3][1]), cvt_pk_bf16(v[3][2], v[3][3])};
    bf16_t* xo = p.xb + (size_t)row * DM + lane * 16;
    *(u32x4*)xo = p0; *(u32x4*)(xo + 8) = p1;
    if (lane < 16) ssq[(size_t)row * 16 + lane] = (lane == 0) ? s : 0.f;
    if (lane == 0) p.rinv[(size_t)chunk * TC + row] = rsqrtf(s * (1.0f / 1024.0f) + 1e-6f);
  }
}

__device__ void phase_rinv(const Params& p, int chunk) {
  const float* ssq = p.ssq + (size_t)chunk * TC * 16; float* rv = p.rinv + (size_t)chunk * TC;
  for (int row = blockIdx.x * 512 + opaque_tid(); row < TC; row += gridDim.x * 512) {
    const f32x4* sp = (const f32x4*)(ssq + (size_t)row * 16);
    const f32x4 a4 = sp[0] + sp[1] + sp[2] + sp[3];
    rv[row] = rsqrtf((a4[0] + a4[1] + a4[2] + a4[3]) * (1.0f / 1024.0f) + 1e-6f);
  }
}

__device__ void phase_final(const Params& p, int chunk) {
  float* x = p.out + (size_t)chunk * TC * DM;
  const float* ssq = p.ssq + (size_t)chunk * TC * 16;
  const int tid = opaque_tid(), lane = tid & 63, w = blockIdx.x * 8 + (tid >> 6), nw = gridDim.x * 8;
  for (int row = w; row < TC; row += nw) {
    const f32x4* sp = (const f32x4*)(ssq + (size_t)row * 16);
    const f32x4 a4 = sp[0] + sp[1] + sp[2] + sp[3];
    const float rinv = rsqrtf((a4[0] + a4[1] + a4[2] + a4[3]) * (1.0f / 1024.0f) + 1e-6f);
    float* xr = x + (size_t)row * DM + lane * 16;
#pragma unroll
    for (int i = 0; i < 4; ++i) { f32x4 v = *(const f32x4*)(xr + i * 4); const f32x4 g = *(const f32x4*)(p.g_final + lane * 16 + i * 4); v = v * rinv * g; *(f32x4*)(xr + i * 4) = v; }
  }
}

__device__ __forceinline__ f32x16 mfma32(bf16x8 a, bf16x8 b, f32x16 c) { return __builtin_amdgcn_mfma_f32_32x32x16_bf16(a, b, c, 0, 0, 0); }
__device__ __forceinline__ bf16x8 ld16(const bf16_t* p) { return *(const bf16x8*)p; }
__device__ __forceinline__ bf16x8 ld8x2(const bf16_t* p0, const bf16_t* p1) { const bf16x4 a = *(const bf16x4*)p0, b = *(const bf16x4*)p1; return __builtin_shufflevector(a, b, 0, 1, 2, 3, 4, 5, 6, 7); }

__device__ __forceinline__ void softmax_tile(f32x16& t, float& m, float& l, float& alpha, bf16x8& p0, bf16x8& p1) {
  float tm = t[0];
#pragma unroll
  for (int i = 1; i < 16; ++i) tm = fmaxf(tm, t[i]);
  tm = fmaxf(tm, __shfl_xor(tm, 32));
  const float mn = fmaxf(m, tm);
  alpha = fexp2(m - mn); m = mn;
  float ls = 0.f;
#pragma unroll
  for (int i = 0; i < 16; ++i) { t[i] = fexp2(t[i] - mn); ls += t[i]; }
  l = l * alpha + ls;
  const u32x4 a = {cvt_pk_bf16(t[0], t[1]), cvt_pk_bf16(t[2], t[3]), cvt_pk_bf16(t[4], t[5]), cvt_pk_bf16(t[6], t[7])};
  const u32x4 b = {cvt_pk_bf16(t[8], t[9]), cvt_pk_bf16(t[10], t[11]), cvt_pk_bf16(t[12], t[13]), cvt_pk_bf16(t[14], t[15])};
  p0 = __builtin_bit_cast(bf16x8, a); p1 = __builtin_bit_cast(bf16x8, b);
}
__device__ __forceinline__ f32x16 zero16() { f32x16 z;
#pragma unroll
  for (int i = 0; i < 16; ++i) z[i] = 0.f; return z; }
__device__ __forceinline__ float silu(float z) { return z * frcp(1.0f + fexp2(-z * LOG2E)); }

constexpr int TB_ROW = 144;
constexpr int KB_BYTES = 64 * TB_ROW;
constexpr int VB_BYTES = 128 * TB_ROW;
constexpr int LDS_K = 0, LDS_V = LDS_K + 2 * KB_BYTES, LDS_ATT_END = LDS_V + 2 * VB_BYTES, LDS_ATT_TOTAL = LDS_ATT_END + 65536;
template <int SIDE>
__device__ __forceinline__ void b_far_subtile(const LAS unsigned char* kb, const LAS unsigned char* vb, int rd, int sub, const bf16x8 (&qf)[4], const f32x16& bp, float slope2, float d0,
                                              float& mrun, float& lrun, f32x16 (&o)[4]) {
  const float base = (SIDE > 0 ? -slope2 : slope2) * d0 - mrun;
  f32x16 sc;
#pragma unroll
  for (int i = 0; i < 16; ++i) sc[i] = SIDE > 0 ? base - bp[i] : base + bp[i];
#pragma unroll
  for (int ks = 0; ks < 4; ++ks) sc = mfma32(*(const LAS bf16x8*)(kb + rd + sub * 32 * TB_ROW + ks * 32), qf[ks], sc);
  float tm = sc[0];
#pragma unroll
  for (int i = 1; i < 16; ++i) tm = fmaxf(tm, sc[i]);
  tm = fmaxf(tm, __shfl_xor(tm, 32));
  if (__builtin_amdgcn_ballot_w64(tm > 0.0f) != 0) {
    const float delta = fmaxf(tm, 0.0f);
    const float al = fexp2(-delta);
    mrun += delta; lrun *= al;
#pragma unroll
    for (int i = 0; i < 16; ++i) sc[i] -= delta;
#pragma unroll
    for (int dt = 0; dt < 4; ++dt) o[dt] *= al;
  }
#pragma unroll
  for (int i = 0; i < 16; ++i) sc[i] = fexp2(sc[i]);
  { const f32x4 a4 = (f32x4){sc[0], sc[1], sc[2], sc[3]} + (f32x4){sc[4], sc[5], sc[6], sc[7]} + (f32x4){sc[8], sc[9], sc[10], sc[11]} + (f32x4){sc[12], sc[13], sc[14], sc[15]};
    lrun += (a4[0] + a4[1]) + (a4[2] + a4[3]); }
  const u32x4 pa = {cvt_pk_bf16(sc[0], sc[1]), cvt_pk_bf16(sc[2], sc[3]), cvt_pk_bf16(sc[4], sc[5]), cvt_pk_bf16(sc[6], sc[7])};
  const u32x4 pb = {cvt_pk_bf16(sc[8], sc[9]), cvt_pk_bf16(sc[10], sc[11]), cvt_pk_bf16(sc[12], sc[13]), cvt_pk_bf16(sc[14], sc[15])};
  const bf16x8 pk0 = __builtin_bit_cast(bf16x8, pa), pk1 = __builtin_bit_cast(bf16x8, pb);
#pragma unroll
  for (int dt = 0; dt < 4; ++dt) {
    o[dt] = mfma32(*(const LAS bf16x8*)(vb + rd + dt * 32 * TB_ROW + (sub * 2) * 32), pk0, o[dt]);
    o[dt] = mfma32(*(const LAS bf16x8*)(vb + rd + dt * 32 * TB_ROW + (sub * 2 + 1) * 32), pk1, o[dt]);
  }
}

__device__ __forceinline__ void attn_b_pass(const Params& p, int L, int seq, int h, int mp, int qblk, int tq, int tid, float slope2, LAS unsigned char* lds, f32x16 (&o)[4], float& linv) {
  const int lane = tid & 63, q = lane & 31, half = lane >> 5;
  const size_t tokbase = (size_t)seq * L;
  bf16x8 qf[4];
  { const bf16_t* qp = p.u + (tokbase + tq) * UW + U_QB + h * 128 + mp * 64 + half * 8;
#pragma unroll
    for (int ks = 0; ks < 4; ++ks) qf[ks] = ld16(qp + ks * 16); }
  const int spart = tid & 7, srow = tid >> 3;
  const bf16_t* kg = p.u + (tokbase + srow) * UW + U_KB + h * 128 + mp * 64 + spart * 8;
  const bf16_t* vg = p.vt + ((size_t)seq * VW + V_B + h * 128 + srow) * L + spart * 8;
  const int kst = srow * TB_ROW + spart * 16;
  const int vst = srow * TB_ROW + ((spart >> 1) * 16 + (spart & 1) * 4) * 2;
  const int rd = q * TB_ROW + half * 16;
#pragma unroll
  for (int dt = 0; dt < 4; ++dt) o[dt] = zero16();
  float mrun = -1e30f, lrun = 0.f;
  f32x16 bp;
#pragma unroll
  for (int i = 0; i < 16; ++i) bp[i] = slope2 * (float)((i >> 2) * 8 + (i & 3));
  const int ntile = L >> 6, t0 = qblk * 4, nR = ntile - t0;
  auto tile_of = [&](int idx) { return idx < nR ? t0 + idx : (t0 - 1) - (idx - nR); };
  bf16x8 krA, vrA0, vrA1, krB, vrB0, vrB1;
  auto gload = [&](int idx, bf16x8& kr, bf16x8& v0, bf16x8& v1) { const int kn = tile_of(idx) * 64; kr = ld16(kg + (size_t)kn * UW); v0 = ld16(vg + kn); v1 = ld16(vg + (size_t)64 * L + kn); };
  auto lwrite = [&](int buf, const bf16x8& kr, const bf16x8& v0, const bf16x8& v1) {
    LAS unsigned char* kb = lds + LDS_K + buf * KB_BYTES; LAS unsigned char* vb = lds + LDS_V + buf * VB_BYTES;
    *(LAS bf16x8*)(kb + kst) = kr;
    *(LAS bf16x4*)(vb + vst) = __builtin_shufflevector(v0, v0, 0, 1, 2, 3); *(LAS bf16x4*)(vb + vst + 16) = __builtin_shufflevector(v0, v0, 4, 5, 6, 7);
    *(LAS bf16x4*)(vb + vst + 64 * TB_ROW) = __builtin_shufflevector(v1, v1, 0, 1, 2, 3); *(LAS bf16x4*)(vb + vst + 64 * TB_ROW + 16) = __builtin_shufflevector(v1, v1, 4, 5, 6, 7);
  };
  auto compute = [&](int idx, int buf) {
    const int k0 = tile_of(idx) * 64;
    const LAS unsigned char* kb = lds + LDS_K + buf * KB_BYTES;
    const LAS unsigned char* vb = lds + LDS_V + buf * VB_BYTES;
    if (idx < 4) {
#pragma unroll
      for (int sub = 0; sub < 2; ++sub) {
        f32x16 sc = zero16();
#pragma unroll
        for (int ks = 0; ks < 4; ++ks) sc = mfma32(*(const LAS bf16x8*)(kb + rd + sub * 32 * TB_ROW + ks * 32), qf[ks], sc);
        const float d0 = (float)(k0 + sub * 32 + half * 4 - tq);
#pragma unroll
        for (int i = 0; i < 16; ++i) sc[i] -= slope2 * fabsf(d0 + (float)((i >> 2) * 8 + (i & 3)));
        float al; bf16x8 pk[2];
        softmax_tile(sc, mrun, lrun, al, pk[0], pk[1]);
        if (__builtin_amdgcn_ballot_w64(al != 1.0f) != 0) {
#pragma unroll
          for (int dt = 0; dt < 4; ++dt) o[dt] *= al;
        }
#pragma unroll
        for (int dt = 0; dt < 4; ++dt)
#pragma unroll
          for (int s2 = 0; s2 < 2; ++s2) o[dt] = mfma32(*(const LAS bf16x8*)(vb + rd + dt * 32 * TB_ROW + (sub * 2 + s2) * 32), pk[s2], o[dt]);
      }
    } else if (idx < nR) {
#pragma unroll
      for (int sub = 0; sub < 2; ++sub) b_far_subtile<1>(kb, vb, rd, sub, qf, bp, slope2, (float)(k0 + sub * 32 + half * 4 - tq), mrun, lrun, o);
    } else {
#pragma unroll
      for (int sub = 0; sub < 2; ++sub) b_far_subtile<-1>(kb, vb, rd, sub, qf, bp, slope2, (float)(k0 + sub * 32 + half * 4 - tq), mrun, lrun, o);
    }
  };
  gload(0, krA, vrA0, vrA1);
  gload(1, krB, vrB0, vrB1);
  lwrite(0, krA, vrA0, vrA1);
  asm volatile("" : "+v"(qf[0]), "+v"(qf[1]), "+v"(qf[2]), "+v"(qf[3]));
  asm volatile("" : "+v"(krB), "+v"(vrB0), "+v"(vrB1));
  __syncthreads();
#pragma unroll 1
  for (int idx = 0; idx < ntile; idx += 2) {
    if (idx + 2 < ntile) gload(idx + 2, krA, vrA0, vrA1);
    compute(idx, 0);
    lwrite(1, krB, vrB0, vrB1);
    __syncthreads();
    if (idx + 3 < ntile) gload(idx + 3, krB, vrB0, vrB1);
    compute(idx + 1, 1);
    if (idx + 2 < ntile) lwrite(0, krA, vrA0, vrA1);
    __syncthreads();
  }
  linv = frcp(lrun + __shfl_xor(lrun, 32));
}
__device__ void attn_b_block(const Params& p, int layer, int L, int seq, int h, int qblk, LAS unsigned char* lds) {
  const int tid = opaque_tid(), lane = tid & 63, wid = __builtin_amdgcn_readfirstlane(tid >> 6);
  const int q = lane & 31, half = lane >> 5;
  const size_t tokbase = (size_t)seq * L;
  const int tq = qblk * 256 + wid * 32 + q;
  const float slope2 = exp2f(-2.0f * (float)(h + 1)) * LOG2E;
  f32x16 o0[4]; float li0, li1;
  LAS u32x4* park = (LAS u32x4*)(lds + LDS_ATT_END) + wid * 512 + lane;
  attn_b_pass(p, L, seq, h, 0, qblk, tq, tid, slope2, lds, o0, li0);
#pragma unroll
  for (int dt = 0; dt < 4; ++dt)
#pragma unroll
    for (int g2 = 0; g2 < 2; ++g2) {
      u32x4 pk;
#pragma unroll
      for (int k = 0; k < 4; ++k) pk[k] = cvt_pk_bf16(o0[dt][g2 * 8 + 2 * k] * li0, o0[dt][g2 * 8 + 2 * k + 1] * li0);
      park[(dt * 2 + g2) * 64] = pk;
    }
  attn_b_pass(p, L, seq, h, 1, qblk, tq, tid, slope2, lds, o0, li1);
  const float c1 = p.lam[layer] * li1;
  const int tid2 = opaque_tid(), half2 = (tid2 >> 5) & 1;
  const size_t tok2 = (size_t)seq * L + qblk * 256 + (tid2 >> 6) * 32 + (tid2 & 31);
  float ss = 0.f;
#pragma unroll
  for (int dt = 0; dt < 4; ++dt)
#pragma unroll
    for (int g2 = 0; g2 < 2; ++g2) {
      const u32x4 pk = park[(dt * 2 + g2) * 64];
#pragma unroll
      for (int k = 0; k < 4; ++k) {
        const float va = bf_lo(pk[k]) - o0[dt][g2 * 8 + 2 * k] * c1, vb = bf_hi(pk[k]) - o0[dt][g2 * 8 + 2 * k + 1] * c1;
        o0[dt][g2 * 8 + 2 * k] = va; o0[dt][g2 * 8 + 2 * k + 1] = vb; ss += va * va + vb * vb;
      }
    }
  ss += __shfl_xor(ss, 32);
  const float rn = rsqrtf(ss * (1.0f / 128.0f) + 1e-6f) * p.lam[4 + layer];
  const float* gd = p.g_diff + layer * 128;
  bf16_t* yrow = p.yg + tok2 * YW + 512 + h * 128;
  const bf16_t* zrow = p.u + tok2 * UW + U_ZB + h * 128;
#pragma unroll
  for (int dt = 0; dt < 4; ++dt)
#pragma unroll
    for (int g4 = 0; g4 < 4; ++g4) {
      const int dim = dt * 32 + g4 * 8 + half2 * 4;
      const u32x2 zr = *(const u32x2*)(zrow + dim);
      const f32x4 gv = *(const f32x4*)(gd + dim);
      const float y0 = o0[dt][g4 * 4 + 0] * rn * gv[0] * silu(bf_lo(zr[0]));
      const float y1 = o0[dt][g4 * 4 + 1] * rn * gv[1] * silu(bf_hi(zr[0]));
      const float y2 = o0[dt][g4 * 4 + 2] * rn * gv[2] * silu(bf_lo(zr[1]));
      const float y3 = o0[dt][g4 * 4 + 3] * rn * gv[3] * silu(bf_hi(zr[1]));
      u32x2 pk = {cvt_pk_bf16(y0, y1), cvt_pk_bf16(y2, y3)};
      *(u32x2*)(yrow + dim) = pk;
    }
}

constexpr int LDS_AK = 0, LDS_AV = LDS_AK + 2 * KB_BYTES, LDS_ATAB = LDS_AV + 2 * KB_BYTES, ATAB_ROW = 128;
__device__ void attn_a_block(const Params& p, int layer, int L, int seq, int h, int r0, LAS unsigned char* lds) {
  const int tid = opaque_tid(), lane = tid & 63, wid = __builtin_amdgcn_readfirstlane(tid >> 6);
  const int q = lane & 31, half = lane >> 5;
  const size_t tokbase = (size_t)seq * L;
  const int rows = L >> 6;
  const int r = r0 + (wid >> 1), cb2 = wid & 1;
  int rs = r - 4; rs = rs < 0 ? 0 : (rs > rows - 8 ? rows - 8 : rs);
  int kr_lo = r0 - 4; kr_lo = kr_lo < 0 ? 0 : (kr_lo > rows - 8 ? rows - 8 : kr_lo);
  int kr_hi = r0 - 1; kr_hi = (kr_hi < 0 ? 0 : (kr_hi > rows - 8 ? rows - 8 : kr_hi)) + 7;
  const int qcol = cb2 * 32 + q, tq = r * 64 + qcol;
  int qstart = qcol - 8; qstart = qstart < 0 ? 0 : (qstart > 48 ? 48 : qstart);
  bf16x8 qf[4];
  { const bf16_t* qp = p.u + (tokbase + tq) * UW + U_QA + h * 64 + half * 8;
#pragma unroll
    for (int ks = 0; ks < 4; ++ks) qf[ks] = ld16(qp + ks * 16); }
  {
    LAS float* tab = (LAS float*)(lds + LDS_ATAB);
    const float* rpb = p.rpb + ((size_t)layer * 8 + h) * 15 * 31;
    for (int idx = tid; idx < 15 * ATAB_ROW; idx += 512) { const int row = idx >> 7, cc = (idx & 127) - 48; tab[idx] = (cc >= 0 && cc <= 30) ? rpb[row * 31 + cc] * LOG2E : 0.f; }
  }
  const int spart = tid & 7, srow = tid >> 3;
  const bf16_t* kg = p.u + (tokbase + srow) * UW + U_KA + h * 64 + spart * 8;
  const bf16_t* vg = p.vt + ((size_t)seq * VW + V_A + h * 64 + srow) * L + spart * 8;
  const int kst = srow * TB_ROW + spart * 16;
  const int vst = srow * TB_ROW + ((spart >> 1) * 16 + (spart & 1) * 4) * 2;
  const int rd = q * TB_ROW + half * 16;
  f32x16 o[2] = {zero16(), zero16()};
  float mrun = -1e30f, lrun = 0.f;
  bf16x8 kr_, vr_;
  kr_ = ld16(kg + (size_t)(kr_lo * 64) * UW); vr_ = ld16(vg + kr_lo * 64);
  *(LAS bf16x8*)(lds + LDS_AK + kst) = kr_;
  *(LAS bf16x4*)(lds + LDS_AV + vst) = __builtin_shufflevector(vr_, vr_, 0, 1, 2, 3); *(LAS bf16x4*)(lds + LDS_AV + vst + 16) = __builtin_shufflevector(vr_, vr_, 4, 5, 6, 7);
  asm volatile("" : "+v"(qf[0]), "+v"(qf[1]), "+v"(qf[2]), "+v"(qf[3]));
  __syncthreads();
#pragma unroll 1
  for (int kr = kr_lo; kr <= kr_hi; ++kr) {
    const int it = kr - kr_lo;
    const bool more = (kr < kr_hi);
    if (more) { kr_ = ld16(kg + (size_t)((kr + 1) * 64) * UW); vr_ = ld16(vg + (kr + 1) * 64); }
    const LAS unsigned char* kb = lds + LDS_AK + (it & 1) * KB_BYTES;
    const LAS unsigned char* vb = lds + LDS_AV + (it & 1) * KB_BYTES;
    if (kr >= rs && kr < rs + 8) {
      const LAS float* trow = (const LAS float*)(lds + LDS_ATAB) + (kr - r + 7) * ATAB_ROW + (half * 4 - qcol + 15 + 48);
#pragma unroll
      for (int seg = 0; seg < 2; ++seg) {
        f32x16 sc = zero16();
#pragma unroll
        for (int ks = 0; ks < 4; ++ks) sc = mfma32(*(const LAS bf16x8*)(kb + rd + seg * 32 * TB_ROW + ks * 32), qf[ks], sc);
#pragma unroll
        for (int ii = 0; ii < 16; ++ii) {
          const int kcol = seg * 32 + (ii >> 2) * 8 + half * 4 + (ii & 3);
          const bool ok = (kcol >= qstart) && (kcol < qstart + 16);
          sc[ii] = ok ? sc[ii] + trow[seg * 32 + (ii >> 2) * 8 + (ii & 3)] : -INFINITY;
        }
        float al; bf16x8 pk[2];
        softmax_tile(sc, mrun, lrun, al, pk[0], pk[1]);
        if (__builtin_amdgcn_ballot_w64(al != 1.0f) != 0) { o[0] *= al; o[1] *= al; }
#pragma unroll
        for (int dt = 0; dt < 2; ++dt)
#pragma unroll
          for (int s2 = 0; s2 < 2; ++s2) o[dt] = mfma32(*(const LAS bf16x8*)(vb + rd + dt * 32 * TB_ROW + (seg * 2 + s2) * 32), pk[s2], o[dt]);
      }
    }
    if (more) {
      LAS unsigned char* kbn = lds + LDS_AK + ((it + 1) & 1) * KB_BYTES; LAS unsigned char* vbn = lds + LDS_AV + ((it + 1) & 1) * KB_BYTES;
      *(LAS bf16x8*)(kbn + kst) = kr_;
      *(LAS bf16x4*)(vbn + vst) = __builtin_shufflevector(vr_, vr_, 0, 1, 2, 3); *(LAS bf16x4*)(vbn + vst + 16) = __builtin_shufflevector(vr_, vr_, 4, 5, 6, 7);
    }
    __syncthreads();
  }
  const float c = frcp(lrun + __shfl_xor(lrun, 32));
  bf16_t* yrow = p.yg + (tokbase + tq) * YW + h * 64;
  const bf16_t* zrow = p.u + (tokbase + tq) * UW + U_ZA + h * 64;
#pragma unroll
  for (int dt = 0; dt < 2; ++dt)
#pragma unroll
    for (int g4 = 0; g4 < 4; ++g4) {
      const int dim = dt * 32 + g4 * 8 + half * 4;
      const u32x2 zr = *(const u32x2*)(zrow + dim);
      const float y0 = o[dt][g4 * 4 + 0] * c * silu(bf_lo(zr[0]));
      const float y1 = o[dt][g4 * 4 + 1] * c * silu(bf_hi(zr[0]));
      const float y2 = o[dt][g4 * 4 + 2] * c * silu(bf_lo(zr[1]));
      const float y3 = o[dt][g4 * 4 + 3] * c * silu(bf_hi(zr[1]));
      u32x2 pk = {cvt_pk_bf16(y0, y1), cvt_pk_bf16(y2, y3)};
      *(u32x2*)(yrow + dim) = pk;
    }
}

__device__ void attn_c_unit(const Params& p, int L, int lshift, int seq, int g, int h, int rr, int mblk, int lane) {
  const int q = lane & 31, half = lane >> 5;
  const size_t tokbase = (size_t)seq * L;
  const int ds = (g == 0) ? 0 : (g == 1 ? 2 : 4), d = 1 << ds, M = L >> ds;
  const int hh = g * 4 + h;
  const int m0 = mblk * 32, mq = m0 + q, tq = mq * d + rr;
  const bf16_t* urow = p.u + (tokbase + tq) * UW;
  bf16x8 qf[4];
#pragma unroll
  for (int ks = 0; ks < 4; ++ks) qf[ks] = ld16(urow + U_QC + hh * 64 + ks * 16 + half * 8);
  f32x16 o[2] = {zero16(), zero16()};
  float mrun = -1e30f, lrun = 0.f;
  const float coef = exp2f(-(2.0f / 3.0f) * (float)(hh + 1)) * (float)d * LOG2E;
  const bf16_t* vbase = p.vt + ((size_t)seq * VW + V_C + hh * 64 + q) * L + (size_t)rr * M;
  bf16x8 kf[5][4];
#pragma unroll
  for (int j = 0; j < 5; ++j) {
    int mkl = m0 - 64 + 32 * j + q; mkl = mkl < 0 ? 0 : (mkl > M - 1 ? M - 1 : mkl);
    const bf16_t* kp = p.u + (tokbase + (size_t)mkl * d + rr) * UW + U_KC + hh * 64 + half * 8;
#pragma unroll
    for (int ks = 0; ks < 4; ++ks) kf[j][ks] = ld16(kp + ks * 16);
  }
  bf16x8 vf[2][2][2];
  auto load_v = [&](int j, bf16x8 (&dst)[2][2]) {
#pragma unroll
    for (int dt = 0; dt < 2; ++dt)
#pragma unroll
      for (int s2 = 0; s2 < 2; ++s2) {
        int pa = m0 - 64 + 32 * j + s2 * 16 + half * 4, pb = pa + 8;
        pa = pa < 0 ? 0 : (pa > M - 4 ? M - 4 : pa); pb = pb < 0 ? 0 : (pb > M - 4 ? M - 4 : pb);
        const bf16_t* vp = vbase + (size_t)(dt * 32) * L;
        dst[dt][s2] = ld8x2(vp + pa, vp + pb);
      }
  };
  load_v(0, vf[0]);
#pragma unroll
  for (int j = 0; j < 5; ++j) {
    if (j + 1 < 5) load_v(j + 1, vf[(j + 1) & 1]);
    const int mk0 = m0 - 64 + 32 * j;
    if (mk0 + 32 <= 0 || mk0 >= M) continue;
    f32x16 s = zero16();
#pragma unroll
    for (int ks = 0; ks < 4; ++ks) s = mfma32(kf[j][ks], qf[ks], s);
#pragma unroll
    for (int ii = 0; ii < 16; ++ii) {
      const int mk = mk0 + (ii >> 2) * 8 + half * 4 + (ii & 3);
      const int rel = mk - mq; const int ar = rel < 0 ? -rel : rel;
      const bool ok = (mk >= 0) && (mk < M) && (ar <= 64);
      s[ii] = ok ? s[ii] - coef * (float)ar : -INFINITY;
    }
    float alpha; bf16x8 pk[2];
    softmax_tile(s, mrun, lrun, alpha, pk[0], pk[1]);
#pragma unroll
    for (int dt = 0; dt < 2; ++dt) {
      o[dt] *= alpha;
#pragma unroll
      for (int s2 = 0; s2 < 2; ++s2) o[dt] = mfma32(vf[j & 1][dt][s2], pk[s2], o[dt]);
    }
  }
  const float lt = lrun + __shfl_xor(lrun, 32);
  const float c = frcp(lt);
  bf16_t* orow = p.oc + (tokbase + tq) * 768 + hh * 64;
#pragma unroll
  for (int dt = 0; dt < 2; ++dt)
#pragma unroll
    for (int g4 = 0; g4 < 4; ++g4) {
      const int dim = dt * 32 + g4 * 8 + half * 4;
      u32x2 pk = {cvt_pk_bf16(o[dt][g4 * 4 + 0] * c, o[dt][g4 * 4 + 1] * c), cvt_pk_bf16(o[dt][g4 * 4 + 2] * c, o[dt][g4 * 4 + 3] * c)};
      *(u32x2*)(orow + dim) = pk;
    }
  if (half == 0) p.lse[(tokbase + tq) * 12 + hh] = mrun + log2f(lt);
}

constexpr int CV_ROW = 784;
constexpr int LDS_CK = 0, LDS_CV = 384 * TB_ROW;
__device__ void attn_c_block(const Params& p, int L, int lshift, int seq, int g, int h, int pblk, LAS unsigned char* lds) {
  const int tid = opaque_tid(), lane = tid & 63, wid = __builtin_amdgcn_readfirstlane(tid >> 6);
  const int q = lane & 31, half = lane >> 5;
  const size_t tokbase = (size_t)seq * L;
  const int ds = (g == 0) ? 0 : (g == 1 ? 2 : 4), d = 1 << ds, M = L >> ds;
  const int hh = g * 4 + h;
  const int p0 = pblk * 256;
  {
    const int part = tid & 7;
#pragma unroll
    for (int c = 0; c < 6; ++c) {
      const int row = (tid >> 3) + c * 64;
      int pp = p0 - 64 + row; pp = pp < 0 ? 0 : (pp > L - 1 ? L - 1 : pp);
      const int tok = ((pp & (M - 1)) << ds) + (pp >> (lshift - ds));
      const bf16x8 v = ld16(p.u + (tokbase + tok) * UW + U_KC + hh * 64 + part * 8);
      *(LAS bf16x8*)(lds + LDS_CK + row * TB_ROW + part * 16) = v;
    }
#pragma unroll
    for (int c = 0; c < 6; ++c) {
      const int idx = tid + c * 512, dim = idx / 48, c8 = idx % 48;
      int pp = p0 - 64 + c8 * 8; pp = pp < 0 ? 0 : (pp > L - 8 ? L - 8 : pp);
      const bf16x8 v = ld16(p.vt + ((size_t)seq * VW + V_C + hh * 64 + dim) * L + pp);
      LAS unsigned char* dst = lds + LDS_CV + dim * CV_ROW + ((c8 >> 1) * 16 + (c8 & 1) * 4) * 2;
      *(LAS bf16x4*)dst = __builtin_shufflevector(v, v, 0, 1, 2, 3); *(LAS bf16x4*)(dst + 16) = __builtin_shufflevector(v, v, 4, 5, 6, 7);
    }
  }
  const int pw = p0 + wid * 32;
  const int rr = pw >> (lshift - ds), m0 = pw & (M - 1), mq = m0 + q, tq = mq * d + rr;
  bf16x8 qf[4];
  { const bf16_t* qp = p.u + (tokbase + tq) * UW + U_QC + hh * 64 + half * 8;
#pragma unroll
    for (int ks = 0; ks < 4; ++ks) qf[ks] = ld16(qp + ks * 16); }
  f32x16 o[2] = {zero16(), zero16()};
  float mrun = -1e30f, lrun = 0.f;
  const float coef = exp2f(-(2.0f / 3.0f) * (float)(hh + 1)) * (float)d * LOG2E;
  __syncthreads();
#pragma unroll
  for (int j = 0; j < 5; ++j) {
    const int mk0 = m0 - 64 + 32 * j;
    if (mk0 + 32 <= 0 || mk0 >= M) continue;
    const LAS unsigned char* kb = lds + LDS_CK + ((wid + j) * 32 + q) * TB_ROW + half * 16;
    f32x16 sc = zero16();
#pragma unroll
    for (int ks = 0; ks < 4; ++ks) sc = mfma32(*(const LAS bf16x8*)(kb + ks * 32), qf[ks], sc);
#pragma unroll
    for (int ii = 0; ii < 16; ++ii) {
      const int mk = mk0 + (ii >> 2) * 8 + half * 4 + (ii & 3);
      const int rel = mk - mq; const int ar = rel < 0 ? -rel : rel;
      const bool ok = (mk >= 0) && (mk < M) && (ar <= 64);
      sc[ii] = ok ? sc[ii] - coef * (float)ar : -INFINITY;
    }
    float alpha; bf16x8 pk[2];
    softmax_tile(sc, mrun, lrun, alpha, pk[0], pk[1]);
#pragma unroll
    for (int dt = 0; dt < 2; ++dt) {
      o[dt] *= alpha;
#pragma unroll
      for (int s2 = 0; s2 < 2; ++s2)
        o[dt] = mfma32(*(const LAS bf16x8*)(lds + LDS_CV + (dt * 32 + q) * CV_ROW + ((wid + j) * 32 + s2 * 16) * 2 + half * 16), pk[s2], o[dt]);
    }
  }
  __syncthreads();
  const float lt = lrun + __shfl_xor(lrun, 32);
  const float c = frcp(lt);
  bf16_t* orow = p.oc + (tokbase + tq) * 768 + hh * 64;
#pragma unroll
  for (int dt = 0; dt < 2; ++dt)
#pragma unroll
    for (int g4 = 0; g4 < 4; ++g4) {
      const int dim = dt * 32 + g4 * 8 + half * 4;
      u32x2 pk = {cvt_pk_bf16(o[dt][g4 * 4 + 0] * c, o[dt][g4 * 4 + 1] * c), cvt_pk_bf16(o[dt][g4 * 4 + 2] * c, o[dt][g4 * 4 + 3] * c)};
      *(u32x2*)(orow + dim) = pk;
    }
  if (half == 0) p.lse[(tokbase + tq) * 12 + hh] = mrun + log2f(lt);
}

__device__ void phase_attn(const Params& p, int layer, int L, int lshift, LAS unsigned char* lds) {
  const int tiles = L >> 5;
  const int nseq = TC >> lshift;
  const int nw = gridDim.x * 8;
  int w, lane;
  { const int qblks = L >> 8, npairs = nseq * 4, nunits = npairs * qblks;
    for (int b = blockIdx.x; b < nunits; b += gridDim.x) {
      int pair, qblk;
      if ((gridDim.x & 7) == 0 && (npairs & 7) == 0 && nunits == (int)gridDim.x) { const int xcd = b & 7, j = b >> 3; pair = xcd * (npairs >> 3) + j / qblks; qblk = j % qblks; }
      else { pair = b / qblks; qblk = b % qblks; }
      attn_b_block(p, layer, L, pair >> 2, pair & 3, qblk, lds);
    }
  }
  { const int tid = opaque_tid(); lane = tid & 63; w = blockIdx.x * 8 + __builtin_amdgcn_readfirstlane(tid >> 6); }
  {
  { const int rgs = L >> 8, nunits = nseq * 8 * rgs;
    for (int b = blockIdx.x; b < nunits; b += gridDim.x) { const int sh = b / rgs, rg = b % rgs; attn_a_block(p, layer, L, sh >> 3, sh & 7, rg * 4, lds); }
  }
  { const int tid = opaque_tid(); lane = tid & 63; w = blockIdx.x * 8 + __builtin_amdgcn_readfirstlane(tid >> 6); }
  { const int pbs = L >> 8, nunits = nseq * 12 * pbs;
    for (int b = blockIdx.x; b < nunits; b += gridDim.x) {
      const int pblk = b % pbs, sgh = b / pbs;
      const int seq = sgh / 12, gh = sgh % 12;
      attn_c_block(p, L, lshift, seq, gh >> 2, gh & 3, pblk, lds);
    }
  }
  }
}

__device__ void phase_combine(const Params& p) {
  const int gt = blockIdx.x * 512 + opaque_tid(), ngt = gridDim.x * 512;
  for (int it = gt; it < TC * 32; it += ngt) {
    const int tok = it >> 5, sub = it & 31, h = sub >> 3, d8 = (sub & 7) * 8;
    const float* ls = p.lse + (size_t)tok * 12;
    const float l0 = ls[h], l1 = ls[4 + h], l2 = ls[8 + h];
    const float mx = fmaxf(l0, fmaxf(l1, l2));
    const float w0 = fexp2(l0 - mx), w1 = fexp2(l1 - mx), w2 = fexp2(l2 - mx);
    const float inv = frcp(w0 + w1 + w2);
    const bf16_t* ob = p.oc + (size_t)tok * 768 + h * 64 + d8;
    const u32x4 a = *(const u32x4*)ob, b = *(const u32x4*)(ob + 256), c = *(const u32x4*)(ob + 512);
    const u32x4 z = *(const u32x4*)(p.u + (size_t)tok * UW + U_ZC + h * 64 + d8);
    u32x4 r;
#pragma unroll
    for (int k = 0; k < 4; ++k) {
      const float vlo = (w0 * bf_lo(a[k]) + w1 * bf_lo(b[k]) + w2 * bf_lo(c[k])) * inv * silu(bf_lo(z[k]));
      const float vhi = (w0 * bf_hi(a[k]) + w1 * bf_hi(b[k]) + w2 * bf_hi(c[k])) * inv * silu(bf_hi(z[k]));
      r[k] = cvt_pk_bf16(vlo, vhi);
    }
    *(u32x4*)(p.yg + (size_t)tok * YW + 1024 + h * 64 + d8) = r;
  }
}


#define XB_TMO      128
#define XB_XCNT(j)  (256  + 64 * (j))
#define XB_XSUB(j)  (1280 + 64 * (j))
#define XB_XGEN(j)  (2304 + 64 * (j))
#define XB_TOP      3328
#define XB_TOPGEN   3392
#define XCD_BAR_WORDS 3456
#define XB_SPIN_CAP (1u << 18)
__device__ __forceinline__ unsigned xb_ld(unsigned* p)              { return __hip_atomic_load(p, __ATOMIC_RELAXED, __HIP_MEMORY_SCOPE_AGENT); }
__device__ __forceinline__ unsigned xb_add(unsigned* p, unsigned v) { return __hip_atomic_fetch_add(p, v, __ATOMIC_RELAXED, __HIP_MEMORY_SCOPE_AGENT); }
__device__ __forceinline__ unsigned xb_xcc_id() { return (unsigned)__builtin_amdgcn_s_getreg((3 << 11) | 20) & 0xFu; }
#define XB_SPIN(cond, bar) do { unsigned _sp = 0; while (cond) { __builtin_amdgcn_s_sleep(1); \
    if ((++_sp & 255u) == 0u) { if (xb_ld(&(bar)[XB_TMO])) break; if (_sp > XB_SPIN_CAP) { atomicAdd(&(bar)[XB_TMO], 1u); break; } } } } while (0)
struct XcdBarrier { unsigned* bar; unsigned x; volatile LAS unsigned* st; };
__device__ __forceinline__ XcdBarrier xcd_barrier_post(unsigned* bar, volatile LAS unsigned* st) {
  XcdBarrier b; b.bar = bar; b.x = xb_xcc_id(); b.st = st;
  if (opaque_tid() == 0) (void)xb_add(&bar[XB_XCNT(b.x)], 1u);
  return b;
}
__device__ __forceinline__ void xcd_barrier_complete(unsigned* bar, unsigned x, unsigned& nloc, unsigned& nx) {
  const unsigned G = gridDim.x * gridDim.y * gridDim.z;
  unsigned sum, cnt, mine, sp = 0u;
  for (;;) {
    sum = 0u; cnt = 0u; mine = 0u;
#pragma unroll
    for (unsigned j = 0; j < 16; ++j) { const unsigned c = xb_ld(&bar[XB_XCNT(j)]); sum += c; cnt += (c > 0u) ? 1u : 0u; mine = (j == x) ? c : mine; }
    if (sum == G) break;
    __builtin_amdgcn_s_sleep(1);
    if ((++sp & 255u) == 0u) { if (xb_ld(&bar[XB_TMO])) break; if (sp > XB_SPIN_CAP) { atomicAdd(&bar[XB_TMO], 1u); break; } }
  }
  nloc = mine > 0u ? mine : 1u; nx = cnt > 0u ? cnt : 1u;
}
__device__ __forceinline__ void xcd_barrier(const XcdBarrier& b) {
  asm volatile("s_waitcnt vmcnt(0)" ::: "memory");
  __syncthreads();
  if (opaque_tid() == 0) {
    unsigned* bar = b.bar;
    __builtin_amdgcn_s_waitcnt(0);
    unsigned nloc = b.st[0], nx = b.st[1];
    if (nloc == 0u) { xcd_barrier_complete(bar, b.x, nloc, nx); b.st[0] = nloc; b.st[1] = nx; }
    const unsigned old = xb_add(&bar[XB_XSUB(b.x)], 1u);
    const unsigned gen = old / nloc;
    if (old + 1u == (gen + 1u) * nloc) {
      __builtin_amdgcn_fence(__ATOMIC_RELEASE, "agent");
      asm volatile("s_waitcnt vmcnt(0)" ::: "memory");
      const unsigned og = xb_add(&bar[XB_TOP], 1u);
      const unsigned tg = og / nx;
      if (og + 1u == (tg + 1u) * nx) xb_add(&bar[XB_TOPGEN], 1u);
      else XB_SPIN(xb_ld(&bar[XB_TOPGEN]) == tg, bar);
      __builtin_amdgcn_fence(__ATOMIC_ACQUIRE, "agent");
      xb_add(&bar[XB_XGEN(b.x)], 1u);
      asm volatile("s_waitcnt vmcnt(0)" ::: "memory");
    } else {
      XB_SPIN(xb_ld(&bar[XB_XGEN(b.x)]) == gen, bar);
      __builtin_amdgcn_fence(__ATOMIC_ACQUIRE, "agent");
      asm volatile("s_waitcnt vmcnt(0)" ::: "memory");
    }
  }
  __syncthreads();
}

__global__ void __launch_bounds__(512) fwd_megakernel(Params p) {
  __shared__ __attribute__((aligned(16))) unsigned char smem[LDS_ATT_TOTAL > pg8::STAGE_BYTES ? LDS_ATT_TOTAL : pg8::STAGE_BYTES];
  __shared__ __attribute__((aligned(16))) unsigned xb_words[4];
  cg::grid_group grid = cg::this_grid();
  if (threadIdx.x == 0) { xb_words[0] = 0u; xb_words[1] = 0u; xb_words[2] = 0u; xb_words[3] = 0u; }
  if ((threadIdx.x & 63) == 0) g_wid_table[hw_wave_slot()] = (int)(threadIdx.x >> 6);
  __syncthreads();
  const XcdBarrier xb = xcd_barrier_post(p.bar, (volatile LAS unsigned*)xb_words);
#define GSYNC() xcd_barrier(xb)
  LAS unsigned char* lds = (LAS unsigned char*)smem;
  phase_prep(p, (LAS float*)smem);
  phase_x(p, 0);
  grid.sync();
  for (int chunk = 0; chunk < NCHUNK; ++chunk) {
    const int L = chunk < 2 ? 2048 : 4096, lshift = chunk < 2 ? 11 : 12;
    const float* xin = (chunk < 2) ? p.xp + (size_t)chunk * TC * DM : p.xs + (size_t)(chunk - 2) * TC * DM;
    float* xres = p.out + (size_t)chunk * TC * DM;
    float* ssq = p.ssq + (size_t)chunk * TC * 16;
    for (int layer = 0; layer < DEPTH; ++layer) {
      {
        {
        { pg8::Gemm g{p.xb, p.wt_in + (size_t)layer * INW * DM, TC, UW, DM, 0, lshift};
          pg8::StaticOrder S; S.init(TC, UW, gridDim.x, blockIdx.x);
          EpiU E{p.u, p.rinv + (size_t)chunk * TC, p.b_gate + (size_t)layer * 3 * DM};
          pg8::gemm_phase(lds, g, S, E); }
        {
          pg8::Gemm g{p.wt_in + ((size_t)layer * INW + UW) * DM, p.xb, VW, TC, DM, 1, lshift};
          pg8::StaticOrder S; S.init(VW, TC, gridDim.x, (blockIdx.x + (gridDim.x >> 2)) % gridDim.x);
          EpiVT E{p.vt, p.rinv + (size_t)chunk * TC, L, lshift};
          pg8::gemm_phase(lds, g, S, E); }
        }
      }
      GSYNC();
      phase_attn(p, layer, L, lshift, lds);
      GSYNC();
      phase_combine(p);
      GSYNC();
      {
        pg8::Gemm g{p.yg, p.wt_br + (size_t)layer * DM * YW, TC, DM, YW, 0, 0};
        pg8::StaticOrder S; S.init(TC, DM, gridDim.x, blockIdx.x);
        EpiMerge E{p.u, p.merged};
        pg8::gemm_phase(lds, g, S, E);
      }
      GSYNC();
      {
        pg8::Gemm g{p.merged, p.wt_out + (size_t)layer * DM * DM, TC, DM, DM, 0, 0};
        pg8::StaticOrder S; S.init(TC, DM, gridDim.x, blockIdx.x);
        EpiRes E{layer == 0 ? xin : (const float*)xres, xres, p.xb, ssq};
        pg8::gemm_phase(lds, g, S, E);
      }
      GSYNC();
      if (layer + 1 < DEPTH) { phase_rinv(p, chunk); GSYNC(); }
    }
    phase_final(p, chunk);
    if (chunk + 1 < NCHUNK) { phase_x(p, chunk + 1); GSYNC(); }
  }
}

extern "C" void kernel_launch(void* const* d_in, const int* in_sizes, int n_in, void* d_out, int out_size, void* d_ws, size_t ws_size, hipStream_t stream) {
  (void)in_sizes; (void)n_in; (void)out_size;
  static int grid_blocks = 0;
  if (!grid_blocks) {
    int dev = 0, cus = 0, per_cu = 0;
    hipGetDevice(&dev);
    hipDeviceGetAttribute(&cus, hipDeviceAttributeMultiprocessorCount, dev);
    hipOccupancyMaxActiveBlocksPerMultiprocessor(&per_cu, fwd_megakernel, 512, 0);
    if (per_cu < 1) per_cu = 1;
    grid_blocks = cus * per_cu;
    if (grid_blocks > 256) grid_blocks = 256;
  }
  Params p{};
  p.xp = (const float*)d_in[0]; p.xs = (const float*)d_in[1]; p.g_norm = (const float*)d_in[2]; p.w_in = (const float*)d_in[3];
  p.b_gate = (const float*)d_in[4]; p.rpb = (const float*)d_in[5]; p.lam_qk = (const float*)d_in[6]; p.g_diff = (const float*)d_in[7];
  p.w_br_a = (const float*)d_in[8]; p.w_br_b = (const float*)d_in[9]; p.w_br_c = (const float*)d_in[10]; p.w_out = (const float*)d_in[11];
  p.g_final = (const float*)d_in[12];
  p.out = (float*)d_out;
  char* w = (char*)d_ws; size_t off = 0;
  auto take = [&](size_t bytes) { char* r = w + off; off += (bytes + 255) & ~(size_t)255; return r; };
  p.wt_in = (bf16_t*)take((size_t)DEPTH * INW * DM * 2);
  p.wt_br = (bf16_t*)take((size_t)DEPTH * DM * YW * 2);
  p.wt_out = (bf16_t*)take((size_t)DEPTH * DM * DM * 2);
  p.xb = (bf16_t*)take((size_t)TC * DM * 2);
  p.u = (bf16_t*)take((size_t)TC * UW * 2);
  p.vt = (bf16_t*)take((size_t)TC * VW * 2);
  p.yg = (bf16_t*)take((size_t)TC * YW * 2);
  p.oc = (bf16_t*)take((size_t)TC * 768 * 2);
  p.merged = (bf16_t*)take((size_t)TC * DM * 2);
  p.lse = (float*)take((size_t)TC * 12 * 4);
  p.ssq = (float*)take((size_t)NTOK * 16 * 4);
  p.lam = (float*)take(256);
  p.rinv = (float*)take((size_t)NTOK * 4);
  p.bar = (unsigned*)take((size_t)XCD_BAR_WORDS * 4);
  if (off > ws_size) fprintf(stderr, "workspace too small: need %zu have %zu\n", off, ws_size);
  hipMemsetAsync(p.bar, 0, (size_t)XCD_BAR_WORDS * 4, stream);
  void* args[] = {&p};
  hipError_t e = hipLaunchCooperativeKernel((void*)fwd_megakernel, dim3(grid_blocks), dim3(512), args, 0, stream);
  if (e != hipSuccess) fprintf(stderr, "cooperative launch failed: %s (grid %d)\n", hipGetErrorString(e), grid_blocks);
}
```

```cpp
#include <hip/hip_runtime.h>
#include <hip/hip_cooperative_groups.h>
#include <cstdio>
namespace cg = cooperative_groups;

#define LAS __attribute__((address_space(3)))
typedef unsigned short bf16_t;
typedef short bf16x8 __attribute__((ext_vector_type(8)));
typedef short bf16x4 __attribute__((ext_vector_type(4)));
typedef float f32x4 __attribute__((ext_vector_type(4)));
typedef float f32x16 __attribute__((ext_vector_type(16)));
typedef unsigned u32x4 __attribute__((ext_vector_type(4)));
typedef unsigned u32x2 __attribute__((ext_vector_type(2)));

constexpr int DM = 1024, DEPTH = 4, INW = 9728, UW = 7936, VW = 1792, YW = 1280;
constexpr int TC = 16384, NCHUNK = 4, NTOK = 65536;
constexpr float LOG2E = 1.4426950408889634f;
constexpr float QSCALE = 0.125f * LOG2E;
constexpr int U_QA = 0, U_KA = 512, U_ZA = 1024, U_QB = 1536, U_KB = 2048, U_ZB = 2560, U_QC = 3072, U_KC = 3840, U_ZC = 4608, U_GL = 4864;
constexpr int V_A = 0, V_B = 512, V_C = 1024;

struct Params {
  const float *xp, *xs, *g_norm, *w_in, *b_gate, *rpb, *lam_qk, *g_diff, *w_br_a, *w_br_b, *w_br_c, *w_out, *g_final;
  float* out;
  bf16_t *wt_in, *wt_br, *wt_out, *xb, *u, *vt, *yg, *oc, *merged;
  float *lse, *ssq, *lam, *rinv;
  unsigned* bar;
};

__device__ __forceinline__ unsigned cvt_pk_bf16(float lo, float hi) { unsigned r; asm volatile("v_cvt_pk_bf16_f32 %0, %1, %2" : "=v"(r) : "v"(lo), "v"(hi)); return r; }
__device__ __forceinline__ float bf_lo(unsigned v) { return __uint_as_float(v << 16); }
__device__ __forceinline__ float bf_hi(unsigned v) { return __uint_as_float(v & 0xffff0000u); }
__device__ __forceinline__ float fexp2(float x) { return __builtin_amdgcn_exp2f(x); }
__device__ __forceinline__ float frcp(float x) { return __builtin_amdgcn_rcpf(x); }

__shared__ int g_wid_table[64];
__device__ __forceinline__ unsigned hw_wave_slot() { return (unsigned)__builtin_amdgcn_s_getreg(((6 - 1) << 11) | (0 << 6) | 4) & 63u; }
__device__ __forceinline__ int opaque_tid() {
  const int wid = __builtin_amdgcn_readfirstlane(g_wid_table[hw_wave_slot()]);
  unsigned z = 0u; asm volatile("" : "+v"(z));
  int t = wid * 64 + (int)__builtin_amdgcn_mbcnt_hi(~0u, __builtin_amdgcn_mbcnt_lo(~0u, z));
  asm volatile("" : "+v"(t)); return t;
}

namespace pg8 {
constexpr int BM = 256, BK = 64, HALF = 128, HTB = HALF * BK * 2, STAGE_BYTES = 8 * HTB, NXCD = 8, WGM = 8;
__device__ __forceinline__ int lds_byte(int r, int c) { const int st = (r >> 4) * 2 + (c >> 5), rr = r & 15, cc = c & 31, ob = rr * 64 + cc * 2; return st * 1024 + (ob ^ (((ob >> 9) & 1) << 5)); }
__device__ __forceinline__ void stage_rc(int b, int& R, int& C) { const int st = b / 1024, sb = b % 1024, swz = sb ^ (((sb >> 9) & 1) << 5); R = (st >> 1) * 16 + swz / 64; C = (st & 1) * 32 + (swz % 64) / 2; }
__device__ __forceinline__ int perm32(int rho) { const int n = rho >> 4, i = rho & 15; return 8 * (i >> 2) + 4 * n + (i & 3); }
struct Unit { int pm, pn; };
struct Gemm { const bf16_t* A; const bf16_t* Bt; int M, N, K; int bperm, lshift; };
struct StaticOrder {
  int nM, nN, nwg, G, c;
  __device__ void init(int M, int N, int G_, int c_) { nM = M / BM; nN = N / BM; nwg = nM * nN; G = G_; c = c_; }
  __device__ bool next(int i, Unit& u) const {
    const long L = (long)i * G + c; if (L >= nwg) return false;
    int wgid = (int)L; { const int q = nwg / NXCD, r = nwg % NXCD, xcd = wgid % NXCD, off = wgid / NXCD; wgid = (xcd < r ? xcd * (q + 1) : r * (q + 1) + (xcd - r) * q) + off; }
    const int nig = WGM * nN, gid = wgid / nig, fm = gid * WGM, gsz = (nM - fm) < WGM ? (nM - fm) : WGM;
    u.pm = fm + ((wgid % nig) % gsz); u.pn = (wgid % nig) / gsz; return true;
  }
};

template <class Epi>
__device__ __forceinline__ void gemm_phase(LAS unsigned char* lds, const Gemm g, const StaticOrder& S, const Epi& E) {
  const int tid_ = opaque_tid();
  const int tid = tid_, wid = __builtin_amdgcn_readfirstlane(tid >> 6), lane = tid & 63, wr = wid >> 2, wc = wid & 3, fr = lane & 15, fq = lane >> 4;
  const int K = g.K, nt = K / BK;
  const size_t kstep = (size_t)(BK * 2);
  const size_t hstep = (size_t)HALF * K * 2;
  const size_t tstep = 2 * hstep;
  unsigned voffA[2], voffBr[2], voffBc[2], voffB[2], voffBn[2];
#pragma unroll
  for (int i = 0; i < 2; ++i) { int R, C; stage_rc(tid * 16 + i * 8192, R, C); const int Rb = (R & ~31) + perm32(R & 31);
    voffA[i] = (unsigned)(R * K + C) * 2u; voffBr[i] = (unsigned)(Rb * K) * 2u; voffBc[i] = (unsigned)C * 2u; voffB[i] = voffBr[i] + voffBc[i]; voffBn[i] = voffB[i]; }
  auto bbase = [&](const Unit& u, int hh, int& sh) -> const char* {
    if (!g.bperm) { sh = 0; return (const char*)g.Bt + (size_t)u.pn * tstep + (size_t)hh * hstep; }
    const int ds = u.pm <= 4 ? 0 : (u.pm == 5 ? 2 : 4); sh = ds;
    const int L = 1 << g.lshift; const int p0 = u.pn * 256 + hh * 128, seq = p0 >> g.lshift, p = p0 & (L - 1);
    const int Mc = L >> ds, r = p / Mc, m0 = p & (Mc - 1);
    return (const char*)g.Bt + ((size_t)seq * L + ((size_t)m0 << ds) + r) * (size_t)K * 2;
  };
  const unsigned ldsw = (unsigned)wid * 1024u;
  const int aoff = lds_byte(wr * 64 + fr, fq * 8), boff = lds_byte(wc * 32 + fr, fq * 8);
#define PG8_SA(b, h) (((b) * 2 + (h)) * HTB)
#define PG8_SB(b, h) ((4 + (b) * 2 + (h)) * HTB)
#define PG8_STAGE(bufoff, gbase, voff) do { _Pragma("unroll") for (int _i = 0; _i < 2; ++_i) \
    __builtin_amdgcn_global_load_lds((const unsigned*)((const char*)(gbase) + (voff)[_i]), (LAS unsigned*)(lds + (bufoff) + ldsw + _i * 8192), 16, 0, 0); } while (0)
#define PG8_LDA(dst, b, h) do { _Pragma("unroll") for (int m = 0; m < 4; ++m) _Pragma("unroll") for (int k = 0; k < 2; ++k) dst[m][k] = *(const LAS bf16x8*)(lds + PG8_SA(b, h) + aoff + m * 2048 + k * 1024); } while (0)
#define PG8_LDB(dst, b, h) do { _Pragma("unroll") for (int n = 0; n < 2; ++n) _Pragma("unroll") for (int k = 0; k < 2; ++k) dst[n][k] = *(const LAS bf16x8*)(lds + PG8_SB(b, h) + boff + n * 2048 + k * 1024); } while (0)
#define PG8_MMA(ai, bj, At, Bt) do { __builtin_amdgcn_s_setprio(1); _Pragma("unroll") for (int m = 0; m < 4; ++m) _Pragma("unroll") for (int n = 0; n < 2; ++n) _Pragma("unroll") for (int k = 0; k < 2; ++k) \
    acc[ai][bj][m][n] = __builtin_amdgcn_mfma_f32_16x16x32_bf16(Bt[n][k], At[m][k], acc[ai][bj][m][n], 0, 0, 0); __builtin_amdgcn_s_setprio(0); } while (0)
#define PG8_WAIT_V(n) asm volatile("s_waitcnt vmcnt(" #n ")" ::: "memory")
#define PG8_WAIT_L(n) asm volatile("s_waitcnt lgkmcnt(" #n ")" ::: "memory")
#define PG8_BAR __builtin_amdgcn_s_barrier()
#define PG8_SCHED __builtin_amdgcn_sched_barrier(0)
  Unit cur, nxt; int ui = 0;
  if (!S.next(0, cur)) return;
  f32x4 acc[2][2][4][2];
#pragma unroll
  for (int a = 0; a < 2; ++a)
#pragma unroll
    for (int b = 0; b < 2; ++b)
#pragma unroll
      for (int m = 0; m < 4; ++m)
#pragma unroll
        for (int n = 0; n < 2; ++n) acc[a][b][m][n] = (f32x4){0.f, 0.f, 0.f, 0.f};
  bf16x8 At[4][2], B0[2][2], B1[2][2];
  const char* cA = (const char*)g.A + (size_t)cur.pm * tstep;
  int csh; const char* cB0 = bbase(cur, 0, csh); const char* cB1 = bbase(cur, 1, csh);
#pragma unroll
  for (int i = 0; i < 2; ++i) voffB[i] = (voffBr[i] << csh) + voffBc[i];
  PG8_STAGE(PG8_SB(0, 0), cB0, voffB); PG8_STAGE(PG8_SA(0, 0), cA, voffA); PG8_STAGE(PG8_SB(0, 1), cB1, voffB); PG8_STAGE(PG8_SA(0, 1), cA + hstep, voffA);
  if (wr == 1) PG8_BAR;
  PG8_WAIT_V(4); PG8_BAR;
  PG8_STAGE(PG8_SB(1, 0), cB0 + kstep, voffB); PG8_STAGE(PG8_SA(1, 0), cA + kstep, voffA); PG8_STAGE(PG8_SB(1, 1), cB1 + kstep, voffB);
  PG8_WAIT_V(6); PG8_BAR;
  for (;;) {
    const bool has_next = S.next(ui + 1, nxt);
    const char* nA = cA; const char* nB0 = cB0; const char* nB1 = cB1;
#pragma unroll
    for (int i = 0; i < 2; ++i) voffBn[i] = voffB[i];
    if (has_next) { int nsh; nA = (const char*)g.A + (size_t)nxt.pm * tstep; nB0 = bbase(nxt, 0, nsh); nB1 = bbase(nxt, 1, nsh);
#pragma unroll
      for (int i = 0; i < 2; ++i) voffBn[i] = (voffBr[i] << nsh) + voffBc[i]; }
    for (int t = 0; t < nt; t += 2) {
      if constexpr (Epi::HOOK) { if (t == 8 || t == 16) E.hook(acc, cur, t, wr, wc, fr, fq); }
      const bool last = (t == nt - 2);
      const char* a1 = cA + (size_t)(t + 1) * kstep;
      const char* a2 = last ? nA : cA + (size_t)(t + 2) * kstep;
      const char* b20 = last ? nB0 : cB0 + (size_t)(t + 2) * kstep; const char* b21 = last ? nB1 : cB1 + (size_t)(t + 2) * kstep;
      const char* a3 = a2 + kstep; const char* b30 = b20 + kstep; const char* b31 = b21 + kstep;
      unsigned vB[2];
#pragma unroll
      for (int i = 0; i < 2; ++i) vB[i] = last ? voffBn[i] : voffB[i];
      PG8_LDB(B0, 0, 0); PG8_SCHED; PG8_LDA(At, 0, 0); PG8_STAGE(PG8_SA(1, 1), a1 + hstep, voffA);
      PG8_WAIT_L(8); PG8_BAR; PG8_WAIT_L(0); PG8_MMA(0, 0, At, B0); PG8_BAR; PG8_SCHED;
      PG8_LDB(B1, 0, 1); PG8_STAGE(PG8_SB(0, 0), b20, vB);
      PG8_BAR; PG8_WAIT_L(0); PG8_MMA(0, 1, At, B1); PG8_BAR;
      PG8_LDA(At, 0, 1); PG8_STAGE(PG8_SA(0, 0), a2, voffA);
      PG8_BAR; PG8_WAIT_L(0); PG8_MMA(1, 0, At, B0); PG8_BAR; PG8_SCHED;
      PG8_STAGE(PG8_SB(0, 1), b21, vB);
      PG8_WAIT_V(6); PG8_BAR; PG8_MMA(1, 1, At, B1); PG8_BAR;
      PG8_LDB(B0, 1, 0); PG8_SCHED; PG8_LDA(At, 1, 0); PG8_STAGE(PG8_SA(0, 1), a2 + hstep, voffA);
      PG8_WAIT_L(8); PG8_BAR; PG8_WAIT_L(0); PG8_MMA(0, 0, At, B0); PG8_BAR; PG8_SCHED;
      PG8_LDB(B1, 1, 1); PG8_STAGE(PG8_SB(1, 0), b30, vB);
      PG8_BAR; PG8_WAIT_L(0); PG8_MMA(0, 1, At, B1); PG8_BAR;
      PG8_LDA(At, 1, 1); PG8_STAGE(PG8_SA(1, 0), a3, voffA);
      PG8_BAR; PG8_WAIT_L(0); PG8_MMA(1, 0, At, B0); PG8_BAR; PG8_SCHED;
      PG8_STAGE(PG8_SB(1, 1), b31, vB);
      PG8_WAIT_V(6); PG8_BAR; PG8_MMA(1, 1, At, B1); PG8_BAR;
    }
    E(acc, cur, wr, wc, fr, fq);
    if (!has_next) break;
#pragma unroll
    for (int a = 0; a < 2; ++a)
#pragma unroll
      for (int b = 0; b < 2; ++b)
#pragma unroll
        for (int m = 0; m < 4; ++m)
#pragma unroll
          for (int n = 0; n < 2; ++n) acc[a][b][m][n] = (f32x4){0.f, 0.f, 0.f, 0.f};
    cur = nxt; cA = nA; cB0 = nB0; cB1 = nB1; ++ui;
#pragma unroll
    for (int i = 0; i < 2; ++i) voffB[i] = voffBn[i];
  }
  PG8_WAIT_V(0);
  if (wr == 0) PG8_BAR;
  PG8_BAR;
#undef PG8_SA
#undef PG8_SB
#undef PG8_STAGE
#undef PG8_LDA
#undef PG8_LDB
#undef PG8_MMA
#undef PG8_WAIT_V
#undef PG8_WAIT_L
#undef PG8_BAR
#undef PG8_SCHED
}
}
using pg8::Unit;

struct EpiU {
  static constexpr bool HOOK = false;
  bf16_t* U; const float* rinv; const float* bg;
  __device__ __forceinline__ void hook(f32x4 (&)[2][2][4][2], const Unit&, int, int, int, int, int) const {}
  __device__ __forceinline__ void operator()(const f32x4 (&acc)[2][2][4][2], const Unit& u, int wr, int wc, int fr, int fq) const {
    asm volatile("" : "+v"(fr), "+v"(fq));
    const int row0 = u.pm * 256 + wr * 64 + fr, col0 = u.pn * 256 + wc * 32 + 8 * fq;
    const bool isg = (u.pn >= 19);
    float ri[2][4];
#pragma unroll
    for (int ai = 0; ai < 2; ++ai)
#pragma unroll
      for (int m = 0; m < 4; ++m) ri[ai][m] = rinv[row0 + ai * 128 + m * 16];
    if (isg) {
      f32x4 b[2][2];
#pragma unroll
      for (int bj = 0; bj < 2; ++bj) { const float* bp = bg + (col0 - U_GL) + bj * 128; b[bj][0] = *(const f32x4*)bp; b[bj][1] = *(const f32x4*)(bp + 4); }
#pragma unroll
      for (int ai = 0; ai < 2; ++ai)
#pragma unroll
        for (int m = 0; m < 4; ++m)
#pragma unroll
          for (int bj = 0; bj < 2; ++bj) {
            f32x4 v0 = acc[ai][bj][m][0] * ri[ai][m] + b[bj][0], v1 = acc[ai][bj][m][1] * ri[ai][m] + b[bj][1];
#pragma unroll
            for (int j = 0; j < 4; ++j) { v0[j] = 1.0f + fminf(fexp2(-v0[j] * LOG2E), 1e30f); v1[j] = 1.0f + fminf(fexp2(-v1[j] * LOG2E), 1e30f); }
            u32x4 pk = {cvt_pk_bf16(v0[0], v0[1]), cvt_pk_bf16(v0[2], v0[3]), cvt_pk_bf16(v1[0], v1[1]), cvt_pk_bf16(v1[2], v1[3])};
            *(u32x4*)(U + (size_t)(row0 + ai * 128 + m * 16) * UW + col0 + bj * 128) = pk;
          }
    } else {
#pragma unroll
      for (int ai = 0; ai < 2; ++ai)
#pragma unroll
        for (int m = 0; m < 4; ++m)
#pragma unroll
          for (int bj = 0; bj < 2; ++bj) {
            const f32x4 v0 = acc[ai][bj][m][0] * ri[ai][m], v1 = acc[ai][bj][m][1] * ri[ai][m];
            u32x4 pk = {cvt_pk_bf16(v0[0], v0[1]), cvt_pk_bf16(v0[2], v0[3]), cvt_pk_bf16(v1[0], v1[1]), cvt_pk_bf16(v1[2], v1[3])};
            *(u32x4*)(U + (size_t)(row0 + ai * 128 + m * 16) * UW + col0 + bj * 128) = pk;
          }
    }
  }
};

struct EpiVT {
  static constexpr bool HOOK = false;
  bf16_t* VT; const float* rv; int L, lshift;
  __device__ __forceinline__ void hook(f32x4 (&)[2][2][4][2], const Unit&, int, int, int, int, int) const {}
  __device__ __forceinline__ void operator()(const f32x4 (&acc)[2][2][4][2], const Unit& u, int wr, int wc, int fr, int fq) const {
    asm volatile("" : "+v"(fr), "+v"(fq));
    const int vrow0 = u.pm * 256 + wr * 64 + fr, pcol0 = u.pn * 256 + wc * 32 + 8 * fq;
    const int ds = u.pm <= 4 ? 0 : (u.pm == 5 ? 2 : 4);
    const int Mc = L >> ds;
#pragma unroll
    for (int bj = 0; bj < 2; ++bj) {
      const int p0 = pcol0 + bj * 128, seq = p0 >> lshift, pos = p0 & (L - 1);
      const int r = pos / Mc, m0 = pos & (Mc - 1);
      float rinv[8];
#pragma unroll
      for (int j = 0; j < 8; ++j) rinv[j] = rv[(seq << lshift) + ((m0 + j) << ds) + r];
      bf16_t* vb = VT + ((size_t)seq * VW + vrow0) * L + pos;
#pragma unroll
      for (int ai = 0; ai < 2; ++ai)
#pragma unroll
        for (int m = 0; m < 4; ++m) {
          const f32x4 v0 = acc[ai][bj][m][0], v1 = acc[ai][bj][m][1];
          u32x4 pk = {cvt_pk_bf16(v0[0] * rinv[0], v0[1] * rinv[1]), cvt_pk_bf16(v0[2] * rinv[2], v0[3] * rinv[3]),
                      cvt_pk_bf16(v1[0] * rinv[4], v1[1] * rinv[5]), cvt_pk_bf16(v1[2] * rinv[6], v1[3] * rinv[7])};
          *(u32x4*)(vb + (size_t)(ai * 128 + m * 16) * L) = pk;
        }
    }
  }
};

struct EpiMerge {
  static constexpr bool HOOK = true;
  const bf16_t* U; bf16_t* MG;
  __device__ __forceinline__ f32x4 gvec(int i, size_t row, int col) const {
    const u32x2 raw = *(const u32x2*)(U + row * UW + U_GL + i * 1024 + col);
    f32x4 e; e[0] = bf_lo(raw[0]); e[1] = bf_hi(raw[0]); e[2] = bf_lo(raw[1]); e[3] = bf_hi(raw[1]); return e;
  }
  __device__ __forceinline__ void hook(f32x4 (&acc)[2][2][4][2], const Unit& u, int t, int wr, int wc, int fr, int fq) const {
    const int i = (t == 8) ? 0 : 1;
    asm volatile("" : "+v"(fr), "+v"(fq));
    const int row0 = u.pm * 256 + wr * 64 + fr, col0 = u.pn * 256 + wc * 32 + 8 * fq;
#pragma unroll
    for (int ai = 0; ai < 2; ++ai) {
#pragma unroll
      for (int m = 0; m < 4; ++m)
#pragma unroll
        for (int bj = 0; bj < 2; ++bj) {
          const bf16_t* gp = U + (size_t)(row0 + ai * 128 + m * 16) * UW + U_GL + i * 1024 + col0 + bj * 128;
          const u32x4 a = *(const u32x4*)gp, b = *(const u32x4*)(gp + 1024);
#pragma unroll
          for (int n = 0; n < 2; ++n) {
            f32x4 r;
            r[0] = bf_lo(b[2 * n]) * frcp(bf_lo(a[2 * n])); r[1] = bf_hi(b[2 * n]) * frcp(bf_hi(a[2 * n]));
            r[2] = bf_lo(b[2 * n + 1]) * frcp(bf_lo(a[2 * n + 1])); r[3] = bf_hi(b[2 * n + 1]) * frcp(bf_hi(a[2 * n + 1]));
            acc[ai][bj][m][n] *= r;
          }
        }
      __builtin_amdgcn_sched_barrier(0);
    }
  }
  __device__ __forceinline__ void operator()(const f32x4 (&acc)[2][2][4][2], const Unit& u, int wr, int wc, int fr, int fq) const {
    asm volatile("" : "+v"(fr), "+v"(fq));
    const int row0 = u.pm * 256 + wr * 64 + fr, col0 = u.pn * 256 + wc * 32 + 8 * fq;
    u32x4 g2[2][4][2];
#pragma unroll
    for (int ai = 0; ai < 2; ++ai)
#pragma unroll
      for (int m = 0; m < 4; ++m)
#pragma unroll
        for (int bj = 0; bj < 2; ++bj) g2[ai][m][bj] = *(const u32x4*)(U + (size_t)(row0 + ai * 128 + m * 16) * UW + U_GL + 2 * 1024 + col0 + bj * 128);
    __builtin_amdgcn_sched_barrier(0);
#pragma unroll
    for (int ai = 0; ai < 2; ++ai)
#pragma unroll
      for (int m = 0; m < 4; ++m)
#pragma unroll
        for (int bj = 0; bj < 2; ++bj) {
          const size_t row = (size_t)(row0 + ai * 128 + m * 16); const int col = col0 + bj * 128;
          const u32x4 g = g2[ai][m][bj];
          f32x4 v0 = acc[ai][bj][m][0], v1 = acc[ai][bj][m][1];
          v0[0] *= frcp(bf_lo(g[0])); v0[1] *= frcp(bf_hi(g[0])); v0[2] *= frcp(bf_lo(g[1])); v0[3] *= frcp(bf_hi(g[1]));
          v1[0] *= frcp(bf_lo(g[2])); v1[1] *= frcp(bf_hi(g[2])); v1[2] *= frcp(bf_lo(g[3])); v1[3] *= frcp(bf_hi(g[3]));
          u32x4 pk = {cvt_pk_bf16(v0[0], v0[1]), cvt_pk_bf16(v0[2], v0[3]), cvt_pk_bf16(v1[0], v1[1]), cvt_pk_bf16(v1[2], v1[3])};
          *(u32x4*)(MG + row * DM + col) = pk;
        }
  }
};

struct EpiRes {
  static constexpr bool HOOK = false;
  const float* R; float* X; bf16_t* XB; float* ssq;
  __device__ __forceinline__ void hook(f32x4 (&)[2][2][4][2], const Unit&, int, int, int, int, int) const {}
  __device__ __forceinline__ void operator()(const f32x4 (&acc)[2][2][4][2], const Unit& u, int wr, int wc, int fr, int fq) const {
    asm volatile("" : "+v"(fr), "+v"(fq));
    const int row0 = u.pm * 256 + wr * 64 + fr, col0 = u.pn * 256 + wc * 32 + 8 * fq;
#pragma unroll
    for (int ai = 0; ai < 2; ++ai) {
      f32x4 r[4][2][2];
#pragma unroll
      for (int m = 0; m < 4; ++m)
#pragma unroll
        for (int bj = 0; bj < 2; ++bj) { const float* rp = R + (size_t)(row0 + ai * 128 + m * 16) * DM + col0 + bj * 128; r[m][bj][0] = *(const f32x4*)rp; r[m][bj][1] = *(const f32x4*)(rp + 4); }
      __builtin_amdgcn_sched_barrier(0);
#pragma unroll
      for (int m = 0; m < 4; ++m) {
        const size_t row = (size_t)(row0 + ai * 128 + m * 16);
        float s = 0.f;
#pragma unroll
        for (int bj = 0; bj < 2; ++bj) {
          const int col = col0 + bj * 128;
          const f32x4 v0 = r[m][bj][0] + acc[ai][bj][m][0], v1 = r[m][bj][1] + acc[ai][bj][m][1];
          *(f32x4*)(X + row * DM + col) = v0; *(f32x4*)(X + row * DM + col + 4) = v1;
          s += v0[0] * v0[0] + v0[1] * v0[1] + v0[2] * v0[2] + v0[3] * v0[3] + v1[0] * v1[0] + v1[1] * v1[1] + v1[2] * v1[2] + v1[3] * v1[3];
          u32x4 pk = {cvt_pk_bf16(v0[0], v0[1]), cvt_pk_bf16(v0[2], v0[3]), cvt_pk_bf16(v1[0], v1[1]), cvt_pk_bf16(v1[2], v1[3])};
          *(u32x4*)(XB + row * DM + col) = pk;
        }
        s += __shfl_xor(s, 16); s += __shfl_xor(s, 32);
        if (fq == 0) ssq[row * 16 + u.pn * 4 + wc] = s;
      }
      __builtin_amdgcn_sched_barrier(0);
    }
  }
};

__device__ __forceinline__ void prep_tile(const float* src, int ldn, int k0, int n0, const float* rscale, float cscale, bf16_t* dst, int ldd, int drow0, int dk0, LAS float* tile) {
  const int tid = opaque_tid(), kk = tid >> 6, nn = tid & 63;
#pragma unroll
  for (int i = 0; i < 8; ++i) {
    const int k = kk * 8 + i;
    float v = src[(size_t)(k0 + k) * ldn + n0 + nn] * cscale;
    if (rscale) v *= rscale[k0 + k];
    tile[k * 65 + nn] = v;
  }
  __syncthreads();
  const int n = tid >> 3, kc = tid & 7;
  float f[8];
#pragma unroll
  for (int j = 0; j < 8; ++j) f[j] = tile[(kc * 8 + j) * 65 + n];
  u32x4 pk = {cvt_pk_bf16(f[0], f[1]), cvt_pk_bf16(f[2], f[3]), cvt_pk_bf16(f[4], f[5]), cvt_pk_bf16(f[6], f[7])};
  *(u32x4*)(dst + (size_t)(drow0 + n) * ldd + dk0 + kc * 8) = pk;
  __syncthreads();
}

__device__ __forceinline__ void win_map(int n0, int& dn0, float& sc) {
  sc = 1.0f;
  if (n0 < 512) { dn0 = U_QA + n0; sc = QSCALE; }
  else if (n0 < 1024) dn0 = U_KA + (n0 - 512);
  else if (n0 < 1536) dn0 = UW + V_A + (n0 - 1024);
  else if (n0 < 2048) dn0 = U_ZA + (n0 - 1536);
  else if (n0 < 2560) { dn0 = U_QB + (n0 - 2048); sc = QSCALE; }
  else if (n0 < 3072) dn0 = U_KB + (n0 - 2560);
  else if (n0 < 3584) dn0 = UW + V_B + (n0 - 3072);
  else if (n0 < 4096) dn0 = U_ZB + (n0 - 3584);
  else if (n0 < 4864) { dn0 = U_QC + (n0 - 4096); sc = QSCALE; }
  else if (n0 < 5632) dn0 = U_KC + (n0 - 4864);
  else if (n0 < 6400) dn0 = UW + V_C + (n0 - 5632);
  else if (n0 < 6656) dn0 = U_ZC + (n0 - 6400);
  else dn0 = U_GL + (n0 - 6656);
}

__device__ void phase_prep(const Params& p, LAS float* tile) {
  constexpr int PER = 3008;
  for (int it = blockIdx.x; it < DEPTH * PER; it += gridDim.x) {
    const int l = it / PER; int r = it % PER;
    if (r < 2432) {
      const int kt = r / 152, ntile = r % 152; int dn0; float sc; win_map(ntile * 64, dn0, sc);
      prep_tile(p.w_in + (size_t)l * DM * INW, INW, kt * 64, ntile * 64, p.g_norm + l * DM, sc, p.wt_in + (size_t)l * INW * DM, DM, dn0, kt * 64, tile);
    } else if ((r -= 2432) < 128) {
      const int kt = r / 16, ntile = r % 16;
      prep_tile(p.w_br_a + (size_t)l * 512 * DM, DM, kt * 64, ntile * 64, nullptr, 1.0f, p.wt_br + (size_t)l * DM * YW, YW, ntile * 64, kt * 64, tile);
    } else if ((r -= 128) < 128) {
      const int kt = r / 16, ntile = r % 16;
      prep_tile(p.w_br_b + (size_t)l * 512 * DM, DM, kt * 64, ntile * 64, nullptr, 1.0f, p.wt_br + (size_t)l * DM * YW, YW, ntile * 64, 512 + kt * 64, tile);
    } else if ((r -= 128) < 64) {
      const int kt = r / 16, ntile = r % 16;
      prep_tile(p.w_br_c + (size_t)l * 256 * DM, DM, kt * 64, ntile * 64, nullptr, 1.0f, p.wt_br + (size_t)l * DM * YW, YW, ntile * 64, 1024 + kt * 64, tile);
    } else {
      r -= 64; const int kt = r / 16, ntile = r % 16;
      prep_tile(p.w_out + (size_t)l * DM * DM, DM, kt * 64, ntile * 64, nullptr, 1.0f, p.wt_out + (size_t)l * DM * DM, DM, ntile * 64, kt * 64, tile);
    }
  }
  const int ptid = opaque_tid();
  if (blockIdx.x == 0 && ptid < 64) {
    const int lane = ptid;
    for (int l = 0; l < DEPTH; ++l) {
      const float* lq = p.lam_qk + l * 256;
      float a = lq[lane] * lq[64 + lane], b = lq[128 + lane] * lq[192 + lane];
      for (int o = 32; o >= 1; o >>= 1) { a += __shfl_xor(a, o); b += __shfl_xor(b, o); }
      if (lane == 0) { const float li = 0.8f - 0.6f * expf(-0.3f * (float)l); p.lam[l] = expf(a) - expf(b) + li; p.lam[4 + l] = 1.0f - li; }
    }
  }
}

__device__ void phase_x(const Params& p, int chunk) {
  const float* xin = (chunk < 2) ? p.xp + (size_t)chunk * TC * DM : p.xs + (size_t)(chunk - 2) * TC * DM;
  float* ssq = p.ssq + (size_t)chunk * TC * 16;
  const int tid = opaque_tid(), lane = tid & 63, w = blockIdx.x * 8 + (tid >> 6), nw = gridDim.x * 8;
  for (int row = w; row < TC; row += nw) {
    const float* xr = xin + (size_t)row * DM + lane * 16;
    f32x4 v[4]; float s = 0.f;
#pragma unroll
    for (int i = 0; i < 4; ++i) { v[i] = *(const f32x4*)(xr + i * 4); s += v[i][0] * v[i][0] + v[i][1] * v[i][1] + v[i][2] * v[i][2] + v[i][3] * v[i][3]; }
    for (int o = 32; o >= 1; o >>= 1) s += __shfl_xor(s, o);
    u32x4 p0 = {cvt_pk_bf16(v[0][0], v[0][1]), cvt_pk_bf16(v[0][2], v[0][3]), cvt_pk_bf16(v[1][0], v[1][1]), cvt_pk_bf16(v[1][2], v[1][3])};
    u32x4 p1 = {cvt_pk_bf16(v[2][0], v[2][1]), cvt_pk_bf16(v[2][2], v[2][3]), cvt_pk_bf16(v[3][0], v[3][1]), cvt_pk_bf16(v[3][2], v[3][3])};
    bf16_t* xo = p.xb + (size_t)row * DM + lane * 16;
    *(u32x4*)xo = p0; *(u32x4*)(xo + 8) = p1;
    if (lane < 16) ssq[(size_t)row * 16 + lane] = (lane == 0) ? s : 0.f;
    if (lane == 0) p.rinv[(size_t)chunk * TC + row] = rsqrtf(s * (1.0f / 1024.0f) + 1e-6f);
  }
}

__device__ void phase_rinv(const Params& p, int chunk) {
  const float* ssq = p.ssq + (size_t)chunk * TC * 16; float* rv = p.rinv + (size_t)chunk * TC;
  for (int row = blockIdx.x * 512 + opaque_tid(); row < TC; row += gridDim.x * 512) {
    const f32x4* sp = (const f32x4*)(ssq + (size_t)row * 16);
    const f32x4 a4 = sp[0] + sp[1] + sp[2] + sp[3];
    rv[row] = rsqrtf((a4[0] + a4[1] + a4[2] + a4[3]) * (1.0f / 1024.0f) + 1e-6f);
  }
}

__device__ void phase_final(const Params& p, int chunk) {
  float* x = p.out + (size_t)chunk * TC * DM;
  const float* ssq = p.ssq + (size_t)chunk * TC * 16;
  const int tid = opaque_tid(), lane = tid & 63, w = blockIdx.x * 8 + (tid >> 6), nw = gridDim.x * 8;
  for (int row = w; row < TC; row += nw) {
    const f32x4* sp = (const f32x4*)(ssq + (size_t)row * 16);
    const f32x4 a4 = sp[0] + sp[1] + sp[2] + sp[3];
    const float rinv = rsqrtf((a4[0] + a4[1] + a4[2] + a4[3]) * (1.0f / 1024.0f) + 1e-6f);
    float* xr = x + (size_t)row * DM + lane * 16;
#pragma unroll
    for (int i = 0; i < 4; ++i) { f32x4 v = *(const f32x4*)(xr + i * 4); const f32x4 g = *(const f32x4*)(p.g_final + lane * 16 + i * 4); v = v * rinv * g; *(f32x4*)(xr + i * 4) = v; }
  }
}

__device__ __forceinline__ f32x16 mfma32(bf16x8 a, bf16x8 b, f32x16 c) { return __builtin_amdgcn_mfma_f32_32x32x16_bf16(a, b, c, 0, 0, 0); }
__device__ __forceinline__ bf16x8 ld16(const bf16_t* p) { return *(const bf16x8*)p; }
__device__ __forceinline__ bf16x8 ld8x2(const bf16_t* p0, const bf16_t* p1) { const bf16x4 a = *(const bf16x4*)p0, b = *(const bf16x4*)p1; return __builtin_shufflevector(a, b, 0, 1, 2, 3, 4, 5, 6, 7); }

__device__ __forceinline__ void softmax_tile(f32x16& t, float& m, float& l, float& alpha, bf16x8& p0, bf16x8& p1) {
  float tm = t[0];
#pragma unroll
  for (int i = 1; i < 16; ++i) tm = fmaxf(tm, t[i]);
  tm = fmaxf(tm, __shfl_xor(tm, 32));
  const float mn = fmaxf(m, tm);
  alpha = fexp2(m - mn); m = mn;
  float ls = 0.f;
#pragma unroll
  for (int i = 0; i < 16; ++i) { t[i] = fexp2(t[i] - mn); ls += t[i]; }
  l = l * alpha + ls;
  const u32x4 a = {cvt_pk_bf16(t[0], t[1]), cvt_pk_bf16(t[2], t[3]), cvt_pk_bf16(t[4], t[5]), cvt_pk_bf16(t[6], t[7])};
  const u32x4 b = {cvt_pk_bf16(t[8], t[9]), cvt_pk_bf16(t[10], t[11]), cvt_pk_bf16(t[12], t[13]), cvt_pk_bf16(t[14], t[15])};
  p0 = __builtin_bit_cast(bf16x8, a); p1 = __builtin_bit_cast(bf16x8, b);
}
__device__ __forceinline__ f32x16 zero16() { f32x16 z;
#pragma unroll
  for (int i = 0; i < 16; ++i) z[i] = 0.f; return z; }
__device__ __forceinline__ float silu(float z) { return z * frcp(1.0f + fexp2(-z * LOG2E)); }

constexpr int TB_ROW = 144;
constexpr int KB_BYTES = 64 * TB_ROW;
constexpr int VB_BYTES = 128 * TB_ROW;
constexpr int LDS_K = 0, LDS_V = LDS_K + 2 * KB_BYTES, LDS_ATT_END = LDS_V + 2 * VB_BYTES, LDS_ATT_TOTAL = LDS_ATT_END + 65536;
template <int SIDE>
__device__ __forceinline__ void b_far_subtile(const LAS unsigned char* kb, const LAS unsigned char* vb, int rd, int sub, const bf16x8 (&qf)[4], const f32x16& bp, float slope2, float d0,
                                              float& mrun, float& lrun, f32x16 (&o)[4]) {
  const float base = (SIDE > 0 ? -slope2 : slope2) * d0 - mrun;
  f32x16 sc;
#pragma unroll
  for (int i = 0; i < 16; ++i) sc[i] = SIDE > 0 ? base - bp[i] : base + bp[i];
#pragma unroll
  for (int ks = 0; ks < 4; ++ks) sc = mfma32(*(const LAS bf16x8*)(kb + rd + sub * 32 * TB_ROW + ks * 32), qf[ks], sc);
  float tm = sc[0];
#pragma unroll
  for (int i = 1; i < 16; ++i) tm = fmaxf(tm, sc[i]);
  tm = fmaxf(tm, __shfl_xor(tm, 32));
  if (__builtin_amdgcn_ballot_w64(tm > 0.0f) != 0) {
    const float delta = fmaxf(tm, 0.0f);
    const float al = fexp2(-delta);
    mrun += delta; lrun *= al;
#pragma unroll
    for (int i = 0; i < 16; ++i) sc[i] -= delta;
#pragma unroll
    for (int dt = 0; dt < 4; ++dt) o[dt] *= al;
  }
#pragma unroll
  for (int i = 0; i < 16; ++i) sc[i] = fexp2(sc[i]);
  { const f32x4 a4 = (f32x4){sc[0], sc[1], sc[2], sc[3]} + (f32x4){sc[4], sc[5], sc[6], sc[7]} + (f32x4){sc[8], sc[9], sc[10], sc[11]} + (f32x4){sc[12], sc[13], sc[14], sc[15]};
    lrun += (a4[0] + a4[1]) + (a4[2] + a4[3]); }
  const u32x4 pa = {cvt_pk_bf16(sc[0], sc[1]), cvt_pk_bf16(sc[2], sc[3]), cvt_pk_bf16(sc[4], sc[5]), cvt_pk_bf16(sc[6], sc[7])};
  const u32x4 pb = {cvt_pk_bf16(sc[8], sc[9]), cvt_pk_bf16(sc[10], sc[11]), cvt_pk_bf16(sc[12], sc[13]), cvt_pk_bf16(sc[14], sc[15])};
  const bf16x8 pk0 = __builtin_bit_cast(bf16x8, pa), pk1 = __builtin_bit_cast(bf16x8, pb);
#pragma unroll
  for (int dt = 0; dt < 4; ++dt) {
    o[dt] = mfma32(*(const LAS bf16x8*)(vb + rd + dt * 32 * TB_ROW + (sub * 2) * 32), pk0, o[dt]);
    o[dt] = mfma32(*(const LAS bf16x8*)(vb + rd + dt * 32 * TB_ROW + (sub * 2 + 1) * 32), pk1, o[dt]);
  }
}

__device__ __forceinline__ void attn_b_pass(const Params& p, int L, int seq, int h, int mp, int qblk, int tq, int tid, float slope2, LAS unsigned char* lds, f32x16 (&o)[4], float& linv) {
  const int lane = tid & 63, q = lane & 31, half = lane >> 5;
  const size_t tokbase = (size_t)seq * L;
  bf16x8 qf[4];
  { const bf16_t* qp = p.u + (tokbase + tq) * UW + U_QB + h * 128 + mp * 64 + half * 8;
#pragma unroll
    for (int ks = 0; ks < 4; ++ks) qf[ks] = ld16(qp + ks * 16); }
  const int spart = tid & 7, srow = tid >> 3;
  const bf16_t* kg = p.u + (tokbase + srow) * UW + U_KB + h * 128 + mp * 64 + spart * 8;
  const bf16_t* vg = p.vt + ((size_t)seq * VW + V_B + h * 128 + srow) * L + spart * 8;
  const int kst = srow * TB_ROW + spart * 16;
  const int vst = srow * TB_ROW + ((spart >> 1) * 16 + (spart & 1) * 4) * 2;
  const int rd = q * TB_ROW + half * 16;
#pragma unroll
  for (int dt = 0; dt < 4; ++dt) o[dt] = zero16();
  float mrun = -1e30f, lrun = 0.f;
  f32x16 bp;
#pragma unroll
  for (int i = 0; i < 16; ++i) bp[i] = slope2 * (float)((i >> 2) * 8 + (i & 3));
  const int ntile = L >> 6, t0 = qblk * 4, nR = ntile - t0;
  auto tile_of = [&](int idx) { return idx < nR ? t0 + idx : (t0 - 1) - (idx - nR); };
  bf16x8 krA, vrA0, vrA1, krB, vrB0, vrB1;
  auto gload = [&](int idx, bf16x8& kr, bf16x8& v0, bf16x8& v1) { const int kn = tile_of(idx) * 64; kr = ld16(kg + (size_t)kn * UW); v0 = ld16(vg + kn); v1 = ld16(vg + (size_t)64 * L + kn); };
  auto lwrite = [&](int buf, const bf16x8& kr, const bf16x8& v0, const bf16x8& v1) {
    LAS unsigned char* kb = lds + LDS_K + buf * KB_BYTES; LAS unsigned char* vb = lds + LDS_V + buf * VB_BYTES;
    *(LAS bf16x8*)(kb + kst) = kr;
    *(LAS bf16x4*)(vb + vst) = __builtin_shufflevector(v0, v0, 0, 1, 2, 3); *(LAS bf16x4*)(vb + vst + 16) = __builtin_shufflevector(v0, v0, 4, 5, 6, 7);
    *(LAS bf16x4*)(vb + vst + 64 * TB_ROW) = __builtin_shufflevector(v1, v1, 0, 1, 2, 3); *(LAS bf16x4*)(vb + vst + 64 * TB_ROW + 16) = __builtin_shufflevector(v1, v1, 4, 5, 6, 7);
  };
  auto compute = [&](int idx, int buf) {
    const int k0 = tile_of(idx) * 64;
    const LAS unsigned char* kb = lds + LDS_K + buf * KB_BYTES;
    const LAS unsigned char* vb = lds + LDS_V + buf * VB_BYTES;
    if (idx < 4) {
#pragma unroll
      for (int sub = 0; sub < 2; ++sub) {
        f32x16 sc = zero16();
#pragma unroll
        for (int ks = 0; ks < 4; ++ks) sc = mfma32(*(const LAS bf16x8*)(kb + rd + sub * 32 * TB_ROW + ks * 32), qf[ks], sc);
        const float d0 = (float)(k0 + sub * 32 + half * 4 - tq);
#pragma unroll
        for (int i = 0; i < 16; ++i) sc[i] -= slope2 * fabsf(d0 + (float)((i >> 2) * 8 + (i & 3)));
        float al; bf16x8 pk[2];
        softmax_tile(sc, mrun, lrun, al, pk[0], pk[1]);
        if (__builtin_amdgcn_ballot_w64(al != 1.0f) != 0) {
#pragma unroll
          for (int dt = 0; dt < 4; ++dt) o[dt] *= al;
        }
#pragma unroll
        for (int dt = 0; dt < 4; ++dt)
#pragma unroll
          for (int s2 = 0; s2 < 2; ++s2) o[dt] = mfma32(*(const LAS bf16x8*)(vb + rd + dt * 32 * TB_ROW + (sub * 2 + s2) * 32), pk[s2], o[dt]);
      }
    } else if (idx < nR) {
#pragma unroll
      for (int sub = 0; sub < 2; ++sub) b_far_subtile<1>(kb, vb, rd, sub, qf, bp, slope2, (float)(k0 + sub * 32 + half * 4 - tq), mrun, lrun, o);
    } else {
#pragma unroll
      for (int sub = 0; sub < 2; ++sub) b_far_subtile<-1>(kb, vb, rd, sub, qf, bp, slope2, (float)(k0 + sub * 32 + half * 4 - tq), mrun, lrun, o);
    }
  };
  gload(0, krA, vrA0, vrA1);
  gload(1, krB, vrB0, vrB1);
  lwrite(0, krA, vrA0, vrA1);
  asm volatile("" : "+v"(qf[0]), "+v"(qf[1]), "+v"(qf[2]), "+v"(qf[3]));
  asm volatile("" : "+v"(krB), "+v"(vrB0), "+v"(vrB1));
  __syncthreads();
#pragma unroll 1
  for (int idx = 0; idx < ntile; idx += 2) {
    if (idx + 2 < ntile) gload(idx + 2, krA, vrA0, vrA1);
    compute(idx, 0);
    lwrite(1, krB, vrB0, vrB1);
    __syncthreads();
    if (idx + 3 < ntile) gload(idx + 3, krB, vrB0, vrB1);
    compute(idx + 1, 1);
    if (idx + 2 < ntile) lwrite(0, krA, vrA0, vrA1);
    __syncthreads();
  }
  linv = frcp(lrun + __shfl_xor(lrun, 32));
}
__device__ void attn_b_block(const Params& p, int layer, int L, int seq, int h, int qblk, LAS unsigned char* lds) {
  const int tid = opaque_tid(), lane = tid & 63, wid = __builtin_amdgcn_readfirstlane(tid >> 6);
  const int q = lane & 31, half = lane >> 5;
  const size_t tokbase = (size_t)seq * L;
  const int tq = qblk * 256 + wid * 32 + q;
  const float slope2 = exp2f(-2.0f * (float)(h + 1)) * LOG2E;
  f32x16 o0[4]; float li0, li1;
  LAS u32x4* park = (LAS u32x4*)(lds + LDS_ATT_END) + wid * 512 + lane;
  attn_b_pass(p, L, seq, h, 0, qblk, tq, tid, slope2, lds, o0, li0);
#pragma unroll
  for (int dt = 0; dt < 4; ++dt)
#pragma unroll
    for (int g2 = 0; g2 < 2; ++g2) {
      u32x4 pk;
#pragma unroll
      for (int k = 0; k < 4; ++k) pk[k] = cvt_pk_bf16(o0[dt][g2 * 8 + 2 * k] * li0, o0[dt][g2 * 8 + 2 * k + 1] * li0);
      park[(dt * 2 + g2) * 64] = pk;
    }
  attn_b_pass(p, L, seq, h, 1, qblk, tq, tid, slope2, lds, o0, li1);
  const float c1 = p.lam[layer] * li1;
  const int tid2 = opaque_tid(), half2 = (tid2 >> 5) & 1;
  const size_t tok2 = (size_t)seq * L + qblk * 256 + (tid2 >> 6) * 32 + (tid2 & 31);
  float ss = 0.f;
#pragma unroll
  for (int dt = 0; dt < 4; ++dt)
#pragma unroll
    for (int g2 = 0; g2 < 2; ++g2) {
      const u32x4 pk = park[(dt * 2 + g2) * 64];
#pragma unroll
      for (int k = 0; k < 4; ++k) {
        const float va = bf_lo(pk[k]) - o0[dt][g2 * 8 + 2 * k] * c1, vb = bf_hi(pk[k]) - o0[dt][g2 * 8 + 2 * k + 1] * c1;
        o0[dt][g2 * 8 + 2 * k] = va; o0[dt][g2 * 8 + 2 * k + 1] = vb; ss += va * va + vb * vb;
      }
    }
  ss += __shfl_xor(ss, 32);
  const float rn = rsqrtf(ss * (1.0f / 128.0f) + 1e-6f) * p.lam[4 + layer];
  const float* gd = p.g_diff + layer * 128;
  bf16_t* yrow = p.yg + tok2 * YW + 512 + h * 128;
  const bf16_t* zrow = p.u + tok2 * UW + U_ZB + h * 128;
#pragma unroll
  for (int dt = 0; dt < 4; ++dt)
#pragma unroll
    for (int g4 = 0; g4 < 4; ++g4) {
      const int dim = dt * 32 + g4 * 8 + half2 * 4;
      const u32x2 zr = *(const u32x2*)(zrow + dim);
      const f32x4 gv = *(const f32x4*)(gd + dim);
      const float y0 = o0[dt][g4 * 4 + 0] * rn * gv[0] * silu(bf_lo(zr[0]));
      const float y1 = o0[dt][g4 * 4 + 1] * rn * gv[1] * silu(bf_hi(zr[0]));
      const float y2 = o0[dt][g4 * 4 + 2] * rn * gv[2] * silu(bf_lo(zr[1]));
      const float y3 = o0[dt][g4 * 4 + 3] * rn * gv[3] * silu(bf_hi(zr[1]));
      u32x2 pk = {cvt_pk_bf16(y0, y1), cvt_pk_bf16(y2, y3)};
      *(u32x2*)(yrow + dim) = pk;
    }
}

constexpr int LDS_AK = 0, LDS_AV = LDS_AK + 2 * KB_BYTES, LDS_ATAB = LDS_AV + 2 * KB_BYTES, ATAB_ROW = 128;
__device__ void attn_a_block(const Params& p, int layer, int L, int seq, int h, int r0, LAS unsigned char* lds) {
  const int tid = opaque_tid(), lane = tid & 63, wid = __builtin_amdgcn_readfirstlane(tid >> 6);
  const int q = lane & 31, half = lane >> 5;
  const size_t tokbase = (size_t)seq * L;
  const int rows = L >> 6;
  const int r = r0 + (wid >> 1), cb2 = wid & 1;
  int rs = r - 4; rs = rs < 0 ? 0 : (rs > rows - 8 ? rows - 8 : rs);
  int kr_lo = r0 - 4; kr_lo = kr_lo < 0 ? 0 : (kr_lo > rows - 8 ? rows - 8 : kr_lo);
  int kr_hi = r0 - 1; kr_hi = (kr_hi < 0 ? 0 : (kr_hi > rows - 8 ? rows - 8 : kr_hi)) + 7;
  const int qcol = cb2 * 32 + q, tq = r * 64 + qcol;
  int qstart = qcol - 8; qstart = qstart < 0 ? 0 : (qstart > 48 ? 48 : qstart);
  bf16x8 qf[4];
  { const bf16_t* qp = p.u + (tokbase + tq) * UW + U_QA + h * 64 + half * 8;
#pragma unroll
    for (int ks = 0; ks < 4; ++ks) qf[ks] = ld16(qp + ks * 16); }
  {
    LAS float* tab = (LAS float*)(lds + LDS_ATAB);
    const float* rpb = p.rpb + ((size_t)layer * 8 + h) * 15 * 31;
    for (int idx = tid; idx < 15 * ATAB_ROW; idx += 512) { const int row = idx >> 7, cc = (idx & 127) - 48; tab[idx] = (cc >= 0 && cc <= 30) ? rpb[row * 31 + cc] * LOG2E : 0.f; }
  }
  const int spart = tid & 7, srow = tid >> 3;
  const bf16_t* kg = p.u + (tokbase + srow) * UW + U_KA + h * 64 + spart * 8;
  const bf16_t* vg = p.vt + ((size_t)seq * VW + V_A + h * 64 + srow) * L + spart * 8;
  const int kst = srow * TB_ROW + spart * 16;
  const int vst = srow * TB_ROW + ((spart >> 1) * 16 + (spart & 1) * 4) * 2;
  const int rd = q * TB_ROW + half * 16;
  f32x16 o[2] = {zero16(), zero16()};
  float mrun = -1e30f, lrun = 0.f;
  bf16x8 kr_, vr_;
  kr_ = ld16(kg + (size_t)(kr_lo * 64) * UW); vr_ = ld16(vg + kr_lo * 64);
  *(LAS bf16x8*)(lds + LDS_AK + kst) = kr_;
  *(LAS bf16x4*)(lds + LDS_AV + vst) = __builtin_shufflevector(vr_, vr_, 0, 1, 2, 3); *(LAS bf16x4*)(lds + LDS_AV + vst + 16) = __builtin_shufflevector(vr_, vr_, 4, 5, 6, 7);
  asm volatile("" : "+v"(qf[0]), "+v"(qf[1]), "+v"(qf[2]), "+v"(qf[3]));
  __syncthreads();
#pragma unroll 1
  for (int kr = kr_lo; kr <= kr_hi; ++kr) {
    const int it = kr - kr_lo;
    const bool more = (kr < kr_hi);
    if (more) { kr_ = ld16(kg + (size_t)((kr + 1) * 64) * UW); vr_ = ld16(vg + (kr + 1) * 64); }
    const LAS unsigned char* kb = lds + LDS_AK + (it & 1) * KB_BYTES;
    const LAS unsigned char* vb = lds + LDS_AV + (it & 1) * KB_BYTES;
    if (kr >= rs && kr < rs + 8) {
      const LAS float* trow = (const LAS float*)(lds + LDS_ATAB) + (kr - r + 7) * ATAB_ROW + (half * 4 - qcol + 15 + 48);
#pragma unroll
      for (int seg = 0; seg < 2; ++seg) {
        f32x16 sc = zero16();
#pragma unroll
        for (int ks = 0; ks < 4; ++ks) sc = mfma32(*(const LAS bf16x8*)(kb + rd + seg * 32 * TB_ROW + ks * 32), qf[ks], sc);
#pragma unroll
        for (int ii = 0; ii < 16; ++ii) {
          const int kcol = seg * 32 + (ii >> 2) * 8 + half * 4 + (ii & 3);
          const bool ok = (kcol >= qstart) && (kcol < qstart + 16);
          sc[ii] = ok ? sc[ii] + trow[seg * 32 + (ii >> 2) * 8 + (ii & 3)] : -INFINITY;
        }
        float al; bf16x8 pk[2];
        softmax_tile(sc, mrun, lrun, al, pk[0], pk[1]);
        if (__builtin_amdgcn_ballot_w64(al != 1.0f) != 0) { o[0] *= al; o[1] *= al; }
#pragma unroll
        for (int dt = 0; dt < 2; ++dt)
#pragma unroll
          for (int s2 = 0; s2 < 2; ++s2) o[dt] = mfma32(*(const LAS bf16x8*)(vb + rd + dt * 32 * TB_ROW + (seg * 2 + s2) * 32), pk[s2], o[dt]);
      }
    }
    if (more) {
      LAS unsigned char* kbn = lds + LDS_AK + ((it + 1) & 1) * KB_BYTES; LAS unsigned char* vbn = lds + LDS_AV + ((it + 1) & 1) * KB_BYTES;
      *(LAS bf16x8*)(kbn + kst) = kr_;
      *(LAS bf16x4*)(vbn + vst) = __builtin_shufflevector(vr_, vr_, 0, 1, 2, 3); *(LAS bf16x4*)(vbn + vst + 16) = __builtin_shufflevector(vr_, vr_, 4, 5, 6, 7);
    }
    __syncthreads();
  }
  const float c = frcp(lrun + __shfl_xor(lrun, 32));
  bf16_t* yrow = p.yg + (tokbase + tq) * YW + h * 64;
  const bf16_t* zrow = p.u + (tokbase + tq) * UW + U_ZA + h * 64;
#pragma unroll
  for (int dt = 0; dt < 2; ++dt)
#pragma unroll
    for (int g4 = 0; g4 < 4; ++g4) {
      const int dim = dt * 32 + g4 * 8 + half * 4;
      const u32x2 zr = *(const u32x2*)(zrow + dim);
      const float y0 = o[dt][g4 * 4 + 0] * c * silu(bf_lo(zr[0]));
      const float y1 = o[dt][g4 * 4 + 1] * c * silu(bf_hi(zr[0]));
      const float y2 = o[dt][g4 * 4 + 2] * c * silu(bf_lo(zr[1]));
      const float y3 = o[dt][g4 * 4 + 3] * c * silu(bf_hi(zr[1]));
      u32x2 pk = {cvt_pk_bf16(y0, y1), cvt_pk_bf16(y2, y3)};
      *(u32x2*)(yrow + dim) = pk;
    }
}

__device__ void attn_c_unit(const Params& p, int L, int lshift, int seq, int g, int h, int rr, int mblk, int lane) {
  const int q = lane & 31, half = lane >> 5;
  const size_t tokbase = (size_t)seq * L;
  const int ds = (g == 0) ? 0 : (g == 1 ? 2 : 4), d = 1 << ds, M = L >> ds;
  const int hh = g * 4 + h;
  const int m0 = mblk * 32, mq = m0 + q, tq = mq * d + rr;
  const bf16_t* urow = p.u + (tokbase + tq) * UW;
  bf16x8 qf[4];
#pragma unroll
  for (int ks = 0; ks < 4; ++ks) qf[ks] = ld16(urow + U_QC + hh * 64 + ks * 16 + half * 8);
  f32x16 o[2] = {zero16(), zero16()};
  float mrun = -1e30f, lrun = 0.f;
  const float coef = exp2f(-(2.0f / 3.0f) * (float)(hh + 1)) * (float)d * LOG2E;
  const bf16_t* vbase = p.vt + ((size_t)seq * VW + V_C + hh * 64 + q) * L + (size_t)rr * M;
  bf16x8 kf[5][4];
#pragma unroll
  for (int j = 0; j < 5; ++j) {
    int mkl = m0 - 64 + 32 * j + q; mkl = mkl < 0 ? 0 : (mkl > M - 1 ? M - 1 : mkl);
    const bf16_t* kp = p.u + (tokbase + (size_t)mkl * d + rr) * UW + U_KC + hh * 64 + half * 8;
#pragma unroll
    for (int ks = 0; ks < 4; ++ks) kf[j][ks] = ld16(kp + ks * 16);
  }
  bf16x8 vf[2][2][2];
  auto load_v = [&](int j, bf16x8 (&dst)[2][2]) {
#pragma unroll
    for (int dt = 0; dt < 2; ++dt)
#pragma unroll
      for (int s2 = 0; s2 < 2; ++s2) {
        int pa = m0 - 64 + 32 * j + s2 * 16 + half * 4, pb = pa + 8;
        pa = pa < 0 ? 0 : (pa > M - 4 ? M - 4 : pa); pb = pb < 0 ? 0 : (pb > M - 4 ? M - 4 : pb);
        const bf16_t* vp = vbase + (size_t)(dt * 32) * L;
        dst[dt][s2] = ld8x2(vp + pa, vp + pb);
      }
  };
  load_v(0, vf[0]);
#pragma unroll
  for (int j = 0; j < 5; ++j) {
    if (j + 1 < 5) load_v(j + 1, vf[(j + 1) & 1]);
    const int mk0 = m0 - 64 + 32 * j;
    if (mk0 + 32 <= 0 || mk0 >= M) continue;
    f32x16 s = zero16();
#pragma unroll
    for (int ks = 0; ks < 4; ++ks) s = mfma32(kf[j][ks], qf[ks], s);
#pragma unroll
    for (int ii = 0; ii < 16; ++ii) {
      const int mk = mk0 + (ii >> 2) * 8 + half * 4 + (ii & 3);
      const int rel = mk - mq; const int ar = rel < 0 ? -rel : rel;
      const bool ok = (mk >= 0) && (mk < M) && (ar <= 64);
      s[ii] = ok ? s[ii] - coef * (float)ar : -INFINITY;
    }
    float alpha; bf16x8 pk[2];
    softmax_tile(s, mrun, lrun, alpha, pk[0], pk[1]);
#pragma unroll
    for (int dt = 0; dt < 2; ++dt) {
      o[dt] *= alpha;
#pragma unroll
      for (int s2 = 0; s2 < 2; ++s2) o[dt] = mfma32(vf[j & 1][dt][s2], pk[s2], o[dt]);
    }
  }
  const float lt = lrun + __shfl_xor(lrun, 32);
  const float c = frcp(lt);
  bf16_t* orow = p.oc + (tokbase + tq) * 768 + hh * 64;
#pragma unroll
  for (int dt = 0; dt < 2; ++dt)
#pragma unroll
    for (int g4 = 0; g4 < 4; ++g4) {
      const int dim = dt * 32 + g4 * 8 + half * 4;
      u32x2 pk = {cvt_pk_bf16(o[dt][g4 * 4 + 0] * c, o[dt][g4 * 4 + 1] * c), cvt_pk_bf16(o[dt][g4 * 4 + 2] * c, o[dt][g4 * 4 + 3] * c)};
      *(u32x2*)(orow + dim) = pk;
    }
  if (half == 0) p.lse[(tokbase + tq) * 12 + hh] = mrun + log2f(lt);
}

constexpr int CV_ROW = 784;
constexpr int LDS_CK = 0, LDS_CV = 384 * TB_ROW;
__device__ void attn_c_block(const Params& p, int L, int lshift, int seq, int g, int h, int pblk, LAS unsigned char* lds) {
  const int tid = opaque_tid(), lane = tid & 63, wid = __builtin_amdgcn_readfirstlane(tid >> 6);
  const int q = lane & 31, half = lane >> 5;
  const size_t tokbase = (size_t)seq * L;
  const int ds = (g == 0) ? 0 : (g == 1 ? 2 : 4), d = 1 << ds, M = L >> ds;
  const int hh = g * 4 + h;
  const int p0 = pblk * 256;
  {
    const int part = tid & 7;
#pragma unroll
    for (int c = 0; c < 6; ++c) {
      const int row = (tid >> 3) + c * 64;
      int pp = p0 - 64 + row; pp = pp < 0 ? 0 : (pp > L - 1 ? L - 1 : pp);
      const int tok = ((pp & (M - 1)) << ds) + (pp >> (lshift - ds));
      const bf16x8 v = ld16(p.u + (tokbase + tok) * UW + U_KC + hh * 64 + part * 8);
      *(LAS bf16x8*)(lds + LDS_CK + row * TB_ROW + part * 16) = v;
    }
#pragma unroll
    for (int c = 0; c < 6; ++c) {
      const int idx = tid + c * 512, dim = idx / 48, c8 = idx % 48;
      int pp = p0 - 64 + c8 * 8; pp = pp < 0 ? 0 : (pp > L - 8 ? L - 8 : pp);
      const bf16x8 v = ld16(p.vt + ((size_t)seq * VW + V_C + hh * 64 + dim) * L + pp);
      LAS unsigned char* dst = lds + LDS_CV + dim * CV_ROW + ((c8 >> 1) * 16 + (c8 & 1) * 4) * 2;
      *(LAS bf16x4*)dst = __builtin_shufflevector(v, v, 0, 1, 2, 3); *(LAS bf16x4*)(dst + 16) = __builtin_shufflevector(v, v, 4, 5, 6, 7);
    }
  }
  const int pw = p0 + wid * 32;
  const int rr = pw >> (lshift - ds), m0 = pw & (M - 1), mq = m0 + q, tq = mq * d + rr;
  bf16x8 qf[4];
  { const bf16_t* qp = p.u + (tokbase + tq) * UW + U_QC + hh * 64 + half * 8;
#pragma unroll
    for (int ks = 0; ks < 4; ++ks) qf[ks] = ld16(qp + ks * 16); }
  f32x16 o[2] = {zero16(), zero16()};
  float mrun = -1e30f, lrun = 0.f;
  const float coef = exp2f(-(2.0f / 3.0f) * (float)(hh + 1)) * (float)d * LOG2E;
  __syncthreads();
#pragma unroll
  for (int j = 0; j < 5; ++j) {
    const int mk0 = m0 - 64 + 32 * j;
    if (mk0 + 32 <= 0 || mk0 >= M) continue;
    const LAS unsigned char* kb = lds + LDS_CK + ((wid + j) * 32 + q) * TB_ROW + half * 16;
    f32x16 sc = zero16();
#pragma unroll
    for (int ks = 0; ks < 4; ++ks) sc = mfma32(*(const LAS bf16x8*)(kb + ks * 32), qf[ks], sc);
#pragma unroll
    for (int ii = 0; ii < 16; ++ii) {
      const int mk = mk0 + (ii >> 2) * 8 + half * 4 + (ii & 3);
      const int rel = mk - mq; const int ar = rel < 0 ? -rel : rel;
      const bool ok = (mk >= 0) && (mk < M) && (ar <= 64);
      sc[ii] = ok ? sc[ii] - coef * (float)ar : -INFINITY;
    }
    float alpha; bf16x8 pk[2];
    softmax_tile(sc, mrun, lrun, alpha, pk[0], pk[1]);
#pragma unroll
    for (int dt = 0; dt < 2; ++dt) {
      o[dt] *= alpha;
#pragma unroll
      for (int s2 = 0; s2 < 2; ++s2)
        o[dt] = mfma32(*(const LAS bf16x8*)(lds + LDS_CV + (dt * 32 + q) * CV_ROW + ((wid + j) * 32 + s2 * 16) * 2 + half * 16), pk[s2], o[dt]);
    }
  }
  __syncthreads();
  const float lt = lrun + __shfl_xor(lrun, 32);
  const float c = frcp(lt);
  bf16_t* orow = p.oc + (tokbase + tq) * 768 + hh * 64;
#pragma unroll
  for (int dt = 0; dt < 2; ++dt)
#pragma unroll
    for (int g4 = 0; g4 < 4; ++g4) {
      const int dim = dt * 32 + g4 * 8 + half * 4;
      u32x2 pk = {cvt_pk_bf16(o[dt][g4 * 4 + 0] * c, o[dt][g4 * 4 + 1] * c), cvt_pk_bf16(o[dt][g4 * 4 + 2] * c, o[dt][g4 * 4 + 3] * c)};
      *(u32x2*)(orow + dim) = pk;
    }
  if (half == 0) p.lse[(tokbase + tq) * 12 + hh] = mrun + log2f(lt);
}

__device__ void phase_attn(const Params& p, int layer, int L, int lshift, LAS unsigned char* lds) {
  const int tiles = L >> 5;
  const int nseq = TC >> lshift;
  const int nw = gridDim.x * 8;
  int w, lane;
  { const int qblks = L >> 8, npairs = nseq * 4, nunits = npairs * qblks;
    for (int b = blockIdx.x; b < nunits; b += gridDim.x) {
      int pair, qblk;
      if ((gridDim.x & 7) == 0 && (npairs & 7) == 0 && nunits == (int)gridDim.x) { const int xcd = b & 7, j = b >> 3; pair = xcd * (npairs >> 3) + j / qblks; qblk = j % qblks; }
      else { pair = b / qblks; qblk = b % qblks; }
      attn_b_block(p, layer, L, pair >> 2, pair & 3, qblk, lds);
    }
  }
  { const int tid = opaque_tid(); lane = tid & 63; w = blockIdx.x * 8 + __builtin_amdgcn_readfirstlane(tid >> 6); }
  {
  { const int rgs = L >> 8, nunits = nseq * 8 * rgs;
    for (int b = blockIdx.x; b < nunits; b += gridDim.x) { const int sh = b / rgs, rg = b % rgs; attn_a_block(p, layer, L, sh >> 3, sh & 7, rg * 4, lds); }
  }
  { const int tid = opaque_tid(); lane = tid & 63; w = blockIdx.x * 8 + __builtin_amdgcn_readfirstlane(tid >> 6); }
  { const int pbs = L >> 8, nunits = nseq * 12 * pbs;
    for (int b = blockIdx.x; b < nunits; b += gridDim.x) {
      const int pblk = b % pbs, sgh = b / pbs;
      const int seq = sgh / 12, gh = sgh % 12;
      attn_c_block(p, L, lshift, seq, gh >> 2, gh & 3, pblk, lds);
    }
  }
  }
}

__device__ void phase_combine(const Params& p) {
  const int gt = blockIdx.x * 512 + opaque_tid(), ngt = gridDim.x * 512;
  for (int it = gt; it < TC * 32; it += ngt) {
    const int tok = it >> 5, sub = it & 31, h = sub >> 3, d8 = (sub & 7) * 8;
    const float* ls = p.lse + (size_t)tok * 12;
    const float l0 = ls[h], l1 = ls[4 + h], l2 = ls[8 + h];
    const float mx = fmaxf(l0, fmaxf(l1, l2));
    const float w0 = fexp2(l0 - mx), w1 = fexp2(l1 - mx), w2 = fexp2(l2 - mx);
    const float inv = frcp(w0 + w1 + w2);
    const bf16_t* ob = p.oc + (size_t)tok * 768 + h * 64 + d8;
    const u32x4 a = *(const u32x4*)ob, b = *(const u32x4*)(ob + 256), c = *(const u32x4*)(ob + 512);
    const u32x4 z = *(const u32x4*)(p.u + (size_t)tok * UW + U_ZC + h * 64 + d8);
    u32x4 r;
#pragma unroll
    for (int k = 0; k < 4; ++k) {
      const float vlo = (w0 * bf_lo(a[k]) + w1 * bf_lo(b[k]) + w2 * bf_lo(c[k])) * inv * silu(bf_lo(z[k]));
      const float vhi = (w0 * bf_hi(a[k]) + w1 * bf_hi(b[k]) + w2 * bf_hi(c[k])) * inv * silu(bf_hi(z[k]));
      r[k] = cvt_pk_bf16(vlo, vhi);
    }
    *(u32x4*)(p.yg + (size_t)tok * YW + 1024 + h * 64 + d8) = r;
  }
}


#define XB_TMO      128
#define XB_XCNT(j)  (256  + 64 * (j))
#define XB_XSUB(j)  (1280 + 64 * (j))
#define XB_XGEN(j)  (2304 + 64 * (j))
#define XB_TOP      3328
#define XB_TOPGEN   3392
#define XCD_BAR_WORDS 3456
#define XB_SPIN_CAP (1u << 18)
__device__ __forceinline__ unsigned xb_ld(unsigned* p)              { return __hip_atomic_load(p, __ATOMIC_RELAXED, __HIP_MEMORY_SCOPE_AGENT); }
__device__ __forceinline__ unsigned xb_add(unsigned* p, unsigned v) { return __hip_atomic_fetch_add(p, v, __ATOMIC_RELAXED, __HIP_MEMORY_SCOPE_AGENT); }
__device__ __forceinline__ unsigned xb_xcc_id() { return (unsigned)__builtin_amdgcn_s_getreg((3 << 11) | 20) & 0xFu; }
#define XB_SPIN(cond, bar) do { unsigned _sp = 0; while (cond) { __builtin_amdgcn_s_sleep(1); \
    if ((++_sp & 255u) == 0u) { if (xb_ld(&(bar)[XB_TMO])) break; if (_sp > XB_SPIN_CAP) { atomicAdd(&(bar)[XB_TMO], 1u); break; } } } } while (0)
struct XcdBarrier { unsigned* bar; unsigned x; volatile LAS unsigned* st; };
__device__ __forceinline__ XcdBarrier xcd_barrier_post(unsigned* bar, volatile LAS unsigned* st) {
  XcdBarrier b; b.bar = bar; b.x = xb_xcc_id(); b.st = st;
  if (opaque_tid() == 0) (void)xb_add(&bar[XB_XCNT(b.x)], 1u);
  return b;
}
__device__ __forceinline__ void xcd_barrier_complete(unsigned* bar, unsigned x, unsigned& nloc, unsigned& nx) {
  const unsigned G = gridDim.x * gridDim.y * gridDim.z;
  unsigned sum, cnt, mine, sp = 0u;
  for (;;) {
    sum = 0u; cnt = 0u; mine = 0u;
#pragma unroll
    for (unsigned j = 0; j < 16; ++j) { const unsigned c = xb_ld(&bar[XB_XCNT(j)]); sum += c; cnt += (c > 0u) ? 1u : 0u; mine = (j == x) ? c : mine; }
    if (sum == G) break;
    __builtin_amdgcn_s_sleep(1);
    if ((++sp & 255u) == 0u) { if (xb_ld(&bar[XB_TMO])) break; if (sp > XB_SPIN_CAP) { atomicAdd(&bar[XB_TMO], 1u); break; } }
  }
  nloc = mine > 0u ? mine : 1u; nx = cnt > 0u ? cnt : 1u;
}
__device__ __forceinline__ void xcd_barrier(const XcdBarrier& b) {
  asm volatile("s_waitcnt vmcnt(0)" ::: "memory");
  __syncthreads();
  if (opaque_tid() == 0) {
    unsigned* bar = b.bar;
    __builtin_amdgcn_s_waitcnt(0);
    unsigned nloc = b.st[0], nx = b.st[1];
    if (nloc == 0u) { xcd_barrier_complete(bar, b.x, nloc, nx); b.st[0] = nloc; b.st[1] = nx; }
    const unsigned old = xb_add(&bar[XB_XSUB(b.x)], 1u);
    const unsigned gen = old / nloc;
    if (old + 1u == (gen + 1u) * nloc) {
      __builtin_amdgcn_fence(__ATOMIC_RELEASE, "agent");
      asm volatile("s_waitcnt vmcnt(0)" ::: "memory");
      const unsigned og = xb_add(&bar[XB_TOP], 1u);
      const unsigned tg = og / nx;
      if (og + 1u == (tg + 1u) * nx) xb_add(&bar[XB_TOPGEN], 1u);
      else XB_SPIN(xb_ld(&bar[XB_TOPGEN]) == tg, bar);
      __builtin_amdgcn_fence(__ATOMIC_ACQUIRE, "agent");
      xb_add(&bar[XB_XGEN(b.x)], 1u);
      asm volatile("s_waitcnt vmcnt(0)" ::: "memory");
    } else {
      XB_SPIN(xb_ld(&bar[XB_XGEN(b.x)]) == gen, bar);
      __builtin_amdgcn_fence(__ATOMIC_ACQUIRE, "agent");
      asm volatile("s_waitcnt vmcnt(0)" ::: "memory");
    }
  }
  __syncthreads();
}

constexpr int DYN_LDS_BYTES = LDS_ATT_TOTAL > pg8::STAGE_BYTES ? LDS_ATT_TOTAL : pg8::STAGE_BYTES;
__global__ void __launch_bounds__(512) fwd_megakernel(Params p) {
  extern __shared__ __attribute__((aligned(16))) unsigned char smem[];
  __shared__ __attribute__((aligned(16))) unsigned xb_words[4];
  cg::grid_group grid = cg::this_grid();
  if (threadIdx.x == 0) { xb_words[0] = 0u; xb_words[1] = 0u; xb_words[2] = 0u; xb_words[3] = 0u; }
  if ((threadIdx.x & 63) == 0) g_wid_table[hw_wave_slot()] = (int)(threadIdx.x >> 6);
  __syncthreads();
  const XcdBarrier xb = xcd_barrier_post(p.bar, (volatile LAS unsigned*)xb_words);
#define GSYNC() xcd_barrier(xb)
  LAS unsigned char* lds = (LAS unsigned char*)smem;
  phase_prep(p, (LAS float*)smem);
  phase_x(p, 0);
  grid.sync();
  for (int chunk = 0; chunk < NCHUNK; ++chunk) {
    const int L = chunk < 2 ? 2048 : 4096, lshift = chunk < 2 ? 11 : 12;
    const float* xin = (chunk < 2) ? p.xp + (size_t)chunk * TC * DM : p.xs + (size_t)(chunk - 2) * TC * DM;
    float* xres = p.out + (size_t)chunk * TC * DM;
    float* ssq = p.ssq + (size_t)chunk * TC * 16;
    for (int layer = 0; layer < DEPTH; ++layer) {
      {
        {
        { pg8::Gemm g{p.xb, p.wt_in + (size_t)layer * INW * DM, TC, UW, DM, 0, lshift};
          pg8::StaticOrder S; S.init(TC, UW, gridDim.x, blockIdx.x);
          EpiU E{p.u, p.rinv + (size_t)chunk * TC, p.b_gate + (size_t)layer * 3 * DM};
          pg8::gemm_phase(lds, g, S, E); }
        {
          pg8::Gemm g{p.wt_in + ((size_t)layer * INW + UW) * DM, p.xb, VW, TC, DM, 1, lshift};
          pg8::StaticOrder S; S.init(VW, TC, gridDim.x, (blockIdx.x + (gridDim.x >> 2)) % gridDim.x);
          EpiVT E{p.vt, p.rinv + (size_t)chunk * TC, L, lshift};
          pg8::gemm_phase(lds, g, S, E); }
        }
      }
      GSYNC();
      phase_attn(p, layer, L, lshift, lds);
      GSYNC();
      phase_combine(p);
      GSYNC();
      {
        pg8::Gemm g{p.yg, p.wt_br + (size_t)layer * DM * YW, TC, DM, YW, 0, 0};
        pg8::StaticOrder S; S.init(TC, DM, gridDim.x, blockIdx.x);
        EpiMerge E{p.u, p.merged};
        pg8::gemm_phase(lds, g, S, E);
      }
      GSYNC();
      {
        pg8::Gemm g{p.merged, p.wt_out + (size_t)layer * DM * DM, TC, DM, DM, 0, 0};
        pg8::StaticOrder S; S.init(TC, DM, gridDim.x, blockIdx.x);
        EpiRes E{layer == 0 ? xin : (const float*)xres, xres, p.xb, ssq};
        pg8::gemm_phase(lds, g, S, E);
      }
      GSYNC();
      if (layer + 1 < DEPTH) { phase_rinv(p, chunk); GSYNC(); }
    }
    phase_final(p, chunk);
    if (chunk + 1 < NCHUNK) { phase_x(p, chunk + 1); GSYNC(); }
  }
}

extern "C" void kernel_launch(void* const* d_in, const int* in_sizes, int n_in, void* d_out, int out_size, void* d_ws, size_t ws_size, hipStream_t stream) {
  (void)in_sizes; (void)n_in; (void)out_size;
  static int grid_blocks = 0;
  if (!grid_blocks) {
    int dev = 0, cus = 0, per_cu = 0;
    hipGetDevice(&dev);
    hipDeviceGetAttribute(&cus, hipDeviceAttributeMultiprocessorCount, dev);
    hipFuncSetAttribute((const void*)fwd_megakernel, hipFuncAttributeMaxDynamicSharedMemorySize, DYN_LDS_BYTES);
    hipOccupancyMaxActiveBlocksPerMultiprocessor(&per_cu, fwd_megakernel, 512, DYN_LDS_BYTES);
    if (per_cu < 1) per_cu = 1;
    grid_blocks = cus * per_cu;
    if (grid_blocks > 256) grid_blocks = 256;
  }
  Params p{};
  p.xp = (const float*)d_in[0]; p.xs = (const float*)d_in[1]; p.g_norm = (const float*)d_in[2]; p.w_in = (const float*)d_in[3];
  p.b_gate = (const float*)d_in[4]; p.rpb = (const float*)d_in[5]; p.lam_qk = (const float*)d_in[6]; p.g_diff = (const float*)d_in[7];
  p.w_br_a = (const float*)d_in[8]; p.w_br_b = (const float*)d_in[9]; p.w_br_c = (const float*)d_in[10]; p.w_out = (const float*)d_in[11];
  p.g_final = (const float*)d_in[12];
  p.out = (float*)d_out;
  char* w = (char*)d_ws; size_t off = 0;
  auto take = [&](size_t bytes) { char* r = w + off; off += (bytes + 255) & ~(size_t)255; return r; };
  p.wt_in = (bf16_t*)take((size_t)DEPTH * INW * DM * 2);
  p.wt_br = (bf16_t*)take((size_t)DEPTH * DM * YW * 2);
  p.wt_out = (bf16_t*)take((size_t)DEPTH * DM * DM * 2);
  p.xb = (bf16_t*)take((size_t)TC * DM * 2);
  p.u = (bf16_t*)take((size_t)TC * UW * 2);
  p.vt = (bf16_t*)take((size_t)TC * VW * 2);
  p.yg = (bf16_t*)take((size_t)TC * YW * 2);
  p.oc = (bf16_t*)take((size_t)TC * 768 * 2);
  p.merged = (bf16_t*)take((size_t)TC * DM * 2);
  p.lse = (float*)take((size_t)TC * 12 * 4);
  p.ssq = (float*)take((size_t)NTOK * 16 * 4);
  p.lam = (float*)take(256);
  p.rinv = (float*)take((size_t)NTOK * 4);
  p.bar = (unsigned*)take((size_t)XCD_BAR_WORDS * 4);
  if (off > ws_size) fprintf(stderr, "workspace too small: need %zu have %zu\n", off, ws_size);
  hipMemsetAsync(p.bar, 0, (size_t)XCD_BAR_WORDS * 4, stream);
  void* args[] = {&p};
  hipError_t e = hipLaunchCooperativeKernel((void*)fwd_megakernel, dim3(grid_blocks), dim3(512), args, DYN_LDS_BYTES, stream);
  if (e != hipSuccess) fprintf(stderr, "cooperative launch failed: %s (grid %d)\n", hipGetErrorString(e), grid_blocks);
}
```

```cpp
#include <hip/hip_runtime.h>
#include <hip/hip_cooperative_groups.h>
#include <cstdio>
namespace cg = cooperative_groups;

#define LAS __attribute__((address_space(3)))
typedef unsigned short bf16_t;
typedef short bf16x8 __attribute__((ext_vector_type(8)));
typedef short bf16x4 __attribute__((ext_vector_type(4)));
typedef float f32x4 __attribute__((ext_vector_type(4)));
typedef float f32x16 __attribute__((ext_vector_type(16)));
typedef unsigned u32x4 __attribute__((ext_vector_type(4)));
typedef unsigned u32x2 __attribute__((ext_vector_type(2)));

constexpr int DM = 1024, DEPTH = 4, INW = 9728, UW = 7936, VW = 1792, YW = 1280;
constexpr int TC = 16384, NCHUNK = 4, NTOK = 65536;
constexpr float LOG2E = 1.4426950408889634f;
constexpr float QSCALE = 0.125f * LOG2E;
constexpr int U_QA = 0, U_KA = 512, U_ZA = 1024, U_QB = 1536, U_KB = 2048, U_ZB = 2560, U_QC = 3072, U_KC = 3840, U_ZC = 4608, U_GL = 4864;
constexpr int V_A = 0, V_B = 512, V_C = 1024;

struct Params {
  const float *xp, *xs, *g_norm, *w_in, *b_gate, *rpb, *lam_qk, *g_diff, *w_br_a, *w_br_b, *w_br_c, *w_out, *g_final;
  float* out;
  bf16_t *wt_in, *wt_br, *wt_out, *xb, *u, *vt, *yg, *oc, *merged;
  float *lse, *ssq, *lam, *rinv;
  unsigned* bar;
};

__device__ __forceinline__ unsigned cvt_pk_bf16(float lo, float hi) { unsigned r; asm volatile("v_cvt_pk_bf16_f32 %0, %1, %2" : "=v"(r) : "v"(lo), "v"(hi)); return r; }
__device__ __forceinline__ float bf_lo(unsigned v) { return __uint_as_float(v << 16); }
__device__ __forceinline__ float bf_hi(unsigned v) { return __uint_as_float(v & 0xffff0000u); }
__device__ __forceinline__ float fexp2(float x) { return __builtin_amdgcn_exp2f(x); }
__device__ __forceinline__ float frcp(float x) { return __builtin_amdgcn_rcpf(x); }

__shared__ int g_wid_table[64];
__device__ __forceinline__ unsigned hw_wave_slot() { return (unsigned)__builtin_amdgcn_s_getreg(((6 - 1) << 11) | (0 << 6) | 4) & 63u; }
__device__ __forceinline__ int opaque_tid() {
  const int wid = __builtin_amdgcn_readfirstlane(g_wid_table[hw_wave_slot()]);
  unsigned z = 0u; asm volatile("" : "+v"(z));
  int t = wid * 64 + (int)__builtin_amdgcn_mbcnt_hi(~0u, __builtin_amdgcn_mbcnt_lo(~0u, z));
  asm volatile("" : "+v"(t)); return t;
}

namespace pg8 {
constexpr int BM = 256, BK = 64, HALF = 128, HTB = HALF * BK * 2, STAGE_BYTES = 8 * HTB, NXCD = 8, WGM = 8;
__device__ __forceinline__ int lds_byte(int r, int c) { const int st = (r >> 4) * 2 + (c >> 5), rr = r & 15, cc = c & 31, ob = rr * 64 + cc * 2; return st * 1024 + (ob ^ (((ob >> 9) & 1) << 5)); }
__device__ __forceinline__ void stage_rc(int b, int& R, int& C) { const int st = b / 1024, sb = b % 1024, swz = sb ^ (((sb >> 9) & 1) << 5); R = (st >> 1) * 16 + swz / 64; C = (st & 1) * 32 + (swz % 64) / 2; }
__device__ __forceinline__ int perm32(int rho) { const int n = rho >> 4, i = rho & 15; return 8 * (i >> 2) + 4 * n + (i & 3); }
struct Unit { int pm, pn; };
struct Gemm { const bf16_t* A; const bf16_t* Bt; int M, N, K; int bperm, lshift; };
struct StaticOrder {
  int nM, nN, nwg, G, c;
  __device__ void init(int M, int N, int G_, int c_) { nM = M / BM; nN = N / BM; nwg = nM * nN; G = G_; c = c_; }
  __device__ bool next(int i, Unit& u) const {
    const long L = (long)i * G + c; if (L >= nwg) return false;
    int wgid = (int)L; { const int q = nwg / NXCD, r = nwg % NXCD, xcd = wgid % NXCD, off = wgid / NXCD; wgid = (xcd < r ? xcd * (q + 1) : r * (q + 1) + (xcd - r) * q) + off; }
    const int nig = WGM * nN, gid = wgid / nig, fm = gid * WGM, gsz = (nM - fm) < WGM ? (nM - fm) : WGM;
    u.pm = fm + ((wgid % nig) % gsz); u.pn = (wgid % nig) / gsz; return true;
  }
};

template <bool BPERM, class Epi>
__device__ __forceinline__ void gemm_phase(LAS unsigned char* lds, const Gemm g, const StaticOrder& S, const Epi& E) {
  const int tid_ = opaque_tid();
  const int tid = tid_, wid = __builtin_amdgcn_readfirstlane(tid >> 6), lane = tid & 63, wr = wid >> 2, wc = wid & 3, fr = lane & 15, fq = lane >> 4;
  const int K = g.K, nt = K / BK;
  const size_t kstep = (size_t)(BK * 2);
  const size_t hstep = (size_t)HALF * K * 2;
  const size_t tstep = 2 * hstep;
  unsigned voffA[2], voffBr[2], voffBc[2], voffB[2], voffBn[2];
#pragma unroll
  for (int i = 0; i < 2; ++i) { int R, C; stage_rc(tid * 16 + i * 8192, R, C); const int Rb = (R & ~31) + perm32(R & 31);
    voffA[i] = (unsigned)(R * K + C) * 2u; voffBr[i] = (unsigned)(Rb * K) * 2u; voffBc[i] = (unsigned)C * 2u; voffB[i] = voffBr[i] + voffBc[i]; voffBn[i] = voffB[i]; }
  auto bbase = [&](const Unit& u, int hh, int& sh) -> const char* {
    if constexpr (!BPERM) { sh = 0; return (const char*)g.Bt + (size_t)u.pn * tstep + (size_t)hh * hstep; }
    const int ds = u.pm <= 4 ? 0 : (u.pm == 5 ? 2 : 4); sh = ds;
    const int L = 1 << g.lshift; const int p0 = u.pn * 256 + hh * 128, seq = p0 >> g.lshift, p = p0 & (L - 1);
    const int Mc = L >> ds, r = p / Mc, m0 = p & (Mc - 1);
    return (const char*)g.Bt + ((size_t)seq * L + ((size_t)m0 << ds) + r) * (size_t)K * 2;
  };
  const unsigned ldsw = (unsigned)wid * 1024u;
  const int aoff = lds_byte(wr * 64 + fr, fq * 8), boff = lds_byte(wc * 32 + fr, fq * 8);
#define PG8_SA(b, h) (((b) * 2 + (h)) * HTB)
#define PG8_SB(b, h) ((4 + (b) * 2 + (h)) * HTB)
#define PG8_STAGE(bufoff, gbase, voff) do { _Pragma("unroll") for (int _i = 0; _i < 2; ++_i) \
    __builtin_amdgcn_global_load_lds((const unsigned*)((const char*)(gbase) + (voff)[_i]), (LAS unsigned*)(lds + (bufoff) + ldsw + _i * 8192), 16, 0, 0); } while (0)
#define PG8_LDA(dst, b, h) do { _Pragma("unroll") for (int m = 0; m < 4; ++m) _Pragma("unroll") for (int k = 0; k < 2; ++k) dst[m][k] = *(const LAS bf16x8*)(lds + PG8_SA(b, h) + aoff + m * 2048 + k * 1024); } while (0)
#define PG8_LDB(dst, b, h) do { _Pragma("unroll") for (int n = 0; n < 2; ++n) _Pragma("unroll") for (int k = 0; k < 2; ++k) dst[n][k] = *(const LAS bf16x8*)(lds + PG8_SB(b, h) + boff + n * 2048 + k * 1024); } while (0)
#define PG8_MMA(ai, bj, At, Bt) do { __builtin_amdgcn_s_setprio(1); _Pragma("unroll") for (int m = 0; m < 4; ++m) _Pragma("unroll") for (int n = 0; n < 2; ++n) _Pragma("unroll") for (int k = 0; k < 2; ++k) \
    acc[ai][bj][m][n] = __builtin_amdgcn_mfma_f32_16x16x32_bf16(Bt[n][k], At[m][k], acc[ai][bj][m][n], 0, 0, 0); __builtin_amdgcn_s_setprio(0); } while (0)
#define PG8_WAIT_V(n) asm volatile("s_waitcnt vmcnt(" #n ")" ::: "memory")
#define PG8_WAIT_L(n) asm volatile("s_waitcnt lgkmcnt(" #n ")" ::: "memory")
#define PG8_BAR __builtin_amdgcn_s_barrier()
#define PG8_SCHED __builtin_amdgcn_sched_barrier(0)
  Unit cur, nxt; int ui = 0;
  if (!S.next(0, cur)) return;
  f32x4 acc[2][2][4][2];
#pragma unroll
  for (int a = 0; a < 2; ++a)
#pragma unroll
    for (int b = 0; b < 2; ++b)
#pragma unroll
      for (int m = 0; m < 4; ++m)
#pragma unroll
        for (int n = 0; n < 2; ++n) acc[a][b][m][n] = (f32x4){0.f, 0.f, 0.f, 0.f};
  bf16x8 At[4][2], B0[2][2], B1[2][2];
  const char* cA = (const char*)g.A + (size_t)cur.pm * tstep;
  int csh; const char* cB0 = bbase(cur, 0, csh); const char* cB1 = bbase(cur, 1, csh);
#pragma unroll
  for (int i = 0; i < 2; ++i) voffB[i] = (voffBr[i] << csh) + voffBc[i];
  PG8_STAGE(PG8_SB(0, 0), cB0, voffB); PG8_STAGE(PG8_SA(0, 0), cA, voffA); PG8_STAGE(PG8_SB(0, 1), cB1, voffB); PG8_STAGE(PG8_SA(0, 1), cA + hstep, voffA);
  if (wr == 1) PG8_BAR;
  PG8_WAIT_V(4); PG8_BAR;
  PG8_STAGE(PG8_SB(1, 0), cB0 + kstep, voffB); PG8_STAGE(PG8_SA(1, 0), cA + kstep, voffA); PG8_STAGE(PG8_SB(1, 1), cB1 + kstep, voffB);
  PG8_WAIT_V(6); PG8_BAR;
  for (;;) {
    const bool has_next = S.next(ui + 1, nxt);
    const char* nA = cA; const char* nB0 = cB0; const char* nB1 = cB1;
#pragma unroll
    for (int i = 0; i < 2; ++i) voffBn[i] = voffB[i];
    if (has_next) { int nsh; nA = (const char*)g.A + (size_t)nxt.pm * tstep; nB0 = bbase(nxt, 0, nsh); nB1 = bbase(nxt, 1, nsh);
#pragma unroll
      for (int i = 0; i < 2; ++i) voffBn[i] = (voffBr[i] << nsh) + voffBc[i]; }
    auto kiter = [&](int t) __attribute__((always_inline)) {
      const bool last = (t == nt - 2);
      const char* a1 = cA + (size_t)(t + 1) * kstep;
      const char* a2 = last ? nA : cA + (size_t)(t + 2) * kstep;
      const char* b20 = last ? nB0 : cB0 + (size_t)(t + 2) * kstep; const char* b21 = last ? nB1 : cB1 + (size_t)(t + 2) * kstep;
      const char* a3 = a2 + kstep; const char* b30 = b20 + kstep; const char* b31 = b21 + kstep;
      unsigned vB[2];
#pragma unroll
      for (int i = 0; i < 2; ++i) vB[i] = BPERM ? (last ? voffBn[i] : voffB[i]) : voffB[i];
      PG8_LDB(B0, 0, 0); PG8_SCHED; PG8_LDA(At, 0, 0); PG8_STAGE(PG8_SA(1, 1), a1 + hstep, voffA);
      PG8_WAIT_L(8); PG8_BAR; PG8_WAIT_L(0); PG8_MMA(0, 0, At, B0); PG8_BAR; PG8_SCHED;
      PG8_LDB(B1, 0, 1); PG8_STAGE(PG8_SB(0, 0), b20, vB);
      PG8_BAR; PG8_WAIT_L(0); PG8_MMA(0, 1, At, B1); PG8_BAR;
      PG8_LDA(At, 0, 1); PG8_STAGE(PG8_SA(0, 0), a2, voffA);
      PG8_BAR; PG8_WAIT_L(0); PG8_MMA(1, 0, At, B0); PG8_BAR; PG8_SCHED;
      PG8_STAGE(PG8_SB(0, 1), b21, vB);
      PG8_WAIT_V(6); PG8_BAR; PG8_MMA(1, 1, At, B1); PG8_BAR;
      PG8_LDB(B0, 1, 0); PG8_SCHED; PG8_LDA(At, 1, 0); PG8_STAGE(PG8_SA(0, 1), a2 + hstep, voffA);
      PG8_WAIT_L(8); PG8_BAR; PG8_WAIT_L(0); PG8_MMA(0, 0, At, B0); PG8_BAR; PG8_SCHED;
      PG8_LDB(B1, 1, 1); PG8_STAGE(PG8_SB(1, 0), b30, vB);
      PG8_BAR; PG8_WAIT_L(0); PG8_MMA(0, 1, At, B1); PG8_BAR;
      PG8_LDA(At, 1, 1); PG8_STAGE(PG8_SA(1, 0), a3, voffA);
      PG8_BAR; PG8_WAIT_L(0); PG8_MMA(1, 0, At, B0); PG8_BAR; PG8_SCHED;
      PG8_STAGE(PG8_SB(1, 1), b31, vB);
      PG8_WAIT_V(6); PG8_BAR; PG8_MMA(1, 1, At, B1); PG8_BAR;
    };
    if constexpr (Epi::HOOK) {
#pragma unroll 1
      for (int seg = 0; seg < 3; ++seg) {
        const int tb = seg * 8, te = seg == 2 ? nt : tb + 8;
#pragma unroll 1
        for (int t = tb; t < te; t += 2) kiter(t);
        if (seg < 2) E.hook(acc, cur, te, wr, wc, fr, fq);
      }
    } else {
      for (int t = 0; t < nt; t += 2) kiter(t);
    }
    E(acc, cur, wr, wc, fr, fq);
    if (!has_next) break;
#pragma unroll
    for (int a = 0; a < 2; ++a)
#pragma unroll
      for (int b = 0; b < 2; ++b)
#pragma unroll
        for (int m = 0; m < 4; ++m)
#pragma unroll
          for (int n = 0; n < 2; ++n) acc[a][b][m][n] = (f32x4){0.f, 0.f, 0.f, 0.f};
    cur = nxt; cA = nA; cB0 = nB0; cB1 = nB1; ++ui;
#pragma unroll
    for (int i = 0; i < 2; ++i) voffB[i] = voffBn[i];
  }
  PG8_WAIT_V(0);
  if (wr == 0) PG8_BAR;
  PG8_BAR;
#undef PG8_SA
#undef PG8_SB
#undef PG8_STAGE
#undef PG8_LDA
#undef PG8_LDB
#undef PG8_MMA
#undef PG8_WAIT_V
#undef PG8_WAIT_L
#undef PG8_BAR
#undef PG8_SCHED
}
}
using pg8::Unit;

struct EpiU {
  static constexpr bool HOOK = false;
  bf16_t* U; const float* rinv; const float* bg;
  __device__ __forceinline__ void hook(f32x4 (&)[2][2][4][2], const Unit&, int, int, int, int, int) const {}
  __device__ __forceinline__ void operator()(const f32x4 (&acc)[2][2][4][2], const Unit& u, int wr, int wc, int fr, int fq) const {
    asm volatile("" : "+v"(fr), "+v"(fq));
    const int row0 = u.pm * 256 + wr * 64 + fr, col0 = u.pn * 256 + wc * 32 + 8 * fq;
    const bool isg = (u.pn >= 19);
    float ri[2][4];
#pragma unroll
    for (int ai = 0; ai < 2; ++ai)
#pragma unroll
      for (int m = 0; m < 4; ++m) ri[ai][m] = rinv[row0 + ai * 128 + m * 16];
    if (isg) {
      f32x4 b[2][2];
#pragma unroll
      for (int bj = 0; bj < 2; ++bj) { const float* bp = bg + (col0 - U_GL) + bj * 128; b[bj][0] = *(const f32x4*)bp; b[bj][1] = *(const f32x4*)(bp + 4); }
#pragma unroll
      for (int ai = 0; ai < 2; ++ai)
#pragma unroll
        for (int m = 0; m < 4; ++m)
#pragma unroll
          for (int bj = 0; bj < 2; ++bj) {
            f32x4 v0 = acc[ai][bj][m][0] * ri[ai][m] + b[bj][0], v1 = acc[ai][bj][m][1] * ri[ai][m] + b[bj][1];
#pragma unroll
            for (int j = 0; j < 4; ++j) { v0[j] = 1.0f + fminf(fexp2(-v0[j] * LOG2E), 1e30f); v1[j] = 1.0f + fminf(fexp2(-v1[j] * LOG2E), 1e30f); }
            u32x4 pk = {cvt_pk_bf16(v0[0], v0[1]), cvt_pk_bf16(v0[2], v0[3]), cvt_pk_bf16(v1[0], v1[1]), cvt_pk_bf16(v1[2], v1[3])};
            *(u32x4*)(U + (size_t)(row0 + ai * 128 + m * 16) * UW + col0 + bj * 128) = pk;
          }
    } else {
#pragma unroll
      for (int ai = 0; ai < 2; ++ai)
#pragma unroll
        for (int m = 0; m < 4; ++m)
#pragma unroll
          for (int bj = 0; bj < 2; ++bj) {
            const f32x4 v0 = acc[ai][bj][m][0] * ri[ai][m], v1 = acc[ai][bj][m][1] * ri[ai][m];
            u32x4 pk = {cvt_pk_bf16(v0[0], v0[1]), cvt_pk_bf16(v0[2], v0[3]), cvt_pk_bf16(v1[0], v1[1]), cvt_pk_bf16(v1[2], v1[3])};
            *(u32x4*)(U + (size_t)(row0 + ai * 128 + m * 16) * UW + col0 + bj * 128) = pk;
          }
    }
  }
};

struct EpiVT {
  static constexpr bool HOOK = false;
  bf16_t* VT; const float* rv; int L, lshift;
  __device__ __forceinline__ void hook(f32x4 (&)[2][2][4][2], const Unit&, int, int, int, int, int) const {}
  __device__ __forceinline__ void operator()(const f32x4 (&acc)[2][2][4][2], const Unit& u, int wr, int wc, int fr, int fq) const {
    asm volatile("" : "+v"(fr), "+v"(fq));
    const int vrow0 = u.pm * 256 + wr * 64 + fr, pcol0 = u.pn * 256 + wc * 32 + 8 * fq;
    const int ds = u.pm <= 4 ? 0 : (u.pm == 5 ? 2 : 4);
    const int Mc = L >> ds;
#pragma unroll
    for (int bj = 0; bj < 2; ++bj) {
      const int p0 = pcol0 + bj * 128, seq = p0 >> lshift, pos = p0 & (L - 1);
      const int r = pos / Mc, m0 = pos & (Mc - 1);
      float rinv[8];
#pragma unroll
      for (int j = 0; j < 8; ++j) rinv[j] = rv[(seq << lshift) + ((m0 + j) << ds) + r];
      bf16_t* vb = VT + ((size_t)seq * VW + vrow0) * L + pos;
#pragma unroll
      for (int ai = 0; ai < 2; ++ai)
#pragma unroll
        for (int m = 0; m < 4; ++m) {
          const f32x4 v0 = acc[ai][bj][m][0], v1 = acc[ai][bj][m][1];
          u32x4 pk = {cvt_pk_bf16(v0[0] * rinv[0], v0[1] * rinv[1]), cvt_pk_bf16(v0[2] * rinv[2], v0[3] * rinv[3]),
                      cvt_pk_bf16(v1[0] * rinv[4], v1[1] * rinv[5]), cvt_pk_bf16(v1[2] * rinv[6], v1[3] * rinv[7])};
          *(u32x4*)(vb + (size_t)(ai * 128 + m * 16) * L) = pk;
        }
    }
  }
};

struct EpiMerge {
  static constexpr bool HOOK = true;
  const bf16_t* U; bf16_t* MG;
  __device__ __forceinline__ f32x4 gvec(int i, size_t row, int col) const {
    const u32x2 raw = *(const u32x2*)(U + row * UW + U_GL + i * 1024 + col);
    f32x4 e; e[0] = bf_lo(raw[0]); e[1] = bf_hi(raw[0]); e[2] = bf_lo(raw[1]); e[3] = bf_hi(raw[1]); return e;
  }
  __device__ __forceinline__ void hook(f32x4 (&acc)[2][2][4][2], const Unit& u, int t, int wr, int wc, int fr, int fq) const {
    const int i = (t == 8) ? 0 : 1;
    asm volatile("" : "+v"(fr), "+v"(fq));
    const int row0 = u.pm * 256 + wr * 64 + fr, col0 = u.pn * 256 + wc * 32 + 8 * fq;
#pragma unroll
    for (int ai = 0; ai < 2; ++ai) {
#pragma unroll
      for (int m = 0; m < 4; ++m)
#pragma unroll
        for (int bj = 0; bj < 2; ++bj) {
          const bf16_t* gp = U + (size_t)(row0 + ai * 128 + m * 16) * UW + U_GL + i * 1024 + col0 + bj * 128;
          const u32x4 a = *(const u32x4*)gp, b = *(const u32x4*)(gp + 1024);
#pragma unroll
          for (int n = 0; n < 2; ++n) {
            f32x4 r;
            r[0] = bf_lo(b[2 * n]) * frcp(bf_lo(a[2 * n])); r[1] = bf_hi(b[2 * n]) * frcp(bf_hi(a[2 * n]));
            r[2] = bf_lo(b[2 * n + 1]) * frcp(bf_lo(a[2 * n + 1])); r[3] = bf_hi(b[2 * n + 1]) * frcp(bf_hi(a[2 * n + 1]));
            acc[ai][bj][m][n] *= r;
          }
        }
      __builtin_amdgcn_sched_barrier(0);
    }
  }
  __device__ __forceinline__ void operator()(const f32x4 (&acc)[2][2][4][2], const Unit& u, int wr, int wc, int fr, int fq) const {
    asm volatile("" : "+v"(fr), "+v"(fq));
    const int row0 = u.pm * 256 + wr * 64 + fr, col0 = u.pn * 256 + wc * 32 + 8 * fq;
    u32x4 g2[2][4][2];
#pragma unroll
    for (int ai = 0; ai < 2; ++ai)
#pragma unroll
      for (int m = 0; m < 4; ++m)
#pragma unroll
        for (int bj = 0; bj < 2; ++bj) g2[ai][m][bj] = *(const u32x4*)(U + (size_t)(row0 + ai * 128 + m * 16) * UW + U_GL + 2 * 1024 + col0 + bj * 128);
    __builtin_amdgcn_sched_barrier(0);
#pragma unroll
    for (int ai = 0; ai < 2; ++ai)
#pragma unroll
      for (int m = 0; m < 4; ++m)
#pragma unroll
        for (int bj = 0; bj < 2; ++bj) {
          const size_t row = (size_t)(row0 + ai * 128 + m * 16); const int col = col0 + bj * 128;
          const u32x4 g = g2[ai][m][bj];
          f32x4 v0 = acc[ai][bj][m][0], v1 = acc[ai][bj][m][1];
          v0[0] *= frcp(bf_lo(g[0])); v0[1] *= frcp(bf_hi(g[0])); v0[2] *= frcp(bf_lo(g[1])); v0[3] *= frcp(bf_hi(g[1]));
          v1[0] *= frcp(bf_lo(g[2])); v1[1] *= frcp(bf_hi(g[2])); v1[2] *= frcp(bf_lo(g[3])); v1[3] *= frcp(bf_hi(g[3]));
          u32x4 pk = {cvt_pk_bf16(v0[0], v0[1]), cvt_pk_bf16(v0[2], v0[3]), cvt_pk_bf16(v1[0], v1[1]), cvt_pk_bf16(v1[2], v1[3])};
          *(u32x4*)(MG + row * DM + col) = pk;
        }
  }
};

struct EpiRes {
  static constexpr bool HOOK = false;
  const float* R; float* X; bf16_t* XB; float* ssq;
  __device__ __forceinline__ void hook(f32x4 (&)[2][2][4][2], const Unit&, int, int, int, int, int) const {}
  __device__ __forceinline__ void operator()(const f32x4 (&acc)[2][2][4][2], const Unit& u, int wr, int wc, int fr, int fq) const {
    asm volatile("" : "+v"(fr), "+v"(fq));
    const int row0 = u.pm * 256 + wr * 64 + fr, col0 = u.pn * 256 + wc * 32 + 8 * fq;
#pragma unroll
    for (int ai = 0; ai < 2; ++ai) {
      f32x4 r[4][2][2];
#pragma unroll
      for (int m = 0; m < 4; ++m)
#pragma unroll
        for (int bj = 0; bj < 2; ++bj) { const float* rp = R + (size_t)(row0 + ai * 128 + m * 16) * DM + col0 + bj * 128; r[m][bj][0] = *(const f32x4*)rp; r[m][bj][1] = *(const f32x4*)(rp + 4); }
      __builtin_amdgcn_sched_barrier(0);
#pragma unroll
      for (int m = 0; m < 4; ++m) {
        const size_t row = (size_t)(row0 + ai * 128 + m * 16);
        float s = 0.f;
#pragma unroll
        for (int bj = 0; bj < 2; ++bj) {
          const int col = col0 + bj * 128;
          const f32x4 v0 = r[m][bj][0] + acc[ai][bj][m][0], v1 = r[m][bj][1] + acc[ai][bj][m][1];
          *(f32x4*)(X + row * DM + col) = v0; *(f32x4*)(X + row * DM + col + 4) = v1;
          s += v0[0] * v0[0] + v0[1] * v0[1] + v0[2] * v0[2] + v0[3] * v0[3] + v1[0] * v1[0] + v1[1] * v1[1] + v1[2] * v1[2] + v1[3] * v1[3];
          u32x4 pk = {cvt_pk_bf16(v0[0], v0[1]), cvt_pk_bf16(v0[2], v0[3]), cvt_pk_bf16(v1[0], v1[1]), cvt_pk_bf16(v1[2], v1[3])};
          *(u32x4*)(XB + row * DM + col) = pk;
        }
        s += __shfl_xor(s, 16); s += __shfl_xor(s, 32);
        if (fq == 0) ssq[row * 16 + u.pn * 4 + wc] = s;
      }
      __builtin_amdgcn_sched_barrier(0);
    }
  }
};

__device__ __forceinline__ void prep_tile(const float* src, int ldn, int k0, int n0, const float* rscale, float cscale, bf16_t* dst, int ldd, int drow0, int dk0, LAS float* tile) {
  const int tid = opaque_tid(), kk = tid >> 6, nn = tid & 63;
#pragma unroll
  for (int i = 0; i < 8; ++i) {
    const int k = kk * 8 + i;
    float v = src[(size_t)(k0 + k) * ldn + n0 + nn] * cscale;
    if (rscale) v *= rscale[k0 + k];
    tile[k * 65 + nn] = v;
  }
  __syncthreads();
  const int n = tid >> 3, kc = tid & 7;
  float f[8];
#pragma unroll
  for (int j = 0; j < 8; ++j) f[j] = tile[(kc * 8 + j) * 65 + n];
  u32x4 pk = {cvt_pk_bf16(f[0], f[1]), cvt_pk_bf16(f[2], f[3]), cvt_pk_bf16(f[4], f[5]), cvt_pk_bf16(f[6], f[7])};
  *(u32x4*)(dst + (size_t)(drow0 + n) * ldd + dk0 + kc * 8) = pk;
  __syncthreads();
}

__device__ __forceinline__ void win_map(int n0, int& dn0, float& sc) {
  sc = 1.0f;
  if (n0 < 512) { dn0 = U_QA + n0; sc = QSCALE; }
  else if (n0 < 1024) dn0 = U_KA + (n0 - 512);
  else if (n0 < 1536) dn0 = UW + V_A + (n0 - 1024);
  else if (n0 < 2048) dn0 = U_ZA + (n0 - 1536);
  else if (n0 < 2560) { dn0 = U_QB + (n0 - 2048); sc = QSCALE; }
  else if (n0 < 3072) dn0 = U_KB + (n0 - 2560);
  else if (n0 < 3584) dn0 = UW + V_B + (n0 - 3072);
  else if (n0 < 4096) dn0 = U_ZB + (n0 - 3584);
  else if (n0 < 4864) { dn0 = U_QC + (n0 - 4096); sc = QSCALE; }
  else if (n0 < 5632) dn0 = U_KC + (n0 - 4864);
  else if (n0 < 6400) dn0 = UW + V_C + (n0 - 5632);
  else if (n0 < 6656) dn0 = U_ZC + (n0 - 6400);
  else dn0 = U_GL + (n0 - 6656);
}

__device__ void phase_prep(const Params& p, LAS float* tile) {
  constexpr int PER = 3008;
  for (int it = blockIdx.x; it < DEPTH * PER; it += gridDim.x) {
    const int l = it / PER; int r = it % PER;
    if (r < 2432) {
      const int kt = r / 152, ntile = r % 152; int dn0; float sc; win_map(ntile * 64, dn0, sc);
      prep_tile(p.w_in + (size_t)l * DM * INW, INW, kt * 64, ntile * 64, p.g_norm + l * DM, sc, p.wt_in + (size_t)l * INW * DM, DM, dn0, kt * 64, tile);
    } else if ((r -= 2432) < 128) {
      const int kt = r / 16, ntile = r % 16;
      prep_tile(p.w_br_a + (size_t)l * 512 * DM, DM, kt * 64, ntile * 64, nullptr, 1.0f, p.wt_br + (size_t)l * DM * YW, YW, ntile * 64, kt * 64, tile);
    } else if ((r -= 128) < 128) {
      const int kt = r / 16, ntile = r % 16;
      prep_tile(p.w_br_b + (size_t)l * 512 * DM, DM, kt * 64, ntile * 64, nullptr, 1.0f, p.wt_br + (size_t)l * DM * YW, YW, ntile * 64, 512 + kt * 64, tile);
    } else if ((r -= 128) < 64) {
      const int kt = r / 16, ntile = r % 16;
      prep_tile(p.w_br_c + (size_t)l * 256 * DM, DM, kt * 64, ntile * 64, nullptr, 1.0f, p.wt_br + (size_t)l * DM * YW, YW, ntile * 64, 1024 + kt * 64, tile);
    } else {
      r -= 64; const int kt = r / 16, ntile = r % 16;
      prep_tile(p.w_out + (size_t)l * DM * DM, DM, kt * 64, ntile * 64, nullptr, 1.0f, p.wt_out + (size_t)l * DM * DM, DM, ntile * 64, kt * 64, tile);
    }
  }
  const int ptid = opaque_tid();
  if (blockIdx.x == 0 && ptid < 64) {
    const int lane = ptid;
    for (int l = 0; l < DEPTH; ++l) {
      const float* lq = p.lam_qk + l * 256;
      float a = lq[lane] * lq[64 + lane], b = lq[128 + lane] * lq[192 + lane];
      for (int o = 32; o >= 1; o >>= 1) { a += __shfl_xor(a, o); b += __shfl_xor(b, o); }
      if (lane == 0) { const float li = 0.8f - 0.6f * expf(-0.3f * (float)l); p.lam[l] = expf(a) - expf(b) + li; p.lam[4 + l] = 1.0f - li; }
    }
  }
}

__device__ void phase_x(const Params& p, int chunk) {
  const float* xin = (chunk < 2) ? p.xp + (size_t)chunk * TC * DM : p.xs + (size_t)(chunk - 2) * TC * DM;
  float* ssq = p.ssq + (size_t)chunk * TC * 16;
  const int tid = opaque_tid(), lane = tid & 63, w = blockIdx.x * 8 + (tid >> 6), nw = gridDim.x * 8;
  for (int row = w; row < TC; row += nw) {
    const float* xr = xin + (size_t)row * DM + lane * 16;
    f32x4 v[4]; float s = 0.f;
#pragma unroll
    for (int i = 0; i < 4; ++i) { v[i] = *(const f32x4*)(xr + i * 4); s += v[i][0] * v[i][0] + v[i][1] * v[i][1] + v[i][2] * v[i][2] + v[i][3] * v[i][3]; }
    for (int o = 32; o >= 1; o >>= 1) s += __shfl_xor(s, o);
    u32x4 p0 = {cvt_pk_bf16(v[0][0], v[0][1]), cvt_pk_bf16(v[0][2], v[0][3]), cvt_pk_bf16(v[1][0], v[1][1]), cvt_pk_bf16(v[1][2], v[1][3])};
    u32x4 p1 = {cvt_pk_bf16(v[2][0], v[2][1]), cvt_pk_bf16(v[2][2], v[2][3]), cvt_pk_bf16(v[3][0], v[3][1]), cvt_pk_bf16(v[3][2], v[3][3])};
    bf16_t* xo = p.xb + (size_t)row * DM + lane * 16;
    *(u32x4*)xo = p0; *(u32x4*)(xo + 8) = p1;
    if (lane < 16) ssq[(size_t)row * 16 + lane] = (lane == 0) ? s : 0.f;
    if (lane == 0) p.rinv[(size_t)chunk * TC + row] = rsqrtf(s * (1.0f / 1024.0f) + 1e-6f);
  }
}

__device__ void phase_rinv(const Params& p, int chunk) {
  const float* ssq = p.ssq + (size_t)chunk * TC * 16; float* rv = p.rinv + (size_t)chunk * TC;
  for (int row = blockIdx.x * 512 + opaque_tid(); row < TC; row += gridDim.x * 512) {
    const f32x4* sp = (const f32x4*)(ssq + (size_t)row * 16);
    const f32x4 a4 = sp[0] + sp[1] + sp[2] + sp[3];
    rv[row] = rsqrtf((a4[0] + a4[1] + a4[2] + a4[3]) * (1.0f / 1024.0f) + 1e-6f);
  }
}

__device__ void phase_final(const Params& p, int chunk) {
  float* x = p.out + (size_t)chunk * TC * DM;
  const float* ssq = p.ssq + (size_t)chunk * TC * 16;
  const int tid = opaque_tid(), lane = tid & 63, w = blockIdx.x * 8 + (tid >> 6), nw = gridDim.x * 8;
  for (int row = w; row < TC; row += nw) {
    const f32x4* sp = (const f32x4*)(ssq + (size_t)row * 16);
    const f32x4 a4 = sp[0] + sp[1] + sp[2] + sp[3];
    const float rinv = rsqrtf((a4[0] + a4[1] + a4[2] + a4[3]) * (1.0f / 1024.0f) + 1e-6f);
    float* xr = x + (size_t)row * DM + lane * 16;
#pragma unroll
    for (int i = 0; i < 4; ++i) { f32x4 v = *(const f32x4*)(xr + i * 4); const f32x4 g = *(const f32x4*)(p.g_final + lane * 16 + i * 4); v = v * rinv * g; *(f32x4*)(xr + i * 4) = v; }
  }
}

__device__ __forceinline__ f32x16 mfma32(bf16x8 a, bf16x8 b, f32x16 c) { return __builtin_amdgcn_mfma_f32_32x32x16_bf16(a, b, c, 0, 0, 0); }
__device__ __forceinline__ bf16x8 ld16(const bf16_t* p) { return *(const bf16x8*)p; }
__device__ __forceinline__ bf16x8 ld8x2(const bf16_t* p0, const bf16_t* p1) { const bf16x4 a = *(const bf16x4*)p0, b = *(const bf16x4*)p1; return __builtin_shufflevector(a, b, 0, 1, 2, 3, 4, 5, 6, 7); }

__device__ __forceinline__ void softmax_tile(f32x16& t, float& m, float& l, float& alpha, bf16x8& p0, bf16x8& p1) {
  float tm = t[0];
#pragma unroll
  for (int i = 1; i < 16; ++i) tm = fmaxf(tm, t[i]);
  tm = fmaxf(tm, __shfl_xor(tm, 32));
  const float mn = fmaxf(m, tm);
  alpha = fexp2(m - mn); m = mn;
  float ls = 0.f;
#pragma unroll
  for (int i = 0; i < 16; ++i) { t[i] = fexp2(t[i] - mn); ls += t[i]; }
  l = l * alpha + ls;
  const u32x4 a = {cvt_pk_bf16(t[0], t[1]), cvt_pk_bf16(t[2], t[3]), cvt_pk_bf16(t[4], t[5]), cvt_pk_bf16(t[6], t[7])};
  const u32x4 b = {cvt_pk_bf16(t[8], t[9]), cvt_pk_bf16(t[10], t[11]), cvt_pk_bf16(t[12], t[13]), cvt_pk_bf16(t[14], t[15])};
  p0 = __builtin_bit_cast(bf16x8, a); p1 = __builtin_bit_cast(bf16x8, b);
}
__device__ __forceinline__ f32x16 zero16() { f32x16 z;
#pragma unroll
  for (int i = 0; i < 16; ++i) z[i] = 0.f; return z; }
__device__ __forceinline__ float silu(float z) { return z * frcp(1.0f + fexp2(-z * LOG2E)); }

constexpr int TB_ROW = 144;
constexpr int KB_BYTES = 64 * TB_ROW;
constexpr int VB_BYTES = 128 * TB_ROW;
constexpr int LDS_K = 0, LDS_V = LDS_K + 2 * KB_BYTES, LDS_ATT_END = LDS_V + 2 * VB_BYTES, LDS_ATT_TOTAL = LDS_ATT_END + 65536;
template <int SIDE>
__device__ __forceinline__ void b_far_subtile(const LAS unsigned char* kb, const LAS unsigned char* vb, int rd, int sub, const bf16x8 (&qf)[4], const f32x16& bp, float slope2, float d0,
                                              float& mrun, float& lrun, f32x16 (&o)[4]) {
  const float base = (SIDE > 0 ? -slope2 : slope2) * d0 - mrun;
  f32x16 sc;
#pragma unroll
  for (int i = 0; i < 16; ++i) sc[i] = SIDE > 0 ? base - bp[i] : base + bp[i];
#pragma unroll
  for (int ks = 0; ks < 4; ++ks) sc = mfma32(*(const LAS bf16x8*)(kb + rd + sub * 32 * TB_ROW + ks * 32), qf[ks], sc);
  float tm = sc[0];
#pragma unroll
  for (int i = 1; i < 16; ++i) tm = fmaxf(tm, sc[i]);
  tm = fmaxf(tm, __shfl_xor(tm, 32));
  if (__builtin_amdgcn_ballot_w64(tm > 0.0f) != 0) {
    const float delta = fmaxf(tm, 0.0f);
    const float al = fexp2(-delta);
    mrun += delta; lrun *= al;
#pragma unroll
    for (int i = 0; i < 16; ++i) sc[i] -= delta;
#pragma unroll
    for (int dt = 0; dt < 4; ++dt) o[dt] *= al;
  }
#pragma unroll
  for (int i = 0; i < 16; ++i) sc[i] = fexp2(sc[i]);
  { const f32x4 a4 = (f32x4){sc[0], sc[1], sc[2], sc[3]} + (f32x4){sc[4], sc[5], sc[6], sc[7]} + (f32x4){sc[8], sc[9], sc[10], sc[11]} + (f32x4){sc[12], sc[13], sc[14], sc[15]};
    lrun += (a4[0] + a4[1]) + (a4[2] + a4[3]); }
  const u32x4 pa = {cvt_pk_bf16(sc[0], sc[1]), cvt_pk_bf16(sc[2], sc[3]), cvt_pk_bf16(sc[4], sc[5]), cvt_pk_bf16(sc[6], sc[7])};
  const u32x4 pb = {cvt_pk_bf16(sc[8], sc[9]), cvt_pk_bf16(sc[10], sc[11]), cvt_pk_bf16(sc[12], sc[13]), cvt_pk_bf16(sc[14], sc[15])};
  const bf16x8 pk0 = __builtin_bit_cast(bf16x8, pa), pk1 = __builtin_bit_cast(bf16x8, pb);
#pragma unroll
  for (int dt = 0; dt < 4; ++dt) {
    o[dt] = mfma32(*(const LAS bf16x8*)(vb + rd + dt * 32 * TB_ROW + (sub * 2) * 32), pk0, o[dt]);
    o[dt] = mfma32(*(const LAS bf16x8*)(vb + rd + dt * 32 * TB_ROW + (sub * 2 + 1) * 32), pk1, o[dt]);
  }
}

__device__ __forceinline__ void attn_b_pass(const Params& p, int L, int seq, int h, int mp, int qblk, int tq, int tid, float slope2, LAS unsigned char* lds, f32x16 (&o)[4], float& linv) {
  const int lane = tid & 63, q = lane & 31, half = lane >> 5;
  const size_t tokbase = (size_t)seq * L;
  bf16x8 qf[4];
  { const bf16_t* qp = p.u + (tokbase + tq) * UW + U_QB + h * 128 + mp * 64 + half * 8;
#pragma unroll
    for (int ks = 0; ks < 4; ++ks) qf[ks] = ld16(qp + ks * 16); }
  const int spart = tid & 7, srow = tid >> 3;
  const bf16_t* kg = p.u + (tokbase + srow) * UW + U_KB + h * 128 + mp * 64 + spart * 8;
  const bf16_t* vg = p.vt + ((size_t)seq * VW + V_B + h * 128 + srow) * L + spart * 8;
  const int kst = srow * TB_ROW + spart * 16;
  const int vst = srow * TB_ROW + ((spart >> 1) * 16 + (spart & 1) * 4) * 2;
  const int rd = q * TB_ROW + half * 16;
#pragma unroll
  for (int dt = 0; dt < 4; ++dt) o[dt] = zero16();
  float mrun = -1e30f, lrun = 0.f;
  f32x16 bp;
#pragma unroll
  for (int i = 0; i < 16; ++i) bp[i] = slope2 * (float)((i >> 2) * 8 + (i & 3));
  const int ntile = L >> 6, t0 = qblk * 4, nR = ntile - t0;
  auto tile_of = [&](int idx) { return idx < nR ? t0 + idx : (t0 - 1) - (idx - nR); };
  bf16x8 krA, vrA0, vrA1, krB, vrB0, vrB1;
  auto gload = [&](int idx, bf16x8& kr, bf16x8& v0, bf16x8& v1) { const int kn = tile_of(idx) * 64; kr = ld16(kg + (size_t)kn * UW); v0 = ld16(vg + kn); v1 = ld16(vg + (size_t)64 * L + kn); };
  auto lwrite = [&](int buf, const bf16x8& kr, const bf16x8& v0, const bf16x8& v1) {
    LAS unsigned char* kb = lds + LDS_K + buf * KB_BYTES; LAS unsigned char* vb = lds + LDS_V + buf * VB_BYTES;
    *(LAS bf16x8*)(kb + kst) = kr;
    *(LAS bf16x4*)(vb + vst) = __builtin_shufflevector(v0, v0, 0, 1, 2, 3); *(LAS bf16x4*)(vb + vst + 16) = __builtin_shufflevector(v0, v0, 4, 5, 6, 7);
    *(LAS bf16x4*)(vb + vst + 64 * TB_ROW) = __builtin_shufflevector(v1, v1, 0, 1, 2, 3); *(LAS bf16x4*)(vb + vst + 64 * TB_ROW + 16) = __builtin_shufflevector(v1, v1, 4, 5, 6, 7);
  };
  auto compute = [&](int idx, int buf) {
    const int k0 = tile_of(idx) * 64;
    const LAS unsigned char* kb = lds + LDS_K + buf * KB_BYTES;
    const LAS unsigned char* vb = lds + LDS_V + buf * VB_BYTES;
    if (idx < 4) {
#pragma unroll
      for (int sub = 0; sub < 2; ++sub) {
        f32x16 sc = zero16();
#pragma unroll
        for (int ks = 0; ks < 4; ++ks) sc = mfma32(*(const LAS bf16x8*)(kb + rd + sub * 32 * TB_ROW + ks * 32), qf[ks], sc);
        const float d0 = (float)(k0 + sub * 32 + half * 4 - tq);
#pragma unroll
        for (int i = 0; i < 16; ++i) sc[i] -= slope2 * fabsf(d0 + (float)((i >> 2) * 8 + (i & 3)));
        float al; bf16x8 pk[2];
        softmax_tile(sc, mrun, lrun, al, pk[0], pk[1]);
        if (__builtin_amdgcn_ballot_w64(al != 1.0f) != 0) {
#pragma unroll
          for (int dt = 0; dt < 4; ++dt) o[dt] *= al;
        }
#pragma unroll
        for (int dt = 0; dt < 4; ++dt)
#pragma unroll
          for (int s2 = 0; s2 < 2; ++s2) o[dt] = mfma32(*(const LAS bf16x8*)(vb + rd + dt * 32 * TB_ROW + (sub * 2 + s2) * 32), pk[s2], o[dt]);
      }
    } else if (idx < nR) {
#pragma unroll
      for (int sub = 0; sub < 2; ++sub) b_far_subtile<1>(kb, vb, rd, sub, qf, bp, slope2, (float)(k0 + sub * 32 + half * 4 - tq), mrun, lrun, o);
    } else {
#pragma unroll
      for (int sub = 0; sub < 2; ++sub) b_far_subtile<-1>(kb, vb, rd, sub, qf, bp, slope2, (float)(k0 + sub * 32 + half * 4 - tq), mrun, lrun, o);
    }
  };
  gload(0, krA, vrA0, vrA1);
  gload(1, krB, vrB0, vrB1);
  lwrite(0, krA, vrA0, vrA1);
  asm volatile("" : "+v"(qf[0]), "+v"(qf[1]), "+v"(qf[2]), "+v"(qf[3]));
  asm volatile("" : "+v"(krB), "+v"(vrB0), "+v"(vrB1));
  __syncthreads();
#pragma unroll 1
  for (int idx = 0; idx < ntile; idx += 2) {
    if (idx + 2 < ntile) gload(idx + 2, krA, vrA0, vrA1);
    compute(idx, 0);
    lwrite(1, krB, vrB0, vrB1);
    __syncthreads();
    if (idx + 3 < ntile) gload(idx + 3, krB, vrB0, vrB1);
    compute(idx + 1, 1);
    if (idx + 2 < ntile) lwrite(0, krA, vrA0, vrA1);
    __syncthreads();
  }
  linv = frcp(lrun + __shfl_xor(lrun, 32));
}
__device__ void attn_b_block(const Params& p, int layer, int L, int seq, int h, int qblk, LAS unsigned char* lds) {
  const int tid = opaque_tid(), lane = tid & 63, wid = __builtin_amdgcn_readfirstlane(tid >> 6);
  const int q = lane & 31, half = lane >> 5;
  const size_t tokbase = (size_t)seq * L;
  const int tq = qblk * 256 + wid * 32 + q;
  const float slope2 = exp2f(-2.0f * (float)(h + 1)) * LOG2E;
  f32x16 o0[4]; float li0, li1;
  LAS u32x4* park = (LAS u32x4*)(lds + LDS_ATT_END) + wid * 512 + lane;
  attn_b_pass(p, L, seq, h, 0, qblk, tq, tid, slope2, lds, o0, li0);
#pragma unroll
  for (int dt = 0; dt < 4; ++dt)
#pragma unroll
    for (int g2 = 0; g2 < 2; ++g2) {
      u32x4 pk;
#pragma unroll
      for (int k = 0; k < 4; ++k) pk[k] = cvt_pk_bf16(o0[dt][g2 * 8 + 2 * k] * li0, o0[dt][g2 * 8 + 2 * k + 1] * li0);
      park[(dt * 2 + g2) * 64] = pk;
    }
  attn_b_pass(p, L, seq, h, 1, qblk, tq, tid, slope2, lds, o0, li1);
  const float c1 = p.lam[layer] * li1;
  const int tid2 = opaque_tid(), half2 = (tid2 >> 5) & 1;
  const size_t tok2 = (size_t)seq * L + qblk * 256 + (tid2 >> 6) * 32 + (tid2 & 31);
  float ss = 0.f;
#pragma unroll
  for (int dt = 0; dt < 4; ++dt)
#pragma unroll
    for (int g2 = 0; g2 < 2; ++g2) {
      const u32x4 pk = park[(dt * 2 + g2) * 64];
#pragma unroll
      for (int k = 0; k < 4; ++k) {
        const float va = bf_lo(pk[k]) - o0[dt][g2 * 8 + 2 * k] * c1, vb = bf_hi(pk[k]) - o0[dt][g2 * 8 + 2 * k + 1] * c1;
        o0[dt][g2 * 8 + 2 * k] = va; o0[dt][g2 * 8 + 2 * k + 1] = vb; ss += va * va + vb * vb;
      }
    }
  ss += __shfl_xor(ss, 32);
  const float rn = rsqrtf(ss * (1.0f / 128.0f) + 1e-6f) * p.lam[4 + layer];
  const float* gd = p.g_diff + layer * 128;
  bf16_t* yrow = p.yg + tok2 * YW + 512 + h * 128;
  const bf16_t* zrow = p.u + tok2 * UW + U_ZB + h * 128;
#pragma unroll
  for (int dt = 0; dt < 4; ++dt)
#pragma unroll
    for (int g4 = 0; g4 < 4; ++g4) {
      const int dim = dt * 32 + g4 * 8 + half2 * 4;
      const u32x2 zr = *(const u32x2*)(zrow + dim);
      const f32x4 gv = *(const f32x4*)(gd + dim);
      const float y0 = o0[dt][g4 * 4 + 0] * rn * gv[0] * silu(bf_lo(zr[0]));
      const float y1 = o0[dt][g4 * 4 + 1] * rn * gv[1] * silu(bf_hi(zr[0]));
      const float y2 = o0[dt][g4 * 4 + 2] * rn * gv[2] * silu(bf_lo(zr[1]));
      const float y3 = o0[dt][g4 * 4 + 3] * rn * gv[3] * silu(bf_hi(zr[1]));
      u32x2 pk = {cvt_pk_bf16(y0, y1), cvt_pk_bf16(y2, y3)};
      *(u32x2*)(yrow + dim) = pk;
    }
}

constexpr int LDS_AK = 0, LDS_AV = LDS_AK + 2 * KB_BYTES, LDS_ATAB = LDS_AV + 2 * KB_BYTES, ATAB_ROW = 128;
__device__ void attn_a_block(const Params& p, int layer, int L, int seq, int h, int r0, LAS unsigned char* lds) {
  const int tid = opaque_tid(), lane = tid & 63, wid = __builtin_amdgcn_readfirstlane(tid >> 6);
  const int q = lane & 31, half = lane >> 5;
  const size_t tokbase = (size_t)seq * L;
  const int rows = L >> 6;
  const int r = r0 + (wid >> 1), cb2 = wid & 1;
  int rs = r - 4; rs = rs < 0 ? 0 : (rs > rows - 8 ? rows - 8 : rs);
  int kr_lo = r0 - 4; kr_lo = kr_lo < 0 ? 0 : (kr_lo > rows - 8 ? rows - 8 : kr_lo);
  int kr_hi = r0 - 1; kr_hi = (kr_hi < 0 ? 0 : (kr_hi > rows - 8 ? rows - 8 : kr_hi)) + 7;
  const int qcol = cb2 * 32 + q, tq = r * 64 + qcol;
  int qstart = qcol - 8; qstart = qstart < 0 ? 0 : (qstart > 48 ? 48 : qstart);
  bf16x8 qf[4];
  { const bf16_t* qp = p.u + (tokbase + tq) * UW + U_QA + h * 64 + half * 8;
#pragma unroll
    for (int ks = 0; ks < 4; ++ks) qf[ks] = ld16(qp + ks * 16); }
  {
    LAS float* tab = (LAS float*)(lds + LDS_ATAB);
    const float* rpb = p.rpb + ((size_t)layer * 8 + h) * 15 * 31;
    for (int idx = tid; idx < 15 * ATAB_ROW; idx += 512) { const int row = idx >> 7, cc = (idx & 127) - 48; tab[idx] = (cc >= 0 && cc <= 30) ? rpb[row * 31 + cc] * LOG2E : 0.f; }
  }
  const int spart = tid & 7, srow = tid >> 3;
  const bf16_t* kg = p.u + (tokbase + srow) * UW + U_KA + h * 64 + spart * 8;
  const bf16_t* vg = p.vt + ((size_t)seq * VW + V_A + h * 64 + srow) * L + spart * 8;
  const int kst = srow * TB_ROW + spart * 16;
  const int vst = srow * TB_ROW + ((spart >> 1) * 16 + (spart & 1) * 4) * 2;
  const int rd = q * TB_ROW + half * 16;
  f32x16 o[2] = {zero16(), zero16()};
  float mrun = -1e30f, lrun = 0.f;
  bf16x8 kr_, vr_;
  kr_ = ld16(kg + (size_t)(kr_lo * 64) * UW); vr_ = ld16(vg + kr_lo * 64);
  *(LAS bf16x8*)(lds + LDS_AK + kst) = kr_;
  *(LAS bf16x4*)(lds + LDS_AV + vst) = __builtin_shufflevector(vr_, vr_, 0, 1, 2, 3); *(LAS bf16x4*)(lds + LDS_AV + vst + 16) = __builtin_shufflevector(vr_, vr_, 4, 5, 6, 7);
  asm volatile("" : "+v"(qf[0]), "+v"(qf[1]), "+v"(qf[2]), "+v"(qf[3]));
  __syncthreads();
#pragma unroll 1
  for (int kr = kr_lo; kr <= kr_hi; ++kr) {
    const int it = kr - kr_lo;
    const bool more = (kr < kr_hi);
    if (more) { kr_ = ld16(kg + (size_t)((kr + 1) * 64) * UW); vr_ = ld16(vg + (kr + 1) * 64); }
    const LAS unsigned char* kb = lds + LDS_AK + (it & 1) * KB_BYTES;
    const LAS unsigned char* vb = lds + LDS_AV + (it & 1) * KB_BYTES;
    if (kr >= rs && kr < rs + 8) {
      const LAS float* trow = (const LAS float*)(lds + LDS_ATAB) + (kr - r + 7) * ATAB_ROW + (half * 4 - qcol + 15 + 48);
#pragma unroll
      for (int seg = 0; seg < 2; ++seg) {
        f32x16 sc = zero16();
#pragma unroll
        for (int ks = 0; ks < 4; ++ks) sc = mfma32(*(const LAS bf16x8*)(kb + rd + seg * 32 * TB_ROW + ks * 32), qf[ks], sc);
#pragma unroll
        for (int ii = 0; ii < 16; ++ii) {
          const int kcol = seg * 32 + (ii >> 2) * 8 + half * 4 + (ii & 3);
          const bool ok = (kcol >= qstart) && (kcol < qstart + 16);
          sc[ii] = ok ? sc[ii] + trow[seg * 32 + (ii >> 2) * 8 + (ii & 3)] : -INFINITY;
        }
        float al; bf16x8 pk[2];
        softmax_tile(sc, mrun, lrun, al, pk[0], pk[1]);
        if (__builtin_amdgcn_ballot_w64(al != 1.0f) != 0) { o[0] *= al; o[1] *= al; }
#pragma unroll
        for (int dt = 0; dt < 2; ++dt)
#pragma unroll
          for (int s2 = 0; s2 < 2; ++s2) o[dt] = mfma32(*(const LAS bf16x8*)(vb + rd + dt * 32 * TB_ROW + (seg * 2 + s2) * 32), pk[s2], o[dt]);
      }
    }
    if (more) {
      LAS unsigned char* kbn = lds + LDS_AK + ((it + 1) & 1) * KB_BYTES; LAS unsigned char* vbn = lds + LDS_AV + ((it + 1) & 1) * KB_BYTES;
      *(LAS bf16x8*)(kbn + kst) = kr_;
      *(LAS bf16x4*)(vbn + vst) = __builtin_shufflevector(vr_, vr_, 0, 1, 2, 3); *(LAS bf16x4*)(vbn + vst + 16) = __builtin_shufflevector(vr_, vr_, 4, 5, 6, 7);
    }
    __syncthreads();
  }
  const float c = frcp(lrun + __shfl_xor(lrun, 32));
  bf16_t* yrow = p.yg + (tokbase + tq) * YW + h * 64;
  const bf16_t* zrow = p.u + (tokbase + tq) * UW + U_ZA + h * 64;
#pragma unroll
  for (int dt = 0; dt < 2; ++dt)
#pragma unroll
    for (int g4 = 0; g4 < 4; ++g4) {
      const int dim = dt * 32 + g4 * 8 + half * 4;
      const u32x2 zr = *(const u32x2*)(zrow + dim);
      const float y0 = o[dt][g4 * 4 + 0] * c * silu(bf_lo(zr[0]));
      const float y1 = o[dt][g4 * 4 + 1] * c * silu(bf_hi(zr[0]));
      const float y2 = o[dt][g4 * 4 + 2] * c * silu(bf_lo(zr[1]));
      const float y3 = o[dt][g4 * 4 + 3] * c * silu(bf_hi(zr[1]));
      u32x2 pk = {cvt_pk_bf16(y0, y1), cvt_pk_bf16(y2, y3)};
      *(u32x2*)(yrow + dim) = pk;
    }
}

__device__ void attn_c_unit(const Params& p, int L, int lshift, int seq, int g, int h, int rr, int mblk, int lane) {
  const int q = lane & 31, half = lane >> 5;
  const size_t tokbase = (size_t)seq * L;
  const int ds = (g == 0) ? 0 : (g == 1 ? 2 : 4), d = 1 << ds, M = L >> ds;
  const int hh = g * 4 + h;
  const int m0 = mblk * 32, mq = m0 + q, tq = mq * d + rr;
  const bf16_t* urow = p.u + (tokbase + tq) * UW;
  bf16x8 qf[4];
#pragma unroll
  for (int ks = 0; ks < 4; ++ks) qf[ks] = ld16(urow + U_QC + hh * 64 + ks * 16 + half * 8);
  f32x16 o[2] = {zero16(), zero16()};
  float mrun = -1e30f, lrun = 0.f;
  const float coef = exp2f(-(2.0f / 3.0f) * (float)(hh + 1)) * (float)d * LOG2E;
  const bf16_t* vbase = p.vt + ((size_t)seq * VW + V_C + hh * 64 + q) * L + (size_t)rr * M;
  bf16x8 kf[5][4];
#pragma unroll
  for (int j = 0; j < 5; ++j) {
    int mkl = m0 - 64 + 32 * j + q; mkl = mkl < 0 ? 0 : (mkl > M - 1 ? M - 1 : mkl);
    const bf16_t* kp = p.u + (tokbase + (size_t)mkl * d + rr) * UW + U_KC + hh * 64 + half * 8;
#pragma unroll
    for (int ks = 0; ks < 4; ++ks) kf[j][ks] = ld16(kp + ks * 16);
  }
  bf16x8 vf[2][2][2];
  auto load_v = [&](int j, bf16x8 (&dst)[2][2]) {
#pragma unroll
    for (int dt = 0; dt < 2; ++dt)
#pragma unroll
      for (int s2 = 0; s2 < 2; ++s2) {
        int pa = m0 - 64 + 32 * j + s2 * 16 + half * 4, pb = pa + 8;
        pa = pa < 0 ? 0 : (pa > M - 4 ? M - 4 : pa); pb = pb < 0 ? 0 : (pb > M - 4 ? M - 4 : pb);
        const bf16_t* vp = vbase + (size_t)(dt * 32) * L;
        dst[dt][s2] = ld8x2(vp + pa, vp + pb);
      }
  };
  load_v(0, vf[0]);
#pragma unroll
  for (int j = 0; j < 5; ++j) {
    if (j + 1 < 5) load_v(j + 1, vf[(j + 1) & 1]);
    const int mk0 = m0 - 64 + 32 * j;
    if (mk0 + 32 <= 0 || mk0 >= M) continue;
    f32x16 s = zero16();
#pragma unroll
    for (int ks = 0; ks < 4; ++ks) s = mfma32(kf[j][ks], qf[ks], s);
#pragma unroll
    for (int ii = 0; ii < 16; ++ii) {
      const int mk = mk0 + (ii >> 2) * 8 + half * 4 + (ii & 3);
      const int rel = mk - mq; const int ar = rel < 0 ? -rel : rel;
      const bool ok = (mk >= 0) && (mk < M) && (ar <= 64);
      s[ii] = ok ? s[ii] - coef * (float)ar : -INFINITY;
    }
    float alpha; bf16x8 pk[2];
    softmax_tile(s, mrun, lrun, alpha, pk[0], pk[1]);
#pragma unroll
    for (int dt = 0; dt < 2; ++dt) {
      o[dt] *= alpha;
#pragma unroll
      for (int s2 = 0; s2 < 2; ++s2) o[dt] = mfma32(vf[j & 1][dt][s2], pk[s2], o[dt]);
    }
  }
  const float lt = lrun + __shfl_xor(lrun, 32);
  const float c = frcp(lt);
  bf16_t* orow = p.oc + (tokbase + tq) * 768 + hh * 64;
#pragma unroll
  for (int dt = 0; dt < 2; ++dt)
#pragma unroll
    for (int g4 = 0; g4 < 4; ++g4) {
      const int dim = dt * 32 + g4 * 8 + half * 4;
      u32x2 pk = {cvt_pk_bf16(o[dt][g4 * 4 + 0] * c, o[dt][g4 * 4 + 1] * c), cvt_pk_bf16(o[dt][g4 * 4 + 2] * c, o[dt][g4 * 4 + 3] * c)};
      *(u32x2*)(orow + dim) = pk;
    }
  if (half == 0) p.lse[(tokbase + tq) * 12 + hh] = mrun + log2f(lt);
}

constexpr int CV_ROW = 784;
constexpr int LDS_CK = 0, LDS_CV = 384 * TB_ROW;
__device__ void attn_c_block(const Params& p, int L, int lshift, int seq, int g, int h, int pblk, LAS unsigned char* lds) {
  const int tid = opaque_tid(), lane = tid & 63, wid = __builtin_amdgcn_readfirstlane(tid >> 6);
  const int q = lane & 31, half = lane >> 5;
  const size_t tokbase = (size_t)seq * L;
  const int ds = (g == 0) ? 0 : (g == 1 ? 2 : 4), d = 1 << ds, M = L >> ds;
  const int hh = g * 4 + h;
  const int p0 = pblk * 256;
  {
    const int part = tid & 7;
#pragma unroll
    for (int c = 0; c < 6; ++c) {
      const int row = (tid >> 3) + c * 64;
      int pp = p0 - 64 + row; pp = pp < 0 ? 0 : (pp > L - 1 ? L - 1 : pp);
      const int tok = ((pp & (M - 1)) << ds) + (pp >> (lshift - ds));
      const bf16x8 v = ld16(p.u + (tokbase + tok) * UW + U_KC + hh * 64 + part * 8);
      *(LAS bf16x8*)(lds + LDS_CK + row * TB_ROW + part * 16) = v;
    }
#pragma unroll
    for (int c = 0; c < 6; ++c) {
      const int idx = tid + c * 512, dim = idx / 48, c8 = idx % 48;
      int pp = p0 - 64 + c8 * 8; pp = pp < 0 ? 0 : (pp > L - 8 ? L - 8 : pp);
      const bf16x8 v = ld16(p.vt + ((size_t)seq * VW + V_C + hh * 64 + dim) * L + pp);
      LAS unsigned char* dst = lds + LDS_CV + dim * CV_ROW + ((c8 >> 1) * 16 + (c8 & 1) * 4) * 2;
      *(LAS bf16x4*)dst = __builtin_shufflevector(v, v, 0, 1, 2, 3); *(LAS bf16x4*)(dst + 16) = __builtin_shufflevector(v, v, 4, 5, 6, 7);
    }
  }
  const int pw = p0 + wid * 32;
  const int rr = pw >> (lshift - ds), m0 = pw & (M - 1), mq = m0 + q, tq = mq * d + rr;
  bf16x8 qf[4];
  { const bf16_t* qp = p.u + (tokbase + tq) * UW + U_QC + hh * 64 + half * 8;
#pragma unroll
    for (int ks = 0; ks < 4; ++ks) qf[ks] = ld16(qp + ks * 16); }
  f32x16 o[2] = {zero16(), zero16()};
  float mrun = -1e30f, lrun = 0.f;
  const float coef = exp2f(-(2.0f / 3.0f) * (float)(hh + 1)) * (float)d * LOG2E;
  __syncthreads();
#pragma unroll
  for (int j = 0; j < 5; ++j) {
    const int mk0 = m0 - 64 + 32 * j;
    if (mk0 + 32 <= 0 || mk0 >= M) continue;
    const LAS unsigned char* kb = lds + LDS_CK + ((wid + j) * 32 + q) * TB_ROW + half * 16;
    f32x16 sc = zero16();
#pragma unroll
    for (int ks = 0; ks < 4; ++ks) sc = mfma32(*(const LAS bf16x8*)(kb + ks * 32), qf[ks], sc);
#pragma unroll
    for (int ii = 0; ii < 16; ++ii) {
      const int mk = mk0 + (ii >> 2) * 8 + half * 4 + (ii & 3);
      const int rel = mk - mq; const int ar = rel < 0 ? -rel : rel;
      const bool ok = (mk >= 0) && (mk < M) && (ar <= 64);
      sc[ii] = ok ? sc[ii] - coef * (float)ar : -INFINITY;
    }
    float alpha; bf16x8 pk[2];
    softmax_tile(sc, mrun, lrun, alpha, pk[0], pk[1]);
#pragma unroll
    for (int dt = 0; dt < 2; ++dt) {
      o[dt] *= alpha;
#pragma unroll
      for (int s2 = 0; s2 < 2; ++s2)
        o[dt] = mfma32(*(const LAS bf16x8*)(lds + LDS_CV + (dt * 32 + q) * CV_ROW + ((wid + j) * 32 + s2 * 16) * 2 + half * 16), pk[s2], o[dt]);
    }
  }
  __syncthreads();
  const float lt = lrun + __shfl_xor(lrun, 32);
  const float c = frcp(lt);
  bf16_t* orow = p.oc + (tokbase + tq) * 768 + hh * 64;
#pragma unroll
  for (int dt = 0; dt < 2; ++dt)
#pragma unroll
    for (int g4 = 0; g4 < 4; ++g4) {
      const int dim = dt * 32 + g4 * 8 + half * 4;
      u32x2 pk = {cvt_pk_bf16(o[dt][g4 * 4 + 0] * c, o[dt][g4 * 4 + 1] * c), cvt_pk_bf16(o[dt][g4 * 4 + 2] * c, o[dt][g4 * 4 + 3] * c)};
      *(u32x2*)(orow + dim) = pk;
    }
  if (half == 0) p.lse[(tokbase + tq) * 12 + hh] = mrun + log2f(lt);
}

__device__ void phase_attn(const Params& p, int layer, int L, int lshift, LAS unsigned char* lds) {
  const int tiles = L >> 5;
  const int nseq = TC >> lshift;
  const int nw = gridDim.x * 8;
  int w, lane;
  { const int qblks = L >> 8, npairs = nseq * 4, nunits = npairs * qblks;
    for (int b = blockIdx.x; b < nunits; b += gridDim.x) {
      int pair, qblk;
      if ((gridDim.x & 7) == 0 && (npairs & 7) == 0 && nunits == (int)gridDim.x) { const int xcd = b & 7, j = b >> 3; pair = xcd * (npairs >> 3) + j / qblks; qblk = j % qblks; }
      else { pair = b / qblks; qblk = b % qblks; }
      attn_b_block(p, layer, L, pair >> 2, pair & 3, qblk, lds);
    }
  }
  { const int tid = opaque_tid(); lane = tid & 63; w = blockIdx.x * 8 + __builtin_amdgcn_readfirstlane(tid >> 6); }
  {
  { const int rgs = L >> 8, nunits = nseq * 8 * rgs;
    for (int b = blockIdx.x; b < nunits; b += gridDim.x) { const int sh = b / rgs, rg = b % rgs; attn_a_block(p, layer, L, sh >> 3, sh & 7, rg * 4, lds); }
  }
  { const int tid = opaque_tid(); lane = tid & 63; w = blockIdx.x * 8 + __builtin_amdgcn_readfirstlane(tid >> 6); }
  { const int pbs = L >> 8, nunits = nseq * 12 * pbs;
    for (int b = blockIdx.x; b < nunits; b += gridDim.x) {
      const int pblk = b % pbs, sgh = b / pbs;
      const int seq = sgh / 12, gh = sgh % 12;
      attn_c_block(p, L, lshift, seq, gh >> 2, gh & 3, pblk, lds);
    }
  }
  }
}

__device__ void phase_combine(const Params& p) {
  const int gt = blockIdx.x * 512 + opaque_tid(), ngt = gridDim.x * 512;
  for (int it = gt; it < TC * 32; it += ngt) {
    const int tok = it >> 5, sub = it & 31, h = sub >> 3, d8 = (sub & 7) * 8;
    const float* ls = p.lse + (size_t)tok * 12;
    const float l0 = ls[h], l1 = ls[4 + h], l2 = ls[8 + h];
    const float mx = fmaxf(l0, fmaxf(l1, l2));
    const float w0 = fexp2(l0 - mx), w1 = fexp2(l1 - mx), w2 = fexp2(l2 - mx);
    const float inv = frcp(w0 + w1 + w2);
    const bf16_t* ob = p.oc + (size_t)tok * 768 + h * 64 + d8;
    const u32x4 a = *(const u32x4*)ob, b = *(const u32x4*)(ob + 256), c = *(const u32x4*)(ob + 512);
    const u32x4 z = *(const u32x4*)(p.u + (size_t)tok * UW + U_ZC + h * 64 + d8);
    u32x4 r;
#pragma unroll
    for (int k = 0; k < 4; ++k) {
      const float vlo = (w0 * bf_lo(a[k]) + w1 * bf_lo(b[k]) + w2 * bf_lo(c[k])) * inv * silu(bf_lo(z[k]));
      const float vhi = (w0 * bf_hi(a[k]) + w1 * bf_hi(b[k]) + w2 * bf_hi(c[k])) * inv * silu(bf_hi(z[k]));
      r[k] = cvt_pk_bf16(vlo, vhi);
    }
    *(u32x4*)(p.yg + (size_t)tok * YW + 1024 + h * 64 + d8) = r;
  }
}


#define XB_TMO      128
#define XB_XCNT(j)  (256  + 64 * (j))
#define XB_XSUB(j)  (1280 + 64 * (j))
#define XB_XGEN(j)  (2304 + 64 * (j))
#define XB_TOP      3328
#define XB_TOPGEN   3392
#define XCD_BAR_WORDS 3456
#define XB_SPIN_CAP (1u << 18)
__device__ __forceinline__ unsigned xb_ld(unsigned* p)              { return __hip_atomic_load(p, __ATOMIC_RELAXED, __HIP_MEMORY_SCOPE_AGENT); }
__device__ __forceinline__ unsigned xb_add(unsigned* p, unsigned v) { return __hip_atomic_fetch_add(p, v, __ATOMIC_RELAXED, __HIP_MEMORY_SCOPE_AGENT); }
__device__ __forceinline__ unsigned xb_xcc_id() { return (unsigned)__builtin_amdgcn_s_getreg((3 << 11) | 20) & 0xFu; }
#define XB_SPIN(cond, bar) do { unsigned _sp = 0; while (cond) { __builtin_amdgcn_s_sleep(1); \
    if ((++_sp & 255u) == 0u) { if (xb_ld(&(bar)[XB_TMO])) break; if (_sp > XB_SPIN_CAP) { atomicAdd(&(bar)[XB_TMO], 1u); break; } } } } while (0)
struct XcdBarrier { unsigned* bar; unsigned x; volatile LAS unsigned* st; };
__device__ __forceinline__ XcdBarrier xcd_barrier_post(unsigned* bar, volatile LAS unsigned* st) {
  XcdBarrier b; b.bar = bar; b.x = xb_xcc_id(); b.st = st;
  if (opaque_tid() == 0) (void)xb_add(&bar[XB_XCNT(b.x)], 1u);
  return b;
}
__device__ __forceinline__ void xcd_barrier_complete(unsigned* bar, unsigned x, unsigned& nloc, unsigned& nx) {
  const unsigned G = gridDim.x * gridDim.y * gridDim.z;
  unsigned sum, cnt, mine, sp = 0u;
  for (;;) {
    sum = 0u; cnt = 0u; mine = 0u;
#pragma unroll
    for (unsigned j = 0; j < 16; ++j) { const unsigned c = xb_ld(&bar[XB_XCNT(j)]); sum += c; cnt += (c > 0u) ? 1u : 0u; mine = (j == x) ? c : mine; }
    if (sum == G) break;
    __builtin_amdgcn_s_sleep(1);
    if ((++sp & 255u) == 0u) { if (xb_ld(&bar[XB_TMO])) break; if (sp > XB_SPIN_CAP) { atomicAdd(&bar[XB_TMO], 1u); break; } }
  }
  nloc = mine > 0u ? mine : 1u; nx = cnt > 0u ? cnt : 1u;
}
__device__ __forceinline__ void xcd_barrier(const XcdBarrier& b) {
  asm volatile("s_waitcnt vmcnt(0)" ::: "memory");
  __syncthreads();
  if (opaque_tid() == 0) {
    unsigned* bar = b.bar;
    __builtin_amdgcn_s_waitcnt(0);
    unsigned nloc = b.st[0], nx = b.st[1];
    if (nloc == 0u) { xcd_barrier_complete(bar, b.x, nloc, nx); b.st[0] = nloc; b.st[1] = nx; }
    const unsigned old = xb_add(&bar[XB_XSUB(b.x)], 1u);
    const unsigned gen = old / nloc;
    if (old + 1u == (gen + 1u) * nloc) {
      __builtin_amdgcn_fence(__ATOMIC_RELEASE, "agent");
      asm volatile("s_waitcnt vmcnt(0)" ::: "memory");
      const unsigned og = xb_add(&bar[XB_TOP], 1u);
      const unsigned tg = og / nx;
      if (og + 1u == (tg + 1u) * nx) xb_add(&bar[XB_TOPGEN], 1u);
      else XB_SPIN(xb_ld(&bar[XB_TOPGEN]) == tg, bar);
      __builtin_amdgcn_fence(__ATOMIC_ACQUIRE, "agent");
      xb_add(&bar[XB_XGEN(b.x)], 1u);
      asm volatile("s_waitcnt vmcnt(0)" ::: "memory");
    } else {
      XB_SPIN(xb_ld(&bar[XB_XGEN(b.x)]) == gen, bar);
      __builtin_amdgcn_fence(__ATOMIC_ACQUIRE, "agent");
      asm volatile("s_waitcnt vmcnt(0)" ::: "memory");
    }
  }
  __syncthreads();
}

constexpr int DYN_LDS_BYTES = LDS_ATT_TOTAL > pg8::STAGE_BYTES ? LDS_ATT_TOTAL : pg8::STAGE_BYTES;
__global__ void __launch_bounds__(512) fwd_megakernel(Params p) {
  extern __shared__ __attribute__((aligned(16))) unsigned char smem[];
  __shared__ __attribute__((aligned(16))) unsigned xb_words[4];
  cg::grid_group grid = cg::this_grid();
  if (threadIdx.x == 0) { xb_words[0] = 0u; xb_words[1] = 0u; xb_words[2] = 0u; xb_words[3] = 0u; }
  if ((threadIdx.x & 63) == 0) g_wid_table[hw_wave_slot()] = (int)(threadIdx.x >> 6);
  __syncthreads();
  const XcdBarrier xb = xcd_barrier_post(p.bar, (volatile LAS unsigned*)xb_words);
#define GSYNC() xcd_barrier(xb)
  LAS unsigned char* lds = (LAS unsigned char*)smem;
  phase_prep(p, (LAS float*)smem);
  phase_x(p, 0);
  grid.sync();
  for (int chunk = 0; chunk < NCHUNK; ++chunk) {
    const int L = chunk < 2 ? 2048 : 4096, lshift = chunk < 2 ? 11 : 12;
    const float* xin = (chunk < 2) ? p.xp + (size_t)chunk * TC * DM : p.xs + (size_t)(chunk - 2) * TC * DM;
    float* xres = p.out + (size_t)chunk * TC * DM;
    float* ssq = p.ssq + (size_t)chunk * TC * 16;
    for (int layer = 0; layer < DEPTH; ++layer) {
      {
        {
        { pg8::Gemm g{p.xb, p.wt_in + (size_t)layer * INW * DM, TC, UW, DM, 0, lshift};
          pg8::StaticOrder S; S.init(TC, UW, gridDim.x, blockIdx.x);
          EpiU E{p.u, p.rinv + (size_t)chunk * TC, p.b_gate + (size_t)layer * 3 * DM};
          pg8::gemm_phase<false>(lds, g, S, E); }
        {
          pg8::Gemm g{p.wt_in + ((size_t)layer * INW + UW) * DM, p.xb, VW, TC, DM, 1, lshift};
          pg8::StaticOrder S; S.init(VW, TC, gridDim.x, (blockIdx.x + (gridDim.x >> 2)) % gridDim.x);
          EpiVT E{p.vt, p.rinv + (size_t)chunk * TC, L, lshift};
          pg8::gemm_phase<true>(lds, g, S, E); }
        }
      }
      GSYNC();
      phase_attn(p, layer, L, lshift, lds);
      GSYNC();
      phase_combine(p);
      GSYNC();
      {
        pg8::Gemm g{p.yg, p.wt_br + (size_t)layer * DM * YW, TC, DM, YW, 0, 0};
        pg8::StaticOrder S; S.init(TC, DM, gridDim.x, blockIdx.x);
        EpiMerge E{p.u, p.merged};
        pg8::gemm_phase<false>(lds, g, S, E);
      }
      GSYNC();
      {
        pg8::Gemm g{p.merged, p.wt_out + (size_t)layer * DM * DM, TC, DM, DM, 0, 0};
        pg8::StaticOrder S; S.init(TC, DM, gridDim.x, blockIdx.x);
        EpiRes E{layer == 0 ? xin : (const float*)xres, xres, p.xb, ssq};
        pg8::gemm_phase<false>(lds, g, S, E);
      }
      GSYNC();
      if (layer + 1 < DEPTH) { phase_rinv(p, chunk); GSYNC(); }
    }
    phase_final(p, chunk);
    if (chunk + 1 < NCHUNK) { phase_x(p, chunk + 1); GSYNC(); }
  }
}

extern "C" void kernel_launch(void* const* d_in, const int* in_sizes, int n_in, void* d_out, int out_size, void* d_ws, size_t ws_size, hipStream_t stream) {
  (void)in_sizes; (void)n_in; (void)out_size;
  static int grid_blocks = 0;
  if (!grid_blocks) {
    int dev = 0, cus = 0, per_cu = 0;
    hipGetDevice(&dev);
    hipDeviceGetAttribute(&cus, hipDeviceAttributeMultiprocessorCount, dev);
    hipFuncSetAttribute((const void*)fwd_megakernel, hipFuncAttributeMaxDynamicSharedMemorySize, DYN_LDS_BYTES);
    hipOccupancyMaxActiveBlocksPerMultiprocessor(&per_cu, fwd_megakernel, 512, DYN_LDS_BYTES);
    if (per_cu < 1) per_cu = 1;
    grid_blocks = cus * per_cu;
    if (grid_blocks > 256) grid_blocks = 256;
  }
  Params p{};
  p.xp = (const float*)d_in[0]; p.xs = (const float*)d_in[1]; p.g_norm = (const float*)d_in[2]; p.w_in = (const float*)d_in[3];
  p.b_gate = (const float*)d_in[4]; p.rpb = (const float*)d_in[5]; p.lam_qk = (const float*)d_in[6]; p.g_diff = (const float*)d_in[7];
  p.w_br_a = (const float*)d_in[8]; p.w_br_b = (const float*)d_in[9]; p.w_br_c = (const float*)d_in[10]; p.w_out = (const float*)d_in[11];
  p.g_final = (const float*)d_in[12];
  p.out = (float*)d_out;
  char* w = (char*)d_ws; size_t off = 0;
  auto take = [&](size_t bytes) { char* r = w + off; off += (bytes + 255) & ~(size_t)255; return r; };
  p.wt_in = (bf16_t*)take((size_t)DEPTH * INW * DM * 2);
  p.wt_br = (bf16_t*)take((size_t)DEPTH * DM * YW * 2);
  p.wt_out = (bf16_t*)take((size_t)DEPTH * DM * DM * 2);
  p.xb = (bf16_t*)take((size_t)TC * DM * 2);
  p.u = (bf16_t*)take((size_t)TC * UW * 2);
  p.vt = (bf16_t*)take((size_t)TC * VW * 2);
  p.yg = (bf16_t*)take((size_t)TC * YW * 2);
  p.oc = (bf16_t*)take((size_t)TC * 768 * 2);
  p.merged = (bf16_t*)take((size_t)TC * DM * 2);
  p.lse = (float*)take((size_t)TC * 12 * 4);
  p.ssq = (float*)take((size_t)NTOK * 16 * 4);
  p.lam = (float*)take(256);
  p.rinv = (float*)take((size_t)NTOK * 4);
  p.bar = (unsigned*)take((size_t)XCD_BAR_WORDS * 4);
  if (off > ws_size) fprintf(stderr, "workspace too small: need %zu have %zu\n", off, ws_size);
  hipMemsetAsync(p.bar, 0, (size_t)XCD_BAR_WORDS * 4, stream);
  void* args[] = {&p};
  hipError_t e = hipLaunchCooperativeKernel((void*)fwd_megakernel, dim3(grid_blocks), dim3(512), args, DYN_LDS_BYTES, stream);
  if (e != hipSuccess) fprintf(stderr, "cooperative launch failed: %s (grid %d)\n", hipGetErrorString(e), grid_blocks);
}
```

```cpp
#include <hip/hip_runtime.h>
#include <hip/hip_cooperative_groups.h>
#include <cstdio>
namespace cg = cooperative_groups;

#define LAS __attribute__((address_space(3)))
typedef unsigned short bf16_t;
typedef short bf16x8 __attribute__((ext_vector_type(8)));
typedef short bf16x4 __attribute__((ext_vector_type(4)));
typedef float f32x4 __attribute__((ext_vector_type(4)));
typedef float f32x16 __attribute__((ext_vector_type(16)));
typedef unsigned u32x4 __attribute__((ext_vector_type(4)));
typedef unsigned u32x2 __attribute__((ext_vector_type(2)));

constexpr int DM = 1024, DEPTH = 4, INW = 9728, UW = 7936, VW = 1792, YW = 1280;
constexpr int TC = 16384, NCHUNK = 4, NTOK = 65536;
constexpr float LOG2E = 1.4426950408889634f;
constexpr float QSCALE = 0.125f * LOG2E;
constexpr int U_QA = 0, U_KA = 512, U_ZA = 1024, U_QB = 1536, U_KB = 2048, U_ZB = 2560, U_QC = 3072, U_KC = 3840, U_ZC = 4608, U_GL = 4864;
constexpr int V_A = 0, V_B = 512, V_C = 1024;

struct Params {
  const float *xp, *xs, *g_norm, *w_in, *b_gate, *rpb, *lam_qk, *g_diff, *w_br_a, *w_br_b, *w_br_c, *w_out, *g_final;
  float* out;
  bf16_t *wt_in, *wt_br, *wt_out, *xb, *u, *vt, *yg, *oc, *merged;
  float *lse, *ssq, *lam, *rinv;
  unsigned* bar;
};

__device__ __forceinline__ unsigned cvt_pk_bf16(float lo, float hi) { unsigned r; asm volatile("v_cvt_pk_bf16_f32 %0, %1, %2" : "=v"(r) : "v"(lo), "v"(hi)); return r; }
__device__ __forceinline__ float bf_lo(unsigned v) { return __uint_as_float(v << 16); }
__device__ __forceinline__ float bf_hi(unsigned v) { return __uint_as_float(v & 0xffff0000u); }
__device__ __forceinline__ float fexp2(float x) { return __builtin_amdgcn_exp2f(x); }
__device__ __forceinline__ float frcp(float x) { return __builtin_amdgcn_rcpf(x); }

__shared__ int g_wid_table[64];
__device__ __forceinline__ unsigned hw_wave_slot() { return (unsigned)__builtin_amdgcn_s_getreg(((6 - 1) << 11) | (0 << 6) | 4) & 63u; }
__device__ __forceinline__ int opaque_tid() {
  const int wid = __builtin_amdgcn_readfirstlane(g_wid_table[hw_wave_slot()]);
  unsigned z = 0u; asm volatile("" : "+v"(z));
  int t = wid * 64 + (int)__builtin_amdgcn_mbcnt_hi(~0u, __builtin_amdgcn_mbcnt_lo(~0u, z));
  asm volatile("" : "+v"(t)); return t;
}

namespace pg8 {
constexpr int BM = 256, BK = 64, HALF = 128, HTB = HALF * BK * 2, STAGE_BYTES = 8 * HTB, NXCD = 8, WGM = 8;
__device__ __forceinline__ int lds_byte(int r, int c) { const int st = (r >> 4) * 2 + (c >> 5), rr = r & 15, cc = c & 31, ob = rr * 64 + cc * 2; return st * 1024 + (ob ^ (((ob >> 9) & 1) << 5)); }
__device__ __forceinline__ void stage_rc(int b, int& R, int& C) { const int st = b / 1024, sb = b % 1024, swz = sb ^ (((sb >> 9) & 1) << 5); R = (st >> 1) * 16 + swz / 64; C = (st & 1) * 32 + (swz % 64) / 2; }
__device__ __forceinline__ int perm32(int rho) { const int n = rho >> 4, i = rho & 15; return 8 * (i >> 2) + 4 * n + (i & 3); }
struct Unit { int pm, pn; };
struct Gemm { const bf16_t* A; const bf16_t* Bt; int M, N, K; int bperm, lshift; };
struct StaticOrder {
  int nM, nN, nwg, G, c;
  __device__ void init(int M, int N, int G_, int c_) { nM = M / BM; nN = N / BM; nwg = nM * nN; G = G_; c = c_; }
  __device__ bool next(int i, Unit& u) const {
    const long L = (long)i * G + c; if (L >= nwg) return false;
    int wgid = (int)L; { const int q = nwg / NXCD, r = nwg % NXCD, xcd = wgid % NXCD, off = wgid / NXCD; wgid = (xcd < r ? xcd * (q + 1) : r * (q + 1) + (xcd - r) * q) + off; }
    const int nig = WGM * nN, gid = wgid / nig, fm = gid * WGM, gsz = (nM - fm) < WGM ? (nM - fm) : WGM;
    u.pm = fm + ((wgid % nig) % gsz); u.pn = (wgid % nig) / gsz; return true;
  }
};

template <bool BPERM, class Epi>
__device__ __forceinline__ void gemm_phase(LAS unsigned char* lds, const Gemm g, const StaticOrder& S, const Epi& E) {
  const int tid_ = opaque_tid();
  const int tid = tid_, wid = __builtin_amdgcn_readfirstlane(tid >> 6), lane = tid & 63, wr = wid >> 2, wc = wid & 3, fr = lane & 15, fq = lane >> 4;
  const int K = g.K, nt = K / BK;
  const size_t kstep = (size_t)(BK * 2);
  const size_t hstep = (size_t)HALF * K * 2;
  const size_t tstep = 2 * hstep;
  unsigned voffA[2], voffBr[2], voffBc[2], voffB[2], voffBn[2];
#pragma unroll
  for (int i = 0; i < 2; ++i) { int R, C; stage_rc(tid * 16 + i * 8192, R, C); const int Rb = (R & ~31) + perm32(R & 31);
    voffA[i] = (unsigned)(R * K + C) * 2u; voffBr[i] = (unsigned)(Rb * K) * 2u; voffBc[i] = (unsigned)C * 2u; voffB[i] = voffBr[i] + voffBc[i]; voffBn[i] = voffB[i]; }
  auto bbase = [&](const Unit& u, int hh, int& sh) -> const char* {
    if constexpr (!BPERM) { sh = 0; return (const char*)g.Bt + (size_t)u.pn * tstep + (size_t)hh * hstep; }
    const int ds = u.pm <= 4 ? 0 : (u.pm == 5 ? 2 : 4); sh = ds;
    const int L = 1 << g.lshift; const int p0 = u.pn * 256 + hh * 128, seq = p0 >> g.lshift, p = p0 & (L - 1);
    const int Mc = L >> ds, r = p / Mc, m0 = p & (Mc - 1);
    return (const char*)g.Bt + ((size_t)seq * L + ((size_t)m0 << ds) + r) * (size_t)K * 2;
  };
  const unsigned ldsw = (unsigned)wid * 1024u;
  const int aoff = lds_byte(wr * 64 + fr, fq * 8), boff = lds_byte(wc * 32 + fr, fq * 8);
#define PG8_SA(b, h) (((b) * 2 + (h)) * HTB)
#define PG8_SB(b, h) ((4 + (b) * 2 + (h)) * HTB)
#define PG8_STAGE(bufoff, gbase, voff) do { _Pragma("unroll") for (int _i = 0; _i < 2; ++_i) \
    __builtin_amdgcn_global_load_lds((const unsigned*)((const char*)(gbase) + (voff)[_i]), (LAS unsigned*)(lds + (bufoff) + ldsw + _i * 8192), 16, 0, 0); } while (0)
#define PG8_LDA(dst, b, h) do { _Pragma("unroll") for (int m = 0; m < 4; ++m) _Pragma("unroll") for (int k = 0; k < 2; ++k) dst[m][k] = *(const LAS bf16x8*)(lds + PG8_SA(b, h) + aoff + m * 2048 + k * 1024); } while (0)
#define PG8_LDB(dst, b, h) do { _Pragma("unroll") for (int n = 0; n < 2; ++n) _Pragma("unroll") for (int k = 0; k < 2; ++k) dst[n][k] = *(const LAS bf16x8*)(lds + PG8_SB(b, h) + boff + n * 2048 + k * 1024); } while (0)
#define PG8_MMA(ai, bj, At, Bt) do { __builtin_amdgcn_s_setprio(1); _Pragma("unroll") for (int m = 0; m < 4; ++m) _Pragma("unroll") for (int n = 0; n < 2; ++n) _Pragma("unroll") for (int k = 0; k < 2; ++k) \
    acc[ai][bj][m][n] = __builtin_amdgcn_mfma_f32_16x16x32_bf16(Bt[n][k], At[m][k], acc[ai][bj][m][n], 0, 0, 0); __builtin_amdgcn_s_setprio(0); } while (0)
#define PG8_WAIT_V(n) asm volatile("s_waitcnt vmcnt(" #n ")" ::: "memory")
#define PG8_WAIT_L(n) asm volatile("s_waitcnt lgkmcnt(" #n ")" ::: "memory")
#define PG8_BAR __builtin_amdgcn_s_barrier()
#define PG8_SCHED __builtin_amdgcn_sched_barrier(0)
  Unit cur, nxt; int ui = 0;
  if (!S.next(0, cur)) return;
  f32x4 acc[2][2][4][2];
#pragma unroll
  for (int a = 0; a < 2; ++a)
#pragma unroll
    for (int b = 0; b < 2; ++b)
#pragma unroll
      for (int m = 0; m < 4; ++m)
#pragma unroll
        for (int n = 0; n < 2; ++n) acc[a][b][m][n] = (f32x4){0.f, 0.f, 0.f, 0.f};
  bf16x8 At[4][2], B0[2][2], B1[2][2];
  const char* cA = (const char*)g.A + (size_t)cur.pm * tstep;
  int csh; const char* cB0 = bbase(cur, 0, csh); const char* cB1 = bbase(cur, 1, csh);
#pragma unroll
  for (int i = 0; i < 2; ++i) voffB[i] = (voffBr[i] << csh) + voffBc[i];
  PG8_STAGE(PG8_SB(0, 0), cB0, voffB); PG8_STAGE(PG8_SA(0, 0), cA, voffA); PG8_STAGE(PG8_SB(0, 1), cB1, voffB); PG8_STAGE(PG8_SA(0, 1), cA + hstep, voffA);
  if (wr == 1) PG8_BAR;
  PG8_WAIT_V(4); PG8_BAR;
  PG8_STAGE(PG8_SB(1, 0), cB0 + kstep, voffB); PG8_STAGE(PG8_SA(1, 0), cA + kstep, voffA); PG8_STAGE(PG8_SB(1, 1), cB1 + kstep, voffB);
  PG8_WAIT_V(6); PG8_BAR;
  for (;;) {
    const bool has_next = S.next(ui + 1, nxt);
    const char* nA = cA; const char* nB0 = cB0; const char* nB1 = cB1;
#pragma unroll
    for (int i = 0; i < 2; ++i) voffBn[i] = voffB[i];
    if (has_next) { int nsh; nA = (const char*)g.A + (size_t)nxt.pm * tstep; nB0 = bbase(nxt, 0, nsh); nB1 = bbase(nxt, 1, nsh);
#pragma unroll
      for (int i = 0; i < 2; ++i) voffBn[i] = (voffBr[i] << nsh) + voffBc[i]; }
    auto kiter = [&](int t) __attribute__((always_inline)) {
      const bool last = (t == nt - 2);
      const char* a1 = cA + (size_t)(t + 1) * kstep;
      const char* a2 = last ? nA : cA + (size_t)(t + 2) * kstep;
      const char* b20 = last ? nB0 : cB0 + (size_t)(t + 2) * kstep; const char* b21 = last ? nB1 : cB1 + (size_t)(t + 2) * kstep;
      const char* a3 = a2 + kstep; const char* b30 = b20 + kstep; const char* b31 = b21 + kstep;
      unsigned vB[2];
#pragma unroll
      for (int i = 0; i < 2; ++i) vB[i] = BPERM ? (last ? voffBn[i] : voffB[i]) : voffB[i];
      PG8_LDB(B0, 0, 0); PG8_SCHED; PG8_LDA(At, 0, 0); PG8_STAGE(PG8_SA(1, 1), a1 + hstep, voffA);
      PG8_WAIT_L(8); PG8_BAR; PG8_WAIT_L(0); PG8_MMA(0, 0, At, B0); PG8_BAR; PG8_SCHED;
      PG8_LDB(B1, 0, 1); PG8_STAGE(PG8_SB(0, 0), b20, vB);
      PG8_BAR; PG8_WAIT_L(0); PG8_MMA(0, 1, At, B1); PG8_BAR;
      PG8_LDA(At, 0, 1); PG8_STAGE(PG8_SA(0, 0), a2, voffA);
      PG8_BAR; PG8_WAIT_L(0); PG8_MMA(1, 0, At, B0); PG8_BAR; PG8_SCHED;
      PG8_STAGE(PG8_SB(0, 1), b21, vB);
      PG8_WAIT_V(6); PG8_BAR; PG8_MMA(1, 1, At, B1); PG8_BAR;
      PG8_LDB(B0, 1, 0); PG8_SCHED; PG8_LDA(At, 1, 0); PG8_STAGE(PG8_SA(0, 1), a2 + hstep, voffA);
      PG8_WAIT_L(8); PG8_BAR; PG8_WAIT_L(0); PG8_MMA(0, 0, At, B0); PG8_BAR; PG8_SCHED;
      PG8_LDB(B1, 1, 1); PG8_STAGE(PG8_SB(1, 0), b30, vB);
      PG8_BAR; PG8_WAIT_L(0); PG8_MMA(0, 1, At, B1); PG8_BAR;
      PG8_LDA(At, 1, 1); PG8_STAGE(PG8_SA(1, 0), a3, voffA);
      PG8_BAR; PG8_WAIT_L(0); PG8_MMA(1, 0, At, B0); PG8_BAR; PG8_SCHED;
      PG8_STAGE(PG8_SB(1, 1), b31, vB);
      PG8_WAIT_V(6); PG8_BAR; PG8_MMA(1, 1, At, B1); PG8_BAR;
    };
    if constexpr (Epi::HOOK) {
#pragma unroll 1
      for (int seg = 0; seg < 3; ++seg) {
        const int tb = seg * 8, te = seg == 2 ? nt : tb + 8;
#pragma unroll 1
        for (int t = tb; t < te; t += 2) kiter(t);
        if (seg < 2) E.hook(acc, cur, te, wr, wc, fr, fq);
      }
    } else {
      for (int t = 0; t < nt; t += 2) kiter(t);
    }
    E(acc, cur, wr, wc, fr, fq);
    if (!has_next) break;
#pragma unroll
    for (int a = 0; a < 2; ++a)
#pragma unroll
      for (int b = 0; b < 2; ++b)
#pragma unroll
        for (int m = 0; m < 4; ++m)
#pragma unroll
          for (int n = 0; n < 2; ++n) acc[a][b][m][n] = (f32x4){0.f, 0.f, 0.f, 0.f};
    cur = nxt; cA = nA; cB0 = nB0; cB1 = nB1; ++ui;
#pragma unroll
    for (int i = 0; i < 2; ++i) voffB[i] = voffBn[i];
  }
  PG8_WAIT_V(0);
  if (wr == 0) PG8_BAR;
  PG8_BAR;
#undef PG8_SA
#undef PG8_SB
#undef PG8_STAGE
#undef PG8_LDA
#undef PG8_LDB
#undef PG8_MMA
#undef PG8_WAIT_V
#undef PG8_WAIT_L
#undef PG8_BAR
#undef PG8_SCHED
}
}
using pg8::Unit;

struct EpiU {
  static constexpr bool HOOK = false;
  bf16_t* U; const float* rinv; const float* bg;
  __device__ __forceinline__ void hook(f32x4 (&)[2][2][4][2], const Unit&, int, int, int, int, int) const {}
  __device__ __forceinline__ void operator()(const f32x4 (&acc)[2][2][4][2], const Unit& u, int wr, int wc, int fr, int fq) const {
    asm volatile("" : "+v"(fr), "+v"(fq));
    const int row0 = u.pm * 256 + wr * 64 + fr, col0 = u.pn * 256 + wc * 32 + 8 * fq;
    const bool isg = (u.pn >= 19);
    float ri[2][4];
#pragma unroll
    for (int ai = 0; ai < 2; ++ai)
#pragma unroll
      for (int m = 0; m < 4; ++m) ri[ai][m] = rinv[row0 + ai * 128 + m * 16];
    if (isg) {
      f32x4 b[2][2];
#pragma unroll
      for (int bj = 0; bj < 2; ++bj) { const float* bp = bg + (col0 - U_GL) + bj * 128; b[bj][0] = *(const f32x4*)bp; b[bj][1] = *(const f32x4*)(bp + 4); }
#pragma unroll
      for (int ai = 0; ai < 2; ++ai)
#pragma unroll
        for (int m = 0; m < 4; ++m)
#pragma unroll
          for (int bj = 0; bj < 2; ++bj) {
            f32x4 v0 = acc[ai][bj][m][0] * ri[ai][m] + b[bj][0], v1 = acc[ai][bj][m][1] * ri[ai][m] + b[bj][1];
#pragma unroll
            for (int j = 0; j < 4; ++j) { v0[j] = 1.0f + fminf(fexp2(-v0[j] * LOG2E), 1e30f); v1[j] = 1.0f + fminf(fexp2(-v1[j] * LOG2E), 1e30f); }
            u32x4 pk = {cvt_pk_bf16(v0[0], v0[1]), cvt_pk_bf16(v0[2], v0[3]), cvt_pk_bf16(v1[0], v1[1]), cvt_pk_bf16(v1[2], v1[3])};
            *(u32x4*)(U + (size_t)(row0 + ai * 128 + m * 16) * UW + col0 + bj * 128) = pk;
          }
    } else {
#pragma unroll
      for (int ai = 0; ai < 2; ++ai)
#pragma unroll
        for (int m = 0; m < 4; ++m)
#pragma unroll
          for (int bj = 0; bj < 2; ++bj) {
            const f32x4 v0 = acc[ai][bj][m][0] * ri[ai][m], v1 = acc[ai][bj][m][1] * ri[ai][m];
            u32x4 pk = {cvt_pk_bf16(v0[0], v0[1]), cvt_pk_bf16(v0[2], v0[3]), cvt_pk_bf16(v1[0], v1[1]), cvt_pk_bf16(v1[2], v1[3])};
            *(u32x4*)(U + (size_t)(row0 + ai * 128 + m * 16) * UW + col0 + bj * 128) = pk;
          }
    }
  }
};

struct EpiVT {
  static constexpr bool HOOK = false;
  bf16_t* VT; const float* rv; int L, lshift;
  __device__ __forceinline__ void hook(f32x4 (&)[2][2][4][2], const Unit&, int, int, int, int, int) const {}
  __device__ __forceinline__ void operator()(const f32x4 (&acc)[2][2][4][2], const Unit& u, int wr, int wc, int fr, int fq) const {
    asm volatile("" : "+v"(fr), "+v"(fq));
    const int vrow0 = u.pm * 256 + wr * 64 + fr, pcol0 = u.pn * 256 + wc * 32 + 8 * fq;
    const int ds = u.pm <= 4 ? 0 : (u.pm == 5 ? 2 : 4);
    const int Mc = L >> ds;
#pragma unroll
    for (int bj = 0; bj < 2; ++bj) {
      const int p0 = pcol0 + bj * 128, seq = p0 >> lshift, pos = p0 & (L - 1);
      const int r = pos / Mc, m0 = pos & (Mc - 1);
      float rinv[8];
#pragma unroll
      for (int j = 0; j < 8; ++j) rinv[j] = rv[(seq << lshift) + ((m0 + j) << ds) + r];
      bf16_t* vb = VT + ((size_t)seq * VW + vrow0) * L + pos;
#pragma unroll
      for (int ai = 0; ai < 2; ++ai)
#pragma unroll
        for (int m = 0; m < 4; ++m) {
          const f32x4 v0 = acc[ai][bj][m][0], v1 = acc[ai][bj][m][1];
          u32x4 pk = {cvt_pk_bf16(v0[0] * rinv[0], v0[1] * rinv[1]), cvt_pk_bf16(v0[2] * rinv[2], v0[3] * rinv[3]),
                      cvt_pk_bf16(v1[0] * rinv[4], v1[1] * rinv[5]), cvt_pk_bf16(v1[2] * rinv[6], v1[3] * rinv[7])};
          *(u32x4*)(vb + (size_t)(ai * 128 + m * 16) * L) = pk;
        }
    }
  }
};

struct EpiMerge {
  static constexpr bool HOOK = true;
  const bf16_t* U; bf16_t* MG;
  __device__ __forceinline__ f32x4 gvec(int i, size_t row, int col) const {
    const u32x2 raw = *(const u32x2*)(U + row * UW + U_GL + i * 1024 + col);
    f32x4 e; e[0] = bf_lo(raw[0]); e[1] = bf_hi(raw[0]); e[2] = bf_lo(raw[1]); e[3] = bf_hi(raw[1]); return e;
  }
  __device__ __forceinline__ void hook(f32x4 (&acc)[2][2][4][2], const Unit& u, int t, int wr, int wc, int fr, int fq) const {
    const int i = (t == 8) ? 0 : 1;
    asm volatile("" : "+v"(fr), "+v"(fq));
    const int row0 = u.pm * 256 + wr * 64 + fr, col0 = u.pn * 256 + wc * 32 + 8 * fq;
#pragma unroll
    for (int ai = 0; ai < 2; ++ai) {
#pragma unroll
      for (int m = 0; m < 4; ++m)
#pragma unroll
        for (int bj = 0; bj < 2; ++bj) {
          const bf16_t* gp = U + (size_t)(row0 + ai * 128 + m * 16) * UW + U_GL + i * 1024 + col0 + bj * 128;
          const u32x4 a = *(const u32x4*)gp, b = *(const u32x4*)(gp + 1024);
#pragma unroll
          for (int n = 0; n < 2; ++n) {
            f32x4 r;
            r[0] = bf_lo(b[2 * n]) * frcp(bf_lo(a[2 * n])); r[1] = bf_hi(b[2 * n]) * frcp(bf_hi(a[2 * n]));
            r[2] = bf_lo(b[2 * n + 1]) * frcp(bf_lo(a[2 * n + 1])); r[3] = bf_hi(b[2 * n + 1]) * frcp(bf_hi(a[2 * n + 1]));
            acc[ai][bj][m][n] *= r;
          }
        }
      __builtin_amdgcn_sched_barrier(0);
    }
  }
  __device__ __forceinline__ void operator()(const f32x4 (&acc)[2][2][4][2], const Unit& u, int wr, int wc, int fr, int fq) const {
    asm volatile("" : "+v"(fr), "+v"(fq));
    const int row0 = u.pm * 256 + wr * 64 + fr, col0 = u.pn * 256 + wc * 32 + 8 * fq;
    u32x4 g2[2][4][2];
#pragma unroll
    for (int ai = 0; ai < 2; ++ai)
#pragma unroll
      for (int m = 0; m < 4; ++m)
#pragma unroll
        for (int bj = 0; bj < 2; ++bj) g2[ai][m][bj] = *(const u32x4*)(U + (size_t)(row0 + ai * 128 + m * 16) * UW + U_GL + 2 * 1024 + col0 + bj * 128);
    __builtin_amdgcn_sched_barrier(0);
#pragma unroll
    for (int ai = 0; ai < 2; ++ai)
#pragma unroll
      for (int m = 0; m < 4; ++m)
#pragma unroll
        for (int bj = 0; bj < 2; ++bj) {
          const size_t row = (size_t)(row0 + ai * 128 + m * 16); const int col = col0 + bj * 128;
          const u32x4 g = g2[ai][m][bj];
          f32x4 v0 = acc[ai][bj][m][0], v1 = acc[ai][bj][m][1];
          v0[0] *= frcp(bf_lo(g[0])); v0[1] *= frcp(bf_hi(g[0])); v0[2] *= frcp(bf_lo(g[1])); v0[3] *= frcp(bf_hi(g[1]));
          v1[0] *= frcp(bf_lo(g[2])); v1[1] *= frcp(bf_hi(g[2])); v1[2] *= frcp(bf_lo(g[3])); v1[3] *= frcp(bf_hi(g[3]));
          u32x4 pk = {cvt_pk_bf16(v0[0], v0[1]), cvt_pk_bf16(v0[2], v0[3]), cvt_pk_bf16(v1[0], v1[1]), cvt_pk_bf16(v1[2], v1[3])};
          *(u32x4*)(MG + row * DM + col) = pk;
        }
  }
};

struct EpiRes {
  static constexpr bool HOOK = false;
  const float* R; float* X; bf16_t* XB; float* ssq;
  __device__ __forceinline__ void hook(f32x4 (&)[2][2][4][2], const Unit&, int, int, int, int, int) const {}
  __device__ __forceinline__ void operator()(const f32x4 (&acc)[2][2][4][2], const Unit& u, int wr, int wc, int fr, int fq) const {
    asm volatile("" : "+v"(fr), "+v"(fq));
    const int row0 = u.pm * 256 + wr * 64 + fr, col0 = u.pn * 256 + wc * 32 + 8 * fq;
#pragma unroll
    for (int ai = 0; ai < 2; ++ai) {
      f32x4 r[4][2][2];
#pragma unroll
      for (int m = 0; m < 4; ++m)
#pragma unroll
        for (int bj = 0; bj < 2; ++bj) { const float* rp = R + (size_t)(row0 + ai * 128 + m * 16) * DM + col0 + bj * 128; r[m][bj][0] = *(const f32x4*)rp; r[m][bj][1] = *(const f32x4*)(rp + 4); }
      __builtin_amdgcn_sched_barrier(0);
#pragma unroll
      for (int m = 0; m < 4; ++m) {
        const size_t row = (size_t)(row0 + ai * 128 + m * 16);
        float s = 0.f;
#pragma unroll
        for (int bj = 0; bj < 2; ++bj) {
          const int col = col0 + bj * 128;
          const f32x4 v0 = r[m][bj][0] + acc[ai][bj][m][0], v1 = r[m][bj][1] + acc[ai][bj][m][1];
          *(f32x4*)(X + row * DM + col) = v0; *(f32x4*)(X + row * DM + col + 4) = v1;
          s += v0[0] * v0[0] + v0[1] * v0[1] + v0[2] * v0[2] + v0[3] * v0[3] + v1[0] * v1[0] + v1[1] * v1[1] + v1[2] * v1[2] + v1[3] * v1[3];
          u32x4 pk = {cvt_pk_bf16(v0[0], v0[1]), cvt_pk_bf16(v0[2], v0[3]), cvt_pk_bf16(v1[0], v1[1]), cvt_pk_bf16(v1[2], v1[3])};
          *(u32x4*)(XB + row * DM + col) = pk;
        }
        s += __shfl_xor(s, 16); s += __shfl_xor(s, 32);
        if (fq == 0) ssq[row * 16 + u.pn * 4 + wc] = s;
      }
      __builtin_amdgcn_sched_barrier(0);
    }
  }
};

__device__ __forceinline__ void prep_tile(const float* src, int ldn, int k0, int n0, const float* rscale, float cscale, bf16_t* dst, int ldd, int drow0, int dk0, LAS float* tile) {
  const int tid = opaque_tid(), kk = tid >> 6, nn = tid & 63;
#pragma unroll
  for (int i = 0; i < 8; ++i) {
    const int k = kk * 8 + i;
    float v = src[(size_t)(k0 + k) * ldn + n0 + nn] * cscale;
    if (rscale) v *= rscale[k0 + k];
    tile[k * 65 + nn] = v;
  }
  __syncthreads();
  const int n = tid >> 3, kc = tid & 7;
  float f[8];
#pragma unroll
  for (int j = 0; j < 8; ++j) f[j] = tile[(kc * 8 + j) * 65 + n];
  u32x4 pk = {cvt_pk_bf16(f[0], f[1]), cvt_pk_bf16(f[2], f[3]), cvt_pk_bf16(f[4], f[5]), cvt_pk_bf16(f[6], f[7])};
  *(u32x4*)(dst + (size_t)(drow0 + n) * ldd + dk0 + kc * 8) = pk;
  __syncthreads();
}

__device__ __forceinline__ void win_map(int n0, int& dn0, float& sc) {
  sc = 1.0f;
  if (n0 < 512) { dn0 = U_QA + n0; sc = QSCALE; }
  else if (n0 < 1024) dn0 = U_KA + (n0 - 512);
  else if (n0 < 1536) dn0 = UW + V_A + (n0 - 1024);
  else if (n0 < 2048) dn0 = U_ZA + (n0 - 1536);
  else if (n0 < 2560) { dn0 = U_QB + (n0 - 2048); sc = QSCALE; }
  else if (n0 < 3072) dn0 = U_KB + (n0 - 2560);
  else if (n0 < 3584) dn0 = UW + V_B + (n0 - 3072);
  else if (n0 < 4096) dn0 = U_ZB + (n0 - 3584);
  else if (n0 < 4864) { dn0 = U_QC + (n0 - 4096); sc = QSCALE; }
  else if (n0 < 5632) dn0 = U_KC + (n0 - 4864);
  else if (n0 < 6400) dn0 = UW + V_C + (n0 - 5632);
  else if (n0 < 6656) dn0 = U_ZC + (n0 - 6400);
  else dn0 = U_GL + (n0 - 6656);
}

__device__ void phase_prep(const Params& p, LAS float* tile) {
  constexpr int PER = 3008;
  for (int it = blockIdx.x; it < DEPTH * PER; it += gridDim.x) {
    const int l = it / PER; int r = it % PER;
    if (r < 2432) {
      const int kt = r / 152, ntile = r % 152; int dn0; float sc; win_map(ntile * 64, dn0, sc);
      prep_tile(p.w_in + (size_t)l * DM * INW, INW, kt * 64, ntile * 64, p.g_norm + l * DM, sc, p.wt_in + (size_t)l * INW * DM, DM, dn0, kt * 64, tile);
    } else if ((r -= 2432) < 128) {
      const int kt = r / 16, ntile = r % 16;
      prep_tile(p.w_br_a + (size_t)l * 512 * DM, DM, kt * 64, ntile * 64, nullptr, 1.0f, p.wt_br + (size_t)l * DM * YW, YW, ntile * 64, kt * 64, tile);
    } else if ((r -= 128) < 128) {
      const int kt = r / 16, ntile = r % 16;
      prep_tile(p.w_br_b + (size_t)l * 512 * DM, DM, kt * 64, ntile * 64, nullptr, 1.0f, p.wt_br + (size_t)l * DM * YW, YW, ntile * 64, 512 + kt * 64, tile);
    } else if ((r -= 128) < 64) {
      const int kt = r / 16, ntile = r % 16;
      prep_tile(p.w_br_c + (size_t)l * 256 * DM, DM, kt * 64, ntile * 64, nullptr, 1.0f, p.wt_br + (size_t)l * DM * YW, YW, ntile * 64, 1024 + kt * 64, tile);
    } else {
      r -= 64; const int kt = r / 16, ntile = r % 16;
      prep_tile(p.w_out + (size_t)l * DM * DM, DM, kt * 64, ntile * 64, nullptr, 1.0f, p.wt_out + (size_t)l * DM * DM, DM, ntile * 64, kt * 64, tile);
    }
  }
  const int ptid = opaque_tid();
  if (blockIdx.x == 0 && ptid < 64) {
    const int lane = ptid;
    for (int l = 0; l < DEPTH; ++l) {
      const float* lq = p.lam_qk + l * 256;
      float a = lq[lane] * lq[64 + lane], b = lq[128 + lane] * lq[192 + lane];
      for (int o = 32; o >= 1; o >>= 1) { a += __shfl_xor(a, o); b += __shfl_xor(b, o); }
      if (lane == 0) { const float li = 0.8f - 0.6f * expf(-0.3f * (float)l); p.lam[l] = expf(a) - expf(b) + li; p.lam[4 + l] = 1.0f - li; }
    }
  }
}

__device__ void phase_x(const Params& p, int chunk) {
  const float* xin = (chunk < 2) ? p.xp + (size_t)chunk * TC * DM : p.xs + (size_t)(chunk - 2) * TC * DM;
  float* ssq = p.ssq + (size_t)chunk * TC * 16;
  const int tid = opaque_tid(), lane = tid & 63, w = blockIdx.x * 8 + (tid >> 6), nw = gridDim.x * 8;
  for (int row = w; row < TC; row += nw) {
    const float* xr = xin + (size_t)row * DM + lane * 16;
    f32x4 v[4]; float s = 0.f;
#pragma unroll
    for (int i = 0; i < 4; ++i) { v[i] = *(const f32x4*)(xr + i * 4); s += v[i][0] * v[i][0] + v[i][1] * v[i][1] + v[i][2] * v[i][2] + v[i][3] * v[i][3]; }
    for (int o = 32; o >= 1; o >>= 1) s += __shfl_xor(s, o);
    u32x4 p0 = {cvt_pk_bf16(v[0][0], v[0][1]), cvt_pk_bf16(v[0][2], v[0][3]), cvt_pk_bf16(v[1][0], v[1][1]), cvt_pk_bf16(v[1][2], v[1][3])};
    u32x4 p1 = {cvt_pk_bf16(v[2][0], v[2][1]), cvt_pk_bf16(v[2][2], v[2][3]), cvt_pk_bf16(v[3][0], v[3][1]), cvt_pk_bf16(v[3][2], v[3][3])};
    bf16_t* xo = p.xb + (size_t)row * DM + lane * 16;
    *(u32x4*)xo = p0; *(u32x4*)(xo + 8) = p1;
    if (lane < 16) ssq[(size_t)row * 16 + lane] = (lane == 0) ? s : 0.f;
    if (lane == 0) p.rinv[(size_t)chunk * TC + row] = rsqrtf(s * (1.0f / 1024.0f) + 1e-6f);
  }
}

__device__ void phase_rinv(const Params& p, int chunk) {
  const float* ssq = p.ssq + (size_t)chunk * TC * 16; float* rv = p.rinv + (size_t)chunk * TC;
  for (int row = blockIdx.x * 512 + opaque_tid(); row < TC; row += gridDim.x * 512) {
    const f32x4* sp = (const f32x4*)(ssq + (size_t)row * 16);
    const f32x4 a4 = sp[0] + sp[1] + sp[2] + sp[3];
    rv[row] = rsqrtf((a4[0] + a4[1] + a4[2] + a4[3]) * (1.0f / 1024.0f) + 1e-6f);
  }
}

__device__ void phase_final(const Params& p, int chunk) {
  float* x = p.out + (size_t)chunk * TC * DM;
  const float* ssq = p.ssq + (size_t)chunk * TC * 16;
  const int tid = opaque_tid(), lane = tid & 63, w = blockIdx.x * 8 + (tid >> 6), nw = gridDim.x * 8;
  for (int row = w; row < TC; row += nw) {
    const f32x4* sp = (const f32x4*)(ssq + (size_t)row * 16);
    const f32x4 a4 = sp[0] + sp[1] + sp[2] + sp[3];
    const float rinv = rsqrtf((a4[0] + a4[1] + a4[2] + a4[3]) * (1.0f / 1024.0f) + 1e-6f);
    float* xr = x + (size_t)row * DM + lane * 16;
#pragma unroll
    for (int i = 0; i < 4; ++i) { f32x4 v = *(const f32x4*)(xr + i * 4); const f32x4 g = *(const f32x4*)(p.g_final + lane * 16 + i * 4); v = v * rinv * g; *(f32x4*)(xr + i * 4) = v; }
  }
}

__device__ __forceinline__ f32x16 mfma32(bf16x8 a, bf16x8 b, f32x16 c) { return __builtin_amdgcn_mfma_f32_32x32x16_bf16(a, b, c, 0, 0, 0); }
__device__ __forceinline__ bf16x8 ld16(const bf16_t* p) { return *(const bf16x8*)p; }
__device__ __forceinline__ bf16x8 ld8x2(const bf16_t* p0, const bf16_t* p1) { const bf16x4 a = *(const bf16x4*)p0, b = *(const bf16x4*)p1; return __builtin_shufflevector(a, b, 0, 1, 2, 3, 4, 5, 6, 7); }

__device__ __forceinline__ void softmax_tile(f32x16& t, float& m, float& l, float& alpha, bf16x8& p0, bf16x8& p1) {
  float tm = t[0];
#pragma unroll
  for (int i = 1; i < 16; ++i) tm = fmaxf(tm, t[i]);
  tm = fmaxf(tm, __shfl_xor(tm, 32));
  const float mn = fmaxf(m, tm);
  alpha = fexp2(m - mn); m = mn;
  float ls = 0.f;
#pragma unroll
  for (int i = 0; i < 16; ++i) { t[i] = fexp2(t[i] - mn); ls += t[i]; }
  l = l * alpha + ls;
  const u32x4 a = {cvt_pk_bf16(t[0], t[1]), cvt_pk_bf16(t[2], t[3]), cvt_pk_bf16(t[4], t[5]), cvt_pk_bf16(t[6], t[7])};
  const u32x4 b = {cvt_pk_bf16(t[8], t[9]), cvt_pk_bf16(t[10], t[11]), cvt_pk_bf16(t[12], t[13]), cvt_pk_bf16(t[14], t[15])};
  p0 = __builtin_bit_cast(bf16x8, a); p1 = __builtin_bit_cast(bf16x8, b);
}
__device__ __forceinline__ f32x16 zero16() { f32x16 z;
#pragma unroll
  for (int i = 0; i < 16; ++i) z[i] = 0.f; return z; }
__device__ __forceinline__ float silu(float z) { return z * frcp(1.0f + fexp2(-z * LOG2E)); }

constexpr int TB_ROW = 144;
constexpr int KB_BYTES = 64 * TB_ROW;
constexpr int VB_BYTES = 128 * TB_ROW;
constexpr int LDS_K = 0, LDS_V = LDS_K + 2 * KB_BYTES, LDS_ATT_END = LDS_V + 2 * VB_BYTES, LDS_ATT_TOTAL = LDS_ATT_END + 65536;
template <int SIDE>
__device__ __forceinline__ void b_far_subtile(const LAS unsigned char* kb, const LAS unsigned char* vb, int rd, int sub, const bf16x8 (&qf)[4], const f32x16& bp, float slope2, float d0,
                                              float& mrun, float& lrun, f32x16 (&o)[4]) {
  const float base = (SIDE > 0 ? -slope2 : slope2) * d0 - mrun;
  f32x16 sc;
#pragma unroll
  for (int i = 0; i < 16; ++i) sc[i] = SIDE > 0 ? base - bp[i] : base + bp[i];
#pragma unroll
  for (int ks = 0; ks < 4; ++ks) sc = mfma32(*(const LAS bf16x8*)(kb + rd + sub * 32 * TB_ROW + ks * 32), qf[ks], sc);
  float tm = sc[0];
#pragma unroll
  for (int i = 1; i < 16; ++i) tm = fmaxf(tm, sc[i]);
  tm = fmaxf(tm, __shfl_xor(tm, 32));
  if (__builtin_amdgcn_ballot_w64(tm > 0.0f) != 0) {
    const float delta = fmaxf(tm, 0.0f);
    const float al = fexp2(-delta);
    mrun += delta; lrun *= al;
#pragma unroll
    for (int i = 0; i < 16; ++i) sc[i] -= delta;
#pragma unroll
    for (int dt = 0; dt < 4; ++dt) o[dt] *= al;
  }
#pragma unroll
  for (int i = 0; i < 16; ++i) sc[i] = fexp2(sc[i]);
  { const f32x4 a4 = (f32x4){sc[0], sc[1], sc[2], sc[3]} + (f32x4){sc[4], sc[5], sc[6], sc[7]} + (f32x4){sc[8], sc[9], sc[10], sc[11]} + (f32x4){sc[12], sc[13], sc[14], sc[15]};
    lrun += (a4[0] + a4[1]) + (a4[2] + a4[3]); }
  const u32x4 pa = {cvt_pk_bf16(sc[0], sc[1]), cvt_pk_bf16(sc[2], sc[3]), cvt_pk_bf16(sc[4], sc[5]), cvt_pk_bf16(sc[6], sc[7])};
  const u32x4 pb = {cvt_pk_bf16(sc[8], sc[9]), cvt_pk_bf16(sc[10], sc[11]), cvt_pk_bf16(sc[12], sc[13]), cvt_pk_bf16(sc[14], sc[15])};
  const bf16x8 pk0 = __builtin_bit_cast(bf16x8, pa), pk1 = __builtin_bit_cast(bf16x8, pb);
#pragma unroll
  for (int dt = 0; dt < 4; ++dt) {
    o[dt] = mfma32(*(const LAS bf16x8*)(vb + rd + dt * 32 * TB_ROW + (sub * 2) * 32), pk0, o[dt]);
    o[dt] = mfma32(*(const LAS bf16x8*)(vb + rd + dt * 32 * TB_ROW + (sub * 2 + 1) * 32), pk1, o[dt]);
  }
}

__device__ __forceinline__ void attn_b_pass(const Params& p, int L, int seq, int h, int mp, int qblk, int tq, int tid, float slope2, LAS unsigned char* lds, f32x16 (&o)[4], float& linv) {
  const int lane = tid & 63, q = lane & 31, half = lane >> 5;
  const size_t tokbase = (size_t)seq * L;
  bf16x8 qf[4];
  { const bf16_t* qp = p.u + (tokbase + tq) * UW + U_QB + h * 128 + mp * 64 + half * 8;
#pragma unroll
    for (int ks = 0; ks < 4; ++ks) qf[ks] = ld16(qp + ks * 16); }
  const int spart = tid & 7, srow = tid >> 3;
  const bf16_t* kg = p.u + (tokbase + srow) * UW + U_KB + h * 128 + mp * 64 + spart * 8;
  const bf16_t* vg = p.vt + ((size_t)seq * VW + V_B + h * 128 + srow) * L + spart * 8;
  const int kst = srow * TB_ROW + spart * 16;
  const int vst = srow * TB_ROW + ((spart >> 1) * 16 + (spart & 1) * 4) * 2;
  const int rd = q * TB_ROW + half * 16;
#pragma unroll
  for (int dt = 0; dt < 4; ++dt) o[dt] = zero16();
  float mrun = -1e30f, lrun = 0.f;
  f32x16 bp;
#pragma unroll
  for (int i = 0; i < 16; ++i) bp[i] = slope2 * (float)((i >> 2) * 8 + (i & 3));
  const int ntile = L >> 6, t0 = qblk * 4, nR = ntile - t0;
  auto tile_of = [&](int idx) { return idx < nR ? t0 + idx : (t0 - 1) - (idx - nR); };
  bf16x8 krA, vrA0, vrA1, krB, vrB0, vrB1;
  auto gload = [&](int idx, bf16x8& kr, bf16x8& v0, bf16x8& v1) { const int kn = tile_of(idx) * 64; kr = ld16(kg + (size_t)kn * UW); v0 = ld16(vg + kn); v1 = ld16(vg + (size_t)64 * L + kn); };
  auto lwrite = [&](int buf, const bf16x8& kr, const bf16x8& v0, const bf16x8& v1) {
    LAS unsigned char* kb = lds + LDS_K + buf * KB_BYTES; LAS unsigned char* vb = lds + LDS_V + buf * VB_BYTES;
    *(LAS bf16x8*)(kb + kst) = kr;
    *(LAS bf16x4*)(vb + vst) = __builtin_shufflevector(v0, v0, 0, 1, 2, 3); *(LAS bf16x4*)(vb + vst + 16) = __builtin_shufflevector(v0, v0, 4, 5, 6, 7);
    *(LAS bf16x4*)(vb + vst + 64 * TB_ROW) = __builtin_shufflevector(v1, v1, 0, 1, 2, 3); *(LAS bf16x4*)(vb + vst + 64 * TB_ROW + 16) = __builtin_shufflevector(v1, v1, 4, 5, 6, 7);
  };
  auto compute = [&](int idx, int buf) {
    const int k0 = tile_of(idx) * 64;
    const LAS unsigned char* kb = lds + LDS_K + buf * KB_BYTES;
    const LAS unsigned char* vb = lds + LDS_V + buf * VB_BYTES;
    if (idx < 4) {
#pragma unroll
      for (int sub = 0; sub < 2; ++sub) {
        f32x16 sc = zero16();
#pragma unroll
        for (int ks = 0; ks < 4; ++ks) sc = mfma32(*(const LAS bf16x8*)(kb + rd + sub * 32 * TB_ROW + ks * 32), qf[ks], sc);
        const float d0 = (float)(k0 + sub * 32 + half * 4 - tq);
#pragma unroll
        for (int i = 0; i < 16; ++i) sc[i] -= slope2 * fabsf(d0 + (float)((i >> 2) * 8 + (i & 3)));
        float al; bf16x8 pk[2];
        softmax_tile(sc, mrun, lrun, al, pk[0], pk[1]);
        if (__builtin_amdgcn_ballot_w64(al != 1.0f) != 0) {
#pragma unroll
          for (int dt = 0; dt < 4; ++dt) o[dt] *= al;
        }
#pragma unroll
        for (int dt = 0; dt < 4; ++dt)
#pragma unroll
          for (int s2 = 0; s2 < 2; ++s2) o[dt] = mfma32(*(const LAS bf16x8*)(vb + rd + dt * 32 * TB_ROW + (sub * 2 + s2) * 32), pk[s2], o[dt]);
      }
    } else if (idx < nR) {
#pragma unroll
      for (int sub = 0; sub < 2; ++sub) b_far_subtile<1>(kb, vb, rd, sub, qf, bp, slope2, (float)(k0 + sub * 32 + half * 4 - tq), mrun, lrun, o);
    } else {
#pragma unroll
      for (int sub = 0; sub < 2; ++sub) b_far_subtile<-1>(kb, vb, rd, sub, qf, bp, slope2, (float)(k0 + sub * 32 + half * 4 - tq), mrun, lrun, o);
    }
  };
  gload(0, krA, vrA0, vrA1);
  gload(1, krB, vrB0, vrB1);
  lwrite(0, krA, vrA0, vrA1);
  asm volatile("" : "+v"(qf[0]), "+v"(qf[1]), "+v"(qf[2]), "+v"(qf[3]));
  asm volatile("" : "+v"(krB), "+v"(vrB0), "+v"(vrB1));
  __syncthreads();
#pragma unroll 1
  for (int idx = 0; idx < ntile; idx += 2) {
    if (idx + 2 < ntile) gload(idx + 2, krA, vrA0, vrA1);
    compute(idx, 0);
    lwrite(1, krB, vrB0, vrB1);
    __syncthreads();
    if (idx + 3 < ntile) gload(idx + 3, krB, vrB0, vrB1);
    compute(idx + 1, 1);
    if (idx + 2 < ntile) lwrite(0, krA, vrA0, vrA1);
    __syncthreads();
  }
  linv = frcp(lrun + __shfl_xor(lrun, 32));
}
__device__ void attn_b_block(const Params& p, int layer, int L, int seq, int h, int qblk, LAS unsigned char* lds) {
  const int tid = opaque_tid(), lane = tid & 63, wid = __builtin_amdgcn_readfirstlane(tid >> 6);
  const int q = lane & 31, half = lane >> 5;
  const size_t tokbase = (size_t)seq * L;
  const int tq = qblk * 256 + wid * 32 + q;
  const float slope2 = exp2f(-2.0f * (float)(h + 1)) * LOG2E;
  f32x16 o0[4]; float li0, li1;
  LAS u32x4* park = (LAS u32x4*)(lds + LDS_ATT_END) + wid * 512 + lane;
  attn_b_pass(p, L, seq, h, 0, qblk, tq, tid, slope2, lds, o0, li0);
#pragma unroll
  for (int dt = 0; dt < 4; ++dt)
#pragma unroll
    for (int g2 = 0; g2 < 2; ++g2) {
      u32x4 pk;
#pragma unroll
      for (int k = 0; k < 4; ++k) pk[k] = cvt_pk_bf16(o0[dt][g2 * 8 + 2 * k] * li0, o0[dt][g2 * 8 + 2 * k + 1] * li0);
      park[(dt * 2 + g2) * 64] = pk;
    }
  attn_b_pass(p, L, seq, h, 1, qblk, tq, tid, slope2, lds, o0, li1);
  const float c1 = p.lam[layer] * li1;
  const int tid2 = opaque_tid(), half2 = (tid2 >> 5) & 1;
  const size_t tok2 = (size_t)seq * L + qblk * 256 + (tid2 >> 6) * 32 + (tid2 & 31);
  float ss = 0.f;
#pragma unroll
  for (int dt = 0; dt < 4; ++dt)
#pragma unroll
    for (int g2 = 0; g2 < 2; ++g2) {
      const u32x4 pk = park[(dt * 2 + g2) * 64];
#pragma unroll
      for (int k = 0; k < 4; ++k) {
        const float va = bf_lo(pk[k]) - o0[dt][g2 * 8 + 2 * k] * c1, vb = bf_hi(pk[k]) - o0[dt][g2 * 8 + 2 * k + 1] * c1;
        o0[dt][g2 * 8 + 2 * k] = va; o0[dt][g2 * 8 + 2 * k + 1] = vb; ss += va * va + vb * vb;
      }
    }
  ss += __shfl_xor(ss, 32);
  const float rn = rsqrtf(ss * (1.0f / 128.0f) + 1e-6f) * p.lam[4 + layer];
  const float* gd = p.g_diff + layer * 128;
  bf16_t* yrow = p.yg + tok2 * YW + 512 + h * 128;
  const bf16_t* zrow = p.u + tok2 * UW + U_ZB + h * 128;
#pragma unroll
  for (int dt = 0; dt < 4; ++dt)
#pragma unroll
    for (int g4 = 0; g4 < 4; ++g4) {
      const int dim = dt * 32 + g4 * 8 + half2 * 4;
      const u32x2 zr = *(const u32x2*)(zrow + dim);
      const f32x4 gv = *(const f32x4*)(gd + dim);
      const float y0 = o0[dt][g4 * 4 + 0] * rn * gv[0] * silu(bf_lo(zr[0]));
      const float y1 = o0[dt][g4 * 4 + 1] * rn * gv[1] * silu(bf_hi(zr[0]));
      const float y2 = o0[dt][g4 * 4 + 2] * rn * gv[2] * silu(bf_lo(zr[1]));
      const float y3 = o0[dt][g4 * 4 + 3] * rn * gv[3] * silu(bf_hi(zr[1]));
      u32x2 pk = {cvt_pk_bf16(y0, y1), cvt_pk_bf16(y2, y3)};
      *(u32x2*)(yrow + dim) = pk;
    }
}

constexpr int LDS_AK = 0, LDS_AV = LDS_AK + 2 * KB_BYTES, LDS_ATAB = LDS_AV + 2 * KB_BYTES, ATAB_ROW = 128;
__device__ void attn_a_block(const Params& p, int layer, int L, int seq, int h, int r0, LAS unsigned char* lds) {
  const int tid = opaque_tid(), lane = tid & 63, wid = __builtin_amdgcn_readfirstlane(tid >> 6);
  const int q = lane & 31, half = lane >> 5;
  const size_t tokbase = (size_t)seq * L;
  const int rows = L >> 6;
  const int ra = r0 + (wid >> 2) * 2, c0 = (wid & 3) * 16;
  int kstart = c0 - 8; kstart = kstart < 0 ? 0 : (kstart > 32 ? 32 : kstart);
  const int qrow = ra + (q >> 4), qcol = c0 + (q & 15), tq = qrow * 64 + qcol;
  int rsq = qrow - 4; rsq = rsq < 0 ? 0 : (rsq > rows - 8 ? rows - 8 : rsq);
  int rsa = ra - 4; rsa = rsa < 0 ? 0 : (rsa > rows - 8 ? rows - 8 : rsa);
  int rsb = ra - 3; rsb = rsb < 0 ? 0 : (rsb > rows - 8 ? rows - 8 : rsb);
  int kr_lo = r0 - 4; kr_lo = kr_lo < 0 ? 0 : (kr_lo > rows - 8 ? rows - 8 : kr_lo);
  int kr_hi = r0 - 1; kr_hi = (kr_hi < 0 ? 0 : (kr_hi > rows - 8 ? rows - 8 : kr_hi)) + 7;
  int qstart = qcol - 8; qstart = qstart < 0 ? 0 : (qstart > 48 ? 48 : qstart);
  bf16x8 qf[4];
  { const bf16_t* qp = p.u + (tokbase + tq) * UW + U_QA + h * 64 + half * 8;
#pragma unroll
    for (int ks = 0; ks < 4; ++ks) qf[ks] = ld16(qp + ks * 16); }
  {
    LAS float* tab = (LAS float*)(lds + LDS_ATAB);
    const float* rpb = p.rpb + ((size_t)layer * 8 + h) * 15 * 31;
    for (int idx = tid; idx < 15 * ATAB_ROW; idx += 512) { const int row = idx >> 7, cc = (idx & 127) - 48; tab[idx] = (cc >= 0 && cc <= 30) ? rpb[row * 31 + cc] * LOG2E : 0.f; }
  }
  const int spart = tid & 7, srow = tid >> 3;
  const bf16_t* kg = p.u + (tokbase + srow) * UW + U_KA + h * 64 + spart * 8;
  const bf16_t* vg = p.vt + ((size_t)seq * VW + V_A + h * 64 + srow) * L + spart * 8;
  const int kst = srow * TB_ROW + spart * 16;
  const int vst = srow * TB_ROW + spart * 16;
  const int krd = (kstart + q) * TB_ROW + half * 16;
  const int vrd = q * TB_ROW + (kstart + half * 4) * 2;
  f32x16 o[2] = {zero16(), zero16()};
  float mrun = -1e30f, lrun = 0.f;
  bf16x8 kr_, vr_;
  kr_ = ld16(kg + (size_t)(kr_lo * 64) * UW); vr_ = ld16(vg + kr_lo * 64);
  *(LAS bf16x8*)(lds + LDS_AK + kst) = kr_;
  *(LAS bf16x8*)(lds + LDS_AV + vst) = vr_;
  asm volatile("" : "+v"(qf[0]), "+v"(qf[1]), "+v"(qf[2]), "+v"(qf[3]));
  __syncthreads();
#pragma unroll 1
  for (int kr = kr_lo; kr <= kr_hi; ++kr) {
    const int it = kr - kr_lo;
    const bool more = (kr < kr_hi);
    if (more) { kr_ = ld16(kg + (size_t)((kr + 1) * 64) * UW); vr_ = ld16(vg + (kr + 1) * 64); }
    const LAS unsigned char* kb = lds + LDS_AK + (it & 1) * KB_BYTES;
    const LAS unsigned char* vb = lds + LDS_AV + (it & 1) * KB_BYTES;
    if (kr >= rsa && kr < rsb + 8) {
      const bool rowok = (kr >= rsq) && (kr < rsq + 8);
      int trow_i = kr - qrow + 7; trow_i = trow_i < 0 ? 0 : (trow_i > 14 ? 14 : trow_i);
      const LAS float* trow = (const LAS float*)(lds + LDS_ATAB) + trow_i * ATAB_ROW + (kstart + half * 4 - qcol + 15 + 48);
      f32x16 sc = zero16();
#pragma unroll
      for (int ks = 0; ks < 4; ++ks) sc = mfma32(*(const LAS bf16x8*)(kb + krd + ks * 32), qf[ks], sc);
#pragma unroll
      for (int ii = 0; ii < 16; ++ii) {
        const int kcol = kstart + (ii >> 2) * 8 + half * 4 + (ii & 3);
        const bool ok = rowok && (kcol >= qstart) && (kcol < qstart + 16);
        sc[ii] = ok ? sc[ii] + trow[(ii >> 2) * 8 + (ii & 3)] : -INFINITY;
      }
      float al; bf16x8 pk[2];
      softmax_tile(sc, mrun, lrun, al, pk[0], pk[1]);
      if (__builtin_amdgcn_ballot_w64(al != 1.0f) != 0) { o[0] *= al; o[1] *= al; }
#pragma unroll
      for (int dt = 0; dt < 2; ++dt)
#pragma unroll
        for (int s2 = 0; s2 < 2; ++s2) {
          const LAS unsigned char* vp = vb + vrd + dt * 32 * TB_ROW + s2 * 32;
          const bf16x4 va = *(const LAS bf16x4*)vp, vc = *(const LAS bf16x4*)(vp + 16);
          o[dt] = mfma32(__builtin_shufflevector(va, vc, 0, 1, 2, 3, 4, 5, 6, 7), pk[s2], o[dt]);
        }
    }
    if (more) {
      *(LAS bf16x8*)(lds + LDS_AK + ((it + 1) & 1) * KB_BYTES + kst) = kr_;
      *(LAS bf16x8*)(lds + LDS_AV + ((it + 1) & 1) * KB_BYTES + vst) = vr_;
    }
    __syncthreads();
  }
  const float c = frcp(lrun + __shfl_xor(lrun, 32));
  bf16_t* yrow = p.yg + (tokbase + tq) * YW + h * 64;
  const bf16_t* zrow = p.u + (tokbase + tq) * UW + U_ZA + h * 64;
#pragma unroll
  for (int dt = 0; dt < 2; ++dt)
#pragma unroll
    for (int g4 = 0; g4 < 4; ++g4) {
      const int dim = dt * 32 + g4 * 8 + half * 4;
      const u32x2 zr = *(const u32x2*)(zrow + dim);
      const float y0 = o[dt][g4 * 4 + 0] * c * silu(bf_lo(zr[0]));
      const float y1 = o[dt][g4 * 4 + 1] * c * silu(bf_hi(zr[0]));
      const float y2 = o[dt][g4 * 4 + 2] * c * silu(bf_lo(zr[1]));
      const float y3 = o[dt][g4 * 4 + 3] * c * silu(bf_hi(zr[1]));
      u32x2 pk = {cvt_pk_bf16(y0, y1), cvt_pk_bf16(y2, y3)};
      *(u32x2*)(yrow + dim) = pk;
    }
}

__device__ void attn_c_unit(const Params& p, int L, int lshift, int seq, int g, int h, int rr, int mblk, int lane) {
  const int q = lane & 31, half = lane >> 5;
  const size_t tokbase = (size_t)seq * L;
  const int ds = (g == 0) ? 0 : (g == 1 ? 2 : 4), d = 1 << ds, M = L >> ds;
  const int hh = g * 4 + h;
  const int m0 = mblk * 32, mq = m0 + q, tq = mq * d + rr;
  const bf16_t* urow = p.u + (tokbase + tq) * UW;
  bf16x8 qf[4];
#pragma unroll
  for (int ks = 0; ks < 4; ++ks) qf[ks] = ld16(urow + U_QC + hh * 64 + ks * 16 + half * 8);
  f32x16 o[2] = {zero16(), zero16()};
  float mrun = -1e30f, lrun = 0.f;
  const float coef = exp2f(-(2.0f / 3.0f) * (float)(hh + 1)) * (float)d * LOG2E;
  const bf16_t* vbase = p.vt + ((size_t)seq * VW + V_C + hh * 64 + q) * L + (size_t)rr * M;
  bf16x8 kf[5][4];
#pragma unroll
  for (int j = 0; j < 5; ++j) {
    int mkl = m0 - 64 + 32 * j + q; mkl = mkl < 0 ? 0 : (mkl > M - 1 ? M - 1 : mkl);
    const bf16_t* kp = p.u + (tokbase + (size_t)mkl * d + rr) * UW + U_KC + hh * 64 + half * 8;
#pragma unroll
    for (int ks = 0; ks < 4; ++ks) kf[j][ks] = ld16(kp + ks * 16);
  }
  bf16x8 vf[2][2][2];
  auto load_v = [&](int j, bf16x8 (&dst)[2][2]) {
#pragma unroll
    for (int dt = 0; dt < 2; ++dt)
#pragma unroll
      for (int s2 = 0; s2 < 2; ++s2) {
        int pa = m0 - 64 + 32 * j + s2 * 16 + half * 4, pb = pa + 8;
        pa = pa < 0 ? 0 : (pa > M - 4 ? M - 4 : pa); pb = pb < 0 ? 0 : (pb > M - 4 ? M - 4 : pb);
        const bf16_t* vp = vbase + (size_t)(dt * 32) * L;
        dst[dt][s2] = ld8x2(vp + pa, vp + pb);
      }
  };
  load_v(0, vf[0]);
#pragma unroll
  for (int j = 0; j < 5; ++j) {
    if (j + 1 < 5) load_v(j + 1, vf[(j + 1) & 1]);
    const int mk0 = m0 - 64 + 32 * j;
    if (mk0 + 32 <= 0 || mk0 >= M) continue;
    f32x16 s = zero16();
#pragma unroll
    for (int ks = 0; ks < 4; ++ks) s = mfma32(kf[j][ks], qf[ks], s);
#pragma unroll
    for (int ii = 0; ii < 16; ++ii) {
      const int mk = mk0 + (ii >> 2) * 8 + half * 4 + (ii & 3);
      const int rel = mk - mq; const int ar = rel < 0 ? -rel : rel;
      const bool ok = (mk >= 0) && (mk < M) && (ar <= 64);
      s[ii] = ok ? s[ii] - coef * (float)ar : -INFINITY;
    }
    float alpha; bf16x8 pk[2];
    softmax_tile(s, mrun, lrun, alpha, pk[0], pk[1]);
#pragma unroll
    for (int dt = 0; dt < 2; ++dt) {
      o[dt] *= alpha;
#pragma unroll
      for (int s2 = 0; s2 < 2; ++s2) o[dt] = mfma32(vf[j & 1][dt][s2], pk[s2], o[dt]);
    }
  }
  const float lt = lrun + __shfl_xor(lrun, 32);
  const float c = frcp(lt);
  bf16_t* orow = p.oc + (tokbase + tq) * 768 + hh * 64;
#pragma unroll
  for (int dt = 0; dt < 2; ++dt)
#pragma unroll
    for (int g4 = 0; g4 < 4; ++g4) {
      const int dim = dt * 32 + g4 * 8 + half * 4;
      u32x2 pk = {cvt_pk_bf16(o[dt][g4 * 4 + 0] * c, o[dt][g4 * 4 + 1] * c), cvt_pk_bf16(o[dt][g4 * 4 + 2] * c, o[dt][g4 * 4 + 3] * c)};
      *(u32x2*)(orow + dim) = pk;
    }
  if (half == 0) p.lse[(tokbase + tq) * 12 + hh] = mrun + log2f(lt);
}

constexpr int CV_ROW = 784;
constexpr int LDS_CK = 0, LDS_CV = 384 * TB_ROW;
__device__ void attn_c_block(const Params& p, int L, int lshift, int seq, int g, int h, int pblk, LAS unsigned char* lds) {
  const int tid = opaque_tid(), lane = tid & 63, wid = __builtin_amdgcn_readfirstlane(tid >> 6);
  const int q = lane & 31, half = lane >> 5;
  const size_t tokbase = (size_t)seq * L;
  const int ds = (g == 0) ? 0 : (g == 1 ? 2 : 4), d = 1 << ds, M = L >> ds;
  const int hh = g * 4 + h;
  const int p0 = pblk * 256;
  {
    const int part = tid & 7;
#pragma unroll
    for (int c = 0; c < 6; ++c) {
      const int row = (tid >> 3) + c * 64;
      int pp = p0 - 64 + row; pp = pp < 0 ? 0 : (pp > L - 1 ? L - 1 : pp);
      const int tok = ((pp & (M - 1)) << ds) + (pp >> (lshift - ds));
      const bf16x8 v = ld16(p.u + (tokbase + tok) * UW + U_KC + hh * 64 + part * 8);
      *(LAS bf16x8*)(lds + LDS_CK + row * TB_ROW + part * 16) = v;
    }
#pragma unroll
    for (int c = 0; c < 6; ++c) {
      const int idx = tid + c * 512, dim = idx / 48, c8 = idx % 48;
      int pp = p0 - 64 + c8 * 8; pp = pp < 0 ? 0 : (pp > L - 8 ? L - 8 : pp);
      const bf16x8 v = ld16(p.vt + ((size_t)seq * VW + V_C + hh * 64 + dim) * L + pp);
      LAS unsigned char* dst = lds + LDS_CV + dim * CV_ROW + ((c8 >> 1) * 16 + (c8 & 1) * 4) * 2;
      *(LAS bf16x4*)dst = __builtin_shufflevector(v, v, 0, 1, 2, 3); *(LAS bf16x4*)(dst + 16) = __builtin_shufflevector(v, v, 4, 5, 6, 7);
    }
  }
  const int pw = p0 + wid * 32;
  const int rr = pw >> (lshift - ds), m0 = pw & (M - 1), mq = m0 + q, tq = mq * d + rr;
  bf16x8 qf[4];
  { const bf16_t* qp = p.u + (tokbase + tq) * UW + U_QC + hh * 64 + half * 8;
#pragma unroll
    for (int ks = 0; ks < 4; ++ks) qf[ks] = ld16(qp + ks * 16); }
  f32x16 o[2] = {zero16(), zero16()};
  float mrun = -1e30f, lrun = 0.f;
  const float coef = exp2f(-(2.0f / 3.0f) * (float)(hh + 1)) * (float)d * LOG2E;
  __syncthreads();
#pragma unroll
  for (int j = 0; j < 5; ++j) {
    const int mk0 = m0 - 64 + 32 * j;
    if (mk0 + 32 <= 0 || mk0 >= M) continue;
    const LAS unsigned char* kb = lds + LDS_CK + ((wid + j) * 32 + q) * TB_ROW + half * 16;
    f32x16 sc = zero16();
#pragma unroll
    for (int ks = 0; ks < 4; ++ks) sc = mfma32(*(const LAS bf16x8*)(kb + ks * 32), qf[ks], sc);
#pragma unroll
    for (int ii = 0; ii < 16; ++ii) {
      const int mk = mk0 + (ii >> 2) * 8 + half * 4 + (ii & 3);
      const int rel = mk - mq; const int ar = rel < 0 ? -rel : rel;
      const bool ok = (mk >= 0) && (mk < M) && (ar <= 64);
      sc[ii] = ok ? sc[ii] - coef * (float)ar : -INFINITY;
    }
    float alpha; bf16x8 pk[2];
    softmax_tile(sc, mrun, lrun, alpha, pk[0], pk[1]);
#pragma unroll
    for (int dt = 0; dt < 2; ++dt) {
      o[dt] *= alpha;
#pragma unroll
      for (int s2 = 0; s2 < 2; ++s2)
        o[dt] = mfma32(*(const LAS bf16x8*)(lds + LDS_CV + (dt * 32 + q) * CV_ROW + ((wid + j) * 32 + s2 * 16) * 2 + half * 16), pk[s2], o[dt]);
    }
  }
  __syncthreads();
  const float lt = lrun + __shfl_xor(lrun, 32);
  const float c = frcp(lt);
  bf16_t* orow = p.oc + (tokbase + tq) * 768 + hh * 64;
#pragma unroll
  for (int dt = 0; dt < 2; ++dt)
#pragma unroll
    for (int g4 = 0; g4 < 4; ++g4) {
      const int dim = dt * 32 + g4 * 8 + half * 4;
      u32x2 pk = {cvt_pk_bf16(o[dt][g4 * 4 + 0] * c, o[dt][g4 * 4 + 1] * c), cvt_pk_bf16(o[dt][g4 * 4 + 2] * c, o[dt][g4 * 4 + 3] * c)};
      *(u32x2*)(orow + dim) = pk;
    }
  if (half == 0) p.lse[(tokbase + tq) * 12 + hh] = mrun + log2f(lt);
}

__device__ void phase_attn(const Params& p, int layer, int L, int lshift, LAS unsigned char* lds) {
  const int tiles = L >> 5;
  const int nseq = TC >> lshift;
  const int nw = gridDim.x * 8;
  int w, lane;
  { const int qblks = L >> 8, npairs = nseq * 4, nunits = npairs * qblks;
    for (int b = blockIdx.x; b < nunits; b += gridDim.x) {
      int pair, qblk;
      if ((gridDim.x & 7) == 0 && (npairs & 7) == 0 && nunits == (int)gridDim.x) { const int xcd = b & 7, j = b >> 3; pair = xcd * (npairs >> 3) + j / qblks; qblk = j % qblks; }
      else { pair = b / qblks; qblk = b % qblks; }
      attn_b_block(p, layer, L, pair >> 2, pair & 3, qblk, lds);
    }
  }
  { const int tid = opaque_tid(); lane = tid & 63; w = blockIdx.x * 8 + __builtin_amdgcn_readfirstlane(tid >> 6); }
  {
  { const int rgs = L >> 8, nunits = nseq * 8 * rgs;
    for (int b = blockIdx.x; b < nunits; b += gridDim.x) { const int sh = b / rgs, rg = b % rgs; attn_a_block(p, layer, L, sh >> 3, sh & 7, rg * 4, lds); }
  }
  { const int tid = opaque_tid(); lane = tid & 63; w = blockIdx.x * 8 + __builtin_amdgcn_readfirstlane(tid >> 6); }
  { const int pbs = L >> 8, nunits = nseq * 12 * pbs;
    for (int b = blockIdx.x; b < nunits; b += gridDim.x) {
      const int pblk = b % pbs, sgh = b / pbs;
      const int seq = sgh / 12, gh = sgh % 12;
      attn_c_block(p, L, lshift, seq, gh >> 2, gh & 3, pblk, lds);
    }
  }
  }
}

__device__ void phase_combine(const Params& p) {
  const int gt = blockIdx.x * 512 + opaque_tid(), ngt = gridDim.x * 512;
  for (int it = gt; it < TC * 32; it += ngt) {
    const int tok = it >> 5, sub = it & 31, h = sub >> 3, d8 = (sub & 7) * 8;
    const float* ls = p.lse + (size_t)tok * 12;
    const float l0 = ls[h], l1 = ls[4 + h], l2 = ls[8 + h];
    const float mx = fmaxf(l0, fmaxf(l1, l2));
    const float w0 = fexp2(l0 - mx), w1 = fexp2(l1 - mx), w2 = fexp2(l2 - mx);
    const float inv = frcp(w0 + w1 + w2);
    const bf16_t* ob = p.oc + (size_t)tok * 768 + h * 64 + d8;
    const u32x4 a = *(const u32x4*)ob, b = *(const u32x4*)(ob + 256), c = *(const u32x4*)(ob + 512);
    const u32x4 z = *(const u32x4*)(p.u + (size_t)tok * UW + U_ZC + h * 64 + d8);
    u32x4 r;
#pragma unroll
    for (int k = 0; k < 4; ++k) {
      const float vlo = (w0 * bf_lo(a[k]) + w1 * bf_lo(b[k]) + w2 * bf_lo(c[k])) * inv * silu(bf_lo(z[k]));
      const float vhi = (w0 * bf_hi(a[k]) + w1 * bf_hi(b[k]) + w2 * bf_hi(c[k])) * inv * silu(bf_hi(z[k]));
      r[k] = cvt_pk_bf16(vlo, vhi);
    }
    *(u32x4*)(p.yg + (size_t)tok * YW + 1024 + h * 64 + d8) = r;
  }
}


#define XB_TMO      128
#define XB_XCNT(j)  (256  + 64 * (j))
#define XB_XSUB(j)  (1280 + 64 * (j))
#define XB_XGEN(j)  (2304 + 64 * (j))
#define XB_TOP      3328
#define XB_TOPGEN   3392
#define XCD_BAR_WORDS 3456
#define XB_SPIN_CAP (1u << 18)
__device__ __forceinline__ unsigned xb_ld(unsigned* p)              { return __hip_atomic_load(p, __ATOMIC_RELAXED, __HIP_MEMORY_SCOPE_AGENT); }
__device__ __forceinline__ unsigned xb_add(unsigned* p, unsigned v) { return __hip_atomic_fetch_add(p, v, __ATOMIC_RELAXED, __HIP_MEMORY_SCOPE_AGENT); }
__device__ __forceinline__ unsigned xb_xcc_id() { return (unsigned)__builtin_amdgcn_s_getreg((3 << 11) | 20) & 0xFu; }
#define XB_SPIN(cond, bar) do { unsigned _sp = 0; while (cond) { __builtin_amdgcn_s_sleep(1); \
    if ((++_sp & 255u) == 0u) { if (xb_ld(&(bar)[XB_TMO])) break; if (_sp > XB_SPIN_CAP) { atomicAdd(&(bar)[XB_TMO], 1u); break; } } } } while (0)
struct XcdBarrier { unsigned* bar; unsigned x; volatile LAS unsigned* st; };
__device__ __forceinline__ XcdBarrier xcd_barrier_post(unsigned* bar, volatile LAS unsigned* st) {
  XcdBarrier b; b.bar = bar; b.x = xb_xcc_id(); b.st = st;
  if (opaque_tid() == 0) (void)xb_add(&bar[XB_XCNT(b.x)], 1u);
  return b;
}
__device__ __forceinline__ void xcd_barrier_complete(unsigned* bar, unsigned x, unsigned& nloc, unsigned& nx) {
  const unsigned G = gridDim.x * gridDim.y * gridDim.z;
  unsigned sum, cnt, mine, sp = 0u;
  for (;;) {
    sum = 0u; cnt = 0u; mine = 0u;
#pragma unroll
    for (unsigned j = 0; j < 16; ++j) { const unsigned c = xb_ld(&bar[XB_XCNT(j)]); sum += c; cnt += (c > 0u) ? 1u : 0u; mine = (j == x) ? c : mine; }
    if (sum == G) break;
    __builtin_amdgcn_s_sleep(1);
    if ((++sp & 255u) == 0u) { if (xb_ld(&bar[XB_TMO])) break; if (sp > XB_SPIN_CAP) { atomicAdd(&bar[XB_TMO], 1u); break; } }
  }
  nloc = mine > 0u ? mine : 1u; nx = cnt > 0u ? cnt : 1u;
}
__device__ __forceinline__ void xcd_barrier(const XcdBarrier& b) {
  asm volatile("s_waitcnt vmcnt(0)" ::: "memory");
  __syncthreads();
  if (opaque_tid() == 0) {
    unsigned* bar = b.bar;
    __builtin_amdgcn_s_waitcnt(0);
    unsigned nloc = b.st[0], nx = b.st[1];
    if (nloc == 0u) { xcd_barrier_complete(bar, b.x, nloc, nx); b.st[0] = nloc; b.st[1] = nx; }
    const unsigned old = xb_add(&bar[XB_XSUB(b.x)], 1u);
    const unsigned gen = old / nloc;
    if (old + 1u == (gen + 1u) * nloc) {
      __builtin_amdgcn_fence(__ATOMIC_RELEASE, "agent");
      asm volatile("s_waitcnt vmcnt(0)" ::: "memory");
      const unsigned og = xb_add(&bar[XB_TOP], 1u);
      const unsigned tg = og / nx;
      if (og + 1u == (tg + 1u) * nx) xb_add(&bar[XB_TOPGEN], 1u);
      else XB_SPIN(xb_ld(&bar[XB_TOPGEN]) == tg, bar);
      __builtin_amdgcn_fence(__ATOMIC_ACQUIRE, "agent");
      xb_add(&bar[XB_XGEN(b.x)], 1u);
      asm volatile("s_waitcnt vmcnt(0)" ::: "memory");
    } else {
      XB_SPIN(xb_ld(&bar[XB_XGEN(b.x)]) == gen, bar);
      __builtin_amdgcn_fence(__ATOMIC_ACQUIRE, "agent");
      asm volatile("s_waitcnt vmcnt(0)" ::: "memory");
    }
  }
  __syncthreads();
}

constexpr int DYN_LDS_BYTES = LDS_ATT_TOTAL > pg8::STAGE_BYTES ? LDS_ATT_TOTAL : pg8::STAGE_BYTES;
__global__ void __launch_bounds__(512) fwd_megakernel(Params p) {
  extern __shared__ __attribute__((aligned(16))) unsigned char smem[];
  __shared__ __attribute__((aligned(16))) unsigned xb_words[4];
  cg::grid_group grid = cg::this_grid();
  if (threadIdx.x == 0) { xb_words[0] = 0u; xb_words[1] = 0u; xb_words[2] = 0u; xb_words[3] = 0u; }
  if ((threadIdx.x & 63) == 0) g_wid_table[hw_wave_slot()] = (int)(threadIdx.x >> 6);
  __syncthreads();
  const XcdBarrier xb = xcd_barrier_post(p.bar, (volatile LAS unsigned*)xb_words);
#define GSYNC() xcd_barrier(xb)
  LAS unsigned char* lds = (LAS unsigned char*)smem;
  phase_prep(p, (LAS float*)smem);
  phase_x(p, 0);
  grid.sync();
  for (int chunk = 0; chunk < NCHUNK; ++chunk) {
    const int L = chunk < 2 ? 2048 : 4096, lshift = chunk < 2 ? 11 : 12;
    const float* xin = (chunk < 2) ? p.xp + (size_t)chunk * TC * DM : p.xs + (size_t)(chunk - 2) * TC * DM;
    float* xres = p.out + (size_t)chunk * TC * DM;
    float* ssq = p.ssq + (size_t)chunk * TC * 16;
    for (int layer = 0; layer < DEPTH; ++layer) {
      {
        {
        { pg8::Gemm g{p.xb, p.wt_in + (size_t)layer * INW * DM, TC, UW, DM, 0, lshift};
          pg8::StaticOrder S; S.init(TC, UW, gridDim.x, blockIdx.x);
          EpiU E{p.u, p.rinv + (size_t)chunk * TC, p.b_gate + (size_t)layer * 3 * DM};
          pg8::gemm_phase<false>(lds, g, S, E); }
        {
          pg8::Gemm g{p.wt_in + ((size_t)layer * INW + UW) * DM, p.xb, VW, TC, DM, 1, lshift};
          pg8::StaticOrder S; S.init(VW, TC, gridDim.x, (blockIdx.x + (gridDim.x >> 2)) % gridDim.x);
          EpiVT E{p.vt, p.rinv + (size_t)chunk * TC, L, lshift};
          pg8::gemm_phase<true>(lds, g, S, E); }
        }
      }
      GSYNC();
      phase_attn(p, layer, L, lshift, lds);
      GSYNC();
      phase_combine(p);
      GSYNC();
      {
        pg8::Gemm g{p.yg, p.wt_br + (size_t)layer * DM * YW, TC, DM, YW, 0, 0};
        pg8::StaticOrder S; S.init(TC, DM, gridDim.x, blockIdx.x);
        EpiMerge E{p.u, p.merged};
        pg8::gemm_phase<false>(lds, g, S, E);
      }
      GSYNC();
      {
        pg8::Gemm g{p.merged, p.wt_out + (size_t)layer * DM * DM, TC, DM, DM, 0, 0};
        pg8::StaticOrder S; S.init(TC, DM, gridDim.x, blockIdx.x);
        EpiRes E{layer == 0 ? xin : (const float*)xres, xres, p.xb, ssq};
        pg8::gemm_phase<false>(lds, g, S, E);
      }
      GSYNC();
      if (layer + 1 < DEPTH) { phase_rinv(p, chunk); GSYNC(); }
    }
    phase_final(p, chunk);
    if (chunk + 1 < NCHUNK) { phase_x(p, chunk + 1); GSYNC(); }
  }
}

extern "C" void kernel_launch(void* const* d_in, const int* in_sizes, int n_in, void* d_out, int out_size, void* d_ws, size_t ws_size, hipStream_t stream) {
  (void)in_sizes; (void)n_in; (void)out_size;
  static int grid_blocks = 0;
  if (!grid_blocks) {
    int dev = 0, cus = 0, per_cu = 0;
    hipGetDevice(&dev);
    hipDeviceGetAttribute(&cus, hipDeviceAttributeMultiprocessorCount, dev);
    hipFuncSetAttribute((const void*)fwd_megakernel, hipFuncAttributeMaxDynamicSharedMemorySize, DYN_LDS_BYTES);
    hipOccupancyMaxActiveBlocksPerMultiprocessor(&per_cu, fwd_megakernel, 512, DYN_LDS_BYTES);
    if (per_cu < 1) per_cu = 1;
    grid_blocks = cus * per_cu;
    if (grid_blocks > 256) grid_blocks = 256;
  }
  Params p{};
  p.xp = (const float*)d_in[0]; p.xs = (const float*)d_in[1]; p.g_norm = (const float*)d_in[2]; p.w_in = (const float*)d_in[3];
  p.b_gate = (const float*)d_in[4]; p.rpb = (const float*)d_in[5]; p.lam_qk = (const float*)d_in[6]; p.g_diff = (const float*)d_in[7];
  p.w_br_a = (const float*)d_in[8]; p.w_br_b = (const float*)d_in[9]; p.w_br_c = (const float*)d_in[10]; p.w_out = (const float*)d_in[11];
  p.g_final = (const float*)d_in[12];
  p.out = (float*)d_out;
  char* w = (char*)d_ws; size_t off = 0;
  auto take = [&](size_t bytes) { char* r = w + off; off += (bytes + 255) & ~(size_t)255; return r; };
  p.wt_in = (bf16_t*)take((size_t)DEPTH * INW * DM * 2);
  p.wt_br = (bf16_t*)take((size_t)DEPTH * DM * YW * 2);
  p.wt_out = (bf16_t*)take((size_t)DEPTH * DM * DM * 2);
  p.xb = (bf16_t*)take((size_t)TC * DM * 2);
  p.u = (bf16_t*)take((size_t)TC * UW * 2);
  p.vt = (bf16_t*)take((size_t)TC * VW * 2);
  p.yg = (bf16_t*)take((size_t)TC * YW * 2);
  p.oc = (bf16_t*)take((size_t)TC * 768 * 2);
  p.merged = (bf16_t*)take((size_t)TC * DM * 2);
  p.lse = (float*)take((size_t)TC * 12 * 4);
  p.ssq = (float*)take((size_t)NTOK * 16 * 4);
  p.lam = (float*)take(256);
  p.rinv = (float*)take((size_t)NTOK * 4);
  p.bar = (unsigned*)take((size_t)XCD_BAR_WORDS * 4);
  if (off > ws_size) fprintf(stderr, "workspace too small: need %zu have %zu\n", off, ws_size);
  hipMemsetAsync(p.bar, 0, (size_t)XCD_BAR_WORDS * 4, stream);
  void* args[] = {&p};
  hipError_t e = hipLaunchCooperativeKernel((void*)fwd_megakernel, dim3(grid_blocks), dim3(512), args, DYN_LDS_BYTES, stream);
  if (e != hipSuccess) fprintf(stderr, "cooperative launch failed: %s (grid %d)\n", hipGetErrorString(e), grid_blocks);
}
```

```cpp
#include <hip/hip_runtime.h>
#include <hip/hip_cooperative_groups.h>
#include <cstdio>
namespace cg = cooperative_groups;

#define LAS __attribute__((address_space(3)))
typedef unsigned short bf16_t;
typedef short bf16x8 __attribute__((ext_vector_type(8)));
typedef short bf16x4 __attribute__((ext_vector_type(4)));
typedef float f32x4 __attribute__((ext_vector_type(4)));
typedef float f32x16 __attribute__((ext_vector_type(16)));
typedef unsigned u32x4 __attribute__((ext_vector_type(4)));
typedef unsigned u32x2 __attribute__((ext_vector_type(2)));

constexpr int DM = 1024, DEPTH = 4, INW = 9728, UW = 7936, VW = 1792, YW = 1280;
constexpr int TC = 16384, NCHUNK = 4, NTOK = 65536;
constexpr float LOG2E = 1.4426950408889634f;
constexpr float QSCALE = 0.125f * LOG2E;
constexpr int U_QA = 0, U_KA = 512, U_ZA = 1024, U_QB = 1536, U_KB = 2048, U_ZB = 2560, U_QC = 3072, U_KC = 3840, U_ZC = 4608, U_GL = 4864;
constexpr int V_A = 0, V_B = 512, V_C = 1024;

struct Params {
  const float *xp, *xs, *g_norm, *w_in, *b_gate, *rpb, *lam_qk, *g_diff, *w_br_a, *w_br_b, *w_br_c, *w_out, *g_final;
  float* out;
  bf16_t *wt_in, *wt_br, *wt_out, *xb, *u, *vt, *yg, *oc, *merged;
  float *lse, *ssq, *lam, *rinv;
  unsigned* bar;
};

__device__ __forceinline__ unsigned cvt_pk_bf16(float lo, float hi) { unsigned r; asm volatile("v_cvt_pk_bf16_f32 %0, %1, %2" : "=v"(r) : "v"(lo), "v"(hi)); return r; }
__device__ __forceinline__ float bf_lo(unsigned v) { return __uint_as_float(v << 16); }
__device__ __forceinline__ float bf_hi(unsigned v) { return __uint_as_float(v & 0xffff0000u); }
__device__ __forceinline__ float fexp2(float x) { return __builtin_amdgcn_exp2f(x); }
__device__ __forceinline__ float frcp(float x) { return __builtin_amdgcn_rcpf(x); }

__shared__ int g_wid_table[64];
__device__ __forceinline__ unsigned hw_wave_slot() { return (unsigned)__builtin_amdgcn_s_getreg(((6 - 1) << 11) | (0 << 6) | 4) & 63u; }
__device__ __forceinline__ int opaque_tid() {
  const int wid = __builtin_amdgcn_readfirstlane(g_wid_table[hw_wave_slot()]);
  unsigned z = 0u; asm volatile("" : "+v"(z));
  int t = wid * 64 + (int)__builtin_amdgcn_mbcnt_hi(~0u, __builtin_amdgcn_mbcnt_lo(~0u, z));
  asm volatile("" : "+v"(t)); return t;
}

namespace pg8 {
constexpr int BM = 256, BK = 64, HALF = 128, HTB = HALF * BK * 2, STAGE_BYTES = 8 * HTB, NXCD = 8, WGM = 8;
__device__ __forceinline__ int lds_byte(int r, int c) { const int st = (r >> 4) * 2 + (c >> 5), rr = r & 15, cc = c & 31, ob = rr * 64 + cc * 2; return st * 1024 + (ob ^ (((ob >> 9) & 1) << 5)); }
__device__ __forceinline__ void stage_rc(int b, int& R, int& C) { const int st = b / 1024, sb = b % 1024, swz = sb ^ (((sb >> 9) & 1) << 5); R = (st >> 1) * 16 + swz / 64; C = (st & 1) * 32 + (swz % 64) / 2; }
__device__ __forceinline__ int perm32(int rho) { const int n = rho >> 4, i = rho & 15; return 8 * (i >> 2) + 4 * n + (i & 3); }
struct Unit { int pm, pn; };
struct Gemm { const bf16_t* A; const bf16_t* Bt; int M, N, K; int bperm, lshift; };
struct StaticOrder {
  int nM, nN, nwg, G, c;
  __device__ void init(int M, int N, int G_, int c_) { nM = M / BM; nN = N / BM; nwg = nM * nN; G = G_; c = c_; }
  __device__ bool next(int i, Unit& u) const {
    const long L = (long)i * G + c; if (L >= nwg) return false;
    int wgid = (int)L; { const int q = nwg / NXCD, r = nwg % NXCD, xcd = wgid % NXCD, off = wgid / NXCD; wgid = (xcd < r ? xcd * (q + 1) : r * (q + 1) + (xcd - r) * q) + off; }
    const int nig = WGM * nN, gid = wgid / nig, fm = gid * WGM, gsz = (nM - fm) < WGM ? (nM - fm) : WGM;
    u.pm = fm + ((wgid % nig) % gsz); u.pn = (wgid % nig) / gsz; return true;
  }
};

template <bool BPERM, class Epi>
__device__ __forceinline__ void gemm_phase(LAS unsigned char* lds, const Gemm g, const StaticOrder& S, const Epi& E) {
  const int tid_ = opaque_tid();
  const int tid = tid_, wid = __builtin_amdgcn_readfirstlane(tid >> 6), lane = tid & 63, wr = wid >> 2, wc = wid & 3, fr = lane & 15, fq = lane >> 4;
  const int K = g.K, nt = K / BK;
  const size_t kstep = (size_t)(BK * 2);
  const size_t hstep = (size_t)HALF * K * 2;
  const size_t tstep = 2 * hstep;
  unsigned voffA[2], voffBr[2], voffBc[2], voffB[2], voffBn[2];
#pragma unroll
  for (int i = 0; i < 2; ++i) { int R, C; stage_rc(tid * 16 + i * 8192, R, C); const int Rb = (R & ~31) + perm32(R & 31);
    voffA[i] = (unsigned)(R * K + C) * 2u; voffBr[i] = (unsigned)(Rb * K) * 2u; voffBc[i] = (unsigned)C * 2u; voffB[i] = voffBr[i] + voffBc[i]; voffBn[i] = voffB[i]; }
  auto bbase = [&](const Unit& u, int hh, int& sh) -> const char* {
    if constexpr (!BPERM) { sh = 0; return (const char*)g.Bt + (size_t)u.pn * tstep + (size_t)hh * hstep; }
    const int ds = u.pm <= 4 ? 0 : (u.pm == 5 ? 2 : 4); sh = ds;
    const int L = 1 << g.lshift; const int p0 = u.pn * 256 + hh * 128, seq = p0 >> g.lshift, p = p0 & (L - 1);
    const int Mc = L >> ds, r = p / Mc, m0 = p & (Mc - 1);
    return (const char*)g.Bt + ((size_t)seq * L + ((size_t)m0 << ds) + r) * (size_t)K * 2;
  };
  const unsigned ldsw = (unsigned)wid * 1024u;
  const int aoff = lds_byte(wr * 64 + fr, fq * 8), boff = lds_byte(wc * 32 + fr, fq * 8);
#define PG8_SA(b, h) (((b) * 2 + (h)) * HTB)
#define PG8_SB(b, h) ((4 + (b) * 2 + (h)) * HTB)
#define PG8_STAGE(bufoff, gbase, voff) do { _Pragma("unroll") for (int _i = 0; _i < 2; ++_i) \
    __builtin_amdgcn_global_load_lds((const unsigned*)((const char*)(gbase) + (voff)[_i]), (LAS unsigned*)(lds + (bufoff) + ldsw + _i * 8192), 16, 0, 0); } while (0)
#define PG8_LDA(dst, b, h) do { _Pragma("unroll") for (int m = 0; m < 4; ++m) _Pragma("unroll") for (int k = 0; k < 2; ++k) dst[m][k] = *(const LAS bf16x8*)(lds + PG8_SA(b, h) + aoff + m * 2048 + k * 1024); } while (0)
#define PG8_LDB(dst, b, h) do { _Pragma("unroll") for (int n = 0; n < 2; ++n) _Pragma("unroll") for (int k = 0; k < 2; ++k) dst[n][k] = *(const LAS bf16x8*)(lds + PG8_SB(b, h) + boff + n * 2048 + k * 1024); } while (0)
#define PG8_MMA(ai, bj, At, Bt) do { __builtin_amdgcn_s_setprio(1); _Pragma("unroll") for (int m = 0; m < 4; ++m) _Pragma("unroll") for (int n = 0; n < 2; ++n) _Pragma("unroll") for (int k = 0; k < 2; ++k) \
    acc[ai][bj][m][n] = __builtin_amdgcn_mfma_f32_16x16x32_bf16(Bt[n][k], At[m][k], acc[ai][bj][m][n], 0, 0, 0); __builtin_amdgcn_s_setprio(0); } while (0)
#define PG8_WAIT_V(n) asm volatile("s_waitcnt vmcnt(" #n ")" ::: "memory")
#define PG8_WAIT_L(n) asm volatile("s_waitcnt lgkmcnt(" #n ")" ::: "memory")
#define PG8_BAR __builtin_amdgcn_s_barrier()
#define PG8_SCHED __builtin_amdgcn_sched_barrier(0)
  Unit cur, nxt; int ui = 0;
  if (!S.next(0, cur)) return;
  f32x4 acc[2][2][4][2];
#pragma unroll
  for (int a = 0; a < 2; ++a)
#pragma unroll
    for (int b = 0; b < 2; ++b)
#pragma unroll
      for (int m = 0; m < 4; ++m)
#pragma unroll
        for (int n = 0; n < 2; ++n) acc[a][b][m][n] = (f32x4){0.f, 0.f, 0.f, 0.f};
  bf16x8 At[4][2], B0[2][2], B1[2][2];
  const char* cA = (const char*)g.A + (size_t)cur.pm * tstep;
  int csh; const char* cB0 = bbase(cur, 0, csh); const char* cB1 = bbase(cur, 1, csh);
#pragma unroll
  for (int i = 0; i < 2; ++i) voffB[i] = (voffBr[i] << csh) + voffBc[i];
  PG8_STAGE(PG8_SB(0, 0), cB0, voffB); PG8_STAGE(PG8_SA(0, 0), cA, voffA); PG8_STAGE(PG8_SB(0, 1), cB1, voffB); PG8_STAGE(PG8_SA(0, 1), cA + hstep, voffA);
  if (wr == 1) PG8_BAR;
  PG8_WAIT_V(4); PG8_BAR;
  PG8_STAGE(PG8_SB(1, 0), cB0 + kstep, voffB); PG8_STAGE(PG8_SA(1, 0), cA + kstep, voffA); PG8_STAGE(PG8_SB(1, 1), cB1 + kstep, voffB);
  PG8_WAIT_V(6); PG8_BAR;
  for (;;) {
    const bool has_next = S.next(ui + 1, nxt);
    const char* nA = cA; const char* nB0 = cB0; const char* nB1 = cB1;
#pragma unroll
    for (int i = 0; i < 2; ++i) voffBn[i] = voffB[i];
    if (has_next) { int nsh; nA = (const char*)g.A + (size_t)nxt.pm * tstep; nB0 = bbase(nxt, 0, nsh); nB1 = bbase(nxt, 1, nsh);
#pragma unroll
      for (int i = 0; i < 2; ++i) voffBn[i] = (voffBr[i] << nsh) + voffBc[i]; }
    auto kiter = [&](int t) __attribute__((always_inline)) {
      const bool last = (t == nt - 2);
      const char* a1 = cA + (size_t)(t + 1) * kstep;
      const char* a2 = last ? nA : cA + (size_t)(t + 2) * kstep;
      const char* b20 = last ? nB0 : cB0 + (size_t)(t + 2) * kstep; const char* b21 = last ? nB1 : cB1 + (size_t)(t + 2) * kstep;
      const char* a3 = a2 + kstep; const char* b30 = b20 + kstep; const char* b31 = b21 + kstep;
      unsigned vB[2];
#pragma unroll
      for (int i = 0; i < 2; ++i) vB[i] = BPERM ? (last ? voffBn[i] : voffB[i]) : voffB[i];
      PG8_LDB(B0, 0, 0); PG8_SCHED; PG8_LDA(At, 0, 0); PG8_STAGE(PG8_SA(1, 1), a1 + hstep, voffA);
      PG8_WAIT_L(8); PG8_BAR; PG8_WAIT_L(0); PG8_MMA(0, 0, At, B0); PG8_BAR; PG8_SCHED;
      PG8_LDB(B1, 0, 1); PG8_STAGE(PG8_SB(0, 0), b20, vB);
      PG8_BAR; PG8_WAIT_L(0); PG8_MMA(0, 1, At, B1); PG8_BAR;
      PG8_LDA(At, 0, 1); PG8_STAGE(PG8_SA(0, 0), a2, voffA);
      PG8_BAR; PG8_WAIT_L(0); PG8_MMA(1, 0, At, B0); PG8_BAR; PG8_SCHED;
      PG8_STAGE(PG8_SB(0, 1), b21, vB);
      PG8_WAIT_V(6); PG8_BAR; PG8_MMA(1, 1, At, B1); PG8_BAR;
      PG8_LDB(B0, 1, 0); PG8_SCHED; PG8_LDA(At, 1, 0); PG8_STAGE(PG8_SA(0, 1), a2 + hstep, voffA);
      PG8_WAIT_L(8); PG8_BAR; PG8_WAIT_L(0); PG8_MMA(0, 0, At, B0); PG8_BAR; PG8_SCHED;
      PG8_LDB(B1, 1, 1); PG8_STAGE(PG8_SB(1, 0), b30, vB);
      PG8_BAR; PG8_WAIT_L(0); PG8_MMA(0, 1, At, B1); PG8_BAR;
      PG8_LDA(At, 1, 1); PG8_STAGE(PG8_SA(1, 0), a3, voffA);
      PG8_BAR; PG8_WAIT_L(0); PG8_MMA(1, 0, At, B0); PG8_BAR; PG8_SCHED;
      PG8_STAGE(PG8_SB(1, 1), b31, vB);
      PG8_WAIT_V(6); PG8_BAR; PG8_MMA(1, 1, At, B1); PG8_BAR;
    };
    if constexpr (Epi::HOOK) {
#pragma unroll 1
      for (int seg = 0; seg < 3; ++seg) {
        const int tb = seg * 8, te = seg == 2 ? nt : tb + 8;
#pragma unroll 1
        for (int t = tb; t < te; t += 2) kiter(t);
        if (seg < 2) E.hook(acc, cur, te, wr, wc, fr, fq);
      }
    } else {
      for (int t = 0; t < nt; t += 2) kiter(t);
    }
    E(acc, cur, wr, wc, fr, fq);
    if (!has_next) break;
#pragma unroll
    for (int a = 0; a < 2; ++a)
#pragma unroll
      for (int b = 0; b < 2; ++b)
#pragma unroll
        for (int m = 0; m < 4; ++m)
#pragma unroll
          for (int n = 0; n < 2; ++n) acc[a][b][m][n] = (f32x4){0.f, 0.f, 0.f, 0.f};
    cur = nxt; cA = nA; cB0 = nB0; cB1 = nB1; ++ui;
#pragma unroll
    for (int i = 0; i < 2; ++i) voffB[i] = voffBn[i];
  }
  PG8_WAIT_V(0);
  if (wr == 0) PG8_BAR;
  PG8_BAR;
#undef PG8_SA
#undef PG8_SB
#undef PG8_STAGE
#undef PG8_LDA
#undef PG8_LDB
#undef PG8_MMA
#undef PG8_WAIT_V
#undef PG8_WAIT_L
#undef PG8_BAR
#undef PG8_SCHED
}
}
using pg8::Unit;

struct EpiU {
  static constexpr bool HOOK = false;
  bf16_t* U; const float* rinv; const float* bg;
  __device__ __forceinline__ void hook(f32x4 (&)[2][2][4][2], const Unit&, int, int, int, int, int) const {}
  __device__ __forceinline__ void operator()(const f32x4 (&acc)[2][2][4][2], const Unit& u, int wr, int wc, int fr, int fq) const {
    asm volatile("" : "+v"(fr), "+v"(fq));
    const int row0 = u.pm * 256 + wr * 64 + fr, col0 = u.pn * 256 + wc * 32 + 8 * fq;
    const bool isg = (u.pn >= 19);
    float ri[2][4];
#pragma unroll
    for (int ai = 0; ai < 2; ++ai)
#pragma unroll
      for (int m = 0; m < 4; ++m) ri[ai][m] = rinv[row0 + ai * 128 + m * 16];
    if (isg) {
      f32x4 b[2][2];
#pragma unroll
      for (int bj = 0; bj < 2; ++bj) { const float* bp = bg + (col0 - U_GL) + bj * 128; b[bj][0] = *(const f32x4*)bp; b[bj][1] = *(const f32x4*)(bp + 4); }
#pragma unroll
      for (int ai = 0; ai < 2; ++ai)
#pragma unroll
        for (int m = 0; m < 4; ++m)
#pragma unroll
          for (int bj = 0; bj < 2; ++bj) {
            f32x4 v0 = acc[ai][bj][m][0] * ri[ai][m] + b[bj][0], v1 = acc[ai][bj][m][1] * ri[ai][m] + b[bj][1];
#pragma unroll
            for (int j = 0; j < 4; ++j) { v0[j] = 1.0f + fminf(fexp2(-v0[j] * LOG2E), 1e30f); v1[j] = 1.0f + fminf(fexp2(-v1[j] * LOG2E), 1e30f); }
            u32x4 pk = {cvt_pk_bf16(v0[0], v0[1]), cvt_pk_bf16(v0[2], v0[3]), cvt_pk_bf16(v1[0], v1[1]), cvt_pk_bf16(v1[2], v1[3])};
            *(u32x4*)(U + (size_t)(row0 + ai * 128 + m * 16) * UW + col0 + bj * 128) = pk;
          }
    } else {
#pragma unroll
      for (int ai = 0; ai < 2; ++ai)
#pragma unroll
        for (int m = 0; m < 4; ++m)
#pragma unroll
          for (int bj = 0; bj < 2; ++bj) {
            const f32x4 v0 = acc[ai][bj][m][0] * ri[ai][m], v1 = acc[ai][bj][m][1] * ri[ai][m];
            u32x4 pk = {cvt_pk_bf16(v0[0], v0[1]), cvt_pk_bf16(v0[2], v0[3]), cvt_pk_bf16(v1[0], v1[1]), cvt_pk_bf16(v1[2], v1[3])};
            *(u32x4*)(U + (size_t)(row0 + ai * 128 + m * 16) * UW + col0 + bj * 128) = pk;
          }
    }
  }
};

struct EpiVT {
  static constexpr bool HOOK = false;
  bf16_t* VT; const float* rv; int L, lshift;
  __device__ __forceinline__ void hook(f32x4 (&)[2][2][4][2], const Unit&, int, int, int, int, int) const {}
  __device__ __forceinline__ void operator()(const f32x4 (&acc)[2][2][4][2], const Unit& u, int wr, int wc, int fr, int fq) const {
    asm volatile("" : "+v"(fr), "+v"(fq));
    const int vrow0 = u.pm * 256 + wr * 64 + fr, pcol0 = u.pn * 256 + wc * 32 + 8 * fq;
    const int ds = u.pm <= 4 ? 0 : (u.pm == 5 ? 2 : 4);
    const int Mc = L >> ds;
#pragma unroll
    for (int bj = 0; bj < 2; ++bj) {
      const int p0 = pcol0 + bj * 128, seq = p0 >> lshift, pos = p0 & (L - 1);
      const int r = pos / Mc, m0 = pos & (Mc - 1);
      float rinv[8];
#pragma unroll
      for (int j = 0; j < 8; ++j) rinv[j] = rv[(seq << lshift) + ((m0 + j) << ds) + r];
      bf16_t* vb = VT + ((size_t)seq * VW + vrow0) * L + pos;
#pragma unroll
      for (int ai = 0; ai < 2; ++ai)
#pragma unroll
        for (int m = 0; m < 4; ++m) {
          const f32x4 v0 = acc[ai][bj][m][0], v1 = acc[ai][bj][m][1];
          u32x4 pk = {cvt_pk_bf16(v0[0] * rinv[0], v0[1] * rinv[1]), cvt_pk_bf16(v0[2] * rinv[2], v0[3] * rinv[3]),
                      cvt_pk_bf16(v1[0] * rinv[4], v1[1] * rinv[5]), cvt_pk_bf16(v1[2] * rinv[6], v1[3] * rinv[7])};
          *(u32x4*)(vb + (size_t)(ai * 128 + m * 16) * L) = pk;
        }
    }
  }
};

struct EpiMerge {
  static constexpr bool HOOK = true;
  const bf16_t* U; bf16_t* MG;
  __device__ __forceinline__ f32x4 gvec(int i, size_t row, int col) const {
    const u32x2 raw = *(const u32x2*)(U + row * UW + U_GL + i * 1024 + col);
    f32x4 e; e[0] = bf_lo(raw[0]); e[1] = bf_hi(raw[0]); e[2] = bf_lo(raw[1]); e[3] = bf_hi(raw[1]); return e;
  }
  __device__ __forceinline__ void hook(f32x4 (&acc)[2][2][4][2], const Unit& u, int t, int wr, int wc, int fr, int fq) const {
    const int i = (t == 8) ? 0 : 1;
    asm volatile("" : "+v"(fr), "+v"(fq));
    const int row0 = u.pm * 256 + wr * 64 + fr, col0 = u.pn * 256 + wc * 32 + 8 * fq;
#pragma unroll
    for (int ai = 0; ai < 2; ++ai) {
#pragma unroll
      for (int m = 0; m < 4; ++m)
#pragma unroll
        for (int bj = 0; bj < 2; ++bj) {
          const bf16_t* gp = U + (size_t)(row0 + ai * 128 + m * 16) * UW + U_GL + i * 1024 + col0 + bj * 128;
          const u32x4 a = *(const u32x4*)gp, b = *(const u32x4*)(gp + 1024);
#pragma unroll
          for (int n = 0; n < 2; ++n) {
            f32x4 r;
            r[0] = bf_lo(b[2 * n]) * frcp(bf_lo(a[2 * n])); r[1] = bf_hi(b[2 * n]) * frcp(bf_hi(a[2 * n]));
            r[2] = bf_lo(b[2 * n + 1]) * frcp(bf_lo(a[2 * n + 1])); r[3] = bf_hi(b[2 * n + 1]) * frcp(bf_hi(a[2 * n + 1]));
            acc[ai][bj][m][n] *= r;
          }
        }
      __builtin_amdgcn_sched_barrier(0);
    }
  }
  __device__ __forceinline__ void operator()(const f32x4 (&acc)[2][2][4][2], const Unit& u, int wr, int wc, int fr, int fq) const {
    asm volatile("" : "+v"(fr), "+v"(fq));
    const int row0 = u.pm * 256 + wr * 64 + fr, col0 = u.pn * 256 + wc * 32 + 8 * fq;
    u32x4 g2[2][4][2];
#pragma unroll
    for (int ai = 0; ai < 2; ++ai)
#pragma unroll
      for (int m = 0; m < 4; ++m)
#pragma unroll
        for (int bj = 0; bj < 2; ++bj) g2[ai][m][bj] = *(const u32x4*)(U + (size_t)(row0 + ai * 128 + m * 16) * UW + U_GL + 2 * 1024 + col0 + bj * 128);
    __builtin_amdgcn_sched_barrier(0);
#pragma unroll
    for (int ai = 0; ai < 2; ++ai)
#pragma unroll
      for (int m = 0; m < 4; ++m)
#pragma unroll
        for (int bj = 0; bj < 2; ++bj) {
          const size_t row = (size_t)(row0 + ai * 128 + m * 16); const int col = col0 + bj * 128;
          const u32x4 g = g2[ai][m][bj];
          f32x4 v0 = acc[ai][bj][m][0], v1 = acc[ai][bj][m][1];
          v0[0] *= frcp(bf_lo(g[0])); v0[1] *= frcp(bf_hi(g[0])); v0[2] *= frcp(bf_lo(g[1])); v0[3] *= frcp(bf_hi(g[1]));
          v1[0] *= frcp(bf_lo(g[2])); v1[1] *= frcp(bf_hi(g[2])); v1[2] *= frcp(bf_lo(g[3])); v1[3] *= frcp(bf_hi(g[3]));
          u32x4 pk = {cvt_pk_bf16(v0[0], v0[1]), cvt_pk_bf16(v0[2], v0[3]), cvt_pk_bf16(v1[0], v1[1]), cvt_pk_bf16(v1[2], v1[3])};
          *(u32x4*)(MG + row * DM + col) = pk;
        }
  }
};

struct EpiRes {
  static constexpr bool HOOK = false;
  const float* R32; const bf16_t* RB; float* X; bf16_t* XB; float* ssq;
  __device__ __forceinline__ void hook(f32x4 (&)[2][2][4][2], const Unit&, int, int, int, int, int) const {}
  __device__ __forceinline__ void operator()(const f32x4 (&acc)[2][2][4][2], const Unit& u, int wr, int wc, int fr, int fq) const {
    asm volatile("" : "+v"(fr), "+v"(fq));
    const int row0 = u.pm * 256 + wr * 64 + fr, col0 = u.pn * 256 + wc * 32 + 8 * fq;
#pragma unroll
    for (int ai = 0; ai < 2; ++ai) {
      f32x4 r[4][2][2];
      if (R32) {
#pragma unroll
        for (int m = 0; m < 4; ++m)
#pragma unroll
          for (int bj = 0; bj < 2; ++bj) { const float* rp = R32 + (size_t)(row0 + ai * 128 + m * 16) * DM + col0 + bj * 128; r[m][bj][0] = *(const f32x4*)rp; r[m][bj][1] = *(const f32x4*)(rp + 4); }
      } else {
        u32x4 rb[4][2];
#pragma unroll
        for (int m = 0; m < 4; ++m)
#pragma unroll
          for (int bj = 0; bj < 2; ++bj) rb[m][bj] = *(const u32x4*)(RB + (size_t)(row0 + ai * 128 + m * 16) * DM + col0 + bj * 128);
#pragma unroll
        for (int m = 0; m < 4; ++m)
#pragma unroll
          for (int bj = 0; bj < 2; ++bj) {
            r[m][bj][0] = (f32x4){bf_lo(rb[m][bj][0]), bf_hi(rb[m][bj][0]), bf_lo(rb[m][bj][1]), bf_hi(rb[m][bj][1])};
            r[m][bj][1] = (f32x4){bf_lo(rb[m][bj][2]), bf_hi(rb[m][bj][2]), bf_lo(rb[m][bj][3]), bf_hi(rb[m][bj][3])};
          }
      }
      __builtin_amdgcn_sched_barrier(0);
#pragma unroll
      for (int m = 0; m < 4; ++m) {
        const size_t row = (size_t)(row0 + ai * 128 + m * 16);
        float s = 0.f;
#pragma unroll
        for (int bj = 0; bj < 2; ++bj) {
          const int col = col0 + bj * 128;
          const f32x4 v0 = r[m][bj][0] + acc[ai][bj][m][0], v1 = r[m][bj][1] + acc[ai][bj][m][1];
          s += v0[0] * v0[0] + v0[1] * v0[1] + v0[2] * v0[2] + v0[3] * v0[3] + v1[0] * v1[0] + v1[1] * v1[1] + v1[2] * v1[2] + v1[3] * v1[3];
          if (X) { *(f32x4*)(X + row * DM + col) = v0; *(f32x4*)(X + row * DM + col + 4) = v1; }
          else { u32x4 pk = {cvt_pk_bf16(v0[0], v0[1]), cvt_pk_bf16(v0[2], v0[3]), cvt_pk_bf16(v1[0], v1[1]), cvt_pk_bf16(v1[2], v1[3])};
                 *(u32x4*)(XB + row * DM + col) = pk; }
        }
        s += __shfl_xor(s, 16); s += __shfl_xor(s, 32);
        if (fq == 0) ssq[row * 16 + u.pn * 4 + wc] = s;
      }
      __builtin_amdgcn_sched_barrier(0);
    }
  }
};

__device__ __forceinline__ void prep_tile(const float* src, int ldn, int k0, int n0, const float* rscale, float cscale, bf16_t* dst, int ldd, int drow0, int dk0, LAS float* tile) {
  const int tid = opaque_tid(), kk = tid >> 6, nn = tid & 63;
#pragma unroll
  for (int i = 0; i < 8; ++i) {
    const int k = kk * 8 + i;
    float v = src[(size_t)(k0 + k) * ldn + n0 + nn] * cscale;
    if (rscale) v *= rscale[k0 + k];
    tile[k * 65 + nn] = v;
  }
  __syncthreads();
  const int n = tid >> 3, kc = tid & 7;
  float f[8];
#pragma unroll
  for (int j = 0; j < 8; ++j) f[j] = tile[(kc * 8 + j) * 65 + n];
  u32x4 pk = {cvt_pk_bf16(f[0], f[1]), cvt_pk_bf16(f[2], f[3]), cvt_pk_bf16(f[4], f[5]), cvt_pk_bf16(f[6], f[7])};
  *(u32x4*)(dst + (size_t)(drow0 + n) * ldd + dk0 + kc * 8) = pk;
  __syncthreads();
}

__device__ __forceinline__ void win_map(int n0, int& dn0, float& sc) {
  sc = 1.0f;
  if (n0 < 512) { dn0 = U_QA + n0; sc = QSCALE; }
  else if (n0 < 1024) dn0 = U_KA + (n0 - 512);
  else if (n0 < 1536) dn0 = UW + V_A + (n0 - 1024);
  else if (n0 < 2048) dn0 = U_ZA + (n0 - 1536);
  else if (n0 < 2560) { dn0 = U_QB + (n0 - 2048); sc = QSCALE; }
  else if (n0 < 3072) dn0 = U_KB + (n0 - 2560);
  else if (n0 < 3584) dn0 = UW + V_B + (n0 - 3072);
  else if (n0 < 4096) dn0 = U_ZB + (n0 - 3584);
  else if (n0 < 4864) { dn0 = U_QC + (n0 - 4096); sc = QSCALE; }
  else if (n0 < 5632) dn0 = U_KC + (n0 - 4864);
  else if (n0 < 6400) dn0 = UW + V_C + (n0 - 5632);
  else if (n0 < 6656) dn0 = U_ZC + (n0 - 6400);
  else dn0 = U_GL + (n0 - 6656);
}

__device__ void phase_prep(const Params& p, LAS float* tile) {
  constexpr int PER = 3008;
  for (int it = blockIdx.x; it < DEPTH * PER; it += gridDim.x) {
    const int l = it / PER; int r = it % PER;
    if (r < 2432) {
      const int kt = r / 152, ntile = r % 152; int dn0; float sc; win_map(ntile * 64, dn0, sc);
      prep_tile(p.w_in + (size_t)l * DM * INW, INW, kt * 64, ntile * 64, p.g_norm + l * DM, sc, p.wt_in + (size_t)l * INW * DM, DM, dn0, kt * 64, tile);
    } else if ((r -= 2432) < 128) {
      const int kt = r / 16, ntile = r % 16;
      prep_tile(p.w_br_a + (size_t)l * 512 * DM, DM, kt * 64, ntile * 64, nullptr, 1.0f, p.wt_br + (size_t)l * DM * YW, YW, ntile * 64, kt * 64, tile);
    } else if ((r -= 128) < 128) {
      const int kt = r / 16, ntile = r % 16;
      prep_tile(p.w_br_b + (size_t)l * 512 * DM, DM, kt * 64, ntile * 64, nullptr, 1.0f, p.wt_br + (size_t)l * DM * YW, YW, ntile * 64, 512 + kt * 64, tile);
    } else if ((r -= 128) < 64) {
      const int kt = r / 16, ntile = r % 16;
      prep_tile(p.w_br_c + (size_t)l * 256 * DM, DM, kt * 64, ntile * 64, nullptr, 1.0f, p.wt_br + (size_t)l * DM * YW, YW, ntile * 64, 1024 + kt * 64, tile);
    } else {
      r -= 64; const int kt = r / 16, ntile = r % 16;
      prep_tile(p.w_out + (size_t)l * DM * DM, DM, kt * 64, ntile * 64, nullptr, 1.0f, p.wt_out + (size_t)l * DM * DM, DM, ntile * 64, kt * 64, tile);
    }
  }
  const int ptid = opaque_tid();
  if (blockIdx.x == 0 && ptid < 64) {
    const int lane = ptid;
    for (int l = 0; l < DEPTH; ++l) {
      const float* lq = p.lam_qk + l * 256;
      float a = lq[lane] * lq[64 + lane], b = lq[128 + lane] * lq[192 + lane];
      for (int o = 32; o >= 1; o >>= 1) { a += __shfl_xor(a, o); b += __shfl_xor(b, o); }
      if (lane == 0) { const float li = 0.8f - 0.6f * expf(-0.3f * (float)l); p.lam[l] = expf(a) - expf(b) + li; p.lam[4 + l] = 1.0f - li; }
    }
  }
}

__device__ void phase_x(const Params& p, int chunk) {
  const float* xin = (chunk < 2) ? p.xp + (size_t)chunk * TC * DM : p.xs + (size_t)(chunk - 2) * TC * DM;
  float* ssq = p.ssq + (size_t)chunk * TC * 16;
  const int tid = opaque_tid(), lane = tid & 63, w = blockIdx.x * 8 + (tid >> 6), nw = gridDim.x * 8;
  for (int row = w; row < TC; row += nw) {
    const float* xr = xin + (size_t)row * DM + lane * 16;
    f32x4 v[4]; float s = 0.f;
#pragma unroll
    for (int i = 0; i < 4; ++i) { v[i] = *(const f32x4*)(xr + i * 4); s += v[i][0] * v[i][0] + v[i][1] * v[i][1] + v[i][2] * v[i][2] + v[i][3] * v[i][3]; }
    for (int o = 32; o >= 1; o >>= 1) s += __shfl_xor(s, o);
    u32x4 p0 = {cvt_pk_bf16(v[0][0], v[0][1]), cvt_pk_bf16(v[0][2], v[0][3]), cvt_pk_bf16(v[1][0], v[1][1]), cvt_pk_bf16(v[1][2], v[1][3])};
    u32x4 p1 = {cvt_pk_bf16(v[2][0], v[2][1]), cvt_pk_bf16(v[2][2], v[2][3]), cvt_pk_bf16(v[3][0], v[3][1]), cvt_pk_bf16(v[3][2], v[3][3])};
    bf16_t* xo = p.xb + (size_t)row * DM + lane * 16;
    *(u32x4*)xo = p0; *(u32x4*)(xo + 8) = p1;
    if (lane < 16) ssq[(size_t)row * 16 + lane] = (lane == 0) ? s : 0.f;
    if (lane == 0) p.rinv[(size_t)chunk * TC + row] = rsqrtf(s * (1.0f / 1024.0f) + 1e-6f);
  }
}

__device__ void phase_rinv(const Params& p, int chunk) {
  const float* ssq = p.ssq + (size_t)chunk * TC * 16; float* rv = p.rinv + (size_t)chunk * TC;
  for (int row = blockIdx.x * 512 + opaque_tid(); row < TC; row += gridDim.x * 512) {
    const f32x4* sp = (const f32x4*)(ssq + (size_t)row * 16);
    const f32x4 a4 = sp[0] + sp[1] + sp[2] + sp[3];
    rv[row] = rsqrtf((a4[0] + a4[1] + a4[2] + a4[3]) * (1.0f / 1024.0f) + 1e-6f);
  }
}

__device__ void phase_final(const Params& p, int chunk) {
  float* x = p.out + (size_t)chunk * TC * DM;
  const float* ssq = p.ssq + (size_t)chunk * TC * 16;
  const int tid = opaque_tid(), lane = tid & 63, w = blockIdx.x * 8 + (tid >> 6), nw = gridDim.x * 8;
  for (int row = w; row < TC; row += nw) {
    const f32x4* sp = (const f32x4*)(ssq + (size_t)row * 16);
    const f32x4 a4 = sp[0] + sp[1] + sp[2] + sp[3];
    const float rinv = rsqrtf((a4[0] + a4[1] + a4[2] + a4[3]) * (1.0f / 1024.0f) + 1e-6f);
    float* xr = x + (size_t)row * DM + lane * 16;
#pragma unroll
    for (int i = 0; i < 4; ++i) { f32x4 v = *(const f32x4*)(xr + i * 4); const f32x4 g = *(const f32x4*)(p.g_final + lane * 16 + i * 4); v = v * rinv * g; *(f32x4*)(xr + i * 4) = v; }
  }
}

__device__ __forceinline__ f32x16 mfma32(bf16x8 a, bf16x8 b, f32x16 c) { return __builtin_amdgcn_mfma_f32_32x32x16_bf16(a, b, c, 0, 0, 0); }
__device__ __forceinline__ bf16x8 ld16(const bf16_t* p) { return *(const bf16x8*)p; }
__device__ __forceinline__ bf16x8 ld8x2(const bf16_t* p0, const bf16_t* p1) { const bf16x4 a = *(const bf16x4*)p0, b = *(const bf16x4*)p1; return __builtin_shufflevector(a, b, 0, 1, 2, 3, 4, 5, 6, 7); }

__device__ __forceinline__ void softmax_tile(f32x16& t, float& m, float& l, float& alpha, bf16x8& p0, bf16x8& p1) {
  float tm = t[0];
#pragma unroll
  for (int i = 1; i < 16; ++i) tm = fmaxf(tm, t[i]);
  tm = fmaxf(tm, __shfl_xor(tm, 32));
  const float mn = fmaxf(m, tm);
  alpha = fexp2(m - mn); m = mn;
  float ls = 0.f;
#pragma unroll
  for (int i = 0; i < 16; ++i) { t[i] = fexp2(t[i] - mn); ls += t[i]; }
  l = l * alpha + ls;
  const u32x4 a = {cvt_pk_bf16(t[0], t[1]), cvt_pk_bf16(t[2], t[3]), cvt_pk_bf16(t[4], t[5]), cvt_pk_bf16(t[6], t[7])};
  const u32x4 b = {cvt_pk_bf16(t[8], t[9]), cvt_pk_bf16(t[10], t[11]), cvt_pk_bf16(t[12], t[13]), cvt_pk_bf16(t[14], t[15])};
  p0 = __builtin_bit_cast(bf16x8, a); p1 = __builtin_bit_cast(bf16x8, b);
}
__device__ __forceinline__ f32x16 zero16() { f32x16 z;
#pragma unroll
  for (int i = 0; i < 16; ++i) z[i] = 0.f; return z; }
__device__ __forceinline__ float silu(float z) { return z * frcp(1.0f + fexp2(-z * LOG2E)); }

constexpr int TB_ROW = 144;
constexpr int KB_BYTES = 64 * TB_ROW;
constexpr int VB_BYTES = 128 * TB_ROW;
constexpr int LDS_K = 0, LDS_V = LDS_K + 2 * KB_BYTES, LDS_ATT_END = LDS_V + 2 * VB_BYTES, LDS_ATT_TOTAL = LDS_ATT_END + 65536;
template <int SIDE>
__device__ __forceinline__ void b_far_subtile(const LAS unsigned char* kb, const LAS unsigned char* vb, int rd, int sub, const bf16x8 (&qf)[4], const f32x16& bp, float slope2, float d0,
                                              float& mrun, float& lrun, f32x16 (&o)[4]) {
  const float base = (SIDE > 0 ? -slope2 : slope2) * d0 - mrun;
  f32x16 sc;
#pragma unroll
  for (int i = 0; i < 16; ++i) sc[i] = SIDE > 0 ? base - bp[i] : base + bp[i];
#pragma unroll
  for (int ks = 0; ks < 4; ++ks) sc = mfma32(*(const LAS bf16x8*)(kb + rd + sub * 32 * TB_ROW + ks * 32), qf[ks], sc);
  float tm = sc[0];
#pragma unroll
  for (int i = 1; i < 16; ++i) tm = fmaxf(tm, sc[i]);
  tm = fmaxf(tm, __shfl_xor(tm, 32));
  if (__builtin_amdgcn_ballot_w64(tm > 0.0f) != 0) {
    const float delta = fmaxf(tm, 0.0f);
    const float al = fexp2(-delta);
    mrun += delta; lrun *= al;
#pragma unroll
    for (int i = 0; i < 16; ++i) sc[i] -= delta;
#pragma unroll
    for (int dt = 0; dt < 4; ++dt) o[dt] *= al;
  }
#pragma unroll
  for (int i = 0; i < 16; ++i) sc[i] = fexp2(sc[i]);
  { const f32x4 a4 = (f32x4){sc[0], sc[1], sc[2], sc[3]} + (f32x4){sc[4], sc[5], sc[6], sc[7]} + (f32x4){sc[8], sc[9], sc[10], sc[11]} + (f32x4){sc[12], sc[13], sc[14], sc[15]};
    lrun += (a4[0] + a4[1]) + (a4[2] + a4[3]); }
  const u32x4 pa = {cvt_pk_bf16(sc[0], sc[1]), cvt_pk_bf16(sc[2], sc[3]), cvt_pk_bf16(sc[4], sc[5]), cvt_pk_bf16(sc[6], sc[7])};
  const u32x4 pb = {cvt_pk_bf16(sc[8], sc[9]), cvt_pk_bf16(sc[10], sc[11]), cvt_pk_bf16(sc[12], sc[13]), cvt_pk_bf16(sc[14], sc[15])};
  const bf16x8 pk0 = __builtin_bit_cast(bf16x8, pa), pk1 = __builtin_bit_cast(bf16x8, pb);
#pragma unroll
  for (int dt = 0; dt < 4; ++dt) {
    o[dt] = mfma32(*(const LAS bf16x8*)(vb + rd + dt * 32 * TB_ROW + (sub * 2) * 32), pk0, o[dt]);
    o[dt] = mfma32(*(const LAS bf16x8*)(vb + rd + dt * 32 * TB_ROW + (sub * 2 + 1) * 32), pk1, o[dt]);
  }
}

__device__ __forceinline__ void attn_b_pass(const Params& p, int L, int seq, int h, int mp, int qblk, int tq, int tid, float slope2, LAS unsigned char* lds, f32x16 (&o)[4], float& linv) {
  const int lane = tid & 63, q = lane & 31, half = lane >> 5;
  const size_t tokbase = (size_t)seq * L;
  bf16x8 qf[4];
  { const bf16_t* qp = p.u + (tokbase + tq) * UW + U_QB + h * 128 + mp * 64 + half * 8;
#pragma unroll
    for (int ks = 0; ks < 4; ++ks) qf[ks] = ld16(qp + ks * 16); }
  const int spart = tid & 7, srow = tid >> 3;
  const bf16_t* kg = p.u + (tokbase + srow) * UW + U_KB + h * 128 + mp * 64 + spart * 8;
  const bf16_t* vg = p.vt + ((size_t)seq * VW + V_B + h * 128 + srow) * L + spart * 8;
  const int kst = srow * TB_ROW + spart * 16;
  const int vst = srow * TB_ROW + ((spart >> 1) * 16 + (spart & 1) * 4) * 2;
  const int rd = q * TB_ROW + half * 16;
#pragma unroll
  for (int dt = 0; dt < 4; ++dt) o[dt] = zero16();
  float mrun = -1e30f, lrun = 0.f;
  f32x16 bp;
#pragma unroll
  for (int i = 0; i < 16; ++i) bp[i] = slope2 * (float)((i >> 2) * 8 + (i & 3));
  const int ntile = L >> 6, t0 = qblk * 4, nR = ntile - t0;
  auto tile_of = [&](int idx) { return idx < nR ? t0 + idx : (t0 - 1) - (idx - nR); };
  bf16x8 krA, vrA0, vrA1, krB, vrB0, vrB1;
  auto gload = [&](int idx, bf16x8& kr, bf16x8& v0, bf16x8& v1) { const int kn = tile_of(idx) * 64; kr = ld16(kg + (size_t)kn * UW); v0 = ld16(vg + kn); v1 = ld16(vg + (size_t)64 * L + kn); };
  auto lwrite = [&](int buf, const bf16x8& kr, const bf16x8& v0, const bf16x8& v1) {
    LAS unsigned char* kb = lds + LDS_K + buf * KB_BYTES; LAS unsigned char* vb = lds + LDS_V + buf * VB_BYTES;
    *(LAS bf16x8*)(kb + kst) = kr;
    *(LAS bf16x4*)(vb + vst) = __builtin_shufflevector(v0, v0, 0, 1, 2, 3); *(LAS bf16x4*)(vb + vst + 16) = __builtin_shufflevector(v0, v0, 4, 5, 6, 7);
    *(LAS bf16x4*)(vb + vst + 64 * TB_ROW) = __builtin_shufflevector(v1, v1, 0, 1, 2, 3); *(LAS bf16x4*)(vb + vst + 64 * TB_ROW + 16) = __builtin_shufflevector(v1, v1, 4, 5, 6, 7);
  };
  auto compute = [&](int idx, int buf) {
    const int k0 = tile_of(idx) * 64;
    const LAS unsigned char* kb = lds + LDS_K + buf * KB_BYTES;
    const LAS unsigned char* vb = lds + LDS_V + buf * VB_BYTES;
    if (idx < 4) {
#pragma unroll
      for (int sub = 0; sub < 2; ++sub) {
        f32x16 sc = zero16();
#pragma unroll
        for (int ks = 0; ks < 4; ++ks) sc = mfma32(*(const LAS bf16x8*)(kb + rd + sub * 32 * TB_ROW + ks * 32), qf[ks], sc);
        const float d0 = (float)(k0 + sub * 32 + half * 4 - tq);
#pragma unroll
        for (int i = 0; i < 16; ++i) sc[i] -= slope2 * fabsf(d0 + (float)((i >> 2) * 8 + (i & 3)));
        float al; bf16x8 pk[2];
        softmax_tile(sc, mrun, lrun, al, pk[0], pk[1]);
        if (__builtin_amdgcn_ballot_w64(al != 1.0f) != 0) {
#pragma unroll
          for (int dt = 0; dt < 4; ++dt) o[dt] *= al;
        }
#pragma unroll
        for (int dt = 0; dt < 4; ++dt)
#pragma unroll
          for (int s2 = 0; s2 < 2; ++s2) o[dt] = mfma32(*(const LAS bf16x8*)(vb + rd + dt * 32 * TB_ROW + (sub * 2 + s2) * 32), pk[s2], o[dt]);
      }
    } else if (idx < nR) {
#pragma unroll
      for (int sub = 0; sub < 2; ++sub) b_far_subtile<1>(kb, vb, rd, sub, qf, bp, slope2, (float)(k0 + sub * 32 + half * 4 - tq), mrun, lrun, o);
    } else {
#pragma unroll
      for (int sub = 0; sub < 2; ++sub) b_far_subtile<-1>(kb, vb, rd, sub, qf, bp, slope2, (float)(k0 + sub * 32 + half * 4 - tq), mrun, lrun, o);
    }
  };
  gload(0, krA, vrA0, vrA1);
  gload(1, krB, vrB0, vrB1);
  lwrite(0, krA, vrA0, vrA1);
  asm volatile("" : "+v"(qf[0]), "+v"(qf[1]), "+v"(qf[2]), "+v"(qf[3]));
  asm volatile("" : "+v"(krB), "+v"(vrB0), "+v"(vrB1));
  __syncthreads();
#pragma unroll 1
  for (int idx = 0; idx < ntile; idx += 2) {
    if (idx + 2 < ntile) gload(idx + 2, krA, vrA0, vrA1);
    compute(idx, 0);
    lwrite(1, krB, vrB0, vrB1);
    __syncthreads();
    if (idx + 3 < ntile) gload(idx + 3, krB, vrB0, vrB1);
    compute(idx + 1, 1);
    if (idx + 2 < ntile) lwrite(0, krA, vrA0, vrA1);
    __syncthreads();
  }
  linv = frcp(lrun + __shfl_xor(lrun, 32));
}
__device__ void attn_b_block(const Params& p, int layer, int L, int seq, int h, int qblk, LAS unsigned char* lds) {
  const int tid = opaque_tid(), lane = tid & 63, wid = __builtin_amdgcn_readfirstlane(tid >> 6);
  const int q = lane & 31, half = lane >> 5;
  const size_t tokbase = (size_t)seq * L;
  const int tq = qblk * 256 + wid * 32 + q;
  const float slope2 = exp2f(-2.0f * (float)(h + 1)) * LOG2E;
  f32x16 o0[4]; float li0, li1;
  LAS u32x4* park = (LAS u32x4*)(lds + LDS_ATT_END) + wid * 512 + lane;
  attn_b_pass(p, L, seq, h, 0, qblk, tq, tid, slope2, lds, o0, li0);
#pragma unroll
  for (int dt = 0; dt < 4; ++dt)
#pragma unroll
    for (int g2 = 0; g2 < 2; ++g2) {
      u32x4 pk;
#pragma unroll
      for (int k = 0; k < 4; ++k) pk[k] = cvt_pk_bf16(o0[dt][g2 * 8 + 2 * k] * li0, o0[dt][g2 * 8 + 2 * k + 1] * li0);
      park[(dt * 2 + g2) * 64] = pk;
    }
  attn_b_pass(p, L, seq, h, 1, qblk, tq, tid, slope2, lds, o0, li1);
  const float c1 = p.lam[layer] * li1;
  const int tid2 = opaque_tid(), half2 = (tid2 >> 5) & 1;
  const size_t tok2 = (size_t)seq * L + qblk * 256 + (tid2 >> 6) * 32 + (tid2 & 31);
  float ss = 0.f;
#pragma unroll
  for (int dt = 0; dt < 4; ++dt)
#pragma unroll
    for (int g2 = 0; g2 < 2; ++g2) {
      const u32x4 pk = park[(dt * 2 + g2) * 64];
#pragma unroll
      for (int k = 0; k < 4; ++k) {
        const float va = bf_lo(pk[k]) - o0[dt][g2 * 8 + 2 * k] * c1, vb = bf_hi(pk[k]) - o0[dt][g2 * 8 + 2 * k + 1] * c1;
        o0[dt][g2 * 8 + 2 * k] = va; o0[dt][g2 * 8 + 2 * k + 1] = vb; ss += va * va + vb * vb;
      }
    }
  ss += __shfl_xor(ss, 32);
  const float rn = rsqrtf(ss * (1.0f / 128.0f) + 1e-6f) * p.lam[4 + layer];
  const float* gd = p.g_diff + layer * 128;
  bf16_t* yrow = p.yg + tok2 * YW + 512 + h * 128;
  const bf16_t* zrow = p.u + tok2 * UW + U_ZB + h * 128;
#pragma unroll
  for (int dt = 0; dt < 4; ++dt)
#pragma unroll
    for (int g4 = 0; g4 < 4; ++g4) {
      const int dim = dt * 32 + g4 * 8 + half2 * 4;
      const u32x2 zr = *(const u32x2*)(zrow + dim);
      const f32x4 gv = *(const f32x4*)(gd + dim);
      const float y0 = o0[dt][g4 * 4 + 0] * rn * gv[0] * silu(bf_lo(zr[0]));
      const float y1 = o0[dt][g4 * 4 + 1] * rn * gv[1] * silu(bf_hi(zr[0]));
      const float y2 = o0[dt][g4 * 4 + 2] * rn * gv[2] * silu(bf_lo(zr[1]));
      const float y3 = o0[dt][g4 * 4 + 3] * rn * gv[3] * silu(bf_hi(zr[1]));
      u32x2 pk = {cvt_pk_bf16(y0, y1), cvt_pk_bf16(y2, y3)};
      *(u32x2*)(yrow + dim) = pk;
    }
}

constexpr int LDS_AK = 0, LDS_AV = LDS_AK + 2 * KB_BYTES, LDS_ATAB = LDS_AV + 2 * KB_BYTES, ATAB_ROW = 128;
__device__ void attn_a_block(const Params& p, int layer, int L, int seq, int h, int r0, LAS unsigned char* lds) {
  const int tid = opaque_tid(), lane = tid & 63, wid = __builtin_amdgcn_readfirstlane(tid >> 6);
  const int q = lane & 31, half = lane >> 5;
  const size_t tokbase = (size_t)seq * L;
  const int rows = L >> 6;
  const int ra = r0 + (wid >> 2) * 2, c0 = (wid & 3) * 16;
  int kstart = c0 - 8; kstart = kstart < 0 ? 0 : (kstart > 32 ? 32 : kstart);
  const int qrow = ra + (q >> 4), qcol = c0 + (q & 15), tq = qrow * 64 + qcol;
  int rsq = qrow - 4; rsq = rsq < 0 ? 0 : (rsq > rows - 8 ? rows - 8 : rsq);
  int rsa = ra - 4; rsa = rsa < 0 ? 0 : (rsa > rows - 8 ? rows - 8 : rsa);
  int rsb = ra - 3; rsb = rsb < 0 ? 0 : (rsb > rows - 8 ? rows - 8 : rsb);
  int kr_lo = r0 - 4; kr_lo = kr_lo < 0 ? 0 : (kr_lo > rows - 8 ? rows - 8 : kr_lo);
  int kr_hi = r0 - 1; kr_hi = (kr_hi < 0 ? 0 : (kr_hi > rows - 8 ? rows - 8 : kr_hi)) + 7;
  int qstart = qcol - 8; qstart = qstart < 0 ? 0 : (qstart > 48 ? 48 : qstart);
  bf16x8 qf[4];
  { const bf16_t* qp = p.u + (tokbase + tq) * UW + U_QA + h * 64 + half * 8;
#pragma unroll
    for (int ks = 0; ks < 4; ++ks) qf[ks] = ld16(qp + ks * 16); }
  {
    LAS float* tab = (LAS float*)(lds + LDS_ATAB);
    const float* rpb = p.rpb + ((size_t)layer * 8 + h) * 15 * 31;
    for (int idx = tid; idx < 15 * ATAB_ROW; idx += 512) { const int row = idx >> 7, cc = (idx & 127) - 48; tab[idx] = (cc >= 0 && cc <= 30) ? rpb[row * 31 + cc] * LOG2E : 0.f; }
  }
  const int spart = tid & 7, srow = tid >> 3;
  const bf16_t* kg = p.u + (tokbase + srow) * UW + U_KA + h * 64 + spart * 8;
  const bf16_t* vg = p.vt + ((size_t)seq * VW + V_A + h * 64 + srow) * L + spart * 8;
  const int kst = srow * TB_ROW + spart * 16;
  const int vst = srow * TB_ROW + spart * 16;
  const int krd = (kstart + q) * TB_ROW + half * 16;
  const int vrd = q * TB_ROW + (kstart + half * 4) * 2;
  f32x16 o[2] = {zero16(), zero16()};
  float mrun = -1e30f, lrun = 0.f;
  bf16x8 kr_, vr_;
  kr_ = ld16(kg + (size_t)(kr_lo * 64) * UW); vr_ = ld16(vg + kr_lo * 64);
  *(LAS bf16x8*)(lds + LDS_AK + kst) = kr_;
  *(LAS bf16x8*)(lds + LDS_AV + vst) = vr_;
  asm volatile("" : "+v"(qf[0]), "+v"(qf[1]), "+v"(qf[2]), "+v"(qf[3]));
  __syncthreads();
#pragma unroll 1
  for (int kr = kr_lo; kr <= kr_hi; ++kr) {
    const int it = kr - kr_lo;
    const bool more = (kr < kr_hi);
    if (more) { kr_ = ld16(kg + (size_t)((kr + 1) * 64) * UW); vr_ = ld16(vg + (kr + 1) * 64); }
    const LAS unsigned char* kb = lds + LDS_AK + (it & 1) * KB_BYTES;
    const LAS unsigned char* vb = lds + LDS_AV + (it & 1) * KB_BYTES;
    if (kr >= rsa && kr < rsb + 8) {
      const bool rowok = (kr >= rsq) && (kr < rsq + 8);
      int trow_i = kr - qrow + 7; trow_i = trow_i < 0 ? 0 : (trow_i > 14 ? 14 : trow_i);
      const LAS float* trow = (const LAS float*)(lds + LDS_ATAB) + trow_i * ATAB_ROW + (kstart + half * 4 - qcol + 15 + 48);
      f32x16 sc = zero16();
#pragma unroll
      for (int ks = 0; ks < 4; ++ks) sc = mfma32(*(const LAS bf16x8*)(kb + krd + ks * 32), qf[ks], sc);
#pragma unroll
      for (int ii = 0; ii < 16; ++ii) {
        const int kcol = kstart + (ii >> 2) * 8 + half * 4 + (ii & 3);
        const bool ok = rowok && (kcol >= qstart) && (kcol < qstart + 16);
        sc[ii] = ok ? sc[ii] + trow[(ii >> 2) * 8 + (ii & 3)] : -INFINITY;
      }
      float al; bf16x8 pk[2];
      softmax_tile(sc, mrun, lrun, al, pk[0], pk[1]);
      if (__builtin_amdgcn_ballot_w64(al != 1.0f) != 0) { o[0] *= al; o[1] *= al; }
#pragma unroll
      for (int dt = 0; dt < 2; ++dt)
#pragma unroll
        for (int s2 = 0; s2 < 2; ++s2) {
          const LAS unsigned char* vp = vb + vrd + dt * 32 * TB_ROW + s2 * 32;
          const bf16x4 va = *(const LAS bf16x4*)vp, vc = *(const LAS bf16x4*)(vp + 16);
          o[dt] = mfma32(__builtin_shufflevector(va, vc, 0, 1, 2, 3, 4, 5, 6, 7), pk[s2], o[dt]);
        }
    }
    if (more) {
      *(LAS bf16x8*)(lds + LDS_AK + ((it + 1) & 1) * KB_BYTES + kst) = kr_;
      *(LAS bf16x8*)(lds + LDS_AV + ((it + 1) & 1) * KB_BYTES + vst) = vr_;
    }
    __syncthreads();
  }
  const float c = frcp(lrun + __shfl_xor(lrun, 32));
  bf16_t* yrow = p.yg + (tokbase + tq) * YW + h * 64;
  const bf16_t* zrow = p.u + (tokbase + tq) * UW + U_ZA + h * 64;
#pragma unroll
  for (int dt = 0; dt < 2; ++dt)
#pragma unroll
    for (int g4 = 0; g4 < 4; ++g4) {
      const int dim = dt * 32 + g4 * 8 + half * 4;
      const u32x2 zr = *(const u32x2*)(zrow + dim);
      const float y0 = o[dt][g4 * 4 + 0] * c * silu(bf_lo(zr[0]));
      const float y1 = o[dt][g4 * 4 + 1] * c * silu(bf_hi(zr[0]));
      const float y2 = o[dt][g4 * 4 + 2] * c * silu(bf_lo(zr[1]));
      const float y3 = o[dt][g4 * 4 + 3] * c * silu(bf_hi(zr[1]));
      u32x2 pk = {cvt_pk_bf16(y0, y1), cvt_pk_bf16(y2, y3)};
      *(u32x2*)(yrow + dim) = pk;
    }
}

__device__ void attn_c_unit(const Params& p, int L, int lshift, int seq, int g, int h, int rr, int mblk, int lane) {
  const int q = lane & 31, half = lane >> 5;
  const size_t tokbase = (size_t)seq * L;
  const int ds = (g == 0) ? 0 : (g == 1 ? 2 : 4), d = 1 << ds, M = L >> ds;
  const int hh = g * 4 + h;
  const int m0 = mblk * 32, mq = m0 + q, tq = mq * d + rr;
  const bf16_t* urow = p.u + (tokbase + tq) * UW;
  bf16x8 qf[4];
#pragma unroll
  for (int ks = 0; ks < 4; ++ks) qf[ks] = ld16(urow + U_QC + hh * 64 + ks * 16 + half * 8);
  f32x16 o[2] = {zero16(), zero16()};
  float mrun = -1e30f, lrun = 0.f;
  const float coef = exp2f(-(2.0f / 3.0f) * (float)(hh + 1)) * (float)d * LOG2E;
  const bf16_t* vbase = p.vt + ((size_t)seq * VW + V_C + hh * 64 + q) * L + (size_t)rr * M;
  bf16x8 kf[5][4];
#pragma unroll
  for (int j = 0; j < 5; ++j) {
    int mkl = m0 - 64 + 32 * j + q; mkl = mkl < 0 ? 0 : (mkl > M - 1 ? M - 1 : mkl);
    const bf16_t* kp = p.u + (tokbase + (size_t)mkl * d + rr) * UW + U_KC + hh * 64 + half * 8;
#pragma unroll
    for (int ks = 0; ks < 4; ++ks) kf[j][ks] = ld16(kp + ks * 16);
  }
  bf16x8 vf[2][2][2];
  auto load_v = [&](int j, bf16x8 (&dst)[2][2]) {
#pragma unroll
    for (int dt = 0; dt < 2; ++dt)
#pragma unroll
      for (int s2 = 0; s2 < 2; ++s2) {
        int pa = m0 - 64 + 32 * j + s2 * 16 + half * 4, pb = pa + 8;
        pa = pa < 0 ? 0 : (pa > M - 4 ? M - 4 : pa); pb = pb < 0 ? 0 : (pb > M - 4 ? M - 4 : pb);
        const bf16_t* vp = vbase + (size_t)(dt * 32) * L;
        dst[dt][s2] = ld8x2(vp + pa, vp + pb);
      }
  };
  load_v(0, vf[0]);
#pragma unroll
  for (int j = 0; j < 5; ++j) {
    if (j + 1 < 5) load_v(j + 1, vf[(j + 1) & 1]);
    const int mk0 = m0 - 64 + 32 * j;
    if (mk0 + 32 <= 0 || mk0 >= M) continue;
    f32x16 s = zero16();
#pragma unroll
    for (int ks = 0; ks < 4; ++ks) s = mfma32(kf[j][ks], qf[ks], s);
#pragma unroll
    for (int ii = 0; ii < 16; ++ii) {
      const int mk = mk0 + (ii >> 2) * 8 + half * 4 + (ii & 3);
      const int rel = mk - mq; const int ar = rel < 0 ? -rel : rel;
      const bool ok = (mk >= 0) && (mk < M) && (ar <= 64);
      s[ii] = ok ? s[ii] - coef * (float)ar : -INFINITY;
    }
    float alpha; bf16x8 pk[2];
    softmax_tile(s, mrun, lrun, alpha, pk[0], pk[1]);
#pragma unroll
    for (int dt = 0; dt < 2; ++dt) {
      o[dt] *= alpha;
#pragma unroll
      for (int s2 = 0; s2 < 2; ++s2) o[dt] = mfma32(vf[j & 1][dt][s2], pk[s2], o[dt]);
    }
  }
  const float lt = lrun + __shfl_xor(lrun, 32);
  const float c = frcp(lt);
  bf16_t* orow = p.oc + (tokbase + tq) * 768 + hh * 64;
#pragma unroll
  for (int dt = 0; dt < 2; ++dt)
#pragma unroll
    for (int g4 = 0; g4 < 4; ++g4) {
      const int dim = dt * 32 + g4 * 8 + half * 4;
      u32x2 pk = {cvt_pk_bf16(o[dt][g4 * 4 + 0] * c, o[dt][g4 * 4 + 1] * c), cvt_pk_bf16(o[dt][g4 * 4 + 2] * c, o[dt][g4 * 4 + 3] * c)};
      *(u32x2*)(orow + dim) = pk;
    }
  if (half == 0) p.lse[(tokbase + tq) * 12 + hh] = mrun + log2f(lt);
}

constexpr int CV_ROW = 784;
constexpr int LDS_CK = 0, LDS_CV = 384 * TB_ROW;
__device__ void attn_c_block(const Params& p, int L, int lshift, int seq, int g, int h, int pblk, LAS unsigned char* lds) {
  const int tid = opaque_tid(), lane = tid & 63, wid = __builtin_amdgcn_readfirstlane(tid >> 6);
  const int q = lane & 31, half = lane >> 5;
  const size_t tokbase = (size_t)seq * L;
  const int ds = (g == 0) ? 0 : (g == 1 ? 2 : 4), d = 1 << ds, M = L >> ds;
  const int hh = g * 4 + h;
  const int p0 = pblk * 256;
  {
    const int part = tid & 7;
#pragma unroll
    for (int c = 0; c < 6; ++c) {
      const int row = (tid >> 3) + c * 64;
      int pp = p0 - 64 + row; pp = pp < 0 ? 0 : (pp > L - 1 ? L - 1 : pp);
      const int tok = ((pp & (M - 1)) << ds) + (pp >> (lshift - ds));
      const bf16x8 v = ld16(p.u + (tokbase + tok) * UW + U_KC + hh * 64 + part * 8);
      *(LAS bf16x8*)(lds + LDS_CK + row * TB_ROW + part * 16) = v;
    }
#pragma unroll
    for (int c = 0; c < 6; ++c) {
      const int idx = tid + c * 512, dim = idx / 48, c8 = idx % 48;
      int pp = p0 - 64 + c8 * 8; pp = pp < 0 ? 0 : (pp > L - 8 ? L - 8 : pp);
      const bf16x8 v = ld16(p.vt + ((size_t)seq * VW + V_C + hh * 64 + dim) * L + pp);
      LAS unsigned char* dst = lds + LDS_CV + dim * CV_ROW + ((c8 >> 1) * 16 + (c8 & 1) * 4) * 2;
      *(LAS bf16x4*)dst = __builtin_shufflevector(v, v, 0, 1, 2, 3); *(LAS bf16x4*)(dst + 16) = __builtin_shufflevector(v, v, 4, 5, 6, 7);
    }
  }
  const int pw = p0 + wid * 32;
  const int rr = pw >> (lshift - ds), m0 = pw & (M - 1), mq = m0 + q, tq = mq * d + rr;
  bf16x8 qf[4];
  { const bf16_t* qp = p.u + (tokbase + tq) * UW + U_QC + hh * 64 + half * 8;
#pragma unroll
    for (int ks = 0; ks < 4; ++ks) qf[ks] = ld16(qp + ks * 16); }
  f32x16 o[2] = {zero16(), zero16()};
  float mrun = -1e30f, lrun = 0.f;
  const float coef = exp2f(-(2.0f / 3.0f) * (float)(hh + 1)) * (float)d * LOG2E;
  __syncthreads();
#pragma unroll
  for (int j = 0; j < 5; ++j) {
    const int mk0 = m0 - 64 + 32 * j;
    if (mk0 + 32 <= 0 || mk0 >= M) continue;
    const LAS unsigned char* kb = lds + LDS_CK + ((wid + j) * 32 + q) * TB_ROW + half * 16;
    f32x16 sc = zero16();
#pragma unroll
    for (int ks = 0; ks < 4; ++ks) sc = mfma32(*(const LAS bf16x8*)(kb + ks * 32), qf[ks], sc);
#pragma unroll
    for (int ii = 0; ii < 16; ++ii) {
      const int mk = mk0 + (ii >> 2) * 8 + half * 4 + (ii & 3);
      const int rel = mk - mq; const int ar = rel < 0 ? -rel : rel;
      const bool ok = (mk >= 0) && (mk < M) && (ar <= 64);
      sc[ii] = ok ? sc[ii] - coef * (float)ar : -INFINITY;
    }
    float alpha; bf16x8 pk[2];
    softmax_tile(sc, mrun, lrun, alpha, pk[0], pk[1]);
#pragma unroll
    for (int dt = 0; dt < 2; ++dt) {
      o[dt] *= alpha;
#pragma unroll
      for (int s2 = 0; s2 < 2; ++s2)
        o[dt] = mfma32(*(const LAS bf16x8*)(lds + LDS_CV + (dt * 32 + q) * CV_ROW + ((wid + j) * 32 + s2 * 16) * 2 + half * 16), pk[s2], o[dt]);
    }
  }
  __syncthreads();
  const float lt = lrun + __shfl_xor(lrun, 32);
  const float c = frcp(lt);
  bf16_t* orow = p.oc + (tokbase + tq) * 768 + hh * 64;
#pragma unroll
  for (int dt = 0; dt < 2; ++dt)
#pragma unroll
    for (int g4 = 0; g4 < 4; ++g4) {
      const int dim = dt * 32 + g4 * 8 + half * 4;
      u32x2 pk = {cvt_pk_bf16(o[dt][g4 * 4 + 0] * c, o[dt][g4 * 4 + 1] * c), cvt_pk_bf16(o[dt][g4 * 4 + 2] * c, o[dt][g4 * 4 + 3] * c)};
      *(u32x2*)(orow + dim) = pk;
    }
  if (half == 0) p.lse[(tokbase + tq) * 12 + hh] = mrun + log2f(lt);
}

__device__ void phase_attn(const Params& p, int layer, int L, int lshift, LAS unsigned char* lds) {
  const int tiles = L >> 5;
  const int nseq = TC >> lshift;
  const int nw = gridDim.x * 8;
  int w, lane;
  { const int qblks = L >> 8, npairs = nseq * 4, nunits = npairs * qblks;
    for (int b = blockIdx.x; b < nunits; b += gridDim.x) {
      int pair, qblk;
      if ((gridDim.x & 7) == 0 && (npairs & 7) == 0 && nunits == (int)gridDim.x) { const int xcd = b & 7, j = b >> 3; pair = xcd * (npairs >> 3) + j / qblks; qblk = j % qblks; }
      else { pair = b / qblks; qblk = b % qblks; }
      attn_b_block(p, layer, L, pair >> 2, pair & 3, qblk, lds);
    }
  }
  { const int tid = opaque_tid(); lane = tid & 63; w = blockIdx.x * 8 + __builtin_amdgcn_readfirstlane(tid >> 6); }
  {
  { const int rgs = L >> 8, nunits = nseq * 8 * rgs;
    for (int b = blockIdx.x; b < nunits; b += gridDim.x) { const int sh = b / rgs, rg = b % rgs; attn_a_block(p, layer, L, sh >> 3, sh & 7, rg * 4, lds); }
  }
  { const int tid = opaque_tid(); lane = tid & 63; w = blockIdx.x * 8 + __builtin_amdgcn_readfirstlane(tid >> 6); }
  { const int pbs = L >> 8, nunits = nseq * 12 * pbs;
    for (int b = blockIdx.x; b < nunits; b += gridDim.x) {
      const int pblk = b % pbs, sgh = b / pbs;
      const int seq = sgh / 12, gh = sgh % 12;
      attn_c_block(p, L, lshift, seq, gh >> 2, gh & 3, pblk, lds);
    }
  }
  }
}

__device__ void phase_combine(const Params& p) {
  const int gt = blockIdx.x * 512 + opaque_tid(), ngt = gridDim.x * 512;
  for (int it = gt; it < TC * 32; it += ngt) {
    const int tok = it >> 5, sub = it & 31, h = sub >> 3, d8 = (sub & 7) * 8;
    const float* ls = p.lse + (size_t)tok * 12;
    const float l0 = ls[h], l1 = ls[4 + h], l2 = ls[8 + h];
    const float mx = fmaxf(l0, fmaxf(l1, l2));
    const float w0 = fexp2(l0 - mx), w1 = fexp2(l1 - mx), w2 = fexp2(l2 - mx);
    const float inv = frcp(w0 + w1 + w2);
    const bf16_t* ob = p.oc + (size_t)tok * 768 + h * 64 + d8;
    const u32x4 a = *(const u32x4*)ob, b = *(const u32x4*)(ob + 256), c = *(const u32x4*)(ob + 512);
    const u32x4 z = *(const u32x4*)(p.u + (size_t)tok * UW + U_ZC + h * 64 + d8);
    u32x4 r;
#pragma unroll
    for (int k = 0; k < 4; ++k) {
      const float vlo = (w0 * bf_lo(a[k]) + w1 * bf_lo(b[k]) + w2 * bf_lo(c[k])) * inv * silu(bf_lo(z[k]));
      const float vhi = (w0 * bf_hi(a[k]) + w1 * bf_hi(b[k]) + w2 * bf_hi(c[k])) * inv * silu(bf_hi(z[k]));
      r[k] = cvt_pk_bf16(vlo, vhi);
    }
    *(u32x4*)(p.yg + (size_t)tok * YW + 1024 + h * 64 + d8) = r;
  }
}


#define XB_TMO      128
#define XB_XCNT(j)  (256  + 64 * (j))
#define XB_XSUB(j)  (1280 + 64 * (j))
#define XB_XGEN(j)  (2304 + 64 * (j))
#define XB_TOP      3328
#define XB_TOPGEN   3392
#define XCD_BAR_WORDS 3456
#define XB_SPIN_CAP (1u << 18)
__device__ __forceinline__ unsigned xb_ld(unsigned* p)              { return __hip_atomic_load(p, __ATOMIC_RELAXED, __HIP_MEMORY_SCOPE_AGENT); }
__device__ __forceinline__ unsigned xb_add(unsigned* p, unsigned v) { return __hip_atomic_fetch_add(p, v, __ATOMIC_RELAXED, __HIP_MEMORY_SCOPE_AGENT); }
__device__ __forceinline__ unsigned xb_xcc_id() { return (unsigned)__builtin_amdgcn_s_getreg((3 << 11) | 20) & 0xFu; }
#define XB_SPIN(cond, bar) do { unsigned _sp = 0; while (cond) { __builtin_amdgcn_s_sleep(1); \
    if ((++_sp & 255u) == 0u) { if (xb_ld(&(bar)[XB_TMO])) break; if (_sp > XB_SPIN_CAP) { atomicAdd(&(bar)[XB_TMO], 1u); break; } } } } while (0)
struct XcdBarrier { unsigned* bar; unsigned x; volatile LAS unsigned* st; };
__device__ __forceinline__ XcdBarrier xcd_barrier_post(unsigned* bar, volatile LAS unsigned* st) {
  XcdBarrier b; b.bar = bar; b.x = xb_xcc_id(); b.st = st;
  if (opaque_tid() == 0) (void)xb_add(&bar[XB_XCNT(b.x)], 1u);
  return b;
}
__device__ __forceinline__ void xcd_barrier_complete(unsigned* bar, unsigned x, unsigned& nloc, unsigned& nx) {
  const unsigned G = gridDim.x * gridDim.y * gridDim.z;
  unsigned sum, cnt, mine, sp = 0u;
  for (;;) {
    sum = 0u; cnt = 0u; mine = 0u;
#pragma unroll
    for (unsigned j = 0; j < 16; ++j) { const unsigned c = xb_ld(&bar[XB_XCNT(j)]); sum += c; cnt += (c > 0u) ? 1u : 0u; mine = (j == x) ? c : mine; }
    if (sum == G) break;
    __builtin_amdgcn_s_sleep(1);
    if ((++sp & 255u) == 0u) { if (xb_ld(&bar[XB_TMO])) break; if (sp > XB_SPIN_CAP) { atomicAdd(&bar[XB_TMO], 1u); break; } }
  }
  nloc = mine > 0u ? mine : 1u; nx = cnt > 0u ? cnt : 1u;
}
__device__ __forceinline__ void xcd_barrier(const XcdBarrier& b) {
  asm volatile("s_waitcnt vmcnt(0)" ::: "memory");
  __syncthreads();
  if (opaque_tid() == 0) {
    unsigned* bar = b.bar;
    __builtin_amdgcn_s_waitcnt(0);
    unsigned nloc = b.st[0], nx = b.st[1];
    if (nloc == 0u) { xcd_barrier_complete(bar, b.x, nloc, nx); b.st[0] = nloc; b.st[1] = nx; }
    const unsigned old = xb_add(&bar[XB_XSUB(b.x)], 1u);
    const unsigned gen = old / nloc;
    if (old + 1u == (gen + 1u) * nloc) {
      __builtin_amdgcn_fence(__ATOMIC_RELEASE, "agent");
      asm volatile("s_waitcnt vmcnt(0)" ::: "memory");
      const unsigned og = xb_add(&bar[XB_TOP], 1u);
      const unsigned tg = og / nx;
      if (og + 1u == (tg + 1u) * nx) xb_add(&bar[XB_TOPGEN], 1u);
      else XB_SPIN(xb_ld(&bar[XB_TOPGEN]) == tg, bar);
      __builtin_amdgcn_fence(__ATOMIC_ACQUIRE, "agent");
      xb_add(&bar[XB_XGEN(b.x)], 1u);
      asm volatile("s_waitcnt vmcnt(0)" ::: "memory");
    } else {
      XB_SPIN(xb_ld(&bar[XB_XGEN(b.x)]) == gen, bar);
      __builtin_amdgcn_fence(__ATOMIC_ACQUIRE, "agent");
      asm volatile("s_waitcnt vmcnt(0)" ::: "memory");
    }
  }
  __syncthreads();
}

constexpr int DYN_LDS_BYTES = LDS_ATT_TOTAL > pg8::STAGE_BYTES ? LDS_ATT_TOTAL : pg8::STAGE_BYTES;
__global__ void __launch_bounds__(512) fwd_megakernel(Params p) {
  extern __shared__ __attribute__((aligned(16))) unsigned char smem[];
  __shared__ __attribute__((aligned(16))) unsigned xb_words[4];
  cg::grid_group grid = cg::this_grid();
  if (threadIdx.x == 0) { xb_words[0] = 0u; xb_words[1] = 0u; xb_words[2] = 0u; xb_words[3] = 0u; }
  if ((threadIdx.x & 63) == 0) g_wid_table[hw_wave_slot()] = (int)(threadIdx.x >> 6);
  __syncthreads();
  const XcdBarrier xb = xcd_barrier_post(p.bar, (volatile LAS unsigned*)xb_words);
#define GSYNC() xcd_barrier(xb)
  LAS unsigned char* lds = (LAS unsigned char*)smem;
  phase_prep(p, (LAS float*)smem);
  phase_x(p, 0);
  grid.sync();
  for (int chunk = 0; chunk < NCHUNK; ++chunk) {
    const int L = chunk < 2 ? 2048 : 4096, lshift = chunk < 2 ? 11 : 12;
    const float* xin = (chunk < 2) ? p.xp + (size_t)chunk * TC * DM : p.xs + (size_t)(chunk - 2) * TC * DM;
    float* xres = p.out + (size_t)chunk * TC * DM;
    float* ssq = p.ssq + (size_t)chunk * TC * 16;
    for (int layer = 0; layer < DEPTH; ++layer) {
      {
        {
        { pg8::Gemm g{p.xb, p.wt_in + (size_t)layer * INW * DM, TC, UW, DM, 0, lshift};
          pg8::StaticOrder S; S.init(TC, UW, gridDim.x, blockIdx.x);
          EpiU E{p.u, p.rinv + (size_t)chunk * TC, p.b_gate + (size_t)layer * 3 * DM};
          pg8::gemm_phase<false>(lds, g, S, E); }
        {
          pg8::Gemm g{p.wt_in + ((size_t)layer * INW + UW) * DM, p.xb, VW, TC, DM, 1, lshift};
          pg8::StaticOrder S; S.init(VW, TC, gridDim.x, (blockIdx.x + (gridDim.x >> 2)) % gridDim.x);
          EpiVT E{p.vt, p.rinv + (size_t)chunk * TC, L, lshift};
          pg8::gemm_phase<true>(lds, g, S, E); }
        }
      }
      GSYNC();
      phase_attn(p, layer, L, lshift, lds);
      GSYNC();
      phase_combine(p);
      GSYNC();
      {
        pg8::Gemm g{p.yg, p.wt_br + (size_t)layer * DM * YW, TC, DM, YW, 0, 0};
        pg8::StaticOrder S; S.init(TC, DM, gridDim.x, blockIdx.x);
        EpiMerge E{p.u, p.merged};
        pg8::gemm_phase<false>(lds, g, S, E);
      }
      GSYNC();
      {
        pg8::Gemm g{p.merged, p.wt_out + (size_t)layer * DM * DM, TC, DM, DM, 0, 0};
        pg8::StaticOrder S; S.init(TC, DM, gridDim.x, blockIdx.x);
        EpiRes E{layer == 0 ? xin : (const float*)nullptr, p.xb, layer == DEPTH - 1 ? xres : (float*)nullptr, p.xb, ssq};
        pg8::gemm_phase<false>(lds, g, S, E);
      }
      GSYNC();
      if (layer + 1 < DEPTH) { phase_rinv(p, chunk); GSYNC(); }
    }
    phase_final(p, chunk);
    if (chunk + 1 < NCHUNK) { phase_x(p, chunk + 1); GSYNC(); }
  }
}

extern "C" void kernel_launch(void* const* d_in, const int* in_sizes, int n_in, void* d_out, int out_size, void* d_ws, size_t ws_size, hipStream_t stream) {
  (void)in_sizes; (void)n_in; (void)out_size;
  static int grid_blocks = 0;
  if (!grid_blocks) {
    int dev = 0, cus = 0, per_cu = 0;
    hipGetDevice(&dev);
    hipDeviceGetAttribute(&cus, hipDeviceAttributeMultiprocessorCount, dev);
    hipFuncSetAttribute((const void*)fwd_megakernel, hipFuncAttributeMaxDynamicSharedMemorySize, DYN_LDS_BYTES);
    hipOccupancyMaxActiveBlocksPerMultiprocessor(&per_cu, fwd_megakernel, 512, DYN_LDS_BYTES);
    if (per_cu < 1) per_cu = 1;
    grid_blocks = cus * per_cu;
    if (grid_blocks > 256) grid_blocks = 256;
  }
  Params p{};
  p.xp = (const float*)d_in[0]; p.xs = (const float*)d_in[1]; p.g_norm = (const float*)d_in[2]; p.w_in = (const float*)d_in[3];
  p.b_gate = (const float*)d_in[4]; p.rpb = (const float*)d_in[5]; p.lam_qk = (const float*)d_in[6]; p.g_diff = (const float*)d_in[7];
  p.w_br_a = (const float*)d_in[8]; p.w_br_b = (const float*)d_in[9]; p.w_br_c = (const float*)d_in[10]; p.w_out = (const float*)d_in[11];
  p.g_final = (const float*)d_in[12];
  p.out = (float*)d_out;
  char* w = (char*)d_ws; size_t off = 0;
  auto take = [&](size_t bytes) { char* r = w + off; off += (bytes + 255) & ~(size_t)255; return r; };
  p.wt_in = (bf16_t*)take((size_t)DEPTH * INW * DM * 2);
  p.wt_br = (bf16_t*)take((size_t)DEPTH * DM * YW * 2);
  p.wt_out = (bf16_t*)take((size_t)DEPTH * DM * DM * 2);
  p.xb = (bf16_t*)take((size_t)TC * DM * 2);
  p.u = (bf16_t*)take((size_t)TC * UW * 2);
  p.vt = (bf16_t*)take((size_t)TC * VW * 2);
  p.yg = (bf16_t*)take((size_t)TC * YW * 2);
  p.oc = (bf16_t*)take((size_t)TC * 768 * 2);
  p.merged = (bf16_t*)take((size_t)TC * DM * 2);
  p.lse = (float*)take((size_t)TC * 12 * 4);
  p.ssq = (float*)take((size_t)NTOK * 16 * 4);
  p.lam = (float*)take(256);
  p.rinv = (float*)take((size_t)NTOK * 4);
  p.bar = (unsigned*)take((size_t)XCD_BAR_WORDS * 4);
  if (off > ws_size) fprintf(stderr, "workspace too small: need %zu have %zu\n", off, ws_size);
  hipMemsetAsync(p.bar, 0, (size_t)XCD_BAR_WORDS * 4, stream);
  void* args[] = {&p};
  hipError_t e = hipLaunchCooperativeKernel((void*)fwd_megakernel, dim3(grid_blocks), dim3(512), args, DYN_LDS_BYTES, stream);
  if (e != hipSuccess) fprintf(stderr, "cooperative launch failed: %s (grid %d)\n", hipGetErrorString(e), grid_blocks);
}
```

```cpp
#include <hip/hip_runtime.h>
#include <hip/hip_cooperative_groups.h>
#include <cstdio>
namespace cg = cooperative_groups;

#define LAS __attribute__((address_space(3)))
typedef unsigned short bf16_t;
typedef short bf16x8 __attribute__((ext_vector_type(8)));
typedef short bf16x4 __attribute__((ext_vector_type(4)));
typedef float f32x4 __attribute__((ext_vector_type(4)));
typedef float f32x16 __attribute__((ext_vector_type(16)));
typedef unsigned u32x4 __attribute__((ext_vector_type(4)));
typedef unsigned u32x2 __attribute__((ext_vector_type(2)));

constexpr int DM = 1024, DEPTH = 4, INW = 9728, UW = 7936, VW = 1792, YW = 1280;
constexpr int TC = 16384, NCHUNK = 4, NTOK = 65536;
constexpr float LOG2E = 1.4426950408889634f;
constexpr float QSCALE = 0.125f * LOG2E;
constexpr int U_QA = 0, U_KA = 512, U_ZA = 1024, U_QB = 1536, U_KB = 2048, U_ZB = 2560, U_QC = 3072, U_KC = 3840, U_ZC = 4608, U_GL = 4864;
constexpr int V_A = 0, V_B = 512, V_C = 1024;

struct Params {
  const float *xp, *xs, *g_norm, *w_in, *b_gate, *rpb, *lam_qk, *g_diff, *w_br_a, *w_br_b, *w_br_c, *w_out, *g_final;
  float* out;
  bf16_t *wt_in, *wt_br, *wt_out, *xb, *u, *vt, *yg, *oc, *merged;
  float *lse, *ssq, *lam, *rinv;
  unsigned* bar;
};

__device__ __forceinline__ unsigned cvt_pk_bf16(float lo, float hi) { unsigned r; asm volatile("v_cvt_pk_bf16_f32 %0, %1, %2" : "=v"(r) : "v"(lo), "v"(hi)); return r; }
__device__ __forceinline__ float bf_lo(unsigned v) { return __uint_as_float(v << 16); }
__device__ __forceinline__ float bf_hi(unsigned v) { return __uint_as_float(v & 0xffff0000u); }
__device__ __forceinline__ float fexp2(float x) { return __builtin_amdgcn_exp2f(x); }
__device__ __forceinline__ float frcp(float x) { return __builtin_amdgcn_rcpf(x); }

__shared__ int g_wid_table[64];
__device__ __forceinline__ unsigned hw_wave_slot() { return (unsigned)__builtin_amdgcn_s_getreg(((6 - 1) << 11) | (0 << 6) | 4) & 63u; }
__device__ __forceinline__ int opaque_tid() {
  const int wid = __builtin_amdgcn_readfirstlane(g_wid_table[hw_wave_slot()]);
  unsigned z = 0u; asm volatile("" : "+v"(z));
  int t = wid * 64 + (int)__builtin_amdgcn_mbcnt_hi(~0u, __builtin_amdgcn_mbcnt_lo(~0u, z));
  asm volatile("" : "+v"(t)); return t;
}

namespace pg8 {
constexpr int BM = 256, BK = 64, HALF = 128, HTB = HALF * BK * 2, STAGE_BYTES = 8 * HTB, NXCD = 8, WGM = 8;
__device__ __forceinline__ int lds_byte(int r, int c) { const int st = (r >> 4) * 2 + (c >> 5), rr = r & 15, cc = c & 31, ob = rr * 64 + cc * 2; return st * 1024 + (ob ^ (((ob >> 9) & 1) << 5)); }
__device__ __forceinline__ void stage_rc(int b, int& R, int& C) { const int st = b / 1024, sb = b % 1024, swz = sb ^ (((sb >> 9) & 1) << 5); R = (st >> 1) * 16 + swz / 64; C = (st & 1) * 32 + (swz % 64) / 2; }
__device__ __forceinline__ int perm32(int rho) { const int n = rho >> 4, i = rho & 15; return 8 * (i >> 2) + 4 * n + (i & 3); }
struct Unit { int pm, pn; };
struct Gemm { const bf16_t* A; const bf16_t* Bt; int M, N, K; int bperm, lshift; };
struct StaticOrder {
  int nM, nN, nwg, G, c;
  __device__ void init(int M, int N, int G_, int c_) { nM = M / BM; nN = N / BM; nwg = nM * nN; G = G_; c = c_; }
  __device__ bool next(int i, Unit& u) const {
    const long L = (long)i * G + c; if (L >= nwg) return false;
    int wgid = (int)L; { const int q = nwg / NXCD, r = nwg % NXCD, xcd = wgid % NXCD, off = wgid / NXCD; wgid = (xcd < r ? xcd * (q + 1) : r * (q + 1) + (xcd - r) * q) + off; }
    const int nig = WGM * nN, gid = wgid / nig, fm = gid * WGM, gsz = (nM - fm) < WGM ? (nM - fm) : WGM;
    u.pm = fm + ((wgid % nig) % gsz); u.pn = (wgid % nig) / gsz; return true;
  }
};

template <bool BPERM, class Epi>
__device__ __forceinline__ void gemm_phase(LAS unsigned char* lds, const Gemm g, const StaticOrder& S, const Epi& E) {
  const int tid_ = opaque_tid();
  const int tid = tid_, wid = __builtin_amdgcn_readfirstlane(tid >> 6), lane = tid & 63, wr = wid >> 2, wc = wid & 3, fr = lane & 15, fq = lane >> 4;
  const int K = g.K, nt = K / BK;
  const size_t kstep = (size_t)(BK * 2);
  const size_t hstep = (size_t)HALF * K * 2;
  const size_t tstep = 2 * hstep;
  unsigned voffA[2], voffBr[2], voffBc[2], voffB[2], voffBn[2];
#pragma unroll
  for (int i = 0; i < 2; ++i) { int R, C; stage_rc(tid * 16 + i * 8192, R, C); const int Rb = (R & ~31) + perm32(R & 31);
    voffA[i] = (unsigned)(R * K + C) * 2u; voffBr[i] = (unsigned)(Rb * K) * 2u; voffBc[i] = (unsigned)C * 2u; voffB[i] = voffBr[i] + voffBc[i]; voffBn[i] = voffB[i]; }
  auto bbase = [&](const Unit& u, int hh, int& sh) -> const char* {
    if constexpr (!BPERM) { sh = 0; return (const char*)g.Bt + (size_t)u.pn * tstep + (size_t)hh * hstep; }
    const int ds = u.pm <= 4 ? 0 : (u.pm == 5 ? 2 : 4); sh = ds;
    const int L = 1 << g.lshift; const int p0 = u.pn * 256 + hh * 128, seq = p0 >> g.lshift, p = p0 & (L - 1);
    const int Mc = L >> ds, r = p / Mc, m0 = p & (Mc - 1);
    return (const char*)g.Bt + ((size_t)seq * L + ((size_t)m0 << ds) + r) * (size_t)K * 2;
  };
  const unsigned ldsw = (unsigned)wid * 1024u;
  const int aoff = lds_byte(wr * 64 + fr, fq * 8), boff = lds_byte(wc * 32 + fr, fq * 8);
#define PG8_SA(b, h) (((b) * 2 + (h)) * HTB)
#define PG8_SB(b, h) ((4 + (b) * 2 + (h)) * HTB)
#define PG8_STAGE(bufoff, gbase, voff) do { _Pragma("unroll") for (int _i = 0; _i < 2; ++_i) \
    __builtin_amdgcn_global_load_lds((const unsigned*)((const char*)(gbase) + (voff)[_i]), (LAS unsigned*)(lds + (bufoff) + ldsw + _i * 8192), 16, 0, 0); } while (0)
#define PG8_LDA(dst, b, h) do { _Pragma("unroll") for (int m = 0; m < 4; ++m) _Pragma("unroll") for (int k = 0; k < 2; ++k) dst[m][k] = *(const LAS bf16x8*)(lds + PG8_SA(b, h) + aoff + m * 2048 + k * 1024); } while (0)
#define PG8_LDB(dst, b, h) do { _Pragma("unroll") for (int n = 0; n < 2; ++n) _Pragma("unroll") for (int k = 0; k < 2; ++k) dst[n][k] = *(const LAS bf16x8*)(lds + PG8_SB(b, h) + boff + n * 2048 + k * 1024); } while (0)
#define PG8_MMA(ai, bj, At, Bt) do { __builtin_amdgcn_s_setprio(1); _Pragma("unroll") for (int m = 0; m < 4; ++m) _Pragma("unroll") for (int n = 0; n < 2; ++n) _Pragma("unroll") for (int k = 0; k < 2; ++k) \
    acc[ai][bj][m][n] = __builtin_amdgcn_mfma_f32_16x16x32_bf16(Bt[n][k], At[m][k], acc[ai][bj][m][n], 0, 0, 0); __builtin_amdgcn_s_setprio(0); } while (0)
#define PG8_WAIT_V(n) asm volatile("s_waitcnt vmcnt(" #n ")" ::: "memory")
#define PG8_WAIT_L(n) asm volatile("s_waitcnt lgkmcnt(" #n ")" ::: "memory")
#define PG8_BAR __builtin_amdgcn_s_barrier()
#define PG8_SCHED __builtin_amdgcn_sched_barrier(0)
  Unit cur, nxt; int ui = 0;
  if (!S.next(0, cur)) return;
  f32x4 acc[2][2][4][2];
#pragma unroll
  for (int a = 0; a < 2; ++a)
#pragma unroll
    for (int b = 0; b < 2; ++b)
#pragma unroll
      for (int m = 0; m < 4; ++m)
#pragma unroll
        for (int n = 0; n < 2; ++n) acc[a][b][m][n] = (f32x4){0.f, 0.f, 0.f, 0.f};
  bf16x8 At[4][2], B0[2][2], B1[2][2];
  const char* cA = (const char*)g.A + (size_t)cur.pm * tstep;
  int csh; const char* cB0 = bbase(cur, 0, csh); const char* cB1 = bbase(cur, 1, csh);
#pragma unroll
  for (int i = 0; i < 2; ++i) voffB[i] = (voffBr[i] << csh) + voffBc[i];
  PG8_STAGE(PG8_SB(0, 0), cB0, voffB); PG8_STAGE(PG8_SA(0, 0), cA, voffA); PG8_STAGE(PG8_SB(0, 1), cB1, voffB); PG8_STAGE(PG8_SA(0, 1), cA + hstep, voffA);
  if (wr == 1) PG8_BAR;
  PG8_WAIT_V(4); PG8_BAR;
  PG8_STAGE(PG8_SB(1, 0), cB0 + kstep, voffB); PG8_STAGE(PG8_SA(1, 0), cA + kstep, voffA); PG8_STAGE(PG8_SB(1, 1), cB1 + kstep, voffB);
  PG8_WAIT_V(6); PG8_BAR;
  for (;;) {
    const bool has_next = S.next(ui + 1, nxt);
    const char* nA = cA; const char* nB0 = cB0; const char* nB1 = cB1;
#pragma unroll
    for (int i = 0; i < 2; ++i) voffBn[i] = voffB[i];
    if (has_next) { int nsh; nA = (const char*)g.A + (size_t)nxt.pm * tstep; nB0 = bbase(nxt, 0, nsh); nB1 = bbase(nxt, 1, nsh);
#pragma unroll
      for (int i = 0; i < 2; ++i) voffBn[i] = (voffBr[i] << nsh) + voffBc[i]; }
    auto kiter = [&](int t) __attribute__((always_inline)) {
      const bool last = (t == nt - 2);
      const char* a1 = cA + (size_t)(t + 1) * kstep;
      const char* a2 = last ? nA : cA + (size_t)(t + 2) * kstep;
      const char* b20 = last ? nB0 : cB0 + (size_t)(t + 2) * kstep; const char* b21 = last ? nB1 : cB1 + (size_t)(t + 2) * kstep;
      const char* a3 = a2 + kstep; const char* b30 = b20 + kstep; const char* b31 = b21 + kstep;
      unsigned vB[2];
#pragma unroll
      for (int i = 0; i < 2; ++i) vB[i] = BPERM ? (last ? voffBn[i] : voffB[i]) : voffB[i];
      PG8_LDB(B0, 0, 0); PG8_SCHED; PG8_LDA(At, 0, 0); PG8_STAGE(PG8_SA(1, 1), a1 + hstep, voffA);
      PG8_WAIT_L(8); PG8_BAR; PG8_WAIT_L(0); PG8_MMA(0, 0, At, B0); PG8_BAR; PG8_SCHED;
      PG8_LDB(B1, 0, 1); PG8_STAGE(PG8_SB(0, 0), b20, vB);
      PG8_BAR; PG8_WAIT_L(0); PG8_MMA(0, 1, At, B1); PG8_BAR;
      PG8_LDA(At, 0, 1); PG8_STAGE(PG8_SA(0, 0), a2, voffA);
      PG8_BAR; PG8_WAIT_L(0); PG8_MMA(1, 0, At, B0); PG8_BAR; PG8_SCHED;
      PG8_STAGE(PG8_SB(0, 1), b21, vB);
      PG8_WAIT_V(6); PG8_BAR; PG8_MMA(1, 1, At, B1); PG8_BAR;
      PG8_LDB(B0, 1, 0); PG8_SCHED; PG8_LDA(At, 1, 0); PG8_STAGE(PG8_SA(0, 1), a2 + hstep, voffA);
      PG8_WAIT_L(8); PG8_BAR; PG8_WAIT_L(0); PG8_MMA(0, 0, At, B0); PG8_BAR; PG8_SCHED;
      PG8_LDB(B1, 1, 1); PG8_STAGE(PG8_SB(1, 0), b30, vB);
      PG8_BAR; PG8_WAIT_L(0); PG8_MMA(0, 1, At, B1); PG8_BAR;
      PG8_LDA(At, 1, 1); PG8_STAGE(PG8_SA(1, 0), a3, voffA);
      PG8_BAR; PG8_WAIT_L(0); PG8_MMA(1, 0, At, B0); PG8_BAR; PG8_SCHED;
      PG8_STAGE(PG8_SB(1, 1), b31, vB);
      PG8_WAIT_V(6); PG8_BAR; PG8_MMA(1, 1, At, B1); PG8_BAR;
    };
    if constexpr (Epi::HOOK) {
#pragma unroll 1
      for (int seg = 0; seg < 3; ++seg) {
        const int tb = seg * 8, te = seg == 2 ? nt : tb + 8;
#pragma unroll 1
        for (int t = tb; t < te; t += 2) kiter(t);
        if (seg < 2) E.hook(acc, cur, te, wr, wc, fr, fq);
      }
    } else {
      for (int t = 0; t < nt; t += 2) kiter(t);
    }
    E(acc, cur, wr, wc, fr, fq);
    if (!has_next) break;
#pragma unroll
    for (int a = 0; a < 2; ++a)
#pragma unroll
      for (int b = 0; b < 2; ++b)
#pragma unroll
        for (int m = 0; m < 4; ++m)
#pragma unroll
          for (int n = 0; n < 2; ++n) acc[a][b][m][n] = (f32x4){0.f, 0.f, 0.f, 0.f};
    cur = nxt; cA = nA; cB0 = nB0; cB1 = nB1; ++ui;
#pragma unroll
    for (int i = 0; i < 2; ++i) voffB[i] = voffBn[i];
  }
  PG8_WAIT_V(0);
  if (wr == 0) PG8_BAR;
  PG8_BAR;
#undef PG8_SA
#undef PG8_SB
#undef PG8_STAGE
#undef PG8_LDA
#undef PG8_LDB
#undef PG8_MMA
#undef PG8_WAIT_V
#undef PG8_WAIT_L
#undef PG8_BAR
#undef PG8_SCHED
}
}
using pg8::Unit;

struct EpiU {
  static constexpr bool HOOK = false;
  bf16_t* U; const float* rinv; const float* bg;
  __device__ __forceinline__ void hook(f32x4 (&)[2][2][4][2], const Unit&, int, int, int, int, int) const {}
  __device__ __forceinline__ void operator()(const f32x4 (&acc)[2][2][4][2], const Unit& u, int wr, int wc, int fr, int fq) const {
    asm volatile("" : "+v"(fr), "+v"(fq));
    const int row0 = u.pm * 256 + wr * 64 + fr, col0 = u.pn * 256 + wc * 32 + 8 * fq;
    const bool isg = (u.pn >= 19);
    float ri[2][4];
#pragma unroll
    for (int ai = 0; ai < 2; ++ai)
#pragma unroll
      for (int m = 0; m < 4; ++m) ri[ai][m] = rinv[row0 + ai * 128 + m * 16];
    if (isg) {
      f32x4 b[2][2];
#pragma unroll
      for (int bj = 0; bj < 2; ++bj) { const float* bp = bg + (col0 - U_GL) + bj * 128; b[bj][0] = *(const f32x4*)bp; b[bj][1] = *(const f32x4*)(bp + 4); }
#pragma unroll
      for (int ai = 0; ai < 2; ++ai)
#pragma unroll
        for (int m = 0; m < 4; ++m)
#pragma unroll
          for (int bj = 0; bj < 2; ++bj) {
            f32x4 v0 = acc[ai][bj][m][0] * ri[ai][m] + b[bj][0], v1 = acc[ai][bj][m][1] * ri[ai][m] + b[bj][1];
#pragma unroll
            for (int j = 0; j < 4; ++j) { v0[j] = 1.0f + fminf(fexp2(-v0[j] * LOG2E), 1e30f); v1[j] = 1.0f + fminf(fexp2(-v1[j] * LOG2E), 1e30f); }
            u32x4 pk = {cvt_pk_bf16(v0[0], v0[1]), cvt_pk_bf16(v0[2], v0[3]), cvt_pk_bf16(v1[0], v1[1]), cvt_pk_bf16(v1[2], v1[3])};
            *(u32x4*)(U + (size_t)(row0 + ai * 128 + m * 16) * UW + col0 + bj * 128) = pk;
          }
    } else {
#pragma unroll
      for (int ai = 0; ai < 2; ++ai)
#pragma unroll
        for (int m = 0; m < 4; ++m)
#pragma unroll
          for (int bj = 0; bj < 2; ++bj) {
            const f32x4 v0 = acc[ai][bj][m][0] * ri[ai][m], v1 = acc[ai][bj][m][1] * ri[ai][m];
            u32x4 pk = {cvt_pk_bf16(v0[0], v0[1]), cvt_pk_bf16(v0[2], v0[3]), cvt_pk_bf16(v1[0], v1[1]), cvt_pk_bf16(v1[2], v1[3])};
            *(u32x4*)(U + (size_t)(row0 + ai * 128 + m * 16) * UW + col0 + bj * 128) = pk;
          }
    }
  }
};

struct EpiVT {
  static constexpr bool HOOK = false;
  bf16_t* VT; const float* rv; int L, lshift;
  __device__ __forceinline__ void hook(f32x4 (&)[2][2][4][2], const Unit&, int, int, int, int, int) const {}
  __device__ __forceinline__ void operator()(const f32x4 (&acc)[2][2][4][2], const Unit& u, int wr, int wc, int fr, int fq) const {
    asm volatile("" : "+v"(fr), "+v"(fq));
    const int vrow0 = u.pm * 256 + wr * 64 + fr, pcol0 = u.pn * 256 + wc * 32 + 8 * fq;
    const int ds = u.pm <= 4 ? 0 : (u.pm == 5 ? 2 : 4);
    const int Mc = L >> ds;
#pragma unroll
    for (int bj = 0; bj < 2; ++bj) {
      const int p0 = pcol0 + bj * 128, seq = p0 >> lshift, pos = p0 & (L - 1);
      const int r = pos / Mc, m0 = pos & (Mc - 1);
      float rinv[8];
#pragma unroll
      for (int j = 0; j < 8; ++j) rinv[j] = rv[(seq << lshift) + ((m0 + j) << ds) + r];
      bf16_t* vb = VT + ((size_t)seq * VW + vrow0) * L + pos;
#pragma unroll
      for (int ai = 0; ai < 2; ++ai)
#pragma unroll
        for (int m = 0; m < 4; ++m) {
          const f32x4 v0 = acc[ai][bj][m][0], v1 = acc[ai][bj][m][1];
          u32x4 pk = {cvt_pk_bf16(v0[0] * rinv[0], v0[1] * rinv[1]), cvt_pk_bf16(v0[2] * rinv[2], v0[3] * rinv[3]),
                      cvt_pk_bf16(v1[0] * rinv[4], v1[1] * rinv[5]), cvt_pk_bf16(v1[2] * rinv[6], v1[3] * rinv[7])};
          *(u32x4*)(vb + (size_t)(ai * 128 + m * 16) * L) = pk;
        }
    }
  }
};

struct EpiMerge {
  static constexpr bool HOOK = true;
  const bf16_t* U; bf16_t* MG;
  __device__ __forceinline__ f32x4 gvec(int i, size_t row, int col) const {
    const u32x2 raw = *(const u32x2*)(U + row * UW + U_GL + i * 1024 + col);
    f32x4 e; e[0] = bf_lo(raw[0]); e[1] = bf_hi(raw[0]); e[2] = bf_lo(raw[1]); e[3] = bf_hi(raw[1]); return e;
  }
  __device__ __forceinline__ void hook(f32x4 (&acc)[2][2][4][2], const Unit& u, int t, int wr, int wc, int fr, int fq) const {
    const int i = (t == 8) ? 0 : 1;
    asm volatile("" : "+v"(fr), "+v"(fq));
    const int row0 = u.pm * 256 + wr * 64 + fr, col0 = u.pn * 256 + wc * 32 + 8 * fq;
#pragma unroll
    for (int ai = 0; ai < 2; ++ai) {
#pragma unroll
      for (int m = 0; m < 4; ++m)
#pragma unroll
        for (int bj = 0; bj < 2; ++bj) {
          const bf16_t* gp = U + (size_t)(row0 + ai * 128 + m * 16) * UW + U_GL + i * 1024 + col0 + bj * 128;
          const u32x4 a = *(const u32x4*)gp, b = *(const u32x4*)(gp + 1024);
#pragma unroll
          for (int n = 0; n < 2; ++n) {
            f32x4 r;
            r[0] = bf_lo(b[2 * n]) * frcp(bf_lo(a[2 * n])); r[1] = bf_hi(b[2 * n]) * frcp(bf_hi(a[2 * n]));
            r[2] = bf_lo(b[2 * n + 1]) * frcp(bf_lo(a[2 * n + 1])); r[3] = bf_hi(b[2 * n + 1]) * frcp(bf_hi(a[2 * n + 1]));
            acc[ai][bj][m][n] *= r;
          }
        }
      __builtin_amdgcn_sched_barrier(0);
    }
  }
  __device__ __forceinline__ void operator()(const f32x4 (&acc)[2][2][4][2], const Unit& u, int wr, int wc, int fr, int fq) const {
    asm volatile("" : "+v"(fr), "+v"(fq));
    const int row0 = u.pm * 256 + wr * 64 + fr, col0 = u.pn * 256 + wc * 32 + 8 * fq;
    u32x4 g2[2][4][2];
#pragma unroll
    for (int ai = 0; ai < 2; ++ai)
#pragma unroll
      for (int m = 0; m < 4; ++m)
#pragma unroll
        for (int bj = 0; bj < 2; ++bj) g2[ai][m][bj] = *(const u32x4*)(U + (size_t)(row0 + ai * 128 + m * 16) * UW + U_GL + 2 * 1024 + col0 + bj * 128);
    __builtin_amdgcn_sched_barrier(0);
#pragma unroll
    for (int ai = 0; ai < 2; ++ai)
#pragma unroll
      for (int m = 0; m < 4; ++m)
#pragma unroll
        for (int bj = 0; bj < 2; ++bj) {
          const size_t row = (size_t)(row0 + ai * 128 + m * 16); const int col = col0 + bj * 128;
          const u32x4 g = g2[ai][m][bj];
          f32x4 v0 = acc[ai][bj][m][0], v1 = acc[ai][bj][m][1];
          v0[0] *= frcp(bf_lo(g[0])); v0[1] *= frcp(bf_hi(g[0])); v0[2] *= frcp(bf_lo(g[1])); v0[3] *= frcp(bf_hi(g[1]));
          v1[0] *= frcp(bf_lo(g[2])); v1[1] *= frcp(bf_hi(g[2])); v1[2] *= frcp(bf_lo(g[3])); v1[3] *= frcp(bf_hi(g[3]));
          u32x4 pk = {cvt_pk_bf16(v0[0], v0[1]), cvt_pk_bf16(v0[2], v0[3]), cvt_pk_bf16(v1[0], v1[1]), cvt_pk_bf16(v1[2], v1[3])};
          *(u32x4*)(MG + row * DM + col) = pk;
        }
  }
};

struct EpiRes {
  static constexpr bool HOOK = false;
  const float* R32; const bf16_t* RB; float* X; bf16_t* XB; float* ssq;
  __device__ __forceinline__ void hook(f32x4 (&)[2][2][4][2], const Unit&, int, int, int, int, int) const {}
  __device__ __forceinline__ void operator()(const f32x4 (&acc)[2][2][4][2], const Unit& u, int wr, int wc, int fr, int fq) const {
    asm volatile("" : "+v"(fr), "+v"(fq));
    const int row0 = u.pm * 256 + wr * 64 + fr, col0 = u.pn * 256 + wc * 32 + 8 * fq;
#pragma unroll
    for (int ai = 0; ai < 2; ++ai) {
      f32x4 r[4][2][2];
      if (R32) {
#pragma unroll
        for (int m = 0; m < 4; ++m)
#pragma unroll
          for (int bj = 0; bj < 2; ++bj) { const float* rp = R32 + (size_t)(row0 + ai * 128 + m * 16) * DM + col0 + bj * 128; r[m][bj][0] = *(const f32x4*)rp; r[m][bj][1] = *(const f32x4*)(rp + 4); }
      } else {
        u32x4 rb[4][2];
#pragma unroll
        for (int m = 0; m < 4; ++m)
#pragma unroll
          for (int bj = 0; bj < 2; ++bj) rb[m][bj] = *(const u32x4*)(RB + (size_t)(row0 + ai * 128 + m * 16) * DM + col0 + bj * 128);
#pragma unroll
        for (int m = 0; m < 4; ++m)
#pragma unroll
          for (int bj = 0; bj < 2; ++bj) {
            r[m][bj][0] = (f32x4){bf_lo(rb[m][bj][0]), bf_hi(rb[m][bj][0]), bf_lo(rb[m][bj][1]), bf_hi(rb[m][bj][1])};
            r[m][bj][1] = (f32x4){bf_lo(rb[m][bj][2]), bf_hi(rb[m][bj][2]), bf_lo(rb[m][bj][3]), bf_hi(rb[m][bj][3])};
          }
      }
      __builtin_amdgcn_sched_barrier(0);
#pragma unroll
      for (int m = 0; m < 4; ++m) {
        const size_t row = (size_t)(row0 + ai * 128 + m * 16);
        float s = 0.f;
#pragma unroll
        for (int bj = 0; bj < 2; ++bj) {
          const int col = col0 + bj * 128;
          const f32x4 v0 = r[m][bj][0] + acc[ai][bj][m][0], v1 = r[m][bj][1] + acc[ai][bj][m][1];
          s += v0[0] * v0[0] + v0[1] * v0[1] + v0[2] * v0[2] + v0[3] * v0[3] + v1[0] * v1[0] + v1[1] * v1[1] + v1[2] * v1[2] + v1[3] * v1[3];
          if (X) { *(f32x4*)(X + row * DM + col) = v0; *(f32x4*)(X + row * DM + col + 4) = v1; }
          else { u32x4 pk = {cvt_pk_bf16(v0[0], v0[1]), cvt_pk_bf16(v0[2], v0[3]), cvt_pk_bf16(v1[0], v1[1]), cvt_pk_bf16(v1[2], v1[3])};
                 *(u32x4*)(XB + row * DM + col) = pk; }
        }
        s += __shfl_xor(s, 16); s += __shfl_xor(s, 32);
        if (fq == 0) ssq[row * 16 + u.pn * 4 + wc] = s;
      }
      __builtin_amdgcn_sched_barrier(0);
    }
  }
};

__device__ __forceinline__ void prep_tile(const float* src, int ldn, int k0, int n0, const float* rscale, float cscale, bf16_t* dst, int ldd, int drow0, int dk0, LAS float* tile) {
  const int tid = opaque_tid(), kk = tid >> 6, nn = tid & 63;
#pragma unroll
  for (int i = 0; i < 8; ++i) {
    const int k = kk * 8 + i;
    float v = src[(size_t)(k0 + k) * ldn + n0 + nn] * cscale;
    if (rscale) v *= rscale[k0 + k];
    tile[k * 65 + nn] = v;
  }
  __syncthreads();
  const int n = tid >> 3, kc = tid & 7;
  float f[8];
#pragma unroll
  for (int j = 0; j < 8; ++j) f[j] = tile[(kc * 8 + j) * 65 + n];
  u32x4 pk = {cvt_pk_bf16(f[0], f[1]), cvt_pk_bf16(f[2], f[3]), cvt_pk_bf16(f[4], f[5]), cvt_pk_bf16(f[6], f[7])};
  *(u32x4*)(dst + (size_t)(drow0 + n) * ldd + dk0 + kc * 8) = pk;
  __syncthreads();
}

__device__ __forceinline__ void win_map(int n0, int& dn0, float& sc) {
  sc = 1.0f;
  if (n0 < 512) { dn0 = U_QA + n0; sc = QSCALE; }
  else if (n0 < 1024) dn0 = U_KA + (n0 - 512);
  else if (n0 < 1536) dn0 = UW + V_A + (n0 - 1024);
  else if (n0 < 2048) dn0 = U_ZA + (n0 - 1536);
  else if (n0 < 2560) { dn0 = U_QB + (n0 - 2048); sc = QSCALE; }
  else if (n0 < 3072) dn0 = U_KB + (n0 - 2560);
  else if (n0 < 3584) dn0 = UW + V_B + (n0 - 3072);
  else if (n0 < 4096) dn0 = U_ZB + (n0 - 3584);
  else if (n0 < 4864) { dn0 = U_QC + (n0 - 4096); sc = QSCALE; }
  else if (n0 < 5632) dn0 = U_KC + (n0 - 4864);
  else if (n0 < 6400) dn0 = UW + V_C + (n0 - 5632);
  else if (n0 < 6656) dn0 = U_ZC + (n0 - 6400);
  else dn0 = U_GL + (n0 - 6656);
}

__device__ void phase_prep(const Params& p, LAS float* tile) {
  constexpr int PER = 3008;
  for (int it = blockIdx.x; it < DEPTH * PER; it += gridDim.x) {
    const int l = it / PER; int r = it % PER;
    if (r < 2432) {
      const int kt = r / 152, ntile = r % 152; int dn0; float sc; win_map(ntile * 64, dn0, sc);
      prep_tile(p.w_in + (size_t)l * DM * INW, INW, kt * 64, ntile * 64, p.g_norm + l * DM, sc, p.wt_in + (size_t)l * INW * DM, DM, dn0, kt * 64, tile);
    } else if ((r -= 2432) < 128) {
      const int kt = r / 16, ntile = r % 16;
      prep_tile(p.w_br_a + (size_t)l * 512 * DM, DM, kt * 64, ntile * 64, nullptr, 1.0f, p.wt_br + (size_t)l * DM * YW, YW, ntile * 64, kt * 64, tile);
    } else if ((r -= 128) < 128) {
      const int kt = r / 16, ntile = r % 16;
      prep_tile(p.w_br_b + (size_t)l * 512 * DM, DM, kt * 64, ntile * 64, nullptr, 1.0f, p.wt_br + (size_t)l * DM * YW, YW, ntile * 64, 512 + kt * 64, tile);
    } else if ((r -= 128) < 64) {
      const int kt = r / 16, ntile = r % 16;
      prep_tile(p.w_br_c + (size_t)l * 256 * DM, DM, kt * 64, ntile * 64, nullptr, 1.0f, p.wt_br + (size_t)l * DM * YW, YW, ntile * 64, 1024 + kt * 64, tile);
    } else {
      r -= 64; const int kt = r / 16, ntile = r % 16;
      prep_tile(p.w_out + (size_t)l * DM * DM, DM, kt * 64, ntile * 64, nullptr, 1.0f, p.wt_out + (size_t)l * DM * DM, DM, ntile * 64, kt * 64, tile);
    }
  }
  const int ptid = opaque_tid();
  if (blockIdx.x == 0 && ptid < 64) {
    const int lane = ptid;
    for (int l = 0; l < DEPTH; ++l) {
      const float* lq = p.lam_qk + l * 256;
      float a = lq[lane] * lq[64 + lane], b = lq[128 + lane] * lq[192 + lane];
      for (int o = 32; o >= 1; o >>= 1) { a += __shfl_xor(a, o); b += __shfl_xor(b, o); }
      if (lane == 0) { const float li = 0.8f - 0.6f * expf(-0.3f * (float)l); p.lam[l] = expf(a) - expf(b) + li; p.lam[4 + l] = 1.0f - li; }
    }
  }
}

__device__ void phase_x(const Params& p, int chunk) {
  const float* xin = (chunk < 2) ? p.xp + (size_t)chunk * TC * DM : p.xs + (size_t)(chunk - 2) * TC * DM;
  float* ssq = p.ssq + (size_t)chunk * TC * 16;
  const int tid = opaque_tid(), lane = tid & 63, w = blockIdx.x * 8 + (tid >> 6), nw = gridDim.x * 8;
  for (int row = w; row < TC; row += nw) {
    const float* xr = xin + (size_t)row * DM + lane * 16;
    f32x4 v[4]; float s = 0.f;
#pragma unroll
    for (int i = 0; i < 4; ++i) { v[i] = *(const f32x4*)(xr + i * 4); s += v[i][0] * v[i][0] + v[i][1] * v[i][1] + v[i][2] * v[i][2] + v[i][3] * v[i][3]; }
    for (int o = 32; o >= 1; o >>= 1) s += __shfl_xor(s, o);
    u32x4 p0 = {cvt_pk_bf16(v[0][0], v[0][1]), cvt_pk_bf16(v[0][2], v[0][3]), cvt_pk_bf16(v[1][0], v[1][1]), cvt_pk_bf16(v[1][2], v[1][3])};
    u32x4 p1 = {cvt_pk_bf16(v[2][0], v[2][1]), cvt_pk_bf16(v[2][2], v[2][3]), cvt_pk_bf16(v[3][0], v[3][1]), cvt_pk_bf16(v[3][2], v[3][3])};
    bf16_t* xo = p.xb + (size_t)row * DM + lane * 16;
    *(u32x4*)xo = p0; *(u32x4*)(xo + 8) = p1;
    if (lane < 16) ssq[(size_t)row * 16 + lane] = (lane == 0) ? s : 0.f;
    if (lane == 0) p.rinv[(size_t)chunk * TC + row] = rsqrtf(s * (1.0f / 1024.0f) + 1e-6f);
  }
}

__device__ void phase_rinv(const Params& p, int chunk) {
  const float* ssq = p.ssq + (size_t)chunk * TC * 16; float* rv = p.rinv + (size_t)chunk * TC;
  for (int row = blockIdx.x * 512 + opaque_tid(); row < TC; row += gridDim.x * 512) {
    const f32x4* sp = (const f32x4*)(ssq + (size_t)row * 16);
    const f32x4 a4 = sp[0] + sp[1] + sp[2] + sp[3];
    rv[row] = rsqrtf((a4[0] + a4[1] + a4[2] + a4[3]) * (1.0f / 1024.0f) + 1e-6f);
  }
}

__device__ void phase_final(const Params& p, int chunk) {
  float* x = p.out + (size_t)chunk * TC * DM;
  const float* ssq = p.ssq + (size_t)chunk * TC * 16;
  const int tid = opaque_tid(), lane = tid & 63, w = blockIdx.x * 8 + (tid >> 6), nw = gridDim.x * 8;
  for (int row = w; row < TC; row += nw) {
    const f32x4* sp = (const f32x4*)(ssq + (size_t)row * 16);
    const f32x4 a4 = sp[0] + sp[1] + sp[2] + sp[3];
    const float rinv = rsqrtf((a4[0] + a4[1] + a4[2] + a4[3]) * (1.0f / 1024.0f) + 1e-6f);
    float* xr = x + (size_t)row * DM + lane * 16;
#pragma unroll
    for (int i = 0; i < 4; ++i) { f32x4 v = *(const f32x4*)(xr + i * 4); const f32x4 g = *(const f32x4*)(p.g_final + lane * 16 + i * 4); v = v * rinv * g; *(f32x4*)(xr + i * 4) = v; }
  }
}

__device__ __forceinline__ f32x16 mfma32(bf16x8 a, bf16x8 b, f32x16 c) { return __builtin_amdgcn_mfma_f32_32x32x16_bf16(a, b, c, 0, 0, 0); }
__device__ __forceinline__ bf16x8 ld16(const bf16_t* p) { return *(const bf16x8*)p; }
__device__ __forceinline__ bf16x8 ld8x2(const bf16_t* p0, const bf16_t* p1) { const bf16x4 a = *(const bf16x4*)p0, b = *(const bf16x4*)p1; return __builtin_shufflevector(a, b, 0, 1, 2, 3, 4, 5, 6, 7); }

__device__ __forceinline__ float xhalf_max(float v) { const auto rr = __builtin_amdgcn_permlane32_swap(__float_as_uint(v), __float_as_uint(v), false, false); return fmaxf(__uint_as_float(rr[0]), __uint_as_float(rr[1])); }
__device__ __forceinline__ float xhalf_sum(float v) { const auto rr = __builtin_amdgcn_permlane32_swap(__float_as_uint(v), __float_as_uint(v), false, false); return __uint_as_float(rr[0]) + __uint_as_float(rr[1]); }
__device__ __forceinline__ void softmax_tile(f32x16& t, float& m, float& l, float& alpha, bf16x8& p0, bf16x8& p1) {
  float tm = t[0];
#pragma unroll
  for (int i = 1; i < 16; ++i) tm = fmaxf(tm, t[i]);
  tm = xhalf_max(tm);
  const float mn = fmaxf(m, tm);
  alpha = fexp2(m - mn); m = mn;
  float ls = 0.f;
#pragma unroll
  for (int i = 0; i < 16; ++i) { t[i] = fexp2(t[i] - mn); ls += t[i]; }
  l = l * alpha + ls;
  const u32x4 a = {cvt_pk_bf16(t[0], t[1]), cvt_pk_bf16(t[2], t[3]), cvt_pk_bf16(t[4], t[5]), cvt_pk_bf16(t[6], t[7])};
  const u32x4 b = {cvt_pk_bf16(t[8], t[9]), cvt_pk_bf16(t[10], t[11]), cvt_pk_bf16(t[12], t[13]), cvt_pk_bf16(t[14], t[15])};
  p0 = __builtin_bit_cast(bf16x8, a); p1 = __builtin_bit_cast(bf16x8, b);
}
__device__ __forceinline__ f32x16 zero16() { f32x16 z;
#pragma unroll
  for (int i = 0; i < 16; ++i) z[i] = 0.f; return z; }
__device__ __forceinline__ float silu(float z) { return z * frcp(1.0f + fexp2(-z * LOG2E)); }

constexpr int TB_ROW = 144;
constexpr int KB_BYTES = 64 * TB_ROW;
constexpr int VB_BYTES = 128 * TB_ROW;
constexpr int LDS_K = 0, LDS_V = LDS_K + 2 * KB_BYTES, LDS_ATT_END = LDS_V + 2 * VB_BYTES, LDS_ATT_TOTAL = LDS_ATT_END + 65536;
template <int SIDE>
__device__ __forceinline__ void b_far_subtile(const LAS unsigned char* kb, const LAS unsigned char* vb, int rd, int sub, const bf16x8 (&qf)[4], const f32x16& bp, float slope2, float d0,
                                              float& mrun, float& lrun, f32x16 (&o)[4]) {
  const float base = (SIDE > 0 ? -slope2 : slope2) * d0 - mrun;
  f32x16 sc;
#pragma unroll
  for (int i = 0; i < 16; ++i) sc[i] = SIDE > 0 ? base - bp[i] : base + bp[i];
#pragma unroll
  for (int ks = 0; ks < 4; ++ks) sc = mfma32(*(const LAS bf16x8*)(kb + rd + sub * 32 * TB_ROW + ks * 32), qf[ks], sc);
  float tm = sc[0];
#pragma unroll
  for (int i = 1; i < 16; ++i) tm = fmaxf(tm, sc[i]);
  tm = xhalf_max(tm);
  if (__builtin_amdgcn_ballot_w64(tm > 0.0f) != 0) {
    const float delta = fmaxf(tm, 0.0f);
    const float al = fexp2(-delta);
    mrun += delta; lrun *= al;
#pragma unroll
    for (int i = 0; i < 16; ++i) sc[i] -= delta;
#pragma unroll
    for (int dt = 0; dt < 4; ++dt) o[dt] *= al;
  }
#pragma unroll
  for (int i = 0; i < 16; ++i) sc[i] = fexp2(sc[i]);
  { const f32x4 a4 = (f32x4){sc[0], sc[1], sc[2], sc[3]} + (f32x4){sc[4], sc[5], sc[6], sc[7]} + (f32x4){sc[8], sc[9], sc[10], sc[11]} + (f32x4){sc[12], sc[13], sc[14], sc[15]};
    lrun += (a4[0] + a4[1]) + (a4[2] + a4[3]); }
  const u32x4 pa = {cvt_pk_bf16(sc[0], sc[1]), cvt_pk_bf16(sc[2], sc[3]), cvt_pk_bf16(sc[4], sc[5]), cvt_pk_bf16(sc[6], sc[7])};
  const u32x4 pb = {cvt_pk_bf16(sc[8], sc[9]), cvt_pk_bf16(sc[10], sc[11]), cvt_pk_bf16(sc[12], sc[13]), cvt_pk_bf16(sc[14], sc[15])};
  const bf16x8 pk0 = __builtin_bit_cast(bf16x8, pa), pk1 = __builtin_bit_cast(bf16x8, pb);
#pragma unroll
  for (int dt = 0; dt < 4; ++dt) {
    o[dt] = mfma32(*(const LAS bf16x8*)(vb + rd + dt * 32 * TB_ROW + (sub * 2) * 32), pk0, o[dt]);
    o[dt] = mfma32(*(const LAS bf16x8*)(vb + rd + dt * 32 * TB_ROW + (sub * 2 + 1) * 32), pk1, o[dt]);
  }
}

__device__ __forceinline__ void attn_b_pass(const Params& p, int L, int seq, int h, int mp, int qblk, int tq, int tid, float slope2, LAS unsigned char* lds, f32x16 (&o)[4], float& linv) {
  const int lane = tid & 63, q = lane & 31, half = lane >> 5;
  const size_t tokbase = (size_t)seq * L;
  bf16x8 qf[4];
  { const bf16_t* qp = p.u + (tokbase + tq) * UW + U_QB + h * 128 + mp * 64 + half * 8;
#pragma unroll
    for (int ks = 0; ks < 4; ++ks) qf[ks] = ld16(qp + ks * 16); }
  const int spart = tid & 7, srow = tid >> 3;
  const bf16_t* kg = p.u + (tokbase + srow) * UW + U_KB + h * 128 + mp * 64 + spart * 8;
  const bf16_t* vg = p.vt + ((size_t)seq * VW + V_B + h * 128 + srow) * L + spart * 8;
  const int kst = srow * TB_ROW + spart * 16;
  const int vst = srow * TB_ROW + ((spart >> 1) * 16 + (spart & 1) * 4) * 2;
  const int rd = q * TB_ROW + half * 16;
#pragma unroll
  for (int dt = 0; dt < 4; ++dt) o[dt] = zero16();
  float mrun = -1e30f, lrun = 0.f;
  f32x16 bp;
#pragma unroll
  for (int i = 0; i < 16; ++i) bp[i] = slope2 * (float)((i >> 2) * 8 + (i & 3));
  const int ntile = L >> 6, t0 = qblk * 4, nR = ntile - t0;
  auto tile_of = [&](int idx) { return idx < nR ? t0 + idx : (t0 - 1) - (idx - nR); };
  bf16x8 krA, vrA0, vrA1, krB, vrB0, vrB1;
  auto gload = [&](int idx, bf16x8& kr, bf16x8& v0, bf16x8& v1) { const int kn = tile_of(idx) * 64; kr = ld16(kg + (size_t)kn * UW); v0 = ld16(vg + kn); v1 = ld16(vg + (size_t)64 * L + kn); };
  auto lwrite = [&](int buf, const bf16x8& kr, const bf16x8& v0, const bf16x8& v1) {
    LAS unsigned char* kb = lds + LDS_K + buf * KB_BYTES; LAS unsigned char* vb = lds + LDS_V + buf * VB_BYTES;
    *(LAS bf16x8*)(kb + kst) = kr;
    *(LAS bf16x4*)(vb + vst) = __builtin_shufflevector(v0, v0, 0, 1, 2, 3); *(LAS bf16x4*)(vb + vst + 16) = __builtin_shufflevector(v0, v0, 4, 5, 6, 7);
    *(LAS bf16x4*)(vb + vst + 64 * TB_ROW) = __builtin_shufflevector(v1, v1, 0, 1, 2, 3); *(LAS bf16x4*)(vb + vst + 64 * TB_ROW + 16) = __builtin_shufflevector(v1, v1, 4, 5, 6, 7);
  };
  auto compute = [&](int idx, int buf) {
    const int k0 = tile_of(idx) * 64;
    const LAS unsigned char* kb = lds + LDS_K + buf * KB_BYTES;
    const LAS unsigned char* vb = lds + LDS_V + buf * VB_BYTES;
    if (idx < 4) {
#pragma unroll
      for (int sub = 0; sub < 2; ++sub) {
        f32x16 sc = zero16();
#pragma unroll
        for (int ks = 0; ks < 4; ++ks) sc = mfma32(*(const LAS bf16x8*)(kb + rd + sub * 32 * TB_ROW + ks * 32), qf[ks], sc);
        const float d0 = (float)(k0 + sub * 32 + half * 4 - tq);
#pragma unroll
        for (int i = 0; i < 16; ++i) sc[i] -= slope2 * fabsf(d0 + (float)((i >> 2) * 8 + (i & 3)));
        float al; bf16x8 pk[2];
        softmax_tile(sc, mrun, lrun, al, pk[0], pk[1]);
        if (__builtin_amdgcn_ballot_w64(al != 1.0f) != 0) {
#pragma unroll
          for (int dt = 0; dt < 4; ++dt) o[dt] *= al;
        }
#pragma unroll
        for (int dt = 0; dt < 4; ++dt)
#pragma unroll
          for (int s2 = 0; s2 < 2; ++s2) o[dt] = mfma32(*(const LAS bf16x8*)(vb + rd + dt * 32 * TB_ROW + (sub * 2 + s2) * 32), pk[s2], o[dt]);
      }
    } else if (idx < nR) {
#pragma unroll
      for (int sub = 0; sub < 2; ++sub) b_far_subtile<1>(kb, vb, rd, sub, qf, bp, slope2, (float)(k0 + sub * 32 + half * 4 - tq), mrun, lrun, o);
    } else {
#pragma unroll
      for (int sub = 0; sub < 2; ++sub) b_far_subtile<-1>(kb, vb, rd, sub, qf, bp, slope2, (float)(k0 + sub * 32 + half * 4 - tq), mrun, lrun, o);
    }
  };
  gload(0, krA, vrA0, vrA1);
  gload(1, krB, vrB0, vrB1);
  lwrite(0, krA, vrA0, vrA1);
  asm volatile("" : "+v"(qf[0]), "+v"(qf[1]), "+v"(qf[2]), "+v"(qf[3]));
  asm volatile("" : "+v"(krB), "+v"(vrB0), "+v"(vrB1));
  __syncthreads();
#pragma unroll 1
  for (int idx = 0; idx < ntile; idx += 2) {
    if (idx + 2 < ntile) gload(idx + 2, krA, vrA0, vrA1);
    compute(idx, 0);
    lwrite(1, krB, vrB0, vrB1);
    __syncthreads();
    if (idx + 3 < ntile) gload(idx + 3, krB, vrB0, vrB1);
    compute(idx + 1, 1);
    if (idx + 2 < ntile) lwrite(0, krA, vrA0, vrA1);
    __syncthreads();
  }
  linv = frcp(xhalf_sum(lrun));
}
__device__ void attn_b_block(const Params& p, int layer, int L, int seq, int h, int qblk, LAS unsigned char* lds) {
  const int tid = opaque_tid(), lane = tid & 63, wid = __builtin_amdgcn_readfirstlane(tid >> 6);
  const int q = lane & 31, half = lane >> 5;
  const size_t tokbase = (size_t)seq * L;
  const int tq = qblk * 256 + wid * 32 + q;
  const float slope2 = exp2f(-2.0f * (float)(h + 1)) * LOG2E;
  f32x16 o0[4]; float li0, li1;
  LAS u32x4* park = (LAS u32x4*)(lds + LDS_ATT_END) + wid * 512 + lane;
  attn_b_pass(p, L, seq, h, 0, qblk, tq, tid, slope2, lds, o0, li0);
#pragma unroll
  for (int dt = 0; dt < 4; ++dt)
#pragma unroll
    for (int g2 = 0; g2 < 2; ++g2) {
      u32x4 pk;
#pragma unroll
      for (int k = 0; k < 4; ++k) pk[k] = cvt_pk_bf16(o0[dt][g2 * 8 + 2 * k] * li0, o0[dt][g2 * 8 + 2 * k + 1] * li0);
      park[(dt * 2 + g2) * 64] = pk;
    }
  attn_b_pass(p, L, seq, h, 1, qblk, tq, tid, slope2, lds, o0, li1);
  const float c1 = p.lam[layer] * li1;
  const int tid2 = opaque_tid(), half2 = (tid2 >> 5) & 1;
  const size_t tok2 = (size_t)seq * L + qblk * 256 + (tid2 >> 6) * 32 + (tid2 & 31);
  float ss = 0.f;
#pragma unroll
  for (int dt = 0; dt < 4; ++dt)
#pragma unroll
    for (int g2 = 0; g2 < 2; ++g2) {
      const u32x4 pk = park[(dt * 2 + g2) * 64];
#pragma unroll
      for (int k = 0; k < 4; ++k) {
        const float va = bf_lo(pk[k]) - o0[dt][g2 * 8 + 2 * k] * c1, vb = bf_hi(pk[k]) - o0[dt][g2 * 8 + 2 * k + 1] * c1;
        o0[dt][g2 * 8 + 2 * k] = va; o0[dt][g2 * 8 + 2 * k + 1] = vb; ss += va * va + vb * vb;
      }
    }
  ss = xhalf_sum(ss);
  const float rn = rsqrtf(ss * (1.0f / 128.0f) + 1e-6f) * p.lam[4 + layer];
  const float* gd = p.g_diff + layer * 128;
  bf16_t* yrow = p.yg + tok2 * YW + 512 + h * 128;
  const bf16_t* zrow = p.u + tok2 * UW + U_ZB + h * 128;
#pragma unroll
  for (int dt = 0; dt < 4; ++dt)
#pragma unroll
    for (int g4 = 0; g4 < 4; ++g4) {
      const int dim = dt * 32 + g4 * 8 + half2 * 4;
      const u32x2 zr = *(const u32x2*)(zrow + dim);
      const f32x4 gv = *(const f32x4*)(gd + dim);
      const float y0 = o0[dt][g4 * 4 + 0] * rn * gv[0] * silu(bf_lo(zr[0]));
      const float y1 = o0[dt][g4 * 4 + 1] * rn * gv[1] * silu(bf_hi(zr[0]));
      const float y2 = o0[dt][g4 * 4 + 2] * rn * gv[2] * silu(bf_lo(zr[1]));
      const float y3 = o0[dt][g4 * 4 + 3] * rn * gv[3] * silu(bf_hi(zr[1]));
      u32x2 pk = {cvt_pk_bf16(y0, y1), cvt_pk_bf16(y2, y3)};
      *(u32x2*)(yrow + dim) = pk;
    }
}

constexpr int LDS_AK = 0, LDS_AV = LDS_AK + 2 * KB_BYTES, LDS_ATAB = LDS_AV + 2 * KB_BYTES, ATAB_ROW = 128;
__device__ void attn_a_block(const Params& p, int layer, int L, int seq, int h, int r0, LAS unsigned char* lds) {
  const int tid = opaque_tid(), lane = tid & 63, wid = __builtin_amdgcn_readfirstlane(tid >> 6);
  const int q = lane & 31, half = lane >> 5;
  const size_t tokbase = (size_t)seq * L;
  const int rows = L >> 6;
  const int ra = r0 + (wid >> 2) * 2, c0 = (wid & 3) * 16;
  int kstart = c0 - 8; kstart = kstart < 0 ? 0 : (kstart > 32 ? 32 : kstart);
  const int qrow = ra + (q >> 4), qcol = c0 + (q & 15), tq = qrow * 64 + qcol;
  int rsq = qrow - 4; rsq = rsq < 0 ? 0 : (rsq > rows - 8 ? rows - 8 : rsq);
  int rsa = ra - 4; rsa = rsa < 0 ? 0 : (rsa > rows - 8 ? rows - 8 : rsa);
  int rsb = ra - 3; rsb = rsb < 0 ? 0 : (rsb > rows - 8 ? rows - 8 : rsb);
  int kr_lo = r0 - 4; kr_lo = kr_lo < 0 ? 0 : (kr_lo > rows - 8 ? rows - 8 : kr_lo);
  int kr_hi = r0 - 1; kr_hi = (kr_hi < 0 ? 0 : (kr_hi > rows - 8 ? rows - 8 : kr_hi)) + 7;
  int qstart = qcol - 8; qstart = qstart < 0 ? 0 : (qstart > 48 ? 48 : qstart);
  bf16x8 qf[4];
  { const bf16_t* qp = p.u + (tokbase + tq) * UW + U_QA + h * 64 + half * 8;
#pragma unroll
    for (int ks = 0; ks < 4; ++ks) qf[ks] = ld16(qp + ks * 16); }
  {
    LAS float* tab = (LAS float*)(lds + LDS_ATAB);
    const float* rpb = p.rpb + ((size_t)layer * 8 + h) * 15 * 31;
    for (int idx = tid; idx < 15 * ATAB_ROW; idx += 512) { const int row = idx >> 7, cc = (idx & 127) - 48; tab[idx] = (cc >= 0 && cc <= 30) ? rpb[row * 31 + cc] * LOG2E : 0.f; }
  }
  const int spart = tid & 7, srow = tid >> 3;
  const bf16_t* kg = p.u + (tokbase + srow) * UW + U_KA + h * 64 + spart * 8;
  const bf16_t* vg = p.vt + ((size_t)seq * VW + V_A + h * 64 + srow) * L + spart * 8;
  const int kst = srow * TB_ROW + spart * 16;
  const int vst = srow * TB_ROW + spart * 16;
  const int krd = (kstart + q) * TB_ROW + half * 16;
  const int vrd = q * TB_ROW + (kstart + half * 4) * 2;
  f32x16 o[2] = {zero16(), zero16()};
  float mrun = -1e30f, lrun = 0.f;
  bf16x8 kr_, vr_;
  kr_ = ld16(kg + (size_t)(kr_lo * 64) * UW); vr_ = ld16(vg + kr_lo * 64);
  *(LAS bf16x8*)(lds + LDS_AK + kst) = kr_;
  *(LAS bf16x8*)(lds + LDS_AV + vst) = vr_;
  asm volatile("" : "+v"(qf[0]), "+v"(qf[1]), "+v"(qf[2]), "+v"(qf[3]));
  __syncthreads();
#pragma unroll 1
  for (int kr = kr_lo; kr <= kr_hi; ++kr) {
    const int it = kr - kr_lo;
    const bool more = (kr < kr_hi);
    if (more) { kr_ = ld16(kg + (size_t)((kr + 1) * 64) * UW); vr_ = ld16(vg + (kr + 1) * 64); }
    const LAS unsigned char* kb = lds + LDS_AK + (it & 1) * KB_BYTES;
    const LAS unsigned char* vb = lds + LDS_AV + (it & 1) * KB_BYTES;
    if (kr >= rsa && kr < rsb + 8) {
      const bool rowok = (kr >= rsq) && (kr < rsq + 8);
      int trow_i = kr - qrow + 7; trow_i = trow_i < 0 ? 0 : (trow_i > 14 ? 14 : trow_i);
      const LAS float* trow = (const LAS float*)(lds + LDS_ATAB) + trow_i * ATAB_ROW + (kstart + half * 4 - qcol + 15 + 48);
      f32x16 sc = zero16();
#pragma unroll
      for (int ks = 0; ks < 4; ++ks) sc = mfma32(*(const LAS bf16x8*)(kb + krd + ks * 32), qf[ks], sc);
#pragma unroll
      for (int ii = 0; ii < 16; ++ii) {
        const int kcol = kstart + (ii >> 2) * 8 + half * 4 + (ii & 3);
        const bool ok = rowok && (kcol >= qstart) && (kcol < qstart + 16);
        sc[ii] = ok ? sc[ii] + trow[(ii >> 2) * 8 + (ii & 3)] : -INFINITY;
      }
      float al; bf16x8 pk[2];
      softmax_tile(sc, mrun, lrun, al, pk[0], pk[1]);
      if (__builtin_amdgcn_ballot_w64(al != 1.0f) != 0) { o[0] *= al; o[1] *= al; }
#pragma unroll
      for (int dt = 0; dt < 2; ++dt)
#pragma unroll
        for (int s2 = 0; s2 < 2; ++s2) {
          const LAS unsigned char* vp = vb + vrd + dt * 32 * TB_ROW + s2 * 32;
          const bf16x4 va = *(const LAS bf16x4*)vp, vc = *(const LAS bf16x4*)(vp + 16);
          o[dt] = mfma32(__builtin_shufflevector(va, vc, 0, 1, 2, 3, 4, 5, 6, 7), pk[s2], o[dt]);
        }
    }
    if (more) {
      *(LAS bf16x8*)(lds + LDS_AK + ((it + 1) & 1) * KB_BYTES + kst) = kr_;
      *(LAS bf16x8*)(lds + LDS_AV + ((it + 1) & 1) * KB_BYTES + vst) = vr_;
    }
    __syncthreads();
  }
  const float c = frcp(xhalf_sum(lrun));
  bf16_t* yrow = p.yg + (tokbase + tq) * YW + h * 64;
  const bf16_t* zrow = p.u + (tokbase + tq) * UW + U_ZA + h * 64;
#pragma unroll
  for (int dt = 0; dt < 2; ++dt)
#pragma unroll
    for (int g4 = 0; g4 < 4; ++g4) {
      const int dim = dt * 32 + g4 * 8 + half * 4;
      const u32x2 zr = *(const u32x2*)(zrow + dim);
      const float y0 = o[dt][g4 * 4 + 0] * c * silu(bf_lo(zr[0]));
      const float y1 = o[dt][g4 * 4 + 1] * c * silu(bf_hi(zr[0]));
      const float y2 = o[dt][g4 * 4 + 2] * c * silu(bf_lo(zr[1]));
      const float y3 = o[dt][g4 * 4 + 3] * c * silu(bf_hi(zr[1]));
      u32x2 pk = {cvt_pk_bf16(y0, y1), cvt_pk_bf16(y2, y3)};
      *(u32x2*)(yrow + dim) = pk;
    }
}

__device__ void attn_c_unit(const Params& p, int L, int lshift, int seq, int g, int h, int rr, int mblk, int lane) {
  const int q = lane & 31, half = lane >> 5;
  const size_t tokbase = (size_t)seq * L;
  const int ds = (g == 0) ? 0 : (g == 1 ? 2 : 4), d = 1 << ds, M = L >> ds;
  const int hh = g * 4 + h;
  const int m0 = mblk * 32, mq = m0 + q, tq = mq * d + rr;
  const bf16_t* urow = p.u + (tokbase + tq) * UW;
  bf16x8 qf[4];
#pragma unroll
  for (int ks = 0; ks < 4; ++ks) qf[ks] = ld16(urow + U_QC + hh * 64 + ks * 16 + half * 8);
  f32x16 o[2] = {zero16(), zero16()};
  float mrun = -1e30f, lrun = 0.f;
  const float coef = exp2f(-(2.0f / 3.0f) * (float)(hh + 1)) * (float)d * LOG2E;
  const bf16_t* vbase = p.vt + ((size_t)seq * VW + V_C + hh * 64 + q) * L + (size_t)rr * M;
  bf16x8 kf[5][4];
#pragma unroll
  for (int j = 0; j < 5; ++j) {
    int mkl = m0 - 64 + 32 * j + q; mkl = mkl < 0 ? 0 : (mkl > M - 1 ? M - 1 : mkl);
    const bf16_t* kp = p.u + (tokbase + (size_t)mkl * d + rr) * UW + U_KC + hh * 64 + half * 8;
#pragma unroll
    for (int ks = 0; ks < 4; ++ks) kf[j][ks] = ld16(kp + ks * 16);
  }
  bf16x8 vf[2][2][2];
  auto load_v = [&](int j, bf16x8 (&dst)[2][2]) {
#pragma unroll
    for (int dt = 0; dt < 2; ++dt)
#pragma unroll
      for (int s2 = 0; s2 < 2; ++s2) {
        int pa = m0 - 64 + 32 * j + s2 * 16 + half * 4, pb = pa + 8;
        pa = pa < 0 ? 0 : (pa > M - 4 ? M - 4 : pa); pb = pb < 0 ? 0 : (pb > M - 4 ? M - 4 : pb);
        const bf16_t* vp = vbase + (size_t)(dt * 32) * L;
        dst[dt][s2] = ld8x2(vp + pa, vp + pb);
      }
  };
  load_v(0, vf[0]);
#pragma unroll
  for (int j = 0; j < 5; ++j) {
    if (j + 1 < 5) load_v(j + 1, vf[(j + 1) & 1]);
    const int mk0 = m0 - 64 + 32 * j;
    if (mk0 + 32 <= 0 || mk0 >= M) continue;
    f32x16 s = zero16();
#pragma unroll
    for (int ks = 0; ks < 4; ++ks) s = mfma32(kf[j][ks], qf[ks], s);
#pragma unroll
    for (int ii = 0; ii < 16; ++ii) {
      const int mk = mk0 + (ii >> 2) * 8 + half * 4 + (ii & 3);
      const int rel = mk - mq; const int ar = rel < 0 ? -rel : rel;
      const bool ok = (mk >= 0) && (mk < M) && (ar <= 64);
      s[ii] = ok ? s[ii] - coef * (float)ar : -INFINITY;
    }
    float alpha; bf16x8 pk[2];
    softmax_tile(s, mrun, lrun, alpha, pk[0], pk[1]);
#pragma unroll
    for (int dt = 0; dt < 2; ++dt) {
      o[dt] *= alpha;
#pragma unroll
      for (int s2 = 0; s2 < 2; ++s2) o[dt] = mfma32(vf[j & 1][dt][s2], pk[s2], o[dt]);
    }
  }
  const float lt = xhalf_sum(lrun);
  const float c = frcp(lt);
  bf16_t* orow = p.oc + (tokbase + tq) * 768 + hh * 64;
#pragma unroll
  for (int dt = 0; dt < 2; ++dt)
#pragma unroll
    for (int g4 = 0; g4 < 4; ++g4) {
      const int dim = dt * 32 + g4 * 8 + half * 4;
      u32x2 pk = {cvt_pk_bf16(o[dt][g4 * 4 + 0] * c, o[dt][g4 * 4 + 1] * c), cvt_pk_bf16(o[dt][g4 * 4 + 2] * c, o[dt][g4 * 4 + 3] * c)};
      *(u32x2*)(orow + dim) = pk;
    }
  if (half == 0) p.lse[(tokbase + tq) * 12 + hh] = mrun + log2f(lt);
}

constexpr int CV_ROW = 784;
constexpr int LDS_CK = 0, LDS_CV = 384 * TB_ROW;
__device__ void attn_c_block(const Params& p, int L, int lshift, int seq, int g, int h, int pblk, LAS unsigned char* lds) {
  const int tid = opaque_tid(), lane = tid & 63, wid = __builtin_amdgcn_readfirstlane(tid >> 6);
  const int q = lane & 31, half = lane >> 5;
  const size_t tokbase = (size_t)seq * L;
  const int ds = (g == 0) ? 0 : (g == 1 ? 2 : 4), d = 1 << ds, M = L >> ds;
  const int hh = g * 4 + h;
  const int p0 = pblk * 256;
  {
    const int part = tid & 7;
#pragma unroll
    for (int c = 0; c < 6; ++c) {
      const int row = (tid >> 3) + c * 64;
      int pp = p0 - 64 + row; pp = pp < 0 ? 0 : (pp > L - 1 ? L - 1 : pp);
      const int tok = ((pp & (M - 1)) << ds) + (pp >> (lshift - ds));
      const bf16x8 v = ld16(p.u + (tokbase + tok) * UW + U_KC + hh * 64 + part * 8);
      *(LAS bf16x8*)(lds + LDS_CK + row * TB_ROW + part * 16) = v;
    }
#pragma unroll
    for (int c = 0; c < 6; ++c) {
      const int idx = tid + c * 512, dim = idx / 48, c8 = idx % 48;
      int pp = p0 - 64 + c8 * 8; pp = pp < 0 ? 0 : (pp > L - 8 ? L - 8 : pp);
      const bf16x8 v = ld16(p.vt + ((size_t)seq * VW + V_C + hh * 64 + dim) * L + pp);
      LAS unsigned char* dst = lds + LDS_CV + dim * CV_ROW + ((c8 >> 1) * 16 + (c8 & 1) * 4) * 2;
      *(LAS bf16x4*)dst = __builtin_shufflevector(v, v, 0, 1, 2, 3); *(LAS bf16x4*)(dst + 16) = __builtin_shufflevector(v, v, 4, 5, 6, 7);
    }
  }
  const int pw = p0 + wid * 32;
  const int rr = pw >> (lshift - ds), m0 = pw & (M - 1), mq = m0 + q, tq = mq * d + rr;
  bf16x8 qf[4];
  { const bf16_t* qp = p.u + (tokbase + tq) * UW + U_QC + hh * 64 + half * 8;
#pragma unroll
    for (int ks = 0; ks < 4; ++ks) qf[ks] = ld16(qp + ks * 16); }
  f32x16 o[2] = {zero16(), zero16()};
  float mrun = -1e30f, lrun = 0.f;
  const float coef = exp2f(-(2.0f / 3.0f) * (float)(hh + 1)) * (float)d * LOG2E;
  __syncthreads();
#pragma unroll
  for (int j = 0; j < 5; ++j) {
    const int mk0 = m0 - 64 + 32 * j;
    if (mk0 + 32 <= 0 || mk0 >= M) continue;
    const LAS unsigned char* kb = lds + LDS_CK + ((wid + j) * 32 + q) * TB_ROW + half * 16;
    f32x16 sc = zero16();
#pragma unroll
    for (int ks = 0; ks < 4; ++ks) sc = mfma32(*(const LAS bf16x8*)(kb + ks * 32), qf[ks], sc);
#pragma unroll
    for (int ii = 0; ii < 16; ++ii) {
      const int mk = mk0 + (ii >> 2) * 8 + half * 4 + (ii & 3);
      const int rel = mk - mq; const int ar = rel < 0 ? -rel : rel;
      const bool ok = (mk >= 0) && (mk < M) && (ar <= 64);
      sc[ii] = ok ? sc[ii] - coef * (float)ar : -INFINITY;
    }
    float alpha; bf16x8 pk[2];
    softmax_tile(sc, mrun, lrun, alpha, pk[0], pk[1]);
#pragma unroll
    for (int dt = 0; dt < 2; ++dt) {
      o[dt] *= alpha;
#pragma unroll
      for (int s2 = 0; s2 < 2; ++s2)
        o[dt] = mfma32(*(const LAS bf16x8*)(lds + LDS_CV + (dt * 32 + q) * CV_ROW + ((wid + j) * 32 + s2 * 16) * 2 + half * 16), pk[s2], o[dt]);
    }
  }
  __syncthreads();
  const float lt = xhalf_sum(lrun);
  const float c = frcp(lt);
  bf16_t* orow = p.oc + (tokbase + tq) * 768 + hh * 64;
#pragma unroll
  for (int dt = 0; dt < 2; ++dt)
#pragma unroll
    for (int g4 = 0; g4 < 4; ++g4) {
      const int dim = dt * 32 + g4 * 8 + half * 4;
      u32x2 pk = {cvt_pk_bf16(o[dt][g4 * 4 + 0] * c, o[dt][g4 * 4 + 1] * c), cvt_pk_bf16(o[dt][g4 * 4 + 2] * c, o[dt][g4 * 4 + 3] * c)};
      *(u32x2*)(orow + dim) = pk;
    }
  if (half == 0) p.lse[(tokbase + tq) * 12 + hh] = mrun + log2f(lt);
}

__device__ void phase_attn(const Params& p, int layer, int L, int lshift, LAS unsigned char* lds) {
  const int tiles = L >> 5;
  const int nseq = TC >> lshift;
  const int nw = gridDim.x * 8;
  int w, lane;
  { const int qblks = L >> 8, npairs = nseq * 4, nunits = npairs * qblks;
    for (int b = blockIdx.x; b < nunits; b += gridDim.x) {
      int pair, qblk;
      if ((gridDim.x & 7) == 0 && (npairs & 7) == 0 && nunits == (int)gridDim.x) { const int xcd = b & 7, j = b >> 3; pair = xcd * (npairs >> 3) + j / qblks; qblk = j % qblks; }
      else { pair = b / qblks; qblk = b % qblks; }
      attn_b_block(p, layer, L, pair >> 2, pair & 3, qblk, lds);
    }
  }
  { const int tid = opaque_tid(); lane = tid & 63; w = blockIdx.x * 8 + __builtin_amdgcn_readfirstlane(tid >> 6); }
  {
  { const int rgs = L >> 8, nunits = nseq * 8 * rgs;
    for (int b = blockIdx.x; b < nunits; b += gridDim.x) { const int sh = b / rgs, rg = b % rgs; attn_a_block(p, layer, L, sh >> 3, sh & 7, rg * 4, lds); }
  }
  { const int tid = opaque_tid(); lane = tid & 63; w = blockIdx.x * 8 + __builtin_amdgcn_readfirstlane(tid >> 6); }
  { const int pbs = L >> 8, nunits = nseq * 12 * pbs;
    for (int b = blockIdx.x; b < nunits; b += gridDim.x) {
      const int pblk = b % pbs, sgh = b / pbs;
      const int seq = sgh / 12, gh = sgh % 12;
      attn_c_block(p, L, lshift, seq, gh >> 2, gh & 3, pblk, lds);
    }
  }
  }
}

__device__ void phase_combine(const Params& p) {
  const int gt = blockIdx.x * 512 + opaque_tid(), ngt = gridDim.x * 512;
  for (int it = gt; it < TC * 32; it += ngt) {
    const int tok = it >> 5, sub = it & 31, h = sub >> 3, d8 = (sub & 7) * 8;
    const float* ls = p.lse + (size_t)tok * 12;
    const float l0 = ls[h], l1 = ls[4 + h], l2 = ls[8 + h];
    const float mx = fmaxf(l0, fmaxf(l1, l2));
    const float w0 = fexp2(l0 - mx), w1 = fexp2(l1 - mx), w2 = fexp2(l2 - mx);
    const float inv = frcp(w0 + w1 + w2);
    const bf16_t* ob = p.oc + (size_t)tok * 768 + h * 64 + d8;
    const u32x4 a = *(const u32x4*)ob, b = *(const u32x4*)(ob + 256), c = *(const u32x4*)(ob + 512);
    const u32x4 z = *(const u32x4*)(p.u + (size_t)tok * UW + U_ZC + h * 64 + d8);
    u32x4 r;
#pragma unroll
    for (int k = 0; k < 4; ++k) {
      const float vlo = (w0 * bf_lo(a[k]) + w1 * bf_lo(b[k]) + w2 * bf_lo(c[k])) * inv * silu(bf_lo(z[k]));
      const float vhi = (w0 * bf_hi(a[k]) + w1 * bf_hi(b[k]) + w2 * bf_hi(c[k])) * inv * silu(bf_hi(z[k]));
      r[k] = cvt_pk_bf16(vlo, vhi);
    }
    *(u32x4*)(p.yg + (size_t)tok * YW + 1024 + h * 64 + d8) = r;
  }
}


#define XB_TMO      128
#define XB_XCNT(j)  (256  + 64 * (j))
#define XB_XSUB(j)  (1280 + 64 * (j))
#define XB_XGEN(j)  (2304 + 64 * (j))
#define XB_TOP      3328
#define XB_TOPGEN   3392
#define XCD_BAR_WORDS 3456
#define XB_SPIN_CAP (1u << 18)
__device__ __forceinline__ unsigned xb_ld(unsigned* p)              { return __hip_atomic_load(p, __ATOMIC_RELAXED, __HIP_MEMORY_SCOPE_AGENT); }
__device__ __forceinline__ unsigned xb_add(unsigned* p, unsigned v) { return __hip_atomic_fetch_add(p, v, __ATOMIC_RELAXED, __HIP_MEMORY_SCOPE_AGENT); }
__device__ __forceinline__ unsigned xb_xcc_id() { return (unsigned)__builtin_amdgcn_s_getreg((3 << 11) | 20) & 0xFu; }
#define XB_SPIN(cond, bar) do { unsigned _sp = 0; while (cond) { __builtin_amdgcn_s_sleep(1); \
    if ((++_sp & 255u) == 0u) { if (xb_ld(&(bar)[XB_TMO])) break; if (_sp > XB_SPIN_CAP) { atomicAdd(&(bar)[XB_TMO], 1u); break; } } } } while (0)
struct XcdBarrier { unsigned* bar; unsigned x; volatile LAS unsigned* st; };
__device__ __forceinline__ XcdBarrier xcd_barrier_post(unsigned* bar, volatile LAS unsigned* st) {
  XcdBarrier b; b.bar = bar; b.x = xb_xcc_id(); b.st = st;
  if (opaque_tid() == 0) (void)xb_add(&bar[XB_XCNT(b.x)], 1u);
  return b;
}
__device__ __forceinline__ void xcd_barrier_complete(unsigned* bar, unsigned x, unsigned& nloc, unsigned& nx) {
  const unsigned G = gridDim.x * gridDim.y * gridDim.z;
  unsigned sum, cnt, mine, sp = 0u;
  for (;;) {
    sum = 0u; cnt = 0u; mine = 0u;
#pragma unroll
    for (unsigned j = 0; j < 16; ++j) { const unsigned c = xb_ld(&bar[XB_XCNT(j)]); sum += c; cnt += (c > 0u) ? 1u : 0u; mine = (j == x) ? c : mine; }
    if (sum == G) break;
    __builtin_amdgcn_s_sleep(1);
    if ((++sp & 255u) == 0u) { if (xb_ld(&bar[XB_TMO])) break; if (sp > XB_SPIN_CAP) { atomicAdd(&bar[XB_TMO], 1u); break; } }
  }
  nloc = mine > 0u ? mine : 1u; nx = cnt > 0u ? cnt : 1u;
}
__device__ __forceinline__ void xcd_barrier(const XcdBarrier& b) {
  asm volatile("s_waitcnt vmcnt(0)" ::: "memory");
  __syncthreads();
  if (opaque_tid() == 0) {
    unsigned* bar = b.bar;
    __builtin_amdgcn_s_waitcnt(0);
    unsigned nloc = b.st[0], nx = b.st[1];
    if (nloc == 0u) { xcd_barrier_complete(bar, b.x, nloc, nx); b.st[0] = nloc; b.st[1] = nx; }
    const unsigned old = xb_add(&bar[XB_XSUB(b.x)], 1u);
    const unsigned gen = old / nloc;
    if (old + 1u == (gen + 1u) * nloc) {
      __builtin_amdgcn_fence(__ATOMIC_RELEASE, "agent");
      asm volatile("s_waitcnt vmcnt(0)" ::: "memory");
      const unsigned og = xb_add(&bar[XB_TOP], 1u);
      const unsigned tg = og / nx;
      if (og + 1u == (tg + 1u) * nx) xb_add(&bar[XB_TOPGEN], 1u);
      else XB_SPIN(xb_ld(&bar[XB_TOPGEN]) == tg, bar);
      __builtin_amdgcn_fence(__ATOMIC_ACQUIRE, "agent");
      xb_add(&bar[XB_XGEN(b.x)], 1u);
      asm volatile("s_waitcnt vmcnt(0)" ::: "memory");
    } else {
      XB_SPIN(xb_ld(&bar[XB_XGEN(b.x)]) == gen, bar);
      __builtin_amdgcn_fence(__ATOMIC_ACQUIRE, "agent");
      asm volatile("s_waitcnt vmcnt(0)" ::: "memory");
    }
  }
  __syncthreads();
}

constexpr int DYN_LDS_BYTES = LDS_ATT_TOTAL > pg8::STAGE_BYTES ? LDS_ATT_TOTAL : pg8::STAGE_BYTES;
__global__ void __launch_bounds__(512) fwd_megakernel(Params p) {
  extern __shared__ __attribute__((aligned(16))) unsigned char smem[];
  __shared__ __attribute__((aligned(16))) unsigned xb_words[4];
  cg::grid_group grid = cg::this_grid();
  if (threadIdx.x == 0) { xb_words[0] = 0u; xb_words[1] = 0u; xb_words[2] = 0u; xb_words[3] = 0u; }
  if ((threadIdx.x & 63) == 0) g_wid_table[hw_wave_slot()] = (int)(threadIdx.x >> 6);
  __syncthreads();
  const XcdBarrier xb = xcd_barrier_post(p.bar, (volatile LAS unsigned*)xb_words);
#define GSYNC() xcd_barrier(xb)
  LAS unsigned char* lds = (LAS unsigned char*)smem;
  phase_prep(p, (LAS float*)smem);
  phase_x(p, 0);
  grid.sync();
  for (int chunk = 0; chunk < NCHUNK; ++chunk) {
    const int L = chunk < 2 ? 2048 : 4096, lshift = chunk < 2 ? 11 : 12;
    const float* xin = (chunk < 2) ? p.xp + (size_t)chunk * TC * DM : p.xs + (size_t)(chunk - 2) * TC * DM;
    float* xres = p.out + (size_t)chunk * TC * DM;
    float* ssq = p.ssq + (size_t)chunk * TC * 16;
    for (int layer = 0; layer < DEPTH; ++layer) {
      {
        {
        { pg8::Gemm g{p.xb, p.wt_in + (size_t)layer * INW * DM, TC, UW, DM, 0, lshift};
          pg8::StaticOrder S; S.init(TC, UW, gridDim.x, blockIdx.x);
          EpiU E{p.u, p.rinv + (size_t)chunk * TC, p.b_gate + (size_t)layer * 3 * DM};
          pg8::gemm_phase<false>(lds, g, S, E); }
        {
          pg8::Gemm g{p.wt_in + ((size_t)layer * INW + UW) * DM, p.xb, VW, TC, DM, 1, lshift};
          pg8::StaticOrder S; S.init(VW, TC, gridDim.x, (blockIdx.x + (gridDim.x >> 2)) % gridDim.x);
          EpiVT E{p.vt, p.rinv + (size_t)chunk * TC, L, lshift};
          pg8::gemm_phase<true>(lds, g, S, E); }
        }
      }
      GSYNC();
      phase_attn(p, layer, L, lshift, lds);
      GSYNC();
      phase_combine(p);
      GSYNC();
      {
        pg8::Gemm g{p.yg, p.wt_br + (size_t)layer * DM * YW, TC, DM, YW, 0, 0};
        pg8::StaticOrder S; S.init(TC, DM, gridDim.x, blockIdx.x);
        EpiMerge E{p.u, p.merged};
        pg8::gemm_phase<false>(lds, g, S, E);
      }
      GSYNC();
      {
        pg8::Gemm g{p.merged, p.wt_out + (size_t)layer * DM * DM, TC, DM, DM, 0, 0};
        pg8::StaticOrder S; S.init(TC, DM, gridDim.x, blockIdx.x);
        EpiRes E{layer == 0 ? xin : (const float*)nullptr, p.xb, layer == DEPTH - 1 ? xres : (float*)nullptr, p.xb, ssq};
        pg8::gemm_phase<false>(lds, g, S, E);
      }
      GSYNC();
      if (layer + 1 < DEPTH) { phase_rinv(p, chunk); GSYNC(); }
    }
    phase_final(p, chunk);
    if (chunk + 1 < NCHUNK) { phase_x(p, chunk + 1); GSYNC(); }
  }
}

extern "C" void kernel_launch(void* const* d_in, const int* in_sizes, int n_in, void* d_out, int out_size, void* d_ws, size_t ws_size, hipStream_t stream) {
  (void)in_sizes; (void)n_in; (void)out_size;
  static int grid_blocks = 0;
  if (!grid_blocks) {
    int dev = 0, cus = 0, per_cu = 0;
    hipGetDevice(&dev);
    hipDeviceGetAttribute(&cus, hipDeviceAttributeMultiprocessorCount, dev);
    hipFuncSetAttribute((const void*)fwd_megakernel, hipFuncAttributeMaxDynamicSharedMemorySize, DYN_LDS_BYTES);
    hipOccupancyMaxActiveBlocksPerMultiprocessor(&per_cu, fwd_megakernel, 512, DYN_LDS_BYTES);
    if (per_cu < 1) per_cu = 1;
    grid_blocks = cus * per_cu;
    if (grid_blocks > 256) grid_blocks = 256;
  }
  Params p{};
  p.xp = (const float*)d_in[0]; p.xs = (const float*)d_in[1]; p.g_norm = (const float*)d_in[2]; p.w_in = (const float*)d_in[3];
  p.b_gate = (const float*)d_in[4]; p.rpb = (const float*)d_in[5]; p.lam_qk = (const float*)d_in[6]; p.g_diff = (const float*)d_in[7];
  p.w_br_a = (const float*)d_in[8]; p.w_br_b = (const float*)d_in[9]; p.w_br_c = (const float*)d_in[10]; p.w_out = (const float*)d_in[11];
  p.g_final = (const float*)d_in[12];
  p.out = (float*)d_out;
  char* w = (char*)d_ws; size_t off = 0;
  auto take = [&](size_t bytes) { char* r = w + off; off += (bytes + 255) & ~(size_t)255; return r; };
  p.wt_in = (bf16_t*)take((size_t)DEPTH * INW * DM * 2);
  p.wt_br = (bf16_t*)take((size_t)DEPTH * DM * YW * 2);
  p.wt_out = (bf16_t*)take((size_t)DEPTH * DM * DM * 2);
  p.xb = (bf16_t*)take((size_t)TC * DM * 2);
  p.u = (bf16_t*)take((size_t)TC * UW * 2);
  p.vt = (bf16_t*)take((size_t)TC * VW * 2);
  p.yg = (bf16_t*)take((size_t)TC * YW * 2);
  p.oc = (bf16_t*)take((size_t)TC * 768 * 2);
  p.merged = (bf16_t*)take((size_t)TC * DM * 2);
  p.lse = (float*)take((size_t)TC * 12 * 4);
  p.ssq = (float*)take((size_t)NTOK * 16 * 4);
  p.lam = (float*)take(256);
  p.rinv = (float*)take((size_t)NTOK * 4);
  p.bar = (unsigned*)take((size_t)XCD_BAR_WORDS * 4);
  if (off > ws_size) fprintf(stderr, "workspace too small: need %zu have %zu\n", off, ws_size);
  hipMemsetAsync(p.bar, 0, (size_t)XCD_BAR_WORDS * 4, stream);
  void* args[] = {&p};
  hipError_t e = hipLaunchCooperativeKernel((void*)fwd_megakernel, dim3(grid_blocks), dim3(512), args, DYN_LDS_BYTES, stream);
  if (e != hipSuccess) fprintf(stderr, "cooperative launch failed: %s (grid %d)\n", hipGetErrorString(e), grid_blocks);
}
```

```cpp
#include <hip/hip_runtime.h>
#include <hip/hip_cooperative_groups.h>
#include <cstdio>
namespace cg = cooperative_groups;

#define LAS __attribute__((address_space(3)))
typedef unsigned short bf16_t;
typedef short bf16x8 __attribute__((ext_vector_type(8)));
typedef short bf16x4 __attribute__((ext_vector_type(4)));
typedef float f32x4 __attribute__((ext_vector_type(4)));
typedef float f32x16 __attribute__((ext_vector_type(16)));
typedef unsigned u32x4 __attribute__((ext_vector_type(4)));
typedef unsigned u32x2 __attribute__((ext_vector_type(2)));

constexpr int DM = 1024, DEPTH = 4, INW = 9728, UW = 7936, VW = 1792, YW = 1280;
constexpr int TC = 16384, NCHUNK = 4, NTOK = 65536;
constexpr float LOG2E = 1.4426950408889634f;
constexpr float QSCALE = 0.125f * LOG2E;
constexpr int U_QA = 0, U_KA = 512, U_ZA = 1024, U_QB = 1536, U_KB = 2048, U_ZB = 2560, U_QC = 3072, U_KC = 3840, U_ZC = 4608, U_GL = 4864;
constexpr int V_A = 0, V_B = 512, V_C = 1024;

struct Params {
  const float *xp, *xs, *g_norm, *w_in, *b_gate, *rpb, *lam_qk, *g_diff, *w_br_a, *w_br_b, *w_br_c, *w_out, *g_final;
  float* out;
  bf16_t *wt_in, *wt_br, *wt_out, *xb, *u, *vt, *yg, *oc, *merged;
  float *lse, *ssq, *lam, *rinv;
  unsigned* bar;
};

__device__ __forceinline__ unsigned cvt_pk_bf16(float lo, float hi) { unsigned r; asm volatile("v_cvt_pk_bf16_f32 %0, %1, %2" : "=v"(r) : "v"(lo), "v"(hi)); return r; }
__device__ __forceinline__ float bf_lo(unsigned v) { return __uint_as_float(v << 16); }
__device__ __forceinline__ float bf_hi(unsigned v) { return __uint_as_float(v & 0xffff0000u); }
__device__ __forceinline__ float fexp2(float x) { return __builtin_amdgcn_exp2f(x); }
__device__ __forceinline__ float frcp(float x) { return __builtin_amdgcn_rcpf(x); }

__shared__ int g_wid_table[64];
__device__ __forceinline__ unsigned hw_wave_slot() { return (unsigned)__builtin_amdgcn_s_getreg(((6 - 1) << 11) | (0 << 6) | 4) & 63u; }
__device__ __forceinline__ int opaque_tid() {
  const int wid = __builtin_amdgcn_readfirstlane(g_wid_table[hw_wave_slot()]);
  unsigned z = 0u; asm volatile("" : "+v"(z));
  int t = wid * 64 + (int)__builtin_amdgcn_mbcnt_hi(~0u, __builtin_amdgcn_mbcnt_lo(~0u, z));
  asm volatile("" : "+v"(t)); return t;
}

namespace pg8 {
constexpr int BM = 256, BK = 64, HALF = 128, HTB = HALF * BK * 2, STAGE_BYTES = 8 * HTB, NXCD = 8, WGM = 4;
__device__ __forceinline__ int lds_byte(int r, int c) { const int st = (r >> 4) * 2 + (c >> 5), rr = r & 15, cc = c & 31, ob = rr * 64 + cc * 2; return st * 1024 + (ob ^ (((ob >> 9) & 1) << 5)); }
__device__ __forceinline__ void stage_rc(int b, int& R, int& C) { const int st = b / 1024, sb = b % 1024, swz = sb ^ (((sb >> 9) & 1) << 5); R = (st >> 1) * 16 + swz / 64; C = (st & 1) * 32 + (swz % 64) / 2; }
__device__ __forceinline__ int perm32(int rho) { const int n = rho >> 4, i = rho & 15; return 8 * (i >> 2) + 4 * n + (i & 3); }
struct Unit { int pm, pn; };
struct Gemm { const bf16_t* A; const bf16_t* Bt; int M, N, K; int bperm, lshift; };
struct StaticOrder {
  int nM, nN, nwg, G, c;
  __device__ void init(int M, int N, int G_, int c_) { nM = M / BM; nN = N / BM; nwg = nM * nN; G = G_; c = c_; }
  __device__ bool next(int i, Unit& u) const {
    const long L = (long)i * G + c; if (L >= nwg) return false;
    int wgid = (int)L; { const int q = nwg / NXCD, r = nwg % NXCD, xcd = wgid % NXCD, off = wgid / NXCD; wgid = (xcd < r ? xcd * (q + 1) : r * (q + 1) + (xcd - r) * q) + off; }
    const int nig = WGM * nN, gid = wgid / nig, fm = gid * WGM, gsz = (nM - fm) < WGM ? (nM - fm) : WGM;
    u.pm = fm + ((wgid % nig) % gsz); u.pn = (wgid % nig) / gsz; return true;
  }
};

template <bool BPERM, class Epi>
__device__ __forceinline__ void gemm_phase(LAS unsigned char* lds, const Gemm g, const StaticOrder& S, const Epi& E) {
  const int tid_ = opaque_tid();
  const int tid = tid_, wid = __builtin_amdgcn_readfirstlane(tid >> 6), lane = tid & 63, wr = wid >> 2, wc = wid & 3, fr = lane & 15, fq = lane >> 4;
  const int K = g.K, nt = K / BK;
  const size_t kstep = (size_t)(BK * 2);
  const size_t hstep = (size_t)HALF * K * 2;
  const size_t tstep = 2 * hstep;
  unsigned voffA[2], voffBr[2], voffBc[2], voffB[2], voffBn[2];
#pragma unroll
  for (int i = 0; i < 2; ++i) { int R, C; stage_rc(tid * 16 + i * 8192, R, C); const int Rb = (R & ~31) + perm32(R & 31);
    voffA[i] = (unsigned)(R * K + C) * 2u; voffBr[i] = (unsigned)(Rb * K) * 2u; voffBc[i] = (unsigned)C * 2u; voffB[i] = voffBr[i] + voffBc[i]; voffBn[i] = voffB[i]; }
  auto bbase = [&](const Unit& u, int hh, int& sh) -> const char* {
    if constexpr (!BPERM) { sh = 0; return (const char*)g.Bt + (size_t)u.pn * tstep + (size_t)hh * hstep; }
    const int ds = u.pm <= 4 ? 0 : (u.pm == 5 ? 2 : 4); sh = ds;
    const int L = 1 << g.lshift; const int p0 = u.pn * 256 + hh * 128, seq = p0 >> g.lshift, p = p0 & (L - 1);
    const int Mc = L >> ds, r = p / Mc, m0 = p & (Mc - 1);
    return (const char*)g.Bt + ((size_t)seq * L + ((size_t)m0 << ds) + r) * (size_t)K * 2;
  };
  const unsigned ldsw = (unsigned)wid * 1024u;
  const int aoff = lds_byte(wr * 64 + fr, fq * 8), boff = lds_byte(wc * 32 + fr, fq * 8);
#define PG8_SA(b, h) (((b) * 2 + (h)) * HTB)
#define PG8_SB(b, h) ((4 + (b) * 2 + (h)) * HTB)
#define PG8_STAGE(bufoff, gbase, voff) do { _Pragma("unroll") for (int _i = 0; _i < 2; ++_i) \
    __builtin_amdgcn_global_load_lds((const unsigned*)((const char*)(gbase) + (voff)[_i]), (LAS unsigned*)(lds + (bufoff) + ldsw + _i * 8192), 16, 0, 0); } while (0)
#define PG8_LDA(dst, b, h) do { _Pragma("unroll") for (int m = 0; m < 4; ++m) _Pragma("unroll") for (int k = 0; k < 2; ++k) dst[m][k] = *(const LAS bf16x8*)(lds + PG8_SA(b, h) + aoff + m * 2048 + k * 1024); } while (0)
#define PG8_LDB(dst, b, h) do { _Pragma("unroll") for (int n = 0; n < 2; ++n) _Pragma("unroll") for (int k = 0; k < 2; ++k) dst[n][k] = *(const LAS bf16x8*)(lds + PG8_SB(b, h) + boff + n * 2048 + k * 1024); } while (0)
#define PG8_MMA(ai, bj, At, Bt) do { __builtin_amdgcn_s_setprio(1); _Pragma("unroll") for (int m = 0; m < 4; ++m) _Pragma("unroll") for (int n = 0; n < 2; ++n) _Pragma("unroll") for (int k = 0; k < 2; ++k) \
    acc[ai][bj][m][n] = __builtin_amdgcn_mfma_f32_16x16x32_bf16(Bt[n][k], At[m][k], acc[ai][bj][m][n], 0, 0, 0); __builtin_amdgcn_s_setprio(0); } while (0)
#define PG8_WAIT_V(n) asm volatile("s_waitcnt vmcnt(" #n ")" ::: "memory")
#define PG8_WAIT_L(n) asm volatile("s_waitcnt lgkmcnt(" #n ")" ::: "memory")
#define PG8_BAR __builtin_amdgcn_s_barrier()
#define PG8_SCHED __builtin_amdgcn_sched_barrier(0)
  Unit cur, nxt; int ui = 0;
  if (!S.next(0, cur)) return;
  f32x4 acc[2][2][4][2];
#pragma unroll
  for (int a = 0; a < 2; ++a)
#pragma unroll
    for (int b = 0; b < 2; ++b)
#pragma unroll
      for (int m = 0; m < 4; ++m)
#pragma unroll
        for (int n = 0; n < 2; ++n) acc[a][b][m][n] = (f32x4){0.f, 0.f, 0.f, 0.f};
  bf16x8 At[4][2], B0[2][2], B1[2][2];
  const char* cA = (const char*)g.A + (size_t)cur.pm * tstep;
  int csh; const char* cB0 = bbase(cur, 0, csh); const char* cB1 = bbase(cur, 1, csh);
#pragma unroll
  for (int i = 0; i < 2; ++i) voffB[i] = (voffBr[i] << csh) + voffBc[i];
  PG8_STAGE(PG8_SB(0, 0), cB0, voffB); PG8_STAGE(PG8_SA(0, 0), cA, voffA); PG8_STAGE(PG8_SB(0, 1), cB1, voffB); PG8_STAGE(PG8_SA(0, 1), cA + hstep, voffA);
  if (wr == 1) PG8_BAR;
  PG8_WAIT_V(4); PG8_BAR;
  PG8_STAGE(PG8_SB(1, 0), cB0 + kstep, voffB); PG8_STAGE(PG8_SA(1, 0), cA + kstep, voffA); PG8_STAGE(PG8_SB(1, 1), cB1 + kstep, voffB);
  PG8_WAIT_V(6); PG8_BAR;
  for (;;) {
    const bool has_next = S.next(ui + 1, nxt);
    const char* nA = cA; const char* nB0 = cB0; const char* nB1 = cB1;
#pragma unroll
    for (int i = 0; i < 2; ++i) voffBn[i] = voffB[i];
    if (has_next) { int nsh; nA = (const char*)g.A + (size_t)nxt.pm * tstep; nB0 = bbase(nxt, 0, nsh); nB1 = bbase(nxt, 1, nsh);
#pragma unroll
      for (int i = 0; i < 2; ++i) voffBn[i] = (voffBr[i] << nsh) + voffBc[i]; }
    auto kiter = [&](int t) __attribute__((always_inline)) {
      const bool last = (t == nt - 2);
      const char* a1 = cA + (size_t)(t + 1) * kstep;
      const char* a2 = last ? nA : cA + (size_t)(t + 2) * kstep;
      const char* b20 = last ? nB0 : cB0 + (size_t)(t + 2) * kstep; const char* b21 = last ? nB1 : cB1 + (size_t)(t + 2) * kstep;
      const char* a3 = a2 + kstep; const char* b30 = b20 + kstep; const char* b31 = b21 + kstep;
      unsigned vB[2];
#pragma unroll
      for (int i = 0; i < 2; ++i) vB[i] = BPERM ? (last ? voffBn[i] : voffB[i]) : voffB[i];
      PG8_LDB(B0, 0, 0); PG8_SCHED; PG8_LDA(At, 0, 0); PG8_STAGE(PG8_SA(1, 1), a1 + hstep, voffA);
      PG8_WAIT_L(8); PG8_BAR; PG8_WAIT_L(0); PG8_MMA(0, 0, At, B0); PG8_BAR; PG8_SCHED;
      PG8_LDB(B1, 0, 1); PG8_STAGE(PG8_SB(0, 0), b20, vB);
      PG8_BAR; PG8_WAIT_L(0); PG8_MMA(0, 1, At, B1); PG8_BAR;
      PG8_LDA(At, 0, 1); PG8_STAGE(PG8_SA(0, 0), a2, voffA);
      PG8_BAR; PG8_WAIT_L(0); PG8_MMA(1, 0, At, B0); PG8_BAR; PG8_SCHED;
      PG8_STAGE(PG8_SB(0, 1), b21, vB);
      PG8_WAIT_V(6); PG8_BAR; PG8_MMA(1, 1, At, B1); PG8_BAR;
      PG8_LDB(B0, 1, 0); PG8_SCHED; PG8_LDA(At, 1, 0); PG8_STAGE(PG8_SA(0, 1), a2 + hstep, voffA);
      PG8_WAIT_L(8); PG8_BAR; PG8_WAIT_L(0); PG8_MMA(0, 0, At, B0); PG8_BAR; PG8_SCHED;
      PG8_LDB(B1, 1, 1); PG8_STAGE(PG8_SB(1, 0), b30, vB);
      PG8_BAR; PG8_WAIT_L(0); PG8_MMA(0, 1, At, B1); PG8_BAR;
      PG8_LDA(At, 1, 1); PG8_STAGE(PG8_SA(1, 0), a3, voffA);
      PG8_BAR; PG8_WAIT_L(0); PG8_MMA(1, 0, At, B0); PG8_BAR; PG8_SCHED;
      PG8_STAGE(PG8_SB(1, 1), b31, vB);
      PG8_WAIT_V(6); PG8_BAR; PG8_MMA(1, 1, At, B1); PG8_BAR;
    };
    if constexpr (Epi::HOOK) {
#pragma unroll 1
      for (int seg = 0; seg < 3; ++seg) {
        const int tb = seg * 8, te = seg == 2 ? nt : tb + 8;
#pragma unroll 1
        for (int t = tb; t < te; t += 2) kiter(t);
        if (seg < 2) E.hook(acc, cur, te, wr, wc, fr, fq);
      }
    } else {
      for (int t = 0; t < nt; t += 2) kiter(t);
    }
    E(acc, cur, wr, wc, fr, fq);
    if (!has_next) break;
#pragma unroll
    for (int a = 0; a < 2; ++a)
#pragma unroll
      for (int b = 0; b < 2; ++b)
#pragma unroll
        for (int m = 0; m < 4; ++m)
#pragma unroll
          for (int n = 0; n < 2; ++n) acc[a][b][m][n] = (f32x4){0.f, 0.f, 0.f, 0.f};
    cur = nxt; cA = nA; cB0 = nB0; cB1 = nB1; ++ui;
#pragma unroll
    for (int i = 0; i < 2; ++i) voffB[i] = voffBn[i];
  }
  PG8_WAIT_V(0);
  if (wr == 0) PG8_BAR;
  PG8_BAR;
#undef PG8_SA
#undef PG8_SB
#undef PG8_STAGE
#undef PG8_LDA
#undef PG8_LDB
#undef PG8_MMA
#undef PG8_WAIT_V
#undef PG8_WAIT_L
#undef PG8_BAR
#undef PG8_SCHED
}
}
using pg8::Unit;

struct EpiU {
  static constexpr bool HOOK = false;
  bf16_t* U; const float* rinv; const float* bg;
  __device__ __forceinline__ void hook(f32x4 (&)[2][2][4][2], const Unit&, int, int, int, int, int) const {}
  __device__ __forceinline__ void operator()(const f32x4 (&acc)[2][2][4][2], const Unit& u, int wr, int wc, int fr, int fq) const {
    asm volatile("" : "+v"(fr), "+v"(fq));
    const int row0 = u.pm * 256 + wr * 64 + fr, col0 = u.pn * 256 + wc * 32 + 8 * fq;
    const bool isg = (u.pn >= 19);
    float ri[2][4];
#pragma unroll
    for (int ai = 0; ai < 2; ++ai)
#pragma unroll
      for (int m = 0; m < 4; ++m) ri[ai][m] = rinv[row0 + ai * 128 + m * 16];
    if (isg) {
      f32x4 b[2][2];
#pragma unroll
      for (int bj = 0; bj < 2; ++bj) { const float* bp = bg + (col0 - U_GL) + bj * 128; b[bj][0] = *(const f32x4*)bp; b[bj][1] = *(const f32x4*)(bp + 4); }
#pragma unroll
      for (int ai = 0; ai < 2; ++ai)
#pragma unroll
        for (int m = 0; m < 4; ++m)
#pragma unroll
          for (int bj = 0; bj < 2; ++bj) {
            f32x4 v0 = acc[ai][bj][m][0] * ri[ai][m] + b[bj][0], v1 = acc[ai][bj][m][1] * ri[ai][m] + b[bj][1];
#pragma unroll
            for (int j = 0; j < 4; ++j) { v0[j] = 1.0f + fminf(fexp2(-v0[j] * LOG2E), 1e30f); v1[j] = 1.0f + fminf(fexp2(-v1[j] * LOG2E), 1e30f); }
            u32x4 pk = {cvt_pk_bf16(v0[0], v0[1]), cvt_pk_bf16(v0[2], v0[3]), cvt_pk_bf16(v1[0], v1[1]), cvt_pk_bf16(v1[2], v1[3])};
            *(u32x4*)(U + (size_t)(row0 + ai * 128 + m * 16) * UW + col0 + bj * 128) = pk;
          }
    } else {
#pragma unroll
      for (int ai = 0; ai < 2; ++ai)
#pragma unroll
        for (int m = 0; m < 4; ++m)
#pragma unroll
          for (int bj = 0; bj < 2; ++bj) {
            const f32x4 v0 = acc[ai][bj][m][0] * ri[ai][m], v1 = acc[ai][bj][m][1] * ri[ai][m];
            u32x4 pk = {cvt_pk_bf16(v0[0], v0[1]), cvt_pk_bf16(v0[2], v0[3]), cvt_pk_bf16(v1[0], v1[1]), cvt_pk_bf16(v1[2], v1[3])};
            *(u32x4*)(U + (size_t)(row0 + ai * 128 + m * 16) * UW + col0 + bj * 128) = pk;
          }
    }
  }
};

struct EpiVT {
  static constexpr bool HOOK = false;
  bf16_t* VT; const float* rv; int L, lshift;
  __device__ __forceinline__ void hook(f32x4 (&)[2][2][4][2], const Unit&, int, int, int, int, int) const {}
  __device__ __forceinline__ void operator()(const f32x4 (&acc)[2][2][4][2], const Unit& u, int wr, int wc, int fr, int fq) const {
    asm volatile("" : "+v"(fr), "+v"(fq));
    const int vrow0 = u.pm * 256 + wr * 64 + fr, pcol0 = u.pn * 256 + wc * 32 + 8 * fq;
    const int ds = u.pm <= 4 ? 0 : (u.pm == 5 ? 2 : 4);
    const int Mc = L >> ds;
#pragma unroll
    for (int bj = 0; bj < 2; ++bj) {
      const int p0 = pcol0 + bj * 128, seq = p0 >> lshift, pos = p0 & (L - 1);
      const int r = pos / Mc, m0 = pos & (Mc - 1);
      float rinv[8];
#pragma unroll
      for (int j = 0; j < 8; ++j) rinv[j] = rv[(seq << lshift) + ((m0 + j) << ds) + r];
      bf16_t* vb = VT + ((size_t)seq * VW + vrow0) * L + pos;
#pragma unroll
      for (int ai = 0; ai < 2; ++ai)
#pragma unroll
        for (int m = 0; m < 4; ++m) {
          const f32x4 v0 = acc[ai][bj][m][0], v1 = acc[ai][bj][m][1];
          u32x4 pk = {cvt_pk_bf16(v0[0] * rinv[0], v0[1] * rinv[1]), cvt_pk_bf16(v0[2] * rinv[2], v0[3] * rinv[3]),
                      cvt_pk_bf16(v1[0] * rinv[4], v1[1] * rinv[5]), cvt_pk_bf16(v1[2] * rinv[6], v1[3] * rinv[7])};
          *(u32x4*)(vb + (size_t)(ai * 128 + m * 16) * L) = pk;
        }
    }
  }
};

struct EpiMerge {
  static constexpr bool HOOK = true;
  const bf16_t* U; bf16_t* MG;
  __device__ __forceinline__ f32x4 gvec(int i, size_t row, int col) const {
    const u32x2 raw = *(const u32x2*)(U + row * UW + U_GL + i * 1024 + col);
    f32x4 e; e[0] = bf_lo(raw[0]); e[1] = bf_hi(raw[0]); e[2] = bf_lo(raw[1]); e[3] = bf_hi(raw[1]); return e;
  }
  __device__ __forceinline__ void hook(f32x4 (&acc)[2][2][4][2], const Unit& u, int t, int wr, int wc, int fr, int fq) const {
    const int i = (t == 8) ? 0 : 1;
    asm volatile("" : "+v"(fr), "+v"(fq));
    const int row0 = u.pm * 256 + wr * 64 + fr, col0 = u.pn * 256 + wc * 32 + 8 * fq;
#pragma unroll
    for (int ai = 0; ai < 2; ++ai) {
#pragma unroll
      for (int m = 0; m < 4; ++m)
#pragma unroll
        for (int bj = 0; bj < 2; ++bj) {
          const bf16_t* gp = U + (size_t)(row0 + ai * 128 + m * 16) * UW + U_GL + i * 1024 + col0 + bj * 128;
          const u32x4 a = *(const u32x4*)gp, b = *(const u32x4*)(gp + 1024);
#pragma unroll
          for (int n = 0; n < 2; ++n) {
            f32x4 r;
            r[0] = bf_lo(b[2 * n]) * frcp(bf_lo(a[2 * n])); r[1] = bf_hi(b[2 * n]) * frcp(bf_hi(a[2 * n]));
            r[2] = bf_lo(b[2 * n + 1]) * frcp(bf_lo(a[2 * n + 1])); r[3] = bf_hi(b[2 * n + 1]) * frcp(bf_hi(a[2 * n + 1]));
            acc[ai][bj][m][n] *= r;
          }
        }
      __builtin_amdgcn_sched_barrier(0);
    }
  }
  __device__ __forceinline__ void operator()(const f32x4 (&acc)[2][2][4][2], const Unit& u, int wr, int wc, int fr, int fq) const {
    asm volatile("" : "+v"(fr), "+v"(fq));
    const int row0 = u.pm * 256 + wr * 64 + fr, col0 = u.pn * 256 + wc * 32 + 8 * fq;
    u32x4 g2[2][4][2];
#pragma unroll
    for (int ai = 0; ai < 2; ++ai)
#pragma unroll
      for (int m = 0; m < 4; ++m)
#pragma unroll
        for (int bj = 0; bj < 2; ++bj) g2[ai][m][bj] = *(const u32x4*)(U + (size_t)(row0 + ai * 128 + m * 16) * UW + U_GL + 2 * 1024 + col0 + bj * 128);
    __builtin_amdgcn_sched_barrier(0);
#pragma unroll
    for (int ai = 0; ai < 2; ++ai)
#pragma unroll
      for (int m = 0; m < 4; ++m)
#pragma unroll
        for (int bj = 0; bj < 2; ++bj) {
          const size_t row = (size_t)(row0 + ai * 128 + m * 16); const int col = col0 + bj * 128;
          const u32x4 g = g2[ai][m][bj];
          f32x4 v0 = acc[ai][bj][m][0], v1 = acc[ai][bj][m][1];
          v0[0] *= frcp(bf_lo(g[0])); v0[1] *= frcp(bf_hi(g[0])); v0[2] *= frcp(bf_lo(g[1])); v0[3] *= frcp(bf_hi(g[1]));
          v1[0] *= frcp(bf_lo(g[2])); v1[1] *= frcp(bf_hi(g[2])); v1[2] *= frcp(bf_lo(g[3])); v1[3] *= frcp(bf_hi(g[3]));
          u32x4 pk = {cvt_pk_bf16(v0[0], v0[1]), cvt_pk_bf16(v0[2], v0[3]), cvt_pk_bf16(v1[0], v1[1]), cvt_pk_bf16(v1[2], v1[3])};
          *(u32x4*)(MG + row * DM + col) = pk;
        }
  }
};

struct EpiRes {
  static constexpr bool HOOK = false;
  const float* R32; const bf16_t* RB; float* X; bf16_t* XB; float* ssq;
  __device__ __forceinline__ void hook(f32x4 (&)[2][2][4][2], const Unit&, int, int, int, int, int) const {}
  __device__ __forceinline__ void operator()(const f32x4 (&acc)[2][2][4][2], const Unit& u, int wr, int wc, int fr, int fq) const {
    asm volatile("" : "+v"(fr), "+v"(fq));
    const int row0 = u.pm * 256 + wr * 64 + fr, col0 = u.pn * 256 + wc * 32 + 8 * fq;
#pragma unroll
    for (int ai = 0; ai < 2; ++ai) {
      f32x4 r[4][2][2];
      if (R32) {
#pragma unroll
        for (int m = 0; m < 4; ++m)
#pragma unroll
          for (int bj = 0; bj < 2; ++bj) { const float* rp = R32 + (size_t)(row0 + ai * 128 + m * 16) * DM + col0 + bj * 128; r[m][bj][0] = *(const f32x4*)rp; r[m][bj][1] = *(const f32x4*)(rp + 4); }
      } else {
        u32x4 rb[4][2];
#pragma unroll
        for (int m = 0; m < 4; ++m)
#pragma unroll
          for (int bj = 0; bj < 2; ++bj) rb[m][bj] = *(const u32x4*)(RB + (size_t)(row0 + ai * 128 + m * 16) * DM + col0 + bj * 128);
#pragma unroll
        for (int m = 0; m < 4; ++m)
#pragma unroll
          for (int bj = 0; bj < 2; ++bj) {
            r[m][bj][0] = (f32x4){bf_lo(rb[m][bj][0]), bf_hi(rb[m][bj][0]), bf_lo(rb[m][bj][1]), bf_hi(rb[m][bj][1])};
            r[m][bj][1] = (f32x4){bf_lo(rb[m][bj][2]), bf_hi(rb[m][bj][2]), bf_lo(rb[m][bj][3]), bf_hi(rb[m][bj][3])};
          }
      }
      __builtin_amdgcn_sched_barrier(0);
#pragma unroll
      for (int m = 0; m < 4; ++m) {
        const size_t row = (size_t)(row0 + ai * 128 + m * 16);
        float s = 0.f;
#pragma unroll
        for (int bj = 0; bj < 2; ++bj) {
          const int col = col0 + bj * 128;
          const f32x4 v0 = r[m][bj][0] + acc[ai][bj][m][0], v1 = r[m][bj][1] + acc[ai][bj][m][1];
          s += v0[0] * v0[0] + v0[1] * v0[1] + v0[2] * v0[2] + v0[3] * v0[3] + v1[0] * v1[0] + v1[1] * v1[1] + v1[2] * v1[2] + v1[3] * v1[3];
          if (X) { *(f32x4*)(X + row * DM + col) = v0; *(f32x4*)(X + row * DM + col + 4) = v1; }
          else { u32x4 pk = {cvt_pk_bf16(v0[0], v0[1]), cvt_pk_bf16(v0[2], v0[3]), cvt_pk_bf16(v1[0], v1[1]), cvt_pk_bf16(v1[2], v1[3])};
                 *(u32x4*)(XB + row * DM + col) = pk; }
        }
        s += __shfl_xor(s, 16); s += __shfl_xor(s, 32);
        if (fq == 0) ssq[row * 16 + u.pn * 4 + wc] = s;
      }
      __builtin_amdgcn_sched_barrier(0);
    }
  }
};

__device__ __forceinline__ void prep_tile(const float* src, int ldn, int k0, int n0, const float* rscale, float cscale, bf16_t* dst, int ldd, int drow0, int dk0, LAS float* tile) {
  const int tid = opaque_tid(), kk = tid >> 6, nn = tid & 63;
#pragma unroll
  for (int i = 0; i < 8; ++i) {
    const int k = kk * 8 + i;
    float v = src[(size_t)(k0 + k) * ldn + n0 + nn] * cscale;
    if (rscale) v *= rscale[k0 + k];
    tile[k * 65 + nn] = v;
  }
  __syncthreads();
  const int n = tid >> 3, kc = tid & 7;
  float f[8];
#pragma unroll
  for (int j = 0; j < 8; ++j) f[j] = tile[(kc * 8 + j) * 65 + n];
  u32x4 pk = {cvt_pk_bf16(f[0], f[1]), cvt_pk_bf16(f[2], f[3]), cvt_pk_bf16(f[4], f[5]), cvt_pk_bf16(f[6], f[7])};
  *(u32x4*)(dst + (size_t)(drow0 + n) * ldd + dk0 + kc * 8) = pk;
  __syncthreads();
}

__device__ __forceinline__ void win_map(int n0, int& dn0, float& sc) {
  sc = 1.0f;
  if (n0 < 512) { dn0 = U_QA + n0; sc = QSCALE; }
  else if (n0 < 1024) dn0 = U_KA + (n0 - 512);
  else if (n0 < 1536) dn0 = UW + V_A + (n0 - 1024);
  else if (n0 < 2048) dn0 = U_ZA + (n0 - 1536);
  else if (n0 < 2560) { dn0 = U_QB + (n0 - 2048); sc = QSCALE; }
  else if (n0 < 3072) dn0 = U_KB + (n0 - 2560);
  else if (n0 < 3584) dn0 = UW + V_B + (n0 - 3072);
  else if (n0 < 4096) dn0 = U_ZB + (n0 - 3584);
  else if (n0 < 4864) { dn0 = U_QC + (n0 - 4096); sc = QSCALE; }
  else if (n0 < 5632) dn0 = U_KC + (n0 - 4864);
  else if (n0 < 6400) dn0 = UW + V_C + (n0 - 5632);
  else if (n0 < 6656) dn0 = U_ZC + (n0 - 6400);
  else dn0 = U_GL + (n0 - 6656);
}

__device__ void phase_prep(const Params& p, LAS float* tile) {
  constexpr int PER = 3008;
  for (int it = blockIdx.x; it < DEPTH * PER; it += gridDim.x) {
    const int l = it / PER; int r = it % PER;
    if (r < 2432) {
      const int kt = r / 152, ntile = r % 152; int dn0; float sc; win_map(ntile * 64, dn0, sc);
      prep_tile(p.w_in + (size_t)l * DM * INW, INW, kt * 64, ntile * 64, p.g_norm + l * DM, sc, p.wt_in + (size_t)l * INW * DM, DM, dn0, kt * 64, tile);
    } else if ((r -= 2432) < 128) {
      const int kt = r / 16, ntile = r % 16;
      prep_tile(p.w_br_a + (size_t)l * 512 * DM, DM, kt * 64, ntile * 64, nullptr, 1.0f, p.wt_br + (size_t)l * DM * YW, YW, ntile * 64, kt * 64, tile);
    } else if ((r -= 128) < 128) {
      const int kt = r / 16, ntile = r % 16;
      prep_tile(p.w_br_b + (size_t)l * 512 * DM, DM, kt * 64, ntile * 64, nullptr, 1.0f, p.wt_br + (size_t)l * DM * YW, YW, ntile * 64, 512 + kt * 64, tile);
    } else if ((r -= 128) < 64) {
      const int kt = r / 16, ntile = r % 16;
      prep_tile(p.w_br_c + (size_t)l * 256 * DM, DM, kt * 64, ntile * 64, nullptr, 1.0f, p.wt_br + (size_t)l * DM * YW, YW, ntile * 64, 1024 + kt * 64, tile);
    } else {
      r -= 64; const int kt = r / 16, ntile = r % 16;
      prep_tile(p.w_out + (size_t)l * DM * DM, DM, kt * 64, ntile * 64, nullptr, 1.0f, p.wt_out + (size_t)l * DM * DM, DM, ntile * 64, kt * 64, tile);
    }
  }
  const int ptid = opaque_tid();
  if (blockIdx.x == 0 && ptid < 64) {
    const int lane = ptid;
    for (int l = 0; l < DEPTH; ++l) {
      const float* lq = p.lam_qk + l * 256;
      float a = lq[lane] * lq[64 + lane], b = lq[128 + lane] * lq[192 + lane];
      for (int o = 32; o >= 1; o >>= 1) { a += __shfl_xor(a, o); b += __shfl_xor(b, o); }
      if (lane == 0) { const float li = 0.8f - 0.6f * expf(-0.3f * (float)l); p.lam[l] = expf(a) - expf(b) + li; p.lam[4 + l] = 1.0f - li; }
    }
  }
}

__device__ void phase_x(const Params& p, int chunk) {
  const float* xin = (chunk < 2) ? p.xp + (size_t)chunk * TC * DM : p.xs + (size_t)(chunk - 2) * TC * DM;
  float* ssq = p.ssq + (size_t)chunk * TC * 16;
  const int tid = opaque_tid(), lane = tid & 63, w = blockIdx.x * 8 + (tid >> 6), nw = gridDim.x * 8;
  for (int row = w; row < TC; row += nw) {
    const float* xr = xin + (size_t)row * DM + lane * 16;
    f32x4 v[4]; float s = 0.f;
#pragma unroll
    for (int i = 0; i < 4; ++i) { v[i] = *(const f32x4*)(xr + i * 4); s += v[i][0] * v[i][0] + v[i][1] * v[i][1] + v[i][2] * v[i][2] + v[i][3] * v[i][3]; }
    for (int o = 32; o >= 1; o >>= 1) s += __shfl_xor(s, o);
    u32x4 p0 = {cvt_pk_bf16(v[0][0], v[0][1]), cvt_pk_bf16(v[0][2], v[0][3]), cvt_pk_bf16(v[1][0], v[1][1]), cvt_pk_bf16(v[1][2], v[1][3])};
    u32x4 p1 = {cvt_pk_bf16(v[2][0], v[2][1]), cvt_pk_bf16(v[2][2], v[2][3]), cvt_pk_bf16(v[3][0], v[3][1]), cvt_pk_bf16(v[3][2], v[3][3])};
    bf16_t* xo = p.xb + (size_t)row * DM + lane * 16;
    *(u32x4*)xo = p0; *(u32x4*)(xo + 8) = p1;
    if (lane < 16) ssq[(size_t)row * 16 + lane] = (lane == 0) ? s : 0.f;
    if (lane == 0) p.rinv[(size_t)chunk * TC + row] = rsqrtf(s * (1.0f / 1024.0f) + 1e-6f);
  }
}

__device__ void phase_rinv(const Params& p, int chunk) {
  const float* ssq = p.ssq + (size_t)chunk * TC * 16; float* rv = p.rinv + (size_t)chunk * TC;
  for (int row = blockIdx.x * 512 + opaque_tid(); row < TC; row += gridDim.x * 512) {
    const f32x4* sp = (const f32x4*)(ssq + (size_t)row * 16);
    const f32x4 a4 = sp[0] + sp[1] + sp[2] + sp[3];
    rv[row] = rsqrtf((a4[0] + a4[1] + a4[2] + a4[3]) * (1.0f / 1024.0f) + 1e-6f);
  }
}

__device__ void phase_final(const Params& p, int chunk) {
  float* x = p.out + (size_t)chunk * TC * DM;
  const float* ssq = p.ssq + (size_t)chunk * TC * 16;
  const int tid = opaque_tid(), lane = tid & 63, w = blockIdx.x * 8 + (tid >> 6), nw = gridDim.x * 8;
  for (int row = w; row < TC; row += nw) {
    const f32x4* sp = (const f32x4*)(ssq + (size_t)row * 16);
    const f32x4 a4 = sp[0] + sp[1] + sp[2] + sp[3];
    const float rinv = rsqrtf((a4[0] + a4[1] + a4[2] + a4[3]) * (1.0f / 1024.0f) + 1e-6f);
    float* xr = x + (size_t)row * DM + lane * 16;
#pragma unroll
    for (int i = 0; i < 4; ++i) { f32x4 v = *(const f32x4*)(xr + i * 4); const f32x4 g = *(const f32x4*)(p.g_final + lane * 16 + i * 4); v = v * rinv * g; *(f32x4*)(xr + i * 4) = v; }
  }
}

__device__ __forceinline__ f32x16 mfma32(bf16x8 a, bf16x8 b, f32x16 c) { return __builtin_amdgcn_mfma_f32_32x32x16_bf16(a, b, c, 0, 0, 0); }
__device__ __forceinline__ bf16x8 ld16(const bf16_t* p) { return *(const bf16x8*)p; }
__device__ __forceinline__ bf16x8 ld8x2(const bf16_t* p0, const bf16_t* p1) { const bf16x4 a = *(const bf16x4*)p0, b = *(const bf16x4*)p1; return __builtin_shufflevector(a, b, 0, 1, 2, 3, 4, 5, 6, 7); }

__device__ __forceinline__ float xhalf_max(float v) { const auto rr = __builtin_amdgcn_permlane32_swap(__float_as_uint(v), __float_as_uint(v), false, false); return fmaxf(__uint_as_float(rr[0]), __uint_as_float(rr[1])); }
__device__ __forceinline__ float xhalf_sum(float v) { const auto rr = __builtin_amdgcn_permlane32_swap(__float_as_uint(v), __float_as_uint(v), false, false); return __uint_as_float(rr[0]) + __uint_as_float(rr[1]); }
__device__ __forceinline__ void softmax_tile(f32x16& t, float& m, float& l, float& alpha, bf16x8& p0, bf16x8& p1) {
  float tm = t[0];
#pragma unroll
  for (int i = 1; i < 16; ++i) tm = fmaxf(tm, t[i]);
  tm = xhalf_max(tm);
  const float mn = fmaxf(m, tm);
  alpha = fexp2(m - mn); m = mn;
  float ls = 0.f;
#pragma unroll
  for (int i = 0; i < 16; ++i) { t[i] = fexp2(t[i] - mn); ls += t[i]; }
  l = l * alpha + ls;
  const u32x4 a = {cvt_pk_bf16(t[0], t[1]), cvt_pk_bf16(t[2], t[3]), cvt_pk_bf16(t[4], t[5]), cvt_pk_bf16(t[6], t[7])};
  const u32x4 b = {cvt_pk_bf16(t[8], t[9]), cvt_pk_bf16(t[10], t[11]), cvt_pk_bf16(t[12], t[13]), cvt_pk_bf16(t[14], t[15])};
  p0 = __builtin_bit_cast(bf16x8, a); p1 = __builtin_bit_cast(bf16x8, b);
}
__device__ __forceinline__ f32x16 zero16() { f32x16 z;
#pragma unroll
  for (int i = 0; i < 16; ++i) z[i] = 0.f; return z; }
__device__ __forceinline__ float silu(float z) { return z * frcp(1.0f + fexp2(-z * LOG2E)); }

constexpr int TB_ROW = 144;
constexpr int KB_BYTES = 64 * TB_ROW;
constexpr int VB_BYTES = 128 * TB_ROW;
constexpr int LDS_K = 0, LDS_V = LDS_K + 2 * KB_BYTES, LDS_ATT_END = LDS_V + 2 * VB_BYTES, LDS_ATT_TOTAL = LDS_ATT_END + 65536;
template <int SIDE>
__device__ __forceinline__ void b_far_subtile(const LAS unsigned char* kb, const LAS unsigned char* vb, int rd, int sub, const bf16x8 (&qf)[4], const f32x16& bp, float slope2, float d0,
                                              float& mrun, float& lrun, f32x16 (&o)[4]) {
  const float base = (SIDE > 0 ? -slope2 : slope2) * d0 - mrun;
  f32x16 sc;
#pragma unroll
  for (int i = 0; i < 16; ++i) sc[i] = SIDE > 0 ? base - bp[i] : base + bp[i];
#pragma unroll
  for (int ks = 0; ks < 4; ++ks) sc = mfma32(*(const LAS bf16x8*)(kb + rd + sub * 32 * TB_ROW + ks * 32), qf[ks], sc);
  float tm = sc[0];
#pragma unroll
  for (int i = 1; i < 16; ++i) tm = fmaxf(tm, sc[i]);
  tm = xhalf_max(tm);
  if (__builtin_amdgcn_ballot_w64(tm > 0.0f) != 0) {
    const float delta = fmaxf(tm, 0.0f);
    const float al = fexp2(-delta);
    mrun += delta; lrun *= al;
#pragma unroll
    for (int i = 0; i < 16; ++i) sc[i] -= delta;
#pragma unroll
    for (int dt = 0; dt < 4; ++dt) o[dt] *= al;
  }
#pragma unroll
  for (int i = 0; i < 16; ++i) sc[i] = fexp2(sc[i]);
  { const f32x4 a4 = (f32x4){sc[0], sc[1], sc[2], sc[3]} + (f32x4){sc[4], sc[5], sc[6], sc[7]} + (f32x4){sc[8], sc[9], sc[10], sc[11]} + (f32x4){sc[12], sc[13], sc[14], sc[15]};
    lrun += (a4[0] + a4[1]) + (a4[2] + a4[3]); }
  const u32x4 pa = {cvt_pk_bf16(sc[0], sc[1]), cvt_pk_bf16(sc[2], sc[3]), cvt_pk_bf16(sc[4], sc[5]), cvt_pk_bf16(sc[6], sc[7])};
  const u32x4 pb = {cvt_pk_bf16(sc[8], sc[9]), cvt_pk_bf16(sc[10], sc[11]), cvt_pk_bf16(sc[12], sc[13]), cvt_pk_bf16(sc[14], sc[15])};
  const bf16x8 pk0 = __builtin_bit_cast(bf16x8, pa), pk1 = __builtin_bit_cast(bf16x8, pb);
#pragma unroll
  for (int dt = 0; dt < 4; ++dt) {
    o[dt] = mfma32(*(const LAS bf16x8*)(vb + rd + dt * 32 * TB_ROW + (sub * 2) * 32), pk0, o[dt]);
    o[dt] = mfma32(*(const LAS bf16x8*)(vb + rd + dt * 32 * TB_ROW + (sub * 2 + 1) * 32), pk1, o[dt]);
  }
}

__device__ __forceinline__ void attn_b_pass(const Params& p, int L, int seq, int h, int mp, int qblk, int tq, int tid, float slope2, LAS unsigned char* lds, f32x16 (&o)[4], float& linv) {
  const int lane = tid & 63, q = lane & 31, half = lane >> 5;
  const size_t tokbase = (size_t)seq * L;
  bf16x8 qf[4];
  { const bf16_t* qp = p.u + (tokbase + tq) * UW + U_QB + h * 128 + mp * 64 + half * 8;
#pragma unroll
    for (int ks = 0; ks < 4; ++ks) qf[ks] = ld16(qp + ks * 16); }
  const int spart = tid & 7, srow = tid >> 3;
  const bf16_t* kg = p.u + (tokbase + srow) * UW + U_KB + h * 128 + mp * 64 + spart * 8;
  const bf16_t* vg = p.vt + ((size_t)seq * VW + V_B + h * 128 + srow) * L + spart * 8;
  const int kst = srow * TB_ROW + spart * 16;
  const int vst = srow * TB_ROW + ((spart >> 1) * 16 + (spart & 1) * 4) * 2;
  const int rd = q * TB_ROW + half * 16;
#pragma unroll
  for (int dt = 0; dt < 4; ++dt) o[dt] = zero16();
  float mrun = -1e30f, lrun = 0.f;
  f32x16 bp;
#pragma unroll
  for (int i = 0; i < 16; ++i) bp[i] = slope2 * (float)((i >> 2) * 8 + (i & 3));
  const int ntile = L >> 6, t0 = qblk * 4, nR = ntile - t0;
  auto tile_of = [&](int idx) { return idx < nR ? t0 + idx : (t0 - 1) - (idx - nR); };
  bf16x8 krA, vrA0, vrA1, krB, vrB0, vrB1;
  auto gload = [&](int idx, bf16x8& kr, bf16x8& v0, bf16x8& v1) { const int kn = tile_of(idx) * 64; kr = ld16(kg + (size_t)kn * UW); v0 = ld16(vg + kn); v1 = ld16(vg + (size_t)64 * L + kn); };
  auto lwrite = [&](int buf, const bf16x8& kr, const bf16x8& v0, const bf16x8& v1) {
    LAS unsigned char* kb = lds + LDS_K + buf * KB_BYTES; LAS unsigned char* vb = lds + LDS_V + buf * VB_BYTES;
    *(LAS bf16x8*)(kb + kst) = kr;
    *(LAS bf16x4*)(vb + vst) = __builtin_shufflevector(v0, v0, 0, 1, 2, 3); *(LAS bf16x4*)(vb + vst + 16) = __builtin_shufflevector(v0, v0, 4, 5, 6, 7);
    *(LAS bf16x4*)(vb + vst + 64 * TB_ROW) = __builtin_shufflevector(v1, v1, 0, 1, 2, 3); *(LAS bf16x4*)(vb + vst + 64 * TB_ROW + 16) = __builtin_shufflevector(v1, v1, 4, 5, 6, 7);
  };
  auto compute = [&](int idx, int buf) {
    const int k0 = tile_of(idx) * 64;
    const LAS unsigned char* kb = lds + LDS_K + buf * KB_BYTES;
    const LAS unsigned char* vb = lds + LDS_V + buf * VB_BYTES;
    if (idx < 4) {
#pragma unroll
      for (int sub = 0; sub < 2; ++sub) {
        f32x16 sc = zero16();
#pragma unroll
        for (int ks = 0; ks < 4; ++ks) sc = mfma32(*(const LAS bf16x8*)(kb + rd + sub * 32 * TB_ROW + ks * 32), qf[ks], sc);
        const float d0 = (float)(k0 + sub * 32 + half * 4 - tq);
#pragma unroll
        for (int i = 0; i < 16; ++i) sc[i] -= slope2 * fabsf(d0 + (float)((i >> 2) * 8 + (i & 3)));
        float al; bf16x8 pk[2];
        softmax_tile(sc, mrun, lrun, al, pk[0], pk[1]);
        if (__builtin_amdgcn_ballot_w64(al != 1.0f) != 0) {
#pragma unroll
          for (int dt = 0; dt < 4; ++dt) o[dt] *= al;
        }
#pragma unroll
        for (int dt = 0; dt < 4; ++dt)
#pragma unroll
          for (int s2 = 0; s2 < 2; ++s2) o[dt] = mfma32(*(const LAS bf16x8*)(vb + rd + dt * 32 * TB_ROW + (sub * 2 + s2) * 32), pk[s2], o[dt]);
      }
    } else if (idx < nR) {
#pragma unroll
      for (int sub = 0; sub < 2; ++sub) b_far_subtile<1>(kb, vb, rd, sub, qf, bp, slope2, (float)(k0 + sub * 32 + half * 4 - tq), mrun, lrun, o);
    } else {
#pragma unroll
      for (int sub = 0; sub < 2; ++sub) b_far_subtile<-1>(kb, vb, rd, sub, qf, bp, slope2, (float)(k0 + sub * 32 + half * 4 - tq), mrun, lrun, o);
    }
  };
  gload(0, krA, vrA0, vrA1);
  gload(1, krB, vrB0, vrB1);
  lwrite(0, krA, vrA0, vrA1);
  asm volatile("" : "+v"(qf[0]), "+v"(qf[1]), "+v"(qf[2]), "+v"(qf[3]));
  asm volatile("" : "+v"(krB), "+v"(vrB0), "+v"(vrB1));
  __syncthreads();
#pragma unroll 1
  for (int idx = 0; idx < ntile; idx += 2) {
    if (idx + 2 < ntile) gload(idx + 2, krA, vrA0, vrA1);
    compute(idx, 0);
    lwrite(1, krB, vrB0, vrB1);
    __syncthreads();
    if (idx + 3 < ntile) gload(idx + 3, krB, vrB0, vrB1);
    compute(idx + 1, 1);
    if (idx + 2 < ntile) lwrite(0, krA, vrA0, vrA1);
    __syncthreads();
  }
  linv = frcp(xhalf_sum(lrun));
}
__device__ void attn_b_block(const Params& p, int layer, int L, int seq, int h, int qblk, LAS unsigned char* lds) {
  const int tid = opaque_tid(), lane = tid & 63, wid = __builtin_amdgcn_readfirstlane(tid >> 6);
  const int q = lane & 31, half = lane >> 5;
  const size_t tokbase = (size_t)seq * L;
  const int tq = qblk * 256 + wid * 32 + q;
  const float slope2 = exp2f(-2.0f * (float)(h + 1)) * LOG2E;
  f32x16 o0[4]; float li0, li1;
  LAS u32x4* park = (LAS u32x4*)(lds + LDS_ATT_END) + wid * 512 + lane;
  attn_b_pass(p, L, seq, h, 0, qblk, tq, tid, slope2, lds, o0, li0);
#pragma unroll
  for (int dt = 0; dt < 4; ++dt)
#pragma unroll
    for (int g2 = 0; g2 < 2; ++g2) {
      u32x4 pk;
#pragma unroll
      for (int k = 0; k < 4; ++k) pk[k] = cvt_pk_bf16(o0[dt][g2 * 8 + 2 * k] * li0, o0[dt][g2 * 8 + 2 * k + 1] * li0);
      park[(dt * 2 + g2) * 64] = pk;
    }
  attn_b_pass(p, L, seq, h, 1, qblk, tq, tid, slope2, lds, o0, li1);
  const float c1 = p.lam[layer] * li1;
  const int tid2 = opaque_tid(), half2 = (tid2 >> 5) & 1;
  const size_t tok2 = (size_t)seq * L + qblk * 256 + (tid2 >> 6) * 32 + (tid2 & 31);
  float ss = 0.f;
#pragma unroll
  for (int dt = 0; dt < 4; ++dt)
#pragma unroll
    for (int g2 = 0; g2 < 2; ++g2) {
      const u32x4 pk = park[(dt * 2 + g2) * 64];
#pragma unroll
      for (int k = 0; k < 4; ++k) {
        const float va = bf_lo(pk[k]) - o0[dt][g2 * 8 + 2 * k] * c1, vb = bf_hi(pk[k]) - o0[dt][g2 * 8 + 2 * k + 1] * c1;
        o0[dt][g2 * 8 + 2 * k] = va; o0[dt][g2 * 8 + 2 * k + 1] = vb; ss += va * va + vb * vb;
      }
    }
  ss = xhalf_sum(ss);
  const float rn = rsqrtf(ss * (1.0f / 128.0f) + 1e-6f) * p.lam[4 + layer];
  const float* gd = p.g_diff + layer * 128;
  bf16_t* yrow = p.yg + tok2 * YW + 512 + h * 128;
  const bf16_t* zrow = p.u + tok2 * UW + U_ZB + h * 128;
#pragma unroll
  for (int dt = 0; dt < 4; ++dt)
#pragma unroll
    for (int g4 = 0; g4 < 4; ++g4) {
      const int dim = dt * 32 + g4 * 8 + half2 * 4;
      const u32x2 zr = *(const u32x2*)(zrow + dim);
      const f32x4 gv = *(const f32x4*)(gd + dim);
      const float y0 = o0[dt][g4 * 4 + 0] * rn * gv[0] * silu(bf_lo(zr[0]));
      const float y1 = o0[dt][g4 * 4 + 1] * rn * gv[1] * silu(bf_hi(zr[0]));
      const float y2 = o0[dt][g4 * 4 + 2] * rn * gv[2] * silu(bf_lo(zr[1]));
      const float y3 = o0[dt][g4 * 4 + 3] * rn * gv[3] * silu(bf_hi(zr[1]));
      u32x2 pk = {cvt_pk_bf16(y0, y1), cvt_pk_bf16(y2, y3)};
      *(u32x2*)(yrow + dim) = pk;
    }
}

constexpr int LDS_AK = 0, LDS_AV = LDS_AK + 2 * KB_BYTES, LDS_ATAB = LDS_AV + 2 * KB_BYTES, ATAB_ROW = 128;
__device__ void attn_a_block(const Params& p, int layer, int L, int seq, int h, int r0, LAS unsigned char* lds) {
  const int tid = opaque_tid(), lane = tid & 63, wid = __builtin_amdgcn_readfirstlane(tid >> 6);
  const int q = lane & 31, half = lane >> 5;
  const size_t tokbase = (size_t)seq * L;
  const int rows = L >> 6;
  const int ra = r0 + (wid >> 2) * 2, c0 = (wid & 3) * 16;
  int kstart = c0 - 8; kstart = kstart < 0 ? 0 : (kstart > 32 ? 32 : kstart);
  const int qrow = ra + (q >> 4), qcol = c0 + (q & 15), tq = qrow * 64 + qcol;
  int rsq = qrow - 4; rsq = rsq < 0 ? 0 : (rsq > rows - 8 ? rows - 8 : rsq);
  int rsa = ra - 4; rsa = rsa < 0 ? 0 : (rsa > rows - 8 ? rows - 8 : rsa);
  int rsb = ra - 3; rsb = rsb < 0 ? 0 : (rsb > rows - 8 ? rows - 8 : rsb);
  int kr_lo = r0 - 4; kr_lo = kr_lo < 0 ? 0 : (kr_lo > rows - 8 ? rows - 8 : kr_lo);
  int kr_hi = r0 - 1; kr_hi = (kr_hi < 0 ? 0 : (kr_hi > rows - 8 ? rows - 8 : kr_hi)) + 7;
  int qstart = qcol - 8; qstart = qstart < 0 ? 0 : (qstart > 48 ? 48 : qstart);
  bf16x8 qf[4];
  { const bf16_t* qp = p.u + (tokbase + tq) * UW + U_QA + h * 64 + half * 8;
#pragma unroll
    for (int ks = 0; ks < 4; ++ks) qf[ks] = ld16(qp + ks * 16); }
  {
    LAS float* tab = (LAS float*)(lds + LDS_ATAB);
    const float* rpb = p.rpb + ((size_t)layer * 8 + h) * 15 * 31;
    for (int idx = tid; idx < 15 * ATAB_ROW; idx += 512) { const int row = idx >> 7, cc = (idx & 127) - 48; tab[idx] = (cc >= 0 && cc <= 30) ? rpb[row * 31 + cc] * LOG2E : 0.f; }
  }
  const int spart = tid & 7, srow = tid >> 3;
  const bf16_t* kg = p.u + (tokbase + srow) * UW + U_KA + h * 64 + spart * 8;
  const bf16_t* vg = p.vt + ((size_t)seq * VW + V_A + h * 64 + srow) * L + spart * 8;
  const int kst = srow * TB_ROW + spart * 16;
  const int vst = srow * TB_ROW + spart * 16;
  const int krd = (kstart + q) * TB_ROW + half * 16;
  const int vrd = q * TB_ROW + (kstart + half * 4) * 2;
  f32x16 o[2] = {zero16(), zero16()};
  float mrun = -1e30f, lrun = 0.f;
  bf16x8 kr_, vr_;
  kr_ = ld16(kg + (size_t)(kr_lo * 64) * UW); vr_ = ld16(vg + kr_lo * 64);
  *(LAS bf16x8*)(lds + LDS_AK + kst) = kr_;
  *(LAS bf16x8*)(lds + LDS_AV + vst) = vr_;
  asm volatile("" : "+v"(qf[0]), "+v"(qf[1]), "+v"(qf[2]), "+v"(qf[3]));
  __syncthreads();
#pragma unroll 1
  for (int kr = kr_lo; kr <= kr_hi; ++kr) {
    const int it = kr - kr_lo;
    const bool more = (kr < kr_hi);
    if (more) { kr_ = ld16(kg + (size_t)((kr + 1) * 64) * UW); vr_ = ld16(vg + (kr + 1) * 64); }
    const LAS unsigned char* kb = lds + LDS_AK + (it & 1) * KB_BYTES;
    const LAS unsigned char* vb = lds + LDS_AV + (it & 1) * KB_BYTES;
    if (kr >= rsa && kr < rsb + 8) {
      const bool rowok = (kr >= rsq) && (kr < rsq + 8);
      int trow_i = kr - qrow + 7; trow_i = trow_i < 0 ? 0 : (trow_i > 14 ? 14 : trow_i);
      const LAS float* trow = (const LAS float*)(lds + LDS_ATAB) + trow_i * ATAB_ROW + (kstart + half * 4 - qcol + 15 + 48);
      f32x16 sc = zero16();
#pragma unroll
      for (int ks = 0; ks < 4; ++ks) sc = mfma32(*(const LAS bf16x8*)(kb + krd + ks * 32), qf[ks], sc);
#pragma unroll
      for (int ii = 0; ii < 16; ++ii) {
        const int kcol = kstart + (ii >> 2) * 8 + half * 4 + (ii & 3);
        const bool ok = rowok && (kcol >= qstart) && (kcol < qstart + 16);
        sc[ii] = ok ? sc[ii] + trow[(ii >> 2) * 8 + (ii & 3)] : -INFINITY;
      }
      float al; bf16x8 pk[2];
      softmax_tile(sc, mrun, lrun, al, pk[0], pk[1]);
      if (__builtin_amdgcn_ballot_w64(al != 1.0f) != 0) { o[0] *= al; o[1] *= al; }
#pragma unroll
      for (int dt = 0; dt < 2; ++dt)
#pragma unroll
        for (int s2 = 0; s2 < 2; ++s2) {
          const LAS unsigned char* vp = vb + vrd + dt * 32 * TB_ROW + s2 * 32;
          const bf16x4 va = *(const LAS bf16x4*)vp, vc = *(const LAS bf16x4*)(vp + 16);
          o[dt] = mfma32(__builtin_shufflevector(va, vc, 0, 1, 2, 3, 4, 5, 6, 7), pk[s2], o[dt]);
        }
    }
    if (more) {
      *(LAS bf16x8*)(lds + LDS_AK + ((it + 1) & 1) * KB_BYTES + kst) = kr_;
      *(LAS bf16x8*)(lds + LDS_AV + ((it + 1) & 1) * KB_BYTES + vst) = vr_;
    }
    __syncthreads();
  }
  const float c = frcp(xhalf_sum(lrun));
  bf16_t* yrow = p.yg + (tokbase + tq) * YW + h * 64;
  const bf16_t* zrow = p.u + (tokbase + tq) * UW + U_ZA + h * 64;
#pragma unroll
  for (int dt = 0; dt < 2; ++dt)
#pragma unroll
    for (int g4 = 0; g4 < 4; ++g4) {
      const int dim = dt * 32 + g4 * 8 + half * 4;
      const u32x2 zr = *(const u32x2*)(zrow + dim);
      const float y0 = o[dt][g4 * 4 + 0] * c * silu(bf_lo(zr[0]));
      const float y1 = o[dt][g4 * 4 + 1] * c * silu(bf_hi(zr[0]));
      const float y2 = o[dt][g4 * 4 + 2] * c * silu(bf_lo(zr[1]));
      const float y3 = o[dt][g4 * 4 + 3] * c * silu(bf_hi(zr[1]));
      u32x2 pk = {cvt_pk_bf16(y0, y1), cvt_pk_bf16(y2, y3)};
      *(u32x2*)(yrow + dim) = pk;
    }
}

__device__ void attn_c_unit(const Params& p, int L, int lshift, int seq, int g, int h, int rr, int mblk, int lane) {
  const int q = lane & 31, half = lane >> 5;
  const size_t tokbase = (size_t)seq * L;
  const int ds = (g == 0) ? 0 : (g == 1 ? 2 : 4), d = 1 << ds, M = L >> ds;
  const int hh = g * 4 + h;
  const int m0 = mblk * 32, mq = m0 + q, tq = mq * d + rr;
  const bf16_t* urow = p.u + (tokbase + tq) * UW;
  bf16x8 qf[4];
#pragma unroll
  for (int ks = 0; ks < 4; ++ks) qf[ks] = ld16(urow + U_QC + hh * 64 + ks * 16 + half * 8);
  f32x16 o[2] = {zero16(), zero16()};
  float mrun = -1e30f, lrun = 0.f;
  const float coef = exp2f(-(2.0f / 3.0f) * (float)(hh + 1)) * (float)d * LOG2E;
  const bf16_t* vbase = p.vt + ((size_t)seq * VW + V_C + hh * 64 + q) * L + (size_t)rr * M;
  bf16x8 kf[5][4];
#pragma unroll
  for (int j = 0; j < 5; ++j) {
    int mkl = m0 - 64 + 32 * j + q; mkl = mkl < 0 ? 0 : (mkl > M - 1 ? M - 1 : mkl);
    const bf16_t* kp = p.u + (tokbase + (size_t)mkl * d + rr) * UW + U_KC + hh * 64 + half * 8;
#pragma unroll
    for (int ks = 0; ks < 4; ++ks) kf[j][ks] = ld16(kp + ks * 16);
  }
  bf16x8 vf[2][2][2];
  auto load_v = [&](int j, bf16x8 (&dst)[2][2]) {
#pragma unroll
    for (int dt = 0; dt < 2; ++dt)
#pragma unroll
      for (int s2 = 0; s2 < 2; ++s2) {
        int pa = m0 - 64 + 32 * j + s2 * 16 + half * 4, pb = pa + 8;
        pa = pa < 0 ? 0 : (pa > M - 4 ? M - 4 : pa); pb = pb < 0 ? 0 : (pb > M - 4 ? M - 4 : pb);
        const bf16_t* vp = vbase + (size_t)(dt * 32) * L;
        dst[dt][s2] = ld8x2(vp + pa, vp + pb);
      }
  };
  load_v(0, vf[0]);
#pragma unroll
  for (int j = 0; j < 5; ++j) {
    if (j + 1 < 5) load_v(j + 1, vf[(j + 1) & 1]);
    const int mk0 = m0 - 64 + 32 * j;
    if (mk0 + 32 <= 0 || mk0 >= M) continue;
    f32x16 s = zero16();
#pragma unroll
    for (int ks = 0; ks < 4; ++ks) s = mfma32(kf[j][ks], qf[ks], s);
#pragma unroll
    for (int ii = 0; ii < 16; ++ii) {
      const int mk = mk0 + (ii >> 2) * 8 + half * 4 + (ii & 3);
      const int rel = mk - mq; const int ar = rel < 0 ? -rel : rel;
      const bool ok = (mk >= 0) && (mk < M) && (ar <= 64);
      s[ii] = ok ? s[ii] - coef * (float)ar : -INFINITY;
    }
    float alpha; bf16x8 pk[2];
    softmax_tile(s, mrun, lrun, alpha, pk[0], pk[1]);
#pragma unroll
    for (int dt = 0; dt < 2; ++dt) {
      o[dt] *= alpha;
#pragma unroll
      for (int s2 = 0; s2 < 2; ++s2) o[dt] = mfma32(vf[j & 1][dt][s2], pk[s2], o[dt]);
    }
  }
  const float lt = xhalf_sum(lrun);
  const float c = frcp(lt);
  bf16_t* orow = p.oc + (tokbase + tq) * 768 + hh * 64;
#pragma unroll
  for (int dt = 0; dt < 2; ++dt)
#pragma unroll
    for (int g4 = 0; g4 < 4; ++g4) {
      const int dim = dt * 32 + g4 * 8 + half * 4;
      u32x2 pk = {cvt_pk_bf16(o[dt][g4 * 4 + 0] * c, o[dt][g4 * 4 + 1] * c), cvt_pk_bf16(o[dt][g4 * 4 + 2] * c, o[dt][g4 * 4 + 3] * c)};
      *(u32x2*)(orow + dim) = pk;
    }
  if (half == 0) p.lse[(tokbase + tq) * 12 + hh] = mrun + log2f(lt);
}

constexpr int CV_ROW = 784;
constexpr int LDS_CK = 0, LDS_CV = 384 * TB_ROW;
__device__ void attn_c_block(const Params& p, int L, int lshift, int seq, int g, int h, int pblk, LAS unsigned char* lds) {
  const int tid = opaque_tid(), lane = tid & 63, wid = __builtin_amdgcn_readfirstlane(tid >> 6);
  const int q = lane & 31, half = lane >> 5;
  const size_t tokbase = (size_t)seq * L;
  const int ds = (g == 0) ? 0 : (g == 1 ? 2 : 4), d = 1 << ds, M = L >> ds;
  const int hh = g * 4 + h;
  const int p0 = pblk * 256;
  {
    const int part = tid & 7;
#pragma unroll
    for (int c = 0; c < 6; ++c) {
      const int row = (tid >> 3) + c * 64;
      int pp = p0 - 64 + row; pp = pp < 0 ? 0 : (pp > L - 1 ? L - 1 : pp);
      const int tok = ((pp & (M - 1)) << ds) + (pp >> (lshift - ds));
      const bf16x8 v = ld16(p.u + (tokbase + tok) * UW + U_KC + hh * 64 + part * 8);
      *(LAS bf16x8*)(lds + LDS_CK + row * TB_ROW + part * 16) = v;
    }
#pragma unroll
    for (int c = 0; c < 6; ++c) {
      const int idx = tid + c * 512, dim = idx / 48, c8 = idx % 48;
      int pp = p0 - 64 + c8 * 8; pp = pp < 0 ? 0 : (pp > L - 8 ? L - 8 : pp);
      const bf16x8 v = ld16(p.vt + ((size_t)seq * VW + V_C + hh * 64 + dim) * L + pp);
      LAS unsigned char* dst = lds + LDS_CV + dim * CV_ROW + ((c8 >> 1) * 16 + (c8 & 1) * 4) * 2;
      *(LAS bf16x4*)dst = __builtin_shufflevector(v, v, 0, 1, 2, 3); *(LAS bf16x4*)(dst + 16) = __builtin_shufflevector(v, v, 4, 5, 6, 7);
    }
  }
  const int pw = p0 + wid * 32;
  const int rr = pw >> (lshift - ds), m0 = pw & (M - 1), mq = m0 + q, tq = mq * d + rr;
  bf16x8 qf[4];
  { const bf16_t* qp = p.u + (tokbase + tq) * UW + U_QC + hh * 64 + half * 8;
#pragma unroll
    for (int ks = 0; ks < 4; ++ks) qf[ks] = ld16(qp + ks * 16); }
  f32x16 o[2] = {zero16(), zero16()};
  float mrun = -1e30f, lrun = 0.f;
  const float coef = exp2f(-(2.0f / 3.0f) * (float)(hh + 1)) * (float)d * LOG2E;
  __syncthreads();
#pragma unroll
  for (int j = 0; j < 5; ++j) {
    const int mk0 = m0 - 64 + 32 * j;
    if (mk0 + 32 <= 0 || mk0 >= M) continue;
    const LAS unsigned char* kb = lds + LDS_CK + ((wid + j) * 32 + q) * TB_ROW + half * 16;
    f32x16 sc = zero16();
#pragma unroll
    for (int ks = 0; ks < 4; ++ks) sc = mfma32(*(const LAS bf16x8*)(kb + ks * 32), qf[ks], sc);
#pragma unroll
    for (int ii = 0; ii < 16; ++ii) {
      const int mk = mk0 + (ii >> 2) * 8 + half * 4 + (ii & 3);
      const int rel = mk - mq; const int ar = rel < 0 ? -rel : rel;
      const bool ok = (mk >= 0) && (mk < M) && (ar <= 64);
      sc[ii] = ok ? sc[ii] - coef * (float)ar : -INFINITY;
    }
    float alpha; bf16x8 pk[2];
    softmax_tile(sc, mrun, lrun, alpha, pk[0], pk[1]);
#pragma unroll
    for (int dt = 0; dt < 2; ++dt) {
      o[dt] *= alpha;
#pragma unroll
      for (int s2 = 0; s2 < 2; ++s2)
        o[dt] = mfma32(*(const LAS bf16x8*)(lds + LDS_CV + (dt * 32 + q) * CV_ROW + ((wid + j) * 32 + s2 * 16) * 2 + half * 16), pk[s2], o[dt]);
    }
  }
  __syncthreads();
  const float lt = xhalf_sum(lrun);
  const float c = frcp(lt);
  bf16_t* orow = p.oc + (tokbase + tq) * 768 + hh * 64;
#pragma unroll
  for (int dt = 0; dt < 2; ++dt)
#pragma unroll
    for (int g4 = 0; g4 < 4; ++g4) {
      const int dim = dt * 32 + g4 * 8 + half * 4;
      u32x2 pk = {cvt_pk_bf16(o[dt][g4 * 4 + 0] * c, o[dt][g4 * 4 + 1] * c), cvt_pk_bf16(o[dt][g4 * 4 + 2] * c, o[dt][g4 * 4 + 3] * c)};
      *(u32x2*)(orow + dim) = pk;
    }
  if (half == 0) p.lse[(tokbase + tq) * 12 + hh] = mrun + log2f(lt);
}

__device__ void phase_attn(const Params& p, int layer, int L, int lshift, LAS unsigned char* lds) {
  const int tiles = L >> 5;
  const int nseq = TC >> lshift;
  const int nw = gridDim.x * 8;
  int w, lane;
  { const int qblks = L >> 8, npairs = nseq * 4, nunits = npairs * qblks;
    for (int b = blockIdx.x; b < nunits; b += gridDim.x) {
      int pair, qblk;
      if ((gridDim.x & 7) == 0 && (npairs & 7) == 0 && nunits == (int)gridDim.x) { const int xcd = b & 7, j = b >> 3; pair = xcd * (npairs >> 3) + j / qblks; qblk = j % qblks; }
      else { pair = b / qblks; qblk = b % qblks; }
      attn_b_block(p, layer, L, pair >> 2, pair & 3, qblk, lds);
    }
  }
  { const int tid = opaque_tid(); lane = tid & 63; w = blockIdx.x * 8 + __builtin_amdgcn_readfirstlane(tid >> 6); }
  {
  { const int rgs = L >> 8, nunits = nseq * 8 * rgs;
    for (int b = blockIdx.x; b < nunits; b += gridDim.x) { const int sh = b / rgs, rg = b % rgs; attn_a_block(p, layer, L, sh >> 3, sh & 7, rg * 4, lds); }
  }
  { const int tid = opaque_tid(); lane = tid & 63; w = blockIdx.x * 8 + __builtin_amdgcn_readfirstlane(tid >> 6); }
  { const int pbs = L >> 8, nunits = nseq * 12 * pbs;
    for (int b = blockIdx.x; b < nunits; b += gridDim.x) {
      const int pblk = b % pbs, sgh = b / pbs;
      const int seq = sgh / 12, gh = sgh % 12;
      attn_c_block(p, L, lshift, seq, gh >> 2, gh & 3, pblk, lds);
    }
  }
  }
}

__device__ void phase_combine(const Params& p) {
  const int gt = blockIdx.x * 512 + opaque_tid(), ngt = gridDim.x * 512;
  for (int it = gt; it < TC * 32; it += ngt) {
    const int tok = it >> 5, sub = it & 31, h = sub >> 3, d8 = (sub & 7) * 8;
    const float* ls = p.lse + (size_t)tok * 12;
    const float l0 = ls[h], l1 = ls[4 + h], l2 = ls[8 + h];
    const float mx = fmaxf(l0, fmaxf(l1, l2));
    const float w0 = fexp2(l0 - mx), w1 = fexp2(l1 - mx), w2 = fexp2(l2 - mx);
    const float inv = frcp(w0 + w1 + w2);
    const bf16_t* ob = p.oc + (size_t)tok * 768 + h * 64 + d8;
    const u32x4 a = *(const u32x4*)ob, b = *(const u32x4*)(ob + 256), c = *(const u32x4*)(ob + 512);
    const u32x4 z = *(const u32x4*)(p.u + (size_t)tok * UW + U_ZC + h * 64 + d8);
    u32x4 r;
#pragma unroll
    for (int k = 0; k < 4; ++k) {
      const float vlo = (w0 * bf_lo(a[k]) + w1 * bf_lo(b[k]) + w2 * bf_lo(c[k])) * inv * silu(bf_lo(z[k]));
      const float vhi = (w0 * bf_hi(a[k]) + w1 * bf_hi(b[k]) + w2 * bf_hi(c[k])) * inv * silu(bf_hi(z[k]));
      r[k] = cvt_pk_bf16(vlo, vhi);
    }
    *(u32x4*)(p.yg + (size_t)tok * YW + 1024 + h * 64 + d8) = r;
  }
}


#define XB_TMO      128
#define XB_XCNT(j)  (256  + 64 * (j))
#define XB_XSUB(j)  (1280 + 64 * (j))
#define XB_XGEN(j)  (2304 + 64 * (j))
#define XB_TOP      3328
#define XB_TOPGEN   3392
#define XCD_BAR_WORDS 3456
#define XB_SPIN_CAP (1u << 18)
__device__ __forceinline__ unsigned xb_ld(unsigned* p)              { return __hip_atomic_load(p, __ATOMIC_RELAXED, __HIP_MEMORY_SCOPE_AGENT); }
__device__ __forceinline__ unsigned xb_add(unsigned* p, unsigned v) { return __hip_atomic_fetch_add(p, v, __ATOMIC_RELAXED, __HIP_MEMORY_SCOPE_AGENT); }
__device__ __forceinline__ unsigned xb_xcc_id() { return (unsigned)__builtin_amdgcn_s_getreg((3 << 11) | 20) & 0xFu; }
#define XB_SPIN(cond, bar) do { unsigned _sp = 0; while (cond) { __builtin_amdgcn_s_sleep(1); \
    if ((++_sp & 255u) == 0u) { if (xb_ld(&(bar)[XB_TMO])) break; if (_sp > XB_SPIN_CAP) { atomicAdd(&(bar)[XB_TMO], 1u); break; } } } } while (0)
struct XcdBarrier { unsigned* bar; unsigned x; volatile LAS unsigned* st; };
__device__ __forceinline__ XcdBarrier xcd_barrier_post(unsigned* bar, volatile LAS unsigned* st) {
  XcdBarrier b; b.bar = bar; b.x = xb_xcc_id(); b.st = st;
  if (opaque_tid() == 0) (void)xb_add(&bar[XB_XCNT(b.x)], 1u);
  return b;
}
__device__ __forceinline__ void xcd_barrier_complete(unsigned* bar, unsigned x, unsigned& nloc, unsigned& nx) {
  const unsigned G = gridDim.x * gridDim.y * gridDim.z;
  unsigned sum, cnt, mine, sp = 0u;
  for (;;) {
    sum = 0u; cnt = 0u; mine = 0u;
#pragma unroll
    for (unsigned j = 0; j < 16; ++j) { const unsigned c = xb_ld(&bar[XB_XCNT(j)]); sum += c; cnt += (c > 0u) ? 1u : 0u; mine = (j == x) ? c : mine; }
    if (sum == G) break;
    __builtin_amdgcn_s_sleep(1);
    if ((++sp & 255u) == 0u) { if (xb_ld(&bar[XB_TMO])) break; if (sp > XB_SPIN_CAP) { atomicAdd(&bar[XB_TMO], 1u); break; } }
  }
  nloc = mine > 0u ? mine : 1u; nx = cnt > 0u ? cnt : 1u;
}
__device__ __forceinline__ void xcd_barrier(const XcdBarrier& b) {
  asm volatile("s_waitcnt vmcnt(0)" ::: "memory");
  __syncthreads();
  if (opaque_tid() == 0) {
    unsigned* bar = b.bar;
    __builtin_amdgcn_s_waitcnt(0);
    unsigned nloc = b.st[0], nx = b.st[1];
    if (nloc == 0u) { xcd_barrier_complete(bar, b.x, nloc, nx); b.st[0] = nloc; b.st[1] = nx; }
    const unsigned old = xb_add(&bar[XB_XSUB(b.x)], 1u);
    const unsigned gen = old / nloc;
    if (old + 1u == (gen + 1u) * nloc) {
      __builtin_amdgcn_fence(__ATOMIC_RELEASE, "agent");
      asm volatile("s_waitcnt vmcnt(0)" ::: "memory");
      const unsigned og = xb_add(&bar[XB_TOP], 1u);
      const unsigned tg = og / nx;
      if (og + 1u == (tg + 1u) * nx) xb_add(&bar[XB_TOPGEN], 1u);
      else XB_SPIN(xb_ld(&bar[XB_TOPGEN]) == tg, bar);
      __builtin_amdgcn_fence(__ATOMIC_ACQUIRE, "agent");
      xb_add(&bar[XB_XGEN(b.x)], 1u);
      asm volatile("s_waitcnt vmcnt(0)" ::: "memory");
    } else {
      XB_SPIN(xb_ld(&bar[XB_XGEN(b.x)]) == gen, bar);
      __builtin_amdgcn_fence(__ATOMIC_ACQUIRE, "agent");
      asm volatile("s_waitcnt vmcnt(0)" ::: "memory");
    }
  }
  __syncthreads();
}

constexpr int DYN_LDS_BYTES = LDS_ATT_TOTAL > pg8::STAGE_BYTES ? LDS_ATT_TOTAL : pg8::STAGE_BYTES;
__global__ void __launch_bounds__(512) fwd_megakernel(Params p) {
  extern __shared__ __attribute__((aligned(16))) unsigned char smem[];
  __shared__ __attribute__((aligned(16))) unsigned xb_words[4];
  cg::grid_group grid = cg::this_grid();
  if (threadIdx.x == 0) { xb_words[0] = 0u; xb_words[1] = 0u; xb_words[2] = 0u; xb_words[3] = 0u; }
  if ((threadIdx.x & 63) == 0) g_wid_table[hw_wave_slot()] = (int)(threadIdx.x >> 6);
  __syncthreads();
  const XcdBarrier xb = xcd_barrier_post(p.bar, (volatile LAS unsigned*)xb_words);
#define GSYNC() xcd_barrier(xb)
  LAS unsigned char* lds = (LAS unsigned char*)smem;
  phase_prep(p, (LAS float*)smem);
  phase_x(p, 0);
  grid.sync();
  for (int chunk = 0; chunk < NCHUNK; ++chunk) {
    const int L = chunk < 2 ? 2048 : 4096, lshift = chunk < 2 ? 11 : 12;
    const float* xin = (chunk < 2) ? p.xp + (size_t)chunk * TC * DM : p.xs + (size_t)(chunk - 2) * TC * DM;
    float* xres = p.out + (size_t)chunk * TC * DM;
    float* ssq = p.ssq + (size_t)chunk * TC * 16;
    for (int layer = 0; layer < DEPTH; ++layer) {
      {
        {
        { pg8::Gemm g{p.xb, p.wt_in + (size_t)layer * INW * DM, TC, UW, DM, 0, lshift};
          pg8::StaticOrder S; S.init(TC, UW, gridDim.x, blockIdx.x);
          EpiU E{p.u, p.rinv + (size_t)chunk * TC, p.b_gate + (size_t)layer * 3 * DM};
          pg8::gemm_phase<false>(lds, g, S, E); }
        {
          pg8::Gemm g{p.wt_in + ((size_t)layer * INW + UW) * DM, p.xb, VW, TC, DM, 1, lshift};
          pg8::StaticOrder S; S.init(VW, TC, gridDim.x, (blockIdx.x + (gridDim.x >> 2)) % gridDim.x);
          EpiVT E{p.vt, p.rinv + (size_t)chunk * TC, L, lshift};
          pg8::gemm_phase<true>(lds, g, S, E); }
        }
      }
      GSYNC();
      phase_attn(p, layer, L, lshift, lds);
      GSYNC();
      phase_combine(p);
      GSYNC();
      {
        pg8::Gemm g{p.yg, p.wt_br + (size_t)layer * DM * YW, TC, DM, YW, 0, 0};
        pg8::StaticOrder S; S.init(TC, DM, gridDim.x, blockIdx.x);
        EpiMerge E{p.u, p.merged};
        pg8::gemm_phase<false>(lds, g, S, E);
      }
      GSYNC();
      {
        pg8::Gemm g{p.merged, p.wt_out + (size_t)layer * DM * DM, TC, DM, DM, 0, 0};
        pg8::StaticOrder S; S.init(TC, DM, gridDim.x, blockIdx.x);
        EpiRes E{layer == 0 ? xin : (const float*)nullptr, p.xb, layer == DEPTH - 1 ? xres : (float*)nullptr, p.xb, ssq};
        pg8::gemm_phase<false>(lds, g, S, E);
      }
      GSYNC();
      if (layer + 1 < DEPTH) { phase_rinv(p, chunk); GSYNC(); }
    }
    phase_final(p, chunk);
    if (chunk + 1 < NCHUNK) { phase_x(p, chunk + 1); GSYNC(); }
  }
}

extern "C" void kernel_launch(void* const* d_in, const int* in_sizes, int n_in, void* d_out, int out_size, void* d_ws, size_t ws_size, hipStream_t stream) {
  (void)in_sizes; (void)n_in; (void)out_size;
  static int grid_blocks = 0;
  if (!grid_blocks) {
    int dev = 0, cus = 0, per_cu = 0;
    hipGetDevice(&dev);
    hipDeviceGetAttribute(&cus, hipDeviceAttributeMultiprocessorCount, dev);
    hipFuncSetAttribute((const void*)fwd_megakernel, hipFuncAttributeMaxDynamicSharedMemorySize, DYN_LDS_BYTES);
    hipOccupancyMaxActiveBlocksPerMultiprocessor(&per_cu, fwd_megakernel, 512, DYN_LDS_BYTES);
    if (per_cu < 1) per_cu = 1;
    grid_blocks = cus * per_cu;
    if (grid_blocks > 256) grid_blocks = 256;
  }
  Params p{};
  p.xp = (const float*)d_in[0]; p.xs = (const float*)d_in[1]; p.g_norm = (const float*)d_in[2]; p.w_in = (const float*)d_in[3];
  p.b_gate = (const float*)d_in[4]; p.rpb = (const float*)d_in[5]; p.lam_qk = (const float*)d_in[6]; p.g_diff = (const float*)d_in[7];
  p.w_br_a = (const float*)d_in[8]; p.w_br_b = (const float*)d_in[9]; p.w_br_c = (const float*)d_in[10]; p.w_out = (const float*)d_in[11];
  p.g_final = (const float*)d_in[12];
  p.out = (float*)d_out;
  char* w = (char*)d_ws; size_t off = 0;
  auto take = [&](size_t bytes) { char* r = w + off; off += (bytes + 255) & ~(size_t)255; return r; };
  p.wt_in = (bf16_t*)take((size_t)DEPTH * INW * DM * 2);
  p.wt_br = (bf16_t*)take((size_t)DEPTH * DM * YW * 2);
  p.wt_out = (bf16_t*)take((size_t)DEPTH * DM * DM * 2);
  p.xb = (bf16_t*)take((size_t)TC * DM * 2);
  p.u = (bf16_t*)take((size_t)TC * UW * 2);
  p.vt = (bf16_t*)take((size_t)TC * VW * 2);
  p.yg = (bf16_t*)take((size_t)TC * YW * 2);
  p.oc = (bf16_t*)take((size_t)TC * 768 * 2);
  p.merged = (bf16_t*)take((size_t)TC * DM * 2);
  p.lse = (float*)take((size_t)TC * 12 * 4);
  p.ssq = (float*)take((size_t)NTOK * 16 * 4);
  p.lam = (float*)take(256);
  p.rinv = (float*)take((size_t)NTOK * 4);
  p.bar = (unsigned*)take((size_t)XCD_BAR_WORDS * 4);
  if (off > ws_size) fprintf(stderr, "workspace too small: need %zu have %zu\n", off, ws_size);
  hipMemsetAsync(p.bar, 0, (size_t)XCD_BAR_WORDS * 4, stream);
  void* args[] = {&p};
  hipError_t e = hipLaunchCooperativeKernel((void*)fwd_megakernel, dim3(grid_blocks), dim3(512), args, DYN_LDS_BYTES, stream);
  if (e != hipSuccess) fprintf(stderr, "cooperative launch failed: %s (grid %d)\n", hipGetErrorString(e), grid_blocks);
}
```

```cpp
#include <hip/hip_runtime.h>
#include <hip/hip_cooperative_groups.h>
#include <cstdio>
namespace cg = cooperative_groups;

#define LAS __attribute__((address_space(3)))
typedef unsigned short bf16_t;
typedef short bf16x8 __attribute__((ext_vector_type(8)));
typedef short bf16x4 __attribute__((ext_vector_type(4)));
typedef float f32x4 __attribute__((ext_vector_type(4)));
typedef float f32x16 __attribute__((ext_vector_type(16)));
typedef unsigned u32x4 __attribute__((ext_vector_type(4)));
typedef unsigned u32x2 __attribute__((ext_vector_type(2)));

constexpr int DM = 1024, DEPTH = 4, INW = 9728, UW = 7936, VW = 1792, YW = 1280;
constexpr int TC = 16384, NCHUNK = 4, NTOK = 65536;
constexpr float LOG2E = 1.4426950408889634f;
constexpr float QSCALE = 0.125f * LOG2E;
constexpr int U_QA = 0, U_KA = 512, U_ZA = 1024, U_QB = 1536, U_KB = 2048, U_ZB = 2560, U_QC = 3072, U_KC = 3840, U_ZC = 4608, U_GL = 4864;
constexpr int V_A = 0, V_B = 512, V_C = 1024;

struct Params {
  const float *xp, *xs, *g_norm, *w_in, *b_gate, *rpb, *lam_qk, *g_diff, *w_br_a, *w_br_b, *w_br_c, *w_out, *g_final;
  float* out;
  bf16_t *wt_in, *wt_br, *wt_out, *xb, *u, *vt, *yg, *oc, *merged;
  float *lse, *ssq, *lam, *rinv;
  unsigned* bar;
};

__device__ __forceinline__ unsigned cvt_pk_bf16(float lo, float hi) { unsigned r; asm volatile("v_cvt_pk_bf16_f32 %0, %1, %2" : "=v"(r) : "v"(lo), "v"(hi)); return r; }
__device__ __forceinline__ float bf_lo(unsigned v) { return __uint_as_float(v << 16); }
__device__ __forceinline__ float bf_hi(unsigned v) { return __uint_as_float(v & 0xffff0000u); }
__device__ __forceinline__ float fexp2(float x) { return __builtin_amdgcn_exp2f(x); }
__device__ __forceinline__ float frcp(float x) { return __builtin_amdgcn_rcpf(x); }

__shared__ int g_wid_table[64];
__device__ __forceinline__ unsigned hw_wave_slot() { return (unsigned)__builtin_amdgcn_s_getreg(((6 - 1) << 11) | (0 << 6) | 4) & 63u; }
__device__ __forceinline__ int opaque_tid() {
  const int wid = __builtin_amdgcn_readfirstlane(g_wid_table[hw_wave_slot()]);
  unsigned z = 0u; asm volatile("" : "+v"(z));
  int t = wid * 64 + (int)__builtin_amdgcn_mbcnt_hi(~0u, __builtin_amdgcn_mbcnt_lo(~0u, z));
  asm volatile("" : "+v"(t)); return t;
}

namespace pg8 {
constexpr int BM = 256, BK = 64, HALF = 128, HTB = HALF * BK * 2, STAGE_BYTES = 8 * HTB, NXCD = 8, WGM = 4;
__device__ __forceinline__ int lds_byte(int r, int c) { const int st = (r >> 4) * 2 + (c >> 5), rr = r & 15, cc = c & 31, ob = rr * 64 + cc * 2; return st * 1024 + (ob ^ (((ob >> 9) & 1) << 5)); }
__device__ __forceinline__ void stage_rc(int b, int& R, int& C) { const int st = b / 1024, sb = b % 1024, swz = sb ^ (((sb >> 9) & 1) << 5); R = (st >> 1) * 16 + swz / 64; C = (st & 1) * 32 + (swz % 64) / 2; }
__device__ __forceinline__ int perm32(int rho) { const int n = rho >> 4, i = rho & 15; return 8 * (i >> 2) + 4 * n + (i & 3); }
struct Unit { int pm, pn; };
struct Gemm { const bf16_t* A; const bf16_t* Bt; int M, N, K; int bperm, lshift; };
struct StaticOrder {
  int nM, nN, nwg, G, c;
  __device__ void init(int M, int N, int G_, int c_) { nM = M / BM; nN = N / BM; nwg = nM * nN; G = G_; c = c_; }
  __device__ bool next(int i, Unit& u) const {
    const long L = (long)i * G + c; if (L >= nwg) return false;
    int wgid = (int)L; { const int q = nwg / NXCD, r = nwg % NXCD, xcd = wgid % NXCD, off = wgid / NXCD; wgid = (xcd < r ? xcd * (q + 1) : r * (q + 1) + (xcd - r) * q) + off; }
    const int nig = WGM * nN, gid = wgid / nig, fm = gid * WGM, gsz = (nM - fm) < WGM ? (nM - fm) : WGM;
    u.pm = fm + ((wgid % nig) % gsz); u.pn = (wgid % nig) / gsz; return true;
  }
};

template <bool BPERM, class Epi>
__device__ __forceinline__ void gemm_phase(LAS unsigned char* lds, const Gemm g, const StaticOrder& S, const Epi& E) {
  const int tid_ = opaque_tid();
  const int tid = tid_, wid = __builtin_amdgcn_readfirstlane(tid >> 6), lane = tid & 63, wr = wid >> 2, wc = wid & 3, fr = lane & 15, fq = lane >> 4;
  const int K = g.K, nt = K / BK;
  const size_t kstep = (size_t)(BK * 2);
  const size_t hstep = (size_t)HALF * K * 2;
  const size_t tstep = 2 * hstep;
  unsigned voffA[2], voffBr[2], voffBc[2], voffB[2], voffBn[2];
#pragma unroll
  for (int i = 0; i < 2; ++i) { int R, C; stage_rc(tid * 16 + i * 8192, R, C); const int Rb = (R & ~31) + perm32(R & 31);
    voffA[i] = (unsigned)(R * K + C) * 2u; voffBr[i] = (unsigned)(Rb * K) * 2u; voffBc[i] = (unsigned)C * 2u; voffB[i] = voffBr[i] + voffBc[i]; voffBn[i] = voffB[i]; }
  auto bbase = [&](const Unit& u, int hh, int& sh) -> const char* {
    if constexpr (!BPERM) { sh = 0; return (const char*)g.Bt + (size_t)u.pn * tstep + (size_t)hh * hstep; }
    const int ds = u.pm <= 4 ? 0 : (u.pm == 5 ? 2 : 4); sh = ds;
    const int L = 1 << g.lshift; const int p0 = u.pn * 256 + hh * 128, seq = p0 >> g.lshift, p = p0 & (L - 1);
    const int Mc = L >> ds, r = p / Mc, m0 = p & (Mc - 1);
    return (const char*)g.Bt + ((size_t)seq * L + ((size_t)m0 << ds) + r) * (size_t)K * 2;
  };
  const unsigned ldsw = (unsigned)wid * 1024u;
  const int aoff = lds_byte(wr * 64 + fr, fq * 8), boff = lds_byte(wc * 32 + fr, fq * 8);
#define PG8_SA(b, h) (((b) * 2 + (h)) * HTB)
#define PG8_SB(b, h) ((4 + (b) * 2 + (h)) * HTB)
#define PG8_STAGE(bufoff, gbase, voff) do { _Pragma("unroll") for (int _i = 0; _i < 2; ++_i) \
    __builtin_amdgcn_global_load_lds((const unsigned*)((const char*)(gbase) + (voff)[_i]), (LAS unsigned*)(lds + (bufoff) + ldsw + _i * 8192), 16, 0, 0); } while (0)
#define PG8_LDA(dst, b, h) do { _Pragma("unroll") for (int m = 0; m < 4; ++m) _Pragma("unroll") for (int k = 0; k < 2; ++k) dst[m][k] = *(const LAS bf16x8*)(lds + PG8_SA(b, h) + aoff + m * 2048 + k * 1024); } while (0)
#define PG8_LDB(dst, b, h) do { _Pragma("unroll") for (int n = 0; n < 2; ++n) _Pragma("unroll") for (int k = 0; k < 2; ++k) dst[n][k] = *(const LAS bf16x8*)(lds + PG8_SB(b, h) + boff + n * 2048 + k * 1024); } while (0)
#define PG8_MMA(ai, bj, At, Bt) do { __builtin_amdgcn_s_setprio(1); _Pragma("unroll") for (int m = 0; m < 4; ++m) _Pragma("unroll") for (int n = 0; n < 2; ++n) _Pragma("unroll") for (int k = 0; k < 2; ++k) \
    acc[ai][bj][m][n] = __builtin_amdgcn_mfma_f32_16x16x32_bf16(Bt[n][k], At[m][k], acc[ai][bj][m][n], 0, 0, 0); __builtin_amdgcn_s_setprio(0); } while (0)
#define PG8_WAIT_V(n) asm volatile("s_waitcnt vmcnt(" #n ")" ::: "memory")
#define PG8_WAIT_L(n) asm volatile("s_waitcnt lgkmcnt(" #n ")" ::: "memory")
#define PG8_BAR __builtin_amdgcn_s_barrier()
#define PG8_SCHED __builtin_amdgcn_sched_barrier(0)
  Unit cur, nxt; int ui = 0;
  if (!S.next(0, cur)) return;
  f32x4 acc[2][2][4][2];
#pragma unroll
  for (int a = 0; a < 2; ++a)
#pragma unroll
    for (int b = 0; b < 2; ++b)
#pragma unroll
      for (int m = 0; m < 4; ++m)
#pragma unroll
        for (int n = 0; n < 2; ++n) acc[a][b][m][n] = (f32x4){0.f, 0.f, 0.f, 0.f};
  bf16x8 At[4][2], B0[2][2], B1[2][2];
  const char* cA = (const char*)g.A + (size_t)cur.pm * tstep;
  int csh; const char* cB0 = bbase(cur, 0, csh); const char* cB1 = bbase(cur, 1, csh);
#pragma unroll
  for (int i = 0; i < 2; ++i) voffB[i] = (voffBr[i] << csh) + voffBc[i];
  PG8_STAGE(PG8_SB(0, 0), cB0, voffB); PG8_STAGE(PG8_SA(0, 0), cA, voffA); PG8_STAGE(PG8_SB(0, 1), cB1, voffB); PG8_STAGE(PG8_SA(0, 1), cA + hstep, voffA);
  if (wr == 1) PG8_BAR;
  PG8_WAIT_V(4); PG8_BAR;
  PG8_STAGE(PG8_SB(1, 0), cB0 + kstep, voffB); PG8_STAGE(PG8_SA(1, 0), cA + kstep, voffA); PG8_STAGE(PG8_SB(1, 1), cB1 + kstep, voffB);
  PG8_WAIT_V(6); PG8_BAR;
  for (;;) {
    const bool has_next = S.next(ui + 1, nxt);
    const char* nA = cA; const char* nB0 = cB0; const char* nB1 = cB1;
#pragma unroll
    for (int i = 0; i < 2; ++i) voffBn[i] = voffB[i];
    if (has_next) { int nsh; nA = (const char*)g.A + (size_t)nxt.pm * tstep; nB0 = bbase(nxt, 0, nsh); nB1 = bbase(nxt, 1, nsh);
#pragma unroll
      for (int i = 0; i < 2; ++i) voffBn[i] = (voffBr[i] << nsh) + voffBc[i]; }
    auto kiter = [&](int t) __attribute__((always_inline)) {
      const bool last = (t == nt - 2);
      const char* a1 = cA + (size_t)(t + 1) * kstep;
      const char* a2 = last ? nA : cA + (size_t)(t + 2) * kstep;
      const char* b20 = last ? nB0 : cB0 + (size_t)(t + 2) * kstep; const char* b21 = last ? nB1 : cB1 + (size_t)(t + 2) * kstep;
      const char* a3 = a2 + kstep; const char* b30 = b20 + kstep; const char* b31 = b21 + kstep;
      unsigned vB[2];
#pragma unroll
      for (int i = 0; i < 2; ++i) vB[i] = BPERM ? (last ? voffBn[i] : voffB[i]) : voffB[i];
      PG8_LDB(B0, 0, 0); PG8_SCHED; PG8_LDA(At, 0, 0); PG8_STAGE(PG8_SA(1, 1), a1 + hstep, voffA);
      PG8_WAIT_L(8); PG8_BAR; PG8_WAIT_L(0); PG8_MMA(0, 0, At, B0); PG8_BAR; PG8_SCHED;
      PG8_LDB(B1, 0, 1); PG8_STAGE(PG8_SB(0, 0), b20, vB);
      PG8_BAR; PG8_WAIT_L(0); PG8_MMA(0, 1, At, B1); PG8_BAR;
      PG8_LDA(At, 0, 1); PG8_STAGE(PG8_SA(0, 0), a2, voffA);
      PG8_BAR; PG8_WAIT_L(0); PG8_MMA(1, 0, At, B0); PG8_BAR; PG8_SCHED;
      PG8_STAGE(PG8_SB(0, 1), b21, vB);
      PG8_WAIT_V(6); PG8_BAR; PG8_MMA(1, 1, At, B1); PG8_BAR;
      PG8_LDB(B0, 1, 0); PG8_SCHED; PG8_LDA(At, 1, 0); PG8_STAGE(PG8_SA(0, 1), a2 + hstep, voffA);
      PG8_WAIT_L(8); PG8_BAR; PG8_WAIT_L(0); PG8_MMA(0, 0, At, B0); PG8_BAR; PG8_SCHED;
      PG8_LDB(B1, 1, 1); PG8_STAGE(PG8_SB(1, 0), b30, vB);
      PG8_BAR; PG8_WAIT_L(0); PG8_MMA(0, 1, At, B1); PG8_BAR;
      PG8_LDA(At, 1, 1); PG8_STAGE(PG8_SA(1, 0), a3, voffA);
      PG8_BAR; PG8_WAIT_L(0); PG8_MMA(1, 0, At, B0); PG8_BAR; PG8_SCHED;
      PG8_STAGE(PG8_SB(1, 1), b31, vB);
      PG8_WAIT_V(6); PG8_BAR; PG8_MMA(1, 1, At, B1); PG8_BAR;
    };
    if constexpr (Epi::HOOK) {
#pragma unroll 1
      for (int seg = 0; seg < 3; ++seg) {
        const int tb = seg * 8, te = seg == 2 ? nt : tb + 8;
#pragma unroll 1
        for (int t = tb; t < te; t += 2) kiter(t);
        if (seg < 2) E.hook(acc, cur, te, wr, wc, fr, fq);
      }
    } else {
      for (int t = 0; t < nt; t += 2) kiter(t);
    }
    E(acc, cur, wr, wc, fr, fq);
    if (!has_next) break;
#pragma unroll
    for (int a = 0; a < 2; ++a)
#pragma unroll
      for (int b = 0; b < 2; ++b)
#pragma unroll
        for (int m = 0; m < 4; ++m)
#pragma unroll
          for (int n = 0; n < 2; ++n) acc[a][b][m][n] = (f32x4){0.f, 0.f, 0.f, 0.f};
    cur = nxt; cA = nA; cB0 = nB0; cB1 = nB1; ++ui;
#pragma unroll
    for (int i = 0; i < 2; ++i) voffB[i] = voffBn[i];
  }
  PG8_WAIT_V(0);
  if (wr == 0) PG8_BAR;
  PG8_BAR;
#undef PG8_SA
#undef PG8_SB
#undef PG8_STAGE
#undef PG8_LDA
#undef PG8_LDB
#undef PG8_MMA
#undef PG8_WAIT_V
#undef PG8_WAIT_L
#undef PG8_BAR
#undef PG8_SCHED
}
}
using pg8::Unit;

struct EpiU {
  static constexpr bool HOOK = false;
  bf16_t* U; const float* rinv; const float* bg;
  __device__ __forceinline__ void hook(f32x4 (&)[2][2][4][2], const Unit&, int, int, int, int, int) const {}
  __device__ __forceinline__ void operator()(const f32x4 (&acc)[2][2][4][2], const Unit& u, int wr, int wc, int fr, int fq) const {
    asm volatile("" : "+v"(fr), "+v"(fq));
    const int row0 = u.pm * 256 + wr * 64 + fr, col0 = u.pn * 256 + wc * 32 + 8 * fq;
    const bool isg = (u.pn >= 19);
    float ri[2][4];
#pragma unroll
    for (int ai = 0; ai < 2; ++ai)
#pragma unroll
      for (int m = 0; m < 4; ++m) ri[ai][m] = rinv[row0 + ai * 128 + m * 16];
    if (isg) {
      f32x4 b[2][2];
#pragma unroll
      for (int bj = 0; bj < 2; ++bj) { const float* bp = bg + (col0 - U_GL) + bj * 128; b[bj][0] = *(const f32x4*)bp; b[bj][1] = *(const f32x4*)(bp + 4); }
#pragma unroll
      for (int ai = 0; ai < 2; ++ai)
#pragma unroll
        for (int m = 0; m < 4; ++m)
#pragma unroll
          for (int bj = 0; bj < 2; ++bj) {
            f32x4 v0 = acc[ai][bj][m][0] * ri[ai][m] + b[bj][0], v1 = acc[ai][bj][m][1] * ri[ai][m] + b[bj][1];
#pragma unroll
            for (int j = 0; j < 4; ++j) { v0[j] = 1.0f + fminf(fexp2(-v0[j] * LOG2E), 1e30f); v1[j] = 1.0f + fminf(fexp2(-v1[j] * LOG2E), 1e30f); }
            u32x4 pk = {cvt_pk_bf16(v0[0], v0[1]), cvt_pk_bf16(v0[2], v0[3]), cvt_pk_bf16(v1[0], v1[1]), cvt_pk_bf16(v1[2], v1[3])};
            __builtin_nontemporal_store(pk, (u32x4*)(U + (size_t)(row0 + ai * 128 + m * 16) * UW + col0 + bj * 128));
          }
    } else {
#pragma unroll
      for (int ai = 0; ai < 2; ++ai)
#pragma unroll
        for (int m = 0; m < 4; ++m)
#pragma unroll
          for (int bj = 0; bj < 2; ++bj) {
            const f32x4 v0 = acc[ai][bj][m][0] * ri[ai][m], v1 = acc[ai][bj][m][1] * ri[ai][m];
            u32x4 pk = {cvt_pk_bf16(v0[0], v0[1]), cvt_pk_bf16(v0[2], v0[3]), cvt_pk_bf16(v1[0], v1[1]), cvt_pk_bf16(v1[2], v1[3])};
            __builtin_nontemporal_store(pk, (u32x4*)(U + (size_t)(row0 + ai * 128 + m * 16) * UW + col0 + bj * 128));
          }
    }
  }
};

struct EpiVT {
  static constexpr bool HOOK = false;
  bf16_t* VT; const float* rv; int L, lshift;
  __device__ __forceinline__ void hook(f32x4 (&)[2][2][4][2], const Unit&, int, int, int, int, int) const {}
  __device__ __forceinline__ void operator()(const f32x4 (&acc)[2][2][4][2], const Unit& u, int wr, int wc, int fr, int fq) const {
    asm volatile("" : "+v"(fr), "+v"(fq));
    const int vrow0 = u.pm * 256 + wr * 64 + fr, pcol0 = u.pn * 256 + wc * 32 + 8 * fq;
    const int ds = u.pm <= 4 ? 0 : (u.pm == 5 ? 2 : 4);
    const int Mc = L >> ds;
#pragma unroll
    for (int bj = 0; bj < 2; ++bj) {
      const int p0 = pcol0 + bj * 128, seq = p0 >> lshift, pos = p0 & (L - 1);
      const int r = pos / Mc, m0 = pos & (Mc - 1);
      float rinv[8];
#pragma unroll
      for (int j = 0; j < 8; ++j) rinv[j] = rv[(seq << lshift) + ((m0 + j) << ds) + r];
      bf16_t* vb = VT + ((size_t)seq * VW + vrow0) * L + pos;
#pragma unroll
      for (int ai = 0; ai < 2; ++ai)
#pragma unroll
        for (int m = 0; m < 4; ++m) {
          const f32x4 v0 = acc[ai][bj][m][0], v1 = acc[ai][bj][m][1];
          u32x4 pk = {cvt_pk_bf16(v0[0] * rinv[0], v0[1] * rinv[1]), cvt_pk_bf16(v0[2] * rinv[2], v0[3] * rinv[3]),
                      cvt_pk_bf16(v1[0] * rinv[4], v1[1] * rinv[5]), cvt_pk_bf16(v1[2] * rinv[6], v1[3] * rinv[7])};
          __builtin_nontemporal_store(pk, (u32x4*)(vb + (size_t)(ai * 128 + m * 16) * L));
        }
    }
  }
};

struct EpiMerge {
  static constexpr bool HOOK = true;
  const bf16_t* U; bf16_t* MG;
  __device__ __forceinline__ f32x4 gvec(int i, size_t row, int col) const {
    const u32x2 raw = *(const u32x2*)(U + row * UW + U_GL + i * 1024 + col);
    f32x4 e; e[0] = bf_lo(raw[0]); e[1] = bf_hi(raw[0]); e[2] = bf_lo(raw[1]); e[3] = bf_hi(raw[1]); return e;
  }
  __device__ __forceinline__ void hook(f32x4 (&acc)[2][2][4][2], const Unit& u, int t, int wr, int wc, int fr, int fq) const {
    const int i = (t == 8) ? 0 : 1;
    asm volatile("" : "+v"(fr), "+v"(fq));
    const int row0 = u.pm * 256 + wr * 64 + fr, col0 = u.pn * 256 + wc * 32 + 8 * fq;
#pragma unroll
    for (int ai = 0; ai < 2; ++ai) {
#pragma unroll
      for (int m = 0; m < 4; ++m)
#pragma unroll
        for (int bj = 0; bj < 2; ++bj) {
          const bf16_t* gp = U + (size_t)(row0 + ai * 128 + m * 16) * UW + U_GL + i * 1024 + col0 + bj * 128;
          const u32x4 a = *(const u32x4*)gp, b = *(const u32x4*)(gp + 1024);
#pragma unroll
          for (int n = 0; n < 2; ++n) {
            f32x4 r;
            r[0] = bf_lo(b[2 * n]) * frcp(bf_lo(a[2 * n])); r[1] = bf_hi(b[2 * n]) * frcp(bf_hi(a[2 * n]));
            r[2] = bf_lo(b[2 * n + 1]) * frcp(bf_lo(a[2 * n + 1])); r[3] = bf_hi(b[2 * n + 1]) * frcp(bf_hi(a[2 * n + 1]));
            acc[ai][bj][m][n] *= r;
          }
        }
      __builtin_amdgcn_sched_barrier(0);
    }
  }
  __device__ __forceinline__ void operator()(const f32x4 (&acc)[2][2][4][2], const Unit& u, int wr, int wc, int fr, int fq) const {
    asm volatile("" : "+v"(fr), "+v"(fq));
    const int row0 = u.pm * 256 + wr * 64 + fr, col0 = u.pn * 256 + wc * 32 + 8 * fq;
    u32x4 g2[2][4][2];
#pragma unroll
    for (int ai = 0; ai < 2; ++ai)
#pragma unroll
      for (int m = 0; m < 4; ++m)
#pragma unroll
        for (int bj = 0; bj < 2; ++bj) g2[ai][m][bj] = *(const u32x4*)(U + (size_t)(row0 + ai * 128 + m * 16) * UW + U_GL + 2 * 1024 + col0 + bj * 128);
    __builtin_amdgcn_sched_barrier(0);
#pragma unroll
    for (int ai = 0; ai < 2; ++ai)
#pragma unroll
      for (int m = 0; m < 4; ++m)
#pragma unroll
        for (int bj = 0; bj < 2; ++bj) {
          const size_t row = (size_t)(row0 + ai * 128 + m * 16); const int col = col0 + bj * 128;
          const u32x4 g = g2[ai][m][bj];
          f32x4 v0 = acc[ai][bj][m][0], v1 = acc[ai][bj][m][1];
          v0[0] *= frcp(bf_lo(g[0])); v0[1] *= frcp(bf_hi(g[0])); v0[2] *= frcp(bf_lo(g[1])); v0[3] *= frcp(bf_hi(g[1]));
          v1[0] *= frcp(bf_lo(g[2])); v1[1] *= frcp(bf_hi(g[2])); v1[2] *= frcp(bf_lo(g[3])); v1[3] *= frcp(bf_hi(g[3]));
          u32x4 pk = {cvt_pk_bf16(v0[0], v0[1]), cvt_pk_bf16(v0[2], v0[3]), cvt_pk_bf16(v1[0], v1[1]), cvt_pk_bf16(v1[2], v1[3])};
          *(u32x4*)(MG + row * DM + col) = pk;
        }
  }
};

struct EpiRes {
  static constexpr bool HOOK = false;
  const float* R32; const bf16_t* RB; float* X; bf16_t* XB; float* ssq;
  __device__ __forceinline__ void hook(f32x4 (&)[2][2][4][2], const Unit&, int, int, int, int, int) const {}
  __device__ __forceinline__ void operator()(const f32x4 (&acc)[2][2][4][2], const Unit& u, int wr, int wc, int fr, int fq) const {
    asm volatile("" : "+v"(fr), "+v"(fq));
    const int row0 = u.pm * 256 + wr * 64 + fr, col0 = u.pn * 256 + wc * 32 + 8 * fq;
#pragma unroll
    for (int ai = 0; ai < 2; ++ai) {
      f32x4 r[4][2][2];
      if (R32) {
#pragma unroll
        for (int m = 0; m < 4; ++m)
#pragma unroll
          for (int bj = 0; bj < 2; ++bj) { const float* rp = R32 + (size_t)(row0 + ai * 128 + m * 16) * DM + col0 + bj * 128; r[m][bj][0] = *(const f32x4*)rp; r[m][bj][1] = *(const f32x4*)(rp + 4); }
      } else {
        u32x4 rb[4][2];
#pragma unroll
        for (int m = 0; m < 4; ++m)
#pragma unroll
          for (int bj = 0; bj < 2; ++bj) rb[m][bj] = *(const u32x4*)(RB + (size_t)(row0 + ai * 128 + m * 16) * DM + col0 + bj * 128);
#pragma unroll
        for (int m = 0; m < 4; ++m)
#pragma unroll
          for (int bj = 0; bj < 2; ++bj) {
            r[m][bj][0] = (f32x4){bf_lo(rb[m][bj][0]), bf_hi(rb[m][bj][0]), bf_lo(rb[m][bj][1]), bf_hi(rb[m][bj][1])};
            r[m][bj][1] = (f32x4){bf_lo(rb[m][bj][2]), bf_hi(rb[m][bj][2]), bf_lo(rb[m][bj][3]), bf_hi(rb[m][bj][3])};
          }
      }
      __builtin_amdgcn_sched_barrier(0);
#pragma unroll
      for (int m = 0; m < 4; ++m) {
        const size_t row = (size_t)(row0 + ai * 128 + m * 16);
        float s = 0.f;
#pragma unroll
        for (int bj = 0; bj < 2; ++bj) {
          const int col = col0 + bj * 128;
          const f32x4 v0 = r[m][bj][0] + acc[ai][bj][m][0], v1 = r[m][bj][1] + acc[ai][bj][m][1];
          s += v0[0] * v0[0] + v0[1] * v0[1] + v0[2] * v0[2] + v0[3] * v0[3] + v1[0] * v1[0] + v1[1] * v1[1] + v1[2] * v1[2] + v1[3] * v1[3];
          if (X) { *(f32x4*)(X + row * DM + col) = v0; *(f32x4*)(X + row * DM + col + 4) = v1; }
          else { u32x4 pk = {cvt_pk_bf16(v0[0], v0[1]), cvt_pk_bf16(v0[2], v0[3]), cvt_pk_bf16(v1[0], v1[1]), cvt_pk_bf16(v1[2], v1[3])};
                 *(u32x4*)(XB + row * DM + col) = pk; }
        }
        s += __shfl_xor(s, 16); s += __shfl_xor(s, 32);
        if (fq == 0) ssq[row * 16 + u.pn * 4 + wc] = s;
      }
      __builtin_amdgcn_sched_barrier(0);
    }
  }
};

__device__ __forceinline__ void prep_tile(const float* src, int ldn, int k0, int n0, const float* rscale, float cscale, bf16_t* dst, int ldd, int drow0, int dk0, LAS float* tile) {
  const int tid = opaque_tid(), kk = tid >> 6, nn = tid & 63;
#pragma unroll
  for (int i = 0; i < 8; ++i) {
    const int k = kk * 8 + i;
    float v = src[(size_t)(k0 + k) * ldn + n0 + nn] * cscale;
    if (rscale) v *= rscale[k0 + k];
    tile[k * 65 + nn] = v;
  }
  __syncthreads();
  const int n = tid >> 3, kc = tid & 7;
  float f[8];
#pragma unroll
  for (int j = 0; j < 8; ++j) f[j] = tile[(kc * 8 + j) * 65 + n];
  u32x4 pk = {cvt_pk_bf16(f[0], f[1]), cvt_pk_bf16(f[2], f[3]), cvt_pk_bf16(f[4], f[5]), cvt_pk_bf16(f[6], f[7])};
  *(u32x4*)(dst + (size_t)(drow0 + n) * ldd + dk0 + kc * 8) = pk;
  __syncthreads();
}

__device__ __forceinline__ void win_map(int n0, int& dn0, float& sc) {
  sc = 1.0f;
  if (n0 < 512) { dn0 = U_QA + n0; sc = QSCALE; }
  else if (n0 < 1024) dn0 = U_KA + (n0 - 512);
  else if (n0 < 1536) dn0 = UW + V_A + (n0 - 1024);
  else if (n0 < 2048) dn0 = U_ZA + (n0 - 1536);
  else if (n0 < 2560) { dn0 = U_QB + (n0 - 2048); sc = QSCALE; }
  else if (n0 < 3072) dn0 = U_KB + (n0 - 2560);
  else if (n0 < 3584) dn0 = UW + V_B + (n0 - 3072);
  else if (n0 < 4096) dn0 = U_ZB + (n0 - 3584);
  else if (n0 < 4864) { dn0 = U_QC + (n0 - 4096); sc = QSCALE; }
  else if (n0 < 5632) dn0 = U_KC + (n0 - 4864);
  else if (n0 < 6400) dn0 = UW + V_C + (n0 - 5632);
  else if (n0 < 6656) dn0 = U_ZC + (n0 - 6400);
  else dn0 = U_GL + (n0 - 6656);
}

__device__ void phase_prep(const Params& p, LAS float* tile) {
  constexpr int PER = 3008;
  for (int it = blockIdx.x; it < DEPTH * PER; it += gridDim.x) {
    const int l = it / PER; int r = it % PER;
    if (r < 2432) {
      const int kt = r / 152, ntile = r % 152; int dn0; float sc; win_map(ntile * 64, dn0, sc);
      prep_tile(p.w_in + (size_t)l * DM * INW, INW, kt * 64, ntile * 64, p.g_norm + l * DM, sc, p.wt_in + (size_t)l * INW * DM, DM, dn0, kt * 64, tile);
    } else if ((r -= 2432) < 128) {
      const int kt = r / 16, ntile = r % 16;
      prep_tile(p.w_br_a + (size_t)l * 512 * DM, DM, kt * 64, ntile * 64, nullptr, 1.0f, p.wt_br + (size_t)l * DM * YW, YW, ntile * 64, kt * 64, tile);
    } else if ((r -= 128) < 128) {
      const int kt = r / 16, ntile = r % 16;
      prep_tile(p.w_br_b + (size_t)l * 512 * DM, DM, kt * 64, ntile * 64, nullptr, 1.0f, p.wt_br + (size_t)l * DM * YW, YW, ntile * 64, 512 + kt * 64, tile);
    } else if ((r -= 128) < 64) {
      const int kt = r / 16, ntile = r % 16;
      prep_tile(p.w_br_c + (size_t)l * 256 * DM, DM, kt * 64, ntile * 64, nullptr, 1.0f, p.wt_br + (size_t)l * DM * YW, YW, ntile * 64, 1024 + kt * 64, tile);
    } else {
      r -= 64; const int kt = r / 16, ntile = r % 16;
      prep_tile(p.w_out + (size_t)l * DM * DM, DM, kt * 64, ntile * 64, nullptr, 1.0f, p.wt_out + (size_t)l * DM * DM, DM, ntile * 64, kt * 64, tile);
    }
  }
  const int ptid = opaque_tid();
  if (blockIdx.x == 0 && ptid < 64) {
    const int lane = ptid;
    for (int l = 0; l < DEPTH; ++l) {
      const float* lq = p.lam_qk + l * 256;
      float a = lq[lane] * lq[64 + lane], b = lq[128 + lane] * lq[192 + lane];
      for (int o = 32; o >= 1; o >>= 1) { a += __shfl_xor(a, o); b += __shfl_xor(b, o); }
      if (lane == 0) { const float li = 0.8f - 0.6f * expf(-0.3f * (float)l); p.lam[l] = expf(a) - expf(b) + li; p.lam[4 + l] = 1.0f - li; }
    }
  }
}

__device__ void phase_x(const Params& p, int chunk) {
  const float* xin = (chunk < 2) ? p.xp + (size_t)chunk * TC * DM : p.xs + (size_t)(chunk - 2) * TC * DM;
  float* ssq = p.ssq + (size_t)chunk * TC * 16;
  const int tid = opaque_tid(), lane = tid & 63, w = blockIdx.x * 8 + (tid >> 6), nw = gridDim.x * 8;
  for (int row = w; row < TC; row += nw) {
    const float* xr = xin + (size_t)row * DM + lane * 16;
    f32x4 v[4]; float s = 0.f;
#pragma unroll
    for (int i = 0; i < 4; ++i) { v[i] = *(const f32x4*)(xr + i * 4); s += v[i][0] * v[i][0] + v[i][1] * v[i][1] + v[i][2] * v[i][2] + v[i][3] * v[i][3]; }
    for (int o = 32; o >= 1; o >>= 1) s += __shfl_xor(s, o);
    u32x4 p0 = {cvt_pk_bf16(v[0][0], v[0][1]), cvt_pk_bf16(v[0][2], v[0][3]), cvt_pk_bf16(v[1][0], v[1][1]), cvt_pk_bf16(v[1][2], v[1][3])};
    u32x4 p1 = {cvt_pk_bf16(v[2][0], v[2][1]), cvt_pk_bf16(v[2][2], v[2][3]), cvt_pk_bf16(v[3][0], v[3][1]), cvt_pk_bf16(v[3][2], v[3][3])};
    bf16_t* xo = p.xb + (size_t)row * DM + lane * 16;
    *(u32x4*)xo = p0; *(u32x4*)(xo + 8) = p1;
    if (lane < 16) ssq[(size_t)row * 16 + lane] = (lane == 0) ? s : 0.f;
    if (lane == 0) p.rinv[(size_t)chunk * TC + row] = rsqrtf(s * (1.0f / 1024.0f) + 1e-6f);
  }
}

__device__ void phase_rinv(const Params& p, int chunk) {
  const float* ssq = p.ssq + (size_t)chunk * TC * 16; float* rv = p.rinv + (size_t)chunk * TC;
  for (int row = blockIdx.x * 512 + opaque_tid(); row < TC; row += gridDim.x * 512) {
    const f32x4* sp = (const f32x4*)(ssq + (size_t)row * 16);
    const f32x4 a4 = sp[0] + sp[1] + sp[2] + sp[3];
    rv[row] = rsqrtf((a4[0] + a4[1] + a4[2] + a4[3]) * (1.0f / 1024.0f) + 1e-6f);
  }
}

__device__ void phase_final(const Params& p, int chunk) {
  float* x = p.out + (size_t)chunk * TC * DM;
  const float* ssq = p.ssq + (size_t)chunk * TC * 16;
  const int tid = opaque_tid(), lane = tid & 63, w = blockIdx.x * 8 + (tid >> 6), nw = gridDim.x * 8;
  for (int row = w; row < TC; row += nw) {
    const f32x4* sp = (const f32x4*)(ssq + (size_t)row * 16);
    const f32x4 a4 = sp[0] + sp[1] + sp[2] + sp[3];
    const float rinv = rsqrtf((a4[0] + a4[1] + a4[2] + a4[3]) * (1.0f / 1024.0f) + 1e-6f);
    float* xr = x + (size_t)row * DM + lane * 16;
#pragma unroll
    for (int i = 0; i < 4; ++i) { f32x4 v = *(const f32x4*)(xr + i * 4); const f32x4 g = *(const f32x4*)(p.g_final + lane * 16 + i * 4); v = v * rinv * g; *(f32x4*)(xr + i * 4) = v; }
  }
}

__device__ __forceinline__ f32x16 mfma32(bf16x8 a, bf16x8 b, f32x16 c) { return __builtin_amdgcn_mfma_f32_32x32x16_bf16(a, b, c, 0, 0, 0); }
__device__ __forceinline__ bf16x8 ld16(const bf16_t* p) { return *(const bf16x8*)p; }
__device__ __forceinline__ bf16x8 ld8x2(const bf16_t* p0, const bf16_t* p1) { const bf16x4 a = *(const bf16x4*)p0, b = *(const bf16x4*)p1; return __builtin_shufflevector(a, b, 0, 1, 2, 3, 4, 5, 6, 7); }

__device__ __forceinline__ float xhalf_max(float v) { const auto rr = __builtin_amdgcn_permlane32_swap(__float_as_uint(v), __float_as_uint(v), false, false); return fmaxf(__uint_as_float(rr[0]), __uint_as_float(rr[1])); }
__device__ __forceinline__ float xhalf_sum(float v) { const auto rr = __builtin_amdgcn_permlane32_swap(__float_as_uint(v), __float_as_uint(v), false, false); return __uint_as_float(rr[0]) + __uint_as_float(rr[1]); }
__device__ __forceinline__ void softmax_tile(f32x16& t, float& m, float& l, float& alpha, bf16x8& p0, bf16x8& p1) {
  float tm = t[0];
#pragma unroll
  for (int i = 1; i < 16; ++i) tm = fmaxf(tm, t[i]);
  tm = xhalf_max(tm);
  const float mn = fmaxf(m, tm);
  alpha = fexp2(m - mn); m = mn;
  float ls = 0.f;
#pragma unroll
  for (int i = 0; i < 16; ++i) { t[i] = fexp2(t[i] - mn); ls += t[i]; }
  l = l * alpha + ls;
  const u32x4 a = {cvt_pk_bf16(t[0], t[1]), cvt_pk_bf16(t[2], t[3]), cvt_pk_bf16(t[4], t[5]), cvt_pk_bf16(t[6], t[7])};
  const u32x4 b = {cvt_pk_bf16(t[8], t[9]), cvt_pk_bf16(t[10], t[11]), cvt_pk_bf16(t[12], t[13]), cvt_pk_bf16(t[14], t[15])};
  p0 = __builtin_bit_cast(bf16x8, a); p1 = __builtin_bit_cast(bf16x8, b);
}
__device__ __forceinline__ f32x16 zero16() { f32x16 z;
#pragma unroll
  for (int i = 0; i < 16; ++i) z[i] = 0.f; return z; }
__device__ __forceinline__ float silu(float z) { return z * frcp(1.0f + fexp2(-z * LOG2E)); }

constexpr int TB_ROW = 144;
constexpr int KB_BYTES = 64 * TB_ROW;
constexpr int VB_BYTES = 128 * TB_ROW;
constexpr int LDS_K = 0, LDS_V = LDS_K + 2 * KB_BYTES, LDS_ATT_END = LDS_V + 2 * VB_BYTES, LDS_ATT_TOTAL = LDS_ATT_END + 65536;
template <int SIDE>
__device__ __forceinline__ void b_far_subtile(const LAS unsigned char* kb, const LAS unsigned char* vb, int rd, int sub, const bf16x8 (&qf)[4], const f32x16& bp, float slope2, float d0,
                                              float& mrun, float& lrun, f32x16 (&o)[4]) {
  const float base = (SIDE > 0 ? -slope2 : slope2) * d0 - mrun;
  f32x16 sc;
#pragma unroll
  for (int i = 0; i < 16; ++i) sc[i] = SIDE > 0 ? base - bp[i] : base + bp[i];
#pragma unroll
  for (int ks = 0; ks < 4; ++ks) sc = mfma32(*(const LAS bf16x8*)(kb + rd + sub * 32 * TB_ROW + ks * 32), qf[ks], sc);
  float tm = sc[0];
#pragma unroll
  for (int i = 1; i < 16; ++i) tm = fmaxf(tm, sc[i]);
  tm = xhalf_max(tm);
  if (__builtin_amdgcn_ballot_w64(tm > 0.0f) != 0) {
    const float delta = fmaxf(tm, 0.0f);
    const float al = fexp2(-delta);
    mrun += delta; lrun *= al;
#pragma unroll
    for (int i = 0; i < 16; ++i) sc[i] -= delta;
#pragma unroll
    for (int dt = 0; dt < 4; ++dt) o[dt] *= al;
  }
#pragma unroll
  for (int i = 0; i < 16; ++i) sc[i] = fexp2(sc[i]);
  { const f32x4 a4 = (f32x4){sc[0], sc[1], sc[2], sc[3]} + (f32x4){sc[4], sc[5], sc[6], sc[7]} + (f32x4){sc[8], sc[9], sc[10], sc[11]} + (f32x4){sc[12], sc[13], sc[14], sc[15]};
    lrun += (a4[0] + a4[1]) + (a4[2] + a4[3]); }
  const u32x4 pa = {cvt_pk_bf16(sc[0], sc[1]), cvt_pk_bf16(sc[2], sc[3]), cvt_pk_bf16(sc[4], sc[5]), cvt_pk_bf16(sc[6], sc[7])};
  const u32x4 pb = {cvt_pk_bf16(sc[8], sc[9]), cvt_pk_bf16(sc[10], sc[11]), cvt_pk_bf16(sc[12], sc[13]), cvt_pk_bf16(sc[14], sc[15])};
  const bf16x8 pk0 = __builtin_bit_cast(bf16x8, pa), pk1 = __builtin_bit_cast(bf16x8, pb);
#pragma unroll
  for (int dt = 0; dt < 4; ++dt) {
    o[dt] = mfma32(*(const LAS bf16x8*)(vb + rd + dt * 32 * TB_ROW + (sub * 2) * 32), pk0, o[dt]);
    o[dt] = mfma32(*(const LAS bf16x8*)(vb + rd + dt * 32 * TB_ROW + (sub * 2 + 1) * 32), pk1, o[dt]);
  }
}

__device__ __forceinline__ void attn_b_pass(const Params& p, int L, int seq, int h, int mp, int qblk, int tq, int tid, float slope2, LAS unsigned char* lds, f32x16 (&o)[4], float& linv) {
  const int lane = tid & 63, q = lane & 31, half = lane >> 5;
  const size_t tokbase = (size_t)seq * L;
  bf16x8 qf[4];
  { const bf16_t* qp = p.u + (tokbase + tq) * UW + U_QB + h * 128 + mp * 64 + half * 8;
#pragma unroll
    for (int ks = 0; ks < 4; ++ks) qf[ks] = ld16(qp + ks * 16); }
  const int spart = tid & 7, srow = tid >> 3;
  const bf16_t* kg = p.u + (tokbase + srow) * UW + U_KB + h * 128 + mp * 64 + spart * 8;
  const bf16_t* vg = p.vt + ((size_t)seq * VW + V_B + h * 128 + srow) * L + spart * 8;
  const int kst = srow * TB_ROW + spart * 16;
  const int vst = srow * TB_ROW + ((spart >> 1) * 16 + (spart & 1) * 4) * 2;
  const int rd = q * TB_ROW + half * 16;
#pragma unroll
  for (int dt = 0; dt < 4; ++dt) o[dt] = zero16();
  float mrun = -1e30f, lrun = 0.f;
  f32x16 bp;
#pragma unroll
  for (int i = 0; i < 16; ++i) bp[i] = slope2 * (float)((i >> 2) * 8 + (i & 3));
  const int ntile = L >> 6, t0 = qblk * 4, nR = ntile - t0;
  auto tile_of = [&](int idx) { return idx < nR ? t0 + idx : (t0 - 1) - (idx - nR); };
  bf16x8 krA, vrA0, vrA1, krB, vrB0, vrB1;
  auto gload = [&](int idx, bf16x8& kr, bf16x8& v0, bf16x8& v1) { const int kn = tile_of(idx) * 64; kr = ld16(kg + (size_t)kn * UW); v0 = ld16(vg + kn); v1 = ld16(vg + (size_t)64 * L + kn); };
  auto lwrite = [&](int buf, const bf16x8& kr, const bf16x8& v0, const bf16x8& v1) {
    LAS unsigned char* kb = lds + LDS_K + buf * KB_BYTES; LAS unsigned char* vb = lds + LDS_V + buf * VB_BYTES;
    *(LAS bf16x8*)(kb + kst) = kr;
    *(LAS bf16x4*)(vb + vst) = __builtin_shufflevector(v0, v0, 0, 1, 2, 3); *(LAS bf16x4*)(vb + vst + 16) = __builtin_shufflevector(v0, v0, 4, 5, 6, 7);
    *(LAS bf16x4*)(vb + vst + 64 * TB_ROW) = __builtin_shufflevector(v1, v1, 0, 1, 2, 3); *(LAS bf16x4*)(vb + vst + 64 * TB_ROW + 16) = __builtin_shufflevector(v1, v1, 4, 5, 6, 7);
  };
  auto compute = [&](int idx, int buf) {
    const int k0 = tile_of(idx) * 64;
    const LAS unsigned char* kb = lds + LDS_K + buf * KB_BYTES;
    const LAS unsigned char* vb = lds + LDS_V + buf * VB_BYTES;
    if (idx < 4) {
#pragma unroll
      for (int sub = 0; sub < 2; ++sub) {
        f32x16 sc = zero16();
#pragma unroll
        for (int ks = 0; ks < 4; ++ks) sc = mfma32(*(const LAS bf16x8*)(kb + rd + sub * 32 * TB_ROW + ks * 32), qf[ks], sc);
        const float d0 = (float)(k0 + sub * 32 + half * 4 - tq);
#pragma unroll
        for (int i = 0; i < 16; ++i) sc[i] -= slope2 * fabsf(d0 + (float)((i >> 2) * 8 + (i & 3)));
        float al; bf16x8 pk[2];
        softmax_tile(sc, mrun, lrun, al, pk[0], pk[1]);
        if (__builtin_amdgcn_ballot_w64(al != 1.0f) != 0) {
#pragma unroll
          for (int dt = 0; dt < 4; ++dt) o[dt] *= al;
        }
#pragma unroll
        for (int dt = 0; dt < 4; ++dt)
#pragma unroll
          for (int s2 = 0; s2 < 2; ++s2) o[dt] = mfma32(*(const LAS bf16x8*)(vb + rd + dt * 32 * TB_ROW + (sub * 2 + s2) * 32), pk[s2], o[dt]);
      }
    } else if (idx < nR) {
#pragma unroll
      for (int sub = 0; sub < 2; ++sub) b_far_subtile<1>(kb, vb, rd, sub, qf, bp, slope2, (float)(k0 + sub * 32 + half * 4 - tq), mrun, lrun, o);
    } else {
#pragma unroll
      for (int sub = 0; sub < 2; ++sub) b_far_subtile<-1>(kb, vb, rd, sub, qf, bp, slope2, (float)(k0 + sub * 32 + half * 4 - tq), mrun, lrun, o);
    }
  };
  gload(0, krA, vrA0, vrA1);
  gload(1, krB, vrB0, vrB1);
  lwrite(0, krA, vrA0, vrA1);
  asm volatile("" : "+v"(qf[0]), "+v"(qf[1]), "+v"(qf[2]), "+v"(qf[3]));
  asm volatile("" : "+v"(krB), "+v"(vrB0), "+v"(vrB1));
  __syncthreads();
#pragma unroll 1
  for (int idx = 0; idx < ntile; idx += 2) {
    if (idx + 2 < ntile) gload(idx + 2, krA, vrA0, vrA1);
    compute(idx, 0);
    lwrite(1, krB, vrB0, vrB1);
    __syncthreads();
    if (idx + 3 < ntile) gload(idx + 3, krB, vrB0, vrB1);
    compute(idx + 1, 1);
    if (idx + 2 < ntile) lwrite(0, krA, vrA0, vrA1);
    __syncthreads();
  }
  linv = frcp(xhalf_sum(lrun));
}
__device__ void attn_b_block(const Params& p, int layer, int L, int seq, int h, int qblk, LAS unsigned char* lds) {
  const int tid = opaque_tid(), lane = tid & 63, wid = __builtin_amdgcn_readfirstlane(tid >> 6);
  const int q = lane & 31, half = lane >> 5;
  const size_t tokbase = (size_t)seq * L;
  const int tq = qblk * 256 + wid * 32 + q;
  const float slope2 = exp2f(-2.0f * (float)(h + 1)) * LOG2E;
  f32x16 o0[4]; float li0, li1;
  LAS u32x4* park = (LAS u32x4*)(lds + LDS_ATT_END) + wid * 512 + lane;
  attn_b_pass(p, L, seq, h, 0, qblk, tq, tid, slope2, lds, o0, li0);
#pragma unroll
  for (int dt = 0; dt < 4; ++dt)
#pragma unroll
    for (int g2 = 0; g2 < 2; ++g2) {
      u32x4 pk;
#pragma unroll
      for (int k = 0; k < 4; ++k) pk[k] = cvt_pk_bf16(o0[dt][g2 * 8 + 2 * k] * li0, o0[dt][g2 * 8 + 2 * k + 1] * li0);
      park[(dt * 2 + g2) * 64] = pk;
    }
  attn_b_pass(p, L, seq, h, 1, qblk, tq, tid, slope2, lds, o0, li1);
  const float c1 = p.lam[layer] * li1;
  const int tid2 = opaque_tid(), half2 = (tid2 >> 5) & 1;
  const size_t tok2 = (size_t)seq * L + qblk * 256 + (tid2 >> 6) * 32 + (tid2 & 31);
  float ss = 0.f;
#pragma unroll
  for (int dt = 0; dt < 4; ++dt)
#pragma unroll
    for (int g2 = 0; g2 < 2; ++g2) {
      const u32x4 pk = park[(dt * 2 + g2) * 64];
#pragma unroll
      for (int k = 0; k < 4; ++k) {
        const float va = bf_lo(pk[k]) - o0[dt][g2 * 8 + 2 * k] * c1, vb = bf_hi(pk[k]) - o0[dt][g2 * 8 + 2 * k + 1] * c1;
        o0[dt][g2 * 8 + 2 * k] = va; o0[dt][g2 * 8 + 2 * k + 1] = vb; ss += va * va + vb * vb;
      }
    }
  ss = xhalf_sum(ss);
  const float rn = rsqrtf(ss * (1.0f / 128.0f) + 1e-6f) * p.lam[4 + layer];
  const float* gd = p.g_diff + layer * 128;
  bf16_t* yrow = p.yg + tok2 * YW + 512 + h * 128;
  const bf16_t* zrow = p.u + tok2 * UW + U_ZB + h * 128;
#pragma unroll
  for (int dt = 0; dt < 4; ++dt)
#pragma unroll
    for (int g4 = 0; g4 < 4; ++g4) {
      const int dim = dt * 32 + g4 * 8 + half2 * 4;
      const u32x2 zr = *(const u32x2*)(zrow + dim);
      const f32x4 gv = *(const f32x4*)(gd + dim);
      const float y0 = o0[dt][g4 * 4 + 0] * rn * gv[0] * silu(bf_lo(zr[0]));
      const float y1 = o0[dt][g4 * 4 + 1] * rn * gv[1] * silu(bf_hi(zr[0]));
      const float y2 = o0[dt][g4 * 4 + 2] * rn * gv[2] * silu(bf_lo(zr[1]));
      const float y3 = o0[dt][g4 * 4 + 3] * rn * gv[3] * silu(bf_hi(zr[1]));
      u32x2 pk = {cvt_pk_bf16(y0, y1), cvt_pk_bf16(y2, y3)};
      *(u32x2*)(yrow + dim) = pk;
    }
}

constexpr int LDS_AK = 0, LDS_AV = LDS_AK + 2 * KB_BYTES, LDS_ATAB = LDS_AV + 2 * KB_BYTES, ATAB_ROW = 128;
__device__ void attn_a_block(const Params& p, int layer, int L, int seq, int h, int r0, LAS unsigned char* lds) {
  const int tid = opaque_tid(), lane = tid & 63, wid = __builtin_amdgcn_readfirstlane(tid >> 6);
  const int q = lane & 31, half = lane >> 5;
  const size_t tokbase = (size_t)seq * L;
  const int rows = L >> 6;
  const int ra = r0 + (wid >> 2) * 2, c0 = (wid & 3) * 16;
  int kstart = c0 - 8; kstart = kstart < 0 ? 0 : (kstart > 32 ? 32 : kstart);
  const int qrow = ra + (q >> 4), qcol = c0 + (q & 15), tq = qrow * 64 + qcol;
  int rsq = qrow - 4; rsq = rsq < 0 ? 0 : (rsq > rows - 8 ? rows - 8 : rsq);
  int rsa = ra - 4; rsa = rsa < 0 ? 0 : (rsa > rows - 8 ? rows - 8 : rsa);
  int rsb = ra - 3; rsb = rsb < 0 ? 0 : (rsb > rows - 8 ? rows - 8 : rsb);
  int kr_lo = r0 - 4; kr_lo = kr_lo < 0 ? 0 : (kr_lo > rows - 8 ? rows - 8 : kr_lo);
  int kr_hi = r0 - 1; kr_hi = (kr_hi < 0 ? 0 : (kr_hi > rows - 8 ? rows - 8 : kr_hi)) + 7;
  int qstart = qcol - 8; qstart = qstart < 0 ? 0 : (qstart > 48 ? 48 : qstart);
  bf16x8 qf[4];
  { const bf16_t* qp = p.u + (tokbase + tq) * UW + U_QA + h * 64 + half * 8;
#pragma unroll
    for (int ks = 0; ks < 4; ++ks) qf[ks] = ld16(qp + ks * 16); }
  {
    LAS float* tab = (LAS float*)(lds + LDS_ATAB);
    const float* rpb = p.rpb + ((size_t)layer * 8 + h) * 15 * 31;
    for (int idx = tid; idx < 15 * ATAB_ROW; idx += 512) { const int row = idx >> 7, cc = (idx & 127) - 48; tab[idx] = (cc >= 0 && cc <= 30) ? rpb[row * 31 + cc] * LOG2E : 0.f; }
  }
  const int spart = tid & 7, srow = tid >> 3;
  const bf16_t* kg = p.u + (tokbase + srow) * UW + U_KA + h * 64 + spart * 8;
  const bf16_t* vg = p.vt + ((size_t)seq * VW + V_A + h * 64 + srow) * L + spart * 8;
  const int kst = srow * TB_ROW + spart * 16;
  const int vst = srow * TB_ROW + spart * 16;
  const int krd = (kstart + q) * TB_ROW + half * 16;
  const int vrd = q * TB_ROW + (kstart + half * 4) * 2;
  f32x16 o[2] = {zero16(), zero16()};
  float mrun = -1e30f, lrun = 0.f;
  bf16x8 kr_, vr_;
  kr_ = ld16(kg + (size_t)(kr_lo * 64) * UW); vr_ = ld16(vg + kr_lo * 64);
  *(LAS bf16x8*)(lds + LDS_AK + kst) = kr_;
  *(LAS bf16x8*)(lds + LDS_AV + vst) = vr_;
  asm volatile("" : "+v"(qf[0]), "+v"(qf[1]), "+v"(qf[2]), "+v"(qf[3]));
  __syncthreads();
#pragma unroll 1
  for (int kr = kr_lo; kr <= kr_hi; ++kr) {
    const int it = kr - kr_lo;
    const bool more = (kr < kr_hi);
    if (more) { kr_ = ld16(kg + (size_t)((kr + 1) * 64) * UW); vr_ = ld16(vg + (kr + 1) * 64); }
    const LAS unsigned char* kb = lds + LDS_AK + (it & 1) * KB_BYTES;
    const LAS unsigned char* vb = lds + LDS_AV + (it & 1) * KB_BYTES;
    if (kr >= rsa && kr < rsb + 8) {
      const bool rowok = (kr >= rsq) && (kr < rsq + 8);
      int trow_i = kr - qrow + 7; trow_i = trow_i < 0 ? 0 : (trow_i > 14 ? 14 : trow_i);
      const LAS float* trow = (const LAS float*)(lds + LDS_ATAB) + trow_i * ATAB_ROW + (kstart + half * 4 - qcol + 15 + 48);
      f32x16 sc = zero16();
#pragma unroll
      for (int ks = 0; ks < 4; ++ks) sc = mfma32(*(const LAS bf16x8*)(kb + krd + ks * 32), qf[ks], sc);
#pragma unroll
      for (int ii = 0; ii < 16; ++ii) {
        const int kcol = kstart + (ii >> 2) * 8 + half * 4 + (ii & 3);
        const bool ok = rowok && (kcol >= qstart) && (kcol < qstart + 16);
        sc[ii] = ok ? sc[ii] + trow[(ii >> 2) * 8 + (ii & 3)] : -INFINITY;
      }
      float al; bf16x8 pk[2];
      softmax_tile(sc, mrun, lrun, al, pk[0], pk[1]);
      if (__builtin_amdgcn_ballot_w64(al != 1.0f) != 0) { o[0] *= al; o[1] *= al; }
#pragma unroll
      for (int dt = 0; dt < 2; ++dt)
#pragma unroll
        for (int s2 = 0; s2 < 2; ++s2) {
          const LAS unsigned char* vp = vb + vrd + dt * 32 * TB_ROW + s2 * 32;
          const bf16x4 va = *(const LAS bf16x4*)vp, vc = *(const LAS bf16x4*)(vp + 16);
          o[dt] = mfma32(__builtin_shufflevector(va, vc, 0, 1, 2, 3, 4, 5, 6, 7), pk[s2], o[dt]);
        }
    }
    if (more) {
      *(LAS bf16x8*)(lds + LDS_AK + ((it + 1) & 1) * KB_BYTES + kst) = kr_;
      *(LAS bf16x8*)(lds + LDS_AV + ((it + 1) & 1) * KB_BYTES + vst) = vr_;
    }
    __syncthreads();
  }
  const float c = frcp(xhalf_sum(lrun));
  bf16_t* yrow = p.yg + (tokbase + tq) * YW + h * 64;
  const bf16_t* zrow = p.u + (tokbase + tq) * UW + U_ZA + h * 64;
#pragma unroll
  for (int dt = 0; dt < 2; ++dt)
#pragma unroll
    for (int g4 = 0; g4 < 4; ++g4) {
      const int dim = dt * 32 + g4 * 8 + half * 4;
      const u32x2 zr = *(const u32x2*)(zrow + dim);
      const float y0 = o[dt][g4 * 4 + 0] * c * silu(bf_lo(zr[0]));
      const float y1 = o[dt][g4 * 4 + 1] * c * silu(bf_hi(zr[0]));
      const float y2 = o[dt][g4 * 4 + 2] * c * silu(bf_lo(zr[1]));
      const float y3 = o[dt][g4 * 4 + 3] * c * silu(bf_hi(zr[1]));
      u32x2 pk = {cvt_pk_bf16(y0, y1), cvt_pk_bf16(y2, y3)};
      *(u32x2*)(yrow + dim) = pk;
    }
}

__device__ void attn_c_unit(const Params& p, int L, int lshift, int seq, int g, int h, int rr, int mblk, int lane) {
  const int q = lane & 31, half = lane >> 5;
  const size_t tokbase = (size_t)seq * L;
  const int ds = (g == 0) ? 0 : (g == 1 ? 2 : 4), d = 1 << ds, M = L >> ds;
  const int hh = g * 4 + h;
  const int m0 = mblk * 32, mq = m0 + q, tq = mq * d + rr;
  const bf16_t* urow = p.u + (tokbase + tq) * UW;
  bf16x8 qf[4];
#pragma unroll
  for (int ks = 0; ks < 4; ++ks) qf[ks] = ld16(urow + U_QC + hh * 64 + ks * 16 + half * 8);
  f32x16 o[2] = {zero16(), zero16()};
  float mrun = -1e30f, lrun = 0.f;
  const float coef = exp2f(-(2.0f / 3.0f) * (float)(hh + 1)) * (float)d * LOG2E;
  const bf16_t* vbase = p.vt + ((size_t)seq * VW + V_C + hh * 64 + q) * L + (size_t)rr * M;
  bf16x8 kf[5][4];
#pragma unroll
  for (int j = 0; j < 5; ++j) {
    int mkl = m0 - 64 + 32 * j + q; mkl = mkl < 0 ? 0 : (mkl > M - 1 ? M - 1 : mkl);
    const bf16_t* kp = p.u + (tokbase + (size_t)mkl * d + rr) * UW + U_KC + hh * 64 + half * 8;
#pragma unroll
    for (int ks = 0; ks < 4; ++ks) kf[j][ks] = ld16(kp + ks * 16);
  }
  bf16x8 vf[2][2][2];
  auto load_v = [&](int j, bf16x8 (&dst)[2][2]) {
#pragma unroll
    for (int dt = 0; dt < 2; ++dt)
#pragma unroll
      for (int s2 = 0; s2 < 2; ++s2) {
        int pa = m0 - 64 + 32 * j + s2 * 16 + half * 4, pb = pa + 8;
        pa = pa < 0 ? 0 : (pa > M - 4 ? M - 4 : pa); pb = pb < 0 ? 0 : (pb > M - 4 ? M - 4 : pb);
        const bf16_t* vp = vbase + (size_t)(dt * 32) * L;
        dst[dt][s2] = ld8x2(vp + pa, vp + pb);
      }
  };
  load_v(0, vf[0]);
#pragma unroll
  for (int j = 0; j < 5; ++j) {
    if (j + 1 < 5) load_v(j + 1, vf[(j + 1) & 1]);
    const int mk0 = m0 - 64 + 32 * j;
    if (mk0 + 32 <= 0 || mk0 >= M) continue;
    f32x16 s = zero16();
#pragma unroll
    for (int ks = 0; ks < 4; ++ks) s = mfma32(kf[j][ks], qf[ks], s);
#pragma unroll
    for (int ii = 0; ii < 16; ++ii) {
      const int mk = mk0 + (ii >> 2) * 8 + half * 4 + (ii & 3);
      const int rel = mk - mq; const int ar = rel < 0 ? -rel : rel;
      const bool ok = (mk >= 0) && (mk < M) && (ar <= 64);
      s[ii] = ok ? s[ii] - coef * (float)ar : -INFINITY;
    }
    float alpha; bf16x8 pk[2];
    softmax_tile(s, mrun, lrun, alpha, pk[0], pk[1]);
#pragma unroll
    for (int dt = 0; dt < 2; ++dt) {
      o[dt] *= alpha;
#pragma unroll
      for (int s2 = 0; s2 < 2; ++s2) o[dt] = mfma32(vf[j & 1][dt][s2], pk[s2], o[dt]);
    }
  }
  const float lt = xhalf_sum(lrun);
  const float c = frcp(lt);
  bf16_t* orow = p.oc + (tokbase + tq) * 768 + hh * 64;
#pragma unroll
  for (int dt = 0; dt < 2; ++dt)
#pragma unroll
    for (int g4 = 0; g4 < 4; ++g4) {
      const int dim = dt * 32 + g4 * 8 + half * 4;
      u32x2 pk = {cvt_pk_bf16(o[dt][g4 * 4 + 0] * c, o[dt][g4 * 4 + 1] * c), cvt_pk_bf16(o[dt][g4 * 4 + 2] * c, o[dt][g4 * 4 + 3] * c)};
      *(u32x2*)(orow + dim) = pk;
    }
  if (half == 0) p.lse[(tokbase + tq) * 12 + hh] = mrun + log2f(lt);
}

constexpr int CV_ROW = 784;
constexpr int LDS_CK = 0, LDS_CV = 384 * TB_ROW;
__device__ void attn_c_block(const Params& p, int L, int lshift, int seq, int g, int h, int pblk, LAS unsigned char* lds) {
  const int tid = opaque_tid(), lane = tid & 63, wid = __builtin_amdgcn_readfirstlane(tid >> 6);
  const int q = lane & 31, half = lane >> 5;
  const size_t tokbase = (size_t)seq * L;
  const int ds = (g == 0) ? 0 : (g == 1 ? 2 : 4), d = 1 << ds, M = L >> ds;
  const int hh = g * 4 + h;
  const int p0 = pblk * 256;
  {
    const int part = tid & 7;
#pragma unroll
    for (int c = 0; c < 6; ++c) {
      const int row = (tid >> 3) + c * 64;
      int pp = p0 - 64 + row; pp = pp < 0 ? 0 : (pp > L - 1 ? L - 1 : pp);
      const int tok = ((pp & (M - 1)) << ds) + (pp >> (lshift - ds));
      const bf16x8 v = ld16(p.u + (tokbase + tok) * UW + U_KC + hh * 64 + part * 8);
      *(LAS bf16x8*)(lds + LDS_CK + row * TB_ROW + part * 16) = v;
    }
#pragma unroll
    for (int c = 0; c < 6; ++c) {
      const int idx = tid + c * 512, dim = idx / 48, c8 = idx % 48;
      int pp = p0 - 64 + c8 * 8; pp = pp < 0 ? 0 : (pp > L - 8 ? L - 8 : pp);
      const bf16x8 v = ld16(p.vt + ((size_t)seq * VW + V_C + hh * 64 + dim) * L + pp);
      LAS unsigned char* dst = lds + LDS_CV + dim * CV_ROW + ((c8 >> 1) * 16 + (c8 & 1) * 4) * 2;
      *(LAS bf16x4*)dst = __builtin_shufflevector(v, v, 0, 1, 2, 3); *(LAS bf16x4*)(dst + 16) = __builtin_shufflevector(v, v, 4, 5, 6, 7);
    }
  }
  const int pw = p0 + wid * 32;
  const int rr = pw >> (lshift - ds), m0 = pw & (M - 1), mq = m0 + q, tq = mq * d + rr;
  bf16x8 qf[4];
  { const bf16_t* qp = p.u + (tokbase + tq) * UW + U_QC + hh * 64 + half * 8;
#pragma unroll
    for (int ks = 0; ks < 4; ++ks) qf[ks] = ld16(qp + ks * 16); }
  f32x16 o[2] = {zero16(), zero16()};
  float mrun = -1e30f, lrun = 0.f;
  const float coef = exp2f(-(2.0f / 3.0f) * (float)(hh + 1)) * (float)d * LOG2E;
  __syncthreads();
#pragma unroll
  for (int j = 0; j < 5; ++j) {
    const int mk0 = m0 - 64 + 32 * j;
    if (mk0 + 32 <= 0 || mk0 >= M) continue;
    const LAS unsigned char* kb = lds + LDS_CK + ((wid + j) * 32 + q) * TB_ROW + half * 16;
    f32x16 sc = zero16();
#pragma unroll
    for (int ks = 0; ks < 4; ++ks) sc = mfma32(*(const LAS bf16x8*)(kb + ks * 32), qf[ks], sc);
#pragma unroll
    for (int ii = 0; ii < 16; ++ii) {
      const int mk = mk0 + (ii >> 2) * 8 + half * 4 + (ii & 3);
      const int rel = mk - mq; const int ar = rel < 0 ? -rel : rel;
      const bool ok = (mk >= 0) && (mk < M) && (ar <= 64);
      sc[ii] = ok ? sc[ii] - coef * (float)ar : -INFINITY;
    }
    float alpha; bf16x8 pk[2];
    softmax_tile(sc, mrun, lrun, alpha, pk[0], pk[1]);
#pragma unroll
    for (int dt = 0; dt < 2; ++dt) {
      o[dt] *= alpha;
#pragma unroll
      for (int s2 = 0; s2 < 2; ++s2)
        o[dt] = mfma32(*(const LAS bf16x8*)(lds + LDS_CV + (dt * 32 + q) * CV_ROW + ((wid + j) * 32 + s2 * 16) * 2 + half * 16), pk[s2], o[dt]);
    }
  }
  __syncthreads();
  const float lt = xhalf_sum(lrun);
  const float c = frcp(lt);
  bf16_t* orow = p.oc + (tokbase + tq) * 768 + hh * 64;
#pragma unroll
  for (int dt = 0; dt < 2; ++dt)
#pragma unroll
    for (int g4 = 0; g4 < 4; ++g4) {
      const int dim = dt * 32 + g4 * 8 + half * 4;
      u32x2 pk = {cvt_pk_bf16(o[dt][g4 * 4 + 0] * c, o[dt][g4 * 4 + 1] * c), cvt_pk_bf16(o[dt][g4 * 4 + 2] * c, o[dt][g4 * 4 + 3] * c)};
      *(u32x2*)(orow + dim) = pk;
    }
  if (half == 0) p.lse[(tokbase + tq) * 12 + hh] = mrun + log2f(lt);
}

__device__ void phase_attn(const Params& p, int layer, int L, int lshift, LAS unsigned char* lds) {
  const int tiles = L >> 5;
  const int nseq = TC >> lshift;
  const int nw = gridDim.x * 8;
  int w, lane;
  { const int qblks = L >> 8, npairs = nseq * 4, nunits = npairs * qblks;
    for (int b = blockIdx.x; b < nunits; b += gridDim.x) {
      int pair, qblk;
      if ((gridDim.x & 7) == 0 && (npairs & 7) == 0 && nunits == (int)gridDim.x) { const int xcd = b & 7, j = b >> 3; pair = xcd * (npairs >> 3) + j / qblks; qblk = j % qblks; }
      else { pair = b / qblks; qblk = b % qblks; }
      attn_b_block(p, layer, L, pair >> 2, pair & 3, qblk, lds);
    }
  }
  { const int tid = opaque_tid(); lane = tid & 63; w = blockIdx.x * 8 + __builtin_amdgcn_readfirstlane(tid >> 6); }
  {
  { const int rgs = L >> 8, nunits = nseq * 8 * rgs;
    for (int b = blockIdx.x; b < nunits; b += gridDim.x) { const int sh = b / rgs, rg = b % rgs; attn_a_block(p, layer, L, sh >> 3, sh & 7, rg * 4, lds); }
  }
  { const int tid = opaque_tid(); lane = tid & 63; w = blockIdx.x * 8 + __builtin_amdgcn_readfirstlane(tid >> 6); }
  { const int pbs = L >> 8, nunits = nseq * 12 * pbs;
    for (int b = blockIdx.x; b < nunits; b += gridDim.x) {
      const int pblk = b % pbs, sgh = b / pbs;
      const int seq = sgh / 12, gh = sgh % 12;
      attn_c_block(p, L, lshift, seq, gh >> 2, gh & 3, pblk, lds);
    }
  }
  }
}

__device__ void phase_combine(const Params& p) {
  const int gt = blockIdx.x * 512 + opaque_tid(), ngt = gridDim.x * 512;
  for (int it = gt; it < TC * 32; it += ngt) {
    const int tok = it >> 5, sub = it & 31, h = sub >> 3, d8 = (sub & 7) * 8;
    const float* ls = p.lse + (size_t)tok * 12;
    const float l0 = ls[h], l1 = ls[4 + h], l2 = ls[8 + h];
    const float mx = fmaxf(l0, fmaxf(l1, l2));
    const float w0 = fexp2(l0 - mx), w1 = fexp2(l1 - mx), w2 = fexp2(l2 - mx);
    const float inv = frcp(w0 + w1 + w2);
    const bf16_t* ob = p.oc + (size_t)tok * 768 + h * 64 + d8;
    const u32x4 a = *(const u32x4*)ob, b = *(const u32x4*)(ob + 256), c = *(const u32x4*)(ob + 512);
    const u32x4 z = *(const u32x4*)(p.u + (size_t)tok * UW + U_ZC + h * 64 + d8);
    u32x4 r;
#pragma unroll
    for (int k = 0; k < 4; ++k) {
      const float vlo = (w0 * bf_lo(a[k]) + w1 * bf_lo(b[k]) + w2 * bf_lo(c[k])) * inv * silu(bf_lo(z[k]));
      const float vhi = (w0 * bf_hi(a[k]) + w1 * bf_hi(b[k]) + w2 * bf_hi(c[k])) * inv * silu(bf_hi(z[k]));
      r[k] = cvt_pk_bf16(vlo, vhi);
    }
    *(u32x4*)(p.yg + (size_t)tok * YW + 1024 + h * 64 + d8) = r;
  }
}


#define XB_TMO      128
#define XB_XCNT(j)  (256  + 64 * (j))
#define XB_XSUB(j)  (1280 + 64 * (j))
#define XB_XGEN(j)  (2304 + 64 * (j))
#define XB_TOP      3328
#define XB_TOPGEN   3392
#define XCD_BAR_WORDS 3456
#define XB_SPIN_CAP (1u << 18)
__device__ __forceinline__ unsigned xb_ld(unsigned* p)              { return __hip_atomic_load(p, __ATOMIC_RELAXED, __HIP_MEMORY_SCOPE_AGENT); }
__device__ __forceinline__ unsigned xb_add(unsigned* p, unsigned v) { return __hip_atomic_fetch_add(p, v, __ATOMIC_RELAXED, __HIP_MEMORY_SCOPE_AGENT); }
__device__ __forceinline__ unsigned xb_xcc_id() { return (unsigned)__builtin_amdgcn_s_getreg((3 << 11) | 20) & 0xFu; }
#define XB_SPIN(cond, bar) do { unsigned _sp = 0; while (cond) { __builtin_amdgcn_s_sleep(1); \
    if ((++_sp & 255u) == 0u) { if (xb_ld(&(bar)[XB_TMO])) break; if (_sp > XB_SPIN_CAP) { atomicAdd(&(bar)[XB_TMO], 1u); break; } } } } while (0)
struct XcdBarrier { unsigned* bar; unsigned x; volatile LAS unsigned* st; };
__device__ __forceinline__ XcdBarrier xcd_barrier_post(unsigned* bar, volatile LAS unsigned* st) {
  XcdBarrier b; b.bar = bar; b.x = xb_xcc_id(); b.st = st;
  if (opaque_tid() == 0) (void)xb_add(&bar[XB_XCNT(b.x)], 1u);
  return b;
}
__device__ __forceinline__ void xcd_barrier_complete(unsigned* bar, unsigned x, unsigned& nloc, unsigned& nx) {
  const unsigned G = gridDim.x * gridDim.y * gridDim.z;
  unsigned sum, cnt, mine, sp = 0u;
  for (;;) {
    sum = 0u; cnt = 0u; mine = 0u;
#pragma unroll
    for (unsigned j = 0; j < 16; ++j) { const unsigned c = xb_ld(&bar[XB_XCNT(j)]); sum += c; cnt += (c > 0u) ? 1u : 0u; mine = (j == x) ? c : mine; }
    if (sum == G) break;
    __builtin_amdgcn_s_sleep(1);
    if ((++sp & 255u) == 0u) { if (xb_ld(&bar[XB_TMO])) break; if (sp > XB_SPIN_CAP) { atomicAdd(&bar[XB_TMO], 1u); break; } }
  }
  nloc = mine > 0u ? mine : 1u; nx = cnt > 0u ? cnt : 1u;
}
__device__ __forceinline__ void xcd_barrier(const XcdBarrier& b) {
  asm volatile("s_waitcnt vmcnt(0)" ::: "memory");
  __syncthreads();
  if (opaque_tid() == 0) {
    unsigned* bar = b.bar;
    __builtin_amdgcn_s_waitcnt(0);
    unsigned nloc = b.st[0], nx = b.st[1];
    if (nloc == 0u) { xcd_barrier_complete(bar, b.x, nloc, nx); b.st[0] = nloc; b.st[1] = nx; }
    const unsigned old = xb_add(&bar[XB_XSUB(b.x)], 1u);
    const unsigned gen = old / nloc;
    if (old + 1u == (gen + 1u) * nloc) {
      __builtin_amdgcn_fence(__ATOMIC_RELEASE, "agent");
      asm volatile("s_waitcnt vmcnt(0)" ::: "memory");
      const unsigned og = xb_add(&bar[XB_TOP], 1u);
      const unsigned tg = og / nx;
      if (og + 1u == (tg + 1u) * nx) xb_add(&bar[XB_TOPGEN], 1u);
      else XB_SPIN(xb_ld(&bar[XB_TOPGEN]) == tg, bar);
      __builtin_amdgcn_fence(__ATOMIC_ACQUIRE, "agent");
      xb_add(&bar[XB_XGEN(b.x)], 1u);
      asm volatile("s_waitcnt vmcnt(0)" ::: "memory");
    } else {
      XB_SPIN(xb_ld(&bar[XB_XGEN(b.x)]) == gen, bar);
      __builtin_amdgcn_fence(__ATOMIC_ACQUIRE, "agent");
      asm volatile("s_waitcnt vmcnt(0)" ::: "memory");
    }
  }
  __syncthreads();
}

constexpr int DYN_LDS_BYTES = LDS_ATT_TOTAL > pg8::STAGE_BYTES ? LDS_ATT_TOTAL : pg8::STAGE_BYTES;
__global__ void __launch_bounds__(512) fwd_megakernel(Params p) {
  extern __shared__ __attribute__((aligned(16))) unsigned char smem[];
  __shared__ __attribute__((aligned(16))) unsigned xb_words[4];
  cg::grid_group grid = cg::this_grid();
  if (threadIdx.x == 0) { xb_words[0] = 0u; xb_words[1] = 0u; xb_words[2] = 0u; xb_words[3] = 0u; }
  if ((threadIdx.x & 63) == 0) g_wid_table[hw_wave_slot()] = (int)(threadIdx.x >> 6);
  __syncthreads();
  const XcdBarrier xb = xcd_barrier_post(p.bar, (volatile LAS unsigned*)xb_words);
#define GSYNC() xcd_barrier(xb)
  LAS unsigned char* lds = (LAS unsigned char*)smem;
  phase_prep(p, (LAS float*)smem);
  phase_x(p, 0);
  grid.sync();
  for (int chunk = 0; chunk < NCHUNK; ++chunk) {
    const int L = chunk < 2 ? 2048 : 4096, lshift = chunk < 2 ? 11 : 12;
    const float* xin = (chunk < 2) ? p.xp + (size_t)chunk * TC * DM : p.xs + (size_t)(chunk - 2) * TC * DM;
    float* xres = p.out + (size_t)chunk * TC * DM;
    float* ssq = p.ssq + (size_t)chunk * TC * 16;
    for (int layer = 0; layer < DEPTH; ++layer) {
      {
        {
        { pg8::Gemm g{p.xb, p.wt_in + (size_t)layer * INW * DM, TC, UW, DM, 0, lshift};
          pg8::StaticOrder S; S.init(TC, UW, gridDim.x, blockIdx.x);
          EpiU E{p.u, p.rinv + (size_t)chunk * TC, p.b_gate + (size_t)layer * 3 * DM};
          pg8::gemm_phase<false>(lds, g, S, E); }
        {
          pg8::Gemm g{p.wt_in + ((size_t)layer * INW + UW) * DM, p.xb, VW, TC, DM, 1, lshift};
          pg8::StaticOrder S; S.init(VW, TC, gridDim.x, (blockIdx.x + (gridDim.x >> 2)) % gridDim.x);
          EpiVT E{p.vt, p.rinv + (size_t)chunk * TC, L, lshift};
          pg8::gemm_phase<true>(lds, g, S, E); }
        }
      }
      GSYNC();
      phase_attn(p, layer, L, lshift, lds);
      GSYNC();
      phase_combine(p);
      GSYNC();
      {
        pg8::Gemm g{p.yg, p.wt_br + (size_t)layer * DM * YW, TC, DM, YW, 0, 0};
        pg8::StaticOrder S; S.init(TC, DM, gridDim.x, blockIdx.x);
        EpiMerge E{p.u, p.merged};
        pg8::gemm_phase<false>(lds, g, S, E);
      }
      GSYNC();
      {
        pg8::Gemm g{p.merged, p.wt_out + (size_t)layer * DM * DM, TC, DM, DM, 0, 0};
        pg8::StaticOrder S; S.init(TC, DM, gridDim.x, blockIdx.x);
        EpiRes E{layer == 0 ? xin : (const float*)nullptr, p.xb, layer == DEPTH - 1 ? xres : (float*)nullptr, p.xb, ssq};
        pg8::gemm_phase<false>(lds, g, S, E);
      }
      GSYNC();
      if (layer + 1 < DEPTH) { phase_rinv(p, chunk); GSYNC(); }
    }
    phase_final(p, chunk);
    if (chunk + 1 < NCHUNK) { phase_x(p, chunk + 1); GSYNC(); }
  }
}

extern "C" void kernel_launch(void* const* d_in, const int* in_sizes, int n_in, void* d_out, int out_size, void* d_ws, size_t ws_size, hipStream_t stream) {
  (void)in_sizes; (void)n_in; (void)out_size;
  static int grid_blocks = 0;
  if (!grid_blocks) {
    int dev = 0, cus = 0, per_cu = 0;
    hipGetDevice(&dev);
    hipDeviceGetAttribute(&cus, hipDeviceAttributeMultiprocessorCount, dev);
    hipFuncSetAttribute((const void*)fwd_megakernel, hipFuncAttributeMaxDynamicSharedMemorySize, DYN_LDS_BYTES);
    hipOccupancyMaxActiveBlocksPerMultiprocessor(&per_cu, fwd_megakernel, 512, DYN_LDS_BYTES);
    if (per_cu < 1) per_cu = 1;
    grid_blocks = cus * per_cu;
    if (grid_blocks > 256) grid_blocks = 256;
  }
  Params p{};
  p.xp = (const float*)d_in[0]; p.xs = (const float*)d_in[1]; p.g_norm = (const float*)d_in[2]; p.w_in = (const float*)d_in[3];
  p.b_gate = (const float*)d_in[4]; p.rpb = (const float*)d_in[5]; p.lam_qk = (const float*)d_in[6]; p.g_diff = (const float*)d_in[7];
  p.w_br_a = (const float*)d_in[8]; p.w_br_b = (const float*)d_in[9]; p.w_br_c = (const float*)d_in[10]; p.w_out = (const float*)d_in[11];
  p.g_final = (const float*)d_in[12];
  p.out = (float*)d_out;
  char* w = (char*)d_ws; size_t off = 0;
  auto take = [&](size_t bytes) { char* r = w + off; off += (bytes + 255) & ~(size_t)255; return r; };
  p.wt_in = (bf16_t*)take((size_t)DEPTH * INW * DM * 2);
  p.wt_br = (bf16_t*)take((size_t)DEPTH * DM * YW * 2);
  p.wt_out = (bf16_t*)take((size_t)DEPTH * DM * DM * 2);
  p.xb = (bf16_t*)take((size_t)TC * DM * 2);
  p.u = (bf16_t*)take((size_t)TC * UW * 2);
  p.vt = (bf16_t*)take((size_t)TC * VW * 2);
  p.yg = (bf16_t*)take((size_t)TC * YW * 2);
  p.oc = (bf16_t*)take((size_t)TC * 768 * 2);
  p.merged = (bf16_t*)take((size_t)TC * DM * 2);
  p.lse = (float*)take((size_t)TC * 12 * 4);
  p.ssq = (float*)take((size_t)NTOK * 16 * 4);
  p.lam = (float*)take(256);
  p.rinv = (float*)take((size_t)NTOK * 4);
  p.bar = (unsigned*)take((size_t)XCD_BAR_WORDS * 4);
  if (off > ws_size) fprintf(stderr, "workspace too small: need %zu have %zu\n", off, ws_size);
  hipMemsetAsync(p.bar, 0, (size_t)XCD_BAR_WORDS * 4, stream);
  void* args[] = {&p};
  hipError_t e = hipLaunchCooperativeKernel((void*)fwd_megakernel, dim3(grid_blocks), dim3(512), args, DYN_LDS_BYTES, stream);
  if (e != hipSuccess) fprintf(stderr, "cooperative launch failed: %s (grid %d)\n", hipGetErrorString(e), grid_blocks);
}
```

```cpp
#include <hip/hip_runtime.h>
#include <hip/hip_cooperative_groups.h>
#include <cstdio>
namespace cg = cooperative_groups;

#define LAS __attribute__((address_space(3)))
typedef unsigned short bf16_t;
typedef short bf16x8 __attribute__((ext_vector_type(8)));
typedef short bf16x4 __attribute__((ext_vector_type(4)));
typedef float f32x4 __attribute__((ext_vector_type(4)));
typedef float f32x16 __attribute__((ext_vector_type(16)));
typedef unsigned u32x4 __attribute__((ext_vector_type(4)));
typedef unsigned u32x2 __attribute__((ext_vector_type(2)));

constexpr int DM = 1024, DEPTH = 4, INW = 9728, UW = 7936, VW = 1792, YW = 1280;
constexpr int TC = 16384, NCHUNK = 4, NTOK = 65536;
constexpr float LOG2E = 1.4426950408889634f;
constexpr float QSCALE = 0.125f * LOG2E;
constexpr int U_QA = 0, U_KA = 512, U_ZA = 1024, U_QB = 1536, U_KB = 2048, U_ZB = 2560, U_QC = 3072, U_KC = 3840, U_ZC = 4608, U_GL = 4864;
constexpr int V_A = 0, V_B = 512, V_C = 1024;

struct Params {
  const float *xp, *xs, *g_norm, *w_in, *b_gate, *rpb, *lam_qk, *g_diff, *w_br_a, *w_br_b, *w_br_c, *w_out, *g_final;
  float* out;
  bf16_t *wt_in, *wt_br, *wt_out, *xb, *u, *vt, *yg, *oc, *merged;
  float *lse, *ssq, *lam, *rinv;
  unsigned* bar;
};

__device__ __forceinline__ unsigned cvt_pk_bf16(float lo, float hi) { unsigned r; asm volatile("v_cvt_pk_bf16_f32 %0, %1, %2" : "=v"(r) : "v"(lo), "v"(hi)); return r; }
__device__ __forceinline__ float bf_lo(unsigned v) { return __uint_as_float(v << 16); }
__device__ __forceinline__ float bf_hi(unsigned v) { return __uint_as_float(v & 0xffff0000u); }
__device__ __forceinline__ float fexp2(float x) { return __builtin_amdgcn_exp2f(x); }
__device__ __forceinline__ float frcp(float x) { return __builtin_amdgcn_rcpf(x); }

__shared__ int g_wid_table[64];
__device__ __forceinline__ unsigned hw_wave_slot() { return (unsigned)__builtin_amdgcn_s_getreg(((6 - 1) << 11) | (0 << 6) | 4) & 63u; }
__device__ __forceinline__ int opaque_tid() {
  const int wid = __builtin_amdgcn_readfirstlane(g_wid_table[hw_wave_slot()]);
  unsigned z = 0u; asm volatile("" : "+v"(z));
  int t = wid * 64 + (int)__builtin_amdgcn_mbcnt_hi(~0u, __builtin_amdgcn_mbcnt_lo(~0u, z));
  asm volatile("" : "+v"(t)); return t;
}

namespace pg8 {
constexpr int BM = 256, BK = 64, HALF = 128, HTB = HALF * BK * 2, STAGE_BYTES = 8 * HTB, NXCD = 8, WGM = 4;
__device__ __forceinline__ int lds_byte(int r, int c) { const int st = (r >> 4) * 2 + (c >> 5), rr = r & 15, cc = c & 31, ob = rr * 64 + cc * 2; return st * 1024 + (ob ^ (((ob >> 9) & 1) << 5)); }
__device__ __forceinline__ void stage_rc(int b, int& R, int& C) { const int st = b / 1024, sb = b % 1024, swz = sb ^ (((sb >> 9) & 1) << 5); R = (st >> 1) * 16 + swz / 64; C = (st & 1) * 32 + (swz % 64) / 2; }
__device__ __forceinline__ int perm32(int rho) { const int n = rho >> 4, i = rho & 15; return 8 * (i >> 2) + 4 * n + (i & 3); }
struct Unit { int pm, pn; };
struct Gemm { const bf16_t* A; const bf16_t* Bt; int M, N, K; int bperm, lshift; };
struct StaticOrder {
  int nM, nN, nwg, G, c;
  __device__ void init(int M, int N, int G_, int c_) { nM = M / BM; nN = N / BM; nwg = nM * nN; G = G_; c = c_; }
  __device__ bool next(int i, Unit& u) const {
    const long L = (long)i * G + c; if (L >= nwg) return false;
    int wgid = (int)L; { const int q = nwg / NXCD, r = nwg % NXCD, xcd = wgid % NXCD, off = wgid / NXCD; wgid = (xcd < r ? xcd * (q + 1) : r * (q + 1) + (xcd - r) * q) + off; }
    const int nig = WGM * nN, gid = wgid / nig, fm = gid * WGM, gsz = (nM - fm) < WGM ? (nM - fm) : WGM;
    u.pm = fm + ((wgid % nig) % gsz); u.pn = (wgid % nig) / gsz; return true;
  }
};

template <bool BPERM, class Epi>
__device__ __forceinline__ void gemm_phase(LAS unsigned char* lds, const Gemm g, const StaticOrder& S, const Epi& E) {
  const int tid_ = opaque_tid();
  const int tid = tid_, wid = __builtin_amdgcn_readfirstlane(tid >> 6), lane = tid & 63, wr = wid >> 2, wc = wid & 3, fr = lane & 15, fq = lane >> 4;
  const int K = g.K, nt = K / BK;
  const size_t kstep = (size_t)(BK * 2);
  const size_t hstep = (size_t)HALF * K * 2;
  const size_t tstep = 2 * hstep;
  unsigned voffA[2], voffBr[2], voffBc[2], voffB[2], voffBn[2];
#pragma unroll
  for (int i = 0; i < 2; ++i) { int R, C; stage_rc(tid * 16 + i * 8192, R, C); const int Rb = (R & ~31) + perm32(R & 31);
    voffA[i] = (unsigned)(R * K + C) * 2u; voffBr[i] = (unsigned)(Rb * K) * 2u; voffBc[i] = (unsigned)C * 2u; voffB[i] = voffBr[i] + voffBc[i]; voffBn[i] = voffB[i]; }
  auto bbase = [&](const Unit& u, int hh, int& sh) -> const char* {
    if constexpr (!BPERM) { sh = 0; return (const char*)g.Bt + (size_t)u.pn * tstep + (size_t)hh * hstep; }
    const int ds = u.pm <= 4 ? 0 : (u.pm == 5 ? 2 : 4); sh = ds;
    const int L = 1 << g.lshift; const int p0 = u.pn * 256 + hh * 128, seq = p0 >> g.lshift, p = p0 & (L - 1);
    const int Mc = L >> ds, r = p / Mc, m0 = p & (Mc - 1);
    return (const char*)g.Bt + ((size_t)seq * L + ((size_t)m0 << ds) + r) * (size_t)K * 2;
  };
  const unsigned ldsw = (unsigned)wid * 1024u;
  const int aoff = lds_byte(wr * 64 + fr, fq * 8), boff = lds_byte(wc * 32 + fr, fq * 8);
#define PG8_SA(b, h) (((b) * 2 + (h)) * HTB)
#define PG8_SB(b, h) ((4 + (b) * 2 + (h)) * HTB)
#define PG8_STAGE(bufoff, gbase, voff) do { _Pragma("unroll") for (int _i = 0; _i < 2; ++_i) \
    __builtin_amdgcn_global_load_lds((const unsigned*)((const char*)(gbase) + (voff)[_i]), (LAS unsigned*)(lds + (bufoff) + ldsw + _i * 8192), 16, 0, 0); } while (0)
#define PG8_LDA(dst, b, h) do { _Pragma("unroll") for (int m = 0; m < 4; ++m) _Pragma("unroll") for (int k = 0; k < 2; ++k) dst[m][k] = *(const LAS bf16x8*)(lds + PG8_SA(b, h) + aoff + m * 2048 + k * 1024); } while (0)
#define PG8_LDB(dst, b, h) do { _Pragma("unroll") for (int n = 0; n < 2; ++n) _Pragma("unroll") for (int k = 0; k < 2; ++k) dst[n][k] = *(const LAS bf16x8*)(lds + PG8_SB(b, h) + boff + n * 2048 + k * 1024); } while (0)
#define PG8_MMA(ai, bj, At, Bt) do { __builtin_amdgcn_s_setprio(1); _Pragma("unroll") for (int m = 0; m < 4; ++m) _Pragma("unroll") for (int n = 0; n < 2; ++n) _Pragma("unroll") for (int k = 0; k < 2; ++k) \
    acc[ai][bj][m][n] = __builtin_amdgcn_mfma_f32_16x16x32_bf16(Bt[n][k], At[m][k], acc[ai][bj][m][n], 0, 0, 0); __builtin_amdgcn_s_setprio(0); } while (0)
#define PG8_WAIT_V(n) asm volatile("s_waitcnt vmcnt(" #n ")" ::: "memory")
#define PG8_WAIT_L(n) asm volatile("s_waitcnt lgkmcnt(" #n ")" ::: "memory")
#define PG8_BAR __builtin_amdgcn_s_barrier()
#define PG8_SCHED __builtin_amdgcn_sched_barrier(0)
  Unit cur, nxt; int ui = 0;
  if (!S.next(0, cur)) return;
  f32x4 acc[2][2][4][2];
#pragma unroll
  for (int a = 0; a < 2; ++a)
#pragma unroll
    for (int b = 0; b < 2; ++b)
#pragma unroll
      for (int m = 0; m < 4; ++m)
#pragma unroll
        for (int n = 0; n < 2; ++n) acc[a][b][m][n] = (f32x4){0.f, 0.f, 0.f, 0.f};
  bf16x8 At[4][2], B0[2][2], B1[2][2];
  const char* cA = (const char*)g.A + (size_t)cur.pm * tstep;
  int csh; const char* cB0 = bbase(cur, 0, csh); const char* cB1 = bbase(cur, 1, csh);
#pragma unroll
  for (int i = 0; i < 2; ++i) voffB[i] = (voffBr[i] << csh) + voffBc[i];
  PG8_STAGE(PG8_SB(0, 0), cB0, voffB); PG8_STAGE(PG8_SA(0, 0), cA, voffA); PG8_STAGE(PG8_SB(0, 1), cB1, voffB); PG8_STAGE(PG8_SA(0, 1), cA + hstep, voffA);
  if (wr == 1) PG8_BAR;
  PG8_WAIT_V(4); PG8_BAR;
  PG8_STAGE(PG8_SB(1, 0), cB0 + kstep, voffB); PG8_STAGE(PG8_SA(1, 0), cA + kstep, voffA); PG8_STAGE(PG8_SB(1, 1), cB1 + kstep, voffB);
  PG8_WAIT_V(6); PG8_BAR;
  for (;;) {
    const bool has_next = S.next(ui + 1, nxt);
    const char* nA = cA; const char* nB0 = cB0; const char* nB1 = cB1;
#pragma unroll
    for (int i = 0; i < 2; ++i) voffBn[i] = voffB[i];
    if (has_next) { int nsh; nA = (const char*)g.A + (size_t)nxt.pm * tstep; nB0 = bbase(nxt, 0, nsh); nB1 = bbase(nxt, 1, nsh);
#pragma unroll
      for (int i = 0; i < 2; ++i) voffBn[i] = (voffBr[i] << nsh) + voffBc[i]; }
    auto kiter = [&](int t) __attribute__((always_inline)) {
      const bool last = (t == nt - 2);
      const char* a1 = cA + (size_t)(t + 1) * kstep;
      const char* a2 = last ? nA : cA + (size_t)(t + 2) * kstep;
      const char* b20 = last ? nB0 : cB0 + (size_t)(t + 2) * kstep; const char* b21 = last ? nB1 : cB1 + (size_t)(t + 2) * kstep;
      const char* a3 = a2 + kstep; const char* b30 = b20 + kstep; const char* b31 = b21 + kstep;
      unsigned vB[2];
#pragma unroll
      for (int i = 0; i < 2; ++i) vB[i] = BPERM ? (last ? voffBn[i] : voffB[i]) : voffB[i];
      PG8_LDB(B0, 0, 0); PG8_SCHED; PG8_LDA(At, 0, 0); PG8_STAGE(PG8_SA(1, 1), a1 + hstep, voffA);
      PG8_WAIT_L(8); PG8_BAR; PG8_WAIT_L(0); PG8_MMA(0, 0, At, B0); PG8_BAR; PG8_SCHED;
      PG8_LDB(B1, 0, 1); PG8_STAGE(PG8_SB(0, 0), b20, vB);
      PG8_BAR; PG8_WAIT_L(0); PG8_MMA(0, 1, At, B1); PG8_BAR;
      PG8_LDA(At, 0, 1); PG8_STAGE(PG8_SA(0, 0), a2, voffA);
      PG8_BAR; PG8_WAIT_L(0); PG8_MMA(1, 0, At, B0); PG8_BAR; PG8_SCHED;
      PG8_STAGE(PG8_SB(0, 1), b21, vB);
      PG8_WAIT_V(6); PG8_BAR; PG8_MMA(1, 1, At, B1); PG8_BAR;
      PG8_LDB(B0, 1, 0); PG8_SCHED; PG8_LDA(At, 1, 0); PG8_STAGE(PG8_SA(0, 1), a2 + hstep, voffA);
      PG8_WAIT_L(8); PG8_BAR; PG8_WAIT_L(0); PG8_MMA(0, 0, At, B0); PG8_BAR; PG8_SCHED;
      PG8_LDB(B1, 1, 1); PG8_STAGE(PG8_SB(1, 0), b30, vB);
      PG8_BAR; PG8_WAIT_L(0); PG8_MMA(0, 1, At, B1); PG8_BAR;
      PG8_LDA(At, 1, 1); PG8_STAGE(PG8_SA(1, 0), a3, voffA);
      PG8_BAR; PG8_WAIT_L(0); PG8_MMA(1, 0, At, B0); PG8_BAR; PG8_SCHED;
      PG8_STAGE(PG8_SB(1, 1), b31, vB);
      PG8_WAIT_V(6); PG8_BAR; PG8_MMA(1, 1, At, B1); PG8_BAR;
    };
    if constexpr (Epi::HOOK) {
#pragma unroll 1
      for (int seg = 0; seg < 3; ++seg) {
        const int tb = seg * 8, te = seg == 2 ? nt : tb + 8;
#pragma unroll 1
        for (int t = tb; t < te; t += 2) kiter(t);
        if (seg < 2) E.hook(acc, cur, te, wr, wc, fr, fq);
      }
    } else {
      for (int t = 0; t < nt; t += 2) kiter(t);
    }
    E(acc, cur, wr, wc, fr, fq);
    if (!has_next) break;
#pragma unroll
    for (int a = 0; a < 2; ++a)
#pragma unroll
      for (int b = 0; b < 2; ++b)
#pragma unroll
        for (int m = 0; m < 4; ++m)
#pragma unroll
          for (int n = 0; n < 2; ++n) acc[a][b][m][n] = (f32x4){0.f, 0.f, 0.f, 0.f};
    cur = nxt; cA = nA; cB0 = nB0; cB1 = nB1; ++ui;
#pragma unroll
    for (int i = 0; i < 2; ++i) voffB[i] = voffBn[i];
  }
  PG8_WAIT_V(0);
  if (wr == 0) PG8_BAR;
  PG8_BAR;
#undef PG8_SA
#undef PG8_SB
#undef PG8_STAGE
#undef PG8_LDA
#undef PG8_LDB
#undef PG8_MMA
#undef PG8_WAIT_V
#undef PG8_WAIT_L
#undef PG8_BAR
#undef PG8_SCHED
}
}
using pg8::Unit;

struct EpiU {
  static constexpr bool HOOK = false;
  bf16_t* U; const float* rinv; const float* bg;
  __device__ __forceinline__ void hook(f32x4 (&)[2][2][4][2], const Unit&, int, int, int, int, int) const {}
  __device__ __forceinline__ void operator()(const f32x4 (&acc)[2][2][4][2], const Unit& u, int wr, int wc, int fr, int fq) const {
    asm volatile("" : "+v"(fr), "+v"(fq));
    const int row0 = u.pm * 256 + wr * 64 + fr, col0 = u.pn * 256 + wc * 32 + 8 * fq;
    const bool isg = (u.pn >= 19);
    float ri[2][4];
#pragma unroll
    for (int ai = 0; ai < 2; ++ai)
#pragma unroll
      for (int m = 0; m < 4; ++m) ri[ai][m] = rinv[row0 + ai * 128 + m * 16];
    if (isg) {
      f32x4 b[2][2];
#pragma unroll
      for (int bj = 0; bj < 2; ++bj) { const float* bp = bg + (col0 - U_GL) + bj * 128; b[bj][0] = *(const f32x4*)bp; b[bj][1] = *(const f32x4*)(bp + 4); }
#pragma unroll
      for (int ai = 0; ai < 2; ++ai)
#pragma unroll
        for (int m = 0; m < 4; ++m)
#pragma unroll
          for (int bj = 0; bj < 2; ++bj) {
            f32x4 v0 = acc[ai][bj][m][0] * ri[ai][m] + b[bj][0], v1 = acc[ai][bj][m][1] * ri[ai][m] + b[bj][1];
#pragma unroll
            for (int j = 0; j < 4; ++j) { v0[j] = 1.0f + fminf(fexp2(-v0[j] * LOG2E), 1e30f); v1[j] = 1.0f + fminf(fexp2(-v1[j] * LOG2E), 1e30f); }
            u32x4 pk = {cvt_pk_bf16(v0[0], v0[1]), cvt_pk_bf16(v0[2], v0[3]), cvt_pk_bf16(v1[0], v1[1]), cvt_pk_bf16(v1[2], v1[3])};
            __builtin_nontemporal_store(pk, (u32x4*)(U + (size_t)(row0 + ai * 128 + m * 16) * UW + col0 + bj * 128));
          }
    } else {
#pragma unroll
      for (int ai = 0; ai < 2; ++ai)
#pragma unroll
        for (int m = 0; m < 4; ++m)
#pragma unroll
          for (int bj = 0; bj < 2; ++bj) {
            const f32x4 v0 = acc[ai][bj][m][0] * ri[ai][m], v1 = acc[ai][bj][m][1] * ri[ai][m];
            u32x4 pk = {cvt_pk_bf16(v0[0], v0[1]), cvt_pk_bf16(v0[2], v0[3]), cvt_pk_bf16(v1[0], v1[1]), cvt_pk_bf16(v1[2], v1[3])};
            __builtin_nontemporal_store(pk, (u32x4*)(U + (size_t)(row0 + ai * 128 + m * 16) * UW + col0 + bj * 128));
          }
    }
  }
};

struct EpiVT {
  static constexpr bool HOOK = false;
  bf16_t* VT; const float* rv; int L, lshift;
  __device__ __forceinline__ void hook(f32x4 (&)[2][2][4][2], const Unit&, int, int, int, int, int) const {}
  __device__ __forceinline__ void operator()(const f32x4 (&acc)[2][2][4][2], const Unit& u, int wr, int wc, int fr, int fq) const {
    asm volatile("" : "+v"(fr), "+v"(fq));
    const int vrow0 = u.pm * 256 + wr * 64 + fr, pcol0 = u.pn * 256 + wc * 32 + 8 * fq;
    const int ds = u.pm <= 4 ? 0 : (u.pm == 5 ? 2 : 4);
    const int Mc = L >> ds;
#pragma unroll
    for (int bj = 0; bj < 2; ++bj) {
      const int p0 = pcol0 + bj * 128, seq = p0 >> lshift, pos = p0 & (L - 1);
      const int r = pos / Mc, m0 = pos & (Mc - 1);
      float rinv[8];
#pragma unroll
      for (int j = 0; j < 8; ++j) rinv[j] = rv[(seq << lshift) + ((m0 + j) << ds) + r];
      bf16_t* vb = VT + ((size_t)seq * VW + vrow0) * L + pos;
#pragma unroll
      for (int ai = 0; ai < 2; ++ai)
#pragma unroll
        for (int m = 0; m < 4; ++m) {
          const f32x4 v0 = acc[ai][bj][m][0], v1 = acc[ai][bj][m][1];
          u32x4 pk = {cvt_pk_bf16(v0[0] * rinv[0], v0[1] * rinv[1]), cvt_pk_bf16(v0[2] * rinv[2], v0[3] * rinv[3]),
                      cvt_pk_bf16(v1[0] * rinv[4], v1[1] * rinv[5]), cvt_pk_bf16(v1[2] * rinv[6], v1[3] * rinv[7])};
          __builtin_nontemporal_store(pk, (u32x4*)(vb + (size_t)(ai * 128 + m * 16) * L));
        }
    }
  }
};

struct EpiMerge {
  static constexpr bool HOOK = true;
  const bf16_t* U; bf16_t* MG;
  __device__ __forceinline__ f32x4 gvec(int i, size_t row, int col) const {
    const u32x2 raw = *(const u32x2*)(U + row * UW + U_GL + i * 1024 + col);
    f32x4 e; e[0] = bf_lo(raw[0]); e[1] = bf_hi(raw[0]); e[2] = bf_lo(raw[1]); e[3] = bf_hi(raw[1]); return e;
  }
  __device__ __forceinline__ void hook(f32x4 (&acc)[2][2][4][2], const Unit& u, int t, int wr, int wc, int fr, int fq) const {
    const int i = (t == 8) ? 0 : 1;
    asm volatile("" : "+v"(fr), "+v"(fq));
    const int row0 = u.pm * 256 + wr * 64 + fr, col0 = u.pn * 256 + wc * 32 + 8 * fq;
#pragma unroll
    for (int ai = 0; ai < 2; ++ai) {
#pragma unroll
      for (int m = 0; m < 4; ++m)
#pragma unroll
        for (int bj = 0; bj < 2; ++bj) {
          const bf16_t* gp = U + (size_t)(row0 + ai * 128 + m * 16) * UW + U_GL + i * 1024 + col0 + bj * 128;
          const u32x4 a = *(const u32x4*)gp, b = *(const u32x4*)(gp + 1024);
#pragma unroll
          for (int n = 0; n < 2; ++n) {
            f32x4 r;
            r[0] = bf_lo(b[2 * n]) * frcp(bf_lo(a[2 * n])); r[1] = bf_hi(b[2 * n]) * frcp(bf_hi(a[2 * n]));
            r[2] = bf_lo(b[2 * n + 1]) * frcp(bf_lo(a[2 * n + 1])); r[3] = bf_hi(b[2 * n + 1]) * frcp(bf_hi(a[2 * n + 1]));
            acc[ai][bj][m][n] *= r;
          }
        }
      __builtin_amdgcn_sched_barrier(0);
    }
  }
  __device__ __forceinline__ void operator()(const f32x4 (&acc)[2][2][4][2], const Unit& u, int wr, int wc, int fr, int fq) const {
    asm volatile("" : "+v"(fr), "+v"(fq));
    const int row0 = u.pm * 256 + wr * 64 + fr, col0 = u.pn * 256 + wc * 32 + 8 * fq;
    u32x4 g2[2][4][2];
#pragma unroll
    for (int ai = 0; ai < 2; ++ai)
#pragma unroll
      for (int m = 0; m < 4; ++m)
#pragma unroll
        for (int bj = 0; bj < 2; ++bj) g2[ai][m][bj] = *(const u32x4*)(U + (size_t)(row0 + ai * 128 + m * 16) * UW + U_GL + 2 * 1024 + col0 + bj * 128);
    __builtin_amdgcn_sched_barrier(0);
#pragma unroll
    for (int ai = 0; ai < 2; ++ai)
#pragma unroll
      for (int m = 0; m < 4; ++m)
#pragma unroll
        for (int bj = 0; bj < 2; ++bj) {
          const size_t row = (size_t)(row0 + ai * 128 + m * 16); const int col = col0 + bj * 128;
          const u32x4 g = g2[ai][m][bj];
          f32x4 v0 = acc[ai][bj][m][0], v1 = acc[ai][bj][m][1];
          v0[0] *= frcp(bf_lo(g[0])); v0[1] *= frcp(bf_hi(g[0])); v0[2] *= frcp(bf_lo(g[1])); v0[3] *= frcp(bf_hi(g[1]));
          v1[0] *= frcp(bf_lo(g[2])); v1[1] *= frcp(bf_hi(g[2])); v1[2] *= frcp(bf_lo(g[3])); v1[3] *= frcp(bf_hi(g[3]));
          u32x4 pk = {cvt_pk_bf16(v0[0], v0[1]), cvt_pk_bf16(v0[2], v0[3]), cvt_pk_bf16(v1[0], v1[1]), cvt_pk_bf16(v1[2], v1[3])};
          *(u32x4*)(MG + row * DM + col) = pk;
        }
  }
};

struct EpiRes {
  static constexpr bool HOOK = false;
  const float* R32; const bf16_t* RB; float* X; bf16_t* XB; float* ssq;
  __device__ __forceinline__ void hook(f32x4 (&)[2][2][4][2], const Unit&, int, int, int, int, int) const {}
  __device__ __forceinline__ void operator()(const f32x4 (&acc)[2][2][4][2], const Unit& u, int wr, int wc, int fr, int fq) const {
    asm volatile("" : "+v"(fr), "+v"(fq));
    const int row0 = u.pm * 256 + wr * 64 + fr, col0 = u.pn * 256 + wc * 32 + 8 * fq;
#pragma unroll
    for (int ai = 0; ai < 2; ++ai) {
      f32x4 r[4][2][2];
      if (R32) {
#pragma unroll
        for (int m = 0; m < 4; ++m)
#pragma unroll
          for (int bj = 0; bj < 2; ++bj) { const float* rp = R32 + (size_t)(row0 + ai * 128 + m * 16) * DM + col0 + bj * 128; r[m][bj][0] = *(const f32x4*)rp; r[m][bj][1] = *(const f32x4*)(rp + 4); }
      } else {
        u32x4 rb[4][2];
#pragma unroll
        for (int m = 0; m < 4; ++m)
#pragma unroll
          for (int bj = 0; bj < 2; ++bj) rb[m][bj] = *(const u32x4*)(RB + (size_t)(row0 + ai * 128 + m * 16) * DM + col0 + bj * 128);
#pragma unroll
        for (int m = 0; m < 4; ++m)
#pragma unroll
          for (int bj = 0; bj < 2; ++bj) {
            r[m][bj][0] = (f32x4){bf_lo(rb[m][bj][0]), bf_hi(rb[m][bj][0]), bf_lo(rb[m][bj][1]), bf_hi(rb[m][bj][1])};
            r[m][bj][1] = (f32x4){bf_lo(rb[m][bj][2]), bf_hi(rb[m][bj][2]), bf_lo(rb[m][bj][3]), bf_hi(rb[m][bj][3])};
          }
      }
      __builtin_amdgcn_sched_barrier(0);
#pragma unroll
      for (int m = 0; m < 4; ++m) {
        const size_t row = (size_t)(row0 + ai * 128 + m * 16);
        float s = 0.f;
#pragma unroll
        for (int bj = 0; bj < 2; ++bj) {
          const int col = col0 + bj * 128;
          const f32x4 v0 = r[m][bj][0] + acc[ai][bj][m][0], v1 = r[m][bj][1] + acc[ai][bj][m][1];
          s += v0[0] * v0[0] + v0[1] * v0[1] + v0[2] * v0[2] + v0[3] * v0[3] + v1[0] * v1[0] + v1[1] * v1[1] + v1[2] * v1[2] + v1[3] * v1[3];
          if (X) { *(f32x4*)(X + row * DM + col) = v0; *(f32x4*)(X + row * DM + col + 4) = v1; }
          else { u32x4 pk = {cvt_pk_bf16(v0[0], v0[1]), cvt_pk_bf16(v0[2], v0[3]), cvt_pk_bf16(v1[0], v1[1]), cvt_pk_bf16(v1[2], v1[3])};
                 *(u32x4*)(XB + row * DM + col) = pk; }
        }
        s += __shfl_xor(s, 16); s += __shfl_xor(s, 32);
        if (fq == 0) ssq[row * 16 + u.pn * 4 + wc] = s;
      }
      __builtin_amdgcn_sched_barrier(0);
    }
  }
};

__device__ __forceinline__ void prep_tile(const float* src, int ldn, int k0, int n0, const float* rscale, float cscale, bf16_t* dst, int ldd, int drow0, int dk0, LAS float* tile) {
  const int tid = opaque_tid(), kk = tid >> 6, nn = tid & 63;
#pragma unroll
  for (int i = 0; i < 8; ++i) {
    const int k = kk * 8 + i;
    float v = src[(size_t)(k0 + k) * ldn + n0 + nn] * cscale;
    if (rscale) v *= rscale[k0 + k];
    tile[k * 65 + nn] = v;
  }
  __syncthreads();
  const int n = tid >> 3, kc = tid & 7;
  float f[8];
#pragma unroll
  for (int j = 0; j < 8; ++j) f[j] = tile[(kc * 8 + j) * 65 + n];
  u32x4 pk = {cvt_pk_bf16(f[0], f[1]), cvt_pk_bf16(f[2], f[3]), cvt_pk_bf16(f[4], f[5]), cvt_pk_bf16(f[6], f[7])};
  *(u32x4*)(dst + (size_t)(drow0 + n) * ldd + dk0 + kc * 8) = pk;
  __syncthreads();
}

__device__ __forceinline__ void win_map(int n0, int& dn0, float& sc) {
  sc = 1.0f;
  if (n0 < 512) { dn0 = U_QA + n0; sc = QSCALE; }
  else if (n0 < 1024) dn0 = U_KA + (n0 - 512);
  else if (n0 < 1536) dn0 = UW + V_A + (n0 - 1024);
  else if (n0 < 2048) dn0 = U_ZA + (n0 - 1536);
  else if (n0 < 2560) { dn0 = U_QB + (n0 - 2048); sc = QSCALE; }
  else if (n0 < 3072) dn0 = U_KB + (n0 - 2560);
  else if (n0 < 3584) dn0 = UW + V_B + (n0 - 3072);
  else if (n0 < 4096) dn0 = U_ZB + (n0 - 3584);
  else if (n0 < 4864) { dn0 = U_QC + (n0 - 4096); sc = QSCALE; }
  else if (n0 < 5632) dn0 = U_KC + (n0 - 4864);
  else if (n0 < 6400) dn0 = UW + V_C + (n0 - 5632);
  else if (n0 < 6656) dn0 = U_ZC + (n0 - 6400);
  else dn0 = U_GL + (n0 - 6656);
}

__device__ void phase_prep(const Params& p, LAS float* tile) {
  constexpr int PER = 3008;
  for (int it = blockIdx.x; it < DEPTH * PER; it += gridDim.x) {
    const int l = it / PER; int r = it % PER;
    if (r < 2432) {
      const int kt = r / 152, ntile = r % 152; int dn0; float sc; win_map(ntile * 64, dn0, sc);
      prep_tile(p.w_in + (size_t)l * DM * INW, INW, kt * 64, ntile * 64, p.g_norm + l * DM, sc, p.wt_in + (size_t)l * INW * DM, DM, dn0, kt * 64, tile);
    } else if ((r -= 2432) < 128) {
      const int kt = r / 16, ntile = r % 16;
      prep_tile(p.w_br_a + (size_t)l * 512 * DM, DM, kt * 64, ntile * 64, nullptr, 1.0f, p.wt_br + (size_t)l * DM * YW, YW, ntile * 64, kt * 64, tile);
    } else if ((r -= 128) < 128) {
      const int kt = r / 16, ntile = r % 16;
      prep_tile(p.w_br_b + (size_t)l * 512 * DM, DM, kt * 64, ntile * 64, nullptr, 1.0f, p.wt_br + (size_t)l * DM * YW, YW, ntile * 64, 512 + kt * 64, tile);
    } else if ((r -= 128) < 64) {
      const int kt = r / 16, ntile = r % 16;
      prep_tile(p.w_br_c + (size_t)l * 256 * DM, DM, kt * 64, ntile * 64, nullptr, 1.0f, p.wt_br + (size_t)l * DM * YW, YW, ntile * 64, 1024 + kt * 64, tile);
    } else {
      r -= 64; const int kt = r / 16, ntile = r % 16;
      prep_tile(p.w_out + (size_t)l * DM * DM, DM, kt * 64, ntile * 64, nullptr, 1.0f, p.wt_out + (size_t)l * DM * DM, DM, ntile * 64, kt * 64, tile);
    }
  }
  const int ptid = opaque_tid();
  if (blockIdx.x == 0 && ptid < 64) {
    const int lane = ptid;
    for (int l = 0; l < DEPTH; ++l) {
      const float* lq = p.lam_qk + l * 256;
      float a = lq[lane] * lq[64 + lane], b = lq[128 + lane] * lq[192 + lane];
      for (int o = 32; o >= 1; o >>= 1) { a += __shfl_xor(a, o); b += __shfl_xor(b, o); }
      if (lane == 0) { const float li = 0.8f - 0.6f * expf(-0.3f * (float)l); p.lam[l] = expf(a) - expf(b) + li; p.lam[4 + l] = 1.0f - li; }
    }
  }
}

__device__ void phase_x(const Params& p, int chunk) {
  const float* xin = (chunk < 2) ? p.xp + (size_t)chunk * TC * DM : p.xs + (size_t)(chunk - 2) * TC * DM;
  float* ssq = p.ssq + (size_t)chunk * TC * 16;
  const int tid = opaque_tid(), lane = tid & 63, w = blockIdx.x * 8 + (tid >> 6), nw = gridDim.x * 8;
  for (int row = w; row < TC; row += nw) {
    const float* xr = xin + (size_t)row * DM + lane * 16;
    f32x4 v[4]; float s = 0.f;
#pragma unroll
    for (int i = 0; i < 4; ++i) { v[i] = *(const f32x4*)(xr + i * 4); s += v[i][0] * v[i][0] + v[i][1] * v[i][1] + v[i][2] * v[i][2] + v[i][3] * v[i][3]; }
    for (int o = 32; o >= 1; o >>= 1) s += __shfl_xor(s, o);
    u32x4 p0 = {cvt_pk_bf16(v[0][0], v[0][1]), cvt_pk_bf16(v[0][2], v[0][3]), cvt_pk_bf16(v[1][0], v[1][1]), cvt_pk_bf16(v[1][2], v[1][3])};
    u32x4 p1 = {cvt_pk_bf16(v[2][0], v[2][1]), cvt_pk_bf16(v[2][2], v[2][3]), cvt_pk_bf16(v[3][0], v[3][1]), cvt_pk_bf16(v[3][2], v[3][3])};
    bf16_t* xo = p.xb + (size_t)row * DM + lane * 16;
    *(u32x4*)xo = p0; *(u32x4*)(xo + 8) = p1;
    if (lane < 16) ssq[(size_t)row * 16 + lane] = (lane == 0) ? s : 0.f;
    if (lane == 0) p.rinv[(size_t)chunk * TC + row] = rsqrtf(s * (1.0f / 1024.0f) + 1e-6f);
  }
}

__device__ void phase_rinv(const Params& p, int chunk) {
  const float* ssq = p.ssq + (size_t)chunk * TC * 16; float* rv = p.rinv + (size_t)chunk * TC;
  for (int row = blockIdx.x * 512 + opaque_tid(); row < TC; row += gridDim.x * 512) {
    const f32x4* sp = (const f32x4*)(ssq + (size_t)row * 16);
    const f32x4 a4 = sp[0] + sp[1] + sp[2] + sp[3];
    rv[row] = rsqrtf((a4[0] + a4[1] + a4[2] + a4[3]) * (1.0f / 1024.0f) + 1e-6f);
  }
}

__device__ void phase_final(const Params& p, int chunk) {
  float* x = p.out + (size_t)chunk * TC * DM;
  const float* ssq = p.ssq + (size_t)chunk * TC * 16;
  const int tid = opaque_tid(), lane = tid & 63, w = blockIdx.x * 8 + (tid >> 6), nw = gridDim.x * 8;
  for (int row = w; row < TC; row += nw) {
    const f32x4* sp = (const f32x4*)(ssq + (size_t)row * 16);
    const f32x4 a4 = sp[0] + sp[1] + sp[2] + sp[3];
    const float rinv = rsqrtf((a4[0] + a4[1] + a4[2] + a4[3]) * (1.0f / 1024.0f) + 1e-6f);
    float* xr = x + (size_t)row * DM + lane * 16;
#pragma unroll
    for (int i = 0; i < 4; ++i) { f32x4 v = *(const f32x4*)(xr + i * 4); const f32x4 g = *(const f32x4*)(p.g_final + lane * 16 + i * 4); v = v * rinv * g; *(f32x4*)(xr + i * 4) = v; }
  }
}

__device__ __forceinline__ f32x16 mfma32(bf16x8 a, bf16x8 b, f32x16 c) { return __builtin_amdgcn_mfma_f32_32x32x16_bf16(a, b, c, 0, 0, 0); }
__device__ __forceinline__ bf16x8 ld16(const bf16_t* p) { return *(const bf16x8*)p; }
__device__ __forceinline__ bf16x8 ld8x2(const bf16_t* p0, const bf16_t* p1) { const bf16x4 a = *(const bf16x4*)p0, b = *(const bf16x4*)p1; return __builtin_shufflevector(a, b, 0, 1, 2, 3, 4, 5, 6, 7); }

__device__ __forceinline__ float xhalf_max(float v) { const auto rr = __builtin_amdgcn_permlane32_swap(__float_as_uint(v), __float_as_uint(v), false, false); return fmaxf(__uint_as_float(rr[0]), __uint_as_float(rr[1])); }
__device__ __forceinline__ float xhalf_sum(float v) { const auto rr = __builtin_amdgcn_permlane32_swap(__float_as_uint(v), __float_as_uint(v), false, false); return __uint_as_float(rr[0]) + __uint_as_float(rr[1]); }
__device__ __forceinline__ void softmax_tile(f32x16& t, float& m, float& l, float& alpha, bf16x8& p0, bf16x8& p1) {
  float tm = t[0];
#pragma unroll
  for (int i = 1; i < 16; ++i) tm = fmaxf(tm, t[i]);
  tm = xhalf_max(tm);
  const float mn = fmaxf(m, tm);
  alpha = fexp2(m - mn); m = mn;
  float ls = 0.f;
#pragma unroll
  for (int i = 0; i < 16; ++i) { t[i] = fexp2(t[i] - mn); ls += t[i]; }
  l = l * alpha + ls;
  const u32x4 a = {cvt_pk_bf16(t[0], t[1]), cvt_pk_bf16(t[2], t[3]), cvt_pk_bf16(t[4], t[5]), cvt_pk_bf16(t[6], t[7])};
  const u32x4 b = {cvt_pk_bf16(t[8], t[9]), cvt_pk_bf16(t[10], t[11]), cvt_pk_bf16(t[12], t[13]), cvt_pk_bf16(t[14], t[15])};
  p0 = __builtin_bit_cast(bf16x8, a); p1 = __builtin_bit_cast(bf16x8, b);
}
__device__ __forceinline__ f32x16 zero16() { f32x16 z;
#pragma unroll
  for (int i = 0; i < 16; ++i) z[i] = 0.f; return z; }
__device__ __forceinline__ float silu(float z) { return z * frcp(1.0f + fexp2(-z * LOG2E)); }

constexpr int TB_ROW = 144;
constexpr int KB_BYTES = 64 * TB_ROW;
constexpr int VB_BYTES = 128 * TB_ROW;
constexpr int LDS_K = 0, LDS_V = LDS_K + 2 * KB_BYTES, LDS_ATT_END = LDS_V + 2 * VB_BYTES, LDS_ATT_TOTAL = LDS_ATT_END + 65536;
template <int SIDE>
__device__ __forceinline__ void b_far_subtile(const LAS unsigned char* kb, const LAS unsigned char* vb, int rd, int sub, const bf16x8 (&qf)[4], const f32x16& bp, float slope2, float d0,
                                              float& mrun, float& lrun, f32x16 (&o)[4]) {
  const float base = (SIDE > 0 ? -slope2 : slope2) * d0 - mrun;
  f32x16 sc;
#pragma unroll
  for (int i = 0; i < 16; ++i) sc[i] = SIDE > 0 ? base - bp[i] : base + bp[i];
#pragma unroll
  for (int ks = 0; ks < 4; ++ks) sc = mfma32(*(const LAS bf16x8*)(kb + rd + sub * 32 * TB_ROW + ks * 32), qf[ks], sc);
  float tm = sc[0];
#pragma unroll
  for (int i = 1; i < 16; ++i) tm = fmaxf(tm, sc[i]);
  tm = xhalf_max(tm);
  if (__builtin_amdgcn_ballot_w64(tm > 0.0f) != 0) {
    const float delta = fmaxf(tm, 0.0f);
    const float al = fexp2(-delta);
    mrun += delta; lrun *= al;
#pragma unroll
    for (int i = 0; i < 16; ++i) sc[i] -= delta;
#pragma unroll
    for (int dt = 0; dt < 4; ++dt) o[dt] *= al;
  }
#pragma unroll
  for (int i = 0; i < 16; ++i) sc[i] = fexp2(sc[i]);
  { const f32x4 a4 = (f32x4){sc[0], sc[1], sc[2], sc[3]} + (f32x4){sc[4], sc[5], sc[6], sc[7]} + (f32x4){sc[8], sc[9], sc[10], sc[11]} + (f32x4){sc[12], sc[13], sc[14], sc[15]};
    lrun += (a4[0] + a4[1]) + (a4[2] + a4[3]); }
  const u32x4 pa = {cvt_pk_bf16(sc[0], sc[1]), cvt_pk_bf16(sc[2], sc[3]), cvt_pk_bf16(sc[4], sc[5]), cvt_pk_bf16(sc[6], sc[7])};
  const u32x4 pb = {cvt_pk_bf16(sc[8], sc[9]), cvt_pk_bf16(sc[10], sc[11]), cvt_pk_bf16(sc[12], sc[13]), cvt_pk_bf16(sc[14], sc[15])};
  const bf16x8 pk0 = __builtin_bit_cast(bf16x8, pa), pk1 = __builtin_bit_cast(bf16x8, pb);
#pragma unroll
  for (int dt = 0; dt < 4; ++dt) {
    o[dt] = mfma32(*(const LAS bf16x8*)(vb + rd + dt * 32 * TB_ROW + (sub * 2) * 32), pk0, o[dt]);
    o[dt] = mfma32(*(const LAS bf16x8*)(vb + rd + dt * 32 * TB_ROW + (sub * 2 + 1) * 32), pk1, o[dt]);
  }
}

__device__ __forceinline__ void attn_b_pass(const Params& p, int L, int seq, int h, int mp, int qblk, int tq, int tid, float slope2, LAS unsigned char* lds, f32x16 (&o)[4], float& linv) {
  const int lane = tid & 63, q = lane & 31, half = lane >> 5;
  const size_t tokbase = (size_t)seq * L;
  bf16x8 qf[4];
  { const bf16_t* qp = p.u + (tokbase + tq) * UW + U_QB + h * 128 + mp * 64 + half * 8;
#pragma unroll
    for (int ks = 0; ks < 4; ++ks) qf[ks] = ld16(qp + ks * 16); }
  const int spart = tid & 7, srow = tid >> 3;
  const bf16_t* kg = p.u + (tokbase + srow) * UW + U_KB + h * 128 + mp * 64 + spart * 8;
  const bf16_t* vg = p.vt + ((size_t)seq * VW + V_B + h * 128 + srow) * L + spart * 8;
  const int kst = srow * TB_ROW + spart * 16;
  const int vst = srow * TB_ROW + ((spart >> 1) * 16 + (spart & 1) * 4) * 2;
  const int rd = q * TB_ROW + half * 16;
#pragma unroll
  for (int dt = 0; dt < 4; ++dt) o[dt] = zero16();
  float mrun = -1e30f, lrun = 0.f;
  f32x16 bp;
#pragma unroll
  for (int i = 0; i < 16; ++i) bp[i] = slope2 * (float)((i >> 2) * 8 + (i & 3));
  const int ntile = L >> 6, t0 = qblk * 4, nR = ntile - t0;
  auto tile_of = [&](int idx) { return idx < nR ? t0 + idx : (t0 - 1) - (idx - nR); };
  bf16x8 krA, vrA0, vrA1, krB, vrB0, vrB1;
  auto gload = [&](int idx, bf16x8& kr, bf16x8& v0, bf16x8& v1) { const int kn = tile_of(idx) * 64; kr = ld16(kg + (size_t)kn * UW); v0 = ld16(vg + kn); v1 = ld16(vg + (size_t)64 * L + kn); };
  auto lwrite = [&](int buf, const bf16x8& kr, const bf16x8& v0, const bf16x8& v1) {
    LAS unsigned char* kb = lds + LDS_K + buf * KB_BYTES; LAS unsigned char* vb = lds + LDS_V + buf * VB_BYTES;
    *(LAS bf16x8*)(kb + kst) = kr;
    *(LAS bf16x4*)(vb + vst) = __builtin_shufflevector(v0, v0, 0, 1, 2, 3); *(LAS bf16x4*)(vb + vst + 16) = __builtin_shufflevector(v0, v0, 4, 5, 6, 7);
    *(LAS bf16x4*)(vb + vst + 64 * TB_ROW) = __builtin_shufflevector(v1, v1, 0, 1, 2, 3); *(LAS bf16x4*)(vb + vst + 64 * TB_ROW + 16) = __builtin_shufflevector(v1, v1, 4, 5, 6, 7);
  };
  auto compute = [&](int idx, int buf) {
    const int k0 = tile_of(idx) * 64;
    const LAS unsigned char* kb = lds + LDS_K + buf * KB_BYTES;
    const LAS unsigned char* vb = lds + LDS_V + buf * VB_BYTES;
    if (idx < 4) {
#pragma unroll
      for (int sub = 0; sub < 2; ++sub) {
        f32x16 sc = zero16();
#pragma unroll
        for (int ks = 0; ks < 4; ++ks) sc = mfma32(*(const LAS bf16x8*)(kb + rd + sub * 32 * TB_ROW + ks * 32), qf[ks], sc);
        const float d0 = (float)(k0 + sub * 32 + half * 4 - tq);
#pragma unroll
        for (int i = 0; i < 16; ++i) sc[i] -= slope2 * fabsf(d0 + (float)((i >> 2) * 8 + (i & 3)));
        float al; bf16x8 pk[2];
        softmax_tile(sc, mrun, lrun, al, pk[0], pk[1]);
        if (__builtin_amdgcn_ballot_w64(al != 1.0f) != 0) {
#pragma unroll
          for (int dt = 0; dt < 4; ++dt) o[dt] *= al;
        }
#pragma unroll
        for (int dt = 0; dt < 4; ++dt)
#pragma unroll
          for (int s2 = 0; s2 < 2; ++s2) o[dt] = mfma32(*(const LAS bf16x8*)(vb + rd + dt * 32 * TB_ROW + (sub * 2 + s2) * 32), pk[s2], o[dt]);
      }
    } else if (idx < nR) {
#pragma unroll
      for (int sub = 0; sub < 2; ++sub) b_far_subtile<1>(kb, vb, rd, sub, qf, bp, slope2, (float)(k0 + sub * 32 + half * 4 - tq), mrun, lrun, o);
    } else {
#pragma unroll
      for (int sub = 0; sub < 2; ++sub) b_far_subtile<-1>(kb, vb, rd, sub, qf, bp, slope2, (float)(k0 + sub * 32 + half * 4 - tq), mrun, lrun, o);
    }
  };
  gload(0, krA, vrA0, vrA1);
  gload(1, krB, vrB0, vrB1);
  lwrite(0, krA, vrA0, vrA1);
  asm volatile("" : "+v"(qf[0]), "+v"(qf[1]), "+v"(qf[2]), "+v"(qf[3]));
  asm volatile("" : "+v"(krB), "+v"(vrB0), "+v"(vrB1));
  __syncthreads();
#pragma unroll 1
  for (int idx = 0; idx < ntile; idx += 2) {
    if (idx + 2 < ntile) gload(idx + 2, krA, vrA0, vrA1);
    compute(idx, 0);
    lwrite(1, krB, vrB0, vrB1);
    __syncthreads();
    if (idx + 3 < ntile) gload(idx + 3, krB, vrB0, vrB1);
    compute(idx + 1, 1);
    if (idx + 2 < ntile) lwrite(0, krA, vrA0, vrA1);
    __syncthreads();
  }
  linv = frcp(xhalf_sum(lrun));
}
__device__ void attn_b_block(const Params& p, int layer, int L, int seq, int h, int qblk, LAS unsigned char* lds) {
  const int tid = opaque_tid(), lane = tid & 63, wid = __builtin_amdgcn_readfirstlane(tid >> 6);
  const int q = lane & 31, half = lane >> 5;
  const size_t tokbase = (size_t)seq * L;
  const int tq = qblk * 256 + wid * 32 + q;
  const float slope2 = exp2f(-2.0f * (float)(h + 1)) * LOG2E;
  f32x16 o0[4]; float li0, li1;
  LAS u32x4* park = (LAS u32x4*)(lds + LDS_ATT_END) + wid * 512 + lane;
  attn_b_pass(p, L, seq, h, 0, qblk, tq, tid, slope2, lds, o0, li0);
#pragma unroll
  for (int dt = 0; dt < 4; ++dt)
#pragma unroll
    for (int g2 = 0; g2 < 2; ++g2) {
      u32x4 pk;
#pragma unroll
      for (int k = 0; k < 4; ++k) pk[k] = cvt_pk_bf16(o0[dt][g2 * 8 + 2 * k] * li0, o0[dt][g2 * 8 + 2 * k + 1] * li0);
      park[(dt * 2 + g2) * 64] = pk;
    }
  attn_b_pass(p, L, seq, h, 1, qblk, tq, tid, slope2, lds, o0, li1);
  const float c1 = p.lam[layer] * li1;
  const int tid2 = opaque_tid(), half2 = (tid2 >> 5) & 1;
  const size_t tok2 = (size_t)seq * L + qblk * 256 + (tid2 >> 6) * 32 + (tid2 & 31);
  float ss = 0.f;
#pragma unroll
  for (int dt = 0; dt < 4; ++dt)
#pragma unroll
    for (int g2 = 0; g2 < 2; ++g2) {
      const u32x4 pk = park[(dt * 2 + g2) * 64];
#pragma unroll
      for (int k = 0; k < 4; ++k) {
        const float va = bf_lo(pk[k]) - o0[dt][g2 * 8 + 2 * k] * c1, vb = bf_hi(pk[k]) - o0[dt][g2 * 8 + 2 * k + 1] * c1;
        o0[dt][g2 * 8 + 2 * k] = va; o0[dt][g2 * 8 + 2 * k + 1] = vb; ss += va * va + vb * vb;
      }
    }
  ss = xhalf_sum(ss);
  const float rn = rsqrtf(ss * (1.0f / 128.0f) + 1e-6f) * p.lam[4 + layer];
  const float* gd = p.g_diff + layer * 128;
  bf16_t* yrow = p.yg + tok2 * YW + 512 + h * 128;
  const bf16_t* zrow = p.u + tok2 * UW + U_ZB + h * 128;
#pragma unroll
  for (int dt = 0; dt < 4; ++dt)
#pragma unroll
    for (int g4 = 0; g4 < 4; ++g4) {
      const int dim = dt * 32 + g4 * 8 + half2 * 4;
      const u32x2 zr = *(const u32x2*)(zrow + dim);
      const f32x4 gv = *(const f32x4*)(gd + dim);
      const float y0 = o0[dt][g4 * 4 + 0] * rn * gv[0] * silu(bf_lo(zr[0]));
      const float y1 = o0[dt][g4 * 4 + 1] * rn * gv[1] * silu(bf_hi(zr[0]));
      const float y2 = o0[dt][g4 * 4 + 2] * rn * gv[2] * silu(bf_lo(zr[1]));
      const float y3 = o0[dt][g4 * 4 + 3] * rn * gv[3] * silu(bf_hi(zr[1]));
      u32x2 pk = {cvt_pk_bf16(y0, y1), cvt_pk_bf16(y2, y3)};
      *(u32x2*)(yrow + dim) = pk;
    }
}

constexpr int LDS_AK = 0, LDS_AV = LDS_AK + 2 * KB_BYTES, LDS_ATAB = LDS_AV + 2 * KB_BYTES, ATAB_ROW = 128;
__device__ void attn_a_block(const Params& p, int layer, int L, int seq, int h, int r0, LAS unsigned char* lds) {
  const int tid = opaque_tid(), lane = tid & 63, wid = __builtin_amdgcn_readfirstlane(tid >> 6);
  const int q = lane & 31, half = lane >> 5;
  const size_t tokbase = (size_t)seq * L;
  const int rows = L >> 6;
  const int ra = r0 + (wid >> 2) * 2, c0 = (wid & 3) * 16;
  int kstart = c0 - 8; kstart = kstart < 0 ? 0 : (kstart > 32 ? 32 : kstart);
  const int qrow = ra + (q >> 4), qcol = c0 + (q & 15), tq = qrow * 64 + qcol;
  int rsq = qrow - 4; rsq = rsq < 0 ? 0 : (rsq > rows - 8 ? rows - 8 : rsq);
  int rsa = ra - 4; rsa = rsa < 0 ? 0 : (rsa > rows - 8 ? rows - 8 : rsa);
  int rsb = ra - 3; rsb = rsb < 0 ? 0 : (rsb > rows - 8 ? rows - 8 : rsb);
  int kr_lo = r0 - 4; kr_lo = kr_lo < 0 ? 0 : (kr_lo > rows - 8 ? rows - 8 : kr_lo);
  int kr_hi = r0 - 1; kr_hi = (kr_hi < 0 ? 0 : (kr_hi > rows - 8 ? rows - 8 : kr_hi)) + 7;
  int qstart = qcol - 8; qstart = qstart < 0 ? 0 : (qstart > 48 ? 48 : qstart);
  bf16x8 qf[4];
  { const bf16_t* qp = p.u + (tokbase + tq) * UW + U_QA + h * 64 + half * 8;
#pragma unroll
    for (int ks = 0; ks < 4; ++ks) qf[ks] = ld16(qp + ks * 16); }
  {
    LAS float* tab = (LAS float*)(lds + LDS_ATAB);
    const float* rpb = p.rpb + ((size_t)layer * 8 + h) * 15 * 31;
    for (int idx = tid; idx < 15 * ATAB_ROW; idx += 512) { const int row = idx >> 7, cc = (idx & 127) - 48; tab[idx] = (cc >= 0 && cc <= 30) ? rpb[row * 31 + cc] * LOG2E : 0.f; }
  }
  const int spart = tid & 7, srow = tid >> 3;
  const bf16_t* kg = p.u + (tokbase + srow) * UW + U_KA + h * 64 + spart * 8;
  const bf16_t* vg = p.vt + ((size_t)seq * VW + V_A + h * 64 + srow) * L + spart * 8;
  const int kst = srow * TB_ROW + spart * 16;
  const int vst = srow * TB_ROW + spart * 16;
  const int krd = (kstart + q) * TB_ROW + half * 16;
  const int vrd = q * TB_ROW + (kstart + half * 4) * 2;
  f32x16 o[2] = {zero16(), zero16()};
  float mrun = -1e30f, lrun = 0.f;
  bf16x8 kr_, vr_;
  kr_ = ld16(kg + (size_t)(kr_lo * 64) * UW); vr_ = ld16(vg + kr_lo * 64);
  *(LAS bf16x8*)(lds + LDS_AK + kst) = kr_;
  *(LAS bf16x8*)(lds + LDS_AV + vst) = vr_;
  asm volatile("" : "+v"(qf[0]), "+v"(qf[1]), "+v"(qf[2]), "+v"(qf[3]));
  __syncthreads();
#pragma unroll 1
  for (int kr = kr_lo; kr <= kr_hi; ++kr) {
    const int it = kr - kr_lo;
    const bool more = (kr < kr_hi);
    if (more) { kr_ = ld16(kg + (size_t)((kr + 1) * 64) * UW); vr_ = ld16(vg + (kr + 1) * 64); }
    const LAS unsigned char* kb = lds + LDS_AK + (it & 1) * KB_BYTES;
    const LAS unsigned char* vb = lds + LDS_AV + (it & 1) * KB_BYTES;
    if (kr >= rsa && kr < rsb + 8) {
      const bool rowok = (kr >= rsq) && (kr < rsq + 8);
      int trow_i = kr - qrow + 7; trow_i = trow_i < 0 ? 0 : (trow_i > 14 ? 14 : trow_i);
      const LAS float* trow = (const LAS float*)(lds + LDS_ATAB) + trow_i * ATAB_ROW + (kstart + half * 4 - qcol + 15 + 48);
      f32x16 sc = zero16();
#pragma unroll
      for (int ks = 0; ks < 4; ++ks) sc = mfma32(*(const LAS bf16x8*)(kb + krd + ks * 32), qf[ks], sc);
#pragma unroll
      for (int ii = 0; ii < 16; ++ii) {
        const int kcol = kstart + (ii >> 2) * 8 + half * 4 + (ii & 3);
        const bool ok = rowok && (kcol >= qstart) && (kcol < qstart + 16);
        sc[ii] = ok ? sc[ii] + trow[(ii >> 2) * 8 + (ii & 3)] : -INFINITY;
      }
      float al; bf16x8 pk[2];
      softmax_tile(sc, mrun, lrun, al, pk[0], pk[1]);
      if (__builtin_amdgcn_ballot_w64(al != 1.0f) != 0) { o[0] *= al; o[1] *= al; }
#pragma unroll
      for (int dt = 0; dt < 2; ++dt)
#pragma unroll
        for (int s2 = 0; s2 < 2; ++s2) {
          const LAS unsigned char* vp = vb + vrd + dt * 32 * TB_ROW + s2 * 32;
          const bf16x4 va = *(const LAS bf16x4*)vp, vc = *(const LAS bf16x4*)(vp + 16);
          o[dt] = mfma32(__builtin_shufflevector(va, vc, 0, 1, 2, 3, 4, 5, 6, 7), pk[s2], o[dt]);
        }
    }
    if (more) {
      *(LAS bf16x8*)(lds + LDS_AK + ((it + 1) & 1) * KB_BYTES + kst) = kr_;
      *(LAS bf16x8*)(lds + LDS_AV + ((it + 1) & 1) * KB_BYTES + vst) = vr_;
    }
    __syncthreads();
  }
  const float c = frcp(xhalf_sum(lrun));
  bf16_t* yrow = p.yg + (tokbase + tq) * YW + h * 64;
  const bf16_t* zrow = p.u + (tokbase + tq) * UW + U_ZA + h * 64;
#pragma unroll
  for (int dt = 0; dt < 2; ++dt)
#pragma unroll
    for (int g4 = 0; g4 < 4; ++g4) {
      const int dim = dt * 32 + g4 * 8 + half * 4;
      const u32x2 zr = *(const u32x2*)(zrow + dim);
      const float y0 = o[dt][g4 * 4 + 0] * c * silu(bf_lo(zr[0]));
      const float y1 = o[dt][g4 * 4 + 1] * c * silu(bf_hi(zr[0]));
      const float y2 = o[dt][g4 * 4 + 2] * c * silu(bf_lo(zr[1]));
      const float y3 = o[dt][g4 * 4 + 3] * c * silu(bf_hi(zr[1]));
      u32x2 pk = {cvt_pk_bf16(y0, y1), cvt_pk_bf16(y2, y3)};
      *(u32x2*)(yrow + dim) = pk;
    }
}

__device__ void attn_c_unit(const Params& p, int L, int lshift, int seq, int g, int h, int rr, int mblk, int lane) {
  const int q = lane & 31, half = lane >> 5;
  const size_t tokbase = (size_t)seq * L;
  const int ds = (g == 0) ? 0 : (g == 1 ? 2 : 4), d = 1 << ds, M = L >> ds;
  const int hh = g * 4 + h;
  const int m0 = mblk * 32, mq = m0 + q, tq = mq * d + rr;
  const bf16_t* urow = p.u + (tokbase + tq) * UW;
  bf16x8 qf[4];
#pragma unroll
  for (int ks = 0; ks < 4; ++ks) qf[ks] = ld16(urow + U_QC + hh * 64 + ks * 16 + half * 8);
  f32x16 o[2] = {zero16(), zero16()};
  float mrun = -1e30f, lrun = 0.f;
  const float coef = exp2f(-(2.0f / 3.0f) * (float)(hh + 1)) * (float)d * LOG2E;
  const bf16_t* vbase = p.vt + ((size_t)seq * VW + V_C + hh * 64 + q) * L + (size_t)rr * M;
  bf16x8 kf[5][4];
#pragma unroll
  for (int j = 0; j < 5; ++j) {
    int mkl = m0 - 64 + 32 * j + q; mkl = mkl < 0 ? 0 : (mkl > M - 1 ? M - 1 : mkl);
    const bf16_t* kp = p.u + (tokbase + (size_t)mkl * d + rr) * UW + U_KC + hh * 64 + half * 8;
#pragma unroll
    for (int ks = 0; ks < 4; ++ks) kf[j][ks] = ld16(kp + ks * 16);
  }
  bf16x8 vf[2][2][2];
  auto load_v = [&](int j, bf16x8 (&dst)[2][2]) {
#pragma unroll
    for (int dt = 0; dt < 2; ++dt)
#pragma unroll
      for (int s2 = 0; s2 < 2; ++s2) {
        int pa = m0 - 64 + 32 * j + s2 * 16 + half * 4, pb = pa + 8;
        pa = pa < 0 ? 0 : (pa > M - 4 ? M - 4 : pa); pb = pb < 0 ? 0 : (pb > M - 4 ? M - 4 : pb);
        const bf16_t* vp = vbase + (size_t)(dt * 32) * L;
        dst[dt][s2] = ld8x2(vp + pa, vp + pb);
      }
  };
  load_v(0, vf[0]);
#pragma unroll
  for (int j = 0; j < 5; ++j) {
    if (j + 1 < 5) load_v(j + 1, vf[(j + 1) & 1]);
    const int mk0 = m0 - 64 + 32 * j;
    if (mk0 + 32 <= 0 || mk0 >= M) continue;
    f32x16 s = zero16();
#pragma unroll
    for (int ks = 0; ks < 4; ++ks) s = mfma32(kf[j][ks], qf[ks], s);
#pragma unroll
    for (int ii = 0; ii < 16; ++ii) {
      const int mk = mk0 + (ii >> 2) * 8 + half * 4 + (ii & 3);
      const int rel = mk - mq; const int ar = rel < 0 ? -rel : rel;
      const bool ok = (mk >= 0) && (mk < M) && (ar <= 64);
      s[ii] = ok ? s[ii] - coef * (float)ar : -INFINITY;
    }
    float alpha; bf16x8 pk[2];
    softmax_tile(s, mrun, lrun, alpha, pk[0], pk[1]);
#pragma unroll
    for (int dt = 0; dt < 2; ++dt) {
      o[dt] *= alpha;
#pragma unroll
      for (int s2 = 0; s2 < 2; ++s2) o[dt] = mfma32(vf[j & 1][dt][s2], pk[s2], o[dt]);
    }
  }
  const float lt = xhalf_sum(lrun);
  const float c = frcp(lt);
  bf16_t* orow = p.oc + (tokbase + tq) * 768 + hh * 64;
#pragma unroll
  for (int dt = 0; dt < 2; ++dt)
#pragma unroll
    for (int g4 = 0; g4 < 4; ++g4) {
      const int dim = dt * 32 + g4 * 8 + half * 4;
      u32x2 pk = {cvt_pk_bf16(o[dt][g4 * 4 + 0] * c, o[dt][g4 * 4 + 1] * c), cvt_pk_bf16(o[dt][g4 * 4 + 2] * c, o[dt][g4 * 4 + 3] * c)};
      *(u32x2*)(orow + dim) = pk;
    }
  if (half == 0) p.lse[(tokbase + tq) * 12 + hh] = mrun + log2f(lt);
}

constexpr int CV_ROW = 784;
constexpr int LDS_CK = 0, LDS_CV = 384 * TB_ROW;
__device__ void attn_c_block(const Params& p, int L, int lshift, int seq, int g, int h, int pblk, LAS unsigned char* lds) {
  const int tid = opaque_tid(), lane = tid & 63, wid = __builtin_amdgcn_readfirstlane(tid >> 6);
  const int q = lane & 31, half = lane >> 5;
  const size_t tokbase = (size_t)seq * L;
  const int ds = (g == 0) ? 0 : (g == 1 ? 2 : 4), d = 1 << ds, M = L >> ds;
  const int hh = g * 4 + h;
  const int p0 = pblk * 256;
  {
    const int part = tid & 7;
#pragma unroll
    for (int c = 0; c < 6; ++c) {
      const int row = (tid >> 3) + c * 64;
      int pp = p0 - 64 + row; pp = pp < 0 ? 0 : (pp > L - 1 ? L - 1 : pp);
      const int tok = ((pp & (M - 1)) << ds) + (pp >> (lshift - ds));
      const bf16x8 v = ld16(p.u + (tokbase + tok) * UW + U_KC + hh * 64 + part * 8);
      *(LAS bf16x8*)(lds + LDS_CK + row * TB_ROW + part * 16) = v;
    }
#pragma unroll
    for (int c = 0; c < 6; ++c) {
      const int idx = tid + c * 512, dim = idx / 48, c8 = idx % 48;
      int pp = p0 - 64 + c8 * 8; pp = pp < 0 ? 0 : (pp > L - 8 ? L - 8 : pp);
      const bf16x8 v = ld16(p.vt + ((size_t)seq * VW + V_C + hh * 64 + dim) * L + pp);
      LAS unsigned char* dst = lds + LDS_CV + dim * CV_ROW + ((c8 >> 1) * 16 + (c8 & 1) * 4) * 2;
      *(LAS bf16x4*)dst = __builtin_shufflevector(v, v, 0, 1, 2, 3); *(LAS bf16x4*)(dst + 16) = __builtin_shufflevector(v, v, 4, 5, 6, 7);
    }
  }
  const int pw = p0 + wid * 32;
  const int rr = pw >> (lshift - ds), m0 = pw & (M - 1), mq = m0 + q, tq = mq * d + rr;
  bf16x8 qf[4];
  { const bf16_t* qp = p.u + (tokbase + tq) * UW + U_QC + hh * 64 + half * 8;
#pragma unroll
    for (int ks = 0; ks < 4; ++ks) qf[ks] = ld16(qp + ks * 16); }
  f32x16 o[2] = {zero16(), zero16()};
  float mrun = -1e30f, lrun = 0.f;
  const float coef = exp2f(-(2.0f / 3.0f) * (float)(hh + 1)) * (float)d * LOG2E;
  __syncthreads();
#pragma unroll
  for (int j = 0; j < 5; ++j) {
    const int mk0 = m0 - 64 + 32 * j;
    if (mk0 + 32 <= 0 || mk0 >= M) continue;
    const LAS unsigned char* kb = lds + LDS_CK + ((wid + j) * 32 + q) * TB_ROW + half * 16;
    f32x16 sc = zero16();
#pragma unroll
    for (int ks = 0; ks < 4; ++ks) sc = mfma32(*(const LAS bf16x8*)(kb + ks * 32), qf[ks], sc);
#pragma unroll
    for (int ii = 0; ii < 16; ++ii) {
      const int mk = mk0 + (ii >> 2) * 8 + half * 4 + (ii & 3);
      const int rel = mk - mq; const int ar = rel < 0 ? -rel : rel;
      const bool ok = (mk >= 0) && (mk < M) && (ar <= 64);
      sc[ii] = ok ? sc[ii] - coef * (float)ar : -INFINITY;
    }
    float alpha; bf16x8 pk[2];
    softmax_tile(sc, mrun, lrun, alpha, pk[0], pk[1]);
#pragma unroll
    for (int dt = 0; dt < 2; ++dt) {
      o[dt] *= alpha;
#pragma unroll
      for (int s2 = 0; s2 < 2; ++s2)
        o[dt] = mfma32(*(const LAS bf16x8*)(lds + LDS_CV + (dt * 32 + q) * CV_ROW + ((wid + j) * 32 + s2 * 16) * 2 + half * 16), pk[s2], o[dt]);
    }
  }
  __syncthreads();
  const float lt = xhalf_sum(lrun);
  const float c = frcp(lt);
  bf16_t* orow = p.oc + (tokbase + tq) * 768 + hh * 64;
#pragma unroll
  for (int dt = 0; dt < 2; ++dt)
#pragma unroll
    for (int g4 = 0; g4 < 4; ++g4) {
      const int dim = dt * 32 + g4 * 8 + half * 4;
      u32x2 pk = {cvt_pk_bf16(o[dt][g4 * 4 + 0] * c, o[dt][g4 * 4 + 1] * c), cvt_pk_bf16(o[dt][g4 * 4 + 2] * c, o[dt][g4 * 4 + 3] * c)};
      *(u32x2*)(orow + dim) = pk;
    }
  if (half == 0) p.lse[(tokbase + tq) * 12 + hh] = mrun + log2f(lt);
}

__device__ void phase_attn(const Params& p, int layer, int L, int lshift, LAS unsigned char* lds) {
  const int tiles = L >> 5;
  const int nseq = TC >> lshift;
  const int nw = gridDim.x * 8;
  int w, lane;
  { const int qblks = L >> 8, npairs = nseq * 4, nunits = npairs * qblks;
    for (int b = blockIdx.x; b < nunits; b += gridDim.x) {
      int pair, qblk;
      if ((gridDim.x & 7) == 0 && (npairs & 7) == 0 && nunits == (int)gridDim.x) { const int xcd = b & 7, j = b >> 3; pair = xcd * (npairs >> 3) + j / qblks; qblk = j % qblks; }
      else { pair = b / qblks; qblk = b % qblks; }
      attn_b_block(p, layer, L, pair >> 2, pair & 3, qblk, lds);
    }
  }
  { const int tid = opaque_tid(); lane = tid & 63; w = blockIdx.x * 8 + __builtin_amdgcn_readfirstlane(tid >> 6); }
  {
  { const int rgs = L >> 8, npairs = nseq * 8, nunits = npairs * rgs;
    const bool pin = (gridDim.x & 7) == 0 && (npairs & 7) == 0 && nunits == 2 * (int)gridDim.x;
    for (int b = blockIdx.x, k = 0; b < nunits; b += gridDim.x, ++k) {
      int sh, rg;
      if (pin) { const int xcd = blockIdx.x & 7, j = (blockIdx.x >> 3) + (gridDim.x >> 3) * k; sh = xcd * (npairs >> 3) + j / rgs; rg = j % rgs; }
      else { sh = b / rgs; rg = b % rgs; }
      attn_a_block(p, layer, L, sh >> 3, sh & 7, rg * 4, lds);
    }
  }
  { const int tid = opaque_tid(); lane = tid & 63; w = blockIdx.x * 8 + __builtin_amdgcn_readfirstlane(tid >> 6); }
  { const int pbs = L >> 8, ntrip = nseq * 12, nunits = ntrip * pbs;
    const bool pin = (gridDim.x & 7) == 0 && (ntrip & 7) == 0 && nunits == 3 * (int)gridDim.x;
    for (int b = blockIdx.x, k = 0; b < nunits; b += gridDim.x, ++k) {
      int pblk, sgh;
      if (pin) { const int xcd = blockIdx.x & 7, j = (blockIdx.x >> 3) + (gridDim.x >> 3) * k; sgh = xcd * (ntrip >> 3) + j / pbs; pblk = j % pbs; }
      else { pblk = b % pbs; sgh = b / pbs; }
      const int seq = sgh / 12, gh = sgh % 12;
      attn_c_block(p, L, lshift, seq, gh >> 2, gh & 3, pblk, lds);
    }
  }
  }
}

__device__ void phase_combine(const Params& p) {
  const int gt = blockIdx.x * 512 + opaque_tid(), ngt = gridDim.x * 512;
  for (int it = gt; it < TC * 32; it += ngt) {
    const int tok = it >> 5, sub = it & 31, h = sub >> 3, d8 = (sub & 7) * 8;
    const float* ls = p.lse + (size_t)tok * 12;
    const float l0 = ls[h], l1 = ls[4 + h], l2 = ls[8 + h];
    const float mx = fmaxf(l0, fmaxf(l1, l2));
    const float w0 = fexp2(l0 - mx), w1 = fexp2(l1 - mx), w2 = fexp2(l2 - mx);
    const float inv = frcp(w0 + w1 + w2);
    const bf16_t* ob = p.oc + (size_t)tok * 768 + h * 64 + d8;
    const u32x4 a = *(const u32x4*)ob, b = *(const u32x4*)(ob + 256), c = *(const u32x4*)(ob + 512);
    const u32x4 z = *(const u32x4*)(p.u + (size_t)tok * UW + U_ZC + h * 64 + d8);
    u32x4 r;
#pragma unroll
    for (int k = 0; k < 4; ++k) {
      const float vlo = (w0 * bf_lo(a[k]) + w1 * bf_lo(b[k]) + w2 * bf_lo(c[k])) * inv * silu(bf_lo(z[k]));
      const float vhi = (w0 * bf_hi(a[k]) + w1 * bf_hi(b[k]) + w2 * bf_hi(c[k])) * inv * silu(bf_hi(z[k]));
      r[k] = cvt_pk_bf16(vlo, vhi);
    }
    *(u32x4*)(p.yg + (size_t)tok * YW + 1024 + h * 64 + d8) = r;
  }
}


#define XB_TMO      128
#define XB_XCNT(j)  (256  + 64 * (j))
#define XB_XSUB(j)  (1280 + 64 * (j))
#define XB_XGEN(j)  (2304 + 64 * (j))
#define XB_TOP      3328
#define XB_TOPGEN   3392
#define XCD_BAR_WORDS 3456
#define XB_SPIN_CAP (1u << 18)
__device__ __forceinline__ unsigned xb_ld(unsigned* p)              { return __hip_atomic_load(p, __ATOMIC_RELAXED, __HIP_MEMORY_SCOPE_AGENT); }
__device__ __forceinline__ unsigned xb_add(unsigned* p, unsigned v) { return __hip_atomic_fetch_add(p, v, __ATOMIC_RELAXED, __HIP_MEMORY_SCOPE_AGENT); }
__device__ __forceinline__ unsigned xb_xcc_id() { return (unsigned)__builtin_amdgcn_s_getreg((3 << 11) | 20) & 0xFu; }
#define XB_SPIN(cond, bar) do { unsigned _sp = 0; while (cond) { __builtin_amdgcn_s_sleep(1); \
    if ((++_sp & 255u) == 0u) { if (xb_ld(&(bar)[XB_TMO])) break; if (_sp > XB_SPIN_CAP) { atomicAdd(&(bar)[XB_TMO], 1u); break; } } } } while (0)
struct XcdBarrier { unsigned* bar; unsigned x; volatile LAS unsigned* st; };
__device__ __forceinline__ XcdBarrier xcd_barrier_post(unsigned* bar, volatile LAS unsigned* st) {
  XcdBarrier b; b.bar = bar; b.x = xb_xcc_id(); b.st = st;
  if (opaque_tid() == 0) (void)xb_add(&bar[XB_XCNT(b.x)], 1u);
  return b;
}
__device__ __forceinline__ void xcd_barrier_complete(unsigned* bar, unsigned x, unsigned& nloc, unsigned& nx) {
  const unsigned G = gridDim.x * gridDim.y * gridDim.z;
  unsigned sum, cnt, mine, sp = 0u;
  for (;;) {
    sum = 0u; cnt = 0u; mine = 0u;
#pragma unroll
    for (unsigned j = 0; j < 16; ++j) { const unsigned c = xb_ld(&bar[XB_XCNT(j)]); sum += c; cnt += (c > 0u) ? 1u : 0u; mine = (j == x) ? c : mine; }
    if (sum == G) break;
    __builtin_amdgcn_s_sleep(1);
    if ((++sp & 255u) == 0u) { if (xb_ld(&bar[XB_TMO])) break; if (sp > XB_SPIN_CAP) { atomicAdd(&bar[XB_TMO], 1u); break; } }
  }
  nloc = mine > 0u ? mine : 1u; nx = cnt > 0u ? cnt : 1u;
}
__device__ __forceinline__ void xcd_barrier(const XcdBarrier& b) {
  asm volatile("s_waitcnt vmcnt(0)" ::: "memory");
  __syncthreads();
  if (opaque_tid() == 0) {
    unsigned* bar = b.bar;
    __builtin_amdgcn_s_waitcnt(0);
    unsigned nloc = b.st[0], nx = b.st[1];
    if (nloc == 0u) { xcd_barrier_complete(bar, b.x, nloc, nx); b.st[0] = nloc; b.st[1] = nx; }
    const unsigned old = xb_add(&bar[XB_XSUB(b.x)], 1u);
    const unsigned gen = old / nloc;
    if (old + 1u == (gen + 1u) * nloc) {
      __builtin_amdgcn_fence(__ATOMIC_RELEASE, "agent");
      asm volatile("s_waitcnt vmcnt(0)" ::: "memory");
      const unsigned og = xb_add(&bar[XB_TOP], 1u);
      const unsigned tg = og / nx;
      if (og + 1u == (tg + 1u) * nx) xb_add(&bar[XB_TOPGEN], 1u);
      else XB_SPIN(xb_ld(&bar[XB_TOPGEN]) == tg, bar);
      __builtin_amdgcn_fence(__ATOMIC_ACQUIRE, "agent");
      xb_add(&bar[XB_XGEN(b.x)], 1u);
      asm volatile("s_waitcnt vmcnt(0)" ::: "memory");
    } else {
      XB_SPIN(xb_ld(&bar[XB_XGEN(b.x)]) == gen, bar);
      __builtin_amdgcn_fence(__ATOMIC_ACQUIRE, "agent");
      asm volatile("s_waitcnt vmcnt(0)" ::: "memory");
    }
  }
  __syncthreads();
}

constexpr int DYN_LDS_BYTES = LDS_ATT_TOTAL > pg8::STAGE_BYTES ? LDS_ATT_TOTAL : pg8::STAGE_BYTES;
__global__ void __launch_bounds__(512) fwd_megakernel(Params p) {
  extern __shared__ __attribute__((aligned(16))) unsigned char smem[];
  __shared__ __attribute__((aligned(16))) unsigned xb_words[4];
  cg::grid_group grid = cg::this_grid();
  if (threadIdx.x == 0) { xb_words[0] = 0u; xb_words[1] = 0u; xb_words[2] = 0u; xb_words[3] = 0u; }
  if ((threadIdx.x & 63) == 0) g_wid_table[hw_wave_slot()] = (int)(threadIdx.x >> 6);
  __syncthreads();
  const XcdBarrier xb = xcd_barrier_post(p.bar, (volatile LAS unsigned*)xb_words);
#define GSYNC() xcd_barrier(xb)
  LAS unsigned char* lds = (LAS unsigned char*)smem;
  phase_prep(p, (LAS float*)smem);
  phase_x(p, 0);
  grid.sync();
  for (int chunk = 0; chunk < NCHUNK; ++chunk) {
    const int L = chunk < 2 ? 2048 : 4096, lshift = chunk < 2 ? 11 : 12;
    const float* xin = (chunk < 2) ? p.xp + (size_t)chunk * TC * DM : p.xs + (size_t)(chunk - 2) * TC * DM;
    float* xres = p.out + (size_t)chunk * TC * DM;
    float* ssq = p.ssq + (size_t)chunk * TC * 16;
    for (int layer = 0; layer < DEPTH; ++layer) {
      {
        {
        { pg8::Gemm g{p.xb, p.wt_in + (size_t)layer * INW * DM, TC, UW, DM, 0, lshift};
          pg8::StaticOrder S; S.init(TC, UW, gridDim.x, blockIdx.x);
          EpiU E{p.u, p.rinv + (size_t)chunk * TC, p.b_gate + (size_t)layer * 3 * DM};
          pg8::gemm_phase<false>(lds, g, S, E); }
        {
          pg8::Gemm g{p.wt_in + ((size_t)layer * INW + UW) * DM, p.xb, VW, TC, DM, 1, lshift};
          pg8::StaticOrder S; S.init(VW, TC, gridDim.x, (blockIdx.x + (gridDim.x >> 2)) % gridDim.x);
          EpiVT E{p.vt, p.rinv + (size_t)chunk * TC, L, lshift};
          pg8::gemm_phase<true>(lds, g, S, E); }
        }
      }
      GSYNC();
      phase_attn(p, layer, L, lshift, lds);
      GSYNC();
      phase_combine(p);
      GSYNC();
      {
        pg8::Gemm g{p.yg, p.wt_br + (size_t)layer * DM * YW, TC, DM, YW, 0, 0};
        pg8::StaticOrder S; S.init(TC, DM, gridDim.x, blockIdx.x);
        EpiMerge E{p.u, p.merged};
        pg8::gemm_phase<false>(lds, g, S, E);
      }
      GSYNC();
      {
        pg8::Gemm g{p.merged, p.wt_out + (size_t)layer * DM * DM, TC, DM, DM, 0, 0};
        pg8::StaticOrder S; S.init(TC, DM, gridDim.x, blockIdx.x);
        EpiRes E{layer == 0 ? xin : (const float*)nullptr, p.xb, layer == DEPTH - 1 ? xres : (float*)nullptr, p.xb, ssq};
        pg8::gemm_phase<false>(lds, g, S, E);
      }
      GSYNC();
      if (layer + 1 < DEPTH) { phase_rinv(p, chunk); GSYNC(); }
    }
    phase_final(p, chunk);
    if (chunk + 1 < NCHUNK) { phase_x(p, chunk + 1); GSYNC(); }
  }
}

extern "C" void kernel_launch(void* const* d_in, const int* in_sizes, int n_in, void* d_out, int out_size, void* d_ws, size_t ws_size, hipStream_t stream) {
  (void)in_sizes; (void)n_in; (void)out_size;
  static int grid_blocks = 0;
  if (!grid_blocks) {
    int dev = 0, cus = 0, per_cu = 0;
    hipGetDevice(&dev);
    hipDeviceGetAttribute(&cus, hipDeviceAttributeMultiprocessorCount, dev);
    hipFuncSetAttribute((const void*)fwd_megakernel, hipFuncAttributeMaxDynamicSharedMemorySize, DYN_LDS_BYTES);
    hipOccupancyMaxActiveBlocksPerMultiprocessor(&per_cu, fwd_megakernel, 512, DYN_LDS_BYTES);
    if (per_cu < 1) per_cu = 1;
    grid_blocks = cus * per_cu;
    if (grid_blocks > 256) grid_blocks = 256;
  }
  Params p{};
  p.xp = (const float*)d_in[0]; p.xs = (const float*)d_in[1]; p.g_norm = (const float*)d_in[2]; p.w_in = (const float*)d_in[3];
  p.b_gate = (const float*)d_in[4]; p.rpb = (const float*)d_in[5]; p.lam_qk = (const float*)d_in[6]; p.g_diff = (const float*)d_in[7];
  p.w_br_a = (const float*)d_in[8]; p.w_br_b = (const float*)d_in[9]; p.w_br_c = (const float*)d_in[10]; p.w_out = (const float*)d_in[11];
  p.g_final = (const float*)d_in[12];
  p.out = (float*)d_out;
  char* w = (char*)d_ws; size_t off = 0;
  auto take = [&](size_t bytes) { char* r = w + off; off += (bytes + 255) & ~(size_t)255; return r; };
  p.wt_in = (bf16_t*)take((size_t)DEPTH * INW * DM * 2);
  p.wt_br = (bf16_t*)take((size_t)DEPTH * DM * YW * 2);
  p.wt_out = (bf16_t*)take((size_t)DEPTH * DM * DM * 2);
  p.xb = (bf16_t*)take((size_t)TC * DM * 2);
  p.u = (bf16_t*)take((size_t)TC * UW * 2);
  p.vt = (bf16_t*)take((size_t)TC * VW * 2);
  p.yg = (bf16_t*)take((size_t)TC * YW * 2);
  p.oc = (bf16_t*)take((size_t)TC * 768 * 2);
  p.merged = (bf16_t*)take((size_t)TC * DM * 2);
  p.lse = (float*)take((size_t)TC * 12 * 4);
  p.ssq = (float*)take((size_t)NTOK * 16 * 4);
  p.lam = (float*)take(256);
  p.rinv = (float*)take((size_t)NTOK * 4);
  p.bar = (unsigned*)take((size_t)XCD_BAR_WORDS * 4);
  if (off > ws_size) fprintf(stderr, "workspace too small: need %zu have %zu\n", off, ws_size);
  hipMemsetAsync(p.bar, 0, (size_t)XCD_BAR_WORDS * 4, stream);
  void* args[] = {&p};
  hipError_t e = hipLaunchCooperativeKernel((void*)fwd_megakernel, dim3(grid_blocks), dim3(512), args, DYN_LDS_BYTES, stream);
  if (e != hipSuccess) fprintf(stderr, "cooperative launch failed: %s (grid %d)\n", hipGetErrorString(e), grid_blocks);
}
```
